# Optimizing an MI355X kernel written in HIP

```python
import math
import jax, jax.numpy as jnp
from jax import lax
import numpy as np

D_MODEL = 2048
BATCH = 1
SEQ = 16384
DEPTH = 2

HEAD_DIM = 64
MIX_WIDTH = D_MODEL
A_WIDTH = MIX_WIDTH // 4
B_WIDTH = MIX_WIDTH // 4
C_WIDTH = MIX_WIDTH // 2
A_HEADS = A_WIDTH // HEAD_DIM
B_HEADS = B_WIDTH // HEAD_DIM
C_VDIM = 2 * HEAD_DIM
C_HEADS = C_WIDTH // C_VDIM
IN_WIDTH = 3 * A_WIDTH + 3 * B_WIDTH + 3 * C_WIDTH
A_PATTERNS = ((128, 1), (512, 4), (2048, 16))
A_BLOCK = 128
MOBA_BLOCK = 256
MOBA_TOPK = 3
QBLOCK = 128
ROPE_THETA = 10000.0
N_EXPERTS = 16
N_GROUPS = 4
EXPERTS_PER_GROUP = N_EXPERTS // N_GROUPS
TOP_K = 2
D_EXPERT = D_MODEL // 2
RMS_EPS = 1e-6

kernel_name = "hybrid_dilated_moba_diffattn_groupmoe"


def _rms_norm(x, g):
    xf = x.astype(jnp.float32)
    y = xf * lax.rsqrt(jnp.mean(xf * xf, axis=-1, keepdims=True) + RMS_EPS)
    return (y * g.astype(jnp.float32)).astype(x.dtype)


def _rope_tables(positions):
    inv = ROPE_THETA ** (-jnp.arange(0, HEAD_DIM, 2, dtype=jnp.float32) / HEAD_DIM)
    ang = positions.astype(jnp.float32)[..., None] * inv
    return jnp.cos(ang)[:, :, None, :], jnp.sin(ang)[:, :, None, :]


def _rope(x, cos, sin):
    xf = x.astype(jnp.float32)
    x1, x2 = xf[..., : HEAD_DIM // 2], xf[..., HEAD_DIM // 2:]
    return jnp.concatenate([x1 * cos - x2 * sin, x2 * cos + x1 * sin], axis=-1).astype(x.dtype)


def _banded_window_attention(q, k, v, span):
    L, hd = q.shape[-2], q.shape[-1]
    lead = q.shape[:-2]
    nb = -(-L // A_BLOCK)
    pad = nb * A_BLOCK - L
    qb = jnp.pad(q, [(0, 0)] * len(lead) + [(0, pad), (0, 0)]).reshape(*lead, nb, A_BLOCK, hd)

    def band(t):
        tb = jnp.pad(t, [(0, 0)] * len(lead) + [(A_BLOCK, pad), (0, 0)])
        tb = tb.reshape(*lead, nb + 1, A_BLOCK, t.shape[-1])
        return jnp.concatenate([tb[..., :-1, :, :], tb[..., 1:, :, :]], axis=-2)

    kb, vb = band(k), band(v)
    s = jnp.einsum('...nqd,...nkd->...nqk', qb, kb).astype(jnp.float32) * (hd ** -0.5)
    dist = A_BLOCK + jnp.arange(A_BLOCK)[:, None] - jnp.arange(2 * A_BLOCK)[None, :]
    kpos = (jnp.arange(nb)[:, None, None] - 1) * A_BLOCK + jnp.arange(2 * A_BLOCK)[None, None, :]
    mask = (dist >= 0) & (dist <= span) & (kpos >= 0)
    s = jnp.where(mask, s, -jnp.inf)
    m = jnp.max(s, axis=-1, keepdims=True)
    p = jnp.exp(s - m)
    den = jnp.sum(p, axis=-1)
    o = jnp.einsum('...nqk,...nkd->...nqd', p.astype(v.dtype), vb).astype(jnp.float32) / den[..., None]
    lse = m[..., 0] + jnp.log(den)
    o = o.reshape(*lead, nb * A_BLOCK, v.shape[-1])[..., :L, :]
    lse = lse.reshape(*lead, nb * A_BLOCK)[..., :L]
    return o, lse


def _dilated_attention(q, k, v):
    B, H, S, hd = q.shape
    outs, lses = [], []
    for window, dil in A_PATTERNS:
        def to_sub(t):
            return t.reshape(B, H, S // dil, dil, t.shape[-1]).swapaxes(2, 3)
        o, lse = _banded_window_attention(to_sub(q), to_sub(k), to_sub(v), window // dil)
        outs.append(o.swapaxes(2, 3).reshape(B, H, S, v.shape[-1]))
        lses.append(lse.swapaxes(2, 3).reshape(B, H, S))
    w = jax.nn.softmax(jnp.stack(lses), axis=0)
    return jnp.sum(w[..., None] * jnp.stack(outs), axis=0)


def _moba_attention(q, k, v):
    B, H, S, hd = q.shape
    nb = -(-S // MOBA_BLOCK)
    sp = nb * MOBA_BLOCK
    kp = jnp.pad(k, [(0, 0), (0, 0), (0, sp - S), (0, 0)])
    vp = jnp.pad(v, [(0, 0), (0, 0), (0, sp - S), (0, 0)])
    kblk = kp.reshape(B, H, nb, MOBA_BLOCK, hd)
    vblk = vp.reshape(B, H, nb, MOBA_BLOCK, hd)
    kmean = jnp.mean(kblk.astype(jnp.float32), axis=3)
    gate = jnp.einsum('bhsd,bhnd->bhsn', q.astype(jnp.float32), kmean)
    own = jnp.arange(S) // MOBA_BLOCK
    past = jnp.arange(nb)[None, :] < own[:, None]
    gate = jnp.where(past, gate, -jnp.inf)
    topk = min(MOBA_TOPK, nb)
    _, idx = lax.top_k(gate, topk)
    valid = jnp.arange(topk)[None, :] < own[:, None]
    nc = S // QBLOCK
    q_c = q.reshape(B, H, nc, QBLOCK, hd).transpose(2, 0, 1, 3, 4)
    idx_c = idx.reshape(B, H, nc, QBLOCK, topk).transpose(2, 0, 1, 3, 4)
    valid_c = valid.reshape(nc, QBLOCK, topk)
    starts = jnp.arange(nc) * QBLOCK
    bi = jnp.arange(B)[:, None, None, None]
    hi = jnp.arange(H)[None, :, None, None]
    scale = hd ** -0.5
    nsel = topk * MOBA_BLOCK

    def one_block(args):
        qc, ic, vc, st = args
        kg = kblk[bi, hi, ic]
        vg = vblk[bi, hi, ic]
        s_r = jnp.einsum('bhqd,bhqnmd->bhqnm', qc, kg).astype(jnp.float32) * scale
        s_r = jnp.where(vc[None, None, :, :, None], s_r, -jnp.inf).reshape(B, H, QBLOCK, nsel)
        own_start = (st // MOBA_BLOCK) * MOBA_BLOCK
        ko = lax.dynamic_slice_in_dim(kp, own_start, MOBA_BLOCK, axis=2)
        vo = lax.dynamic_slice_in_dim(vp, own_start, MOBA_BLOCK, axis=2)
        s_o = jnp.einsum('bhqd,bhmd->bhqm', qc, ko).astype(jnp.float32) * scale
        causal = (own_start + jnp.arange(MOBA_BLOCK))[None, :] <= (st + jnp.arange(QBLOCK))[:, None]
        s_o = jnp.where(causal, s_o, -jnp.inf)
        p = jax.nn.softmax(jnp.concatenate([s_r, s_o], axis=-1), axis=-1)
        p_r = p[..., :nsel].reshape(B, H, QBLOCK, topk, MOBA_BLOCK).astype(v.dtype)
        p_o = p[..., nsel:].astype(v.dtype)
        return (jnp.einsum('bhqnm,bhqnmd->bhqd', p_r, vg).astype(jnp.float32)
                + jnp.einsum('bhqm,bhmd->bhqd', p_o, vo).astype(jnp.float32))

    out = lax.map(one_block, (q_c, idx_c, valid_c, starts))
    return out.transpose(1, 2, 0, 3, 4).reshape(B, H, S, hd)


def _diff_attention(q1, q2, k1, k2, v, lam):
    B, H, S, hd = q1.shape
    nc = S // QBLOCK
    scale = hd ** -0.5
    kpos = jnp.arange(S)

    def chunks(t):
        return t.reshape(B, H, nc, QBLOCK, hd).transpose(2, 0, 1, 3, 4)

    def one_block(args):
        q1c, q2c, st = args
        causal = kpos[None, :] <= (st + jnp.arange(QBLOCK))[:, None]

        def attn_map(qc, kk):
            s = jnp.einsum('bhqd,bhkd->bhqk', qc, kk).astype(jnp.float32) * scale
            return jax.nn.softmax(jnp.where(causal, s, -jnp.inf), axis=-1)

        a = attn_map(q1c, k1) - lam * attn_map(q2c, k2)
        return jnp.einsum('bhqk,bhkd->bhqd', a.astype(v.dtype), v).astype(jnp.float32)

    out = lax.map(one_block, (chunks(q1), chunks(q2), jnp.arange(nc) * QBLOCK))
    return out.transpose(1, 2, 0, 3, 4).reshape(B, H, S, v.shape[-1])


def _token_mixer(h, cos, sin, w_in, w_out, lq1, lk1, lq2, lk2, g_sub, lam_init):
    B, S, _ = h.shape
    sizes = [A_WIDTH] * 3 + [B_WIDTH] * 3 + [C_WIDTH] * 3
    splits = [int(v) for v in np.cumsum(sizes)[:-1]]
    proj = jnp.dot(h, w_in)
    qa, ka, va, qb, kb, vb, qc, kc, vc = jnp.split(proj, splits, axis=-1)

    def heads(t, n):
        return t.reshape(B, S, n, -1)

    def bhsd(t):
        return t.transpose(0, 2, 1, 3)

    def flat(o):
        return o.transpose(0, 2, 1, 3).reshape(B, S, -1).astype(h.dtype)

    o_a = _dilated_attention(bhsd(_rope(heads(qa, A_HEADS), cos, sin)),
                             bhsd(_rope(heads(ka, A_HEADS), cos, sin)),
                             bhsd(heads(va, A_HEADS)))
    o_b = _moba_attention(bhsd(_rope(heads(qb, B_HEADS), cos, sin)),
                          bhsd(_rope(heads(kb, B_HEADS), cos, sin)),
                          bhsd(heads(vb, B_HEADS)))
    qc, kc = heads(qc, C_HEADS), heads(kc, C_HEADS)
    q1 = _rope(qc[..., :HEAD_DIM], cos, sin)
    q2 = _rope(qc[..., HEAD_DIM:], cos, sin)
    k1 = _rope(kc[..., :HEAD_DIM], cos, sin)
    k2 = _rope(kc[..., HEAD_DIM:], cos, sin)
    f32 = jnp.float32
    lam = (jnp.exp(jnp.sum(lq1.astype(f32) * lk1.astype(f32)))
           - jnp.exp(jnp.sum(lq2.astype(f32) * lk2.astype(f32))) + lam_init)
    o_c = _diff_attention(bhsd(q1), bhsd(q2), bhsd(k1), bhsd(k2), bhsd(heads(vc, C_HEADS)), lam)
    o_c = _rms_norm(o_c, g_sub) * (1.0 - lam_init)

    merged = jnp.concatenate([flat(o_a), flat(o_b), flat(o_c)], axis=-1)
    return jnp.dot(merged, w_out)


def _moe(h, w_router, b_router, w_gate, w_up, w_down):
    B, S, D = h.shape
    T = B * S
    tok = h.reshape(T, D)
    s = jax.nn.sigmoid(jnp.dot(tok, w_router).astype(jnp.float32))
    sg = (s + b_router.astype(jnp.float32)).reshape(T, N_GROUPS, EXPERTS_PER_GROUP)
    group_score = jnp.sum(lax.top_k(sg, TOP_K)[0], axis=-1)
    g = jnp.argmax(group_score, axis=-1)
    cand = jnp.take_along_axis(sg, g[:, None, None], axis=1)[:, 0]
    _, loc = lax.top_k(cand, TOP_K)
    eid = g[:, None] * EXPERTS_PER_GROUP + loc
    wts = jnp.take_along_axis(s, eid, axis=1)
    wts = wts / jnp.sum(wts, axis=-1, keepdims=True)
    flat_e = eid.reshape(-1)
    order = jnp.argsort(flat_e)
    tok_idx = order // TOP_K
    xs = tok[tok_idx]
    gs = jnp.bincount(flat_e, length=N_EXPERTS).astype(jnp.int32)
    a = lax.ragged_dot(xs, w_gate, gs)
    b = lax.ragged_dot(xs, w_up, gs)
    y = lax.ragged_dot(jax.nn.silu(a) * b, w_down, gs)
    y = y * wts.reshape(-1)[order][:, None].astype(y.dtype)
    out = jnp.zeros_like(tok).at[tok_idx].add(y)
    return out.reshape(B, S, D)


def setup_inputs(seed: int = 0) -> dict:
    key = jax.random.key(seed)
    ks = jax.random.split(key, 20)
    D = D_MODEL

    def nrm(k, shape, std):
        return jax.random.normal(k, shape, jnp.float32) * std

    return {
        "x": nrm(ks[0], (BATCH, SEQ, D), 1.0),
        "c": nrm(ks[1], (BATCH, D), 1.0),
        "positions": jnp.broadcast_to(jnp.arange(SEQ, dtype=jnp.int32)[None, :], (BATCH, SEQ)),
        "w_ada": nrm(ks[2], (DEPTH, D, 6 * D), 0.5 * D ** -0.5),
        "b_ada": nrm(ks[3], (DEPTH, 6 * D), 0.01),
        "g_attn": 1.0 + nrm(ks[4], (DEPTH, D), 0.05),
        "g_mlp": 1.0 + nrm(ks[5], (DEPTH, D), 0.05),
        "w_in": nrm(ks[6], (DEPTH, D, IN_WIDTH), D ** -0.5),
        "w_out": nrm(ks[7], (DEPTH, MIX_WIDTH, D), MIX_WIDTH ** -0.5),
        "lam_q1": nrm(ks[8], (DEPTH, HEAD_DIM), 0.1),
        "lam_k1": nrm(ks[9], (DEPTH, HEAD_DIM), 0.1),
        "lam_q2": nrm(ks[10], (DEPTH, HEAD_DIM), 0.1),
        "lam_k2": nrm(ks[11], (DEPTH, HEAD_DIM), 0.1),
        "g_subln": 1.0 + nrm(ks[12], (DEPTH, C_VDIM), 0.05),
        "w_gate": nrm(ks[13], (DEPTH, N_EXPERTS, D, D_EXPERT), D ** -0.5),
        "w_up": nrm(ks[14], (DEPTH, N_EXPERTS, D, D_EXPERT), D ** -0.5),
        "w_down": nrm(ks[15], (DEPTH, N_EXPERTS, D_EXPERT, D), D_EXPERT ** -0.5),
        "w_router": nrm(ks[16], (D, N_EXPERTS), D ** -0.5),
        "b_router": nrm(ks[17], (N_EXPERTS,), 0.01),
        "g_final": 1.0 + nrm(ks[18], (D,), 0.05),
    }


def reference(x, c, positions, w_ada, b_ada, g_attn, g_mlp, w_in, w_out,
              lam_q1, lam_k1, lam_q2, lam_k2, g_subln, w_gate, w_up, w_down,
              w_router, b_router, g_final):
    cos, sin = _rope_tables(positions)
    for l in range(DEPTH):
        lam_init = 0.8 - 0.6 * math.exp(-0.3 * l)
        mod = jnp.dot(jax.nn.silu(c), w_ada[l]) + b_ada[l]
        sh_a, sc_a, gt_a, sh_m, sc_m, gt_m = jnp.split(mod, 6, axis=-1)
        h = _rms_norm(x, g_attn[l]) * (1.0 + sc_a[:, None, :]) + sh_a[:, None, :]
        x = x + gt_a[:, None, :] * _token_mixer(h, cos, sin, w_in[l], w_out[l], lam_q1[l], lam_k1[l],
                                                lam_q2[l], lam_k2[l], g_subln[l], lam_init)
        h = _rms_norm(x, g_mlp[l]) * (1.0 + sc_m[:, None, :]) + sh_m[:, None, :]
        x = x + gt_m[:, None, :] * _moe(h, w_router, b_router, w_gate[l], w_up[l], w_down[l])
    return _rms_norm(x, g_final)
```

```cpp
#include <hip/hip_runtime.h>
#include <hip/hip_bf16.h>
#include <cstdio>
#include <cstdint>
#include <cmath>
namespace pg8 {
#define PG8_LAS __attribute__((address_space(3)))
typedef unsigned short bf16_t;
typedef short bf16x8 __attribute__((ext_vector_type(8)));
typedef float f32x4 __attribute__((ext_vector_type(4)));
typedef unsigned u32x4 __attribute__((ext_vector_type(4)));
constexpr int BM = 256, BK = 64, HALF = 128, HTB = HALF * BK * 2  , STAGE_BYTES = 8 * HTB, NXCD = 8, WGM = 8;

__host__ __device__ __forceinline__ int lds_byte(int r, int c) { const int st = (r >> 4) * 2 + (c >> 5), rr = r & 15, cc = c & 31, ob = rr * 64 + cc * 2; return st * 1024 + (ob ^ (((ob >> 9) & 1) << 5)); }
__host__ __device__ __forceinline__ void stage_rc(int b, int& R, int& C) { const int st = b / 1024, sb = b % 1024, swz = sb ^ (((sb >> 9) & 1) << 5); R = (st >> 1) * 16 + swz / 64; C = (st & 1) * 32 + (swz % 64) / 2; }
__host__ __device__ __forceinline__ int perm32(int rho) { const int n = rho >> 4, i = rho & 15; return 8 * (i >> 2) + 4 * n + (i & 3); }

struct Unit { int pm, pn; };
struct Gemm { const bf16_t* A; const bf16_t* Bt; int M, N, K; };

struct StaticOrder {
    int nM, nN, nwg, G, c;
    __host__ __device__ void init(int M, int N, int G_, int c_) { nM = M / BM; nN = N / BM; nwg = nM * nN; G = G_; c = c_; }
    __host__ __device__ bool next(int i, Unit& u) const {
        const long L = (long)i * G + c; if (L >= nwg) return false;
        int wgid = (int)L; { const int q = nwg / NXCD, r = nwg % NXCD, xcd = wgid % NXCD, off = wgid / NXCD; wgid = (xcd < r ? xcd * (q + 1) : r * (q + 1) + (xcd - r) * q) + off; }
        const int nig = WGM * nN, gid = wgid / nig, fm = gid * WGM, gsz = (nM - fm) < WGM ? (nM - fm) : WGM;
        u.pm = fm + ((wgid % nig) % gsz); u.pn = (wgid % nig) / gsz; return true;
    }
    __device__ __forceinline__ void a_ready(const Unit&) const {}
    __device__ __forceinline__ void done(const Unit&) const {}
};

struct DenseSched {
    const char* A; const char* Bt; size_t tstep; StaticOrder so;
    __device__ __forceinline__ void init(const void* A_, const void* Bt_, int M, int N, int K, int G, int c) { A = (const char*)A_; Bt = (const char*)Bt_; tstep = (size_t)BM * K * 2; so.init(M, N, G, c); }
    __device__ __forceinline__ bool next(int i, Unit& u) const { return so.next(i, u); }
    __device__ __forceinline__ const char* a_ptr(const Unit& u) const { return A + (size_t)u.pm * tstep; }
    __device__ __forceinline__ const char* b_ptr(const Unit& u) const { return Bt + (size_t)u.pn * tstep; }
    __device__ __forceinline__ void a_ready(const Unit&) const {}
    __device__ __forceinline__ void done(const Unit&) const {}
};
struct MoeSched {
    const char* A; const char* Bt; size_t tstep, estride; StaticOrder so; const PG8_LAS unsigned char* p2e;
    __device__ __forceinline__ void init(const void* A_, const void* Bt_, int Mpad, int N, int K, size_t estride_, const PG8_LAS unsigned char* p2e_, int G, int c) {
        A = (const char*)A_; Bt = (const char*)Bt_; tstep = (size_t)BM * K * 2; estride = estride_; p2e = p2e_; so.init(Mpad, N, G, c); }
    __device__ __forceinline__ bool next(int i, Unit& u) const { return so.next(i, u); }
    __device__ __forceinline__ const char* a_ptr(const Unit& u) const { return A + (size_t)u.pm * tstep; }
    __device__ __forceinline__ const char* b_ptr(const Unit& u) const { const int e = __builtin_amdgcn_readfirstlane((int)p2e[u.pm]); return Bt + (size_t)e * estride + (size_t)u.pn * tstep; }
    __device__ __forceinline__ void a_ready(const Unit&) const {}
    __device__ __forceinline__ void done(const Unit&) const {}
};

__device__ __forceinline__ unsigned cvt_pk_bf16(float lo, float hi) { unsigned r; asm volatile("v_cvt_pk_bf16_f32 %0, %1, %2" : "=v"(r) : "v"(lo), "v"(hi)); return r; }

struct EpiProj {
    static constexpr bool PERM = true, AFTER_DRAIN = false;
    bf16_t* O; const float* cosT; const float* sinT; float qscale;
    __device__ __forceinline__ void operator()(const f32x4 (&acc)[2][2][4][2], const Unit& u, int wr, int wc, int fr, int fq) const {
        const int pn = u.pn;
        const bool isq = (pn < 2) || (pn == 6) || (pn == 7) || (pn >= 12 && pn < 16);
        const bool isk = (pn == 2) || (pn == 3) || (pn == 8) || (pn == 9) || (pn >= 16 && pn < 20);
        const int row0 = u.pm * BM + wr * 64 + fr, col0 = pn * BM + wc * 32 + 8 * fq;
        const int i0 = (wc & 1) * 16 + 4 * fq;
        const float sc = isq ? qscale : 1.f;
#pragma unroll
        for (int ai = 0; ai < 2; ++ai)
#pragma unroll
            for (int m = 0; m < 4; ++m) { const int row = row0 + ai * HALF + m * 16; bf16_t* rowp = O + (size_t)row * 6144 + col0;
                f32x4 cs = (f32x4){1.f, 1.f, 1.f, 1.f}, sn = (f32x4){0.f, 0.f, 0.f, 0.f};
                if (isq || isk) { cs = *(const f32x4*)(cosT + (size_t)row * 32 + i0); sn = *(const f32x4*)(sinT + (size_t)row * 32 + i0); }
#pragma unroll
                for (int bj = 0; bj < 2; ++bj) { const f32x4 v0 = acc[ai][bj][m][0], v1 = acc[ai][bj][m][1];
                    const float a0 = (v0[0] * cs[0] - v0[1] * sn[0]) * sc, b0 = (v0[1] * cs[0] + v0[0] * sn[0]) * sc;
                    const float a1 = (v0[2] * cs[1] - v0[3] * sn[1]) * sc, b1 = (v0[3] * cs[1] + v0[2] * sn[1]) * sc;
                    const float a2 = (v1[0] * cs[2] - v1[1] * sn[2]) * sc, b2 = (v1[1] * cs[2] + v1[0] * sn[2]) * sc;
                    const float a3 = (v1[2] * cs[3] - v1[3] * sn[3]) * sc, b3 = (v1[3] * cs[3] + v1[2] * sn[3]) * sc;
                    u32x4 w; w.x = cvt_pk_bf16(a0, b0); w.y = cvt_pk_bf16(a1, b1); w.z = cvt_pk_bf16(a2, b2); w.w = cvt_pk_bf16(a3, b3);
                    *(u32x4*)(rowp + bj * HALF) = w; } }
    }
};
struct EpiGateRes {
    static constexpr bool PERM = false, AFTER_DRAIN = false;
    const float* base; float* out; const float* gate;
    __device__ __forceinline__ void operator()(const f32x4 (&acc)[2][2][4][2], const Unit& u, int wr, int wc, int fr, int fq) const {
        const int col0 = u.pn * BM + wc * 32 + 4 * fq;
        f32x4 gv[2][2];
#pragma unroll
        for (int bj = 0; bj < 2; ++bj)
#pragma unroll
            for (int n = 0; n < 2; ++n) gv[bj][n] = *(const f32x4*)(gate + col0 + bj * HALF + n * 16);
#pragma unroll
        for (int ai = 0; ai < 2; ++ai)
#pragma unroll
            for (int m = 0; m < 4; ++m) { const size_t off = (size_t)(u.pm * BM + ai * HALF + wr * 64 + m * 16 + fr) * 2048 + col0;
#pragma unroll
                for (int bj = 0; bj < 2; ++bj)
#pragma unroll
                    for (int n = 0; n < 2; ++n) { const f32x4 bs = *(const f32x4*)(base + off + bj * HALF + n * 16); *(f32x4*)(out + off + bj * HALF + n * 16) = bs + gv[bj][n] * acc[ai][bj][m][n]; } }
    }
};
struct EpiSwiglu {
    static constexpr bool PERM = true, AFTER_DRAIN = false;
    bf16_t* O;
    __device__ __forceinline__ void operator()(const f32x4 (&acc)[2][2][4][2], const Unit& u, int wr, int wc, int fr, int fq) const {
        const int row0 = u.pm * BM + wr * 64 + fr, col0 = u.pn * 128 + wc * 16 + 4 * fq;
        typedef unsigned u32x2 __attribute__((ext_vector_type(2)));
#pragma unroll
        for (int ai = 0; ai < 2; ++ai)
#pragma unroll
            for (int m = 0; m < 4; ++m) { bf16_t* rowp = O + (size_t)(row0 + ai * HALF + m * 16) * 1024 + col0;
#pragma unroll
                for (int bj = 0; bj < 2; ++bj) { const f32x4 g = acc[ai][bj][m][0], up = acc[ai][bj][m][1]; float r[4];
#pragma unroll
                    for (int j = 0; j < 4; ++j) { const float e = __builtin_amdgcn_exp2f(-1.4426950408889634f * g[j]); r[j] = g[j] * __builtin_amdgcn_rcpf(1.f + e) * up[j]; }
                    u32x2 w; w.x = cvt_pk_bf16(r[0], r[1]); w.y = cvt_pk_bf16(r[2], r[3]); *(u32x2*)(rowp + bj * 64) = w; } }
    }
};
struct EpiDown {
    static constexpr bool PERM = true, AFTER_DRAIN = false;
    bf16_t* Y; const int* rowtok; const float* roww;
    __device__ __forceinline__ void operator()(const f32x4 (&acc)[2][2][4][2], const Unit& u, int wr, int wc, int fr, int fq) const {
        const int row0 = u.pm * BM + wr * 64 + fr, col0 = u.pn * BM + wc * 32 + 8 * fq;
#pragma unroll
        for (int ai = 0; ai < 2; ++ai)
#pragma unroll
            for (int m = 0; m < 4; ++m) { const int pos = row0 + ai * HALF + m * 16; const int tk = rowtok[pos]; const float w8 = roww[pos];
                if (tk >= 0) { bf16_t* rowp = Y + (size_t)tk * 2048 + col0;
#pragma unroll
                    for (int bj = 0; bj < 2; ++bj) { const f32x4 v0 = acc[ai][bj][m][0] * w8, v1 = acc[ai][bj][m][1] * w8;
                        u32x4 w; w.x = cvt_pk_bf16(v0[0], v0[1]); w.y = cvt_pk_bf16(v0[2], v0[3]); w.z = cvt_pk_bf16(v1[0], v1[1]); w.w = cvt_pk_bf16(v1[2], v1[3]);
                        *(u32x4*)(rowp + bj * HALF) = w; } } }
    }
};

template <class Epi, class Sched, bool ALIGN_EPI = false, bool SP2 = false>
__device__ __forceinline__ void gemm_phase(PG8_LAS unsigned char* lds, const int K, const Sched& S, const Epi& E) {
    int tid = threadIdx.x; asm volatile("" : "+v"(tid)); const int wid = __builtin_amdgcn_readfirstlane(tid >> 6), lane = tid & 63, wr = wid >> 2, wc = wid & 3, fr = lane & 15, fq = lane >> 4;
    const int nt = K / BK;
    unsigned voffA[2], voffB[2];
#pragma unroll
    for (int i = 0; i < 2; ++i) { int R, C; stage_rc(tid * 16 + i * 8192, R, C); const int Rb = Epi::PERM ? ((R & ~31) + perm32(R & 31)) : R;
        voffA[i] = (unsigned)(R * K + C) * 2u; voffB[i] = (unsigned)(Rb * K + C) * 2u; }
    const size_t kstep = (size_t)(BK * 2);
    const size_t hstep = (size_t)HALF * K * 2;
    const unsigned ldsw = (unsigned)wid * 1024u;
    const int aoff = lds_byte(wr * 64 + fr, fq * 8), boff = lds_byte(wc * 32 + fr, fq * 8);
#define PG8_SA(b, h) (((b) * 2 + (h)) * HTB)
#define PG8_SB(b, h) ((4 + (b) * 2 + (h)) * HTB)
#define PG8_STAGE(bufoff, gbase, voff) do { _Pragma("unroll") for (int _i = 0; _i < 2; ++_i) \
        __builtin_amdgcn_global_load_lds((const unsigned*)((const char*)(gbase) + (voff)[_i]), (PG8_LAS unsigned*)(lds + (bufoff) + ldsw + _i * 8192), 16, 0, 0); } while (0)
#define PG8_LDA(dst, b, h) do { _Pragma("unroll") for (int m = 0; m < 4; ++m) _Pragma("unroll") for (int k = 0; k < 2; ++k) dst[m][k] = *(const PG8_LAS bf16x8*)(lds + PG8_SA(b, h) + aoff + m * 2048 + k * 1024); } while (0)
#define PG8_LDB(dst, b, h) do { _Pragma("unroll") for (int n = 0; n < 2; ++n) _Pragma("unroll") for (int k = 0; k < 2; ++k) dst[n][k] = *(const PG8_LAS bf16x8*)(lds + PG8_SB(b, h) + boff + n * 2048 + k * 1024); } while (0)
#define PG8_MMA(ai, bj, At, Bt) do { __builtin_amdgcn_s_setprio(1); _Pragma("unroll") for (int m = 0; m < 4; ++m) _Pragma("unroll") for (int n = 0; n < 2; ++n) _Pragma("unroll") for (int k = 0; k < 2; ++k) \
        acc[ai][bj][m][n] = __builtin_amdgcn_mfma_f32_16x16x32_bf16(Bt[n][k], At[m][k], acc[ai][bj][m][n], 0, 0, 0); __builtin_amdgcn_s_setprio(0); } while (0)
#define PG8_WAIT_V(n) asm volatile("s_waitcnt vmcnt(" #n ")" ::: "memory")
#define PG8_WAIT_L(n) asm volatile("s_waitcnt lgkmcnt(" #n ")" ::: "memory")
#define PG8_BAR __builtin_amdgcn_s_barrier()
#define PG8_SCHED __builtin_amdgcn_sched_barrier(0)
    Unit cur, nxt; int ui = 0;
    if (!S.next(0, cur)) return;
    f32x4 acc[2][2][4][2];
#pragma unroll
    for (int a = 0; a < 2; ++a)
#pragma unroll
        for (int b = 0; b < 2; ++b)
#pragma unroll
            for (int m = 0; m < 4; ++m)
#pragma unroll
                for (int n = 0; n < 2; ++n) acc[a][b][m][n] = (f32x4){0.f, 0.f, 0.f, 0.f};
    bf16x8 At[4][2], B0[2][2], B1[2][2];
    const char* cA = S.a_ptr(cur); const char* cB = S.b_ptr(cur);
    S.a_ready(cur);
    if constexpr (SP2) {
        PG8_STAGE(PG8_SB(0, 0), cB, voffB); PG8_STAGE(PG8_SB(0, 1), cB + hstep, voffB); PG8_STAGE(PG8_SA(0, 0), cA, voffA); PG8_STAGE(PG8_SA(0, 1), cA + hstep, voffA);
        if (wr == 1) PG8_BAR;
        PG8_WAIT_V(2); PG8_BAR;
        PG8_STAGE(PG8_SB(1, 0), cB + kstep, voffB); PG8_STAGE(PG8_SA(1, 0), cA + kstep, voffA); PG8_STAGE(PG8_SB(1, 1), cB + hstep + kstep, voffB);
        PG8_WAIT_V(6); PG8_BAR;
    } else {
        PG8_STAGE(PG8_SB(0, 0), cB, voffB); PG8_STAGE(PG8_SA(0, 0), cA, voffA); PG8_STAGE(PG8_SB(0, 1), cB + hstep, voffB); PG8_STAGE(PG8_SA(0, 1), cA + hstep, voffA);
        if (wr == 1) PG8_BAR;
        PG8_WAIT_V(4); PG8_BAR;
        PG8_STAGE(PG8_SB(1, 0), cB + kstep, voffB); PG8_STAGE(PG8_SA(1, 0), cA + kstep, voffA); PG8_STAGE(PG8_SB(1, 1), cB + hstep + kstep, voffB);
        PG8_WAIT_V(6); PG8_BAR;
    }
    for (;;) {
        const bool has_next = S.next(ui + 1, nxt);
        const char* nA = has_next ? S.a_ptr(nxt) : cA; const char* nB = has_next ? S.b_ptr(nxt) : cB;
        for (int t = 0; t < nt; t += 2) {
            const bool last = (t == nt - 2);
            const char* a1 = cA + (size_t)(t + 1) * kstep;
            const char* a2 = last ? nA : cA + (size_t)(t + 2) * kstep; const char* b2 = last ? nB : cB + (size_t)(t + 2) * kstep;
            const char* a3 = a2 + kstep; const char* b3 = b2 + kstep;
            if (last && has_next) S.a_ready(nxt);
            if constexpr (SP2) {
            PG8_LDB(B0, 0, 0); PG8_LDB(B1, 0, 1); PG8_SCHED; PG8_LDA(At, 0, 0); PG8_STAGE(PG8_SA(1, 1), a1 + hstep, voffA);
            PG8_WAIT_V(8); PG8_WAIT_L(0); PG8_BAR; PG8_MMA(0, 0, At, B0); PG8_MMA(0, 1, At, B1); PG8_BAR; PG8_SCHED;
            PG8_LDA(At, 0, 1); PG8_STAGE(PG8_SB(0, 0), b2, voffB); PG8_STAGE(PG8_SB(0, 1), b2 + hstep, voffB); PG8_STAGE(PG8_SA(0, 0), a2, voffA);
            PG8_WAIT_V(8); PG8_WAIT_L(0); PG8_BAR; PG8_MMA(1, 0, At, B0); PG8_MMA(1, 1, At, B1); PG8_BAR; PG8_SCHED;
            PG8_LDB(B0, 1, 0); PG8_LDB(B1, 1, 1); PG8_SCHED; PG8_LDA(At, 1, 0); PG8_STAGE(PG8_SA(0, 1), a2 + hstep, voffA);
            PG8_WAIT_V(8); PG8_WAIT_L(0); PG8_BAR; PG8_MMA(0, 0, At, B0); PG8_MMA(0, 1, At, B1); PG8_BAR; PG8_SCHED;
            PG8_LDA(At, 1, 1); PG8_STAGE(PG8_SB(1, 0), b3, voffB); PG8_STAGE(PG8_SB(1, 1), b3 + hstep, voffB); PG8_STAGE(PG8_SA(1, 0), a3, voffA);
            PG8_WAIT_V(8); PG8_WAIT_L(0); PG8_BAR; PG8_MMA(1, 0, At, B0); PG8_MMA(1, 1, At, B1); PG8_BAR; PG8_SCHED;
            } else {
            PG8_LDB(B0, 0, 0); PG8_SCHED; PG8_LDA(At, 0, 0); PG8_STAGE(PG8_SA(1, 1), a1 + hstep, voffA);
            PG8_WAIT_L(8); PG8_BAR; PG8_WAIT_L(0); PG8_MMA(0, 0, At, B0); PG8_BAR; PG8_SCHED;
            PG8_LDB(B1, 0, 1); PG8_STAGE(PG8_SB(0, 0), b2, voffB);
            PG8_BAR; PG8_WAIT_L(0); PG8_MMA(0, 1, At, B1); PG8_BAR;
            PG8_LDA(At, 0, 1); PG8_STAGE(PG8_SA(0, 0), a2, voffA);
            PG8_BAR; PG8_WAIT_L(0); PG8_MMA(1, 0, At, B0); PG8_BAR; PG8_SCHED;
            PG8_STAGE(PG8_SB(0, 1), b2 + hstep, voffB);
            PG8_WAIT_V(6); PG8_BAR; PG8_MMA(1, 1, At, B1); PG8_BAR;
            PG8_LDB(B0, 1, 0); PG8_SCHED; PG8_LDA(At, 1, 0); PG8_STAGE(PG8_SA(0, 1), a2 + hstep, voffA);
            PG8_WAIT_L(8); PG8_BAR; PG8_WAIT_L(0); PG8_MMA(0, 0, At, B0); PG8_BAR; PG8_SCHED;
            PG8_LDB(B1, 1, 1); PG8_STAGE(PG8_SB(1, 0), b3, voffB);
            PG8_BAR; PG8_WAIT_L(0); PG8_MMA(0, 1, At, B1); PG8_BAR;
            PG8_LDA(At, 1, 1); PG8_STAGE(PG8_SA(1, 0), a3, voffA);
            PG8_BAR; PG8_WAIT_L(0); PG8_MMA(1, 0, At, B0); PG8_BAR; PG8_SCHED;
            PG8_STAGE(PG8_SB(1, 1), b3 + hstep, voffB);
            PG8_WAIT_V(6); PG8_BAR; PG8_MMA(1, 1, At, B1); PG8_BAR;
            }
        }
        if constexpr (ALIGN_EPI) { if (wr == 0) PG8_BAR; }
        if constexpr (!Epi::AFTER_DRAIN) { E(acc, cur, wr, wc, fr, fq); S.done(cur); }
        if (!has_next) break;
#pragma unroll
        for (int a = 0; a < 2; ++a)
#pragma unroll
            for (int b = 0; b < 2; ++b)
#pragma unroll
                for (int m = 0; m < 4; ++m)
#pragma unroll
                    for (int n = 0; n < 2; ++n) acc[a][b][m][n] = (f32x4){0.f, 0.f, 0.f, 0.f};
        cur = nxt; cA = nA; cB = nB; ++ui;
        if constexpr (ALIGN_EPI) { if (wr == 1) PG8_BAR; }
    }
    PG8_WAIT_V(0);
    if constexpr (!ALIGN_EPI) { if (wr == 0) PG8_BAR; }
    PG8_BAR;
    if constexpr (Epi::AFTER_DRAIN) { E.fused(acc, cur, wr, wc, fr, fq, lds, wid, lane); S.done(cur); }
#undef PG8_SA
#undef PG8_SB
#undef PG8_STAGE
#undef PG8_LDA
#undef PG8_LDB
#undef PG8_MMA
#undef PG8_WAIT_V
#undef PG8_WAIT_L
#undef PG8_BAR
#undef PG8_SCHED
}
}

#include <hip/hip_bf16.h>
#include <cmath>
namespace attn_body {
using bf16=__hip_bfloat16;
using bf16x8=__attribute__((ext_vector_type(8)))short;
using s16x4=__attribute__((ext_vector_type(4)))short;
using f32x16=__attribute__((ext_vector_type(16)))float;
using u32x4=__attribute__((ext_vector_type(4)))unsigned;
constexpr int SEQ=16384,D=64,DM=6144;
constexpr int NW=8,QBLK=32,QB=QBLK*NW,KVBLK=64,NQB=SEQ/QB;
constexpr int ATTN_UNIT_ROWS=QB;
__device__ __forceinline__ int crow(int r,int hi){return (r&3)+8*(r>>2)+4*hi;}
#define SBAR() __builtin_amdgcn_sched_barrier(0)
__device__ __forceinline__ void cmask(f32x16&p0,f32x16&p1,int jb,int qrel,int hi){
  const float NEG=-INFINITY; int kb=64*jb+4*hi;
  #pragma unroll
  for(int r=0;r<16;++r){int kv=kb+(r&3)+8*(r>>2); if(kv>qrel)p0[r]=NEG; if(kv+32>qrel)p1[r]=NEG;}
}

constexpr int NSLOT=3, SLOTB=8192;
constexpr int LDS_K=0, LDS_V=NSLOT*SLOTB, LDS_WS=2*NSLOT*SLOTB, LDS_OST=LDS_WS+NW*64*4, LDS_BYTES=LDS_OST+NW*4096;
constexpr float C2=0.125f*1.4426950408889634f;
__device__ __forceinline__ void glds16(const void*gsrc,unsigned lds_dst){unsigned keep;
  asm volatile("s_mov_b32 %0, m0\n\ts_mov_b32 m0, %2\n\ts_nop 0\n\tglobal_load_lds_dwordx4 %1, off\n\ts_mov_b32 m0, %0":"=&s"(keep):"v"(gsrc),"s"(lds_dst):"memory");}
__device__ __forceinline__ float max3f(float a,float b,float c){float r;asm("v_max3_f32 %0, %1, %2, %3":"=v"(r):"v"(a),"v"(b),"v"(c));return r;}
__device__ __forceinline__ float max2f(float a,float b){float r;asm("v_max_f32_e32 %0, %1, %2":"=v"(r):"v"(a),"v"(b));return r;}
__device__ __forceinline__ float fadd_s(float a,float b){float r;asm("v_add_f32_e32 %0, %1, %2":"=v"(r):"v"(a),"v"(b));return r;}
__device__ __forceinline__ float fsub_s(float a,float b){float r;asm("v_sub_f32_e32 %0, %1, %2":"=v"(r):"v"(a),"v"(b));return r;}
typedef float f32x2_t __attribute__((ext_vector_type(2))); typedef __bf16 bf16x2_t __attribute__((ext_vector_type(2)));
__device__ __forceinline__ unsigned cvtpk_s(float lo,float hi){f32x2_t v={lo,hi};bf16x2_t b=__builtin_convertvector(v,bf16x2_t);return __builtin_bit_cast(unsigned,b);}
#define WAIT_BAR(N) asm volatile("s_waitcnt vmcnt(" #N ") lgkmcnt(0)\n\ts_barrier":::"memory")

__device__ __forceinline__ void rmask(f32x16&p0,f32x16&p1,bool keep){
  const float NEG=-INFINITY;
  #pragma unroll
  for(int r=0;r<16;++r){ p0[r]=keep?p0[r]:NEG; p1[r]=keep?p1[r]:NEG; }
}
__device__ __forceinline__ float abias(int d){
  const int t1=1+((128-d)>>31);
  const int t4=(((d&3)-1)>>31)&(1+((512-d)>>31));
  const int t16=(((d&15)-1)>>31)&(1+((2048-d)>>31));
  const int m=(t1+t4+t16)&~(d>>31);
  return __builtin_amdgcn_logf((float)m);
}
__device__ __forceinline__ void amask(f32x16&p0,f32x16&p1,int dbase){
  #pragma unroll
  for(int r=0;r<16;++r){ int d=dbase-((r&3)+8*(r>>2)); asm volatile("":"+v"(d)); p0[r]+=abias(d); int d2=d-32; asm volatile("":"+v"(d2)); p1[r]+=abias(d2); }
}
__device__ __forceinline__ void qkt(f32x16&p0,f32x16&p1,const char*Kslot,const bf16x8*qr,const f32x16&negm,int r32,int hi){
  const char*kb=Kslot+hi*1024+r32*16;
  #pragma unroll
  for(int d0=0;d0<4;++d0){
    const bf16x8 b0=*reinterpret_cast<const bf16x8*>(kb+d0*2048);
    const bf16x8 b1=*reinterpret_cast<const bf16x8*>(kb+d0*2048+512);
    if(d0==0){p0=__builtin_amdgcn_mfma_f32_32x32x16_bf16(b0,qr[0],negm,0,0,0);p1=__builtin_amdgcn_mfma_f32_32x32x16_bf16(b1,qr[0],negm,0,0,0);}
    else{p0=__builtin_amdgcn_mfma_f32_32x32x16_bf16(b0,qr[d0],p0,0,0,0);p1=__builtin_amdgcn_mfma_f32_32x32x16_bf16(b1,qr[d0],p1,0,0,0);}}
}
typedef __attribute__((address_space(3))) const char* lds_cptr;
typedef short v4i16_t __attribute__((ext_vector_type(4)));
__device__ __forceinline__ void kload8(bf16x8*kf,lds_cptr kp){
  kf[0]=*(const __attribute__((address_space(3))) bf16x8*)(kp);      kf[1]=*(const __attribute__((address_space(3))) bf16x8*)(kp+512);
  kf[2]=*(const __attribute__((address_space(3))) bf16x8*)(kp+2048); kf[3]=*(const __attribute__((address_space(3))) bf16x8*)(kp+2560);
  kf[4]=*(const __attribute__((address_space(3))) bf16x8*)(kp+4096); kf[5]=*(const __attribute__((address_space(3))) bf16x8*)(kp+4608);
  kf[6]=*(const __attribute__((address_space(3))) bf16x8*)(kp+6144); kf[7]=*(const __attribute__((address_space(3))) bf16x8*)(kp+6656);
}
__device__ __forceinline__ void kload2(bf16x8*kf,lds_cptr kp,int j){ kf[2*j]=*(const __attribute__((address_space(3))) bf16x8*)(kp+j*2048); kf[2*j+1]=*(const __attribute__((address_space(3))) bf16x8*)(kp+j*2048+512); }
__device__ __forceinline__ s16x4 vtr(lds_cptr p){ return __builtin_bit_cast(s16x4,__builtin_amdgcn_ds_read_tr16_b64_v4i16((__attribute__((address_space(3))) v4i16_t*)p)); }
__device__ __forceinline__ float rowmax(const f32x16&p0,const f32x16&p1){
  float a=max3f(p0[0],p0[1],p1[0]),b=max3f(p0[2],p0[3],p1[1]);a=max3f(a,p1[2],p1[3]);
  #pragma unroll
  for(int r=4;r<16;r+=4){a=max3f(a,p0[r],p0[r+1]);b=max3f(b,p0[r+2],p0[r+3]);a=max3f(a,p1[r],p1[r+1]);b=max3f(b,p1[r+2],p1[r+3]);}
  const float m=max2f(a,b);
  auto rr=__builtin_amdgcn_permlane32_swap(__float_as_uint(m),__float_as_uint(m),false,false);
  return max2f(__uint_as_float(rr[0]),__uint_as_float(rr[1]));
}
__device__ __forceinline__ void pv(f32x16*o,int vb,bf16x8 pa0,bf16x8 pa1,bf16x8 pa2,bf16x8 pa3){
  #pragma unroll
  for(int d0=0;d0<2;++d0){s16x4 lo[4],hi[4];
    #pragma unroll
    for(int ks=0;ks<4;++ks){
      asm volatile("ds_read_b64_tr_b16 %0,%1 offset:%c2":"=&v"(lo[ks]):"v"(vb),"i"(d0*4096+ks*1024):"memory");
      asm volatile("ds_read_b64_tr_b16 %0,%1 offset:%c2":"=&v"(hi[ks]):"v"(vb),"i"(d0*4096+ks*1024+512):"memory");}
    asm volatile("s_waitcnt lgkmcnt(0)":::"memory");SBAR();
    #define PK(k) (bf16x8){lo[k][0],lo[k][1],lo[k][2],lo[k][3],hi[k][0],hi[k][1],hi[k][2],hi[k][3]}
    o[d0]=__builtin_amdgcn_mfma_f32_32x32x16_bf16(pa0,PK(0),o[d0],0,0,0);
    o[d0]=__builtin_amdgcn_mfma_f32_32x32x16_bf16(pa1,PK(1),o[d0],0,0,0);
    o[d0]=__builtin_amdgcn_mfma_f32_32x32x16_bf16(pa2,PK(2),o[d0],0,0,0);
    o[d0]=__builtin_amdgcn_mfma_f32_32x32x16_bf16(pa3,PK(3),o[d0],0,0,0);
    #undef PK
  }
}

#ifndef ATTN_STORE16
#define ATTN_STORE16(p,v) (*(u32x4*)(p)=(v))
#endif
template<int THRL,int MODE> __device__ __forceinline__ void attn_unit(int qb,int T0,const bf16*Q,const bf16*__restrict__ K,const bf16*__restrict__ V,void*Ov,int opitch,const unsigned long long*sel,char*shm){
  int tid=threadIdx.x; asm volatile("":"+v"(tid)); const int lane=tid&63,r32=lane&31,hi=lane>>5; const int wid=__builtin_amdgcn_readfirstlane(tid>>6);
  const int q0=qb*QB;
  const bf16*Qw=Q+(long)(q0+wid*QBLK)*DM;
  const bf16*Kh=K+(long)T0*KVBLK*DM,*Vh=V+(long)T0*KVBLK*DM;
  const unsigned lds0=(unsigned)(uintptr_t)shm;
  float*wsf=(float*)(shm+LDS_WS)+wid*64;
  const bf16*ksrc=Kh+(long)lane*DM+wid*8;
  const bf16*vsrc=Vh+(long)(16*(wid&3)+(lane>>2))*DM+(wid>>2)*32+(lane&3)*8;
  const unsigned kdst=lds0+LDS_K+wid*1024, vdst=lds0+LDS_V+wid*1024;
  #define DMA_K(t,slot) glds16(ksrc+(long)(t)*KVBLK*DM,(unsigned)__builtin_amdgcn_readfirstlane(kdst+(slot)))
  #define DMA_V(t,slot) glds16(vsrc+(long)(t)*KVBLK*DM,(unsigned)__builtin_amdgcn_readfirstlane(vdst+(slot)))
  const int vb0=(int)(lds0+LDS_V)+((lane>>4)&1)*32+(lane&3)*8+(4*hi+((lane&15)>>2))*64;
  const char*Kbase=shm+LDS_K; bf16x8 kf[8];
  const lds_cptr shm3=(lds_cptr)shm; const lds_cptr kp0=shm3+LDS_K+hi*1024+r32*16; const lds_cptr vp0=shm3+LDS_V+((lane>>4)&1)*32+(lane&3)*8+(4*hi+((lane&15)>>2))*64;
  const int NT=(q0+QB)/KVBLK-T0;
  DMA_K(0,0);DMA_V(0,0);DMA_K(1,SLOTB);
  bf16x8 qr[4];
  #pragma unroll
  for(int d0=0;d0<4;++d0)qr[d0]=*reinterpret_cast<const bf16x8*>(&Qw[(long)r32*DM+d0*16+hi*8]);
  float mhat=0.f,l_reg=0.f;f32x16 o[2];o[0]=f32x16{};o[1]=f32x16{};f32x16 negm=f32x16{};asm volatile("":"+v"(negm));
  const int qrel=wid*QBLK+r32;
  unsigned sel_lo=0u,sel_hi=0u; if(MODE==1){ const unsigned long long sv=sel[qrel]; sel_lo=(unsigned)sv; sel_hi=(unsigned)(sv>>32); }
  const int dq=q0+qrel-4*hi-T0*KVBLK;
  #define RKEEP(t) ((((t)>>2)<32?(sel_lo>>((t)>>2)):(sel_hi>>(((t)>>2)-32)))&1u)
  #define CMASK(P0,P1,t) do{ if(MODE==2){amask(P0,P1,dq-64*(t));} else {int jb_=(t)-(NT-4); if(jb_>=0)cmask(P0,P1,jb_,qrel,hi); else if(MODE==1)rmask(P0,P1,RKEEP(t)!=0u);} }while(0)
  bool resc=false;
  #define START(P0,P1) do{ const float rm=rowmax(P0,P1); resc=false; \
    { const float dl=(MODE==0)?rm:((rm>-3.0e38f)?rm:0.f); mhat=fadd_s(mhat,dl); \
      _Pragma("unroll") for(int r=0;r<16;++r){P0[r]=fsub_s(P0[r],dl);P1[r]=fsub_s(P1[r],dl);} \
      _Pragma("unroll") for(int r=0;r<16;++r)negm[r]=-mhat; asm volatile("":"+v"(negm)); } \
    _Pragma("unroll") for(int r=0;r<16;++r)P0[r]=__builtin_amdgcn_exp2f(P0[r]); }while(0)
  #define RESC() do{ if(resc){ asm volatile("s_waitcnt lgkmcnt(0)":::"memory"); \
      _Pragma("unroll") for(int d_=0;d_<2;++d_) _Pragma("unroll") for(int r=0;r<16;++r)o[d_][r]*=wsf[crow(r,hi)]; } }while(0)
  f32x16 pA0,pA1,pB0,pB1;
  int sl_prev=0,sl_cur=0,sl_next=SLOTB;
  #define ROT() do{sl_prev=sl_cur;sl_cur=sl_next;sl_next=(sl_next==(NSLOT-1)*SLOTB)?0:sl_next+SLOTB;}while(0)
  DMA_K(2,2*SLOTB);
  WAIT_BAR(3);
  qkt(pA0,pA1,Kbase,qr,negm,r32,hi);asm volatile("s_nop 15\n\ts_nop 7":"+v"(pA0),"+v"(pA1));CMASK(pA0,pA1,0);
  START(pA0,pA1);
  _Pragma("unroll") for(int r=0;r<16;++r)pA1[r]=__builtin_amdgcn_exp2f(pA1[r]);
  WAIT_BAR(0);
  DMA_K(3,0);DMA_V(1,SLOTB);
  ROT();
  kload8(kf,kp0+sl_cur);
  WAIT_BAR(2);
  s16x4 vlo[8],vhi[8]; u32x4 pw0,pw1,pw2,pw3;
  #define PKW(P,B) cvtpk_s(P[B],P[B+1])
  #define PAF(k) __builtin_bit_cast(bf16x8,pw##k)
  #define VFR(i) (bf16x8){vlo[i][0],vlo[i][1],vlo[i][2],vlo[i][3],vhi[i][0],vhi[i][1],vhi[i][2],vhi[i][3]}
  #define PIN(x) asm volatile("":"+v"(x))
  #define MX3(a,b,c) __builtin_fmaxf(__builtin_fmaxf((a),(b)),(c))
  #define GAPA(MF,A0,A1,A2,A3,W0,W1,PW) do{ MF; sacc+=A0; sacc+=A1; sacc+=A2; sacc+=A3; PIN(sacc); W0; W1; PIN(PW); SBAR(); }while(0)
  #define EX(v) __builtin_amdgcn_exp2f(v)
  #define GAPB(MF,X,B) do{ MF; X[B]=EX(X[B]); X[B+1]=EX(X[B+1]); X[B+2]=EX(X[B+2]); X[B+3]=EX(X[B+3]); PIN(X); SBAR(); }while(0)
  #define VRD(i) do{ vlo[i]=vtr(vp_+(((i)>>2)*4096+((i)&3)*1024)); vhi[i]=vtr(vp_+(((i)>>2)*4096+((i)&3)*1024+512)); }while(0)
  #define KRD(G,j) do{ if(G){ kload2(kf,kp0+sl_next,j); SBAR(); } }while(0)
  #define STEP(C0,C1,P0,P1,t,GK,GV,GL) do{ SBAR(); \
    const lds_cptr vp_=vp0+sl_prev; \
    VRD(0); SBAR(); float sacc=(P0[0]+P0[1]); \
    GAPA(C0=__builtin_amdgcn_mfma_f32_32x32x16_bf16(kf[0],qr[0],negm,0,0,0), P0[2],P0[3],P0[4],P0[5],     pw0[0]=PKW(P0,0), pw0[1]=PKW(P0,2), pw0); \
    VRD(4); SBAR(); GAPA(C1=__builtin_amdgcn_mfma_f32_32x32x16_bf16(kf[1],qr[0],negm,0,0,0), P0[6],P0[7],P0[8],P0[9],     pw0[2]=PKW(P0,4), pw0[3]=PKW(P0,6), pw0); \
    VRD(1); SBAR(); GAPA(C0=__builtin_amdgcn_mfma_f32_32x32x16_bf16(kf[2],qr[1],C0,0,0,0),   P0[10],P0[11],P0[12],P0[13], pw1[0]=PKW(P0,8), pw1[1]=PKW(P0,10), pw1); \
    VRD(5); SBAR(); GAPA(C1=__builtin_amdgcn_mfma_f32_32x32x16_bf16(kf[3],qr[1],C1,0,0,0),   P0[14],P0[15],P1[0],P1[1],   pw1[2]=PKW(P0,12),pw1[3]=PKW(P0,14), pw1); \
    VRD(2); SBAR(); GAPA(C0=__builtin_amdgcn_mfma_f32_32x32x16_bf16(kf[4],qr[2],C0,0,0,0),   P1[2],P1[3],P1[4],P1[5],     pw2[0]=PKW(P1,0), pw2[1]=PKW(P1,2), pw2); \
    VRD(6); SBAR(); GAPA(C1=__builtin_amdgcn_mfma_f32_32x32x16_bf16(kf[5],qr[2],C1,0,0,0),   P1[6],P1[7],P1[8],P1[9],     pw2[2]=PKW(P1,4), pw2[3]=PKW(P1,6), pw2); \
    VRD(3); SBAR(); GAPA(C0=__builtin_amdgcn_mfma_f32_32x32x16_bf16(kf[6],qr[3],C0,0,0,0),   P1[10],P1[11],P1[12],P1[13], pw3[0]=PKW(P1,8), pw3[1]=PKW(P1,10), pw3); \
    VRD(7); SBAR(); GAPA(C1=__builtin_amdgcn_mfma_f32_32x32x16_bf16(kf[7],qr[3],C1,0,0,0),   P1[14],P1[15],0.f,0.f,       pw3[2]=PKW(P1,12),pw3[3]=PKW(P1,14), pw3); \
    l_reg+=sacc; \
    if(GK){DMA_K((t)+3,sl_cur);} if(GV){DMA_V((t)+1,sl_next);} \
    CMASK(C0,C1,t); \
    { float a=MX3(C0[0],C0[1],C1[0]),b=MX3(C0[2],C0[3],C1[1]); a=MX3(a,C1[2],C1[3]); \
      _Pragma("unroll") for(int r=4;r<16;r+=4){a=MX3(a,C0[r],C0[r+1]);b=MX3(b,C0[r+2],C0[r+3]);a=MX3(a,C1[r],C1[r+1]);b=MX3(b,C1[r+2],C1[r+3]);} \
      float rm=__builtin_fmaxf(a,b); { auto rr=__builtin_amdgcn_permlane32_swap(__float_as_uint(rm),__float_as_uint(rm),false,false); rm=__builtin_fmaxf(__uint_as_float(rr[0]),__uint_as_float(rr[1])); } \
      resc=false; \
      if(__builtin_expect(__any(rm>(float)THRL),0)){ const float dl=__builtin_fmaxf(rm,0.f); mhat+=dl; \
        _Pragma("unroll") for(int r=0;r<16;++r){C0[r]-=dl;C1[r]-=dl;} \
        _Pragma("unroll") for(int r=0;r<16;++r)negm[r]=-mhat; asm volatile("":"+v"(negm)); \
        const float f=__builtin_amdgcn_exp2f(-dl); l_reg*=f; if(hi==0)wsf[r32]=f; resc=true; } } \
    SBAR(); \
    GAPB(o[0]=__builtin_amdgcn_mfma_f32_32x32x16_bf16(PAF(0),VFR(0),o[0],0,0,0), C0,0); \
    GAPB(o[1]=__builtin_amdgcn_mfma_f32_32x32x16_bf16(PAF(0),VFR(4),o[1],0,0,0), C0,4); \
    KRD(GL,0); GAPB(o[0]=__builtin_amdgcn_mfma_f32_32x32x16_bf16(PAF(1),VFR(1),o[0],0,0,0), C0,8); \
    KRD(GL,1); GAPB(o[1]=__builtin_amdgcn_mfma_f32_32x32x16_bf16(PAF(1),VFR(5),o[1],0,0,0), C0,12); \
    KRD(GL,2); GAPB(o[0]=__builtin_amdgcn_mfma_f32_32x32x16_bf16(PAF(2),VFR(2),o[0],0,0,0), C1,0); \
    KRD(GL,3); GAPB(o[1]=__builtin_amdgcn_mfma_f32_32x32x16_bf16(PAF(2),VFR(6),o[1],0,0,0), C1,4); \
    GAPB(o[0]=__builtin_amdgcn_mfma_f32_32x32x16_bf16(PAF(3),VFR(3),o[0],0,0,0), C1,8); \
    GAPB(o[1]=__builtin_amdgcn_mfma_f32_32x32x16_bf16(PAF(3),VFR(7),o[1],0,0,0), C1,12); \
    }while(0)
  int t=1;
  #undef CMASK
  #define CMASK(P0,P1,t) do{ if(MODE==2){amask(P0,P1,dq-64*(t));} else if(MODE==1){rmask(P0,P1,RKEEP(t)!=0u);} }while(0)
  for(;t+5<NT;t+=2){
    STEP(pB0,pB1,pA0,pA1,t,true,true,true);     WAIT_BAR(2); RESC(); ROT();
    STEP(pA0,pA1,pB0,pB1,t+1,true,true,true);   WAIT_BAR(2); RESC(); ROT();
  }
  #undef CMASK
  #define CMASK(P0,P1,t) do{ if(MODE==2){amask(P0,P1,dq-64*(t));} else {int jb_=(t)-(NT-4); if(jb_>=0)cmask(P0,P1,jb_,qrel,hi); else if(MODE==1)rmask(P0,P1,RKEEP(t)!=0u);} }while(0)
  #define ENDW(tt) do{ if((tt)+3<NT){WAIT_BAR(2);} else if((tt)+2<NT){WAIT_BAR(1);} else {WAIT_BAR(0);} }while(0)
  for(;t+1<NT;t+=2){
    STEP(pB0,pB1,pA0,pA1,t,(t+3<NT),(t+1<NT),(t+1<NT));       ENDW(t);   RESC(); ROT();
    STEP(pA0,pA1,pB0,pB1,t+1,(t+4<NT),(t+2<NT),(t+2<NT));     ENDW(t+1); RESC(); ROT();
  }
  STEP(pB0,pB1,pA0,pA1,NT-1,false,false,false); RESC();
  { float sacc=pB0[0]+pB0[1]; _Pragma("unroll") for(int r=2;r<16;++r)sacc+=pB0[r]; _Pragma("unroll") for(int r=0;r<16;++r)sacc+=pB1[r]; l_reg+=sacc;
    pw0=(u32x4){PKW(pB0,0),PKW(pB0,2),PKW(pB0,4),PKW(pB0,6)};pw1=(u32x4){PKW(pB0,8),PKW(pB0,10),PKW(pB0,12),PKW(pB0,14)};pw2=(u32x4){PKW(pB1,0),PKW(pB1,2),PKW(pB1,4),PKW(pB1,6)};pw3=(u32x4){PKW(pB1,8),PKW(pB1,10),PKW(pB1,12),PKW(pB1,14)};
    SBAR(); pv(o,vb0+sl_cur,PAF(0),PAF(1),PAF(2),PAF(3)); }
  #undef PKW
  #undef PAF
  #undef VFR
  #undef PIN
  #undef MX3
  #undef GAPA
  #undef GAPB
  #undef EX
  #undef VRD
  #undef KRD
  #undef STEP
  #undef ENDW
  {auto rr=__builtin_amdgcn_permlane32_swap(__float_as_uint(l_reg),__float_as_uint(l_reg),false,false);l_reg=__uint_as_float(rr[0])+__uint_as_float(rr[1]);}
  if(hi==0)wsf[32+r32]=l_reg;asm volatile("s_waitcnt lgkmcnt(0)":::"memory");
  float rli[16];
  #pragma unroll
  for(int r=0;r<16;++r)rli[r]=__builtin_amdgcn_rcpf(wsf[32+crow(r,hi)]);
  if(MODE==0){ float*Of=(float*)Ov+(long)(q0+wid*QBLK)*opitch;
    #pragma unroll
    for(int r=0;r<16;++r){const int orow=crow(r,hi);
      #pragma unroll
      for(int d0=0;d0<2;++d0)Of[(long)orow*opitch+d0*32+r32]=o[d0][r]*rli[r];} }
  else { bf16*Ow=(bf16*)Ov+(long)(q0+wid*QBLK)*opitch; bf16*stg=(bf16*)(shm+LDS_OST)+wid*2048;
    #pragma unroll
    for(int r=0;r<16;++r){const int orow=crow(r,hi);
      #pragma unroll
      for(int d0=0;d0<2;++d0)stg[orow*64+d0*32+r32]=__float2bfloat16(o[d0][r]*rli[r]);}
    asm volatile("s_waitcnt lgkmcnt(0)":::"memory");
    #pragma unroll
    for(int i=0;i<4;++i){const int row=i*8+(lane>>3),ch=lane&7; const u32x4 v=*(const u32x4*)(stg+row*64+ch*8); ATTN_STORE16(Ow+(long)row*opitch+ch*8,v);} }
  asm volatile("s_waitcnt lgkmcnt(0)\n\ts_barrier":::"memory");
  #undef DMA_K
  #undef DMA_V
  #undef CMASK
  #undef RKEEP
  #undef START
  #undef RESC
  #undef ROT
}
constexpr int ATTN_LDS_BYTES=LDS_BYTES;
#undef SBAR
#undef WAIT_BAR
}


constexpr int NWAVES = 8;
#ifndef MK_N_LAUNCHES
#define MK_N_LAUNCHES 22
#endif
constexpr int N_PHASES = 22;
static_assert(MK_N_LAUNCHES == 1 || MK_N_LAUNCHES == N_PHASES, "MK_N_LAUNCHES is 1 or 22");

constexpr int S_ = 16384, DM_ = 2048, INW = 6144, NEXP = 16, DEXP = 1024, DEPTH = 2, NROWBLK = 256  ;
constexpr int C_QA = 0, C_KA = 512, C_VA = 1024, C_QB = 1536, C_KB = 2048, C_VB = 2560, C_QC = 3072, C_KC = 4096, C_VC = 5120;
constexpr int MAXPOS = 2 * S_ + NEXP * 256;
constexpr float RMS_EPS = 1e-6f;

constexpr size_t MiB = 1u << 20;
constexpr size_t WS_CTL = 0, CTL_ZERO_BYTES = 1 * MiB;
constexpr size_t WS_MOD = 1 * MiB;
constexpr size_t WS_COS = 2 * MiB, WS_SIN = 4 * MiB;
constexpr size_t WS_EID = 6 * MiB;
constexpr size_t WS_WTS = WS_EID + 131072;
constexpr size_t WS_ROWTOK = WS_WTS + 131072;
constexpr size_t WS_ROWW = WS_ROWTOK + 163840;
constexpr size_t WS_CNT = WS_ROWW + 163840;
constexpr size_t WS_KMEAN = 8 * MiB;
constexpr size_t WS_WIN = 16 * MiB;
constexpr size_t WS_WOUT = 64 * MiB;
constexpr size_t WS_WGU = 80 * MiB;
constexpr size_t WS_WDN = 336 * MiB;
constexpr size_t WS_H = 464 * MiB;
constexpr size_t WS_PROJ = 528 * MiB;
constexpr size_t WS_MERGED = 720 * MiB;
constexpr size_t WS_T = 784 * MiB;
constexpr size_t WS_ACT = 912 * MiB;
constexpr size_t WS_XS = 984 * MiB;
constexpr size_t WS_Y = WS_PROJ;
constexpr size_t WS_END = 1128 * MiB;
static_assert(WS_XS + (size_t)MAXPOS * 2048 * 2 <= WS_END && WS_ACT + (size_t)MAXPOS * 1024 * 2 <= WS_XS && WS_CNT + 16384 <= WS_KMEAN, "d_ws map");
constexpr int CW_TMO = 0, CW_CODE = 1, CW_BAR = 4096;
constexpr int CW_DBG = 16384;

constexpr int RING_OFF = 0, RING_BYTES = 131072;
constexpr int LDSCTL_OFF = RING_BYTES, MISC_OFF = LDSCTL_OFF + 320;
constexpr int LT_SEGS = LDSCTL_OFF + 1024;
constexpr int LT_TOT = LT_SEGS + 128;
constexpr int LT_BASE = LT_TOT + 64;
constexpr int LT_CNT = LT_BASE + 64;
constexpr int LT_P2E = LT_CNT + 64;
constexpr int LT_POS = LT_P2E + 160;
constexpr int LDS_BYTES = 147456;
constexpr int ATT_SEL_OFF = 98304, ATT_KM_OFF = 100352;
static_assert(LT_POS + 512 <= LDS_BYTES && attn_body::ATTN_LDS_BYTES <= ATT_SEL_OFF && ATT_KM_OFF + 16384 <= RING_BYTES, "LDS map");

#define GAS __attribute__((address_space(1)))
#define LAS __attribute__((address_space(3)))
typedef unsigned short bf16;
typedef unsigned v4u __attribute__((ext_vector_type(4)));
typedef unsigned v2u __attribute__((ext_vector_type(2)));
typedef float f32x4 __attribute__((ext_vector_type(4)));
typedef short bf16x8 __attribute__((ext_vector_type(8)));
typedef GAS unsigned gu32;
#define RLX_AGENT __ATOMIC_RELAXED, __HIP_MEMORY_SCOPE_AGENT
#define LDS_WAIT() asm volatile("s_waitcnt lgkmcnt(0)" ::: "memory")
__device__ __forceinline__ unsigned f2bf(float f) { unsigned u = __builtin_bit_cast(unsigned, f); return (u + 0x7fffu + ((u >> 16) & 1u)) >> 16; }
__device__ __forceinline__ unsigned pk2(float lo, float hi) { return f2bf(lo) | (f2bf(hi) << 16); }
__device__ __forceinline__ float bflo(unsigned w) { return __builtin_bit_cast(float, w << 16); }
__device__ __forceinline__ float bfhi(unsigned w) { return __builtin_bit_cast(float, w & 0xffff0000u); }
__device__ __forceinline__ float wave_sum(float v) {
#pragma unroll
    for (int o = 1; o < 64; o <<= 1) v += __shfl_xor(v, o);
    return v;
}

#define XB_TMO      128
#define XB_XCNT(j)  (256  + 64 * (j))
#define XB_XSUB(j)  (1280 + 64 * (j))
#define XB_XGEN(j)  (2304 + 64 * (j))
#define XB_TOP      3328
#define XB_TOPGEN   3392
#define XCD_BAR_WORDS 3456
#define XB_SPIN_CAP (1u << 18)

__device__ __forceinline__ unsigned xb_ld(unsigned* p)              { return __hip_atomic_load(p, __ATOMIC_RELAXED, __HIP_MEMORY_SCOPE_AGENT); }
__device__ __forceinline__ unsigned xb_add(unsigned* p, unsigned v) { return __hip_atomic_fetch_add(p, v, __ATOMIC_RELAXED, __HIP_MEMORY_SCOPE_AGENT); }
__device__ __forceinline__ unsigned xb_xcc_id() { return (unsigned)__builtin_amdgcn_s_getreg((3 << 11) | 20) & 0xFu; }
#define XB_SPIN(cond, bar) do { unsigned _sp = 0; while (cond) { __builtin_amdgcn_s_sleep(1); \
    if ((++_sp & 255u) == 0u) { if (xb_ld(&(bar)[XB_TMO])) break; if (_sp > XB_SPIN_CAP) { atomicAdd(&(bar)[XB_TMO], 1u); break; } } } } while (0)

struct XcdBarrier {
    unsigned* bar; unsigned x;
    volatile LAS unsigned* st;
};

__device__ __forceinline__ XcdBarrier xcd_barrier_post(unsigned* bar, volatile LAS unsigned* st) {
    XcdBarrier b; b.bar = bar; b.x = xb_xcc_id(); b.st = st;
    if (threadIdx.x == 0) (void)xb_add(&bar[XB_XCNT(b.x)], 1u);
    return b;
}
__device__ __forceinline__ void xcd_barrier_complete(unsigned* bar, unsigned x, unsigned& nloc, unsigned& nx) {
    const unsigned G = gridDim.x * gridDim.y * gridDim.z;
    unsigned sum, cnt, mine, sp = 0u;
    for (;;) {
        sum = 0u; cnt = 0u; mine = 0u;
#pragma unroll
        for (unsigned j = 0; j < 16; ++j) { const unsigned c = xb_ld(&bar[XB_XCNT(j)]); sum += c; cnt += (c > 0u) ? 1u : 0u; mine = (j == x) ? c : mine; }
        if (sum == G) break;
        __builtin_amdgcn_s_sleep(1);
        if ((++sp & 255u) == 0u) { if (xb_ld(&bar[XB_TMO])) break; if (sp > XB_SPIN_CAP) { atomicAdd(&bar[XB_TMO], 1u); break; } }
    }
    nloc = mine > 0u ? mine : 1u; nx = cnt > 0u ? cnt : 1u;
}

__device__ __forceinline__ void xcd_barrier(const XcdBarrier& b) {
    asm volatile("s_waitcnt vmcnt(0)" ::: "memory");
    __syncthreads();
    if (threadIdx.x == 0) {
        unsigned* bar = b.bar; asm volatile("" : "+s"(bar));
        __builtin_amdgcn_s_waitcnt(0);
        unsigned nloc = b.st[0], nx = b.st[1];
        if (nloc == 0u) { xcd_barrier_complete(bar, b.x, nloc, nx); b.st[0] = nloc; b.st[1] = nx; }
        const unsigned old = xb_add(&bar[XB_XSUB(b.x)], 1u);
        const unsigned gen = old / nloc;
        if (old + 1u == (gen + 1u) * nloc) {
            __builtin_amdgcn_fence(__ATOMIC_RELEASE, "agent");
            asm volatile("s_waitcnt vmcnt(0)" ::: "memory");
            const unsigned og = xb_add(&bar[XB_TOP], 1u);
            const unsigned tg = og / nx;
            if (og + 1u == (tg + 1u) * nx) xb_add(&bar[XB_TOPGEN], 1u);
            else XB_SPIN(xb_ld(&bar[XB_TOPGEN]) == tg, bar);
            __builtin_amdgcn_fence(__ATOMIC_ACQUIRE, "agent");
            xb_add(&bar[XB_XGEN(b.x)], 1u);
            asm volatile("s_waitcnt vmcnt(0)" ::: "memory");
        } else {
            XB_SPIN(xb_ld(&bar[XB_XGEN(b.x)]) == gen, bar);
            __builtin_amdgcn_fence(__ATOMIC_ACQUIRE, "agent");
            asm volatile("s_waitcnt vmcnt(0)" ::: "memory");
        }
    }
    __syncthreads();
}


__device__ __forceinline__ int dest_row(int map, int n) {
    if (map == 1) { const int seg = n >> 9; const bool qk = (seg == 0) || (seg == 1) || (seg == 3) || (seg == 4) || (seg >= 6 && seg <= 9); if (!qk) return n; const int j = n & 63; return (n & ~63) + ((j < 32) ? 2 * j : 2 * (j - 32) + 1); }
    if (map == 2) return 8 * (n >> 2) + (n & 3);
    if (map == 3) return 8 * (n >> 2) + 4 + (n & 3);
    return n;
}
__device__ __forceinline__ void p0_transpose_item(const float* W, int K, int N, bf16* WT, int map, LAS float* scr, int item, int lane) {
    const int nblk = N / 32, kb = item / nblk, nb = item % nblk, k0 = 64 * kb, n0 = 32 * nb;
#pragma unroll 8
    for (int i = 0; i < 32; ++i) { const int kk = 2 * i + (lane >> 5); scr[kk * 33 + (lane & 31)] = W[(size_t)(k0 + kk) * N + n0 + (lane & 31)]; }
    LDS_WAIT(); asm volatile("" ::: "memory");
    const int c = lane & 7;
#pragma unroll
    for (int j = 0; j < 4; ++j) { const int n = (lane >> 3) + 8 * j; const LAS float* s = scr + (8 * c) * 33 + n;
        v4u o; o.x = pk2(s[0 * 33], s[1 * 33]); o.y = pk2(s[2 * 33], s[3 * 33]); o.z = pk2(s[4 * 33], s[5 * 33]); o.w = pk2(s[6 * 33], s[7 * 33]);
        *(GAS v4u*)(WT + (size_t)dest_row(map, n0 + n) * K + k0 + 8 * c) = o; }
    LDS_WAIT(); asm volatile("" ::: "memory");
}

struct Args { const void* in[20]; float* out; unsigned char* ws; int ph_lo, ph_hi; };

__global__ void __launch_bounds__(NWAVES * 64, 2) fwd(Args args) {
    extern __shared__ __attribute__((aligned(16))) unsigned char lds[];
    LAS unsigned char* const L = (LAS unsigned char*)lds;
    const int G = gridDim.x, bx = blockIdx.x;
    const int vcu = (G % 8 == 0) ? (bx % 8) * (G / 8) + bx / 8 : bx;
    const int NGW = G * NWAVES;
    typedef __attribute__((address_space(4))) const Args* kargp_t;
#define PHASE_BEGIN() \
    kargp_t ka = (kargp_t)__builtin_amdgcn_kernarg_segment_ptr(); asm volatile("" : "+s"(ka)); \
    unsigned char* const ws = ka->ws; \
    int tid = threadIdx.x; asm volatile("" : "+v"(tid)); \
    const int lane = tid & 63, wave = __builtin_amdgcn_readfirstlane(tid >> 6); const int gw = vcu * NWAVES + wave; (void)gw; (void)lane; (void)ws
#define KIN(T, k) ((const T*)ka->in[k])
    LAS int* const segs = (LAS int*)(L + LT_SEGS); LAS int* const tot = (LAS int*)(L + LT_TOT); LAS int* const basee = (LAS int*)(L + LT_BASE); LAS int* const cnt16 = (LAS int*)(L + LT_CNT);
    LAS unsigned char* const p2e = L + LT_P2E; LAS int* const postab = (LAS int*)(L + LT_POS);
    gu32* const ctl = (gu32*)(args.ws + WS_CTL);

    for (int u = threadIdx.x; u < (LDS_BYTES - LDSCTL_OFF) / 4; u += NWAVES * 64) ((LAS unsigned*)(L + LDSCTL_OFF))[u] = 0u;
    __syncthreads();
    const int lo = args.ph_lo, hi = args.ph_hi;
    XcdBarrier bar; bar.bar = (unsigned*)(ctl + CW_BAR); bar.x = 0; bar.st = nullptr;
    if (hi - lo > 1) bar = xcd_barrier_post((unsigned*)(ctl + CW_BAR), (volatile LAS unsigned*)(L + MISC_OFF) + 8);
#ifndef PHMASK
#define PHMASK 0xfff
#endif
#define IN(k) (lo <= (k) && (k) < hi)
#define INJ(j) ((((PHMASK) >> (j)) & 1) && IN(pb + (j)))
#define SEAM(k) do { if (IN(k) && IN((k) + 1)) xcd_barrier(bar); } while (0)

#define COMPUTE_SEGMENTS(myrb) do { \
        _Pragma("unroll") for (int q_ = 0; q_ < 2; ++q_) { const int e_ = 2 * wave + q_; int t_ = 0, p_ = 0; \
            _Pragma("unroll") for (int j_ = 0; j_ < 4; ++j_) { const int rb_ = lane + 64 * j_; const int c_ = CNT[rb_ * 16 + e_]; t_ += c_; p_ += (rb_ < (myrb)) ? c_ : 0; } \
            t_ = (int)wave_sum((float)t_); p_ = (int)wave_sum((float)p_); if (lane == 0) { tot[e_] = t_; basee[e_] = p_; } } \
        __syncthreads(); \
        if (tid == 0) { int s_ = 0; for (int e_ = 0; e_ < 16; ++e_) { segs[e_] = s_; s_ += (tot[e_] + 255) & ~255; } segs[16] = s_; } \
        __syncthreads(); \
        if (tid < 160) { const int r_ = tid * 256; int e_ = 0; for (int k_ = 1; k_ < 16; ++k_) if (r_ >= segs[k_]) e_ = k_; p2e[tid] = (unsigned char)e_; } \
        if (tid < 16) basee[tid] += segs[tid]; \
        __syncthreads(); } while (0)

    if (((PHMASK >> 10) & 1) && IN(0)) {
        PHASE_BEGIN();
        const float* const c_in = KIN(float, 1); const int* const positions = KIN(int, 2); const float* const w_ada = KIN(float, 3); const float* const b_ada = KIN(float, 4);
        const float* const w_in = KIN(float, 7); const float* const w_out = KIN(float, 8); const float* const w_gate = KIN(float, 14); const float* const w_up = KIN(float, 15); const float* const w_down = KIN(float, 16);
        float* const MOD = (float*)(ws + WS_MOD); float* const COS = (float*)(ws + WS_COS); float* const SIN = (float*)(ws + WS_SIN);
        bf16* const WIN = (bf16*)(ws + WS_WIN); bf16* const WOUT = (bf16*)(ws + WS_WOUT); bf16* const WGU = (bf16*)(ws + WS_WGU); bf16* const WDN = (bf16*)(ws + WS_WDN);
        for (int it = bx; it < 96; it += G) {
            const int l = it / 48, cg = it % 48, col = cg * 256 + lane * 4;
            const float* W = w_ada + ((size_t)l * 2048 + wave * 256) * 12288 + col; const float* cc = c_in + wave * 256;
            f32x4 a = (f32x4){0.f, 0.f, 0.f, 0.f};
#pragma unroll 8
            for (int k = 0; k < 256; ++k) { const float cv = cc[k]; const float sv = cv / (1.f + expf(-cv)); a += sv * *(const GAS f32x4*)(W + (size_t)k * 12288); }
            LAS f32x4* red = (LAS f32x4*)L; red[wave * 64 + lane] = a;
            __syncthreads();
            if (tid < 256) { float s = 0.f; const LAS float* rf = (const LAS float*)L;
#pragma unroll
                for (int w = 0; w < 8; ++w) s += rf[(w * 64 + (tid >> 2)) * 4 + (tid & 3)];
                MOD[l * 12288 + cg * 256 + tid] = s + b_ada[l * 12288 + cg * 256 + tid]; }
            __syncthreads();
        }
        { LAS float* scr = (LAS float*)(L + RING_OFF + wave * 16384);
          constexpr int I_IN = 2 * 32 * 192, I_OUT = 2 * 32 * 64, I_G = 32 * 32 * 32, I_D = 32 * 16 * 64, NITEMS = I_IN + I_OUT + 2 * I_G + I_D;
          for (int it = gw; it < NITEMS; it += NGW) {
              int r = it;
              if (r < I_IN) { const int l = r / 6144; p0_transpose_item(w_in + (size_t)l * 2048 * 6144, 2048, 6144, WIN + (size_t)l * 6144 * 2048, 1, scr, r % 6144, lane); continue; } r -= I_IN;
              if (r < I_OUT) { const int l = r / 2048; p0_transpose_item(w_out + (size_t)l * 2048 * 2048, 2048, 2048, WOUT + (size_t)l * 2048 * 2048, 0, scr, r % 2048, lane); continue; } r -= I_OUT;
              if (r < I_G) { const int mt = r / 1024; p0_transpose_item(w_gate + (size_t)mt * 2048 * 1024, 2048, 1024, WGU + (size_t)mt * 2048 * 2048, 2, scr, r % 1024, lane); continue; } r -= I_G;
              if (r < I_G) { const int mt = r / 1024; p0_transpose_item(w_up + (size_t)mt * 2048 * 1024, 2048, 1024, WGU + (size_t)mt * 2048 * 2048, 3, scr, r % 1024, lane); continue; } r -= I_G;
              { const int mt = r / 1024; p0_transpose_item(w_down + (size_t)mt * 1024 * 2048, 1024, 2048, WDN + (size_t)mt * 2048 * 1024, 0, scr, r % 1024, lane); }
          } }
        for (int idx = (vcu * NWAVES * 64 + tid); idx < S_ * 32; idx += G * NWAVES * 64) {
            const int pi = idx >> 5, i = idx & 31; const float inv = (float)exp2(-(double)i * (13.287712379549449 / 32.0)); const float ang = (float)positions[pi] * inv;
            COS[idx] = (float)cos((double)ang); SIN[idx] = (float)sin((double)ang); }
    }
    SEAM(0);

    for (int l = 0; l < DEPTH; ++l) {
        const int pb = 1 + 10 * l;
        const float lam_init = (l == 0) ? 0.2f : 0.35550906759f;
        if (INJ(0)) {
            PHASE_BEGIN();
            const float* const x_in = KIN(float, 0); const float* const g_attn = KIN(float, 5); float* const xbuf = ka->out;
            const float* const MOD = (const float*)(ws + WS_MOD); const float* const mod = MOD + l * 12288; bf16* const HB = (bf16*)(ws + WS_H); const bf16* const YB = (const bf16*)(ws + WS_Y);
            f32x4 cA[8], cB[8], cG[8];
#pragma unroll
            for (int j = 0; j < 8; ++j) { const int c4 = lane + 64 * j; const f32x4 g = ((const f32x4*)(g_attn + l * 2048))[c4]; const f32x4 sc = ((const f32x4*)(mod + 2048))[c4];
                cA[j] = g * (1.f + sc); cB[j] = ((const f32x4*)(mod + 0))[c4]; cG[j] = (l > 0) ? ((const f32x4*)(MOD + (l - 1) * 12288 + 10240))[c4] : (f32x4){0.f, 0.f, 0.f, 0.f}; }
            const float* xsrc = (l == 0) ? x_in : xbuf;
            for (int row = gw; row < S_; row += NGW) {
                f32x4 v[8];
#pragma unroll
                for (int j = 0; j < 8; ++j) v[j] = ((const GAS f32x4*)(xsrc + (size_t)row * 2048))[lane + 64 * j];
                if (l > 0) {
#pragma unroll
                    for (int j = 0; j < 8; ++j) { const v2u a = ((const GAS v2u*)(YB + (size_t)(2 * row) * 2048))[lane + 64 * j], b = ((const GAS v2u*)(YB + (size_t)(2 * row + 1) * 2048))[lane + 64 * j];
                        const f32x4 ys = (f32x4){bflo(a.x) + bflo(b.x), bfhi(a.x) + bfhi(b.x), bflo(a.y) + bflo(b.y), bfhi(a.y) + bfhi(b.y)};
                        v[j] += cG[j] * ys; ((GAS f32x4*)(xbuf + (size_t)row * 2048))[lane + 64 * j] = v[j]; }
                }
                float ss = 0.f;
#pragma unroll
                for (int j = 0; j < 8; ++j) ss += (v[j].x * v[j].x + v[j].y * v[j].y) + (v[j].z * v[j].z + v[j].w * v[j].w);
                const float rs = 1.f / sqrtf(wave_sum(ss) * (1.f / 2048.f) + RMS_EPS);
#pragma unroll
                for (int j = 0; j < 8; ++j) { const f32x4 o = v[j] * rs * cA[j] + cB[j]; v2u w; w.x = pk2(o.x, o.y); w.y = pk2(o.z, o.w); ((GAS v2u*)(HB + (size_t)row * 2048))[lane + 64 * j] = w; }
            }
        }
        SEAM(pb + 0);
        if (INJ(1)) {
            PHASE_BEGIN();
            bf16* const HB = (bf16*)(ws + WS_H); bf16* const WIN = (bf16*)(ws + WS_WIN); bf16* const PROJ = (bf16*)(ws + WS_PROJ); const float* const COS = (const float*)(ws + WS_COS); const float* const SIN = (const float*)(ws + WS_SIN);
            pg8::DenseSched Sd; Sd.init(HB, WIN + (size_t)l * 6144 * 2048, S_, INW, 2048, G, bx);
            pg8::EpiProj E{PROJ, COS, SIN, attn_body::C2};
            pg8::gemm_phase<pg8::EpiProj, pg8::DenseSched, true, true>(L + RING_OFF, 2048, Sd, E);
        }
        SEAM(pb + 1);
        if (INJ(2)) {
            PHASE_BEGIN();
            const bf16* const PROJ = (const bf16*)(ws + WS_PROJ); float* const KMEAN = (float*)(ws + WS_KMEAN);
            for (int t = gw; t < 512; t += NGW) { const int h = t >> 6, j = t & 63; const int rg = lane >> 3, ch = lane & 7;
                float a[8];
#pragma unroll
                for (int e = 0; e < 8; ++e) a[e] = 0.f;
                for (int it = 0; it < 32; ++it) { const v4u w = *(const GAS v4u*)(PROJ + (size_t)(256 * j + 8 * it + rg) * 6144 + C_KB + 64 * h + 8 * ch);
                    a[0] += bflo(w.x); a[1] += bfhi(w.x); a[2] += bflo(w.y); a[3] += bfhi(w.y); a[4] += bflo(w.z); a[5] += bfhi(w.z); a[6] += bflo(w.w); a[7] += bfhi(w.w); }
#pragma unroll
                for (int e = 0; e < 8; ++e) { a[e] += __shfl_xor(a[e], 8); a[e] += __shfl_xor(a[e], 16); a[e] += __shfl_xor(a[e], 32); }
                if (lane < 8) {
#pragma unroll
                    for (int e = 0; e < 8; ++e) KMEAN[(size_t)(h * 64 + j) * 64 + 8 * lane + e] = a[e] * (1.f / 256.f); }
            }
        }
        SEAM(pb + 2);
        if (INJ(3)) {
            PHASE_BEGIN();
            const bf16* const PROJ = (const bf16*)(ws + WS_PROJ); const float* const KMEAN = (const float*)(ws + WS_KMEAN); bf16* const MERGED = (bf16*)(ws + WS_MERGED); float* const TB = (float*)(ws + WS_T);
            char* const shm = (char*)lds + RING_OFF;
            for (int vc = vcu; vc < 256; vc += G) {
#if !defined(NO_ATT_C)
                { const int bhv = vc >> 3, hd = bhv >> 2, mp = (bhv >> 1) & 1, vh = bhv & 1, s = vc & 7;
                  const attn_body::bf16* Qp = (const attn_body::bf16*)PROJ + C_QC + hd * 128 + mp * 64; const attn_body::bf16* Kp = (const attn_body::bf16*)PROJ + C_KC + hd * 128 + mp * 64;
                  const attn_body::bf16* Vp = (const attn_body::bf16*)PROJ + C_VC + hd * 128 + vh * 64; float* Op = TB + (size_t)mp * S_ * 1024 + hd * 128 + vh * 64;
                  for (int i = 7; i >= 0; --i) { const int qb = 16 * (i >> 1) + ((i & 1) ? 15 - s : s);
                      attn_body::attn_unit<8, 0>(qb, 0, Qp, Kp, Vp, (void*)Op, 1024, nullptr, shm); } }
#endif
#if !defined(NO_ATT_B)
                { const int hd = vc >> 5, ii = vc & 31;
                  const attn_body::bf16* Qp = (const attn_body::bf16*)PROJ + C_QB + hd * 64; const attn_body::bf16* Kp = (const attn_body::bf16*)PROJ + C_KB + hd * 64; const attn_body::bf16* Vp = (const attn_body::bf16*)PROJ + C_VB + hd * 64;
                  for (int i = 0; i < 2; ++i) { const int qb = i ? ii : 63 - ii;
                      { int st = threadIdx.x; asm volatile("" : "+v"(st));
                        LAS float* km = (LAS float*)(L + ATT_KM_OFF); LAS unsigned long long* selt = (LAS unsigned long long*)(L + ATT_SEL_OFF);
                        for (int k4 = st; k4 < qb * 16; k4 += NWAVES * 64) ((LAS f32x4*)km)[k4] = ((const GAS f32x4*)(KMEAN + (size_t)hd * 64 * 64))[k4];
                        const int q = st >> 1, dh = st & 1; float qf[32];
                        { const bf16* qrow = PROJ + (size_t)(qb * 256 + q) * 6144 + C_QB + hd * 64 + dh * 32;
#pragma unroll
                          for (int c8 = 0; c8 < 4; ++c8) { const v4u w = *(const GAS v4u*)(qrow + 8 * c8); qf[8 * c8 + 0] = bflo(w.x); qf[8 * c8 + 1] = bfhi(w.x); qf[8 * c8 + 2] = bflo(w.y); qf[8 * c8 + 3] = bfhi(w.y);
                              qf[8 * c8 + 4] = bflo(w.z); qf[8 * c8 + 5] = bfhi(w.z); qf[8 * c8 + 6] = bflo(w.w); qf[8 * c8 + 7] = bfhi(w.w); } }
                        __syncthreads();
                        float b0 = -INFINITY, b1 = -INFINITY, b2 = -INFINITY; int i0 = -1, i1 = -1, i2 = -1;
                        for (int j = 0; j < qb; ++j) { const LAS f32x4* kr = (const LAS f32x4*)(km + j * 64 + dh * 32); float g = 0.f;
#pragma unroll
                            for (int c4 = 0; c4 < 8; ++c4) { const f32x4 kv = kr[c4]; g = fmaf(qf[4 * c4 + 0], kv.x, g); g = fmaf(qf[4 * c4 + 1], kv.y, g); g = fmaf(qf[4 * c4 + 2], kv.z, g); g = fmaf(qf[4 * c4 + 3], kv.w, g); }
                            g += __shfl_xor(g, 1);
                            if (g > b0) { b2 = b1; i2 = i1; b1 = b0; i1 = i0; b0 = g; i0 = j; } else if (g > b1) { b2 = b1; i2 = i1; b1 = g; i1 = j; } else if (g > b2) { b2 = g; i2 = j; } }
                        unsigned long long m = 0ull; if (i0 >= 0) m |= 1ull << i0; if (i1 >= 0) m |= 1ull << i1; if (i2 >= 0) m |= 1ull << i2;
                        if (dh == 0) selt[q] = m;
                        __syncthreads(); }
                      attn_body::attn_unit<8, 1>(qb, 0, Qp, Kp, Vp, (void*)(MERGED + 512 + hd * 64), 2048, (const unsigned long long*)((char*)lds + ATT_SEL_OFF), shm); } }
#endif
#if !defined(NO_ATT_A)
                { const int hd = vc >> 5, ii = vc & 31;
                  const attn_body::bf16* Qp = (const attn_body::bf16*)PROJ + C_QA + hd * 64; const attn_body::bf16* Kp = (const attn_body::bf16*)PROJ + C_KA + hd * 64; const attn_body::bf16* Vp = (const attn_body::bf16*)PROJ + C_VA + hd * 64;
                  for (int i = 0; i < 2; ++i) { const int qb = i ? ii : 63 - ii; const int T0 = (qb > 8) ? 4 * (qb - 8) : 0;
                      attn_body::attn_unit<8, 2>(qb, T0, Qp, Kp, Vp, (void*)(MERGED + hd * 64), 2048, nullptr, shm); } }
#endif
            }
        }
        SEAM(pb + 3);
        if (INJ(4)) {
            PHASE_BEGIN();
            const float* const lam_q1 = KIN(float, 9); const float* const lam_k1 = KIN(float, 10); const float* const lam_q2 = KIN(float, 11); const float* const lam_k2 = KIN(float, 12); const float* const g_sub = KIN(float, 13);
            const float* const TB = (const float*)(ws + WS_T); bf16* const MERGED = (bf16*)(ws + WS_MERGED);
            const float d1 = wave_sum(lam_q1[l * 64 + lane] * lam_k1[l * 64 + lane]), d2 = wave_sum(lam_q2[l * 64 + lane] * lam_k2[l * 64 + lane]);
            const float lam = expf(d1) - expf(d2) + lam_init;
            const f32x4 gs = ((const f32x4*)(g_sub + l * 128))[lane & 31]; const float osc = 1.f - lam_init;
            for (int row = gw; row < S_; row += NGW) {
#pragma unroll
                for (int j = 0; j < 4; ++j) { const f32x4 a = ((const GAS f32x4*)(TB + (size_t)row * 1024))[lane + 64 * j], b = ((const GAS f32x4*)(TB + (size_t)(S_ + row) * 1024))[lane + 64 * j];
                    const f32x4 v = a - lam * b; float ss = (v.x * v.x + v.y * v.y) + (v.z * v.z + v.w * v.w);
                    ss += __shfl_xor(ss, 1); ss += __shfl_xor(ss, 2); ss += __shfl_xor(ss, 4); ss += __shfl_xor(ss, 8); ss += __shfl_xor(ss, 16);
                    const float rs = 1.f / sqrtf(ss * (1.f / 128.f) + RMS_EPS); const f32x4 o = v * rs * gs * osc;
                    v2u w; w.x = pk2(o.x, o.y); w.y = pk2(o.z, o.w); ((GAS v2u*)(MERGED + (size_t)row * 2048 + 1024))[lane + 64 * j] = w; }
            }
        }
        SEAM(pb + 4);
        if (INJ(5)) {
            PHASE_BEGIN();
            const float* const x_in = KIN(float, 0); float* const xbuf = ka->out; const float* const mod = (const float*)(ws + WS_MOD) + l * 12288;
            bf16* const MERGED = (bf16*)(ws + WS_MERGED); bf16* const WOUT = (bf16*)(ws + WS_WOUT);
            pg8::DenseSched Sd; Sd.init(MERGED, WOUT + (size_t)l * 2048 * 2048, S_, 2048, 2048, G, bx);
            pg8::EpiGateRes E{(l == 0) ? x_in : (const float*)xbuf, xbuf, mod + 4096};
            pg8::gemm_phase<pg8::EpiGateRes, pg8::DenseSched, true, true>(L + RING_OFF, 2048, Sd, E);
        }
        SEAM(pb + 5);
        if (INJ(6)) {
            PHASE_BEGIN();
            const float* const g_mlp = KIN(float, 6); const float* const w_router = KIN(float, 17); const float* const b_router = KIN(float, 18); const float* const xbuf = ka->out;
            const float* const mod = (const float*)(ws + WS_MOD) + l * 12288; bf16* const HB = (bf16*)(ws + WS_H);
            int* const EID = (int*)(ws + WS_EID); float* const WTS = (float*)(ws + WS_WTS); int* const CNT = (int*)(ws + WS_CNT);
            LAS float* const RW = (LAS float*)L;
            for (int idx = tid; idx < 32768; idx += NWAVES * 64) RW[(idx & 15) * 2048 + (idx >> 4)] = w_router[idx];
            f32x4 cA[8], cB[8];
#pragma unroll
            for (int j = 0; j < 8; ++j) { const int c4 = lane + 64 * j; const f32x4 g = ((const f32x4*)(g_mlp + l * 2048))[c4]; const f32x4 sc = ((const f32x4*)(mod + 8192))[c4];
                cA[j] = g * (1.f + sc); cB[j] = ((const f32x4*)(mod + 6144))[c4]; }
            float br[16];
#pragma unroll
            for (int e = 0; e < 16; ++e) br[e] = b_router[e];
            for (int rb = bx; rb < NROWBLK; rb += G) {
                if (tid < 16) cnt16[tid] = 0;
                __syncthreads();
                for (int i = 0; i < 8; ++i) { const int row = 64 * rb + 8 * wave + i;
                    f32x4 v[8]; float ss = 0.f;
#pragma unroll
                    for (int j = 0; j < 8; ++j) { v[j] = ((const GAS f32x4*)(xbuf + (size_t)row * 2048))[lane + 64 * j]; ss += (v[j].x * v[j].x + v[j].y * v[j].y) + (v[j].z * v[j].z + v[j].w * v[j].w); }
                    const float rs = 1.f / sqrtf(wave_sum(ss) * (1.f / 2048.f) + RMS_EPS);
                    float p[16];
#pragma unroll
                    for (int e = 0; e < 16; ++e) p[e] = 0.f;
#pragma unroll
                    for (int j = 0; j < 8; ++j) { const f32x4 o = v[j] * rs * cA[j] + cB[j]; v2u w; w.x = pk2(o.x, o.y); w.y = pk2(o.z, o.w); ((GAS v2u*)(HB + (size_t)row * 2048))[lane + 64 * j] = w;
#pragma unroll
                        for (int e = 0; e < 16; ++e) { const f32x4 w4 = ((const LAS f32x4*)(RW + e * 2048))[lane + 64 * j]; p[e] += (o.x * w4.x + o.y * w4.y) + (o.z * w4.z + o.w * w4.w); } }
#pragma unroll
                    for (int e = 0; e < 16; ++e) p[e] = wave_sum(p[e]);
                    float sg[16], sv[16];
#pragma unroll
                    for (int e = 0; e < 16; ++e) { sv[e] = 1.f / (1.f + expf(-p[e])); sg[e] = sv[e] + br[e]; }
                    float gsc[4];
#pragma unroll
                    for (int g4 = 0; g4 < 4; ++g4) { const float a = sg[4 * g4], b = sg[4 * g4 + 1], c = sg[4 * g4 + 2], d = sg[4 * g4 + 3];
                        const float h1 = fmaxf(a, b), l1 = fminf(a, b), h2 = fmaxf(c, d), l2 = fminf(c, d); gsc[g4] = fmaxf(h1, h2) + fmaxf(fminf(h1, h2), fmaxf(l1, l2)); }
                    int gi = 0; float gb = gsc[0];
#pragma unroll
                    for (int g4 = 1; g4 < 4; ++g4) if (gsc[g4] > gb) { gb = gsc[g4]; gi = g4; }
                    float cd[4], cs[4];
#pragma unroll
                    for (int k = 0; k < 4; ++k) { cd[k] = (gi == 0) ? sg[k] : (gi == 1) ? sg[4 + k] : (gi == 2) ? sg[8 + k] : sg[12 + k]; cs[k] = (gi == 0) ? sv[k] : (gi == 1) ? sv[4 + k] : (gi == 2) ? sv[8 + k] : sv[12 + k]; }
                    int l0 = 0; float v0 = cd[0], s0 = cs[0];
#pragma unroll
                    for (int k = 1; k < 4; ++k) if (cd[k] > v0) { v0 = cd[k]; l0 = k; s0 = cs[k]; }
                    int l1i = -1; float v1 = -INFINITY, s1 = 0.f;
#pragma unroll
                    for (int k = 0; k < 4; ++k) if (k != l0 && cd[k] > v1) { v1 = cd[k]; l1i = k; s1 = cs[k]; }
                    const int e0 = 4 * gi + l0, e1 = 4 * gi + l1i; const float wsum = s0 + s1;
                    if (lane == 0) { EID[2 * row] = e0; EID[2 * row + 1] = e1; WTS[2 * row] = s0 / wsum; WTS[2 * row + 1] = s1 / wsum; atomicAdd((int*)(cnt16 + e0), 1); atomicAdd((int*)(cnt16 + e1), 1); }
                }
                __syncthreads();
                if (tid < 16) CNT[rb * 16 + tid] = cnt16[tid];
                __syncthreads();
            }
        }
        SEAM(pb + 6);
        if (INJ(7)) {
            PHASE_BEGIN();
            const bf16* const HB = (const bf16*)(ws + WS_H); bf16* const XS = (bf16*)(ws + WS_XS);
            const int* const EID = (const int*)(ws + WS_EID); const float* const WTS = (const float*)(ws + WS_WTS); int* const ROWTOK = (int*)(ws + WS_ROWTOK); float* const ROWW = (float*)(ws + WS_ROWW); const int* const CNT = (const int*)(ws + WS_CNT);
            for (int rb = bx; rb < NROWBLK; rb += G) {
                COMPUTE_SEGMENTS(rb);
                if (wave == 0) { const int row = 64 * rb + lane; const int e0 = EID[2 * row], e1 = EID[2 * row + 1]; int p0 = 0, p1 = 0;
                    const unsigned long long lt = (1ull << lane) - 1ull;
                    for (int e = 0; e < 16; ++e) { const unsigned long long m0 = __ballot(e0 == e), m1 = __ballot(e1 == e); const int r = __popcll(m0 & lt) + __popcll(m1 & lt);
                        if (e0 == e) p0 = basee[e] + r; if (e1 == e) p1 = basee[e] + r; }
                    postab[2 * lane] = p0; postab[2 * lane + 1] = p1;
                    ROWTOK[p0] = 2 * row; ROWTOK[p1] = 2 * row + 1; ROWW[p0] = WTS[2 * row]; ROWW[p1] = WTS[2 * row + 1]; }
                __syncthreads();
                for (int i = 0; i < 8; ++i) { const int r = 8 * wave + i, row = 64 * rb + r; const int p0 = postab[2 * r], p1 = postab[2 * r + 1];
#pragma unroll
                    for (int c = 0; c < 4; ++c) { const v4u w = ((const GAS v4u*)(HB + (size_t)row * 2048))[lane + 64 * c]; ((GAS v4u*)(XS + (size_t)p0 * 2048))[lane + 64 * c] = w; ((GAS v4u*)(XS + (size_t)p1 * 2048))[lane + 64 * c] = w; } }
                if (rb < 16) { const int pbeg = segs[rb] + tot[rb], pend = segs[rb + 1];
                    for (int p = pbeg + tid; p < pend; p += NWAVES * 64) { ROWTOK[p] = -1; ROWW[p] = 0.f; } }
                __syncthreads();
            }
        }
        SEAM(pb + 7);
        if (INJ(8)) {
            PHASE_BEGIN();
            const int* const CNT = (const int*)(ws + WS_CNT); bf16* const XS = (bf16*)(ws + WS_XS); bf16* const WGU = (bf16*)(ws + WS_WGU); bf16* const ACT = (bf16*)(ws + WS_ACT);
            COMPUTE_SEGMENTS(0);
            pg8::MoeSched Sm; Sm.init(XS, WGU + (size_t)l * 16 * 2048 * 2048, segs[16], 2048, 2048, (size_t)2048 * 2048 * 2, (const PG8_LAS unsigned char*)p2e, G, bx);
            pg8::EpiSwiglu E{ACT};
            pg8::gemm_phase<pg8::EpiSwiglu, pg8::MoeSched, true, true>(L + RING_OFF, 2048, Sm, E);
        }
        SEAM(pb + 8);
        if (INJ(9)) {
            PHASE_BEGIN();
            const int* const CNT = (const int*)(ws + WS_CNT); bf16* const ACT = (bf16*)(ws + WS_ACT); bf16* const WDN = (bf16*)(ws + WS_WDN); bf16* const YB = (bf16*)(ws + WS_Y);
            const int* const ROWTOK = (const int*)(ws + WS_ROWTOK); const float* const ROWW = (const float*)(ws + WS_ROWW);
            COMPUTE_SEGMENTS(0);
            pg8::MoeSched Sm; Sm.init(ACT, WDN + (size_t)l * 16 * 2048 * 1024, segs[16], 2048, 1024, (size_t)2048 * 1024 * 2, (const PG8_LAS unsigned char*)p2e, G, bx);
            pg8::EpiDown E{YB, ROWTOK, ROWW};
            pg8::gemm_phase<pg8::EpiDown, pg8::MoeSched, true, true>(L + RING_OFF, 1024, Sm, E);
        }
        SEAM(pb + 9);
    }
    if (((PHMASK >> 11) & 1) && IN(21)) {
        PHASE_BEGIN();
        const float* const g_final = KIN(float, 19); float* const xbuf = ka->out; const float* const MOD = (const float*)(ws + WS_MOD); const bf16* const YB = (const bf16*)(ws + WS_Y);
        f32x4 cA[8], cG[8];
#pragma unroll
        for (int j = 0; j < 8; ++j) { const int c4 = lane + 64 * j; cA[j] = ((const f32x4*)g_final)[c4]; cG[j] = ((const f32x4*)(MOD + 12288 + 10240))[c4]; }
        for (int row = gw; row < S_; row += NGW) {
            f32x4 v[8]; float ss = 0.f;
#pragma unroll
            for (int j = 0; j < 8; ++j) { v[j] = ((const GAS f32x4*)(xbuf + (size_t)row * 2048))[lane + 64 * j];
                const v2u a = ((const GAS v2u*)(YB + (size_t)(2 * row) * 2048))[lane + 64 * j], b = ((const GAS v2u*)(YB + (size_t)(2 * row + 1) * 2048))[lane + 64 * j];
                const f32x4 ys = (f32x4){bflo(a.x) + bflo(b.x), bfhi(a.x) + bfhi(b.x), bflo(a.y) + bflo(b.y), bfhi(a.y) + bfhi(b.y)};
                v[j] += cG[j] * ys; ss += (v[j].x * v[j].x + v[j].y * v[j].y) + (v[j].z * v[j].z + v[j].w * v[j].w); }
            const float rs = 1.f / sqrtf(wave_sum(ss) * (1.f / 2048.f) + RMS_EPS);
#pragma unroll
            for (int j = 0; j < 8; ++j) ((GAS f32x4*)(xbuf + (size_t)row * 2048))[lane + 64 * j] = v[j] * rs * cA[j];
        }
    }
#undef IN
#undef INJ
#undef PHASE_BEGIN
#undef KIN
#undef SEAM
#undef COMPUTE_SEGMENTS
}

extern "C" void kernel_launch(void* const* d_in, const int* in_sizes, int n_in, void* d_out, int out_size, void* d_ws, size_t ws_size, hipStream_t stream) {
    static int grid = 0;
    if (grid == 0) {
        if (n_in != 20 || in_sizes[0] != S_ * DM_ || out_size != S_ * DM_ || ws_size < WS_END) { fprintf(stderr, "kernel_launch: unexpected shapes or workspace (%d inputs, in0 %d, out %d, ws %zu); nothing launched\n", n_in, n_in > 0 ? in_sizes[0] : -1, out_size, ws_size); grid = -1; return; }
        int dev = 0, cus = 0, per_cu = 0;
        if (hipGetDevice(&dev) != hipSuccess || hipDeviceGetAttribute(&cus, hipDeviceAttributeMultiprocessorCount, dev) != hipSuccess) { grid = -1; return; }
        if (hipFuncSetAttribute((const void*)fwd, hipFuncAttributeMaxDynamicSharedMemorySize, LDS_BYTES) != hipSuccess) { fprintf(stderr, "kernel_launch: hipFuncSetAttribute failed\n"); grid = -1; return; }
        if (hipOccupancyMaxActiveBlocksPerMultiprocessor(&per_cu, (const void*)fwd, NWAVES * 64, LDS_BYTES) != hipSuccess || per_cu < 1) fprintf(stderr, "kernel_launch: occupancy query reports %d blocks per CU\n", per_cu);
        (void)hipGetLastError();
        grid = cus;
    }
    if (grid < 0) return;
    if (hipMemsetAsync((char*)d_ws + WS_CTL, 0, CTL_ZERO_BYTES, stream) != hipSuccess) return;
    Args a{};
    for (int i = 0; i < 20; ++i) a.in[i] = d_in[i];
    a.out = (float*)d_out; a.ws = (unsigned char*)d_ws;
    if (MK_N_LAUNCHES == 1) { a.ph_lo = 0; a.ph_hi = N_PHASES; hipLaunchKernelGGL(fwd, dim3(grid), dim3(NWAVES * 64), LDS_BYTES, stream, a); }
    else for (int p = 0; p < N_PHASES; ++p) { a.ph_lo = p; a.ph_hi = p + 1; hipLaunchKernelGGL(fwd, dim3(grid), dim3(NWAVES * 64), LDS_BYTES, stream, a); }
}
```

```cpp
#include <hip/hip_runtime.h>
#include <hip/hip_bf16.h>
#include <cstdio>
#include <cstdint>
#include <cmath>
namespace pg8 {
#define PG8_LAS __attribute__((address_space(3)))
typedef unsigned short bf16_t;
typedef short bf16x8 __attribute__((ext_vector_type(8)));
typedef float f32x4 __attribute__((ext_vector_type(4)));
typedef unsigned u32x4 __attribute__((ext_vector_type(4)));
constexpr int BM = 256, BK = 64, HALF = 128, HTB = HALF * BK * 2  , STAGE_BYTES = 8 * HTB, NXCD = 8, WGM = 8;

__host__ __device__ __forceinline__ int lds_byte(int r, int c) { const int st = (r >> 4) * 2 + (c >> 5), rr = r & 15, cc = c & 31, ob = rr * 64 + cc * 2; return st * 1024 + (ob ^ (((ob >> 9) & 1) << 5)); }
__host__ __device__ __forceinline__ void stage_rc(int b, int& R, int& C) { const int st = b / 1024, sb = b % 1024, swz = sb ^ (((sb >> 9) & 1) << 5); R = (st >> 1) * 16 + swz / 64; C = (st & 1) * 32 + (swz % 64) / 2; }
__host__ __device__ __forceinline__ int perm32(int rho) { const int n = rho >> 4, i = rho & 15; return 8 * (i >> 2) + 4 * n + (i & 3); }

struct Unit { int pm, pn; };
struct Gemm { const bf16_t* A; const bf16_t* Bt; int M, N, K; };

struct StaticOrder {
    int nM, nN, nwg, G, c;
    __host__ __device__ void init(int M, int N, int G_, int c_) { nM = M / BM; nN = N / BM; nwg = nM * nN; G = G_; c = c_; }
    __host__ __device__ bool next(int i, Unit& u) const {
        const long L = (long)i * G + c; if (L >= nwg) return false;
        int wgid = (int)L; { const int q = nwg / NXCD, r = nwg % NXCD, xcd = wgid % NXCD, off = wgid / NXCD; wgid = (xcd < r ? xcd * (q + 1) : r * (q + 1) + (xcd - r) * q) + off; }
        const int nig = WGM * nN, gid = wgid / nig, fm = gid * WGM, gsz = (nM - fm) < WGM ? (nM - fm) : WGM;
        u.pm = fm + ((wgid % nig) % gsz); u.pn = (wgid % nig) / gsz; return true;
    }
    __device__ __forceinline__ void a_ready(const Unit&) const {}
    __device__ __forceinline__ void done(const Unit&) const {}
};

struct DenseSched {
    const char* A; const char* Bt; size_t tstep; StaticOrder so;
    __device__ __forceinline__ void init(const void* A_, const void* Bt_, int M, int N, int K, int G, int c) { A = (const char*)A_; Bt = (const char*)Bt_; tstep = (size_t)BM * K * 2; so.init(M, N, G, c); }
    __device__ __forceinline__ bool next(int i, Unit& u) const { return so.next(i, u); }
    __device__ __forceinline__ const char* a_ptr(const Unit& u) const { return A + (size_t)u.pm * tstep; }
    __device__ __forceinline__ const char* b_ptr(const Unit& u) const { return Bt + (size_t)u.pn * tstep; }
    __device__ __forceinline__ void a_ready(const Unit&) const {}
    __device__ __forceinline__ void done(const Unit&) const {}
};
struct MoeSched {
    const char* A; const char* Bt; size_t tstep, estride; StaticOrder so; const PG8_LAS unsigned char* p2e;
    __device__ __forceinline__ void init(const void* A_, const void* Bt_, int Mpad, int N, int K, size_t estride_, const PG8_LAS unsigned char* p2e_, int G, int c) {
        A = (const char*)A_; Bt = (const char*)Bt_; tstep = (size_t)BM * K * 2; estride = estride_; p2e = p2e_; so.init(Mpad, N, G, c); }
    __device__ __forceinline__ bool next(int i, Unit& u) const { return so.next(i, u); }
    __device__ __forceinline__ const char* a_ptr(const Unit& u) const { return A + (size_t)u.pm * tstep; }
    __device__ __forceinline__ const char* b_ptr(const Unit& u) const { const int e = __builtin_amdgcn_readfirstlane((int)p2e[u.pm]); return Bt + (size_t)e * estride + (size_t)u.pn * tstep; }
    __device__ __forceinline__ void a_ready(const Unit&) const {}
    __device__ __forceinline__ void done(const Unit&) const {}
};

__device__ __forceinline__ unsigned cvt_pk_bf16(float lo, float hi) { unsigned r; asm volatile("v_cvt_pk_bf16_f32 %0, %1, %2" : "=v"(r) : "v"(lo), "v"(hi)); return r; }

struct EpiProj {
    static constexpr bool PERM = true, AFTER_DRAIN = false;
    bf16_t* O; const float* cosT; const float* sinT; float qscale;
    __device__ __forceinline__ void operator()(const f32x4 (&acc)[2][2][4][2], const Unit& u, int wr, int wc, int fr, int fq) const {
        const int pn = u.pn;
        const bool isq = (pn < 2) || (pn == 6) || (pn == 7) || (pn >= 12 && pn < 16);
        const bool isk = (pn == 2) || (pn == 3) || (pn == 8) || (pn == 9) || (pn >= 16 && pn < 20);
        const int row0 = u.pm * BM + wr * 64 + fr, col0 = pn * BM + wc * 32 + 8 * fq;
        const int i0 = (wc & 1) * 16 + 4 * fq;
        const float sc = isq ? qscale : 1.f;
#pragma unroll
        for (int ai = 0; ai < 2; ++ai)
#pragma unroll
            for (int m = 0; m < 4; ++m) { const int row = row0 + ai * HALF + m * 16; bf16_t* rowp = O + (size_t)row * 6144 + col0;
                f32x4 cs = (f32x4){1.f, 1.f, 1.f, 1.f}, sn = (f32x4){0.f, 0.f, 0.f, 0.f};
                if (isq || isk) { cs = *(const f32x4*)(cosT + (size_t)row * 32 + i0); sn = *(const f32x4*)(sinT + (size_t)row * 32 + i0); }
#pragma unroll
                for (int bj = 0; bj < 2; ++bj) { const f32x4 v0 = acc[ai][bj][m][0], v1 = acc[ai][bj][m][1];
                    const float a0 = (v0[0] * cs[0] - v0[1] * sn[0]) * sc, b0 = (v0[1] * cs[0] + v0[0] * sn[0]) * sc;
                    const float a1 = (v0[2] * cs[1] - v0[3] * sn[1]) * sc, b1 = (v0[3] * cs[1] + v0[2] * sn[1]) * sc;
                    const float a2 = (v1[0] * cs[2] - v1[1] * sn[2]) * sc, b2 = (v1[1] * cs[2] + v1[0] * sn[2]) * sc;
                    const float a3 = (v1[2] * cs[3] - v1[3] * sn[3]) * sc, b3 = (v1[3] * cs[3] + v1[2] * sn[3]) * sc;
                    u32x4 w; w.x = cvt_pk_bf16(a0, b0); w.y = cvt_pk_bf16(a1, b1); w.z = cvt_pk_bf16(a2, b2); w.w = cvt_pk_bf16(a3, b3);
                    *(u32x4*)(rowp + bj * HALF) = w; } }
    }
};
struct EpiGateRes {
    static constexpr bool PERM = false, AFTER_DRAIN = false;
    const float* base; float* out; const float* gate;
    __device__ __forceinline__ void operator()(const f32x4 (&acc)[2][2][4][2], const Unit& u, int wr, int wc, int fr, int fq) const {
        const int col0 = u.pn * BM + wc * 32 + 4 * fq;
        f32x4 gv[2][2];
#pragma unroll
        for (int bj = 0; bj < 2; ++bj)
#pragma unroll
            for (int n = 0; n < 2; ++n) gv[bj][n] = *(const f32x4*)(gate + col0 + bj * HALF + n * 16);
#pragma unroll
        for (int ai = 0; ai < 2; ++ai)
#pragma unroll
            for (int m = 0; m < 4; ++m) { const size_t off = (size_t)(u.pm * BM + ai * HALF + wr * 64 + m * 16 + fr) * 2048 + col0;
#pragma unroll
                for (int bj = 0; bj < 2; ++bj)
#pragma unroll
                    for (int n = 0; n < 2; ++n) { const f32x4 bs = *(const f32x4*)(base + off + bj * HALF + n * 16); *(f32x4*)(out + off + bj * HALF + n * 16) = bs + gv[bj][n] * acc[ai][bj][m][n]; } }
    }
};
struct EpiSwiglu {
    static constexpr bool PERM = true, AFTER_DRAIN = false;
    bf16_t* O;
    __device__ __forceinline__ void operator()(const f32x4 (&acc)[2][2][4][2], const Unit& u, int wr, int wc, int fr, int fq) const {
        const int row0 = u.pm * BM + wr * 64 + fr, col0 = u.pn * 128 + wc * 16 + 4 * fq;
        typedef unsigned u32x2 __attribute__((ext_vector_type(2)));
#pragma unroll
        for (int ai = 0; ai < 2; ++ai)
#pragma unroll
            for (int m = 0; m < 4; ++m) { bf16_t* rowp = O + (size_t)(row0 + ai * HALF + m * 16) * 1024 + col0;
#pragma unroll
                for (int bj = 0; bj < 2; ++bj) { const f32x4 g = acc[ai][bj][m][0], up = acc[ai][bj][m][1]; float r[4];
#pragma unroll
                    for (int j = 0; j < 4; ++j) { const float e = __builtin_amdgcn_exp2f(-1.4426950408889634f * g[j]); r[j] = g[j] * __builtin_amdgcn_rcpf(1.f + e) * up[j]; }
                    u32x2 w; w.x = cvt_pk_bf16(r[0], r[1]); w.y = cvt_pk_bf16(r[2], r[3]); *(u32x2*)(rowp + bj * 64) = w; } }
    }
};
struct EpiDown {
    static constexpr bool PERM = true, AFTER_DRAIN = false;
    bf16_t* Y; const int* rowtok; const float* roww;
    __device__ __forceinline__ void operator()(const f32x4 (&acc)[2][2][4][2], const Unit& u, int wr, int wc, int fr, int fq) const {
        const int row0 = u.pm * BM + wr * 64 + fr, col0 = u.pn * BM + wc * 32 + 8 * fq;
#pragma unroll
        for (int ai = 0; ai < 2; ++ai)
#pragma unroll
            for (int m = 0; m < 4; ++m) { const int pos = row0 + ai * HALF + m * 16; const int tk = rowtok[pos]; const float w8 = roww[pos];
                if (tk >= 0) { bf16_t* rowp = Y + (size_t)tk * 2048 + col0;
#pragma unroll
                    for (int bj = 0; bj < 2; ++bj) { const f32x4 v0 = acc[ai][bj][m][0] * w8, v1 = acc[ai][bj][m][1] * w8;
                        u32x4 w; w.x = cvt_pk_bf16(v0[0], v0[1]); w.y = cvt_pk_bf16(v0[2], v0[3]); w.z = cvt_pk_bf16(v1[0], v1[1]); w.w = cvt_pk_bf16(v1[2], v1[3]);
                        *(u32x4*)(rowp + bj * HALF) = w; } } }
    }
};

template <class Epi, class Sched, bool ALIGN_EPI = false, bool SP2 = false>
__device__ __forceinline__ void gemm_phase(PG8_LAS unsigned char* lds, const int K, const Sched& S, const Epi& E) {
    int tid = threadIdx.x; asm volatile("" : "+v"(tid)); const int wid = __builtin_amdgcn_readfirstlane(tid >> 6), lane = tid & 63, wr = wid >> 2, wc = wid & 3, fr = lane & 15, fq = lane >> 4;
    const int nt = K / BK;
    unsigned voffA[2], voffB[2];
#pragma unroll
    for (int i = 0; i < 2; ++i) { int R, C; stage_rc(tid * 16 + i * 8192, R, C); const int Rb = Epi::PERM ? ((R & ~31) + perm32(R & 31)) : R;
        voffA[i] = (unsigned)(R * K + C) * 2u; voffB[i] = (unsigned)(Rb * K + C) * 2u; }
    const size_t kstep = (size_t)(BK * 2);
    const size_t hstep = (size_t)HALF * K * 2;
    const unsigned ldsw = (unsigned)wid * 1024u;
    const int aoff = lds_byte(wr * 64 + fr, fq * 8), boff = lds_byte(wc * 32 + fr, fq * 8);
#define PG8_SA(b, h) (((b) * 2 + (h)) * HTB)
#define PG8_SB(b, h) ((4 + (b) * 2 + (h)) * HTB)
#define PG8_STAGE(bufoff, gbase, voff) do { _Pragma("unroll") for (int _i = 0; _i < 2; ++_i) \
        __builtin_amdgcn_global_load_lds((const unsigned*)((const char*)(gbase) + (voff)[_i]), (PG8_LAS unsigned*)(lds + (bufoff) + ldsw + _i * 8192), 16, 0, 0); } while (0)
#define PG8_LDA(dst, b, h) do { _Pragma("unroll") for (int m = 0; m < 4; ++m) _Pragma("unroll") for (int k = 0; k < 2; ++k) dst[m][k] = *(const PG8_LAS bf16x8*)(lds + PG8_SA(b, h) + aoff + m * 2048 + k * 1024); } while (0)
#define PG8_LDB(dst, b, h) do { _Pragma("unroll") for (int n = 0; n < 2; ++n) _Pragma("unroll") for (int k = 0; k < 2; ++k) dst[n][k] = *(const PG8_LAS bf16x8*)(lds + PG8_SB(b, h) + boff + n * 2048 + k * 1024); } while (0)
#define PG8_MMA(ai, bj, At, Bt) do { __builtin_amdgcn_s_setprio(1); _Pragma("unroll") for (int m = 0; m < 4; ++m) _Pragma("unroll") for (int n = 0; n < 2; ++n) _Pragma("unroll") for (int k = 0; k < 2; ++k) \
        acc[ai][bj][m][n] = __builtin_amdgcn_mfma_f32_16x16x32_bf16(Bt[n][k], At[m][k], acc[ai][bj][m][n], 0, 0, 0); __builtin_amdgcn_s_setprio(0); } while (0)
#define PG8_WAIT_V(n) asm volatile("s_waitcnt vmcnt(" #n ")" ::: "memory")
#define PG8_WAIT_L(n) asm volatile("s_waitcnt lgkmcnt(" #n ")" ::: "memory")
#define PG8_BAR __builtin_amdgcn_s_barrier()
#define PG8_SCHED __builtin_amdgcn_sched_barrier(0)
    Unit cur, nxt; int ui = 0;
    if (!S.next(0, cur)) return;
    f32x4 acc[2][2][4][2];
#pragma unroll
    for (int a = 0; a < 2; ++a)
#pragma unroll
        for (int b = 0; b < 2; ++b)
#pragma unroll
            for (int m = 0; m < 4; ++m)
#pragma unroll
                for (int n = 0; n < 2; ++n) acc[a][b][m][n] = (f32x4){0.f, 0.f, 0.f, 0.f};
    bf16x8 At[4][2], B0[2][2], B1[2][2];
    const char* cA = S.a_ptr(cur); const char* cB = S.b_ptr(cur);
    S.a_ready(cur);
    if constexpr (SP2) {
        PG8_STAGE(PG8_SB(0, 0), cB, voffB); PG8_STAGE(PG8_SB(0, 1), cB + hstep, voffB); PG8_STAGE(PG8_SA(0, 0), cA, voffA); PG8_STAGE(PG8_SA(0, 1), cA + hstep, voffA);
        if (wr == 1) PG8_BAR;
        PG8_WAIT_V(2); PG8_BAR;
        PG8_STAGE(PG8_SB(1, 0), cB + kstep, voffB); PG8_STAGE(PG8_SA(1, 0), cA + kstep, voffA); PG8_STAGE(PG8_SB(1, 1), cB + hstep + kstep, voffB);
        PG8_WAIT_V(6); PG8_BAR;
    } else {
        PG8_STAGE(PG8_SB(0, 0), cB, voffB); PG8_STAGE(PG8_SA(0, 0), cA, voffA); PG8_STAGE(PG8_SB(0, 1), cB + hstep, voffB); PG8_STAGE(PG8_SA(0, 1), cA + hstep, voffA);
        if (wr == 1) PG8_BAR;
        PG8_WAIT_V(4); PG8_BAR;
        PG8_STAGE(PG8_SB(1, 0), cB + kstep, voffB); PG8_STAGE(PG8_SA(1, 0), cA + kstep, voffA); PG8_STAGE(PG8_SB(1, 1), cB + hstep + kstep, voffB);
        PG8_WAIT_V(6); PG8_BAR;
    }
    for (;;) {
        const bool has_next = S.next(ui + 1, nxt);
        const char* nA = has_next ? S.a_ptr(nxt) : cA; const char* nB = has_next ? S.b_ptr(nxt) : cB;
        for (int t = 0; t < nt; t += 2) {
            const bool last = (t == nt - 2);
            const char* a1 = cA + (size_t)(t + 1) * kstep;
            const char* a2 = last ? nA : cA + (size_t)(t + 2) * kstep; const char* b2 = last ? nB : cB + (size_t)(t + 2) * kstep;
            const char* a3 = a2 + kstep; const char* b3 = b2 + kstep;
            if (last && has_next) S.a_ready(nxt);
            if constexpr (SP2) {
            PG8_LDB(B0, 0, 0); PG8_LDB(B1, 0, 1); PG8_SCHED; PG8_LDA(At, 0, 0); PG8_STAGE(PG8_SA(1, 1), a1 + hstep, voffA);
            PG8_WAIT_V(8); PG8_WAIT_L(0); PG8_BAR; PG8_MMA(0, 0, At, B0); PG8_MMA(0, 1, At, B1); PG8_BAR; PG8_SCHED;
            PG8_LDA(At, 0, 1); PG8_STAGE(PG8_SB(0, 0), b2, voffB); PG8_STAGE(PG8_SB(0, 1), b2 + hstep, voffB); PG8_STAGE(PG8_SA(0, 0), a2, voffA);
            PG8_WAIT_V(8); PG8_WAIT_L(0); PG8_BAR; PG8_MMA(1, 0, At, B0); PG8_MMA(1, 1, At, B1); PG8_BAR; PG8_SCHED;
            PG8_LDB(B0, 1, 0); PG8_LDB(B1, 1, 1); PG8_SCHED; PG8_LDA(At, 1, 0); PG8_STAGE(PG8_SA(0, 1), a2 + hstep, voffA);
            PG8_WAIT_V(8); PG8_WAIT_L(0); PG8_BAR; PG8_MMA(0, 0, At, B0); PG8_MMA(0, 1, At, B1); PG8_BAR; PG8_SCHED;
            PG8_LDA(At, 1, 1); PG8_STAGE(PG8_SB(1, 0), b3, voffB); PG8_STAGE(PG8_SB(1, 1), b3 + hstep, voffB); PG8_STAGE(PG8_SA(1, 0), a3, voffA);
            PG8_WAIT_V(8); PG8_WAIT_L(0); PG8_BAR; PG8_MMA(1, 0, At, B0); PG8_MMA(1, 1, At, B1); PG8_BAR; PG8_SCHED;
            } else {
            PG8_LDB(B0, 0, 0); PG8_SCHED; PG8_LDA(At, 0, 0); PG8_STAGE(PG8_SA(1, 1), a1 + hstep, voffA);
            PG8_WAIT_L(8); PG8_BAR; PG8_WAIT_L(0); PG8_MMA(0, 0, At, B0); PG8_BAR; PG8_SCHED;
            PG8_LDB(B1, 0, 1); PG8_STAGE(PG8_SB(0, 0), b2, voffB);
            PG8_BAR; PG8_WAIT_L(0); PG8_MMA(0, 1, At, B1); PG8_BAR;
            PG8_LDA(At, 0, 1); PG8_STAGE(PG8_SA(0, 0), a2, voffA);
            PG8_BAR; PG8_WAIT_L(0); PG8_MMA(1, 0, At, B0); PG8_BAR; PG8_SCHED;
            PG8_STAGE(PG8_SB(0, 1), b2 + hstep, voffB);
            PG8_WAIT_V(6); PG8_BAR; PG8_MMA(1, 1, At, B1); PG8_BAR;
            PG8_LDB(B0, 1, 0); PG8_SCHED; PG8_LDA(At, 1, 0); PG8_STAGE(PG8_SA(0, 1), a2 + hstep, voffA);
            PG8_WAIT_L(8); PG8_BAR; PG8_WAIT_L(0); PG8_MMA(0, 0, At, B0); PG8_BAR; PG8_SCHED;
            PG8_LDB(B1, 1, 1); PG8_STAGE(PG8_SB(1, 0), b3, voffB);
            PG8_BAR; PG8_WAIT_L(0); PG8_MMA(0, 1, At, B1); PG8_BAR;
            PG8_LDA(At, 1, 1); PG8_STAGE(PG8_SA(1, 0), a3, voffA);
            PG8_BAR; PG8_WAIT_L(0); PG8_MMA(1, 0, At, B0); PG8_BAR; PG8_SCHED;
            PG8_STAGE(PG8_SB(1, 1), b3 + hstep, voffB);
            PG8_WAIT_V(6); PG8_BAR; PG8_MMA(1, 1, At, B1); PG8_BAR;
            }
        }
        if constexpr (ALIGN_EPI) { if (wr == 0) PG8_BAR; }
        if constexpr (!Epi::AFTER_DRAIN) { E(acc, cur, wr, wc, fr, fq); S.done(cur); }
        if (!has_next) break;
#pragma unroll
        for (int a = 0; a < 2; ++a)
#pragma unroll
            for (int b = 0; b < 2; ++b)
#pragma unroll
                for (int m = 0; m < 4; ++m)
#pragma unroll
                    for (int n = 0; n < 2; ++n) acc[a][b][m][n] = (f32x4){0.f, 0.f, 0.f, 0.f};
        cur = nxt; cA = nA; cB = nB; ++ui;
        if constexpr (ALIGN_EPI) { if (wr == 1) PG8_BAR; }
    }
    PG8_WAIT_V(0);
    if constexpr (!ALIGN_EPI) { if (wr == 0) PG8_BAR; }
    PG8_BAR;
    if constexpr (Epi::AFTER_DRAIN) { E.fused(acc, cur, wr, wc, fr, fq, lds, wid, lane); S.done(cur); }
#undef PG8_SA
#undef PG8_SB
#undef PG8_STAGE
#undef PG8_LDA
#undef PG8_LDB
#undef PG8_MMA
#undef PG8_WAIT_V
#undef PG8_WAIT_L
#undef PG8_BAR
#undef PG8_SCHED
}
}

#include <hip/hip_bf16.h>
#include <cmath>
namespace attn_body {
using bf16=__hip_bfloat16;
using bf16x8=__attribute__((ext_vector_type(8)))short;
using s16x4=__attribute__((ext_vector_type(4)))short;
using f32x16=__attribute__((ext_vector_type(16)))float;
using u32x4=__attribute__((ext_vector_type(4)))unsigned;
constexpr int SEQ=16384,D=64,DM=6144;
constexpr int NW=8,QBLK=32,QB=QBLK*NW,KVBLK=64,NQB=SEQ/QB;
constexpr int ATTN_UNIT_ROWS=QB;
__device__ __forceinline__ int crow(int r,int hi){return (r&3)+8*(r>>2)+4*hi;}
#define SBAR() __builtin_amdgcn_sched_barrier(0)
__device__ __forceinline__ void cmask(f32x16&p0,f32x16&p1,int jb,int qrel,int hi){
  const float NEG=-INFINITY; int kb=64*jb+4*hi;
  #pragma unroll
  for(int r=0;r<16;++r){int kv=kb+(r&3)+8*(r>>2); if(kv>qrel)p0[r]=NEG; if(kv+32>qrel)p1[r]=NEG;}
}

constexpr int NSLOT=3, SLOTB=8192;
constexpr int LDS_K=0, LDS_V=NSLOT*SLOTB, LDS_WS=2*NSLOT*SLOTB, LDS_OST=LDS_WS+NW*64*4, LDS_BYTES=LDS_OST+NW*4096;
constexpr float C2=0.125f*1.4426950408889634f;
__device__ __forceinline__ void glds16(const void*gsrc,unsigned lds_dst){unsigned keep;
  asm volatile("s_mov_b32 %0, m0\n\ts_mov_b32 m0, %2\n\ts_nop 0\n\tglobal_load_lds_dwordx4 %1, off\n\ts_mov_b32 m0, %0":"=&s"(keep):"v"(gsrc),"s"(lds_dst):"memory");}
__device__ __forceinline__ float max3f(float a,float b,float c){float r;asm("v_max3_f32 %0, %1, %2, %3":"=v"(r):"v"(a),"v"(b),"v"(c));return r;}
__device__ __forceinline__ float max2f(float a,float b){float r;asm("v_max_f32_e32 %0, %1, %2":"=v"(r):"v"(a),"v"(b));return r;}
__device__ __forceinline__ float fadd_s(float a,float b){float r;asm("v_add_f32_e32 %0, %1, %2":"=v"(r):"v"(a),"v"(b));return r;}
__device__ __forceinline__ float fsub_s(float a,float b){float r;asm("v_sub_f32_e32 %0, %1, %2":"=v"(r):"v"(a),"v"(b));return r;}
typedef float f32x2_t __attribute__((ext_vector_type(2))); typedef __bf16 bf16x2_t __attribute__((ext_vector_type(2)));
__device__ __forceinline__ unsigned cvtpk_s(float lo,float hi){f32x2_t v={lo,hi};bf16x2_t b=__builtin_convertvector(v,bf16x2_t);return __builtin_bit_cast(unsigned,b);}
#define WAIT_BAR(N) asm volatile("s_waitcnt vmcnt(" #N ") lgkmcnt(0)\n\ts_barrier":::"memory")

__device__ __forceinline__ void rmask(f32x16&p0,f32x16&p1,bool keep){
  const float NEG=-INFINITY;
  #pragma unroll
  for(int r=0;r<16;++r){ p0[r]=keep?p0[r]:NEG; p1[r]=keep?p1[r]:NEG; }
}
__device__ __forceinline__ float abias(int d){
  const int t1=1+((128-d)>>31);
  const int t4=(((d&3)-1)>>31)&(1+((512-d)>>31));
  const int t16=(((d&15)-1)>>31)&(1+((2048-d)>>31));
  const int m=(t1+t4+t16)&~(d>>31);
  return __builtin_amdgcn_logf((float)m);
}
__device__ __forceinline__ void amask(f32x16&p0,f32x16&p1,int dbase){
  #pragma unroll
  for(int r=0;r<16;++r){ int d=dbase-((r&3)+8*(r>>2)); asm volatile("":"+v"(d)); p0[r]+=abias(d); int d2=d-32; asm volatile("":"+v"(d2)); p1[r]+=abias(d2); }
}
__device__ __forceinline__ void qkt(f32x16&p0,f32x16&p1,const char*Kslot,const bf16x8*qr,const f32x16&negm,int r32,int hi){
  const char*kb=Kslot+hi*1024+r32*16;
  #pragma unroll
  for(int d0=0;d0<4;++d0){
    const bf16x8 b0=*reinterpret_cast<const bf16x8*>(kb+d0*2048);
    const bf16x8 b1=*reinterpret_cast<const bf16x8*>(kb+d0*2048+512);
    if(d0==0){p0=__builtin_amdgcn_mfma_f32_32x32x16_bf16(b0,qr[0],negm,0,0,0);p1=__builtin_amdgcn_mfma_f32_32x32x16_bf16(b1,qr[0],negm,0,0,0);}
    else{p0=__builtin_amdgcn_mfma_f32_32x32x16_bf16(b0,qr[d0],p0,0,0,0);p1=__builtin_amdgcn_mfma_f32_32x32x16_bf16(b1,qr[d0],p1,0,0,0);}}
}
typedef __attribute__((address_space(3))) const char* lds_cptr;
typedef short v4i16_t __attribute__((ext_vector_type(4)));
__device__ __forceinline__ void kload8(bf16x8*kf,lds_cptr kp){
  kf[0]=*(const __attribute__((address_space(3))) bf16x8*)(kp);      kf[1]=*(const __attribute__((address_space(3))) bf16x8*)(kp+512);
  kf[2]=*(const __attribute__((address_space(3))) bf16x8*)(kp+2048); kf[3]=*(const __attribute__((address_space(3))) bf16x8*)(kp+2560);
  kf[4]=*(const __attribute__((address_space(3))) bf16x8*)(kp+4096); kf[5]=*(const __attribute__((address_space(3))) bf16x8*)(kp+4608);
  kf[6]=*(const __attribute__((address_space(3))) bf16x8*)(kp+6144); kf[7]=*(const __attribute__((address_space(3))) bf16x8*)(kp+6656);
}
__device__ __forceinline__ void kload2(bf16x8*kf,lds_cptr kp,int j){ kf[2*j]=*(const __attribute__((address_space(3))) bf16x8*)(kp+j*2048); kf[2*j+1]=*(const __attribute__((address_space(3))) bf16x8*)(kp+j*2048+512); }
__device__ __forceinline__ s16x4 vtr(lds_cptr p){ return __builtin_bit_cast(s16x4,__builtin_amdgcn_ds_read_tr16_b64_v4i16((__attribute__((address_space(3))) v4i16_t*)p)); }
__device__ __forceinline__ float rowmax(const f32x16&p0,const f32x16&p1){
  float a=max3f(p0[0],p0[1],p1[0]),b=max3f(p0[2],p0[3],p1[1]);a=max3f(a,p1[2],p1[3]);
  #pragma unroll
  for(int r=4;r<16;r+=4){a=max3f(a,p0[r],p0[r+1]);b=max3f(b,p0[r+2],p0[r+3]);a=max3f(a,p1[r],p1[r+1]);b=max3f(b,p1[r+2],p1[r+3]);}
  const float m=max2f(a,b);
  auto rr=__builtin_amdgcn_permlane32_swap(__float_as_uint(m),__float_as_uint(m),false,false);
  return max2f(__uint_as_float(rr[0]),__uint_as_float(rr[1]));
}
__device__ __forceinline__ void pv(f32x16*o,int vb,bf16x8 pa0,bf16x8 pa1,bf16x8 pa2,bf16x8 pa3){
  #pragma unroll
  for(int d0=0;d0<2;++d0){s16x4 lo[4],hi[4];
    #pragma unroll
    for(int ks=0;ks<4;++ks){
      asm volatile("ds_read_b64_tr_b16 %0,%1 offset:%c2":"=&v"(lo[ks]):"v"(vb),"i"(d0*4096+ks*1024):"memory");
      asm volatile("ds_read_b64_tr_b16 %0,%1 offset:%c2":"=&v"(hi[ks]):"v"(vb),"i"(d0*4096+ks*1024+512):"memory");}
    asm volatile("s_waitcnt lgkmcnt(0)":::"memory");SBAR();
    #define PK(k) (bf16x8){lo[k][0],lo[k][1],lo[k][2],lo[k][3],hi[k][0],hi[k][1],hi[k][2],hi[k][3]}
    o[d0]=__builtin_amdgcn_mfma_f32_32x32x16_bf16(pa0,PK(0),o[d0],0,0,0);
    o[d0]=__builtin_amdgcn_mfma_f32_32x32x16_bf16(pa1,PK(1),o[d0],0,0,0);
    o[d0]=__builtin_amdgcn_mfma_f32_32x32x16_bf16(pa2,PK(2),o[d0],0,0,0);
    o[d0]=__builtin_amdgcn_mfma_f32_32x32x16_bf16(pa3,PK(3),o[d0],0,0,0);
    #undef PK
  }
}

#ifndef ATTN_STORE16
#define ATTN_STORE16(p,v) (*(u32x4*)(p)=(v))
#endif
template<int THRL,int MODE> __device__ __forceinline__ void attn_unit(int qb,int T0,const bf16*Q,const bf16*__restrict__ K,const bf16*__restrict__ V,void*Ov,int opitch,const unsigned long long*sel,char*shm){
  int tid=threadIdx.x; asm volatile("":"+v"(tid)); const int lane=tid&63,r32=lane&31,hi=lane>>5; const int wid=__builtin_amdgcn_readfirstlane(tid>>6);
  const int q0=qb*QB;
  const bf16*Qw=Q+(long)(q0+wid*QBLK)*DM;
  const bf16*Kh=K+(long)T0*KVBLK*DM,*Vh=V+(long)T0*KVBLK*DM;
  const unsigned lds0=(unsigned)(uintptr_t)shm;
  float*wsf=(float*)(shm+LDS_WS)+wid*64;
  const bf16*ksrc=Kh+(long)lane*DM+wid*8;
  const bf16*vsrc=Vh+(long)(16*(wid&3)+(lane>>2))*DM+(wid>>2)*32+(lane&3)*8;
  const unsigned kdst=lds0+LDS_K+wid*1024, vdst=lds0+LDS_V+wid*1024;
  #define DMA_K(t,slot) glds16(ksrc+(long)(t)*KVBLK*DM,(unsigned)__builtin_amdgcn_readfirstlane(kdst+(slot)))
  #define DMA_V(t,slot) glds16(vsrc+(long)(t)*KVBLK*DM,(unsigned)__builtin_amdgcn_readfirstlane(vdst+(slot)))
  const int vb0=(int)(lds0+LDS_V)+((lane>>4)&1)*32+(lane&3)*8+(4*hi+((lane&15)>>2))*64;
  const char*Kbase=shm+LDS_K; bf16x8 kf[8];
  const lds_cptr shm3=(lds_cptr)shm; const lds_cptr kp0=shm3+LDS_K+hi*1024+r32*16; const lds_cptr vp0=shm3+LDS_V+((lane>>4)&1)*32+(lane&3)*8+(4*hi+((lane&15)>>2))*64;
  const int NT=(q0+QB)/KVBLK-T0;
  DMA_K(0,0);DMA_V(0,0);DMA_K(1,SLOTB);
  bf16x8 qr[4];
  #pragma unroll
  for(int d0=0;d0<4;++d0)qr[d0]=*reinterpret_cast<const bf16x8*>(&Qw[(long)r32*DM+d0*16+hi*8]);
  float mhat=0.f,l_reg=0.f;f32x16 o[2];o[0]=f32x16{};o[1]=f32x16{};f32x16 negm=f32x16{};asm volatile("":"+v"(negm));
  const int qrel=wid*QBLK+r32;
  unsigned sel_lo=0u,sel_hi=0u; if(MODE==1){ const unsigned long long sv=sel[qrel]; sel_lo=(unsigned)sv; sel_hi=(unsigned)(sv>>32); }
  const int dq=q0+qrel-4*hi-T0*KVBLK;
  #define RKEEP(t) ((((t)>>2)<32?(sel_lo>>((t)>>2)):(sel_hi>>(((t)>>2)-32)))&1u)
  #define CMASK(P0,P1,t) do{ if(MODE==2){amask(P0,P1,dq-64*(t));} else {int jb_=(t)-(NT-4); if(jb_>=0)cmask(P0,P1,jb_,qrel,hi); else if(MODE==1)rmask(P0,P1,RKEEP(t)!=0u);} }while(0)
  bool resc=false;
  #define START(P0,P1) do{ const float rm=rowmax(P0,P1); resc=false; \
    { const float dl=(MODE==0)?rm:((rm>-3.0e38f)?rm:0.f); mhat=fadd_s(mhat,dl); \
      _Pragma("unroll") for(int r=0;r<16;++r){P0[r]=fsub_s(P0[r],dl);P1[r]=fsub_s(P1[r],dl);} \
      _Pragma("unroll") for(int r=0;r<16;++r)negm[r]=-mhat; asm volatile("":"+v"(negm)); } \
    _Pragma("unroll") for(int r=0;r<16;++r)P0[r]=__builtin_amdgcn_exp2f(P0[r]); }while(0)
  #define RESC() do{ if(resc){ asm volatile("s_waitcnt lgkmcnt(0)":::"memory"); \
      _Pragma("unroll") for(int d_=0;d_<2;++d_) _Pragma("unroll") for(int r=0;r<16;++r)o[d_][r]*=wsf[crow(r,hi)]; } }while(0)
  f32x16 pA0,pA1,pB0,pB1;
  int sl_prev=0,sl_cur=0,sl_next=SLOTB;
  #define ROT() do{sl_prev=sl_cur;sl_cur=sl_next;sl_next=(sl_next==(NSLOT-1)*SLOTB)?0:sl_next+SLOTB;}while(0)
  DMA_K(2,2*SLOTB);
  WAIT_BAR(3);
  qkt(pA0,pA1,Kbase,qr,negm,r32,hi);asm volatile("s_nop 15\n\ts_nop 7":"+v"(pA0),"+v"(pA1));CMASK(pA0,pA1,0);
  START(pA0,pA1);
  _Pragma("unroll") for(int r=0;r<16;++r)pA1[r]=__builtin_amdgcn_exp2f(pA1[r]);
  WAIT_BAR(0);
  DMA_K(3,0);DMA_V(1,SLOTB);
  ROT();
  kload8(kf,kp0+sl_cur);
  WAIT_BAR(2);
  s16x4 vlo[8],vhi[8]; u32x4 pw0,pw1,pw2,pw3;
  #define PKW(P,B) cvtpk_s(P[B],P[B+1])
  #define PAF(k) __builtin_bit_cast(bf16x8,pw##k)
  #define VFR(i) (bf16x8){vlo[i][0],vlo[i][1],vlo[i][2],vlo[i][3],vhi[i][0],vhi[i][1],vhi[i][2],vhi[i][3]}
  #define PIN(x) asm volatile("":"+v"(x))
  #define MX3(a,b,c) __builtin_fmaxf(__builtin_fmaxf((a),(b)),(c))
  #define GAPA(MF,A0,A1,A2,A3,W0,W1,PW) do{ MF; sacc+=A0; sacc+=A1; sacc+=A2; sacc+=A3; PIN(sacc); W0; W1; PIN(PW); SBAR(); }while(0)
  #define EX(v) __builtin_amdgcn_exp2f(v)
  #define GAPB(MF,X,B) do{ MF; X[B]=EX(X[B]); X[B+1]=EX(X[B+1]); X[B+2]=EX(X[B+2]); X[B+3]=EX(X[B+3]); PIN(X); SBAR(); }while(0)
  #define VRD(i) do{ vlo[i]=vtr(vp_+(((i)>>2)*4096+((i)&3)*1024)); vhi[i]=vtr(vp_+(((i)>>2)*4096+((i)&3)*1024+512)); }while(0)
  #define KRD(G,j) do{ if(G){ kload2(kf,kp0+sl_next,j); SBAR(); } }while(0)
  #define STEP(C0,C1,P0,P1,t,GK,GV,GL) do{ SBAR(); \
    const lds_cptr vp_=vp0+sl_prev; \
    VRD(0); SBAR(); float sacc=(P0[0]+P0[1]); \
    GAPA(C0=__builtin_amdgcn_mfma_f32_32x32x16_bf16(kf[0],qr[0],negm,0,0,0), P0[2],P0[3],P0[4],P0[5],     pw0[0]=PKW(P0,0), pw0[1]=PKW(P0,2), pw0); \
    VRD(4); SBAR(); GAPA(C1=__builtin_amdgcn_mfma_f32_32x32x16_bf16(kf[1],qr[0],negm,0,0,0), P0[6],P0[7],P0[8],P0[9],     pw0[2]=PKW(P0,4), pw0[3]=PKW(P0,6), pw0); \
    VRD(1); SBAR(); GAPA(C0=__builtin_amdgcn_mfma_f32_32x32x16_bf16(kf[2],qr[1],C0,0,0,0),   P0[10],P0[11],P0[12],P0[13], pw1[0]=PKW(P0,8), pw1[1]=PKW(P0,10), pw1); \
    VRD(5); SBAR(); GAPA(C1=__builtin_amdgcn_mfma_f32_32x32x16_bf16(kf[3],qr[1],C1,0,0,0),   P0[14],P0[15],P1[0],P1[1],   pw1[2]=PKW(P0,12),pw1[3]=PKW(P0,14), pw1); \
    VRD(2); SBAR(); GAPA(C0=__builtin_amdgcn_mfma_f32_32x32x16_bf16(kf[4],qr[2],C0,0,0,0),   P1[2],P1[3],P1[4],P1[5],     pw2[0]=PKW(P1,0), pw2[1]=PKW(P1,2), pw2); \
    VRD(6); SBAR(); GAPA(C1=__builtin_amdgcn_mfma_f32_32x32x16_bf16(kf[5],qr[2],C1,0,0,0),   P1[6],P1[7],P1[8],P1[9],     pw2[2]=PKW(P1,4), pw2[3]=PKW(P1,6), pw2); \
    VRD(3); SBAR(); GAPA(C0=__builtin_amdgcn_mfma_f32_32x32x16_bf16(kf[6],qr[3],C0,0,0,0),   P1[10],P1[11],P1[12],P1[13], pw3[0]=PKW(P1,8), pw3[1]=PKW(P1,10), pw3); \
    VRD(7); SBAR(); GAPA(C1=__builtin_amdgcn_mfma_f32_32x32x16_bf16(kf[7],qr[3],C1,0,0,0),   P1[14],P1[15],0.f,0.f,       pw3[2]=PKW(P1,12),pw3[3]=PKW(P1,14), pw3); \
    l_reg+=sacc; \
    if(GK){DMA_K((t)+3,sl_cur);} if(GV){DMA_V((t)+1,sl_next);} \
    CMASK(C0,C1,t); \
    { float a=MX3(C0[0],C0[1],C1[0]),b=MX3(C0[2],C0[3],C1[1]); a=MX3(a,C1[2],C1[3]); \
      _Pragma("unroll") for(int r=4;r<16;r+=4){a=MX3(a,C0[r],C0[r+1]);b=MX3(b,C0[r+2],C0[r+3]);a=MX3(a,C1[r],C1[r+1]);b=MX3(b,C1[r+2],C1[r+3]);} \
      float rm=__builtin_fmaxf(a,b); { auto rr=__builtin_amdgcn_permlane32_swap(__float_as_uint(rm),__float_as_uint(rm),false,false); rm=__builtin_fmaxf(__uint_as_float(rr[0]),__uint_as_float(rr[1])); } \
      resc=false; \
      if(__builtin_expect(__any(rm>(float)THRL),0)){ const float dl=__builtin_fmaxf(rm,0.f); mhat+=dl; \
        _Pragma("unroll") for(int r=0;r<16;++r){C0[r]-=dl;C1[r]-=dl;} \
        _Pragma("unroll") for(int r=0;r<16;++r)negm[r]=-mhat; asm volatile("":"+v"(negm)); \
        const float f=__builtin_amdgcn_exp2f(-dl); l_reg*=f; if(hi==0)wsf[r32]=f; resc=true; } } \
    SBAR(); \
    GAPB(o[0]=__builtin_amdgcn_mfma_f32_32x32x16_bf16(PAF(0),VFR(0),o[0],0,0,0), C0,0); \
    GAPB(o[1]=__builtin_amdgcn_mfma_f32_32x32x16_bf16(PAF(0),VFR(4),o[1],0,0,0), C0,4); \
    KRD(GL,0); GAPB(o[0]=__builtin_amdgcn_mfma_f32_32x32x16_bf16(PAF(1),VFR(1),o[0],0,0,0), C0,8); \
    KRD(GL,1); GAPB(o[1]=__builtin_amdgcn_mfma_f32_32x32x16_bf16(PAF(1),VFR(5),o[1],0,0,0), C0,12); \
    KRD(GL,2); GAPB(o[0]=__builtin_amdgcn_mfma_f32_32x32x16_bf16(PAF(2),VFR(2),o[0],0,0,0), C1,0); \
    KRD(GL,3); GAPB(o[1]=__builtin_amdgcn_mfma_f32_32x32x16_bf16(PAF(2),VFR(6),o[1],0,0,0), C1,4); \
    GAPB(o[0]=__builtin_amdgcn_mfma_f32_32x32x16_bf16(PAF(3),VFR(3),o[0],0,0,0), C1,8); \
    GAPB(o[1]=__builtin_amdgcn_mfma_f32_32x32x16_bf16(PAF(3),VFR(7),o[1],0,0,0), C1,12); \
    }while(0)
  int t=1;
  #undef CMASK
  #define CMASK(P0,P1,t) do{ if(MODE==2){amask(P0,P1,dq-64*(t));} else if(MODE==1){rmask(P0,P1,RKEEP(t)!=0u);} }while(0)
  for(;t+5<NT;t+=2){
    STEP(pB0,pB1,pA0,pA1,t,true,true,true);     WAIT_BAR(2); RESC(); ROT();
    STEP(pA0,pA1,pB0,pB1,t+1,true,true,true);   WAIT_BAR(2); RESC(); ROT();
  }
  #undef CMASK
  #define CMASK(P0,P1,t) do{ if(MODE==2){amask(P0,P1,dq-64*(t));} else {int jb_=(t)-(NT-4); if(jb_>=0)cmask(P0,P1,jb_,qrel,hi); else if(MODE==1)rmask(P0,P1,RKEEP(t)!=0u);} }while(0)
  #define ENDW(tt) do{ if((tt)+3<NT){WAIT_BAR(2);} else if((tt)+2<NT){WAIT_BAR(1);} else {WAIT_BAR(0);} }while(0)
  for(;t+1<NT;t+=2){
    STEP(pB0,pB1,pA0,pA1,t,(t+3<NT),(t+1<NT),(t+1<NT));       ENDW(t);   RESC(); ROT();
    STEP(pA0,pA1,pB0,pB1,t+1,(t+4<NT),(t+2<NT),(t+2<NT));     ENDW(t+1); RESC(); ROT();
  }
  STEP(pB0,pB1,pA0,pA1,NT-1,false,false,false); RESC();
  { float sacc=pB0[0]+pB0[1]; _Pragma("unroll") for(int r=2;r<16;++r)sacc+=pB0[r]; _Pragma("unroll") for(int r=0;r<16;++r)sacc+=pB1[r]; l_reg+=sacc;
    pw0=(u32x4){PKW(pB0,0),PKW(pB0,2),PKW(pB0,4),PKW(pB0,6)};pw1=(u32x4){PKW(pB0,8),PKW(pB0,10),PKW(pB0,12),PKW(pB0,14)};pw2=(u32x4){PKW(pB1,0),PKW(pB1,2),PKW(pB1,4),PKW(pB1,6)};pw3=(u32x4){PKW(pB1,8),PKW(pB1,10),PKW(pB1,12),PKW(pB1,14)};
    SBAR(); pv(o,vb0+sl_cur,PAF(0),PAF(1),PAF(2),PAF(3)); }
  #undef PKW
  #undef PAF
  #undef VFR
  #undef PIN
  #undef MX3
  #undef GAPA
  #undef GAPB
  #undef EX
  #undef VRD
  #undef KRD
  #undef STEP
  #undef ENDW
  {auto rr=__builtin_amdgcn_permlane32_swap(__float_as_uint(l_reg),__float_as_uint(l_reg),false,false);l_reg=__uint_as_float(rr[0])+__uint_as_float(rr[1]);}
  if(hi==0)wsf[32+r32]=l_reg;asm volatile("s_waitcnt lgkmcnt(0)":::"memory");
  float rli[16];
  #pragma unroll
  for(int r=0;r<16;++r)rli[r]=__builtin_amdgcn_rcpf(wsf[32+crow(r,hi)]);
  if(MODE==0){ float*Of=(float*)Ov+(long)(q0+wid*QBLK)*opitch;
    #pragma unroll
    for(int r=0;r<16;++r){const int orow=crow(r,hi);
      #pragma unroll
      for(int d0=0;d0<2;++d0)Of[(long)orow*opitch+d0*32+r32]=o[d0][r]*rli[r];} }
  else { bf16*Ow=(bf16*)Ov+(long)(q0+wid*QBLK)*opitch; bf16*stg=(bf16*)(shm+LDS_OST)+wid*2048;
    #pragma unroll
    for(int r=0;r<16;++r){const int orow=crow(r,hi);
      #pragma unroll
      for(int d0=0;d0<2;++d0)stg[orow*64+d0*32+r32]=__float2bfloat16(o[d0][r]*rli[r]);}
    asm volatile("s_waitcnt lgkmcnt(0)":::"memory");
    #pragma unroll
    for(int i=0;i<4;++i){const int row=i*8+(lane>>3),ch=lane&7; const u32x4 v=*(const u32x4*)(stg+row*64+ch*8); ATTN_STORE16(Ow+(long)row*opitch+ch*8,v);} }
  asm volatile("s_waitcnt lgkmcnt(0)\n\ts_barrier":::"memory");
  #undef DMA_K
  #undef DMA_V
  #undef CMASK
  #undef RKEEP
  #undef START
  #undef RESC
  #undef ROT
}
constexpr int ATTN_LDS_BYTES=LDS_BYTES;
#undef SBAR
#undef WAIT_BAR
}


constexpr int NWAVES = 8;
#ifndef MK_N_LAUNCHES
#define MK_N_LAUNCHES 1
#endif
constexpr int N_PHASES = 22;
static_assert(MK_N_LAUNCHES == 1 || MK_N_LAUNCHES == N_PHASES, "MK_N_LAUNCHES is 1 or 22");

constexpr int S_ = 16384, DM_ = 2048, INW = 6144, NEXP = 16, DEXP = 1024, DEPTH = 2, NROWBLK = 256  ;
constexpr int C_QA = 0, C_KA = 512, C_VA = 1024, C_QB = 1536, C_KB = 2048, C_VB = 2560, C_QC = 3072, C_KC = 4096, C_VC = 5120;
constexpr int MAXPOS = 2 * S_ + NEXP * 256;
constexpr float RMS_EPS = 1e-6f;

constexpr size_t MiB = 1u << 20;
constexpr size_t WS_CTL = 0, CTL_ZERO_BYTES = 1 * MiB;
constexpr size_t WS_MOD = 1 * MiB;
constexpr size_t WS_COS = 2 * MiB, WS_SIN = 4 * MiB;
constexpr size_t WS_EID = 6 * MiB;
constexpr size_t WS_WTS = WS_EID + 131072;
constexpr size_t WS_ROWTOK = WS_WTS + 131072;
constexpr size_t WS_ROWW = WS_ROWTOK + 163840;
constexpr size_t WS_CNT = WS_ROWW + 163840;
constexpr size_t WS_KMEAN = 8 * MiB;
constexpr size_t WS_WIN = 16 * MiB;
constexpr size_t WS_WOUT = 64 * MiB;
constexpr size_t WS_WGU = 80 * MiB;
constexpr size_t WS_WDN = 336 * MiB;
constexpr size_t WS_H = 464 * MiB;
constexpr size_t WS_PROJ = 528 * MiB;
constexpr size_t WS_MERGED = 720 * MiB;
constexpr size_t WS_T = 784 * MiB;
constexpr size_t WS_ACT = 912 * MiB;
constexpr size_t WS_XS = 984 * MiB;
constexpr size_t WS_Y = WS_PROJ;
constexpr size_t WS_END = 1128 * MiB;
static_assert(WS_XS + (size_t)MAXPOS * 2048 * 2 <= WS_END && WS_ACT + (size_t)MAXPOS * 1024 * 2 <= WS_XS && WS_CNT + 16384 <= WS_KMEAN, "d_ws map");
constexpr int CW_TMO = 0, CW_CODE = 1, CW_BAR = 4096;
constexpr int CW_DBG = 16384;

constexpr int RING_OFF = 0, RING_BYTES = 131072;
constexpr int LDSCTL_OFF = RING_BYTES, MISC_OFF = LDSCTL_OFF + 320;
constexpr int LT_SEGS = LDSCTL_OFF + 1024;
constexpr int LT_TOT = LT_SEGS + 128;
constexpr int LT_BASE = LT_TOT + 64;
constexpr int LT_CNT = LT_BASE + 64;
constexpr int LT_P2E = LT_CNT + 64;
constexpr int LT_POS = LT_P2E + 160;
constexpr int LDS_BYTES = 147456;
constexpr int ATT_SEL_OFF = 98304, ATT_KM_OFF = 100352;
static_assert(LT_POS + 512 <= LDS_BYTES && attn_body::ATTN_LDS_BYTES <= ATT_SEL_OFF && ATT_KM_OFF + 16384 <= RING_BYTES, "LDS map");

#define GAS __attribute__((address_space(1)))
#define LAS __attribute__((address_space(3)))
typedef unsigned short bf16;
typedef unsigned v4u __attribute__((ext_vector_type(4)));
typedef unsigned v2u __attribute__((ext_vector_type(2)));
typedef float f32x4 __attribute__((ext_vector_type(4)));
typedef short bf16x8 __attribute__((ext_vector_type(8)));
typedef GAS unsigned gu32;
#define RLX_AGENT __ATOMIC_RELAXED, __HIP_MEMORY_SCOPE_AGENT
#define LDS_WAIT() asm volatile("s_waitcnt lgkmcnt(0)" ::: "memory")
__device__ __forceinline__ unsigned f2bf(float f) { unsigned u = __builtin_bit_cast(unsigned, f); return (u + 0x7fffu + ((u >> 16) & 1u)) >> 16; }
__device__ __forceinline__ unsigned pk2(float lo, float hi) { return f2bf(lo) | (f2bf(hi) << 16); }
__device__ __forceinline__ float bflo(unsigned w) { return __builtin_bit_cast(float, w << 16); }
__device__ __forceinline__ float bfhi(unsigned w) { return __builtin_bit_cast(float, w & 0xffff0000u); }
__device__ __forceinline__ float wave_sum(float v) {
#pragma unroll
    for (int o = 1; o < 64; o <<= 1) v += __shfl_xor(v, o);
    return v;
}

#define XB_TMO      128
#define XB_XCNT(j)  (256  + 64 * (j))
#define XB_XSUB(j)  (1280 + 64 * (j))
#define XB_XGEN(j)  (2304 + 64 * (j))
#define XB_TOP      3328
#define XB_TOPGEN   3392
#define XCD_BAR_WORDS 3456
#define XB_SPIN_CAP (1u << 18)

__device__ __forceinline__ unsigned xb_ld(unsigned* p)              { return __hip_atomic_load(p, __ATOMIC_RELAXED, __HIP_MEMORY_SCOPE_AGENT); }
__device__ __forceinline__ unsigned xb_add(unsigned* p, unsigned v) { return __hip_atomic_fetch_add(p, v, __ATOMIC_RELAXED, __HIP_MEMORY_SCOPE_AGENT); }
__device__ __forceinline__ unsigned xb_xcc_id() { return (unsigned)__builtin_amdgcn_s_getreg((3 << 11) | 20) & 0xFu; }
#define XB_SPIN(cond, bar) do { unsigned _sp = 0; while (cond) { __builtin_amdgcn_s_sleep(1); \
    if ((++_sp & 255u) == 0u) { if (xb_ld(&(bar)[XB_TMO])) break; if (_sp > XB_SPIN_CAP) { atomicAdd(&(bar)[XB_TMO], 1u); break; } } } } while (0)

struct XcdBarrier {
    unsigned* bar; unsigned x;
    volatile LAS unsigned* st;
};

__device__ __forceinline__ XcdBarrier xcd_barrier_post(unsigned* bar, volatile LAS unsigned* st) {
    XcdBarrier b; b.bar = bar; b.x = xb_xcc_id(); b.st = st;
    if (threadIdx.x == 0) (void)xb_add(&bar[XB_XCNT(b.x)], 1u);
    return b;
}
__device__ __forceinline__ void xcd_barrier_complete(unsigned* bar, unsigned x, unsigned& nloc, unsigned& nx) {
    const unsigned G = gridDim.x * gridDim.y * gridDim.z;
    unsigned sum, cnt, mine, sp = 0u;
    for (;;) {
        sum = 0u; cnt = 0u; mine = 0u;
#pragma unroll
        for (unsigned j = 0; j < 16; ++j) { const unsigned c = xb_ld(&bar[XB_XCNT(j)]); sum += c; cnt += (c > 0u) ? 1u : 0u; mine = (j == x) ? c : mine; }
        if (sum == G) break;
        __builtin_amdgcn_s_sleep(1);
        if ((++sp & 255u) == 0u) { if (xb_ld(&bar[XB_TMO])) break; if (sp > XB_SPIN_CAP) { atomicAdd(&bar[XB_TMO], 1u); break; } }
    }
    nloc = mine > 0u ? mine : 1u; nx = cnt > 0u ? cnt : 1u;
}

__device__ __forceinline__ void xcd_barrier(const XcdBarrier& b) {
    asm volatile("s_waitcnt vmcnt(0)" ::: "memory");
    __syncthreads();
    if (threadIdx.x == 0) {
        unsigned* bar = b.bar; asm volatile("" : "+s"(bar));
        __builtin_amdgcn_s_waitcnt(0);
        unsigned nloc = b.st[0], nx = b.st[1];
        if (nloc == 0u) { xcd_barrier_complete(bar, b.x, nloc, nx); b.st[0] = nloc; b.st[1] = nx; }
        const unsigned old = xb_add(&bar[XB_XSUB(b.x)], 1u);
        const unsigned gen = old / nloc;
        if (old + 1u == (gen + 1u) * nloc) {
            __builtin_amdgcn_fence(__ATOMIC_RELEASE, "agent");
            asm volatile("s_waitcnt vmcnt(0)" ::: "memory");
            const unsigned og = xb_add(&bar[XB_TOP], 1u);
            const unsigned tg = og / nx;
            if (og + 1u == (tg + 1u) * nx) xb_add(&bar[XB_TOPGEN], 1u);
            else XB_SPIN(xb_ld(&bar[XB_TOPGEN]) == tg, bar);
            __builtin_amdgcn_fence(__ATOMIC_ACQUIRE, "agent");
            xb_add(&bar[XB_XGEN(b.x)], 1u);
            asm volatile("s_waitcnt vmcnt(0)" ::: "memory");
        } else {
            XB_SPIN(xb_ld(&bar[XB_XGEN(b.x)]) == gen, bar);
            __builtin_amdgcn_fence(__ATOMIC_ACQUIRE, "agent");
            asm volatile("s_waitcnt vmcnt(0)" ::: "memory");
        }
    }
    __syncthreads();
}


__device__ __forceinline__ int dest_row(int map, int n) {
    if (map == 1) { const int seg = n >> 9; const bool qk = (seg == 0) || (seg == 1) || (seg == 3) || (seg == 4) || (seg >= 6 && seg <= 9); if (!qk) return n; const int j = n & 63; return (n & ~63) + ((j < 32) ? 2 * j : 2 * (j - 32) + 1); }
    if (map == 2) return 8 * (n >> 2) + (n & 3);
    if (map == 3) return 8 * (n >> 2) + 4 + (n & 3);
    return n;
}
__device__ __forceinline__ void p0_transpose_item(const float* W, int K, int N, bf16* WT, int map, LAS float* scr, int item, int lane) {
    const int nblk = N / 32, kb = item / nblk, nb = item % nblk, k0 = 64 * kb, n0 = 32 * nb;
#pragma unroll 8
    for (int i = 0; i < 32; ++i) { const int kk = 2 * i + (lane >> 5); scr[kk * 33 + (lane & 31)] = W[(size_t)(k0 + kk) * N + n0 + (lane & 31)]; }
    LDS_WAIT(); asm volatile("" ::: "memory");
    const int c = lane & 7;
#pragma unroll
    for (int j = 0; j < 4; ++j) { const int n = (lane >> 3) + 8 * j; const LAS float* s = scr + (8 * c) * 33 + n;
        v4u o; o.x = pk2(s[0 * 33], s[1 * 33]); o.y = pk2(s[2 * 33], s[3 * 33]); o.z = pk2(s[4 * 33], s[5 * 33]); o.w = pk2(s[6 * 33], s[7 * 33]);
        *(GAS v4u*)(WT + (size_t)dest_row(map, n0 + n) * K + k0 + 8 * c) = o; }
    LDS_WAIT(); asm volatile("" ::: "memory");
}

struct Args { const void* in[20]; float* out; unsigned char* ws; int ph_lo, ph_hi; };

__global__ void __launch_bounds__(NWAVES * 64, 2) fwd(Args args) {
    extern __shared__ __attribute__((aligned(16))) unsigned char lds[];
    LAS unsigned char* const L = (LAS unsigned char*)lds;
    const int G = gridDim.x, bx = blockIdx.x;
    const int vcu = (G % 8 == 0) ? (bx % 8) * (G / 8) + bx / 8 : bx;
    const int NGW = G * NWAVES;
    typedef __attribute__((address_space(4))) const Args* kargp_t;
#define PHASE_BEGIN() \
    kargp_t ka = (kargp_t)__builtin_amdgcn_kernarg_segment_ptr(); asm volatile("" : "+s"(ka)); \
    unsigned char* const ws = ka->ws; \
    int tid = threadIdx.x; asm volatile("" : "+v"(tid)); \
    const int lane = tid & 63, wave = __builtin_amdgcn_readfirstlane(tid >> 6); const int gw = vcu * NWAVES + wave; (void)gw; (void)lane; (void)ws
#define KIN(T, k) ((const T*)ka->in[k])
    LAS int* const segs = (LAS int*)(L + LT_SEGS); LAS int* const tot = (LAS int*)(L + LT_TOT); LAS int* const basee = (LAS int*)(L + LT_BASE); LAS int* const cnt16 = (LAS int*)(L + LT_CNT);
    LAS unsigned char* const p2e = L + LT_P2E; LAS int* const postab = (LAS int*)(L + LT_POS);
    gu32* const ctl = (gu32*)(args.ws + WS_CTL);

    for (int u = threadIdx.x; u < (LDS_BYTES - LDSCTL_OFF) / 4; u += NWAVES * 64) ((LAS unsigned*)(L + LDSCTL_OFF))[u] = 0u;
    __syncthreads();
    const int lo = args.ph_lo, hi = args.ph_hi;
    XcdBarrier bar; bar.bar = (unsigned*)(ctl + CW_BAR); bar.x = 0; bar.st = nullptr;
    if (hi - lo > 1) bar = xcd_barrier_post((unsigned*)(ctl + CW_BAR), (volatile LAS unsigned*)(L + MISC_OFF) + 8);
#ifndef PHMASK
#define PHMASK 0xfff
#endif
#define IN(k) (lo <= (k) && (k) < hi)
#define INJ(j) ((((PHMASK) >> (j)) & 1) && IN(pb + (j)))
#define SEAM(k) do { if (IN(k) && IN((k) + 1)) xcd_barrier(bar); } while (0)

#define COMPUTE_SEGMENTS(myrb) do { \
        _Pragma("unroll") for (int q_ = 0; q_ < 2; ++q_) { const int e_ = 2 * wave + q_; int t_ = 0, p_ = 0; \
            _Pragma("unroll") for (int j_ = 0; j_ < 4; ++j_) { const int rb_ = lane + 64 * j_; const int c_ = CNT[rb_ * 16 + e_]; t_ += c_; p_ += (rb_ < (myrb)) ? c_ : 0; } \
            t_ = (int)wave_sum((float)t_); p_ = (int)wave_sum((float)p_); if (lane == 0) { tot[e_] = t_; basee[e_] = p_; } } \
        __syncthreads(); \
        if (tid == 0) { int s_ = 0; for (int e_ = 0; e_ < 16; ++e_) { segs[e_] = s_; s_ += (tot[e_] + 255) & ~255; } segs[16] = s_; } \
        __syncthreads(); \
        if (tid < 160) { const int r_ = tid * 256; int e_ = 0; for (int k_ = 1; k_ < 16; ++k_) if (r_ >= segs[k_]) e_ = k_; p2e[tid] = (unsigned char)e_; } \
        if (tid < 16) basee[tid] += segs[tid]; \
        __syncthreads(); } while (0)

    if (((PHMASK >> 10) & 1) && IN(0)) {
        PHASE_BEGIN();
        const float* const c_in = KIN(float, 1); const int* const positions = KIN(int, 2); const float* const w_ada = KIN(float, 3); const float* const b_ada = KIN(float, 4);
        const float* const w_in = KIN(float, 7); const float* const w_out = KIN(float, 8); const float* const w_gate = KIN(float, 14); const float* const w_up = KIN(float, 15); const float* const w_down = KIN(float, 16);
        float* const MOD = (float*)(ws + WS_MOD); float* const COS = (float*)(ws + WS_COS); float* const SIN = (float*)(ws + WS_SIN);
        bf16* const WIN = (bf16*)(ws + WS_WIN); bf16* const WOUT = (bf16*)(ws + WS_WOUT); bf16* const WGU = (bf16*)(ws + WS_WGU); bf16* const WDN = (bf16*)(ws + WS_WDN);
        for (int it = bx; it < 96; it += G) {
            const int l = it / 48, cg = it % 48, col = cg * 256 + lane * 4;
            const float* W = w_ada + ((size_t)l * 2048 + wave * 256) * 12288 + col; const float* cc = c_in + wave * 256;
            f32x4 a = (f32x4){0.f, 0.f, 0.f, 0.f};
#pragma unroll 8
            for (int k = 0; k < 256; ++k) { const float cv = cc[k]; const float sv = cv / (1.f + expf(-cv)); a += sv * *(const GAS f32x4*)(W + (size_t)k * 12288); }
            LAS f32x4* red = (LAS f32x4*)L; red[wave * 64 + lane] = a;
            __syncthreads();
            if (tid < 256) { float s = 0.f; const LAS float* rf = (const LAS float*)L;
#pragma unroll
                for (int w = 0; w < 8; ++w) s += rf[(w * 64 + (tid >> 2)) * 4 + (tid & 3)];
                MOD[l * 12288 + cg * 256 + tid] = s + b_ada[l * 12288 + cg * 256 + tid]; }
            __syncthreads();
        }
        { LAS float* scr = (LAS float*)(L + RING_OFF + wave * 16384);
          constexpr int I_IN = 2 * 32 * 192, I_OUT = 2 * 32 * 64, I_G = 32 * 32 * 32, I_D = 32 * 16 * 64, NITEMS = I_IN + I_OUT + 2 * I_G + I_D;
          for (int it = gw; it < NITEMS; it += NGW) {
              int r = it;
              if (r < I_IN) { const int l = r / 6144; p0_transpose_item(w_in + (size_t)l * 2048 * 6144, 2048, 6144, WIN + (size_t)l * 6144 * 2048, 1, scr, r % 6144, lane); continue; } r -= I_IN;
              if (r < I_OUT) { const int l = r / 2048; p0_transpose_item(w_out + (size_t)l * 2048 * 2048, 2048, 2048, WOUT + (size_t)l * 2048 * 2048, 0, scr, r % 2048, lane); continue; } r -= I_OUT;
              if (r < I_G) { const int mt = r / 1024; p0_transpose_item(w_gate + (size_t)mt * 2048 * 1024, 2048, 1024, WGU + (size_t)mt * 2048 * 2048, 2, scr, r % 1024, lane); continue; } r -= I_G;
              if (r < I_G) { const int mt = r / 1024; p0_transpose_item(w_up + (size_t)mt * 2048 * 1024, 2048, 1024, WGU + (size_t)mt * 2048 * 2048, 3, scr, r % 1024, lane); continue; } r -= I_G;
              { const int mt = r / 1024; p0_transpose_item(w_down + (size_t)mt * 1024 * 2048, 1024, 2048, WDN + (size_t)mt * 2048 * 1024, 0, scr, r % 1024, lane); }
          } }
        for (int idx = (vcu * NWAVES * 64 + tid); idx < S_ * 32; idx += G * NWAVES * 64) {
            const int pi = idx >> 5, i = idx & 31; const float inv = (float)exp2(-(double)i * (13.287712379549449 / 32.0)); const float ang = (float)positions[pi] * inv;
            COS[idx] = (float)cos((double)ang); SIN[idx] = (float)sin((double)ang); }
    }
    SEAM(0);

    for (int l = 0; l < DEPTH; ++l) {
        const int pb = 1 + 10 * l;
        const float lam_init = (l == 0) ? 0.2f : 0.35550906759f;
        if (INJ(0)) {
            PHASE_BEGIN();
            const float* const x_in = KIN(float, 0); const float* const g_attn = KIN(float, 5); float* const xbuf = ka->out;
            const float* const MOD = (const float*)(ws + WS_MOD); const float* const mod = MOD + l * 12288; bf16* const HB = (bf16*)(ws + WS_H); const bf16* const YB = (const bf16*)(ws + WS_Y);
            f32x4 cA[8], cB[8], cG[8];
#pragma unroll
            for (int j = 0; j < 8; ++j) { const int c4 = lane + 64 * j; const f32x4 g = ((const f32x4*)(g_attn + l * 2048))[c4]; const f32x4 sc = ((const f32x4*)(mod + 2048))[c4];
                cA[j] = g * (1.f + sc); cB[j] = ((const f32x4*)(mod + 0))[c4]; cG[j] = (l > 0) ? ((const f32x4*)(MOD + (l - 1) * 12288 + 10240))[c4] : (f32x4){0.f, 0.f, 0.f, 0.f}; }
            const float* xsrc = (l == 0) ? x_in : xbuf;
            for (int row = gw; row < S_; row += NGW) {
                f32x4 v[8];
#pragma unroll
                for (int j = 0; j < 8; ++j) v[j] = ((const GAS f32x4*)(xsrc + (size_t)row * 2048))[lane + 64 * j];
                if (l > 0) {
#pragma unroll
                    for (int j = 0; j < 8; ++j) { const v2u a = ((const GAS v2u*)(YB + (size_t)(2 * row) * 2048))[lane + 64 * j], b = ((const GAS v2u*)(YB + (size_t)(2 * row + 1) * 2048))[lane + 64 * j];
                        const f32x4 ys = (f32x4){bflo(a.x) + bflo(b.x), bfhi(a.x) + bfhi(b.x), bflo(a.y) + bflo(b.y), bfhi(a.y) + bfhi(b.y)};
                        v[j] += cG[j] * ys; ((GAS f32x4*)(xbuf + (size_t)row * 2048))[lane + 64 * j] = v[j]; }
                }
                float ss = 0.f;
#pragma unroll
                for (int j = 0; j < 8; ++j) ss += (v[j].x * v[j].x + v[j].y * v[j].y) + (v[j].z * v[j].z + v[j].w * v[j].w);
                const float rs = 1.f / sqrtf(wave_sum(ss) * (1.f / 2048.f) + RMS_EPS);
#pragma unroll
                for (int j = 0; j < 8; ++j) { const f32x4 o = v[j] * rs * cA[j] + cB[j]; v2u w; w.x = pk2(o.x, o.y); w.y = pk2(o.z, o.w); ((GAS v2u*)(HB + (size_t)row * 2048))[lane + 64 * j] = w; }
            }
        }
        SEAM(pb + 0);
        if (INJ(1)) {
            PHASE_BEGIN();
            bf16* const HB = (bf16*)(ws + WS_H); bf16* const WIN = (bf16*)(ws + WS_WIN); bf16* const PROJ = (bf16*)(ws + WS_PROJ); const float* const COS = (const float*)(ws + WS_COS); const float* const SIN = (const float*)(ws + WS_SIN);
            pg8::DenseSched Sd; Sd.init(HB, WIN + (size_t)l * 6144 * 2048, S_, INW, 2048, G, bx);
            pg8::EpiProj E{PROJ, COS, SIN, attn_body::C2};
            pg8::gemm_phase<pg8::EpiProj, pg8::DenseSched, true, true>(L + RING_OFF, 2048, Sd, E);
        }
        SEAM(pb + 1);
        if (INJ(2)) {
            PHASE_BEGIN();
            const bf16* const PROJ = (const bf16*)(ws + WS_PROJ); float* const KMEAN = (float*)(ws + WS_KMEAN);
            for (int t = gw; t < 512; t += NGW) { const int h = t >> 6, j = t & 63; const int rg = lane >> 3, ch = lane & 7;
                float a[8];
#pragma unroll
                for (int e = 0; e < 8; ++e) a[e] = 0.f;
                for (int it = 0; it < 32; ++it) { const v4u w = *(const GAS v4u*)(PROJ + (size_t)(256 * j + 8 * it + rg) * 6144 + C_KB + 64 * h + 8 * ch);
                    a[0] += bflo(w.x); a[1] += bfhi(w.x); a[2] += bflo(w.y); a[3] += bfhi(w.y); a[4] += bflo(w.z); a[5] += bfhi(w.z); a[6] += bflo(w.w); a[7] += bfhi(w.w); }
#pragma unroll
                for (int e = 0; e < 8; ++e) { a[e] += __shfl_xor(a[e], 8); a[e] += __shfl_xor(a[e], 16); a[e] += __shfl_xor(a[e], 32); }
                if (lane < 8) {
#pragma unroll
                    for (int e = 0; e < 8; ++e) KMEAN[(size_t)(h * 64 + j) * 64 + 8 * lane + e] = a[e] * (1.f / 256.f); }
            }
        }
        SEAM(pb + 2);
        if (INJ(3)) {
            PHASE_BEGIN();
            const bf16* const PROJ = (const bf16*)(ws + WS_PROJ); const float* const KMEAN = (const float*)(ws + WS_KMEAN); bf16* const MERGED = (bf16*)(ws + WS_MERGED); float* const TB = (float*)(ws + WS_T);
            char* const shm = (char*)lds + RING_OFF;
            for (int vc = vcu; vc < 256; vc += G) {
#if !defined(NO_ATT_C)
                { const int bhv = vc >> 3, hd = bhv >> 2, mp = (bhv >> 1) & 1, vh = bhv & 1, s = vc & 7;
                  const attn_body::bf16* Qp = (const attn_body::bf16*)PROJ + C_QC + hd * 128 + mp * 64; const attn_body::bf16* Kp = (const attn_body::bf16*)PROJ + C_KC + hd * 128 + mp * 64;
                  const attn_body::bf16* Vp = (const attn_body::bf16*)PROJ + C_VC + hd * 128 + vh * 64; float* Op = TB + (size_t)mp * S_ * 1024 + hd * 128 + vh * 64;
                  for (int i = 7; i >= 0; --i) { const int qb = 16 * (i >> 1) + ((i & 1) ? 15 - s : s);
                      attn_body::attn_unit<8, 0>(qb, 0, Qp, Kp, Vp, (void*)Op, 1024, nullptr, shm); } }
#endif
#if !defined(NO_ATT_B)
                { const int hd = vc >> 5, ii = vc & 31;
                  const attn_body::bf16* Qp = (const attn_body::bf16*)PROJ + C_QB + hd * 64; const attn_body::bf16* Kp = (const attn_body::bf16*)PROJ + C_KB + hd * 64; const attn_body::bf16* Vp = (const attn_body::bf16*)PROJ + C_VB + hd * 64;
                  for (int i = 0; i < 2; ++i) { const int qb = i ? ii : 63 - ii;
                      { int st = threadIdx.x; asm volatile("" : "+v"(st));
                        LAS float* km = (LAS float*)(L + ATT_KM_OFF); LAS unsigned long long* selt = (LAS unsigned long long*)(L + ATT_SEL_OFF);
                        for (int k4 = st; k4 < qb * 16; k4 += NWAVES * 64) ((LAS f32x4*)km)[k4] = ((const GAS f32x4*)(KMEAN + (size_t)hd * 64 * 64))[k4];
                        const int q = st >> 1, dh = st & 1; float qf[32];
                        { const bf16* qrow = PROJ + (size_t)(qb * 256 + q) * 6144 + C_QB + hd * 64 + dh * 32;
#pragma unroll
                          for (int c8 = 0; c8 < 4; ++c8) { const v4u w = *(const GAS v4u*)(qrow + 8 * c8); qf[8 * c8 + 0] = bflo(w.x); qf[8 * c8 + 1] = bfhi(w.x); qf[8 * c8 + 2] = bflo(w.y); qf[8 * c8 + 3] = bfhi(w.y);
                              qf[8 * c8 + 4] = bflo(w.z); qf[8 * c8 + 5] = bfhi(w.z); qf[8 * c8 + 6] = bflo(w.w); qf[8 * c8 + 7] = bfhi(w.w); } }
                        __syncthreads();
                        float b0 = -INFINITY, b1 = -INFINITY, b2 = -INFINITY; int i0 = -1, i1 = -1, i2 = -1;
                        for (int j = 0; j < qb; ++j) { const LAS f32x4* kr = (const LAS f32x4*)(km + j * 64 + dh * 32); float g = 0.f;
#pragma unroll
                            for (int c4 = 0; c4 < 8; ++c4) { const f32x4 kv = kr[c4]; g = fmaf(qf[4 * c4 + 0], kv.x, g); g = fmaf(qf[4 * c4 + 1], kv.y, g); g = fmaf(qf[4 * c4 + 2], kv.z, g); g = fmaf(qf[4 * c4 + 3], kv.w, g); }
                            g += __shfl_xor(g, 1);
                            if (g > b0) { b2 = b1; i2 = i1; b1 = b0; i1 = i0; b0 = g; i0 = j; } else if (g > b1) { b2 = b1; i2 = i1; b1 = g; i1 = j; } else if (g > b2) { b2 = g; i2 = j; } }
                        unsigned long long m = 0ull; if (i0 >= 0) m |= 1ull << i0; if (i1 >= 0) m |= 1ull << i1; if (i2 >= 0) m |= 1ull << i2;
                        if (dh == 0) selt[q] = m;
                        __syncthreads(); }
                      attn_body::attn_unit<8, 1>(qb, 0, Qp, Kp, Vp, (void*)(MERGED + 512 + hd * 64), 2048, (const unsigned long long*)((char*)lds + ATT_SEL_OFF), shm); } }
#endif
#if !defined(NO_ATT_A)
                { const int hd = vc >> 5, ii = vc & 31;
                  const attn_body::bf16* Qp = (const attn_body::bf16*)PROJ + C_QA + hd * 64; const attn_body::bf16* Kp = (const attn_body::bf16*)PROJ + C_KA + hd * 64; const attn_body::bf16* Vp = (const attn_body::bf16*)PROJ + C_VA + hd * 64;
                  for (int i = 0; i < 2; ++i) { const int qb = i ? ii : 63 - ii; const int T0 = (qb > 8) ? 4 * (qb - 8) : 0;
                      attn_body::attn_unit<8, 2>(qb, T0, Qp, Kp, Vp, (void*)(MERGED + hd * 64), 2048, nullptr, shm); } }
#endif
            }
        }
        SEAM(pb + 3);
        if (INJ(4)) {
            PHASE_BEGIN();
            const float* const lam_q1 = KIN(float, 9); const float* const lam_k1 = KIN(float, 10); const float* const lam_q2 = KIN(float, 11); const float* const lam_k2 = KIN(float, 12); const float* const g_sub = KIN(float, 13);
            const float* const TB = (const float*)(ws + WS_T); bf16* const MERGED = (bf16*)(ws + WS_MERGED);
            const float d1 = wave_sum(lam_q1[l * 64 + lane] * lam_k1[l * 64 + lane]), d2 = wave_sum(lam_q2[l * 64 + lane] * lam_k2[l * 64 + lane]);
            const float lam = expf(d1) - expf(d2) + lam_init;
            const f32x4 gs = ((const f32x4*)(g_sub + l * 128))[lane & 31]; const float osc = 1.f - lam_init;
            for (int row = gw; row < S_; row += NGW) {
#pragma unroll
                for (int j = 0; j < 4; ++j) { const f32x4 a = ((const GAS f32x4*)(TB + (size_t)row * 1024))[lane + 64 * j], b = ((const GAS f32x4*)(TB + (size_t)(S_ + row) * 1024))[lane + 64 * j];
                    const f32x4 v = a - lam * b; float ss = (v.x * v.x + v.y * v.y) + (v.z * v.z + v.w * v.w);
                    ss += __shfl_xor(ss, 1); ss += __shfl_xor(ss, 2); ss += __shfl_xor(ss, 4); ss += __shfl_xor(ss, 8); ss += __shfl_xor(ss, 16);
                    const float rs = 1.f / sqrtf(ss * (1.f / 128.f) + RMS_EPS); const f32x4 o = v * rs * gs * osc;
                    v2u w; w.x = pk2(o.x, o.y); w.y = pk2(o.z, o.w); ((GAS v2u*)(MERGED + (size_t)row * 2048 + 1024))[lane + 64 * j] = w; }
            }
        }
        SEAM(pb + 4);
        if (INJ(5)) {
            PHASE_BEGIN();
            const float* const x_in = KIN(float, 0); float* const xbuf = ka->out; const float* const mod = (const float*)(ws + WS_MOD) + l * 12288;
            bf16* const MERGED = (bf16*)(ws + WS_MERGED); bf16* const WOUT = (bf16*)(ws + WS_WOUT);
            pg8::DenseSched Sd; Sd.init(MERGED, WOUT + (size_t)l * 2048 * 2048, S_, 2048, 2048, G, bx);
            pg8::EpiGateRes E{(l == 0) ? x_in : (const float*)xbuf, xbuf, mod + 4096};
            pg8::gemm_phase<pg8::EpiGateRes, pg8::DenseSched, true, true>(L + RING_OFF, 2048, Sd, E);
        }
        SEAM(pb + 5);
        if (INJ(6)) {
            PHASE_BEGIN();
            const float* const g_mlp = KIN(float, 6); const float* const w_router = KIN(float, 17); const float* const b_router = KIN(float, 18); const float* const xbuf = ka->out;
            const float* const mod = (const float*)(ws + WS_MOD) + l * 12288; bf16* const HB = (bf16*)(ws + WS_H);
            int* const EID = (int*)(ws + WS_EID); float* const WTS = (float*)(ws + WS_WTS); int* const CNT = (int*)(ws + WS_CNT);
            LAS float* const RW = (LAS float*)L;
            for (int idx = tid; idx < 32768; idx += NWAVES * 64) RW[(idx & 15) * 2048 + (idx >> 4)] = w_router[idx];
            f32x4 cA[8], cB[8];
#pragma unroll
            for (int j = 0; j < 8; ++j) { const int c4 = lane + 64 * j; const f32x4 g = ((const f32x4*)(g_mlp + l * 2048))[c4]; const f32x4 sc = ((const f32x4*)(mod + 8192))[c4];
                cA[j] = g * (1.f + sc); cB[j] = ((const f32x4*)(mod + 6144))[c4]; }
            float br[16];
#pragma unroll
            for (int e = 0; e < 16; ++e) br[e] = b_router[e];
            for (int rb = bx; rb < NROWBLK; rb += G) {
                if (tid < 16) cnt16[tid] = 0;
                __syncthreads();
                for (int i = 0; i < 8; ++i) { const int row = 64 * rb + 8 * wave + i;
                    f32x4 v[8]; float ss = 0.f;
#pragma unroll
                    for (int j = 0; j < 8; ++j) { v[j] = ((const GAS f32x4*)(xbuf + (size_t)row * 2048))[lane + 64 * j]; ss += (v[j].x * v[j].x + v[j].y * v[j].y) + (v[j].z * v[j].z + v[j].w * v[j].w); }
                    const float rs = 1.f / sqrtf(wave_sum(ss) * (1.f / 2048.f) + RMS_EPS);
                    float p[16];
#pragma unroll
                    for (int e = 0; e < 16; ++e) p[e] = 0.f;
#pragma unroll
                    for (int j = 0; j < 8; ++j) { const f32x4 o = v[j] * rs * cA[j] + cB[j]; v2u w; w.x = pk2(o.x, o.y); w.y = pk2(o.z, o.w); ((GAS v2u*)(HB + (size_t)row * 2048))[lane + 64 * j] = w;
#pragma unroll
                        for (int e = 0; e < 16; ++e) { const f32x4 w4 = ((const LAS f32x4*)(RW + e * 2048))[lane + 64 * j]; p[e] += (o.x * w4.x + o.y * w4.y) + (o.z * w4.z + o.w * w4.w); } }
#pragma unroll
                    for (int e = 0; e < 16; ++e) p[e] = wave_sum(p[e]);
                    float sg[16], sv[16];
#pragma unroll
                    for (int e = 0; e < 16; ++e) { sv[e] = 1.f / (1.f + expf(-p[e])); sg[e] = sv[e] + br[e]; }
                    float gsc[4];
#pragma unroll
                    for (int g4 = 0; g4 < 4; ++g4) { const float a = sg[4 * g4], b = sg[4 * g4 + 1], c = sg[4 * g4 + 2], d = sg[4 * g4 + 3];
                        const float h1 = fmaxf(a, b), l1 = fminf(a, b), h2 = fmaxf(c, d), l2 = fminf(c, d); gsc[g4] = fmaxf(h1, h2) + fmaxf(fminf(h1, h2), fmaxf(l1, l2)); }
                    int gi = 0; float gb = gsc[0];
#pragma unroll
                    for (int g4 = 1; g4 < 4; ++g4) if (gsc[g4] > gb) { gb = gsc[g4]; gi = g4; }
                    float cd[4], cs[4];
#pragma unroll
                    for (int k = 0; k < 4; ++k) { cd[k] = (gi == 0) ? sg[k] : (gi == 1) ? sg[4 + k] : (gi == 2) ? sg[8 + k] : sg[12 + k]; cs[k] = (gi == 0) ? sv[k] : (gi == 1) ? sv[4 + k] : (gi == 2) ? sv[8 + k] : sv[12 + k]; }
                    int l0 = 0; float v0 = cd[0], s0 = cs[0];
#pragma unroll
                    for (int k = 1; k < 4; ++k) if (cd[k] > v0) { v0 = cd[k]; l0 = k; s0 = cs[k]; }
                    int l1i = -1; float v1 = -INFINITY, s1 = 0.f;
#pragma unroll
                    for (int k = 0; k < 4; ++k) if (k != l0 && cd[k] > v1) { v1 = cd[k]; l1i = k; s1 = cs[k]; }
                    const int e0 = 4 * gi + l0, e1 = 4 * gi + l1i; const float wsum = s0 + s1;
                    if (lane == 0) { EID[2 * row] = e0; EID[2 * row + 1] = e1; WTS[2 * row] = s0 / wsum; WTS[2 * row + 1] = s1 / wsum; atomicAdd((int*)(cnt16 + e0), 1); atomicAdd((int*)(cnt16 + e1), 1); }
                }
                __syncthreads();
                if (tid < 16) CNT[rb * 16 + tid] = cnt16[tid];
                __syncthreads();
            }
        }
        SEAM(pb + 6);
        if (INJ(7)) {
            PHASE_BEGIN();
            const bf16* const HB = (const bf16*)(ws + WS_H); bf16* const XS = (bf16*)(ws + WS_XS);
            const int* const EID = (const int*)(ws + WS_EID); const float* const WTS = (const float*)(ws + WS_WTS); int* const ROWTOK = (int*)(ws + WS_ROWTOK); float* const ROWW = (float*)(ws + WS_ROWW); const int* const CNT = (const int*)(ws + WS_CNT);
            for (int rb = bx; rb < NROWBLK; rb += G) {
                COMPUTE_SEGMENTS(rb);
                if (wave == 0) { const int row = 64 * rb + lane; const int e0 = EID[2 * row], e1 = EID[2 * row + 1]; int p0 = 0, p1 = 0;
                    const unsigned long long lt = (1ull << lane) - 1ull;
                    for (int e = 0; e < 16; ++e) { const unsigned long long m0 = __ballot(e0 == e), m1 = __ballot(e1 == e); const int r = __popcll(m0 & lt) + __popcll(m1 & lt);
                        if (e0 == e) p0 = basee[e] + r; if (e1 == e) p1 = basee[e] + r; }
                    postab[2 * lane] = p0; postab[2 * lane + 1] = p1;
                    ROWTOK[p0] = 2 * row; ROWTOK[p1] = 2 * row + 1; ROWW[p0] = WTS[2 * row]; ROWW[p1] = WTS[2 * row + 1]; }
                __syncthreads();
                for (int i = 0; i < 8; ++i) { const int r = 8 * wave + i, row = 64 * rb + r; const int p0 = postab[2 * r], p1 = postab[2 * r + 1];
#pragma unroll
                    for (int c = 0; c < 4; ++c) { const v4u w = ((const GAS v4u*)(HB + (size_t)row * 2048))[lane + 64 * c]; ((GAS v4u*)(XS + (size_t)p0 * 2048))[lane + 64 * c] = w; ((GAS v4u*)(XS + (size_t)p1 * 2048))[lane + 64 * c] = w; } }
                if (rb < 16) { const int pbeg = segs[rb] + tot[rb], pend = segs[rb + 1];
                    for (int p = pbeg + tid; p < pend; p += NWAVES * 64) { ROWTOK[p] = -1; ROWW[p] = 0.f; } }
                __syncthreads();
            }
        }
        SEAM(pb + 7);
        if (INJ(8)) {
            PHASE_BEGIN();
            const int* const CNT = (const int*)(ws + WS_CNT); bf16* const XS = (bf16*)(ws + WS_XS); bf16* const WGU = (bf16*)(ws + WS_WGU); bf16* const ACT = (bf16*)(ws + WS_ACT);
            COMPUTE_SEGMENTS(0);
            pg8::MoeSched Sm; Sm.init(XS, WGU + (size_t)l * 16 * 2048 * 2048, segs[16], 2048, 2048, (size_t)2048 * 2048 * 2, (const PG8_LAS unsigned char*)p2e, G, bx);
            pg8::EpiSwiglu E{ACT};
            pg8::gemm_phase<pg8::EpiSwiglu, pg8::MoeSched, true, true>(L + RING_OFF, 2048, Sm, E);
        }
        SEAM(pb + 8);
        if (INJ(9)) {
            PHASE_BEGIN();
            const int* const CNT = (const int*)(ws + WS_CNT); bf16* const ACT = (bf16*)(ws + WS_ACT); bf16* const WDN = (bf16*)(ws + WS_WDN); bf16* const YB = (bf16*)(ws + WS_Y);
            const int* const ROWTOK = (const int*)(ws + WS_ROWTOK); const float* const ROWW = (const float*)(ws + WS_ROWW);
            COMPUTE_SEGMENTS(0);
            pg8::MoeSched Sm; Sm.init(ACT, WDN + (size_t)l * 16 * 2048 * 1024, segs[16], 2048, 1024, (size_t)2048 * 1024 * 2, (const PG8_LAS unsigned char*)p2e, G, bx);
            pg8::EpiDown E{YB, ROWTOK, ROWW};
            pg8::gemm_phase<pg8::EpiDown, pg8::MoeSched, true, true>(L + RING_OFF, 1024, Sm, E);
        }
        SEAM(pb + 9);
    }
    if (((PHMASK >> 11) & 1) && IN(21)) {
        PHASE_BEGIN();
        const float* const g_final = KIN(float, 19); float* const xbuf = ka->out; const float* const MOD = (const float*)(ws + WS_MOD); const bf16* const YB = (const bf16*)(ws + WS_Y);
        f32x4 cA[8], cG[8];
#pragma unroll
        for (int j = 0; j < 8; ++j) { const int c4 = lane + 64 * j; cA[j] = ((const f32x4*)g_final)[c4]; cG[j] = ((const f32x4*)(MOD + 12288 + 10240))[c4]; }
        for (int row = gw; row < S_; row += NGW) {
            f32x4 v[8]; float ss = 0.f;
#pragma unroll
            for (int j = 0; j < 8; ++j) { v[j] = ((const GAS f32x4*)(xbuf + (size_t)row * 2048))[lane + 64 * j];
                const v2u a = ((const GAS v2u*)(YB + (size_t)(2 * row) * 2048))[lane + 64 * j], b = ((const GAS v2u*)(YB + (size_t)(2 * row + 1) * 2048))[lane + 64 * j];
                const f32x4 ys = (f32x4){bflo(a.x) + bflo(b.x), bfhi(a.x) + bfhi(b.x), bflo(a.y) + bflo(b.y), bfhi(a.y) + bfhi(b.y)};
                v[j] += cG[j] * ys; ss += (v[j].x * v[j].x + v[j].y * v[j].y) + (v[j].z * v[j].z + v[j].w * v[j].w); }
            const float rs = 1.f / sqrtf(wave_sum(ss) * (1.f / 2048.f) + RMS_EPS);
#pragma unroll
            for (int j = 0; j < 8; ++j) ((GAS f32x4*)(xbuf + (size_t)row * 2048))[lane + 64 * j] = v[j] * rs * cA[j];
        }
    }
#undef IN
#undef INJ
#undef PHASE_BEGIN
#undef KIN
#undef SEAM
#undef COMPUTE_SEGMENTS
}

extern "C" void kernel_launch(void* const* d_in, const int* in_sizes, int n_in, void* d_out, int out_size, void* d_ws, size_t ws_size, hipStream_t stream) {
    static int grid = 0;
    if (grid == 0) {
        if (n_in != 20 || in_sizes[0] != S_ * DM_ || out_size != S_ * DM_ || ws_size < WS_END) { fprintf(stderr, "kernel_launch: unexpected shapes or workspace (%d inputs, in0 %d, out %d, ws %zu); nothing launched\n", n_in, n_in > 0 ? in_sizes[0] : -1, out_size, ws_size); grid = -1; return; }
        int dev = 0, cus = 0, per_cu = 0;
        if (hipGetDevice(&dev) != hipSuccess || hipDeviceGetAttribute(&cus, hipDeviceAttributeMultiprocessorCount, dev) != hipSuccess) { grid = -1; return; }
        if (hipFuncSetAttribute((const void*)fwd, hipFuncAttributeMaxDynamicSharedMemorySize, LDS_BYTES) != hipSuccess) { fprintf(stderr, "kernel_launch: hipFuncSetAttribute failed\n"); grid = -1; return; }
        if (hipOccupancyMaxActiveBlocksPerMultiprocessor(&per_cu, (const void*)fwd, NWAVES * 64, LDS_BYTES) != hipSuccess || per_cu < 1) fprintf(stderr, "kernel_launch: occupancy query reports %d blocks per CU\n", per_cu);
        (void)hipGetLastError();
        grid = cus;
    }
    if (grid < 0) return;
    if (hipMemsetAsync((char*)d_ws + WS_CTL, 0, CTL_ZERO_BYTES, stream) != hipSuccess) return;
    Args a{};
    for (int i = 0; i < 20; ++i) a.in[i] = d_in[i];
    a.out = (float*)d_out; a.ws = (unsigned char*)d_ws;
    if (MK_N_LAUNCHES == 1) { a.ph_lo = 0; a.ph_hi = N_PHASES; hipLaunchKernelGGL(fwd, dim3(grid), dim3(NWAVES * 64), LDS_BYTES, stream, a); }
    else for (int p = 0; p < N_PHASES; ++p) { a.ph_lo = p; a.ph_hi = p + 1; hipLaunchKernelGGL(fwd, dim3(grid), dim3(NWAVES * 64), LDS_BYTES, stream, a); }
}
```

```cpp
#include <hip/hip_runtime.h>
#include <hip/hip_bf16.h>
#include <cstdio>
#include <cstdint>
#include <cmath>
namespace pg8 {
#define PG8_LAS __attribute__((address_space(3)))
typedef unsigned short bf16_t;
typedef short bf16x8 __attribute__((ext_vector_type(8)));
typedef float f32x4 __attribute__((ext_vector_type(4)));
typedef unsigned u32x4 __attribute__((ext_vector_type(4)));
constexpr int BM = 256, BK = 64, HALF = 128, HTB = HALF * BK * 2  , STAGE_BYTES = 8 * HTB, NXCD = 8, WGM = 8;

__host__ __device__ __forceinline__ int lds_byte(int r, int c) { const int st = (r >> 4) * 2 + (c >> 5), rr = r & 15, cc = c & 31, ob = rr * 64 + cc * 2; return st * 1024 + (ob ^ (((ob >> 9) & 1) << 5)); }
__host__ __device__ __forceinline__ void stage_rc(int b, int& R, int& C) { const int st = b / 1024, sb = b % 1024, swz = sb ^ (((sb >> 9) & 1) << 5); R = (st >> 1) * 16 + swz / 64; C = (st & 1) * 32 + (swz % 64) / 2; }
__host__ __device__ __forceinline__ int perm32(int rho) { const int n = rho >> 4, i = rho & 15; return 8 * (i >> 2) + 4 * n + (i & 3); }

struct Unit { int pm, pn; };
struct Gemm { const bf16_t* A; const bf16_t* Bt; int M, N, K; };

struct StaticOrder {
    int nM, nN, nwg, G, c;
    __host__ __device__ void init(int M, int N, int G_, int c_) { nM = M / BM; nN = N / BM; nwg = nM * nN; G = G_; c = c_; }
    __host__ __device__ bool next(int i, Unit& u) const {
        const long L = (long)i * G + c; if (L >= nwg) return false;
        int wgid = (int)L; { const int q = nwg / NXCD, r = nwg % NXCD, xcd = wgid % NXCD, off = wgid / NXCD; wgid = (xcd < r ? xcd * (q + 1) : r * (q + 1) + (xcd - r) * q) + off; }
        const int nig = WGM * nN, gid = wgid / nig, fm = gid * WGM, gsz = (nM - fm) < WGM ? (nM - fm) : WGM;
        u.pm = fm + ((wgid % nig) % gsz); u.pn = (wgid % nig) / gsz; return true;
    }
    __device__ __forceinline__ void a_ready(const Unit&) const {}
    __device__ __forceinline__ void done(const Unit&) const {}
};

struct DenseSched {
    const char* A; const char* Bt; size_t tstep; StaticOrder so;
    __device__ __forceinline__ void init(const void* A_, const void* Bt_, int M, int N, int K, int G, int c) { A = (const char*)A_; Bt = (const char*)Bt_; tstep = (size_t)BM * K * 2; so.init(M, N, G, c); }
    __device__ __forceinline__ bool next(int i, Unit& u) const { return so.next(i, u); }
    __device__ __forceinline__ const char* a_ptr(const Unit& u) const { return A + (size_t)u.pm * tstep; }
    __device__ __forceinline__ const char* b_ptr(const Unit& u) const { return Bt + (size_t)u.pn * tstep; }
    __device__ __forceinline__ void a_ready(const Unit&) const {}
    __device__ __forceinline__ void done(const Unit&) const {}
};
struct MoeSched {
    const char* A; const char* Bt; size_t tstep, estride; StaticOrder so; const PG8_LAS unsigned char* p2e;
    __device__ __forceinline__ void init(const void* A_, const void* Bt_, int Mpad, int N, int K, size_t estride_, const PG8_LAS unsigned char* p2e_, int G, int c) {
        A = (const char*)A_; Bt = (const char*)Bt_; tstep = (size_t)BM * K * 2; estride = estride_; p2e = p2e_; so.init(Mpad, N, G, c); }
    __device__ __forceinline__ bool next(int i, Unit& u) const { return so.next(i, u); }
    __device__ __forceinline__ const char* a_ptr(const Unit& u) const { return A + (size_t)u.pm * tstep; }
    __device__ __forceinline__ const char* b_ptr(const Unit& u) const { const int e = __builtin_amdgcn_readfirstlane((int)p2e[u.pm]); return Bt + (size_t)e * estride + (size_t)u.pn * tstep; }
    __device__ __forceinline__ void a_ready(const Unit&) const {}
    __device__ __forceinline__ void done(const Unit&) const {}
};

__device__ __forceinline__ unsigned cvt_pk_bf16(float lo, float hi) { unsigned r; asm volatile("v_cvt_pk_bf16_f32 %0, %1, %2" : "=v"(r) : "v"(lo), "v"(hi)); return r; }

struct EpiProj {
    static constexpr bool PERM = true, AFTER_DRAIN = false;
    bf16_t* O; const float* cosT; const float* sinT; float qscale;
    __device__ __forceinline__ void operator()(const f32x4 (&acc)[2][2][4][2], const Unit& u, int wr, int wc, int fr, int fq) const {
        const int pn = u.pn;
        const bool isq = (pn < 2) || (pn == 6) || (pn == 7) || (pn >= 12 && pn < 16);
        const bool isk = (pn == 2) || (pn == 3) || (pn == 8) || (pn == 9) || (pn >= 16 && pn < 20);
        const int row0 = u.pm * BM + wr * 64 + fr, col0 = pn * BM + wc * 32 + 8 * fq;
        const int i0 = (wc & 1) * 16 + 4 * fq;
        const float sc = isq ? qscale : 1.f;
#pragma unroll
        for (int ai = 0; ai < 2; ++ai)
#pragma unroll
            for (int m = 0; m < 4; ++m) { const int row = row0 + ai * HALF + m * 16; bf16_t* rowp = O + (size_t)row * 6144 + col0;
                f32x4 cs = (f32x4){1.f, 1.f, 1.f, 1.f}, sn = (f32x4){0.f, 0.f, 0.f, 0.f};
                if (isq || isk) { cs = *(const f32x4*)(cosT + (size_t)row * 32 + i0); sn = *(const f32x4*)(sinT + (size_t)row * 32 + i0); }
#pragma unroll
                for (int bj = 0; bj < 2; ++bj) { const f32x4 v0 = acc[ai][bj][m][0], v1 = acc[ai][bj][m][1];
                    const float a0 = (v0[0] * cs[0] - v0[1] * sn[0]) * sc, b0 = (v0[1] * cs[0] + v0[0] * sn[0]) * sc;
                    const float a1 = (v0[2] * cs[1] - v0[3] * sn[1]) * sc, b1 = (v0[3] * cs[1] + v0[2] * sn[1]) * sc;
                    const float a2 = (v1[0] * cs[2] - v1[1] * sn[2]) * sc, b2 = (v1[1] * cs[2] + v1[0] * sn[2]) * sc;
                    const float a3 = (v1[2] * cs[3] - v1[3] * sn[3]) * sc, b3 = (v1[3] * cs[3] + v1[2] * sn[3]) * sc;
                    u32x4 w; w.x = cvt_pk_bf16(a0, b0); w.y = cvt_pk_bf16(a1, b1); w.z = cvt_pk_bf16(a2, b2); w.w = cvt_pk_bf16(a3, b3);
                    *(u32x4*)(rowp + bj * HALF) = w; } }
    }
};
struct EpiGateRes {
    static constexpr bool PERM = false, AFTER_DRAIN = false;
    const float* base; float* out; const float* gate;
    __device__ __forceinline__ void operator()(const f32x4 (&acc)[2][2][4][2], const Unit& u, int wr, int wc, int fr, int fq) const {
        const int col0 = u.pn * BM + wc * 32 + 4 * fq;
        f32x4 gv[2][2];
#pragma unroll
        for (int bj = 0; bj < 2; ++bj)
#pragma unroll
            for (int n = 0; n < 2; ++n) gv[bj][n] = *(const f32x4*)(gate + col0 + bj * HALF + n * 16);
#pragma unroll
        for (int ai = 0; ai < 2; ++ai)
#pragma unroll
            for (int m = 0; m < 4; ++m) { const size_t off = (size_t)(u.pm * BM + ai * HALF + wr * 64 + m * 16 + fr) * 2048 + col0;
#pragma unroll
                for (int bj = 0; bj < 2; ++bj)
#pragma unroll
                    for (int n = 0; n < 2; ++n) { const f32x4 bs = *(const f32x4*)(base + off + bj * HALF + n * 16); *(f32x4*)(out + off + bj * HALF + n * 16) = bs + gv[bj][n] * acc[ai][bj][m][n]; } }
    }
};
struct EpiSwiglu {
    static constexpr bool PERM = true, AFTER_DRAIN = false;
    bf16_t* O;
    __device__ __forceinline__ void operator()(const f32x4 (&acc)[2][2][4][2], const Unit& u, int wr, int wc, int fr, int fq) const {
        const int row0 = u.pm * BM + wr * 64 + fr, col0 = u.pn * 128 + wc * 16 + 4 * fq;
        typedef unsigned u32x2 __attribute__((ext_vector_type(2)));
#pragma unroll
        for (int ai = 0; ai < 2; ++ai)
#pragma unroll
            for (int m = 0; m < 4; ++m) { bf16_t* rowp = O + (size_t)(row0 + ai * HALF + m * 16) * 1024 + col0;
#pragma unroll
                for (int bj = 0; bj < 2; ++bj) { const f32x4 g = acc[ai][bj][m][0], up = acc[ai][bj][m][1]; float r[4];
#pragma unroll
                    for (int j = 0; j < 4; ++j) { const float e = __builtin_amdgcn_exp2f(-1.4426950408889634f * g[j]); r[j] = g[j] * __builtin_amdgcn_rcpf(1.f + e) * up[j]; }
                    u32x2 w; w.x = cvt_pk_bf16(r[0], r[1]); w.y = cvt_pk_bf16(r[2], r[3]); *(u32x2*)(rowp + bj * 64) = w; } }
    }
};
struct EpiDown {
    static constexpr bool PERM = true, AFTER_DRAIN = false;
    bf16_t* Y; const int* rowtok; const float* roww;
    __device__ __forceinline__ void operator()(const f32x4 (&acc)[2][2][4][2], const Unit& u, int wr, int wc, int fr, int fq) const {
        const int row0 = u.pm * BM + wr * 64 + fr, col0 = u.pn * BM + wc * 32 + 8 * fq;
#pragma unroll
        for (int ai = 0; ai < 2; ++ai)
#pragma unroll
            for (int m = 0; m < 4; ++m) { const int pos = row0 + ai * HALF + m * 16; const int tk = rowtok[pos]; const float w8 = roww[pos];
                if (tk >= 0) { bf16_t* rowp = Y + (size_t)tk * 2048 + col0;
#pragma unroll
                    for (int bj = 0; bj < 2; ++bj) { const f32x4 v0 = acc[ai][bj][m][0] * w8, v1 = acc[ai][bj][m][1] * w8;
                        u32x4 w; w.x = cvt_pk_bf16(v0[0], v0[1]); w.y = cvt_pk_bf16(v0[2], v0[3]); w.z = cvt_pk_bf16(v1[0], v1[1]); w.w = cvt_pk_bf16(v1[2], v1[3]);
                        *(u32x4*)(rowp + bj * HALF) = w; } } }
    }
};

template <class Epi, class Sched, bool ALIGN_EPI = false, bool SP2 = false>
__device__ __forceinline__ void gemm_phase(PG8_LAS unsigned char* lds, const int K, const Sched& S, const Epi& E) {
    int tid = threadIdx.x; asm volatile("" : "+v"(tid)); const int wid = __builtin_amdgcn_readfirstlane(tid >> 6), lane = tid & 63, wr = wid >> 2, wc = wid & 3, fr = lane & 15, fq = lane >> 4;
    const int nt = K / BK;
    unsigned voffA[2], voffB[2];
#pragma unroll
    for (int i = 0; i < 2; ++i) { int R, C; stage_rc(tid * 16 + i * 8192, R, C); const int Rb = Epi::PERM ? ((R & ~31) + perm32(R & 31)) : R;
        voffA[i] = (unsigned)(R * K + C) * 2u; voffB[i] = (unsigned)(Rb * K + C) * 2u; }
    const size_t kstep = (size_t)(BK * 2);
    const size_t hstep = (size_t)HALF * K * 2;
    const unsigned ldsw = (unsigned)wid * 1024u;
    const int aoff = lds_byte(wr * 64 + fr, fq * 8), boff = lds_byte(wc * 32 + fr, fq * 8);
#define PG8_SA(b, h) (((b) * 2 + (h)) * HTB)
#define PG8_SB(b, h) ((4 + (b) * 2 + (h)) * HTB)
#define PG8_STAGE(bufoff, gbase, voff) do { _Pragma("unroll") for (int _i = 0; _i < 2; ++_i) \
        __builtin_amdgcn_global_load_lds((const unsigned*)((const char*)(gbase) + (voff)[_i]), (PG8_LAS unsigned*)(lds + (bufoff) + ldsw + _i * 8192), 16, 0, 0); } while (0)
#define PG8_LDA(dst, b, h) do { _Pragma("unroll") for (int m = 0; m < 4; ++m) _Pragma("unroll") for (int k = 0; k < 2; ++k) dst[m][k] = *(const PG8_LAS bf16x8*)(lds + PG8_SA(b, h) + aoff + m * 2048 + k * 1024); } while (0)
#define PG8_LDB(dst, b, h) do { _Pragma("unroll") for (int n = 0; n < 2; ++n) _Pragma("unroll") for (int k = 0; k < 2; ++k) dst[n][k] = *(const PG8_LAS bf16x8*)(lds + PG8_SB(b, h) + boff + n * 2048 + k * 1024); } while (0)
#define PG8_MMA(ai, bj, At, Bt) do { __builtin_amdgcn_s_setprio(1); _Pragma("unroll") for (int m = 0; m < 4; ++m) _Pragma("unroll") for (int n = 0; n < 2; ++n) _Pragma("unroll") for (int k = 0; k < 2; ++k) \
        acc[ai][bj][m][n] = __builtin_amdgcn_mfma_f32_16x16x32_bf16(Bt[n][k], At[m][k], acc[ai][bj][m][n], 0, 0, 0); __builtin_amdgcn_s_setprio(0); } while (0)
#define PG8_WAIT_V(n) asm volatile("s_waitcnt vmcnt(" #n ")" ::: "memory")
#define PG8_WAIT_L(n) asm volatile("s_waitcnt lgkmcnt(" #n ")" ::: "memory")
#define PG8_BAR __builtin_amdgcn_s_barrier()
#define PG8_SCHED __builtin_amdgcn_sched_barrier(0)
    Unit cur, nxt; int ui = 0;
    if (!S.next(0, cur)) return;
    f32x4 acc[2][2][4][2];
#pragma unroll
    for (int a = 0; a < 2; ++a)
#pragma unroll
        for (int b = 0; b < 2; ++b)
#pragma unroll
            for (int m = 0; m < 4; ++m)
#pragma unroll
                for (int n = 0; n < 2; ++n) acc[a][b][m][n] = (f32x4){0.f, 0.f, 0.f, 0.f};
    bf16x8 At[4][2], B0[2][2], B1[2][2];
    const char* cA = S.a_ptr(cur); const char* cB = S.b_ptr(cur);
    S.a_ready(cur);
    if constexpr (SP2) {
        PG8_STAGE(PG8_SB(0, 0), cB, voffB); PG8_STAGE(PG8_SB(0, 1), cB + hstep, voffB); PG8_STAGE(PG8_SA(0, 0), cA, voffA); PG8_STAGE(PG8_SA(0, 1), cA + hstep, voffA);
        if (wr == 1) PG8_BAR;
        PG8_WAIT_V(2); PG8_BAR;
        PG8_STAGE(PG8_SB(1, 0), cB + kstep, voffB); PG8_STAGE(PG8_SA(1, 0), cA + kstep, voffA); PG8_STAGE(PG8_SB(1, 1), cB + hstep + kstep, voffB);
        PG8_WAIT_V(6); PG8_BAR;
    } else {
        PG8_STAGE(PG8_SB(0, 0), cB, voffB); PG8_STAGE(PG8_SA(0, 0), cA, voffA); PG8_STAGE(PG8_SB(0, 1), cB + hstep, voffB); PG8_STAGE(PG8_SA(0, 1), cA + hstep, voffA);
        if (wr == 1) PG8_BAR;
        PG8_WAIT_V(4); PG8_BAR;
        PG8_STAGE(PG8_SB(1, 0), cB + kstep, voffB); PG8_STAGE(PG8_SA(1, 0), cA + kstep, voffA); PG8_STAGE(PG8_SB(1, 1), cB + hstep + kstep, voffB);
        PG8_WAIT_V(6); PG8_BAR;
    }
    for (;;) {
        const bool has_next = S.next(ui + 1, nxt);
        const char* nA = has_next ? S.a_ptr(nxt) : cA; const char* nB = has_next ? S.b_ptr(nxt) : cB;
        for (int t = 0; t < nt; t += 2) {
            const bool last = (t == nt - 2);
            const char* a1 = cA + (size_t)(t + 1) * kstep;
            const char* a2 = last ? nA : cA + (size_t)(t + 2) * kstep; const char* b2 = last ? nB : cB + (size_t)(t + 2) * kstep;
            const char* a3 = a2 + kstep; const char* b3 = b2 + kstep;
            if (last && has_next) S.a_ready(nxt);
            if constexpr (SP2) {
            PG8_LDB(B0, 0, 0); PG8_LDB(B1, 0, 1); PG8_SCHED; PG8_LDA(At, 0, 0); PG8_STAGE(PG8_SA(1, 1), a1 + hstep, voffA);
            PG8_WAIT_V(8); PG8_WAIT_L(0); PG8_BAR; PG8_MMA(0, 0, At, B0); PG8_MMA(0, 1, At, B1); PG8_BAR; PG8_SCHED;
            PG8_LDA(At, 0, 1); PG8_STAGE(PG8_SB(0, 0), b2, voffB); PG8_STAGE(PG8_SB(0, 1), b2 + hstep, voffB); PG8_STAGE(PG8_SA(0, 0), a2, voffA);
            PG8_WAIT_V(8); PG8_WAIT_L(0); PG8_BAR; PG8_MMA(1, 0, At, B0); PG8_MMA(1, 1, At, B1); PG8_BAR; PG8_SCHED;
            PG8_LDB(B0, 1, 0); PG8_LDB(B1, 1, 1); PG8_SCHED; PG8_LDA(At, 1, 0); PG8_STAGE(PG8_SA(0, 1), a2 + hstep, voffA);
            PG8_WAIT_V(8); PG8_WAIT_L(0); PG8_BAR; PG8_MMA(0, 0, At, B0); PG8_MMA(0, 1, At, B1); PG8_BAR; PG8_SCHED;
            PG8_LDA(At, 1, 1); PG8_STAGE(PG8_SB(1, 0), b3, voffB); PG8_STAGE(PG8_SB(1, 1), b3 + hstep, voffB); PG8_STAGE(PG8_SA(1, 0), a3, voffA);
            PG8_WAIT_V(8); PG8_WAIT_L(0); PG8_BAR; PG8_MMA(1, 0, At, B0); PG8_MMA(1, 1, At, B1); PG8_BAR; PG8_SCHED;
            } else {
            PG8_LDB(B0, 0, 0); PG8_SCHED; PG8_LDA(At, 0, 0); PG8_STAGE(PG8_SA(1, 1), a1 + hstep, voffA);
            PG8_WAIT_L(8); PG8_BAR; PG8_WAIT_L(0); PG8_MMA(0, 0, At, B0); PG8_BAR; PG8_SCHED;
            PG8_LDB(B1, 0, 1); PG8_STAGE(PG8_SB(0, 0), b2, voffB);
            PG8_BAR; PG8_WAIT_L(0); PG8_MMA(0, 1, At, B1); PG8_BAR;
            PG8_LDA(At, 0, 1); PG8_STAGE(PG8_SA(0, 0), a2, voffA);
            PG8_BAR; PG8_WAIT_L(0); PG8_MMA(1, 0, At, B0); PG8_BAR; PG8_SCHED;
            PG8_STAGE(PG8_SB(0, 1), b2 + hstep, voffB);
            PG8_WAIT_V(6); PG8_BAR; PG8_MMA(1, 1, At, B1); PG8_BAR;
            PG8_LDB(B0, 1, 0); PG8_SCHED; PG8_LDA(At, 1, 0); PG8_STAGE(PG8_SA(0, 1), a2 + hstep, voffA);
            PG8_WAIT_L(8); PG8_BAR; PG8_WAIT_L(0); PG8_MMA(0, 0, At, B0); PG8_BAR; PG8_SCHED;
            PG8_LDB(B1, 1, 1); PG8_STAGE(PG8_SB(1, 0), b3, voffB);
            PG8_BAR; PG8_WAIT_L(0); PG8_MMA(0, 1, At, B1); PG8_BAR;
            PG8_LDA(At, 1, 1); PG8_STAGE(PG8_SA(1, 0), a3, voffA);
            PG8_BAR; PG8_WAIT_L(0); PG8_MMA(1, 0, At, B0); PG8_BAR; PG8_SCHED;
            PG8_STAGE(PG8_SB(1, 1), b3 + hstep, voffB);
            PG8_WAIT_V(6); PG8_BAR; PG8_MMA(1, 1, At, B1); PG8_BAR;
            }
        }
        if constexpr (ALIGN_EPI) { if (wr == 0) PG8_BAR; }
        if constexpr (!Epi::AFTER_DRAIN) { E(acc, cur, wr, wc, fr, fq); S.done(cur); }
        if (!has_next) break;
#pragma unroll
        for (int a = 0; a < 2; ++a)
#pragma unroll
            for (int b = 0; b < 2; ++b)
#pragma unroll
                for (int m = 0; m < 4; ++m)
#pragma unroll
                    for (int n = 0; n < 2; ++n) acc[a][b][m][n] = (f32x4){0.f, 0.f, 0.f, 0.f};
        cur = nxt; cA = nA; cB = nB; ++ui;
        if constexpr (ALIGN_EPI) { if (wr == 1) PG8_BAR; }
    }
    PG8_WAIT_V(0);
    if constexpr (!ALIGN_EPI) { if (wr == 0) PG8_BAR; }
    PG8_BAR;
    if constexpr (Epi::AFTER_DRAIN) { E.fused(acc, cur, wr, wc, fr, fq, lds, wid, lane); S.done(cur); }
#undef PG8_SA
#undef PG8_SB
#undef PG8_STAGE
#undef PG8_LDA
#undef PG8_LDB
#undef PG8_MMA
#undef PG8_WAIT_V
#undef PG8_WAIT_L
#undef PG8_BAR
#undef PG8_SCHED
}
}

#include <hip/hip_bf16.h>
#include <cmath>
namespace attn_body {
using bf16=__hip_bfloat16;
using bf16x8=__attribute__((ext_vector_type(8)))short;
using s16x4=__attribute__((ext_vector_type(4)))short;
using f32x16=__attribute__((ext_vector_type(16)))float;
using u32x4=__attribute__((ext_vector_type(4)))unsigned;
constexpr int SEQ=16384,D=64,DM=6144;
constexpr int NW=8,QBLK=32,QB=QBLK*NW,KVBLK=64,NQB=SEQ/QB;
constexpr int ATTN_UNIT_ROWS=QB;
__device__ __forceinline__ int crow(int r,int hi){return (r&3)+8*(r>>2)+4*hi;}
#define SBAR() __builtin_amdgcn_sched_barrier(0)
__device__ __forceinline__ void cmask(f32x16&p0,f32x16&p1,int jb,int qrel,int hi){
  const float NEG=-INFINITY; int kb=64*jb+4*hi;
  #pragma unroll
  for(int r=0;r<16;++r){int kv=kb+(r&3)+8*(r>>2); if(kv>qrel)p0[r]=NEG; if(kv+32>qrel)p1[r]=NEG;}
}

constexpr int NSLOT=3, SLOTB=8192;
constexpr int LDS_K=0, LDS_V=NSLOT*SLOTB, LDS_WS=2*NSLOT*SLOTB, LDS_OST=LDS_WS+NW*64*4, LDS_BYTES=LDS_OST+NW*4096;
constexpr float C2=0.125f*1.4426950408889634f;
__device__ __forceinline__ void glds16(const void*gsrc,unsigned lds_dst){unsigned keep;
  asm volatile("s_mov_b32 %0, m0\n\ts_mov_b32 m0, %2\n\ts_nop 0\n\tglobal_load_lds_dwordx4 %1, off\n\ts_mov_b32 m0, %0":"=&s"(keep):"v"(gsrc),"s"(lds_dst):"memory");}
__device__ __forceinline__ float max3f(float a,float b,float c){float r;asm("v_max3_f32 %0, %1, %2, %3":"=v"(r):"v"(a),"v"(b),"v"(c));return r;}
__device__ __forceinline__ float max2f(float a,float b){float r;asm("v_max_f32_e32 %0, %1, %2":"=v"(r):"v"(a),"v"(b));return r;}
__device__ __forceinline__ float fadd_s(float a,float b){float r;asm("v_add_f32_e32 %0, %1, %2":"=v"(r):"v"(a),"v"(b));return r;}
__device__ __forceinline__ float fsub_s(float a,float b){float r;asm("v_sub_f32_e32 %0, %1, %2":"=v"(r):"v"(a),"v"(b));return r;}
typedef float f32x2_t __attribute__((ext_vector_type(2))); typedef __bf16 bf16x2_t __attribute__((ext_vector_type(2)));
__device__ __forceinline__ unsigned cvtpk_s(float lo,float hi){f32x2_t v={lo,hi};bf16x2_t b=__builtin_convertvector(v,bf16x2_t);return __builtin_bit_cast(unsigned,b);}
#define WAIT_BAR(N) asm volatile("s_waitcnt vmcnt(" #N ") lgkmcnt(0)\n\ts_barrier":::"memory")

__device__ __forceinline__ void rmask(f32x16&p0,f32x16&p1,bool keep){
  const float NEG=-INFINITY;
  #pragma unroll
  for(int r=0;r<16;++r){ p0[r]=keep?p0[r]:NEG; p1[r]=keep?p1[r]:NEG; }
}
__device__ __forceinline__ float abias(int d){
  const int t1=1+((128-d)>>31);
  const int t4=(((d&3)-1)>>31)&(1+((512-d)>>31));
  const int t16=(((d&15)-1)>>31)&(1+((2048-d)>>31));
  const int m=(t1+t4+t16)&~(d>>31);
  return __builtin_amdgcn_logf((float)m);
}
__device__ __forceinline__ void amask(f32x16&p0,f32x16&p1,int dbase){
  #pragma unroll
  for(int r=0;r<16;++r){ int d=dbase-((r&3)+8*(r>>2)); asm volatile("":"+v"(d)); p0[r]+=abias(d); int d2=d-32; asm volatile("":"+v"(d2)); p1[r]+=abias(d2); }
}
__device__ __forceinline__ void qkt(f32x16&p0,f32x16&p1,const char*Kslot,const bf16x8*qr,const f32x16&negm,int r32,int hi){
  const char*kb=Kslot+hi*1024+r32*16;
  #pragma unroll
  for(int d0=0;d0<4;++d0){
    const bf16x8 b0=*reinterpret_cast<const bf16x8*>(kb+d0*2048);
    const bf16x8 b1=*reinterpret_cast<const bf16x8*>(kb+d0*2048+512);
    if(d0==0){p0=__builtin_amdgcn_mfma_f32_32x32x16_bf16(b0,qr[0],negm,0,0,0);p1=__builtin_amdgcn_mfma_f32_32x32x16_bf16(b1,qr[0],negm,0,0,0);}
    else{p0=__builtin_amdgcn_mfma_f32_32x32x16_bf16(b0,qr[d0],p0,0,0,0);p1=__builtin_amdgcn_mfma_f32_32x32x16_bf16(b1,qr[d0],p1,0,0,0);}}
}
typedef __attribute__((address_space(3))) const char* lds_cptr;
typedef short v4i16_t __attribute__((ext_vector_type(4)));
__device__ __forceinline__ void kload8(bf16x8*kf,lds_cptr kp){
  kf[0]=*(const __attribute__((address_space(3))) bf16x8*)(kp);      kf[1]=*(const __attribute__((address_space(3))) bf16x8*)(kp+512);
  kf[2]=*(const __attribute__((address_space(3))) bf16x8*)(kp+2048); kf[3]=*(const __attribute__((address_space(3))) bf16x8*)(kp+2560);
  kf[4]=*(const __attribute__((address_space(3))) bf16x8*)(kp+4096); kf[5]=*(const __attribute__((address_space(3))) bf16x8*)(kp+4608);
  kf[6]=*(const __attribute__((address_space(3))) bf16x8*)(kp+6144); kf[7]=*(const __attribute__((address_space(3))) bf16x8*)(kp+6656);
}
__device__ __forceinline__ void kload2(bf16x8*kf,lds_cptr kp,int j){ kf[2*j]=*(const __attribute__((address_space(3))) bf16x8*)(kp+j*2048); kf[2*j+1]=*(const __attribute__((address_space(3))) bf16x8*)(kp+j*2048+512); }
__device__ __forceinline__ s16x4 vtr(lds_cptr p){ return __builtin_bit_cast(s16x4,__builtin_amdgcn_ds_read_tr16_b64_v4i16((__attribute__((address_space(3))) v4i16_t*)p)); }
__device__ __forceinline__ float rowmax(const f32x16&p0,const f32x16&p1){
  float a=max3f(p0[0],p0[1],p1[0]),b=max3f(p0[2],p0[3],p1[1]);a=max3f(a,p1[2],p1[3]);
  #pragma unroll
  for(int r=4;r<16;r+=4){a=max3f(a,p0[r],p0[r+1]);b=max3f(b,p0[r+2],p0[r+3]);a=max3f(a,p1[r],p1[r+1]);b=max3f(b,p1[r+2],p1[r+3]);}
  const float m=max2f(a,b);
  auto rr=__builtin_amdgcn_permlane32_swap(__float_as_uint(m),__float_as_uint(m),false,false);
  return max2f(__uint_as_float(rr[0]),__uint_as_float(rr[1]));
}
__device__ __forceinline__ void pv(f32x16*o,int vb,bf16x8 pa0,bf16x8 pa1,bf16x8 pa2,bf16x8 pa3){
  #pragma unroll
  for(int d0=0;d0<2;++d0){s16x4 lo[4],hi[4];
    #pragma unroll
    for(int ks=0;ks<4;++ks){
      asm volatile("ds_read_b64_tr_b16 %0,%1 offset:%c2":"=&v"(lo[ks]):"v"(vb),"i"(d0*4096+ks*1024):"memory");
      asm volatile("ds_read_b64_tr_b16 %0,%1 offset:%c2":"=&v"(hi[ks]):"v"(vb),"i"(d0*4096+ks*1024+512):"memory");}
    asm volatile("s_waitcnt lgkmcnt(0)":::"memory");SBAR();
    #define PK(k) (bf16x8){lo[k][0],lo[k][1],lo[k][2],lo[k][3],hi[k][0],hi[k][1],hi[k][2],hi[k][3]}
    o[d0]=__builtin_amdgcn_mfma_f32_32x32x16_bf16(pa0,PK(0),o[d0],0,0,0);
    o[d0]=__builtin_amdgcn_mfma_f32_32x32x16_bf16(pa1,PK(1),o[d0],0,0,0);
    o[d0]=__builtin_amdgcn_mfma_f32_32x32x16_bf16(pa2,PK(2),o[d0],0,0,0);
    o[d0]=__builtin_amdgcn_mfma_f32_32x32x16_bf16(pa3,PK(3),o[d0],0,0,0);
    #undef PK
  }
}

#ifndef ATTN_STORE16
#define ATTN_STORE16(p,v) (*(u32x4*)(p)=(v))
#endif
template<int THRL,int MODE> __device__ __forceinline__ void attn_unit(int qb,int T0,const bf16*Q,const bf16*__restrict__ K,const bf16*__restrict__ V,void*Ov,int opitch,const unsigned long long*sel,char*shm){
  int tid=threadIdx.x; asm volatile("":"+v"(tid)); const int lane=tid&63,r32=lane&31,hi=lane>>5; const int wid=__builtin_amdgcn_readfirstlane(tid>>6);
  const int q0=qb*QB;
  const bf16*Qw=Q+(long)(q0+wid*QBLK)*DM;
  const bf16*Kh=K+(long)T0*KVBLK*DM,*Vh=V+(long)T0*KVBLK*DM;
  const unsigned lds0=(unsigned)(uintptr_t)shm;
  float*wsf=(float*)(shm+LDS_WS)+wid*64;
  const bf16*ksrc=Kh+(long)lane*DM+wid*8;
  const bf16*vsrc=Vh+(long)(16*(wid&3)+(lane>>2))*DM+(wid>>2)*32+(lane&3)*8;
  const unsigned kdst=lds0+LDS_K+wid*1024, vdst=lds0+LDS_V+wid*1024;
  #define DMA_K(t,slot) glds16(ksrc+(long)(t)*KVBLK*DM,(unsigned)__builtin_amdgcn_readfirstlane(kdst+(slot)))
  #define DMA_V(t,slot) glds16(vsrc+(long)(t)*KVBLK*DM,(unsigned)__builtin_amdgcn_readfirstlane(vdst+(slot)))
  const int vb0=(int)(lds0+LDS_V)+((lane>>4)&1)*32+(lane&3)*8+(4*hi+((lane&15)>>2))*64;
  const char*Kbase=shm+LDS_K; bf16x8 kf[8];
  const lds_cptr shm3=(lds_cptr)shm; const lds_cptr kp0=shm3+LDS_K+hi*1024+r32*16; const lds_cptr vp0=shm3+LDS_V+((lane>>4)&1)*32+(lane&3)*8+(4*hi+((lane&15)>>2))*64;
  const int NT=(q0+QB)/KVBLK-T0;
  DMA_K(0,0);DMA_V(0,0);DMA_K(1,SLOTB);
  bf16x8 qr[4];
  #pragma unroll
  for(int d0=0;d0<4;++d0)qr[d0]=*reinterpret_cast<const bf16x8*>(&Qw[(long)r32*DM+d0*16+hi*8]);
  float mhat=0.f,l_reg=0.f;f32x16 o[2];o[0]=f32x16{};o[1]=f32x16{};f32x16 negm=f32x16{};asm volatile("":"+v"(negm));
  const int qrel=wid*QBLK+r32;
  unsigned sel_lo=0u,sel_hi=0u; if(MODE==1){ const unsigned long long sv=sel[qrel]; sel_lo=(unsigned)sv; sel_hi=(unsigned)(sv>>32); }
  const int dq=q0+qrel-4*hi-T0*KVBLK;
  #define RKEEP(t) ((((t)>>2)<32?(sel_lo>>((t)>>2)):(sel_hi>>(((t)>>2)-32)))&1u)
  #define CMASK(P0,P1,t) do{ if(MODE==2){amask(P0,P1,dq-64*(t));} else {int jb_=(t)-(NT-4); if(jb_>=0)cmask(P0,P1,jb_,qrel,hi); else if(MODE==1)rmask(P0,P1,RKEEP(t)!=0u);} }while(0)
  bool resc=false;
  #define START(P0,P1) do{ const float rm=rowmax(P0,P1); resc=false; \
    { const float dl=(MODE==0)?rm:((rm>-3.0e38f)?rm:0.f); mhat=fadd_s(mhat,dl); \
      _Pragma("unroll") for(int r=0;r<16;++r){P0[r]=fsub_s(P0[r],dl);P1[r]=fsub_s(P1[r],dl);} \
      _Pragma("unroll") for(int r=0;r<16;++r)negm[r]=-mhat; asm volatile("":"+v"(negm)); } \
    _Pragma("unroll") for(int r=0;r<16;++r)P0[r]=__builtin_amdgcn_exp2f(P0[r]); }while(0)
  #define RESC() do{ if(resc){ asm volatile("s_waitcnt lgkmcnt(0)":::"memory"); \
      _Pragma("unroll") for(int d_=0;d_<2;++d_) _Pragma("unroll") for(int r=0;r<16;++r)o[d_][r]*=wsf[crow(r,hi)]; } }while(0)
  f32x16 pA0,pA1,pB0,pB1;
  int sl_prev=0,sl_cur=0,sl_next=SLOTB;
  #define ROT() do{sl_prev=sl_cur;sl_cur=sl_next;sl_next=(sl_next==(NSLOT-1)*SLOTB)?0:sl_next+SLOTB;}while(0)
  DMA_K(2,2*SLOTB);
  WAIT_BAR(3);
  qkt(pA0,pA1,Kbase,qr,negm,r32,hi);asm volatile("s_nop 15\n\ts_nop 7":"+v"(pA0),"+v"(pA1));CMASK(pA0,pA1,0);
  START(pA0,pA1);
  _Pragma("unroll") for(int r=0;r<16;++r)pA1[r]=__builtin_amdgcn_exp2f(pA1[r]);
  WAIT_BAR(0);
  DMA_K(3,0);DMA_V(1,SLOTB);
  ROT();
  kload8(kf,kp0+sl_cur);
  WAIT_BAR(2);
  s16x4 vlo[8],vhi[8]; u32x4 pw0,pw1,pw2,pw3;
  #define PKW(P,B) cvtpk_s(P[B],P[B+1])
  #define PAF(k) __builtin_bit_cast(bf16x8,pw##k)
  #define VFR(i) (bf16x8){vlo[i][0],vlo[i][1],vlo[i][2],vlo[i][3],vhi[i][0],vhi[i][1],vhi[i][2],vhi[i][3]}
  #define PIN(x) asm volatile("":"+v"(x))
  #define MX3(a,b,c) __builtin_fmaxf(__builtin_fmaxf((a),(b)),(c))
  #define GAPA(MF,A0,A1,A2,A3,W0,W1,PW) do{ MF; sacc+=A0; sacc+=A1; sacc+=A2; sacc+=A3; PIN(sacc); W0; W1; PIN(PW); SBAR(); }while(0)
  #define EX(v) __builtin_amdgcn_exp2f(v)
  #define GAPB(MF,X,B) do{ MF; X[B]=EX(X[B]); X[B+1]=EX(X[B+1]); X[B+2]=EX(X[B+2]); X[B+3]=EX(X[B+3]); PIN(X); SBAR(); }while(0)
  #define VRD(i) do{ vlo[i]=vtr(vp_+(((i)>>2)*4096+((i)&3)*1024)); vhi[i]=vtr(vp_+(((i)>>2)*4096+((i)&3)*1024+512)); }while(0)
  #define KRD(G,j) do{ if(G){ kload2(kf,kp0+sl_next,j); SBAR(); } }while(0)
  #define STEP(C0,C1,P0,P1,t,GK,GV,GL) do{ SBAR(); \
    const lds_cptr vp_=vp0+sl_prev; \
    VRD(0); SBAR(); float sacc=(P0[0]+P0[1]); \
    GAPA(C0=__builtin_amdgcn_mfma_f32_32x32x16_bf16(kf[0],qr[0],negm,0,0,0), P0[2],P0[3],P0[4],P0[5],     pw0[0]=PKW(P0,0), pw0[1]=PKW(P0,2), pw0); \
    VRD(4); SBAR(); GAPA(C1=__builtin_amdgcn_mfma_f32_32x32x16_bf16(kf[1],qr[0],negm,0,0,0), P0[6],P0[7],P0[8],P0[9],     pw0[2]=PKW(P0,4), pw0[3]=PKW(P0,6), pw0); \
    VRD(1); SBAR(); GAPA(C0=__builtin_amdgcn_mfma_f32_32x32x16_bf16(kf[2],qr[1],C0,0,0,0),   P0[10],P0[11],P0[12],P0[13], pw1[0]=PKW(P0,8), pw1[1]=PKW(P0,10), pw1); \
    VRD(5); SBAR(); GAPA(C1=__builtin_amdgcn_mfma_f32_32x32x16_bf16(kf[3],qr[1],C1,0,0,0),   P0[14],P0[15],P1[0],P1[1],   pw1[2]=PKW(P0,12),pw1[3]=PKW(P0,14), pw1); \
    VRD(2); SBAR(); GAPA(C0=__builtin_amdgcn_mfma_f32_32x32x16_bf16(kf[4],qr[2],C0,0,0,0),   P1[2],P1[3],P1[4],P1[5],     pw2[0]=PKW(P1,0), pw2[1]=PKW(P1,2), pw2); \
    VRD(6); SBAR(); GAPA(C1=__builtin_amdgcn_mfma_f32_32x32x16_bf16(kf[5],qr[2],C1,0,0,0),   P1[6],P1[7],P1[8],P1[9],     pw2[2]=PKW(P1,4), pw2[3]=PKW(P1,6), pw2); \
    VRD(3); SBAR(); GAPA(C0=__builtin_amdgcn_mfma_f32_32x32x16_bf16(kf[6],qr[3],C0,0,0,0),   P1[10],P1[11],P1[12],P1[13], pw3[0]=PKW(P1,8), pw3[1]=PKW(P1,10), pw3); \
    VRD(7); SBAR(); GAPA(C1=__builtin_amdgcn_mfma_f32_32x32x16_bf16(kf[7],qr[3],C1,0,0,0),   P1[14],P1[15],0.f,0.f,       pw3[2]=PKW(P1,12),pw3[3]=PKW(P1,14), pw3); \
    l_reg+=sacc; \
    if(GK){DMA_K((t)+3,sl_cur);} if(GV){DMA_V((t)+1,sl_next);} \
    CMASK(C0,C1,t); \
    { float a=MX3(C0[0],C0[1],C1[0]),b=MX3(C0[2],C0[3],C1[1]); a=MX3(a,C1[2],C1[3]); \
      _Pragma("unroll") for(int r=4;r<16;r+=4){a=MX3(a,C0[r],C0[r+1]);b=MX3(b,C0[r+2],C0[r+3]);a=MX3(a,C1[r],C1[r+1]);b=MX3(b,C1[r+2],C1[r+3]);} \
      float rm=__builtin_fmaxf(a,b); { auto rr=__builtin_amdgcn_permlane32_swap(__float_as_uint(rm),__float_as_uint(rm),false,false); rm=__builtin_fmaxf(__uint_as_float(rr[0]),__uint_as_float(rr[1])); } \
      resc=false; \
      if(__builtin_expect(__any(rm>(float)THRL),0)){ const float dl=__builtin_fmaxf(rm,0.f); mhat+=dl; \
        _Pragma("unroll") for(int r=0;r<16;++r){C0[r]-=dl;C1[r]-=dl;} \
        _Pragma("unroll") for(int r=0;r<16;++r)negm[r]=-mhat; asm volatile("":"+v"(negm)); \
        const float f=__builtin_amdgcn_exp2f(-dl); l_reg*=f; if(hi==0)wsf[r32]=f; resc=true; } } \
    SBAR(); \
    GAPB(o[0]=__builtin_amdgcn_mfma_f32_32x32x16_bf16(PAF(0),VFR(0),o[0],0,0,0), C0,0); \
    GAPB(o[1]=__builtin_amdgcn_mfma_f32_32x32x16_bf16(PAF(0),VFR(4),o[1],0,0,0), C0,4); \
    KRD(GL,0); GAPB(o[0]=__builtin_amdgcn_mfma_f32_32x32x16_bf16(PAF(1),VFR(1),o[0],0,0,0), C0,8); \
    KRD(GL,1); GAPB(o[1]=__builtin_amdgcn_mfma_f32_32x32x16_bf16(PAF(1),VFR(5),o[1],0,0,0), C0,12); \
    KRD(GL,2); GAPB(o[0]=__builtin_amdgcn_mfma_f32_32x32x16_bf16(PAF(2),VFR(2),o[0],0,0,0), C1,0); \
    KRD(GL,3); GAPB(o[1]=__builtin_amdgcn_mfma_f32_32x32x16_bf16(PAF(2),VFR(6),o[1],0,0,0), C1,4); \
    GAPB(o[0]=__builtin_amdgcn_mfma_f32_32x32x16_bf16(PAF(3),VFR(3),o[0],0,0,0), C1,8); \
    GAPB(o[1]=__builtin_amdgcn_mfma_f32_32x32x16_bf16(PAF(3),VFR(7),o[1],0,0,0), C1,12); \
    }while(0)
  int t=1;
  #undef CMASK
  #define CMASK(P0,P1,t) do{ if(MODE==2){amask(P0,P1,dq-64*(t));} else if(MODE==1){rmask(P0,P1,RKEEP(t)!=0u);} }while(0)
  for(;t+5<NT;t+=2){
    STEP(pB0,pB1,pA0,pA1,t,true,true,true);     WAIT_BAR(2); RESC(); ROT();
    STEP(pA0,pA1,pB0,pB1,t+1,true,true,true);   WAIT_BAR(2); RESC(); ROT();
  }
  #undef CMASK
  #define CMASK(P0,P1,t) do{ if(MODE==2){amask(P0,P1,dq-64*(t));} else {int jb_=(t)-(NT-4); if(jb_>=0)cmask(P0,P1,jb_,qrel,hi); else if(MODE==1)rmask(P0,P1,RKEEP(t)!=0u);} }while(0)
  #define ENDW(tt) do{ if((tt)+3<NT){WAIT_BAR(2);} else if((tt)+2<NT){WAIT_BAR(1);} else {WAIT_BAR(0);} }while(0)
  for(;t+1<NT;t+=2){
    STEP(pB0,pB1,pA0,pA1,t,(t+3<NT),(t+1<NT),(t+1<NT));       ENDW(t);   RESC(); ROT();
    STEP(pA0,pA1,pB0,pB1,t+1,(t+4<NT),(t+2<NT),(t+2<NT));     ENDW(t+1); RESC(); ROT();
  }
  STEP(pB0,pB1,pA0,pA1,NT-1,false,false,false); RESC();
  { float sacc=pB0[0]+pB0[1]; _Pragma("unroll") for(int r=2;r<16;++r)sacc+=pB0[r]; _Pragma("unroll") for(int r=0;r<16;++r)sacc+=pB1[r]; l_reg+=sacc;
    pw0=(u32x4){PKW(pB0,0),PKW(pB0,2),PKW(pB0,4),PKW(pB0,6)};pw1=(u32x4){PKW(pB0,8),PKW(pB0,10),PKW(pB0,12),PKW(pB0,14)};pw2=(u32x4){PKW(pB1,0),PKW(pB1,2),PKW(pB1,4),PKW(pB1,6)};pw3=(u32x4){PKW(pB1,8),PKW(pB1,10),PKW(pB1,12),PKW(pB1,14)};
    SBAR(); pv(o,vb0+sl_cur,PAF(0),PAF(1),PAF(2),PAF(3)); }
  #undef PKW
  #undef PAF
  #undef VFR
  #undef PIN
  #undef MX3
  #undef GAPA
  #undef GAPB
  #undef EX
  #undef VRD
  #undef KRD
  #undef STEP
  #undef ENDW
  {auto rr=__builtin_amdgcn_permlane32_swap(__float_as_uint(l_reg),__float_as_uint(l_reg),false,false);l_reg=__uint_as_float(rr[0])+__uint_as_float(rr[1]);}
  if(hi==0)wsf[32+r32]=l_reg;asm volatile("s_waitcnt lgkmcnt(0)":::"memory");
  float rli[16];
  #pragma unroll
  for(int r=0;r<16;++r)rli[r]=__builtin_amdgcn_rcpf(wsf[32+crow(r,hi)]);
  if(MODE==0){ float*Of=(float*)Ov+(long)(q0+wid*QBLK)*opitch;
    #pragma unroll
    for(int r=0;r<16;++r){const int orow=crow(r,hi);
      #pragma unroll
      for(int d0=0;d0<2;++d0)Of[(long)orow*opitch+d0*32+r32]=o[d0][r]*rli[r];} }
  else { bf16*Ow=(bf16*)Ov+(long)(q0+wid*QBLK)*opitch; bf16*stg=(bf16*)(shm+LDS_OST)+wid*2048;
    #pragma unroll
    for(int r=0;r<16;++r){const int orow=crow(r,hi);
      #pragma unroll
      for(int d0=0;d0<2;++d0)stg[orow*64+d0*32+r32]=__float2bfloat16(o[d0][r]*rli[r]);}
    asm volatile("s_waitcnt lgkmcnt(0)":::"memory");
    #pragma unroll
    for(int i=0;i<4;++i){const int row=i*8+(lane>>3),ch=lane&7; const u32x4 v=*(const u32x4*)(stg+row*64+ch*8); ATTN_STORE16(Ow+(long)row*opitch+ch*8,v);} }
  asm volatile("s_waitcnt lgkmcnt(0)\n\ts_barrier":::"memory");
  #undef DMA_K
  #undef DMA_V
  #undef CMASK
  #undef RKEEP
  #undef START
  #undef RESC
  #undef ROT
}
constexpr int ATTN_LDS_BYTES=LDS_BYTES;

constexpr int BRA_MAXKT=6, BRA_K=0, BRA_V=BRA_MAXKT*8192, BRA_WS=2*BRA_MAXKT*8192, BRA_LDS_BYTES=BRA_WS+NW*512;
struct BraUnit {
  const bf16* Q; const bf16* K; const bf16* V;
  bf16* PO; float* PL;
  int kbase, kstride, t_first, nkt;
  int nqt;
  int qbase, qstride, slotA;
  const int* list; int nlist, tile0, ownrow0;
};
#define BMX3(a,b,c) __builtin_fmaxf(__builtin_fmaxf((a),(b)),(c))
template<int MODE> __device__ __forceinline__ void bra_unit(const BraUnit&u,char*shm){
  int tid=threadIdx.x; asm volatile("":"+v"(tid)); const int lane=tid&63,r32=lane&31,hi=lane>>5; const int wid=__builtin_amdgcn_readfirstlane(tid>>6);
  const unsigned lds0=(unsigned)(uintptr_t)shm;
  for(int T=u.t_first;T<u.nkt;++T){
    const long krow=u.kbase+(long)u.kstride*(64*T+lane), vrow=u.kbase+(long)u.kstride*(64*T+16*(wid&3)+(lane>>2));
    glds16(u.K+krow*DM+wid*8,(unsigned)__builtin_amdgcn_readfirstlane(lds0+BRA_K+T*8192+wid*1024));
    glds16(u.V+vrow*DM+(wid>>2)*32+(lane&3)*8,(unsigned)__builtin_amdgcn_readfirstlane(lds0+BRA_V+T*8192+wid*1024)); }
  asm volatile("s_waitcnt vmcnt(0)\n\ts_barrier":::"memory");
  float*wsf=(float*)(shm+BRA_WS)+wid*128; int*wsi=(int*)wsf+64;
  const int vbl=(int)(lds0+BRA_V)+((lane>>4)&1)*32+(lane&3)*8+(4*hi+((lane&15)>>2))*64;
  for(int qt=wid;qt<u.nqt;qt+=NW){
    int qrow,ql,Tlo,Thi,slot; bool valid=true,masked=true; unsigned dmax;
    if(MODE==0){ ql=32*qt+r32; qrow=u.qbase+u.qstride*ql; Tlo=(qt>>1)>u.t_first?(qt>>1):u.t_first; Thi=(qt>>1)+2; slot=u.slotA; dmax=128u; }
    else { const int g=u.tile0+qt;
      if(g<8){ ql=32*g+r32; qrow=u.ownrow0+ql; Tlo=0; Thi=g>>1; slot=3; dmax=0x7fffffffu; }
      else { const int e=(g-8)*32+r32; valid=e<u.nlist; const int ent=valid?u.list[e]:0; qrow=ent&0xffff; slot=ent>>16; ql=0; Tlo=0; Thi=3; masked=false; dmax=0x7fffffffu; } }
    bf16x8 qr[4];
    #pragma unroll
    for(int d0=0;d0<4;++d0)qr[d0]=*reinterpret_cast<const bf16x8*>(&u.Q[(long)qrow*DM+d0*16+hi*8]);
    float mhat=0.f,l_reg=0.f; f32x16 o[2]; o[0]=f32x16{}; o[1]=f32x16{}; f32x16 negm=f32x16{};
    for(int T=Tlo;T<=Thi;++T){
      f32x16 p0,p1; qkt(p0,p1,shm+BRA_K+T*8192,qr,negm,r32,hi);
      if(masked){ const int db=ql-64*T-4*hi+((MODE==0)?128:0);
        #pragma unroll
        for(int r=0;r<16;++r){ const int d=db-((r&3)+8*(r>>2)); if((unsigned)d>dmax)p0[r]=-INFINITY; if((unsigned)(d-32)>dmax)p1[r]=-INFINITY; } }
      float a=BMX3(p0[0],p0[1],p1[0]),b=BMX3(p0[2],p0[3],p1[1]); a=BMX3(a,p1[2],p1[3]);
      #pragma unroll
      for(int r=4;r<16;r+=4){a=BMX3(a,p0[r],p0[r+1]);b=BMX3(b,p0[r+2],p0[r+3]);a=BMX3(a,p1[r],p1[r+1]);b=BMX3(b,p1[r+2],p1[r+3]);}
      float rm=__builtin_fmaxf(a,b); { auto rr=__builtin_amdgcn_permlane32_swap(__float_as_uint(rm),__float_as_uint(rm),false,false); rm=__builtin_fmaxf(__uint_as_float(rr[0]),__uint_as_float(rr[1])); }
      if(__any(rm>8.f)){ const float dl=(rm>8.f)?rm:0.f; mhat+=dl;
        #pragma unroll
        for(int r=0;r<16;++r){p0[r]-=dl;p1[r]-=dl;}
        #pragma unroll
        for(int r=0;r<16;++r)negm[r]=-mhat;
        const float f=__builtin_amdgcn_exp2f(-dl); l_reg*=f; if(hi==0)wsf[r32]=f;
        asm volatile("s_waitcnt lgkmcnt(0)":::"memory");
        #pragma unroll
        for(int d_=0;d_<2;++d_)
          #pragma unroll
          for(int r=0;r<16;++r)o[d_][r]*=wsf[crow(r,hi)];
        asm volatile("s_waitcnt lgkmcnt(0)":::"memory"); }
      float sacc=0.f;
      #pragma unroll
      for(int r=0;r<16;++r){p0[r]=__builtin_amdgcn_exp2f(p0[r]);p1[r]=__builtin_amdgcn_exp2f(p1[r]);sacc+=p0[r]+p1[r];}
      l_reg+=sacc;
      u32x4 pw0,pw1,pw2,pw3;
      pw0=(u32x4){cvtpk_s(p0[0],p0[1]),cvtpk_s(p0[2],p0[3]),cvtpk_s(p0[4],p0[5]),cvtpk_s(p0[6],p0[7])}; pw1=(u32x4){cvtpk_s(p0[8],p0[9]),cvtpk_s(p0[10],p0[11]),cvtpk_s(p0[12],p0[13]),cvtpk_s(p0[14],p0[15])};
      pw2=(u32x4){cvtpk_s(p1[0],p1[1]),cvtpk_s(p1[2],p1[3]),cvtpk_s(p1[4],p1[5]),cvtpk_s(p1[6],p1[7])}; pw3=(u32x4){cvtpk_s(p1[8],p1[9]),cvtpk_s(p1[10],p1[11]),cvtpk_s(p1[12],p1[13]),cvtpk_s(p1[14],p1[15])};
      SBAR(); pv(o,vbl+T*8192,__builtin_bit_cast(bf16x8,pw0),__builtin_bit_cast(bf16x8,pw1),__builtin_bit_cast(bf16x8,pw2),__builtin_bit_cast(bf16x8,pw3));
    }
    {auto rr=__builtin_amdgcn_permlane32_swap(__float_as_uint(l_reg),__float_as_uint(l_reg),false,false);l_reg=__uint_as_float(rr[0])+__uint_as_float(rr[1]);}
    if(hi==0){ wsf[r32]=l_reg; wsi[r32]=valid?(slot*SEQ+qrow):-1; }
    asm volatile("s_waitcnt lgkmcnt(0)":::"memory");
    if(hi==0&&valid) u.PL[(long)(slot*SEQ+qrow)*8]=mhat+__builtin_amdgcn_logf(l_reg);
    #pragma unroll
    for(int r=0;r<16;++r){ const int orow=crow(r,hi); const float rl=__builtin_amdgcn_rcpf(wsf[orow]); const int dst=wsi[orow];
      if(dst>=0){ bf16*op=u.PO+(long)dst*512+r32; op[0]=__float2bfloat16(o[0][r]*rl); op[32]=__float2bfloat16(o[1][r]*rl); } }
    asm volatile("s_waitcnt lgkmcnt(0)":::"memory");
  }
  asm volatile("s_waitcnt vmcnt(0) lgkmcnt(0)\n\ts_barrier":::"memory");
}
#undef BMX3
#undef SBAR
#undef WAIT_BAR
}


constexpr int NWAVES = 8;
#ifndef MK_N_LAUNCHES
#define MK_N_LAUNCHES 1
#endif
constexpr int N_PHASES = 24;
static_assert(MK_N_LAUNCHES == 1 || MK_N_LAUNCHES == N_PHASES, "MK_N_LAUNCHES is 1 or 24");

constexpr int S_ = 16384, DM_ = 2048, INW = 6144, NEXP = 16, DEXP = 1024, DEPTH = 2, NROWBLK = 256  ;
constexpr int C_QA = 0, C_KA = 512, C_VA = 1024, C_QB = 1536, C_KB = 2048, C_VB = 2560, C_QC = 3072, C_KC = 4096, C_VC = 5120;
constexpr int MAXPOS = 2 * S_ + NEXP * 256;
constexpr float RMS_EPS = 1e-6f;

constexpr size_t MiB = 1u << 20;
constexpr size_t WS_CTL = 0, CTL_ZERO_BYTES = 1 * MiB;
constexpr size_t WS_MOD = 1 * MiB;
constexpr size_t WS_COS = 2 * MiB, WS_SIN = 4 * MiB;
constexpr size_t WS_EID = 6 * MiB;
constexpr size_t WS_WTS = WS_EID + 131072;
constexpr size_t WS_ROWTOK = WS_WTS + 131072;
constexpr size_t WS_ROWW = WS_ROWTOK + 163840;
constexpr size_t WS_CNT = WS_ROWW + 163840;
constexpr size_t WS_KMEAN = 8 * MiB;
constexpr size_t WS_WIN = 16 * MiB;
constexpr size_t WS_WOUT = 64 * MiB;
constexpr size_t WS_WGU = 80 * MiB;
constexpr size_t WS_WDN = 336 * MiB;
constexpr size_t WS_H = 464 * MiB;
constexpr size_t WS_PROJ = 528 * MiB;
constexpr size_t WS_MERGED = 720 * MiB;
constexpr size_t WS_T = 784 * MiB;
constexpr size_t WS_ACT = 912 * MiB;
constexpr size_t WS_XS = 984 * MiB;
constexpr size_t WS_POA = WS_ACT;
constexpr size_t WS_POB = WS_POA + 48 * MiB;
constexpr size_t WS_PLA = WS_POB + 64 * MiB;
constexpr size_t WS_PLB = WS_PLA + 2 * MiB;
constexpr size_t WS_LIST = WS_PLB + 2 * MiB;
static_assert(WS_LIST + 32 * MiB <= 1128 * MiB, "partials and lists inside the MoE-only regions");
constexpr size_t WS_Y = WS_PROJ;
constexpr size_t WS_END = 1128 * MiB;
static_assert(WS_XS + (size_t)MAXPOS * 2048 * 2 <= WS_END && WS_ACT + (size_t)MAXPOS * 1024 * 2 <= WS_XS && WS_CNT + 16384 <= WS_KMEAN, "d_ws map");
constexpr int CW_TMO = 0, CW_CODE = 1, CW_BAR = 4096;
constexpr int CW_CNTB = 8192;
constexpr int CW_QUEUE = 8192 + 1024;

constexpr int RING_OFF = 0, RING_BYTES = 131072;
constexpr int LDSCTL_OFF = RING_BYTES, MISC_OFF = LDSCTL_OFF + 320;
constexpr int LT_SEGS = LDSCTL_OFF + 1024;
constexpr int LT_TOT = LT_SEGS + 128;
constexpr int LT_BASE = LT_TOT + 64;
constexpr int LT_CNT = LT_BASE + 64;
constexpr int LT_P2E = LT_CNT + 64;
constexpr int LT_POS = LT_P2E + 160;
constexpr int LDS_BYTES = 147456;
constexpr int ATT_KM_OFF = 0;
constexpr int ATT_UST_OFF = 106496, ATT_QN_OFF = ATT_UST_OFF + 2304;
static_assert(LT_POS + 512 <= LDS_BYTES && attn_body::ATTN_LDS_BYTES <= ATT_UST_OFF && attn_body::BRA_LDS_BYTES <= ATT_UST_OFF && ATT_QN_OFF + 64 <= RING_BYTES, "LDS map");

#define GAS __attribute__((address_space(1)))
#define LAS __attribute__((address_space(3)))
typedef unsigned short bf16;
typedef unsigned v4u __attribute__((ext_vector_type(4)));
typedef unsigned v2u __attribute__((ext_vector_type(2)));
typedef float f32x4 __attribute__((ext_vector_type(4)));
typedef short bf16x8 __attribute__((ext_vector_type(8)));
typedef GAS unsigned gu32;
#define RLX_AGENT __ATOMIC_RELAXED, __HIP_MEMORY_SCOPE_AGENT
#define LDS_WAIT() asm volatile("s_waitcnt lgkmcnt(0)" ::: "memory")
__device__ __forceinline__ unsigned f2bf(float f) { unsigned u = __builtin_bit_cast(unsigned, f); return (u + 0x7fffu + ((u >> 16) & 1u)) >> 16; }
__device__ __forceinline__ unsigned pk2(float lo, float hi) { return f2bf(lo) | (f2bf(hi) << 16); }
__device__ __forceinline__ float bflo(unsigned w) { return __builtin_bit_cast(float, w << 16); }
__device__ __forceinline__ float bfhi(unsigned w) { return __builtin_bit_cast(float, w & 0xffff0000u); }
__device__ __forceinline__ float wave_sum(float v) {
#pragma unroll
    for (int o = 1; o < 64; o <<= 1) v += __shfl_xor(v, o);
    return v;
}

#define XB_TMO      128
#define XB_XCNT(j)  (256  + 64 * (j))
#define XB_XSUB(j)  (1280 + 64 * (j))
#define XB_XGEN(j)  (2304 + 64 * (j))
#define XB_TOP      3328
#define XB_TOPGEN   3392
#define XCD_BAR_WORDS 3456
#define XB_SPIN_CAP (1u << 18)

__device__ __forceinline__ unsigned xb_ld(unsigned* p)              { return __hip_atomic_load(p, __ATOMIC_RELAXED, __HIP_MEMORY_SCOPE_AGENT); }
__device__ __forceinline__ unsigned xb_add(unsigned* p, unsigned v) { return __hip_atomic_fetch_add(p, v, __ATOMIC_RELAXED, __HIP_MEMORY_SCOPE_AGENT); }
__device__ __forceinline__ unsigned xb_xcc_id() { return (unsigned)__builtin_amdgcn_s_getreg((3 << 11) | 20) & 0xFu; }
#define XB_SPIN(cond, bar) do { unsigned _sp = 0; while (cond) { __builtin_amdgcn_s_sleep(1); \
    if ((++_sp & 255u) == 0u) { if (xb_ld(&(bar)[XB_TMO])) break; if (_sp > XB_SPIN_CAP) { atomicAdd(&(bar)[XB_TMO], 1u); break; } } } } while (0)

struct XcdBarrier {
    unsigned* bar; unsigned x;
    volatile LAS unsigned* st;
};

__device__ __forceinline__ XcdBarrier xcd_barrier_post(unsigned* bar, volatile LAS unsigned* st) {
    XcdBarrier b; b.bar = bar; b.x = xb_xcc_id(); b.st = st;
    if (threadIdx.x == 0) (void)xb_add(&bar[XB_XCNT(b.x)], 1u);
    return b;
}
__device__ __forceinline__ void xcd_barrier_complete(unsigned* bar, unsigned x, unsigned& nloc, unsigned& nx) {
    const unsigned G = gridDim.x * gridDim.y * gridDim.z;
    unsigned sum, cnt, mine, sp = 0u;
    for (;;) {
        sum = 0u; cnt = 0u; mine = 0u;
#pragma unroll
        for (unsigned j = 0; j < 16; ++j) { const unsigned c = xb_ld(&bar[XB_XCNT(j)]); sum += c; cnt += (c > 0u) ? 1u : 0u; mine = (j == x) ? c : mine; }
        if (sum == G) break;
        __builtin_amdgcn_s_sleep(1);
        if ((++sp & 255u) == 0u) { if (xb_ld(&bar[XB_TMO])) break; if (sp > XB_SPIN_CAP) { atomicAdd(&bar[XB_TMO], 1u); break; } }
    }
    nloc = mine > 0u ? mine : 1u; nx = cnt > 0u ? cnt : 1u;
}

__device__ __forceinline__ void xcd_barrier(const XcdBarrier& b) {
    asm volatile("s_waitcnt vmcnt(0)" ::: "memory");
    __syncthreads();
    if (threadIdx.x == 0) {
        unsigned* bar = b.bar; asm volatile("" : "+s"(bar));
        __builtin_amdgcn_s_waitcnt(0);
        unsigned nloc = b.st[0], nx = b.st[1];
        if (nloc == 0u) { xcd_barrier_complete(bar, b.x, nloc, nx); b.st[0] = nloc; b.st[1] = nx; }
        const unsigned old = xb_add(&bar[XB_XSUB(b.x)], 1u);
        const unsigned gen = old / nloc;
        if (old + 1u == (gen + 1u) * nloc) {
            __builtin_amdgcn_fence(__ATOMIC_RELEASE, "agent");
            asm volatile("s_waitcnt vmcnt(0)" ::: "memory");
            const unsigned og = xb_add(&bar[XB_TOP], 1u);
            const unsigned tg = og / nx;
            if (og + 1u == (tg + 1u) * nx) xb_add(&bar[XB_TOPGEN], 1u);
            else XB_SPIN(xb_ld(&bar[XB_TOPGEN]) == tg, bar);
            __builtin_amdgcn_fence(__ATOMIC_ACQUIRE, "agent");
            xb_add(&bar[XB_XGEN(b.x)], 1u);
            asm volatile("s_waitcnt vmcnt(0)" ::: "memory");
        } else {
            XB_SPIN(xb_ld(&bar[XB_XGEN(b.x)]) == gen, bar);
            __builtin_amdgcn_fence(__ATOMIC_ACQUIRE, "agent");
            asm volatile("s_waitcnt vmcnt(0)" ::: "memory");
        }
    }
    __syncthreads();
}


__device__ __forceinline__ int dest_row(int map, int n) {
    if (map == 1) { const int seg = n >> 9; const bool qk = (seg == 0) || (seg == 1) || (seg == 3) || (seg == 4) || (seg >= 6 && seg <= 9); if (!qk) return n; const int j = n & 63; return (n & ~63) + ((j < 32) ? 2 * j : 2 * (j - 32) + 1); }
    if (map == 2) return 8 * (n >> 2) + (n & 3);
    if (map == 3) return 8 * (n >> 2) + 4 + (n & 3);
    return n;
}
__device__ __forceinline__ void p0_transpose_item(const float* W, int K, int N, bf16* WT, int map, LAS float* scr, int item, int lane) {
    const int nblk = N / 32, kb = item / nblk, nb = item % nblk, k0 = 64 * kb, n0 = 32 * nb;
#pragma unroll 8
    for (int i = 0; i < 32; ++i) { const int kk = 2 * i + (lane >> 5); scr[kk * 33 + (lane & 31)] = W[(size_t)(k0 + kk) * N + n0 + (lane & 31)]; }
    LDS_WAIT(); asm volatile("" ::: "memory");
    const int c = lane & 7;
#pragma unroll
    for (int j = 0; j < 4; ++j) { const int n = (lane >> 3) + 8 * j; const LAS float* s = scr + (8 * c) * 33 + n;
        v4u o; o.x = pk2(s[0 * 33], s[1 * 33]); o.y = pk2(s[2 * 33], s[3 * 33]); o.z = pk2(s[4 * 33], s[5 * 33]); o.w = pk2(s[6 * 33], s[7 * 33]);
        *(GAS v4u*)(WT + (size_t)dest_row(map, n0 + n) * K + k0 + 8 * c) = o; }
    LDS_WAIT(); asm volatile("" ::: "memory");
}

struct Args { const void* in[20]; float* out; unsigned char* ws; int ph_lo, ph_hi; };

__global__ void __launch_bounds__(NWAVES * 64, 2) fwd(Args args) {
    extern __shared__ __attribute__((aligned(16))) unsigned char lds[];
    LAS unsigned char* const L = (LAS unsigned char*)lds;
    const int G = gridDim.x, bx = blockIdx.x;
    const int vcu = (G % 8 == 0) ? (bx % 8) * (G / 8) + bx / 8 : bx;
    const int NGW = G * NWAVES;
    typedef __attribute__((address_space(4))) const Args* kargp_t;
#define PHASE_BEGIN() \
    kargp_t ka = (kargp_t)__builtin_amdgcn_kernarg_segment_ptr(); asm volatile("" : "+s"(ka)); \
    unsigned char* const ws = ka->ws; \
    int tid = threadIdx.x; asm volatile("" : "+v"(tid)); \
    const int lane = tid & 63, wave = __builtin_amdgcn_readfirstlane(tid >> 6); const int gw = vcu * NWAVES + wave; (void)gw; (void)lane; (void)ws
#define KIN(T, k) ((const T*)ka->in[k])
    LAS int* const segs = (LAS int*)(L + LT_SEGS); LAS int* const tot = (LAS int*)(L + LT_TOT); LAS int* const basee = (LAS int*)(L + LT_BASE); LAS int* const cnt16 = (LAS int*)(L + LT_CNT);
    LAS unsigned char* const p2e = L + LT_P2E; LAS int* const postab = (LAS int*)(L + LT_POS);
    gu32* const ctl = (gu32*)(args.ws + WS_CTL);

    for (int u = threadIdx.x; u < (LDS_BYTES - LDSCTL_OFF) / 4; u += NWAVES * 64) ((LAS unsigned*)(L + LDSCTL_OFF))[u] = 0u;
    __syncthreads();
    const int lo = args.ph_lo, hi = args.ph_hi;
    XcdBarrier bar; bar.bar = (unsigned*)(ctl + CW_BAR); bar.x = 0; bar.st = nullptr;
    if (hi - lo > 1) bar = xcd_barrier_post((unsigned*)(ctl + CW_BAR), (volatile LAS unsigned*)(L + MISC_OFF) + 8);
#ifndef PHMASK
#define PHMASK 0x1fff
#endif
#define IN(k) (lo <= (k) && (k) < hi)
#define INJ(j) ((((PHMASK) >> (j)) & 1) && IN(pb + (j)))
#define SEAM(k) do { if (IN(k) && IN((k) + 1)) xcd_barrier(bar); } while (0)

#define COMPUTE_SEGMENTS(myrb) do { \
        _Pragma("unroll") for (int q_ = 0; q_ < 2; ++q_) { const int e_ = 2 * wave + q_; int t_ = 0, p_ = 0; \
            _Pragma("unroll") for (int j_ = 0; j_ < 4; ++j_) { const int rb_ = lane + 64 * j_; const int c_ = CNT[rb_ * 16 + e_]; t_ += c_; p_ += (rb_ < (myrb)) ? c_ : 0; } \
            t_ = (int)wave_sum((float)t_); p_ = (int)wave_sum((float)p_); if (lane == 0) { tot[e_] = t_; basee[e_] = p_; } } \
        __syncthreads(); \
        if (tid == 0) { int s_ = 0; for (int e_ = 0; e_ < 16; ++e_) { segs[e_] = s_; s_ += (tot[e_] + 255) & ~255; } segs[16] = s_; } \
        __syncthreads(); \
        if (tid < 160) { const int r_ = tid * 256; int e_ = 0; for (int k_ = 1; k_ < 16; ++k_) if (r_ >= segs[k_]) e_ = k_; p2e[tid] = (unsigned char)e_; } \
        if (tid < 16) basee[tid] += segs[tid]; \
        __syncthreads(); } while (0)

    if (((PHMASK >> 11) & 1) && IN(0)) {
        PHASE_BEGIN();
        const float* const c_in = KIN(float, 1); const int* const positions = KIN(int, 2); const float* const w_ada = KIN(float, 3); const float* const b_ada = KIN(float, 4);
        const float* const w_in = KIN(float, 7); const float* const w_out = KIN(float, 8); const float* const w_gate = KIN(float, 14); const float* const w_up = KIN(float, 15); const float* const w_down = KIN(float, 16);
        float* const MOD = (float*)(ws + WS_MOD); float* const COS = (float*)(ws + WS_COS); float* const SIN = (float*)(ws + WS_SIN);
        bf16* const WIN = (bf16*)(ws + WS_WIN); bf16* const WOUT = (bf16*)(ws + WS_WOUT); bf16* const WGU = (bf16*)(ws + WS_WGU); bf16* const WDN = (bf16*)(ws + WS_WDN);
        for (int it = bx; it < 96; it += G) {
            const int l = it / 48, cg = it % 48, col = cg * 256 + lane * 4;
            const float* W = w_ada + ((size_t)l * 2048 + wave * 256) * 12288 + col; const float* cc = c_in + wave * 256;
            f32x4 a = (f32x4){0.f, 0.f, 0.f, 0.f};
#pragma unroll 8
            for (int k = 0; k < 256; ++k) { const float cv = cc[k]; const float sv = cv / (1.f + expf(-cv)); a += sv * *(const GAS f32x4*)(W + (size_t)k * 12288); }
            LAS f32x4* red = (LAS f32x4*)L; red[wave * 64 + lane] = a;
            __syncthreads();
            if (tid < 256) { float s = 0.f; const LAS float* rf = (const LAS float*)L;
#pragma unroll
                for (int w = 0; w < 8; ++w) s += rf[(w * 64 + (tid >> 2)) * 4 + (tid & 3)];
                MOD[l * 12288 + cg * 256 + tid] = s + b_ada[l * 12288 + cg * 256 + tid]; }
            __syncthreads();
        }
        { LAS float* scr = (LAS float*)(L + RING_OFF + wave * 16384);
          constexpr int I_IN = 2 * 32 * 192, I_OUT = 2 * 32 * 64, I_G = 32 * 32 * 32, I_D = 32 * 16 * 64, NITEMS = I_IN + I_OUT + 2 * I_G + I_D;
          for (int it = gw; it < NITEMS; it += NGW) {
              int r = it;
              if (r < I_IN) { const int l = r / 6144; p0_transpose_item(w_in + (size_t)l * 2048 * 6144, 2048, 6144, WIN + (size_t)l * 6144 * 2048, 1, scr, r % 6144, lane); continue; } r -= I_IN;
              if (r < I_OUT) { const int l = r / 2048; p0_transpose_item(w_out + (size_t)l * 2048 * 2048, 2048, 2048, WOUT + (size_t)l * 2048 * 2048, 0, scr, r % 2048, lane); continue; } r -= I_OUT;
              if (r < I_G) { const int mt = r / 1024; p0_transpose_item(w_gate + (size_t)mt * 2048 * 1024, 2048, 1024, WGU + (size_t)mt * 2048 * 2048, 2, scr, r % 1024, lane); continue; } r -= I_G;
              if (r < I_G) { const int mt = r / 1024; p0_transpose_item(w_up + (size_t)mt * 2048 * 1024, 2048, 1024, WGU + (size_t)mt * 2048 * 2048, 3, scr, r % 1024, lane); continue; } r -= I_G;
              { const int mt = r / 1024; p0_transpose_item(w_down + (size_t)mt * 1024 * 2048, 1024, 2048, WDN + (size_t)mt * 2048 * 1024, 0, scr, r % 1024, lane); }
          } }
        for (int idx = (vcu * NWAVES * 64 + tid); idx < S_ * 32; idx += G * NWAVES * 64) {
            const int pi = idx >> 5, i = idx & 31; const float inv = (float)exp2(-(double)i * (13.287712379549449 / 32.0)); const float ang = (float)positions[pi] * inv;
            COS[idx] = (float)cos((double)ang); SIN[idx] = (float)sin((double)ang); }
    }
    SEAM(0);

    for (int l = 0; l < DEPTH; ++l) {
        const int pb = 1 + 11 * l;
        const float lam_init = (l == 0) ? 0.2f : 0.35550906759f;
        if (INJ(0)) {
            PHASE_BEGIN();
            const float* const x_in = KIN(float, 0); const float* const g_attn = KIN(float, 5); float* const xbuf = ka->out;
            const float* const MOD = (const float*)(ws + WS_MOD); const float* const mod = MOD + l * 12288; bf16* const HB = (bf16*)(ws + WS_H); const bf16* const YB = (const bf16*)(ws + WS_Y);
            f32x4 cA[8], cB[8], cG[8];
#pragma unroll
            for (int j = 0; j < 8; ++j) { const int c4 = lane + 64 * j; const f32x4 g = ((const f32x4*)(g_attn + l * 2048))[c4]; const f32x4 sc = ((const f32x4*)(mod + 2048))[c4];
                cA[j] = g * (1.f + sc); cB[j] = ((const f32x4*)(mod + 0))[c4]; cG[j] = (l > 0) ? ((const f32x4*)(MOD + (l - 1) * 12288 + 10240))[c4] : (f32x4){0.f, 0.f, 0.f, 0.f}; }
            const float* xsrc = (l == 0) ? x_in : xbuf;
            for (int row = gw; row < S_; row += NGW) {
                f32x4 v[8];
#pragma unroll
                for (int j = 0; j < 8; ++j) v[j] = ((const GAS f32x4*)(xsrc + (size_t)row * 2048))[lane + 64 * j];
                if (l > 0) {
#pragma unroll
                    for (int j = 0; j < 8; ++j) { const v2u a = ((const GAS v2u*)(YB + (size_t)(2 * row) * 2048))[lane + 64 * j], b = ((const GAS v2u*)(YB + (size_t)(2 * row + 1) * 2048))[lane + 64 * j];
                        const f32x4 ys = (f32x4){bflo(a.x) + bflo(b.x), bfhi(a.x) + bfhi(b.x), bflo(a.y) + bflo(b.y), bfhi(a.y) + bfhi(b.y)};
                        v[j] += cG[j] * ys; ((GAS f32x4*)(xbuf + (size_t)row * 2048))[lane + 64 * j] = v[j]; }
                }
                float ss = 0.f;
#pragma unroll
                for (int j = 0; j < 8; ++j) ss += (v[j].x * v[j].x + v[j].y * v[j].y) + (v[j].z * v[j].z + v[j].w * v[j].w);
                const float rs = 1.f / sqrtf(wave_sum(ss) * (1.f / 2048.f) + RMS_EPS);
#pragma unroll
                for (int j = 0; j < 8; ++j) { const f32x4 o = v[j] * rs * cA[j] + cB[j]; v2u w; w.x = pk2(o.x, o.y); w.y = pk2(o.z, o.w); ((GAS v2u*)(HB + (size_t)row * 2048))[lane + 64 * j] = w; }
            }
        }
        SEAM(pb + 0);
        if (INJ(1)) {
            PHASE_BEGIN();
            bf16* const HB = (bf16*)(ws + WS_H); bf16* const WIN = (bf16*)(ws + WS_WIN); bf16* const PROJ = (bf16*)(ws + WS_PROJ); const float* const COS = (const float*)(ws + WS_COS); const float* const SIN = (const float*)(ws + WS_SIN);
            pg8::DenseSched Sd; Sd.init(HB, WIN + (size_t)l * 6144 * 2048, S_, INW, 2048, G, bx);
            pg8::EpiProj E{PROJ, COS, SIN, attn_body::C2};
            pg8::gemm_phase<pg8::EpiProj, pg8::DenseSched, true, true>(L + RING_OFF, 2048, Sd, E);
        }
        SEAM(pb + 1);
        if (INJ(2)) {
            PHASE_BEGIN();
            const bf16* const PROJ = (const bf16*)(ws + WS_PROJ); float* const KMEAN = (float*)(ws + WS_KMEAN);
            for (int t = gw; t < 512; t += NGW) { const int h = t >> 6, j = t & 63; const int rg = lane >> 3, ch = lane & 7;
                float a[8];
#pragma unroll
                for (int e = 0; e < 8; ++e) a[e] = 0.f;
                for (int it = 0; it < 32; ++it) { const v4u w = *(const GAS v4u*)(PROJ + (size_t)(256 * j + 8 * it + rg) * 6144 + C_KB + 64 * h + 8 * ch);
                    a[0] += bflo(w.x); a[1] += bfhi(w.x); a[2] += bflo(w.y); a[3] += bfhi(w.y); a[4] += bflo(w.z); a[5] += bfhi(w.z); a[6] += bflo(w.w); a[7] += bfhi(w.w); }
#pragma unroll
                for (int e = 0; e < 8; ++e) { a[e] += __shfl_xor(a[e], 8); a[e] += __shfl_xor(a[e], 16); a[e] += __shfl_xor(a[e], 32); }
                if (lane < 8) {
#pragma unroll
                    for (int e = 0; e < 8; ++e) KMEAN[(size_t)(h * 64 + j) * 64 + 8 * lane + e] = a[e] * (1.f / 256.f); }
            }
        }
        SEAM(pb + 2);
        if (INJ(3)) {
            PHASE_BEGIN();
            const bf16* const PROJ = (const bf16*)(ws + WS_PROJ); const float* const KMEAN = (const float*)(ws + WS_KMEAN); int* const LISTB = (int*)(ws + WS_LIST);
            int* const CNTB = (int*)(ctl + CW_CNTB + l * 512);
            for (int it = vcu; it < 512; it += G) { const int hd = it & 7, qq = it >> 3, qb = (qq & 1) ? 63 - (qq >> 1) : (qq >> 1);
                if (qb == 0) continue;
                LAS float* km = (LAS float*)(L + ATT_KM_OFF);
                __syncthreads();
                for (int k4 = tid; k4 < qb * 16; k4 += NWAVES * 64) ((LAS f32x4*)km)[k4] = ((const GAS f32x4*)(KMEAN + (size_t)hd * 64 * 64))[k4];
                const int q = tid >> 1, dh = tid & 1; float qf[32];
                { const bf16* qrow = PROJ + (size_t)(qb * 256 + q) * 6144 + C_QB + hd * 64 + dh * 32;
#pragma unroll
                  for (int c8 = 0; c8 < 4; ++c8) { const v4u w = *(const GAS v4u*)(qrow + 8 * c8); qf[8 * c8 + 0] = bflo(w.x); qf[8 * c8 + 1] = bfhi(w.x); qf[8 * c8 + 2] = bflo(w.y); qf[8 * c8 + 3] = bfhi(w.y);
                      qf[8 * c8 + 4] = bflo(w.z); qf[8 * c8 + 5] = bfhi(w.z); qf[8 * c8 + 6] = bflo(w.w); qf[8 * c8 + 7] = bfhi(w.w); } }
                __syncthreads();
                float b0 = -INFINITY, b1 = -INFINITY, b2 = -INFINITY; int i0 = -1, i1 = -1, i2 = -1;
                for (int j = 0; j < qb; ++j) { const LAS f32x4* kr = (const LAS f32x4*)(km + j * 64 + dh * 32); float g = 0.f;
#pragma unroll
                    for (int c4 = 0; c4 < 8; ++c4) { const f32x4 kv = kr[c4]; g = fmaf(qf[4 * c4 + 0], kv.x, g); g = fmaf(qf[4 * c4 + 1], kv.y, g); g = fmaf(qf[4 * c4 + 2], kv.z, g); g = fmaf(qf[4 * c4 + 3], kv.w, g); }
                    g += __shfl_xor(g, 1);
                    if (g > b0) { b2 = b1; i2 = i1; b1 = b0; i1 = i0; b0 = g; i0 = j; } else if (g > b1) { b2 = b1; i2 = i1; b1 = g; i1 = j; } else if (g > b2) { b2 = g; i2 = j; } }
                if (dh == 0) { const int row = qb * 256 + q;
                    if (i0 >= 0) { const int p = __hip_atomic_fetch_add(CNTB + hd * 64 + i0, 1, RLX_AGENT); LISTB[(size_t)(hd * 64 + i0) * 16384 + p] = row; }
                    if (i1 >= 0) { const int p = __hip_atomic_fetch_add(CNTB + hd * 64 + i1, 1, RLX_AGENT); LISTB[(size_t)(hd * 64 + i1) * 16384 + p] = row | (1 << 16); }
                    if (i2 >= 0) { const int p = __hip_atomic_fetch_add(CNTB + hd * 64 + i2, 1, RLX_AGENT); LISTB[(size_t)(hd * 64 + i2) * 16384 + p] = row | (2 << 16); } }
            }
        }
        SEAM(pb + 3);
        if (INJ(4)) {
            PHASE_BEGIN();
            const bf16* const PROJ = (const bf16*)(ws + WS_PROJ); float* const TB = (float*)(ws + WS_T);
            char* const shm = (char*)lds + RING_OFF;
#if !defined(NO_ATT_C)
            for (int vc = vcu; vc < 256; vc += G) {
                const int bhv = vc >> 3, hd = bhv >> 2, mp = (bhv >> 1) & 1, vh = bhv & 1, s = vc & 7;
                const attn_body::bf16* Qp = (const attn_body::bf16*)PROJ + C_QC + hd * 128 + mp * 64; const attn_body::bf16* Kp = (const attn_body::bf16*)PROJ + C_KC + hd * 128 + mp * 64;
                const attn_body::bf16* Vp = (const attn_body::bf16*)PROJ + C_VC + hd * 128 + vh * 64; float* Op = TB + (size_t)mp * S_ * 1024 + hd * 128 + vh * 64;
                for (int i = 7; i >= 0; --i) { const int qb = 16 * (i >> 1) + ((i & 1) ? 15 - s : s);
                    attn_body::attn_unit<8, 0>(qb, 0, Qp, Kp, Vp, (void*)Op, 1024, nullptr, shm); }
            }
#endif
            { int t2 = threadIdx.x; asm volatile("" : "+v"(t2));
              LAS int* const ust = (LAS int*)(L + ATT_UST_OFF); LAS int* const wtot = ust + 520; LAS int* const qn = (LAS int*)(L + ATT_QN_OFF);
              const int* const CNTB = (const int*)(ctl + CW_CNTB + l * 512);
              const int nl = CNTB[t2]; const int nch = (8 + ((nl + 31) >> 5) + 15) >> 4;
              int inc = nch;
#pragma unroll
              for (int o = 1; o < 64; o <<= 1) { const int v = __shfl_up(inc, o); if ((t2 & 63) >= o) inc += v; }
              if ((t2 & 63) == 63) wtot[t2 >> 6] = inc;
              __syncthreads();
              int pre = 0;
              for (int w = 0; w < (t2 >> 6); ++w) pre += wtot[w];
              ust[t2 + 1] = pre + inc; if (t2 == 0) ust[0] = 0;
              __syncthreads();
              const int nB = ust[512], nU = nB + 1536;
              gu32* const qhead = ctl + CW_QUEUE + 64 * l;
              for (;;) {
                  if (t2 == 0) qn[0] = (int)__hip_atomic_fetch_add(qhead, 1u, RLX_AGENT);
                  __syncthreads();
                  const int u = __builtin_amdgcn_readfirstlane(qn[0]);
                  __syncthreads();
                  if (u >= nU) break;
                  attn_body::BraUnit U;
                  if (u < nB) {
                      int lo_ = 0, hi_ = 512;
                      while (hi_ - lo_ > 1) { const int mid = (lo_ + hi_) >> 1; if (ust[mid] <= u) lo_ = mid; else hi_ = mid; }
                      const int hj = lo_, hd = hj >> 6, jb = hj & 63, c = u - ust[hj]; const int nlist = CNTB[hj]; const int ntile = 8 + ((nlist + 31) >> 5);
                      U.Q = (const attn_body::bf16*)PROJ + C_QB + hd * 64; U.K = (const attn_body::bf16*)PROJ + C_KB + hd * 64; U.V = (const attn_body::bf16*)PROJ + C_VB + hd * 64;
                      U.PO = (attn_body::bf16*)(ws + WS_POB) + hd * 64; U.PL = (float*)(ws + WS_PLB) + hd;
                      U.kbase = 256 * jb; U.kstride = 1; U.t_first = 0; U.nkt = 4; U.nqt = (ntile - 16 * c) < 16 ? (ntile - 16 * c) : 16;
                      U.qbase = 0; U.qstride = 0; U.slotA = 0; U.list = (const int*)(ws + WS_LIST) + (size_t)hj * 16384; U.nlist = nlist; U.tile0 = 16 * c; U.ownrow0 = 256 * jb;
                      attn_body::bra_unit<1>(U, shm);
                  } else {
                      const int a = u - nB, hd = a / 192, r = a % 192, pt = r >> 6, w6 = r & 63; const int dil = (pt == 0) ? 1 : (pt == 1) ? 4 : 16;
                      const int nblk = 64 / dil, rho = w6 / nblk, ib = w6 % nblk;
                      U.Q = (const attn_body::bf16*)PROJ + C_QA + hd * 64; U.K = (const attn_body::bf16*)PROJ + C_KA + hd * 64; U.V = (const attn_body::bf16*)PROJ + C_VA + hd * 64;
                      U.PO = (attn_body::bf16*)(ws + WS_POA) + hd * 64; U.PL = (float*)(ws + WS_PLA) + hd;
                      U.kbase = rho + dil * (256 * ib - 128); U.kstride = dil; U.t_first = (ib == 0) ? 2 : 0; U.nkt = 6; U.nqt = 8;
                      U.qbase = rho + dil * 256 * ib; U.qstride = dil; U.slotA = pt; U.list = nullptr; U.nlist = 0; U.tile0 = 0; U.ownrow0 = 0;
                      attn_body::bra_unit<0>(U, shm);
                  }
              }
            }
        }
        SEAM(pb + 4);
        if (INJ(5)) {
            PHASE_BEGIN();
            const float* const lam_q1 = KIN(float, 9); const float* const lam_k1 = KIN(float, 10); const float* const lam_q2 = KIN(float, 11); const float* const lam_k2 = KIN(float, 12); const float* const g_sub = KIN(float, 13);
            const float* const TB = (const float*)(ws + WS_T); bf16* const MERGED = (bf16*)(ws + WS_MERGED);
            const bf16* const POA = (const bf16*)(ws + WS_POA); const bf16* const POB = (const bf16*)(ws + WS_POB); const float* const PLA = (const float*)(ws + WS_PLA); const float* const PLB = (const float*)(ws + WS_PLB);
            const float d1 = wave_sum(lam_q1[l * 64 + lane] * lam_k1[l * 64 + lane]), d2 = wave_sum(lam_q2[l * 64 + lane] * lam_k2[l * 64 + lane]);
            const float lam = expf(d1) - expf(d2) + lam_init;
            const f32x4 gs = ((const f32x4*)(g_sub + l * 128))[lane & 31]; const float osc = 1.f - lam_init;
            for (int row = gw; row < S_; row += NGW) {
                { float ls[3], mx = -INFINITY;
#pragma unroll
                  for (int sl = 0; sl < 3; ++sl) { ls[sl] = PLA[((size_t)sl * S_ + row) * 8 + (lane >> 3)]; mx = fmaxf(mx, ls[sl]); }
                  float acc[8], wsum = 0.f;
#pragma unroll
                  for (int e = 0; e < 8; ++e) acc[e] = 0.f;
#pragma unroll
                  for (int sl = 0; sl < 3; ++sl) { const float wgt = exp2f(ls[sl] - mx); wsum += wgt; const v4u w = ((const GAS v4u*)(POA + ((size_t)sl * S_ + row) * 512))[lane];
                      acc[0] += wgt * bflo(w.x); acc[1] += wgt * bfhi(w.x); acc[2] += wgt * bflo(w.y); acc[3] += wgt * bfhi(w.y); acc[4] += wgt * bflo(w.z); acc[5] += wgt * bfhi(w.z); acc[6] += wgt * bflo(w.w); acc[7] += wgt * bfhi(w.w); }
                  const float iw = 1.f / wsum; v4u o; o.x = pk2(acc[0] * iw, acc[1] * iw); o.y = pk2(acc[2] * iw, acc[3] * iw); o.z = pk2(acc[4] * iw, acc[5] * iw); o.w = pk2(acc[6] * iw, acc[7] * iw);
                  ((GAS v4u*)(MERGED + (size_t)row * 2048))[lane] = o; }
                { const int own = row >> 8, nsel = own < 3 ? own : 3; float ls[4], mx = -INFINITY;
#pragma unroll
                  for (int sl = 0; sl < 4; ++sl) { const bool on = (sl == 3) || (sl < nsel); ls[sl] = on ? PLB[((size_t)sl * S_ + row) * 8 + (lane >> 3)] : -INFINITY; mx = fmaxf(mx, ls[sl]); }
                  float acc[8], wsum = 0.f;
#pragma unroll
                  for (int e = 0; e < 8; ++e) acc[e] = 0.f;
#pragma unroll
                  for (int sl = 0; sl < 4; ++sl) { const bool on = (sl == 3) || (sl < nsel);
                      if (on) { const float wgt = exp2f(ls[sl] - mx); wsum += wgt; const v4u w = ((const GAS v4u*)(POB + ((size_t)sl * S_ + row) * 512))[lane];
                          acc[0] += wgt * bflo(w.x); acc[1] += wgt * bfhi(w.x); acc[2] += wgt * bflo(w.y); acc[3] += wgt * bfhi(w.y); acc[4] += wgt * bflo(w.z); acc[5] += wgt * bfhi(w.z); acc[6] += wgt * bflo(w.w); acc[7] += wgt * bfhi(w.w); } }
                  const float iw = 1.f / wsum; v4u o; o.x = pk2(acc[0] * iw, acc[1] * iw); o.y = pk2(acc[2] * iw, acc[3] * iw); o.z = pk2(acc[4] * iw, acc[5] * iw); o.w = pk2(acc[6] * iw, acc[7] * iw);
                  ((GAS v4u*)(MERGED + (size_t)row * 2048 + 512))[lane] = o; }
#pragma unroll
                for (int j = 0; j < 4; ++j) { const f32x4 a = ((const GAS f32x4*)(TB + (size_t)row * 1024))[lane + 64 * j], b = ((const GAS f32x4*)(TB + (size_t)(S_ + row) * 1024))[lane + 64 * j];
                    const f32x4 v = a - lam * b; float ss = (v.x * v.x + v.y * v.y) + (v.z * v.z + v.w * v.w);
                    ss += __shfl_xor(ss, 1); ss += __shfl_xor(ss, 2); ss += __shfl_xor(ss, 4); ss += __shfl_xor(ss, 8); ss += __shfl_xor(ss, 16);
                    const float rs = 1.f / sqrtf(ss * (1.f / 128.f) + RMS_EPS); const f32x4 o = v * rs * gs * osc;
                    v2u w; w.x = pk2(o.x, o.y); w.y = pk2(o.z, o.w); ((GAS v2u*)(MERGED + (size_t)row * 2048 + 1024))[lane + 64 * j] = w; }
            }
        }
        SEAM(pb + 5);
        if (INJ(6)) {
            PHASE_BEGIN();
            const float* const x_in = KIN(float, 0); float* const xbuf = ka->out; const float* const mod = (const float*)(ws + WS_MOD) + l * 12288;
            bf16* const MERGED = (bf16*)(ws + WS_MERGED); bf16* const WOUT = (bf16*)(ws + WS_WOUT);
            pg8::DenseSched Sd; Sd.init(MERGED, WOUT + (size_t)l * 2048 * 2048, S_, 2048, 2048, G, bx);
            pg8::EpiGateRes E{(l == 0) ? x_in : (const float*)xbuf, xbuf, mod + 4096};
            pg8::gemm_phase<pg8::EpiGateRes, pg8::DenseSched, true, true>(L + RING_OFF, 2048, Sd, E);
        }
        SEAM(pb + 6);
        if (INJ(7)) {
            PHASE_BEGIN();
            const float* const g_mlp = KIN(float, 6); const float* const w_router = KIN(float, 17); const float* const b_router = KIN(float, 18); const float* const xbuf = ka->out;
            const float* const mod = (const float*)(ws + WS_MOD) + l * 12288; bf16* const HB = (bf16*)(ws + WS_H);
            int* const EID = (int*)(ws + WS_EID); float* const WTS = (float*)(ws + WS_WTS); int* const CNT = (int*)(ws + WS_CNT);
            LAS float* const RW = (LAS float*)L;
            for (int idx = tid; idx < 32768; idx += NWAVES * 64) RW[(idx & 15) * 2048 + (idx >> 4)] = w_router[idx];
            f32x4 cA[8], cB[8];
#pragma unroll
            for (int j = 0; j < 8; ++j) { const int c4 = lane + 64 * j; const f32x4 g = ((const f32x4*)(g_mlp + l * 2048))[c4]; const f32x4 sc = ((const f32x4*)(mod + 8192))[c4];
                cA[j] = g * (1.f + sc); cB[j] = ((const f32x4*)(mod + 6144))[c4]; }
            float br[16];
#pragma unroll
            for (int e = 0; e < 16; ++e) br[e] = b_router[e];
            for (int rb = bx; rb < NROWBLK; rb += G) {
                if (tid < 16) cnt16[tid] = 0;
                __syncthreads();
                for (int i = 0; i < 8; ++i) { const int row = 64 * rb + 8 * wave + i;
                    f32x4 v[8]; float ss = 0.f;
#pragma unroll
                    for (int j = 0; j < 8; ++j) { v[j] = ((const GAS f32x4*)(xbuf + (size_t)row * 2048))[lane + 64 * j]; ss += (v[j].x * v[j].x + v[j].y * v[j].y) + (v[j].z * v[j].z + v[j].w * v[j].w); }
                    const float rs = 1.f / sqrtf(wave_sum(ss) * (1.f / 2048.f) + RMS_EPS);
                    float p[16];
#pragma unroll
                    for (int e = 0; e < 16; ++e) p[e] = 0.f;
#pragma unroll
                    for (int j = 0; j < 8; ++j) { const f32x4 o = v[j] * rs * cA[j] + cB[j]; v2u w; w.x = pk2(o.x, o.y); w.y = pk2(o.z, o.w); ((GAS v2u*)(HB + (size_t)row * 2048))[lane + 64 * j] = w;
#pragma unroll
                        for (int e = 0; e < 16; ++e) { const f32x4 w4 = ((const LAS f32x4*)(RW + e * 2048))[lane + 64 * j]; p[e] += (o.x * w4.x + o.y * w4.y) + (o.z * w4.z + o.w * w4.w); } }
#pragma unroll
                    for (int e = 0; e < 16; ++e) p[e] = wave_sum(p[e]);
                    float sg[16], sv[16];
#pragma unroll
                    for (int e = 0; e < 16; ++e) { sv[e] = 1.f / (1.f + expf(-p[e])); sg[e] = sv[e] + br[e]; }
                    float gsc[4];
#pragma unroll
                    for (int g4 = 0; g4 < 4; ++g4) { const float a = sg[4 * g4], b = sg[4 * g4 + 1], c = sg[4 * g4 + 2], d = sg[4 * g4 + 3];
                        const float h1 = fmaxf(a, b), l1 = fminf(a, b), h2 = fmaxf(c, d), l2 = fminf(c, d); gsc[g4] = fmaxf(h1, h2) + fmaxf(fminf(h1, h2), fmaxf(l1, l2)); }
                    int gi = 0; float gb = gsc[0];
#pragma unroll
                    for (int g4 = 1; g4 < 4; ++g4) if (gsc[g4] > gb) { gb = gsc[g4]; gi = g4; }
                    float cd[4], cs[4];
#pragma unroll
                    for (int k = 0; k < 4; ++k) { cd[k] = (gi == 0) ? sg[k] : (gi == 1) ? sg[4 + k] : (gi == 2) ? sg[8 + k] : sg[12 + k]; cs[k] = (gi == 0) ? sv[k] : (gi == 1) ? sv[4 + k] : (gi == 2) ? sv[8 + k] : sv[12 + k]; }
                    int l0 = 0; float v0 = cd[0], s0 = cs[0];
#pragma unroll
                    for (int k = 1; k < 4; ++k) if (cd[k] > v0) { v0 = cd[k]; l0 = k; s0 = cs[k]; }
                    int l1i = -1; float v1 = -INFINITY, s1 = 0.f;
#pragma unroll
                    for (int k = 0; k < 4; ++k) if (k != l0 && cd[k] > v1) { v1 = cd[k]; l1i = k; s1 = cs[k]; }
                    const int e0 = 4 * gi + l0, e1 = 4 * gi + l1i; const float wsum = s0 + s1;
                    if (lane == 0) { EID[2 * row] = e0; EID[2 * row + 1] = e1; WTS[2 * row] = s0 / wsum; WTS[2 * row + 1] = s1 / wsum; atomicAdd((int*)(cnt16 + e0), 1); atomicAdd((int*)(cnt16 + e1), 1); }
                }
                __syncthreads();
                if (tid < 16) CNT[rb * 16 + tid] = cnt16[tid];
                __syncthreads();
            }
        }
        SEAM(pb + 7);
        if (INJ(8)) {
            PHASE_BEGIN();
            const bf16* const HB = (const bf16*)(ws + WS_H); bf16* const XS = (bf16*)(ws + WS_XS);
            const int* const EID = (const int*)(ws + WS_EID); const float* const WTS = (const float*)(ws + WS_WTS); int* const ROWTOK = (int*)(ws + WS_ROWTOK); float* const ROWW = (float*)(ws + WS_ROWW); const int* const CNT = (const int*)(ws + WS_CNT);
            for (int rb = bx; rb < NROWBLK; rb += G) {
                COMPUTE_SEGMENTS(rb);
                if (wave == 0) { const int row = 64 * rb + lane; const int e0 = EID[2 * row], e1 = EID[2 * row + 1]; int p0 = 0, p1 = 0;
                    const unsigned long long lt = (1ull << lane) - 1ull;
                    for (int e = 0; e < 16; ++e) { const unsigned long long m0 = __ballot(e0 == e), m1 = __ballot(e1 == e); const int r = __popcll(m0 & lt) + __popcll(m1 & lt);
                        if (e0 == e) p0 = basee[e] + r; if (e1 == e) p1 = basee[e] + r; }
                    postab[2 * lane] = p0; postab[2 * lane + 1] = p1;
                    ROWTOK[p0] = 2 * row; ROWTOK[p1] = 2 * row + 1; ROWW[p0] = WTS[2 * row]; ROWW[p1] = WTS[2 * row + 1]; }
                __syncthreads();
                for (int i = 0; i < 8; ++i) { const int r = 8 * wave + i, row = 64 * rb + r; const int p0 = postab[2 * r], p1 = postab[2 * r + 1];
#pragma unroll
                    for (int c = 0; c < 4; ++c) { const v4u w = ((const GAS v4u*)(HB + (size_t)row * 2048))[lane + 64 * c]; ((GAS v4u*)(XS + (size_t)p0 * 2048))[lane + 64 * c] = w; ((GAS v4u*)(XS + (size_t)p1 * 2048))[lane + 64 * c] = w; } }
                if (rb < 16) { const int pbeg = segs[rb] + tot[rb], pend = segs[rb + 1];
                    for (int p = pbeg + tid; p < pend; p += NWAVES * 64) { ROWTOK[p] = -1; ROWW[p] = 0.f; } }
                __syncthreads();
            }
        }
        SEAM(pb + 8);
        if (INJ(9)) {
            PHASE_BEGIN();
            const int* const CNT = (const int*)(ws + WS_CNT); bf16* const XS = (bf16*)(ws + WS_XS); bf16* const WGU = (bf16*)(ws + WS_WGU); bf16* const ACT = (bf16*)(ws + WS_ACT);
            COMPUTE_SEGMENTS(0);
            pg8::MoeSched Sm; Sm.init(XS, WGU + (size_t)l * 16 * 2048 * 2048, segs[16], 2048, 2048, (size_t)2048 * 2048 * 2, (const PG8_LAS unsigned char*)p2e, G, bx);
            pg8::EpiSwiglu E{ACT};
            pg8::gemm_phase<pg8::EpiSwiglu, pg8::MoeSched, true, true>(L + RING_OFF, 2048, Sm, E);
        }
        SEAM(pb + 9);
        if (INJ(10)) {
            PHASE_BEGIN();
            const int* const CNT = (const int*)(ws + WS_CNT); bf16* const ACT = (bf16*)(ws + WS_ACT); bf16* const WDN = (bf16*)(ws + WS_WDN); bf16* const YB = (bf16*)(ws + WS_Y);
            const int* const ROWTOK = (const int*)(ws + WS_ROWTOK); const float* const ROWW = (const float*)(ws + WS_ROWW);
            COMPUTE_SEGMENTS(0);
            pg8::MoeSched Sm; Sm.init(ACT, WDN + (size_t)l * 16 * 2048 * 1024, segs[16], 2048, 1024, (size_t)2048 * 1024 * 2, (const PG8_LAS unsigned char*)p2e, G, bx);
            pg8::EpiDown E{YB, ROWTOK, ROWW};
            pg8::gemm_phase<pg8::EpiDown, pg8::MoeSched, true, true>(L + RING_OFF, 1024, Sm, E);
        }
        SEAM(pb + 10);
    }
    if (((PHMASK >> 12) & 1) && IN(23)) {
        PHASE_BEGIN();
        const float* const g_final = KIN(float, 19); float* const xbuf = ka->out; const float* const MOD = (const float*)(ws + WS_MOD); const bf16* const YB = (const bf16*)(ws + WS_Y);
        f32x4 cA[8], cG[8];
#pragma unroll
        for (int j = 0; j < 8; ++j) { const int c4 = lane + 64 * j; cA[j] = ((const f32x4*)g_final)[c4]; cG[j] = ((const f32x4*)(MOD + 12288 + 10240))[c4]; }
        for (int row = gw; row < S_; row += NGW) {
            f32x4 v[8]; float ss = 0.f;
#pragma unroll
            for (int j = 0; j < 8; ++j) { v[j] = ((const GAS f32x4*)(xbuf + (size_t)row * 2048))[lane + 64 * j];
                const v2u a = ((const GAS v2u*)(YB + (size_t)(2 * row) * 2048))[lane + 64 * j], b = ((const GAS v2u*)(YB + (size_t)(2 * row + 1) * 2048))[lane + 64 * j];
                const f32x4 ys = (f32x4){bflo(a.x) + bflo(b.x), bfhi(a.x) + bfhi(b.x), bflo(a.y) + bflo(b.y), bfhi(a.y) + bfhi(b.y)};
                v[j] += cG[j] * ys; ss += (v[j].x * v[j].x + v[j].y * v[j].y) + (v[j].z * v[j].z + v[j].w * v[j].w); }
            const float rs = 1.f / sqrtf(wave_sum(ss) * (1.f / 2048.f) + RMS_EPS);
#pragma unroll
            for (int j = 0; j < 8; ++j) ((GAS f32x4*)(xbuf + (size_t)row * 2048))[lane + 64 * j] = v[j] * rs * cA[j];
        }
    }
#undef IN
#undef INJ
#undef PHASE_BEGIN
#undef KIN
#undef SEAM
#undef COMPUTE_SEGMENTS
}

extern "C" void kernel_launch(void* const* d_in, const int* in_sizes, int n_in, void* d_out, int out_size, void* d_ws, size_t ws_size, hipStream_t stream) {
    static int grid = 0;
    if (grid == 0) {
        if (n_in != 20 || in_sizes[0] != S_ * DM_ || out_size != S_ * DM_ || ws_size < WS_END) { fprintf(stderr, "kernel_launch: unexpected shapes or workspace (%d inputs, in0 %d, out %d, ws %zu); nothing launched\n", n_in, n_in > 0 ? in_sizes[0] : -1, out_size, ws_size); grid = -1; return; }
        int dev = 0, cus = 0, per_cu = 0;
        if (hipGetDevice(&dev) != hipSuccess || hipDeviceGetAttribute(&cus, hipDeviceAttributeMultiprocessorCount, dev) != hipSuccess) { grid = -1; return; }
        if (hipFuncSetAttribute((const void*)fwd, hipFuncAttributeMaxDynamicSharedMemorySize, LDS_BYTES) != hipSuccess) { fprintf(stderr, "kernel_launch: hipFuncSetAttribute failed\n"); grid = -1; return; }
        if (hipOccupancyMaxActiveBlocksPerMultiprocessor(&per_cu, (const void*)fwd, NWAVES * 64, LDS_BYTES) != hipSuccess || per_cu < 1) fprintf(stderr, "kernel_launch: occupancy query reports %d blocks per CU\n", per_cu);
        (void)hipGetLastError();
        grid = cus;
    }
    if (grid < 0) return;
    if (hipMemsetAsync((char*)d_ws + WS_CTL, 0, CTL_ZERO_BYTES, stream) != hipSuccess) return;
    Args a{};
    for (int i = 0; i < 20; ++i) a.in[i] = d_in[i];
    a.out = (float*)d_out; a.ws = (unsigned char*)d_ws;
    if (MK_N_LAUNCHES == 1) { a.ph_lo = 0; a.ph_hi = N_PHASES; hipLaunchKernelGGL(fwd, dim3(grid), dim3(NWAVES * 64), LDS_BYTES, stream, a); }
    else for (int p = 0; p < N_PHASES; ++p) { a.ph_lo = p; a.ph_hi = p + 1; hipLaunchKernelGGL(fwd, dim3(grid), dim3(NWAVES * 64), LDS_BYTES, stream, a); }
}
```

```cpp
#include <hip/hip_runtime.h>
#include <hip/hip_bf16.h>
#include <cstdio>
#include <cstdint>
#include <cmath>
namespace pg8 {
#define PG8_LAS __attribute__((address_space(3)))
typedef unsigned short bf16_t;
typedef short bf16x8 __attribute__((ext_vector_type(8)));
typedef float f32x4 __attribute__((ext_vector_type(4)));
typedef unsigned u32x4 __attribute__((ext_vector_type(4)));
constexpr int BM = 256, BK = 64, HALF = 128, HTB = HALF * BK * 2  , STAGE_BYTES = 8 * HTB, NXCD = 8, WGM = 8;

__host__ __device__ __forceinline__ int lds_byte(int r, int c) { const int st = (r >> 4) * 2 + (c >> 5), rr = r & 15, cc = c & 31, ob = rr * 64 + cc * 2; return st * 1024 + (ob ^ (((ob >> 9) & 1) << 5)); }
__host__ __device__ __forceinline__ void stage_rc(int b, int& R, int& C) { const int st = b / 1024, sb = b % 1024, swz = sb ^ (((sb >> 9) & 1) << 5); R = (st >> 1) * 16 + swz / 64; C = (st & 1) * 32 + (swz % 64) / 2; }
__host__ __device__ __forceinline__ int perm32(int rho) { const int n = rho >> 4, i = rho & 15; return 8 * (i >> 2) + 4 * n + (i & 3); }

struct Unit { int pm, pn; };
struct Gemm { const bf16_t* A; const bf16_t* Bt; int M, N, K; };

struct StaticOrder {
    int nM, nN, nwg, G, c;
    __host__ __device__ void init(int M, int N, int G_, int c_) { nM = M / BM; nN = N / BM; nwg = nM * nN; G = G_; c = c_; }
    __host__ __device__ bool next(int i, Unit& u) const {
        const long L = (long)i * G + c; if (L >= nwg) return false;
        int wgid = (int)L; { const int q = nwg / NXCD, r = nwg % NXCD, xcd = wgid % NXCD, off = wgid / NXCD; wgid = (xcd < r ? xcd * (q + 1) : r * (q + 1) + (xcd - r) * q) + off; }
        const int nig = WGM * nN, gid = wgid / nig, fm = gid * WGM, gsz = (nM - fm) < WGM ? (nM - fm) : WGM;
        u.pm = fm + ((wgid % nig) % gsz); u.pn = (wgid % nig) / gsz; return true;
    }
    __device__ __forceinline__ void a_ready(const Unit&) const {}
    __device__ __forceinline__ void done(const Unit&) const {}
};

struct DenseSched {
    const char* A; const char* Bt; size_t tstep; StaticOrder so;
    __device__ __forceinline__ void init(const void* A_, const void* Bt_, int M, int N, int K, int G, int c) { A = (const char*)A_; Bt = (const char*)Bt_; tstep = (size_t)BM * K * 2; so.init(M, N, G, c); }
    __device__ __forceinline__ bool next(int i, Unit& u) const { return so.next(i, u); }
    __device__ __forceinline__ const char* a_ptr(const Unit& u) const { return A + (size_t)u.pm * tstep; }
    __device__ __forceinline__ const char* b_ptr(const Unit& u) const { return Bt + (size_t)u.pn * tstep; }
    __device__ __forceinline__ void a_ready(const Unit&) const {}
    __device__ __forceinline__ void done(const Unit&) const {}
};
struct MoeSched {
    const char* A; const char* Bt; size_t tstep, estride; StaticOrder so; const PG8_LAS unsigned char* p2e;
    __device__ __forceinline__ void init(const void* A_, const void* Bt_, int Mpad, int N, int K, size_t estride_, const PG8_LAS unsigned char* p2e_, int G, int c) {
        A = (const char*)A_; Bt = (const char*)Bt_; tstep = (size_t)BM * K * 2; estride = estride_; p2e = p2e_; so.init(Mpad, N, G, c); }
    __device__ __forceinline__ bool next(int i, Unit& u) const { return so.next(i, u); }
    __device__ __forceinline__ const char* a_ptr(const Unit& u) const { return A + (size_t)u.pm * tstep; }
    __device__ __forceinline__ const char* b_ptr(const Unit& u) const { const int e = __builtin_amdgcn_readfirstlane((int)p2e[u.pm]); return Bt + (size_t)e * estride + (size_t)u.pn * tstep; }
    __device__ __forceinline__ void a_ready(const Unit&) const {}
    __device__ __forceinline__ void done(const Unit&) const {}
};

__device__ __forceinline__ unsigned cvt_pk_bf16(float lo, float hi) { unsigned r; asm volatile("v_cvt_pk_bf16_f32 %0, %1, %2" : "=v"(r) : "v"(lo), "v"(hi)); return r; }

struct EpiProj {
    static constexpr bool PERM = true, AFTER_DRAIN = false;
    bf16_t* O; const float* cosT; const float* sinT; float qscale;
    __device__ __forceinline__ void operator()(const f32x4 (&acc)[2][2][4][2], const Unit& u, int wr, int wc, int fr, int fq) const {
        const int pn = u.pn;
        const bool isq = (pn < 2) || (pn == 6) || (pn == 7) || (pn >= 12 && pn < 16);
        const bool isk = (pn == 2) || (pn == 3) || (pn == 8) || (pn == 9) || (pn >= 16 && pn < 20);
        const int row0 = u.pm * BM + wr * 64 + fr, col0 = pn * BM + wc * 32 + 8 * fq;
        const int i0 = (wc & 1) * 16 + 4 * fq;
        const float sc = isq ? qscale : 1.f;
#pragma unroll
        for (int ai = 0; ai < 2; ++ai)
#pragma unroll
            for (int m = 0; m < 4; ++m) { const int row = row0 + ai * HALF + m * 16; bf16_t* rowp = O + (size_t)row * 6144 + col0;
                f32x4 cs = (f32x4){1.f, 1.f, 1.f, 1.f}, sn = (f32x4){0.f, 0.f, 0.f, 0.f};
                if (isq || isk) { cs = *(const f32x4*)(cosT + (size_t)row * 32 + i0); sn = *(const f32x4*)(sinT + (size_t)row * 32 + i0); }
#pragma unroll
                for (int bj = 0; bj < 2; ++bj) { const f32x4 v0 = acc[ai][bj][m][0], v1 = acc[ai][bj][m][1];
                    const float a0 = (v0[0] * cs[0] - v0[1] * sn[0]) * sc, b0 = (v0[1] * cs[0] + v0[0] * sn[0]) * sc;
                    const float a1 = (v0[2] * cs[1] - v0[3] * sn[1]) * sc, b1 = (v0[3] * cs[1] + v0[2] * sn[1]) * sc;
                    const float a2 = (v1[0] * cs[2] - v1[1] * sn[2]) * sc, b2 = (v1[1] * cs[2] + v1[0] * sn[2]) * sc;
                    const float a3 = (v1[2] * cs[3] - v1[3] * sn[3]) * sc, b3 = (v1[3] * cs[3] + v1[2] * sn[3]) * sc;
                    u32x4 w; w.x = cvt_pk_bf16(a0, b0); w.y = cvt_pk_bf16(a1, b1); w.z = cvt_pk_bf16(a2, b2); w.w = cvt_pk_bf16(a3, b3);
                    *(u32x4*)(rowp + bj * HALF) = w; } }
    }
};
struct EpiGateRes {
    static constexpr bool PERM = false, AFTER_DRAIN = false;
    const float* base; float* out; const float* gate;
    __device__ __forceinline__ void operator()(const f32x4 (&acc)[2][2][4][2], const Unit& u, int wr, int wc, int fr, int fq) const {
        const int col0 = u.pn * BM + wc * 32 + 4 * fq;
        f32x4 gv[2][2];
#pragma unroll
        for (int bj = 0; bj < 2; ++bj)
#pragma unroll
            for (int n = 0; n < 2; ++n) gv[bj][n] = *(const f32x4*)(gate + col0 + bj * HALF + n * 16);
#pragma unroll
        for (int ai = 0; ai < 2; ++ai)
#pragma unroll
            for (int m = 0; m < 4; ++m) { const size_t off = (size_t)(u.pm * BM + ai * HALF + wr * 64 + m * 16 + fr) * 2048 + col0;
#pragma unroll
                for (int bj = 0; bj < 2; ++bj)
#pragma unroll
                    for (int n = 0; n < 2; ++n) { const f32x4 bs = *(const f32x4*)(base + off + bj * HALF + n * 16); *(f32x4*)(out + off + bj * HALF + n * 16) = bs + gv[bj][n] * acc[ai][bj][m][n]; } }
    }
};
struct EpiSwiglu {
    static constexpr bool PERM = true, AFTER_DRAIN = false;
    bf16_t* O;
    __device__ __forceinline__ void operator()(const f32x4 (&acc)[2][2][4][2], const Unit& u, int wr, int wc, int fr, int fq) const {
        const int row0 = u.pm * BM + wr * 64 + fr, col0 = u.pn * 128 + wc * 16 + 4 * fq;
        typedef unsigned u32x2 __attribute__((ext_vector_type(2)));
#pragma unroll
        for (int ai = 0; ai < 2; ++ai)
#pragma unroll
            for (int m = 0; m < 4; ++m) { bf16_t* rowp = O + (size_t)(row0 + ai * HALF + m * 16) * 1024 + col0;
#pragma unroll
                for (int bj = 0; bj < 2; ++bj) { const f32x4 g = acc[ai][bj][m][0], up = acc[ai][bj][m][1]; float r[4];
#pragma unroll
                    for (int j = 0; j < 4; ++j) { const float e = __builtin_amdgcn_exp2f(-1.4426950408889634f * g[j]); r[j] = g[j] * __builtin_amdgcn_rcpf(1.f + e) * up[j]; }
                    u32x2 w; w.x = cvt_pk_bf16(r[0], r[1]); w.y = cvt_pk_bf16(r[2], r[3]); *(u32x2*)(rowp + bj * 64) = w; } }
    }
};
struct EpiDown {
    static constexpr bool PERM = true, AFTER_DRAIN = false;
    bf16_t* Y; const int* rowtok; const float* roww;
    __device__ __forceinline__ void operator()(const f32x4 (&acc)[2][2][4][2], const Unit& u, int wr, int wc, int fr, int fq) const {
        const int row0 = u.pm * BM + wr * 64 + fr, col0 = u.pn * BM + wc * 32 + 8 * fq;
#pragma unroll
        for (int ai = 0; ai < 2; ++ai)
#pragma unroll
            for (int m = 0; m < 4; ++m) { const int pos = row0 + ai * HALF + m * 16; const int tk = rowtok[pos]; const float w8 = roww[pos];
                if (tk >= 0) { bf16_t* rowp = Y + (size_t)tk * 2048 + col0;
#pragma unroll
                    for (int bj = 0; bj < 2; ++bj) { const f32x4 v0 = acc[ai][bj][m][0] * w8, v1 = acc[ai][bj][m][1] * w8;
                        u32x4 w; w.x = cvt_pk_bf16(v0[0], v0[1]); w.y = cvt_pk_bf16(v0[2], v0[3]); w.z = cvt_pk_bf16(v1[0], v1[1]); w.w = cvt_pk_bf16(v1[2], v1[3]);
                        *(u32x4*)(rowp + bj * HALF) = w; } } }
    }
};

template <class Epi, class Sched, bool ALIGN_EPI = false, bool SP2 = false>
__device__ __forceinline__ void gemm_phase(PG8_LAS unsigned char* lds, const int K, const Sched& S, const Epi& E) {
    int tid = threadIdx.x; asm volatile("" : "+v"(tid)); const int wid = __builtin_amdgcn_readfirstlane(tid >> 6), lane = tid & 63, wr = wid >> 2, wc = wid & 3, fr = lane & 15, fq = lane >> 4;
    const int nt = K / BK;
    unsigned voffA[2], voffB[2];
#pragma unroll
    for (int i = 0; i < 2; ++i) { int R, C; stage_rc(tid * 16 + i * 8192, R, C); const int Rb = Epi::PERM ? ((R & ~31) + perm32(R & 31)) : R;
        voffA[i] = (unsigned)(R * K + C) * 2u; voffB[i] = (unsigned)(Rb * K + C) * 2u; }
    const size_t kstep = (size_t)(BK * 2);
    const size_t hstep = (size_t)HALF * K * 2;
    const unsigned ldsw = (unsigned)wid * 1024u;
    const int aoff = lds_byte(wr * 64 + fr, fq * 8), boff = lds_byte(wc * 32 + fr, fq * 8);
#define PG8_SA(b, h) (((b) * 2 + (h)) * HTB)
#define PG8_SB(b, h) ((4 + (b) * 2 + (h)) * HTB)
#define PG8_STAGE(bufoff, gbase, voff) do { _Pragma("unroll") for (int _i = 0; _i < 2; ++_i) \
        __builtin_amdgcn_global_load_lds((const unsigned*)((const char*)(gbase) + (voff)[_i]), (PG8_LAS unsigned*)(lds + (bufoff) + ldsw + _i * 8192), 16, 0, 0); } while (0)
#define PG8_LDA(dst, b, h) do { _Pragma("unroll") for (int m = 0; m < 4; ++m) _Pragma("unroll") for (int k = 0; k < 2; ++k) dst[m][k] = *(const PG8_LAS bf16x8*)(lds + PG8_SA(b, h) + aoff + m * 2048 + k * 1024); } while (0)
#define PG8_LDB(dst, b, h) do { _Pragma("unroll") for (int n = 0; n < 2; ++n) _Pragma("unroll") for (int k = 0; k < 2; ++k) dst[n][k] = *(const PG8_LAS bf16x8*)(lds + PG8_SB(b, h) + boff + n * 2048 + k * 1024); } while (0)
#define PG8_MMA(ai, bj, At, Bt) do { __builtin_amdgcn_s_setprio(1); _Pragma("unroll") for (int m = 0; m < 4; ++m) _Pragma("unroll") for (int n = 0; n < 2; ++n) _Pragma("unroll") for (int k = 0; k < 2; ++k) \
        acc[ai][bj][m][n] = __builtin_amdgcn_mfma_f32_16x16x32_bf16(Bt[n][k], At[m][k], acc[ai][bj][m][n], 0, 0, 0); __builtin_amdgcn_s_setprio(0); } while (0)
#define PG8_WAIT_V(n) asm volatile("s_waitcnt vmcnt(" #n ")" ::: "memory")
#define PG8_WAIT_L(n) asm volatile("s_waitcnt lgkmcnt(" #n ")" ::: "memory")
#define PG8_BAR __builtin_amdgcn_s_barrier()
#define PG8_SCHED __builtin_amdgcn_sched_barrier(0)
    Unit cur, nxt; int ui = 0;
    if (!S.next(0, cur)) return;
    f32x4 acc[2][2][4][2];
#pragma unroll
    for (int a = 0; a < 2; ++a)
#pragma unroll
        for (int b = 0; b < 2; ++b)
#pragma unroll
            for (int m = 0; m < 4; ++m)
#pragma unroll
                for (int n = 0; n < 2; ++n) acc[a][b][m][n] = (f32x4){0.f, 0.f, 0.f, 0.f};
    bf16x8 At[4][2], B0[2][2], B1[2][2];
    const char* cA = S.a_ptr(cur); const char* cB = S.b_ptr(cur);
    S.a_ready(cur);
    if constexpr (SP2) {
        PG8_STAGE(PG8_SB(0, 0), cB, voffB); PG8_STAGE(PG8_SB(0, 1), cB + hstep, voffB); PG8_STAGE(PG8_SA(0, 0), cA, voffA); PG8_STAGE(PG8_SA(0, 1), cA + hstep, voffA);
        if (wr == 1) PG8_BAR;
        PG8_WAIT_V(2); PG8_BAR;
        PG8_STAGE(PG8_SB(1, 0), cB + kstep, voffB); PG8_STAGE(PG8_SA(1, 0), cA + kstep, voffA); PG8_STAGE(PG8_SB(1, 1), cB + hstep + kstep, voffB);
        PG8_WAIT_V(6); PG8_BAR;
    } else {
        PG8_STAGE(PG8_SB(0, 0), cB, voffB); PG8_STAGE(PG8_SA(0, 0), cA, voffA); PG8_STAGE(PG8_SB(0, 1), cB + hstep, voffB); PG8_STAGE(PG8_SA(0, 1), cA + hstep, voffA);
        if (wr == 1) PG8_BAR;
        PG8_WAIT_V(4); PG8_BAR;
        PG8_STAGE(PG8_SB(1, 0), cB + kstep, voffB); PG8_STAGE(PG8_SA(1, 0), cA + kstep, voffA); PG8_STAGE(PG8_SB(1, 1), cB + hstep + kstep, voffB);
        PG8_WAIT_V(6); PG8_BAR;
    }
    for (;;) {
        const bool has_next = S.next(ui + 1, nxt);
        const char* nA = has_next ? S.a_ptr(nxt) : cA; const char* nB = has_next ? S.b_ptr(nxt) : cB;
        for (int t = 0; t < nt; t += 2) {
            const bool last = (t == nt - 2);
            const char* a1 = cA + (size_t)(t + 1) * kstep;
            const char* a2 = last ? nA : cA + (size_t)(t + 2) * kstep; const char* b2 = last ? nB : cB + (size_t)(t + 2) * kstep;
            const char* a3 = a2 + kstep; const char* b3 = b2 + kstep;
            if (last && has_next) S.a_ready(nxt);
            if constexpr (SP2) {
            PG8_LDB(B0, 0, 0); PG8_LDB(B1, 0, 1); PG8_SCHED; PG8_LDA(At, 0, 0); PG8_STAGE(PG8_SA(1, 1), a1 + hstep, voffA);
            PG8_WAIT_V(8); PG8_WAIT_L(0); PG8_BAR; PG8_MMA(0, 0, At, B0); PG8_MMA(0, 1, At, B1); PG8_BAR; PG8_SCHED;
            PG8_LDA(At, 0, 1); PG8_STAGE(PG8_SB(0, 0), b2, voffB); PG8_STAGE(PG8_SB(0, 1), b2 + hstep, voffB); PG8_STAGE(PG8_SA(0, 0), a2, voffA);
            PG8_WAIT_V(8); PG8_WAIT_L(0); PG8_BAR; PG8_MMA(1, 0, At, B0); PG8_MMA(1, 1, At, B1); PG8_BAR; PG8_SCHED;
            PG8_LDB(B0, 1, 0); PG8_LDB(B1, 1, 1); PG8_SCHED; PG8_LDA(At, 1, 0); PG8_STAGE(PG8_SA(0, 1), a2 + hstep, voffA);
            PG8_WAIT_V(8); PG8_WAIT_L(0); PG8_BAR; PG8_MMA(0, 0, At, B0); PG8_MMA(0, 1, At, B1); PG8_BAR; PG8_SCHED;
            PG8_LDA(At, 1, 1); PG8_STAGE(PG8_SB(1, 0), b3, voffB); PG8_STAGE(PG8_SB(1, 1), b3 + hstep, voffB); PG8_STAGE(PG8_SA(1, 0), a3, voffA);
            PG8_WAIT_V(8); PG8_WAIT_L(0); PG8_BAR; PG8_MMA(1, 0, At, B0); PG8_MMA(1, 1, At, B1); PG8_BAR; PG8_SCHED;
            } else {
            PG8_LDB(B0, 0, 0); PG8_SCHED; PG8_LDA(At, 0, 0); PG8_STAGE(PG8_SA(1, 1), a1 + hstep, voffA);
            PG8_WAIT_L(8); PG8_BAR; PG8_WAIT_L(0); PG8_MMA(0, 0, At, B0); PG8_BAR; PG8_SCHED;
            PG8_LDB(B1, 0, 1); PG8_STAGE(PG8_SB(0, 0), b2, voffB);
            PG8_BAR; PG8_WAIT_L(0); PG8_MMA(0, 1, At, B1); PG8_BAR;
            PG8_LDA(At, 0, 1); PG8_STAGE(PG8_SA(0, 0), a2, voffA);
            PG8_BAR; PG8_WAIT_L(0); PG8_MMA(1, 0, At, B0); PG8_BAR; PG8_SCHED;
            PG8_STAGE(PG8_SB(0, 1), b2 + hstep, voffB);
            PG8_WAIT_V(6); PG8_BAR; PG8_MMA(1, 1, At, B1); PG8_BAR;
            PG8_LDB(B0, 1, 0); PG8_SCHED; PG8_LDA(At, 1, 0); PG8_STAGE(PG8_SA(0, 1), a2 + hstep, voffA);
            PG8_WAIT_L(8); PG8_BAR; PG8_WAIT_L(0); PG8_MMA(0, 0, At, B0); PG8_BAR; PG8_SCHED;
            PG8_LDB(B1, 1, 1); PG8_STAGE(PG8_SB(1, 0), b3, voffB);
            PG8_BAR; PG8_WAIT_L(0); PG8_MMA(0, 1, At, B1); PG8_BAR;
            PG8_LDA(At, 1, 1); PG8_STAGE(PG8_SA(1, 0), a3, voffA);
            PG8_BAR; PG8_WAIT_L(0); PG8_MMA(1, 0, At, B0); PG8_BAR; PG8_SCHED;
            PG8_STAGE(PG8_SB(1, 1), b3 + hstep, voffB);
            PG8_WAIT_V(6); PG8_BAR; PG8_MMA(1, 1, At, B1); PG8_BAR;
            }
        }
        if constexpr (ALIGN_EPI) { if (wr == 0) PG8_BAR; }
        if constexpr (!Epi::AFTER_DRAIN) { E(acc, cur, wr, wc, fr, fq); S.done(cur); }
        if (!has_next) break;
#pragma unroll
        for (int a = 0; a < 2; ++a)
#pragma unroll
            for (int b = 0; b < 2; ++b)
#pragma unroll
                for (int m = 0; m < 4; ++m)
#pragma unroll
                    for (int n = 0; n < 2; ++n) acc[a][b][m][n] = (f32x4){0.f, 0.f, 0.f, 0.f};
        cur = nxt; cA = nA; cB = nB; ++ui;
        if constexpr (ALIGN_EPI) { if (wr == 1) PG8_BAR; }
    }
    PG8_WAIT_V(0);
    if constexpr (!ALIGN_EPI) { if (wr == 0) PG8_BAR; }
    PG8_BAR;
    if constexpr (Epi::AFTER_DRAIN) { E.fused(acc, cur, wr, wc, fr, fq, lds, wid, lane); S.done(cur); }
#undef PG8_SA
#undef PG8_SB
#undef PG8_STAGE
#undef PG8_LDA
#undef PG8_LDB
#undef PG8_MMA
#undef PG8_WAIT_V
#undef PG8_WAIT_L
#undef PG8_BAR
#undef PG8_SCHED
}
}

#include <hip/hip_bf16.h>
#include <cmath>
namespace attn_body {
using bf16=__hip_bfloat16;
using bf16x8=__attribute__((ext_vector_type(8)))short;
using s16x4=__attribute__((ext_vector_type(4)))short;
using f32x16=__attribute__((ext_vector_type(16)))float;
using u32x4=__attribute__((ext_vector_type(4)))unsigned;
constexpr int SEQ=16384,D=64,DM=6144;
constexpr int NW=8,QBLK=32,QB=QBLK*NW,KVBLK=64,NQB=SEQ/QB;
constexpr int ATTN_UNIT_ROWS=QB;
__device__ __forceinline__ int crow(int r,int hi){return (r&3)+8*(r>>2)+4*hi;}
#define SBAR() __builtin_amdgcn_sched_barrier(0)
__device__ __forceinline__ void cmask(f32x16&p0,f32x16&p1,int jb,int qrel,int hi){
  const float NEG=-INFINITY; int kb=64*jb+4*hi;
  #pragma unroll
  for(int r=0;r<16;++r){int kv=kb+(r&3)+8*(r>>2); if(kv>qrel)p0[r]=NEG; if(kv+32>qrel)p1[r]=NEG;}
}

constexpr int NSLOT=3, SLOTB=8192;
constexpr int LDS_K=0, LDS_V=NSLOT*SLOTB, LDS_WS=2*NSLOT*SLOTB, LDS_OST=LDS_WS+NW*64*4, LDS_BYTES=LDS_OST+NW*4096;
constexpr float C2=0.125f*1.4426950408889634f;
__device__ __forceinline__ void glds16(const void*gsrc,unsigned lds_dst){unsigned keep;
  asm volatile("s_mov_b32 %0, m0\n\ts_mov_b32 m0, %2\n\ts_nop 0\n\tglobal_load_lds_dwordx4 %1, off\n\ts_mov_b32 m0, %0":"=&s"(keep):"v"(gsrc),"s"(lds_dst):"memory");}
__device__ __forceinline__ float max3f(float a,float b,float c){float r;asm("v_max3_f32 %0, %1, %2, %3":"=v"(r):"v"(a),"v"(b),"v"(c));return r;}
__device__ __forceinline__ float max2f(float a,float b){float r;asm("v_max_f32_e32 %0, %1, %2":"=v"(r):"v"(a),"v"(b));return r;}
__device__ __forceinline__ float fadd_s(float a,float b){float r;asm("v_add_f32_e32 %0, %1, %2":"=v"(r):"v"(a),"v"(b));return r;}
__device__ __forceinline__ float fsub_s(float a,float b){float r;asm("v_sub_f32_e32 %0, %1, %2":"=v"(r):"v"(a),"v"(b));return r;}
typedef float f32x2_t __attribute__((ext_vector_type(2))); typedef __bf16 bf16x2_t __attribute__((ext_vector_type(2)));
__device__ __forceinline__ unsigned cvtpk_s(float lo,float hi){f32x2_t v={lo,hi};bf16x2_t b=__builtin_convertvector(v,bf16x2_t);return __builtin_bit_cast(unsigned,b);}
#define WAIT_BAR(N) asm volatile("s_waitcnt vmcnt(" #N ") lgkmcnt(0)\n\ts_barrier":::"memory")

__device__ __forceinline__ void rmask(f32x16&p0,f32x16&p1,bool keep){
  const float NEG=-INFINITY;
  #pragma unroll
  for(int r=0;r<16;++r){ p0[r]=keep?p0[r]:NEG; p1[r]=keep?p1[r]:NEG; }
}
__device__ __forceinline__ float abias(int d){
  const int t1=1+((128-d)>>31);
  const int t4=(((d&3)-1)>>31)&(1+((512-d)>>31));
  const int t16=(((d&15)-1)>>31)&(1+((2048-d)>>31));
  const int m=(t1+t4+t16)&~(d>>31);
  return __builtin_amdgcn_logf((float)m);
}
__device__ __forceinline__ void amask(f32x16&p0,f32x16&p1,int dbase){
  #pragma unroll
  for(int r=0;r<16;++r){ int d=dbase-((r&3)+8*(r>>2)); asm volatile("":"+v"(d)); p0[r]+=abias(d); int d2=d-32; asm volatile("":"+v"(d2)); p1[r]+=abias(d2); }
}
__device__ __forceinline__ void qkt(f32x16&p0,f32x16&p1,const char*Kslot,const bf16x8*qr,const f32x16&negm,int r32,int hi){
  const char*kb=Kslot+hi*1024+r32*16;
  #pragma unroll
  for(int d0=0;d0<4;++d0){
    const bf16x8 b0=*reinterpret_cast<const bf16x8*>(kb+d0*2048);
    const bf16x8 b1=*reinterpret_cast<const bf16x8*>(kb+d0*2048+512);
    if(d0==0){p0=__builtin_amdgcn_mfma_f32_32x32x16_bf16(b0,qr[0],negm,0,0,0);p1=__builtin_amdgcn_mfma_f32_32x32x16_bf16(b1,qr[0],negm,0,0,0);}
    else{p0=__builtin_amdgcn_mfma_f32_32x32x16_bf16(b0,qr[d0],p0,0,0,0);p1=__builtin_amdgcn_mfma_f32_32x32x16_bf16(b1,qr[d0],p1,0,0,0);}}
}
typedef __attribute__((address_space(3))) const char* lds_cptr;
typedef short v4i16_t __attribute__((ext_vector_type(4)));
__device__ __forceinline__ void kload8(bf16x8*kf,lds_cptr kp){
  kf[0]=*(const __attribute__((address_space(3))) bf16x8*)(kp);      kf[1]=*(const __attribute__((address_space(3))) bf16x8*)(kp+512);
  kf[2]=*(const __attribute__((address_space(3))) bf16x8*)(kp+2048); kf[3]=*(const __attribute__((address_space(3))) bf16x8*)(kp+2560);
  kf[4]=*(const __attribute__((address_space(3))) bf16x8*)(kp+4096); kf[5]=*(const __attribute__((address_space(3))) bf16x8*)(kp+4608);
  kf[6]=*(const __attribute__((address_space(3))) bf16x8*)(kp+6144); kf[7]=*(const __attribute__((address_space(3))) bf16x8*)(kp+6656);
}
__device__ __forceinline__ void kload2(bf16x8*kf,lds_cptr kp,int j){ kf[2*j]=*(const __attribute__((address_space(3))) bf16x8*)(kp+j*2048); kf[2*j+1]=*(const __attribute__((address_space(3))) bf16x8*)(kp+j*2048+512); }
__device__ __forceinline__ s16x4 vtr(lds_cptr p){ return __builtin_bit_cast(s16x4,__builtin_amdgcn_ds_read_tr16_b64_v4i16((__attribute__((address_space(3))) v4i16_t*)p)); }
__device__ __forceinline__ float rowmax(const f32x16&p0,const f32x16&p1){
  float a=max3f(p0[0],p0[1],p1[0]),b=max3f(p0[2],p0[3],p1[1]);a=max3f(a,p1[2],p1[3]);
  #pragma unroll
  for(int r=4;r<16;r+=4){a=max3f(a,p0[r],p0[r+1]);b=max3f(b,p0[r+2],p0[r+3]);a=max3f(a,p1[r],p1[r+1]);b=max3f(b,p1[r+2],p1[r+3]);}
  const float m=max2f(a,b);
  auto rr=__builtin_amdgcn_permlane32_swap(__float_as_uint(m),__float_as_uint(m),false,false);
  return max2f(__uint_as_float(rr[0]),__uint_as_float(rr[1]));
}
__device__ __forceinline__ void pv(f32x16*o,int vb,bf16x8 pa0,bf16x8 pa1,bf16x8 pa2,bf16x8 pa3){
  #pragma unroll
  for(int d0=0;d0<2;++d0){s16x4 lo[4],hi[4];
    #pragma unroll
    for(int ks=0;ks<4;++ks){
      asm volatile("ds_read_b64_tr_b16 %0,%1 offset:%c2":"=&v"(lo[ks]):"v"(vb),"i"(d0*4096+ks*1024):"memory");
      asm volatile("ds_read_b64_tr_b16 %0,%1 offset:%c2":"=&v"(hi[ks]):"v"(vb),"i"(d0*4096+ks*1024+512):"memory");}
    asm volatile("s_waitcnt lgkmcnt(0)":::"memory");SBAR();
    #define PK(k) (bf16x8){lo[k][0],lo[k][1],lo[k][2],lo[k][3],hi[k][0],hi[k][1],hi[k][2],hi[k][3]}
    o[d0]=__builtin_amdgcn_mfma_f32_32x32x16_bf16(pa0,PK(0),o[d0],0,0,0);
    o[d0]=__builtin_amdgcn_mfma_f32_32x32x16_bf16(pa1,PK(1),o[d0],0,0,0);
    o[d0]=__builtin_amdgcn_mfma_f32_32x32x16_bf16(pa2,PK(2),o[d0],0,0,0);
    o[d0]=__builtin_amdgcn_mfma_f32_32x32x16_bf16(pa3,PK(3),o[d0],0,0,0);
    #undef PK
  }
}

#ifndef ATTN_STORE16
#define ATTN_STORE16(p,v) (*(u32x4*)(p)=(v))
#endif
template<int THRL,int MODE> __device__ __forceinline__ void attn_unit(int qb,int T0,const bf16*Q,const bf16*__restrict__ K,const bf16*__restrict__ V,void*Ov,int opitch,const unsigned long long*sel,char*shm){
  int tid=threadIdx.x; asm volatile("":"+v"(tid)); const int lane=tid&63,r32=lane&31,hi=lane>>5; const int wid=__builtin_amdgcn_readfirstlane(tid>>6);
  const int q0=qb*QB;
  const bf16*Qw=Q+(long)(q0+wid*QBLK)*DM;
  const bf16*Kh=K+(long)T0*KVBLK*DM,*Vh=V+(long)T0*KVBLK*DM;
  const unsigned lds0=(unsigned)(uintptr_t)shm;
  float*wsf=(float*)(shm+LDS_WS)+wid*64;
  const bf16*ksrc=Kh+(long)lane*DM+wid*8;
  const bf16*vsrc=Vh+(long)(16*(wid&3)+(lane>>2))*DM+(wid>>2)*32+(lane&3)*8;
  const unsigned kdst=lds0+LDS_K+wid*1024, vdst=lds0+LDS_V+wid*1024;
  #define DMA_K(t,slot) glds16(ksrc+(long)(t)*KVBLK*DM,(unsigned)__builtin_amdgcn_readfirstlane(kdst+(slot)))
  #define DMA_V(t,slot) glds16(vsrc+(long)(t)*KVBLK*DM,(unsigned)__builtin_amdgcn_readfirstlane(vdst+(slot)))
  const int vb0=(int)(lds0+LDS_V)+((lane>>4)&1)*32+(lane&3)*8+(4*hi+((lane&15)>>2))*64;
  const char*Kbase=shm+LDS_K; bf16x8 kf[8];
  const lds_cptr shm3=(lds_cptr)shm; const lds_cptr kp0=shm3+LDS_K+hi*1024+r32*16; const lds_cptr vp0=shm3+LDS_V+((lane>>4)&1)*32+(lane&3)*8+(4*hi+((lane&15)>>2))*64;
  const int NT=(q0+QB)/KVBLK-T0;
  DMA_K(0,0);DMA_V(0,0);DMA_K(1,SLOTB);
  bf16x8 qr[4];
  #pragma unroll
  for(int d0=0;d0<4;++d0)qr[d0]=*reinterpret_cast<const bf16x8*>(&Qw[(long)r32*DM+d0*16+hi*8]);
  float mhat=0.f,l_reg=0.f;f32x16 o[2];o[0]=f32x16{};o[1]=f32x16{};f32x16 negm=f32x16{};asm volatile("":"+v"(negm));
  const int qrel=wid*QBLK+r32;
  unsigned sel_lo=0u,sel_hi=0u; if(MODE==1){ const unsigned long long sv=sel[qrel]; sel_lo=(unsigned)sv; sel_hi=(unsigned)(sv>>32); }
  const int dq=q0+qrel-4*hi-T0*KVBLK;
  #define RKEEP(t) ((((t)>>2)<32?(sel_lo>>((t)>>2)):(sel_hi>>(((t)>>2)-32)))&1u)
  #define CMASK(P0,P1,t) do{ if(MODE==2){amask(P0,P1,dq-64*(t));} else {int jb_=(t)-(NT-4); if(jb_>=0)cmask(P0,P1,jb_,qrel,hi); else if(MODE==1)rmask(P0,P1,RKEEP(t)!=0u);} }while(0)
  bool resc=false;
  #define START(P0,P1) do{ const float rm=rowmax(P0,P1); resc=false; \
    { const float dl=(MODE==0)?rm:((rm>-3.0e38f)?rm:0.f); mhat=fadd_s(mhat,dl); \
      _Pragma("unroll") for(int r=0;r<16;++r){P0[r]=fsub_s(P0[r],dl);P1[r]=fsub_s(P1[r],dl);} \
      _Pragma("unroll") for(int r=0;r<16;++r)negm[r]=-mhat; asm volatile("":"+v"(negm)); } \
    _Pragma("unroll") for(int r=0;r<16;++r)P0[r]=__builtin_amdgcn_exp2f(P0[r]); }while(0)
  #define RESC() do{ if(resc){ asm volatile("s_waitcnt lgkmcnt(0)":::"memory"); \
      _Pragma("unroll") for(int d_=0;d_<2;++d_) _Pragma("unroll") for(int r=0;r<16;++r)o[d_][r]*=wsf[crow(r,hi)]; } }while(0)
  f32x16 pA0,pA1,pB0,pB1;
  int sl_prev=0,sl_cur=0,sl_next=SLOTB;
  #define ROT() do{sl_prev=sl_cur;sl_cur=sl_next;sl_next=(sl_next==(NSLOT-1)*SLOTB)?0:sl_next+SLOTB;}while(0)
  DMA_K(2,2*SLOTB);
  WAIT_BAR(3);
  qkt(pA0,pA1,Kbase,qr,negm,r32,hi);asm volatile("s_nop 15\n\ts_nop 7":"+v"(pA0),"+v"(pA1));CMASK(pA0,pA1,0);
  START(pA0,pA1);
  _Pragma("unroll") for(int r=0;r<16;++r)pA1[r]=__builtin_amdgcn_exp2f(pA1[r]);
  WAIT_BAR(0);
  DMA_K(3,0);DMA_V(1,SLOTB);
  ROT();
  kload8(kf,kp0+sl_cur);
  WAIT_BAR(2);
  s16x4 vlo[8],vhi[8]; u32x4 pw0,pw1,pw2,pw3;
  #define PKW(P,B) cvtpk_s(P[B],P[B+1])
  #define PAF(k) __builtin_bit_cast(bf16x8,pw##k)
  #define VFR(i) (bf16x8){vlo[i][0],vlo[i][1],vlo[i][2],vlo[i][3],vhi[i][0],vhi[i][1],vhi[i][2],vhi[i][3]}
  #define PIN(x) asm volatile("":"+v"(x))
  #define MX3(a,b,c) __builtin_fmaxf(__builtin_fmaxf((a),(b)),(c))
  #define GAPA(MF,A0,A1,A2,A3,W0,W1,PW) do{ MF; sacc+=A0; sacc+=A1; sacc+=A2; sacc+=A3; PIN(sacc); W0; W1; PIN(PW); SBAR(); }while(0)
  #define EX(v) __builtin_amdgcn_exp2f(v)
  #define GAPB(MF,X,B) do{ MF; X[B]=EX(X[B]); X[B+1]=EX(X[B+1]); X[B+2]=EX(X[B+2]); X[B+3]=EX(X[B+3]); PIN(X); SBAR(); }while(0)
  #define VRD(i) do{ vlo[i]=vtr(vp_+(((i)>>2)*4096+((i)&3)*1024)); vhi[i]=vtr(vp_+(((i)>>2)*4096+((i)&3)*1024+512)); }while(0)
  #define KRD(G,j) do{ if(G){ kload2(kf,kp0+sl_next,j); SBAR(); } }while(0)
  #define STEP(C0,C1,P0,P1,t,GK,GV,GL) do{ SBAR(); \
    const lds_cptr vp_=vp0+sl_prev; \
    VRD(0); SBAR(); float sacc=(P0[0]+P0[1]); \
    GAPA(C0=__builtin_amdgcn_mfma_f32_32x32x16_bf16(kf[0],qr[0],negm,0,0,0), P0[2],P0[3],P0[4],P0[5],     pw0[0]=PKW(P0,0), pw0[1]=PKW(P0,2), pw0); \
    VRD(4); SBAR(); GAPA(C1=__builtin_amdgcn_mfma_f32_32x32x16_bf16(kf[1],qr[0],negm,0,0,0), P0[6],P0[7],P0[8],P0[9],     pw0[2]=PKW(P0,4), pw0[3]=PKW(P0,6), pw0); \
    VRD(1); SBAR(); GAPA(C0=__builtin_amdgcn_mfma_f32_32x32x16_bf16(kf[2],qr[1],C0,0,0,0),   P0[10],P0[11],P0[12],P0[13], pw1[0]=PKW(P0,8), pw1[1]=PKW(P0,10), pw1); \
    VRD(5); SBAR(); GAPA(C1=__builtin_amdgcn_mfma_f32_32x32x16_bf16(kf[3],qr[1],C1,0,0,0),   P0[14],P0[15],P1[0],P1[1],   pw1[2]=PKW(P0,12),pw1[3]=PKW(P0,14), pw1); \
    VRD(2); SBAR(); GAPA(C0=__builtin_amdgcn_mfma_f32_32x32x16_bf16(kf[4],qr[2],C0,0,0,0),   P1[2],P1[3],P1[4],P1[5],     pw2[0]=PKW(P1,0), pw2[1]=PKW(P1,2), pw2); \
    VRD(6); SBAR(); GAPA(C1=__builtin_amdgcn_mfma_f32_32x32x16_bf16(kf[5],qr[2],C1,0,0,0),   P1[6],P1[7],P1[8],P1[9],     pw2[2]=PKW(P1,4), pw2[3]=PKW(P1,6), pw2); \
    VRD(3); SBAR(); GAPA(C0=__builtin_amdgcn_mfma_f32_32x32x16_bf16(kf[6],qr[3],C0,0,0,0),   P1[10],P1[11],P1[12],P1[13], pw3[0]=PKW(P1,8), pw3[1]=PKW(P1,10), pw3); \
    VRD(7); SBAR(); GAPA(C1=__builtin_amdgcn_mfma_f32_32x32x16_bf16(kf[7],qr[3],C1,0,0,0),   P1[14],P1[15],0.f,0.f,       pw3[2]=PKW(P1,12),pw3[3]=PKW(P1,14), pw3); \
    l_reg+=sacc; \
    if(GK){DMA_K((t)+3,sl_cur);} if(GV){DMA_V((t)+1,sl_next);} \
    CMASK(C0,C1,t); \
    { float a=MX3(C0[0],C0[1],C1[0]),b=MX3(C0[2],C0[3],C1[1]); a=MX3(a,C1[2],C1[3]); \
      _Pragma("unroll") for(int r=4;r<16;r+=4){a=MX3(a,C0[r],C0[r+1]);b=MX3(b,C0[r+2],C0[r+3]);a=MX3(a,C1[r],C1[r+1]);b=MX3(b,C1[r+2],C1[r+3]);} \
      float rm=__builtin_fmaxf(a,b); { auto rr=__builtin_amdgcn_permlane32_swap(__float_as_uint(rm),__float_as_uint(rm),false,false); rm=__builtin_fmaxf(__uint_as_float(rr[0]),__uint_as_float(rr[1])); } \
      resc=false; \
      if(__builtin_expect(__any(rm>(float)THRL),0)){ const float dl=__builtin_fmaxf(rm,0.f); mhat+=dl; \
        _Pragma("unroll") for(int r=0;r<16;++r){C0[r]-=dl;C1[r]-=dl;} \
        _Pragma("unroll") for(int r=0;r<16;++r)negm[r]=-mhat; asm volatile("":"+v"(negm)); \
        const float f=__builtin_amdgcn_exp2f(-dl); l_reg*=f; if(hi==0)wsf[r32]=f; resc=true; } } \
    SBAR(); \
    GAPB(o[0]=__builtin_amdgcn_mfma_f32_32x32x16_bf16(PAF(0),VFR(0),o[0],0,0,0), C0,0); \
    GAPB(o[1]=__builtin_amdgcn_mfma_f32_32x32x16_bf16(PAF(0),VFR(4),o[1],0,0,0), C0,4); \
    KRD(GL,0); GAPB(o[0]=__builtin_amdgcn_mfma_f32_32x32x16_bf16(PAF(1),VFR(1),o[0],0,0,0), C0,8); \
    KRD(GL,1); GAPB(o[1]=__builtin_amdgcn_mfma_f32_32x32x16_bf16(PAF(1),VFR(5),o[1],0,0,0), C0,12); \
    KRD(GL,2); GAPB(o[0]=__builtin_amdgcn_mfma_f32_32x32x16_bf16(PAF(2),VFR(2),o[0],0,0,0), C1,0); \
    KRD(GL,3); GAPB(o[1]=__builtin_amdgcn_mfma_f32_32x32x16_bf16(PAF(2),VFR(6),o[1],0,0,0), C1,4); \
    GAPB(o[0]=__builtin_amdgcn_mfma_f32_32x32x16_bf16(PAF(3),VFR(3),o[0],0,0,0), C1,8); \
    GAPB(o[1]=__builtin_amdgcn_mfma_f32_32x32x16_bf16(PAF(3),VFR(7),o[1],0,0,0), C1,12); \
    }while(0)
  int t=1;
  #undef CMASK
  #define CMASK(P0,P1,t) do{ if(MODE==2){amask(P0,P1,dq-64*(t));} else if(MODE==1){rmask(P0,P1,RKEEP(t)!=0u);} }while(0)
  for(;t+5<NT;t+=2){
    STEP(pB0,pB1,pA0,pA1,t,true,true,true);     WAIT_BAR(2); RESC(); ROT();
    STEP(pA0,pA1,pB0,pB1,t+1,true,true,true);   WAIT_BAR(2); RESC(); ROT();
  }
  #undef CMASK
  #define CMASK(P0,P1,t) do{ if(MODE==2){amask(P0,P1,dq-64*(t));} else {int jb_=(t)-(NT-4); if(jb_>=0)cmask(P0,P1,jb_,qrel,hi); else if(MODE==1)rmask(P0,P1,RKEEP(t)!=0u);} }while(0)
  #define ENDW(tt) do{ if((tt)+3<NT){WAIT_BAR(2);} else if((tt)+2<NT){WAIT_BAR(1);} else {WAIT_BAR(0);} }while(0)
  for(;t+1<NT;t+=2){
    STEP(pB0,pB1,pA0,pA1,t,(t+3<NT),(t+1<NT),(t+1<NT));       ENDW(t);   RESC(); ROT();
    STEP(pA0,pA1,pB0,pB1,t+1,(t+4<NT),(t+2<NT),(t+2<NT));     ENDW(t+1); RESC(); ROT();
  }
  STEP(pB0,pB1,pA0,pA1,NT-1,false,false,false); RESC();
  { float sacc=pB0[0]+pB0[1]; _Pragma("unroll") for(int r=2;r<16;++r)sacc+=pB0[r]; _Pragma("unroll") for(int r=0;r<16;++r)sacc+=pB1[r]; l_reg+=sacc;
    pw0=(u32x4){PKW(pB0,0),PKW(pB0,2),PKW(pB0,4),PKW(pB0,6)};pw1=(u32x4){PKW(pB0,8),PKW(pB0,10),PKW(pB0,12),PKW(pB0,14)};pw2=(u32x4){PKW(pB1,0),PKW(pB1,2),PKW(pB1,4),PKW(pB1,6)};pw3=(u32x4){PKW(pB1,8),PKW(pB1,10),PKW(pB1,12),PKW(pB1,14)};
    SBAR(); pv(o,vb0+sl_cur,PAF(0),PAF(1),PAF(2),PAF(3)); }
  #undef PKW
  #undef PAF
  #undef VFR
  #undef PIN
  #undef MX3
  #undef GAPA
  #undef GAPB
  #undef EX
  #undef VRD
  #undef KRD
  #undef STEP
  #undef ENDW
  {auto rr=__builtin_amdgcn_permlane32_swap(__float_as_uint(l_reg),__float_as_uint(l_reg),false,false);l_reg=__uint_as_float(rr[0])+__uint_as_float(rr[1]);}
  if(hi==0)wsf[32+r32]=l_reg;asm volatile("s_waitcnt lgkmcnt(0)":::"memory");
  float rli[16];
  #pragma unroll
  for(int r=0;r<16;++r)rli[r]=__builtin_amdgcn_rcpf(wsf[32+crow(r,hi)]);
  if(MODE==0){ float*Of=(float*)Ov+(long)(q0+wid*QBLK)*opitch;
    #pragma unroll
    for(int r=0;r<16;++r){const int orow=crow(r,hi);
      #pragma unroll
      for(int d0=0;d0<2;++d0)Of[(long)orow*opitch+d0*32+r32]=o[d0][r]*rli[r];} }
  else { bf16*Ow=(bf16*)Ov+(long)(q0+wid*QBLK)*opitch; bf16*stg=(bf16*)(shm+LDS_OST)+wid*2048;
    #pragma unroll
    for(int r=0;r<16;++r){const int orow=crow(r,hi);
      #pragma unroll
      for(int d0=0;d0<2;++d0)stg[orow*64+d0*32+r32]=__float2bfloat16(o[d0][r]*rli[r]);}
    asm volatile("s_waitcnt lgkmcnt(0)":::"memory");
    #pragma unroll
    for(int i=0;i<4;++i){const int row=i*8+(lane>>3),ch=lane&7; const u32x4 v=*(const u32x4*)(stg+row*64+ch*8); ATTN_STORE16(Ow+(long)row*opitch+ch*8,v);} }
  asm volatile("s_waitcnt lgkmcnt(0)\n\ts_barrier":::"memory");
  #undef DMA_K
  #undef DMA_V
  #undef CMASK
  #undef RKEEP
  #undef START
  #undef RESC
  #undef ROT
}
constexpr int ATTN_LDS_BYTES=LDS_BYTES;


constexpr int X_K=0, X_V=3*SLOTB, X_WS=X_V+6*SLOTB, X_LDS_BYTES=X_WS+NW*256;
__device__ __forceinline__ void pv4(f32x16*o,int vb,bf16x8 pa0,bf16x8 pa1,bf16x8 pa2,bf16x8 pa3){
  #pragma unroll
  for(int d0=0;d0<4;++d0){s16x4 lo[4],hi[4];
    #pragma unroll
    for(int ks=0;ks<4;++ks){
      asm volatile("ds_read_b64_tr_b16 %0,%1 offset:%c2":"=&v"(lo[ks]):"v"(vb),"i"(d0*4096+ks*1024):"memory");
      asm volatile("ds_read_b64_tr_b16 %0,%1 offset:%c2":"=&v"(hi[ks]):"v"(vb),"i"(d0*4096+ks*1024+512):"memory");}
    asm volatile("s_waitcnt lgkmcnt(0)":::"memory");SBAR();
    #define PK(k) (bf16x8){lo[k][0],lo[k][1],lo[k][2],lo[k][3],hi[k][0],hi[k][1],hi[k][2],hi[k][3]}
    o[d0]=__builtin_amdgcn_mfma_f32_32x32x16_bf16(pa0,PK(0),o[d0],0,0,0);
    o[d0]=__builtin_amdgcn_mfma_f32_32x32x16_bf16(pa1,PK(1),o[d0],0,0,0);
    o[d0]=__builtin_amdgcn_mfma_f32_32x32x16_bf16(pa2,PK(2),o[d0],0,0,0);
    o[d0]=__builtin_amdgcn_mfma_f32_32x32x16_bf16(pa3,PK(3),o[d0],0,0,0);
    #undef PK
  }
}
template<int THRL> __device__ __forceinline__ void attn_unit128(int qb,const bf16*Q,const bf16*__restrict__ K,const bf16*__restrict__ V,float*O,int opitch,char*shm){
  int tid=threadIdx.x; asm volatile("":"+v"(tid)); const int lane=tid&63,r32=lane&31,hi=lane>>5; const int wid=__builtin_amdgcn_readfirstlane(tid>>6);
  const int q0=qb*QB;
  const bf16*Qw=Q+(long)(q0+wid*QBLK)*DM;
  const unsigned lds0=(unsigned)(uintptr_t)shm;
  float*wsf=(float*)(shm+X_WS)+wid*64;
  const bf16*ksrc=K+(long)lane*DM+wid*8;
  const bf16*vsrc=V+(long)(16*(wid&3)+(lane>>2))*DM+(wid>>2)*32+(lane&3)*8;
  const unsigned kdst=lds0+X_K+wid*1024, vdst=lds0+X_V+wid*1024;
  #define DMA_K(t,slot) glds16(ksrc+(long)(t)*KVBLK*DM,(unsigned)__builtin_amdgcn_readfirstlane(kdst+(slot)))
  #define DMA_V(t,slot) do{ glds16(vsrc+(long)(t)*KVBLK*DM,(unsigned)__builtin_amdgcn_readfirstlane(vdst+2*(slot))); glds16(vsrc+(long)(t)*KVBLK*DM+64,(unsigned)__builtin_amdgcn_readfirstlane(vdst+2*(slot)+8192)); }while(0)
  const int vb0=(int)(lds0+X_V)+((lane>>4)&1)*32+(lane&3)*8+(4*hi+((lane&15)>>2))*64;
  const char*Kbase=shm+X_K; bf16x8 kf[8];
  const lds_cptr shm3=(lds_cptr)shm; const lds_cptr kp0=shm3+X_K+hi*1024+r32*16; const lds_cptr vp0=shm3+X_V+((lane>>4)&1)*32+(lane&3)*8+(4*hi+((lane&15)>>2))*64;
  const int NT=(q0+QB)/KVBLK;
  DMA_K(0,0);DMA_V(0,0);DMA_K(1,SLOTB);
  bf16x8 qr[4];
  #pragma unroll
  for(int d0=0;d0<4;++d0)qr[d0]=*reinterpret_cast<const bf16x8*>(&Qw[(long)r32*DM+d0*16+hi*8]);
  float mhat=0.f,l_reg=0.f;f32x16 o[4];o[0]=f32x16{};o[1]=f32x16{};o[2]=f32x16{};o[3]=f32x16{};f32x16 negm=f32x16{};asm volatile("":"+v"(negm));
  const int qrel=wid*QBLK+r32;
  #define CMASK(P0,P1,t) do{int jb_=(t)-(NT-4); if(jb_>=0)cmask(P0,P1,jb_,qrel,hi);}while(0)
  bool resc=false;
  #define RESC() do{ if(resc){ asm volatile("s_waitcnt lgkmcnt(0)":::"memory"); \
      _Pragma("unroll") for(int d_=0;d_<4;++d_) _Pragma("unroll") for(int r=0;r<16;++r)o[d_][r]*=wsf[crow(r,hi)]; } }while(0)
  f32x16 C0,C1; u32x4 pw0,pw1,pw2,pw3;
  int sl_prev=0,sl_cur=0,sl_next=SLOTB;
  #define ROT() do{sl_prev=sl_cur;sl_cur=sl_next;sl_next=(sl_next==(NSLOT-1)*SLOTB)?0:sl_next+SLOTB;}while(0)
  #define PKW(P,B) cvtpk_s(P[B],P[B+1])
  DMA_K(2,2*SLOTB);
  WAIT_BAR(4);
  qkt(C0,C1,Kbase,qr,negm,r32,hi);asm volatile("s_nop 15\n\ts_nop 7":"+v"(C0),"+v"(C1));CMASK(C0,C1,0);
  { const float rm=rowmax(C0,C1); const float dl=rm; mhat=fadd_s(mhat,dl);
    _Pragma("unroll") for(int r=0;r<16;++r){C0[r]=fsub_s(C0[r],dl);C1[r]=fsub_s(C1[r],dl);}
    _Pragma("unroll") for(int r=0;r<16;++r)negm[r]=-mhat; asm volatile("":"+v"(negm));
    _Pragma("unroll") for(int r=0;r<16;++r){C0[r]=__builtin_amdgcn_exp2f(C0[r]);C1[r]=__builtin_amdgcn_exp2f(C1[r]);}
    float sacc=C0[0]+C0[1]; _Pragma("unroll") for(int r=2;r<16;++r)sacc+=C0[r]; _Pragma("unroll") for(int r=0;r<16;++r)sacc+=C1[r]; l_reg+=sacc;
    pw0=(u32x4){PKW(C0,0),PKW(C0,2),PKW(C0,4),PKW(C0,6)};pw1=(u32x4){PKW(C0,8),PKW(C0,10),PKW(C0,12),PKW(C0,14)};pw2=(u32x4){PKW(C1,0),PKW(C1,2),PKW(C1,4),PKW(C1,6)};pw3=(u32x4){PKW(C1,8),PKW(C1,10),PKW(C1,12),PKW(C1,14)}; }
  WAIT_BAR(0);
  DMA_K(3,0);DMA_V(1,SLOTB);
  ROT();
  kload8(kf,kp0+sl_cur);
  WAIT_BAR(3);
  s16x4 vlo[8],vhi[8];
  #define PAF(k) __builtin_bit_cast(bf16x8,pw##k)
  #define VFR(i) (bf16x8){vlo[i][0],vlo[i][1],vlo[i][2],vlo[i][3],vhi[i][0],vhi[i][1],vhi[i][2],vhi[i][3]}
  #define PIN(x) asm volatile("":"+v"(x))
  #define MX3(a,b,c) __builtin_fmaxf(__builtin_fmaxf((a),(b)),(c))
  #define EX(v) __builtin_amdgcn_exp2f(v)
  #define VRDF(s,d,ks) do{ vlo[s]=vtr(vp_+((d)*4096+(ks)*1024)); vhi[s]=vtr(vp_+((d)*4096+(ks)*1024+512)); }while(0)
  #define GA(s,MF) do{ VRDF(s,(s)&3,(s)>>2); SBAR(); MF; SBAR(); }while(0)
  #define EX2(X,B) do{ X[B]=EX(X[B]); X[B+1]=EX(X[B+1]); PIN(X); }while(0)
  #define PK1(W,j,X,B) do{ sacc+=X[B]; sacc+=X[B+1]; W[j]=PKW(X,B); PIN(W); PIN(sacc); }while(0)
  #define KRD(G,j) do{ if(G){ kload2(kf,kp0+sl_next,j); } }while(0)
  #define STEP(t,GK,GV,GL) do{ SBAR(); \
    const lds_cptr vp_=vp0+2*sl_prev; \
    GA(0,C0=__builtin_amdgcn_mfma_f32_32x32x16_bf16(kf[0],qr[0],negm,0,0,0)); \
    GA(1,C1=__builtin_amdgcn_mfma_f32_32x32x16_bf16(kf[1],qr[0],negm,0,0,0)); \
    GA(2,C0=__builtin_amdgcn_mfma_f32_32x32x16_bf16(kf[2],qr[1],C0,0,0,0)); \
    GA(3,C1=__builtin_amdgcn_mfma_f32_32x32x16_bf16(kf[3],qr[1],C1,0,0,0)); \
    GA(4,C0=__builtin_amdgcn_mfma_f32_32x32x16_bf16(kf[4],qr[2],C0,0,0,0)); \
    GA(5,C1=__builtin_amdgcn_mfma_f32_32x32x16_bf16(kf[5],qr[2],C1,0,0,0)); \
    GA(6,C0=__builtin_amdgcn_mfma_f32_32x32x16_bf16(kf[6],qr[3],C0,0,0,0)); \
    GA(7,C1=__builtin_amdgcn_mfma_f32_32x32x16_bf16(kf[7],qr[3],C1,0,0,0)); \
    if(GK){DMA_K((t)+3,sl_cur);} if(GV){DMA_V((t)+1,sl_next);} \
    CMASK(C0,C1,t); \
    { float a=MX3(C0[0],C0[1],C1[0]),b=MX3(C0[2],C0[3],C1[1]); a=MX3(a,C1[2],C1[3]); \
      _Pragma("unroll") for(int r=4;r<16;r+=4){a=MX3(a,C0[r],C0[r+1]);b=MX3(b,C0[r+2],C0[r+3]);a=MX3(a,C1[r],C1[r+1]);b=MX3(b,C1[r+2],C1[r+3]);} \
      float rm=__builtin_fmaxf(a,b); { auto rr=__builtin_amdgcn_permlane32_swap(__float_as_uint(rm),__float_as_uint(rm),false,false); rm=__builtin_fmaxf(__uint_as_float(rr[0]),__uint_as_float(rr[1])); } \
      resc=false; \
      if(__builtin_expect(__any(rm>(float)THRL),0)){ const float dl=__builtin_fmaxf(rm,0.f); mhat+=dl; \
        _Pragma("unroll") for(int r=0;r<16;++r){C0[r]-=dl;C1[r]-=dl;} \
        _Pragma("unroll") for(int r=0;r<16;++r)negm[r]=-mhat; asm volatile("":"+v"(negm)); \
        const float f=__builtin_amdgcn_exp2f(-dl); l_reg*=f; if(hi==0)wsf[r32]=f; resc=true; } } \
    SBAR(); \
    float sacc=0.f; u32x4 nw0=(u32x4){0u,0u,0u,0u},nw1=nw0,nw2=nw0,nw3=nw0; \
    o[0]=__builtin_amdgcn_mfma_f32_32x32x16_bf16(PAF(0),VFR(0),o[0],0,0,0); VRDF(0,0,2); EX2(C0,0); SBAR(); \
    o[1]=__builtin_amdgcn_mfma_f32_32x32x16_bf16(PAF(0),VFR(1),o[1],0,0,0); VRDF(1,1,2); EX2(C0,2); SBAR(); \
    o[2]=__builtin_amdgcn_mfma_f32_32x32x16_bf16(PAF(0),VFR(2),o[2],0,0,0); VRDF(2,2,2); EX2(C0,4); SBAR(); \
    o[3]=__builtin_amdgcn_mfma_f32_32x32x16_bf16(PAF(0),VFR(3),o[3],0,0,0); VRDF(3,3,2); EX2(C0,6); SBAR(); \
    o[0]=__builtin_amdgcn_mfma_f32_32x32x16_bf16(PAF(1),VFR(4),o[0],0,0,0); VRDF(4,0,3); EX2(C0,8);  PK1(nw0,0,C0,0); SBAR(); \
    o[1]=__builtin_amdgcn_mfma_f32_32x32x16_bf16(PAF(1),VFR(5),o[1],0,0,0); VRDF(5,1,3); EX2(C0,10); PK1(nw0,1,C0,2); SBAR(); \
    o[2]=__builtin_amdgcn_mfma_f32_32x32x16_bf16(PAF(1),VFR(6),o[2],0,0,0); VRDF(6,2,3); EX2(C0,12); PK1(nw0,2,C0,4); SBAR(); \
    o[3]=__builtin_amdgcn_mfma_f32_32x32x16_bf16(PAF(1),VFR(7),o[3],0,0,0); VRDF(7,3,3); EX2(C0,14); PK1(nw0,3,C0,6); SBAR(); \
    o[0]=__builtin_amdgcn_mfma_f32_32x32x16_bf16(PAF(2),VFR(0),o[0],0,0,0); KRD(GL,0); EX2(C1,0);  PK1(nw1,0,C0,8);  SBAR(); \
    o[1]=__builtin_amdgcn_mfma_f32_32x32x16_bf16(PAF(2),VFR(1),o[1],0,0,0); KRD(GL,1); EX2(C1,2);  PK1(nw1,1,C0,10); SBAR(); \
    o[2]=__builtin_amdgcn_mfma_f32_32x32x16_bf16(PAF(2),VFR(2),o[2],0,0,0); KRD(GL,2); EX2(C1,4);  PK1(nw1,2,C0,12); SBAR(); \
    o[3]=__builtin_amdgcn_mfma_f32_32x32x16_bf16(PAF(2),VFR(3),o[3],0,0,0); KRD(GL,3); EX2(C1,6);  PK1(nw1,3,C0,14); SBAR(); \
    o[0]=__builtin_amdgcn_mfma_f32_32x32x16_bf16(PAF(3),VFR(4),o[0],0,0,0); EX2(C1,8);  PK1(nw2,0,C1,0); SBAR(); \
    o[1]=__builtin_amdgcn_mfma_f32_32x32x16_bf16(PAF(3),VFR(5),o[1],0,0,0); EX2(C1,10); PK1(nw2,1,C1,2); SBAR(); \
    o[2]=__builtin_amdgcn_mfma_f32_32x32x16_bf16(PAF(3),VFR(6),o[2],0,0,0); EX2(C1,12); PK1(nw2,2,C1,4); PK1(nw3,0,C1,8); SBAR(); \
    o[3]=__builtin_amdgcn_mfma_f32_32x32x16_bf16(PAF(3),VFR(7),o[3],0,0,0); EX2(C1,14); PK1(nw2,3,C1,6); PK1(nw3,1,C1,10); SBAR(); \
    PK1(nw3,2,C1,12); PK1(nw3,3,C1,14); l_reg+=sacc; pw0=nw0; pw1=nw1; pw2=nw2; pw3=nw3; \
    }while(0)
  #define ENDW(tt) do{ if((tt)+3<NT){WAIT_BAR(3);} else if((tt)+2<NT){WAIT_BAR(2);} else {WAIT_BAR(0);} }while(0)
  int t=1;
  #undef CMASK
  #define CMASK(P0,P1,t) do{}while(0)
  for(;t<NT-4;++t){ STEP(t,true,true,true); WAIT_BAR(3); RESC(); ROT(); }
  #undef CMASK
  #define CMASK(P0,P1,t) do{int jb_=(t)-(NT-4); if(jb_>=0)cmask(P0,P1,jb_,qrel,hi);}while(0)
  for(;t<NT-1;++t){ STEP(t,(t+3<NT),(t+1<NT),(t+1<NT)); ENDW(t); RESC(); ROT(); }
  STEP(NT-1,false,false,false); RESC();
  SBAR(); pv4(o,vb0+2*sl_cur,PAF(0),PAF(1),PAF(2),PAF(3));
  #undef PKW
  #undef PAF
  #undef VFR
  #undef PIN
  #undef MX3
  #undef EX
  #undef VRDF
  #undef GA
  #undef EX2
  #undef PK1
  #undef KRD
  #undef STEP
  #undef ENDW
  {auto rr=__builtin_amdgcn_permlane32_swap(__float_as_uint(l_reg),__float_as_uint(l_reg),false,false);l_reg=__uint_as_float(rr[0])+__uint_as_float(rr[1]);}
  if(hi==0)wsf[32+r32]=l_reg;asm volatile("s_waitcnt lgkmcnt(0)":::"memory");
  { float*Of=O+(long)(q0+wid*QBLK)*opitch;
    #pragma unroll
    for(int r=0;r<16;++r){const int orow=crow(r,hi); const float rl=__builtin_amdgcn_rcpf(wsf[32+orow]);
      #pragma unroll
      for(int d0=0;d0<4;++d0)Of[(long)orow*opitch+d0*32+r32]=o[d0][r]*rl;} }
  asm volatile("s_waitcnt lgkmcnt(0)\n\ts_barrier":::"memory");
  #undef DMA_K
  #undef DMA_V
  #undef CMASK
  #undef RESC
  #undef ROT
}

constexpr int BRA_MAXKT=6, BRA_K=0, BRA_V=BRA_MAXKT*8192, BRA_WS=2*BRA_MAXKT*8192, BRA_LDS_BYTES=BRA_WS+NW*512;
struct BraUnit {
  const bf16* Q; const bf16* K; const bf16* V;
  bf16* PO; float* PL;
  int kbase, kstride, t_first, nkt;
  int nqt;
  int qbase, qstride, slotA;
  const int* list; int nlist, tile0, ownrow0;
};
#define BMX3(a,b,c) __builtin_fmaxf(__builtin_fmaxf((a),(b)),(c))
template<int MODE> __device__ __forceinline__ void bra_unit(const BraUnit&u,char*shm){
  int tid=threadIdx.x; asm volatile("":"+v"(tid)); const int lane=tid&63,r32=lane&31,hi=lane>>5; const int wid=__builtin_amdgcn_readfirstlane(tid>>6);
  const unsigned lds0=(unsigned)(uintptr_t)shm;
  for(int T=u.t_first;T<u.nkt;++T){
    const long krow=u.kbase+(long)u.kstride*(64*T+lane), vrow=u.kbase+(long)u.kstride*(64*T+16*(wid&3)+(lane>>2));
    glds16(u.K+krow*DM+wid*8,(unsigned)__builtin_amdgcn_readfirstlane(lds0+BRA_K+T*8192+wid*1024));
    glds16(u.V+vrow*DM+(wid>>2)*32+(lane&3)*8,(unsigned)__builtin_amdgcn_readfirstlane(lds0+BRA_V+T*8192+wid*1024)); }
  asm volatile("s_waitcnt vmcnt(0)\n\ts_barrier":::"memory");
  float*wsf=(float*)(shm+BRA_WS)+wid*128; int*wsi=(int*)wsf+64;
  const int vbl=(int)(lds0+BRA_V)+((lane>>4)&1)*32+(lane&3)*8+(4*hi+((lane&15)>>2))*64;
  for(int qt=wid;qt<u.nqt;qt+=NW){
    int qrow,ql,Tlo,Thi,slot; bool valid=true,masked=true; unsigned dmax;
    if(MODE==0){ ql=32*qt+r32; qrow=u.qbase+u.qstride*ql; Tlo=(qt>>1)>u.t_first?(qt>>1):u.t_first; Thi=(qt>>1)+2; slot=u.slotA; dmax=128u; }
    else { const int g=u.tile0+qt;
      if(g<8){ ql=32*g+r32; qrow=u.ownrow0+ql; Tlo=0; Thi=g>>1; slot=3; dmax=0x7fffffffu; }
      else { const int e=(g-8)*32+r32; valid=e<u.nlist; const int ent=valid?u.list[e]:0; qrow=ent&0xffff; slot=ent>>16; ql=0; Tlo=0; Thi=3; masked=false; dmax=0x7fffffffu; } }
    bf16x8 qr[4];
    #pragma unroll
    for(int d0=0;d0<4;++d0)qr[d0]=*reinterpret_cast<const bf16x8*>(&u.Q[(long)qrow*DM+d0*16+hi*8]);
    float mhat=0.f,l_reg=0.f; f32x16 o[2]; o[0]=f32x16{}; o[1]=f32x16{}; f32x16 negm=f32x16{};
    for(int T=Tlo;T<=Thi;++T){
      f32x16 p0,p1; qkt(p0,p1,shm+BRA_K+T*8192,qr,negm,r32,hi);
      if(masked){ const int db=ql-64*T-4*hi+((MODE==0)?128:0);
        #pragma unroll
        for(int r=0;r<16;++r){ const int d=db-((r&3)+8*(r>>2)); if((unsigned)d>dmax)p0[r]=-INFINITY; if((unsigned)(d-32)>dmax)p1[r]=-INFINITY; } }
      float a=BMX3(p0[0],p0[1],p1[0]),b=BMX3(p0[2],p0[3],p1[1]); a=BMX3(a,p1[2],p1[3]);
      #pragma unroll
      for(int r=4;r<16;r+=4){a=BMX3(a,p0[r],p0[r+1]);b=BMX3(b,p0[r+2],p0[r+3]);a=BMX3(a,p1[r],p1[r+1]);b=BMX3(b,p1[r+2],p1[r+3]);}
      float rm=__builtin_fmaxf(a,b); { auto rr=__builtin_amdgcn_permlane32_swap(__float_as_uint(rm),__float_as_uint(rm),false,false); rm=__builtin_fmaxf(__uint_as_float(rr[0]),__uint_as_float(rr[1])); }
      if(__any(rm>8.f)){ const float dl=(rm>8.f)?rm:0.f; mhat+=dl;
        #pragma unroll
        for(int r=0;r<16;++r){p0[r]-=dl;p1[r]-=dl;}
        #pragma unroll
        for(int r=0;r<16;++r)negm[r]=-mhat;
        const float f=__builtin_amdgcn_exp2f(-dl); l_reg*=f; if(hi==0)wsf[r32]=f;
        asm volatile("s_waitcnt lgkmcnt(0)":::"memory");
        #pragma unroll
        for(int d_=0;d_<2;++d_)
          #pragma unroll
          for(int r=0;r<16;++r)o[d_][r]*=wsf[crow(r,hi)];
        asm volatile("s_waitcnt lgkmcnt(0)":::"memory"); }
      float sacc=0.f;
      #pragma unroll
      for(int r=0;r<16;++r){p0[r]=__builtin_amdgcn_exp2f(p0[r]);p1[r]=__builtin_amdgcn_exp2f(p1[r]);sacc+=p0[r]+p1[r];}
      l_reg+=sacc;
      u32x4 pw0,pw1,pw2,pw3;
      pw0=(u32x4){cvtpk_s(p0[0],p0[1]),cvtpk_s(p0[2],p0[3]),cvtpk_s(p0[4],p0[5]),cvtpk_s(p0[6],p0[7])}; pw1=(u32x4){cvtpk_s(p0[8],p0[9]),cvtpk_s(p0[10],p0[11]),cvtpk_s(p0[12],p0[13]),cvtpk_s(p0[14],p0[15])};
      pw2=(u32x4){cvtpk_s(p1[0],p1[1]),cvtpk_s(p1[2],p1[3]),cvtpk_s(p1[4],p1[5]),cvtpk_s(p1[6],p1[7])}; pw3=(u32x4){cvtpk_s(p1[8],p1[9]),cvtpk_s(p1[10],p1[11]),cvtpk_s(p1[12],p1[13]),cvtpk_s(p1[14],p1[15])};
      SBAR(); pv(o,vbl+T*8192,__builtin_bit_cast(bf16x8,pw0),__builtin_bit_cast(bf16x8,pw1),__builtin_bit_cast(bf16x8,pw2),__builtin_bit_cast(bf16x8,pw3));
    }
    {auto rr=__builtin_amdgcn_permlane32_swap(__float_as_uint(l_reg),__float_as_uint(l_reg),false,false);l_reg=__uint_as_float(rr[0])+__uint_as_float(rr[1]);}
    if(hi==0){ wsf[r32]=l_reg; wsi[r32]=valid?(slot*SEQ+qrow):-1; }
    asm volatile("s_waitcnt lgkmcnt(0)":::"memory");
    if(hi==0&&valid) u.PL[(long)(slot*SEQ+qrow)*8]=mhat+__builtin_amdgcn_logf(l_reg);
    #pragma unroll
    for(int r=0;r<16;++r){ const int orow=crow(r,hi); const float rl=__builtin_amdgcn_rcpf(wsf[orow]); const int dst=wsi[orow];
      if(dst>=0){ bf16*op=u.PO+(long)dst*512+r32; op[0]=__float2bfloat16(o[0][r]*rl); op[32]=__float2bfloat16(o[1][r]*rl); } }
    asm volatile("s_waitcnt lgkmcnt(0)":::"memory");
  }
  asm volatile("s_waitcnt vmcnt(0) lgkmcnt(0)\n\ts_barrier":::"memory");
}
#undef BMX3
#undef SBAR
#undef WAIT_BAR
}


constexpr int NWAVES = 8;
#ifndef MK_N_LAUNCHES
#define MK_N_LAUNCHES 1
#endif
constexpr int N_PHASES = 24;
static_assert(MK_N_LAUNCHES == 1 || MK_N_LAUNCHES == N_PHASES, "MK_N_LAUNCHES is 1 or 24");

constexpr int S_ = 16384, DM_ = 2048, INW = 6144, NEXP = 16, DEXP = 1024, DEPTH = 2, NROWBLK = 256  ;
constexpr int C_QA = 0, C_KA = 512, C_VA = 1024, C_QB = 1536, C_KB = 2048, C_VB = 2560, C_QC = 3072, C_KC = 4096, C_VC = 5120;
constexpr int MAXPOS = 2 * S_ + NEXP * 256;
constexpr float RMS_EPS = 1e-6f;

constexpr size_t MiB = 1u << 20;
constexpr size_t WS_CTL = 0, CTL_ZERO_BYTES = 1 * MiB;
constexpr size_t WS_MOD = 1 * MiB;
constexpr size_t WS_COS = 2 * MiB, WS_SIN = 4 * MiB;
constexpr size_t WS_EID = 6 * MiB;
constexpr size_t WS_WTS = WS_EID + 131072;
constexpr size_t WS_ROWTOK = WS_WTS + 131072;
constexpr size_t WS_ROWW = WS_ROWTOK + 163840;
constexpr size_t WS_CNT = WS_ROWW + 163840;
constexpr size_t WS_KMEAN = 8 * MiB;
constexpr size_t WS_WIN = 16 * MiB;
constexpr size_t WS_WOUT = 64 * MiB;
constexpr size_t WS_WGU = 80 * MiB;
constexpr size_t WS_WDN = 336 * MiB;
constexpr size_t WS_H = 464 * MiB;
constexpr size_t WS_PROJ = 528 * MiB;
constexpr size_t WS_MERGED = 720 * MiB;
constexpr size_t WS_T = 784 * MiB;
constexpr size_t WS_ACT = 912 * MiB;
constexpr size_t WS_XS = 984 * MiB;
constexpr size_t WS_POA = WS_ACT;
constexpr size_t WS_POB = WS_POA + 48 * MiB;
constexpr size_t WS_PLA = WS_POB + 64 * MiB;
constexpr size_t WS_PLB = WS_PLA + 2 * MiB;
constexpr size_t WS_LIST = WS_PLB + 2 * MiB;
static_assert(WS_LIST + 32 * MiB <= 1128 * MiB, "partials and lists inside the MoE-only regions");
constexpr size_t WS_Y = WS_PROJ;
constexpr size_t WS_END = 1128 * MiB;
static_assert(WS_XS + (size_t)MAXPOS * 2048 * 2 <= WS_END && WS_ACT + (size_t)MAXPOS * 1024 * 2 <= WS_XS && WS_CNT + 16384 <= WS_KMEAN, "d_ws map");
constexpr int CW_TMO = 0, CW_CODE = 1, CW_BAR = 4096;
constexpr int CW_CNTB = 8192;
constexpr int CW_QUEUE = 8192 + 1024;

constexpr int RING_OFF = 0, RING_BYTES = 131072;
constexpr int LDSCTL_OFF = RING_BYTES, MISC_OFF = LDSCTL_OFF + 320;
constexpr int LT_SEGS = LDSCTL_OFF + 1024;
constexpr int LT_TOT = LT_SEGS + 128;
constexpr int LT_BASE = LT_TOT + 64;
constexpr int LT_CNT = LT_BASE + 64;
constexpr int LT_P2E = LT_CNT + 64;
constexpr int LT_POS = LT_P2E + 160;
constexpr int LDS_BYTES = 147456;
constexpr int ATT_KM_OFF = 0;
constexpr int ATT_UST_OFF = 106496, ATT_QN_OFF = ATT_UST_OFF + 2304;
static_assert(LT_POS + 512 <= LDS_BYTES && attn_body::ATTN_LDS_BYTES <= ATT_UST_OFF && attn_body::X_LDS_BYTES <= ATT_UST_OFF && attn_body::BRA_LDS_BYTES <= ATT_UST_OFF && ATT_QN_OFF + 64 <= RING_BYTES, "LDS map");

#define GAS __attribute__((address_space(1)))
#define LAS __attribute__((address_space(3)))
typedef unsigned short bf16;
typedef unsigned v4u __attribute__((ext_vector_type(4)));
typedef unsigned v2u __attribute__((ext_vector_type(2)));
typedef float f32x4 __attribute__((ext_vector_type(4)));
typedef short bf16x8 __attribute__((ext_vector_type(8)));
typedef GAS unsigned gu32;
#define RLX_AGENT __ATOMIC_RELAXED, __HIP_MEMORY_SCOPE_AGENT
#define LDS_WAIT() asm volatile("s_waitcnt lgkmcnt(0)" ::: "memory")
__device__ __forceinline__ unsigned f2bf(float f) { unsigned u = __builtin_bit_cast(unsigned, f); return (u + 0x7fffu + ((u >> 16) & 1u)) >> 16; }
__device__ __forceinline__ unsigned pk2(float lo, float hi) { return f2bf(lo) | (f2bf(hi) << 16); }
__device__ __forceinline__ float bflo(unsigned w) { return __builtin_bit_cast(float, w << 16); }
__device__ __forceinline__ float bfhi(unsigned w) { return __builtin_bit_cast(float, w & 0xffff0000u); }
__device__ __forceinline__ float wave_sum(float v) {
#pragma unroll
    for (int o = 1; o < 64; o <<= 1) v += __shfl_xor(v, o);
    return v;
}

#define XB_TMO      128
#define XB_XCNT(j)  (256  + 64 * (j))
#define XB_XSUB(j)  (1280 + 64 * (j))
#define XB_XGEN(j)  (2304 + 64 * (j))
#define XB_TOP      3328
#define XB_TOPGEN   3392
#define XCD_BAR_WORDS 3456
#define XB_SPIN_CAP (1u << 18)

__device__ __forceinline__ unsigned xb_ld(unsigned* p)              { return __hip_atomic_load(p, __ATOMIC_RELAXED, __HIP_MEMORY_SCOPE_AGENT); }
__device__ __forceinline__ unsigned xb_add(unsigned* p, unsigned v) { return __hip_atomic_fetch_add(p, v, __ATOMIC_RELAXED, __HIP_MEMORY_SCOPE_AGENT); }
__device__ __forceinline__ unsigned xb_xcc_id() { return (unsigned)__builtin_amdgcn_s_getreg((3 << 11) | 20) & 0xFu; }
#define XB_SPIN(cond, bar) do { unsigned _sp = 0; while (cond) { __builtin_amdgcn_s_sleep(1); \
    if ((++_sp & 255u) == 0u) { if (xb_ld(&(bar)[XB_TMO])) break; if (_sp > XB_SPIN_CAP) { atomicAdd(&(bar)[XB_TMO], 1u); break; } } } } while (0)

struct XcdBarrier {
    unsigned* bar; unsigned x;
    volatile LAS unsigned* st;
};

__device__ __forceinline__ XcdBarrier xcd_barrier_post(unsigned* bar, volatile LAS unsigned* st) {
    XcdBarrier b; b.bar = bar; b.x = xb_xcc_id(); b.st = st;
    if (threadIdx.x == 0) (void)xb_add(&bar[XB_XCNT(b.x)], 1u);
    return b;
}
__device__ __forceinline__ void xcd_barrier_complete(unsigned* bar, unsigned x, unsigned& nloc, unsigned& nx) {
    const unsigned G = gridDim.x * gridDim.y * gridDim.z;
    unsigned sum, cnt, mine, sp = 0u;
    for (;;) {
        sum = 0u; cnt = 0u; mine = 0u;
#pragma unroll
        for (unsigned j = 0; j < 16; ++j) { const unsigned c = xb_ld(&bar[XB_XCNT(j)]); sum += c; cnt += (c > 0u) ? 1u : 0u; mine = (j == x) ? c : mine; }
        if (sum == G) break;
        __builtin_amdgcn_s_sleep(1);
        if ((++sp & 255u) == 0u) { if (xb_ld(&bar[XB_TMO])) break; if (sp > XB_SPIN_CAP) { atomicAdd(&bar[XB_TMO], 1u); break; } }
    }
    nloc = mine > 0u ? mine : 1u; nx = cnt > 0u ? cnt : 1u;
}

__device__ __forceinline__ void xcd_barrier(const XcdBarrier& b) {
    asm volatile("s_waitcnt vmcnt(0)" ::: "memory");
    __syncthreads();
    if (threadIdx.x == 0) {
        unsigned* bar = b.bar; asm volatile("" : "+s"(bar));
        __builtin_amdgcn_s_waitcnt(0);
        unsigned nloc = b.st[0], nx = b.st[1];
        if (nloc == 0u) { xcd_barrier_complete(bar, b.x, nloc, nx); b.st[0] = nloc; b.st[1] = nx; }
        const unsigned old = xb_add(&bar[XB_XSUB(b.x)], 1u);
        const unsigned gen = old / nloc;
        if (old + 1u == (gen + 1u) * nloc) {
            __builtin_amdgcn_fence(__ATOMIC_RELEASE, "agent");
            asm volatile("s_waitcnt vmcnt(0)" ::: "memory");
            const unsigned og = xb_add(&bar[XB_TOP], 1u);
            const unsigned tg = og / nx;
            if (og + 1u == (tg + 1u) * nx) xb_add(&bar[XB_TOPGEN], 1u);
            else XB_SPIN(xb_ld(&bar[XB_TOPGEN]) == tg, bar);
            __builtin_amdgcn_fence(__ATOMIC_ACQUIRE, "agent");
            xb_add(&bar[XB_XGEN(b.x)], 1u);
            asm volatile("s_waitcnt vmcnt(0)" ::: "memory");
        } else {
            XB_SPIN(xb_ld(&bar[XB_XGEN(b.x)]) == gen, bar);
            __builtin_amdgcn_fence(__ATOMIC_ACQUIRE, "agent");
            asm volatile("s_waitcnt vmcnt(0)" ::: "memory");
        }
    }
    __syncthreads();
}


__device__ __forceinline__ int dest_row(int map, int n) {
    if (map == 1) { const int seg = n >> 9; const bool qk = (seg == 0) || (seg == 1) || (seg == 3) || (seg == 4) || (seg >= 6 && seg <= 9); if (!qk) return n; const int j = n & 63; return (n & ~63) + ((j < 32) ? 2 * j : 2 * (j - 32) + 1); }
    if (map == 2) return 8 * (n >> 2) + (n & 3);
    if (map == 3) return 8 * (n >> 2) + 4 + (n & 3);
    return n;
}
__device__ __forceinline__ void p0_transpose_item(const float* W, int K, int N, bf16* WT, int map, LAS float* scr, int item, int lane) {
    const int nblk = N / 32, kb = item / nblk, nb = item % nblk, k0 = 64 * kb, n0 = 32 * nb;
#pragma unroll 8
    for (int i = 0; i < 32; ++i) { const int kk = 2 * i + (lane >> 5); scr[kk * 33 + (lane & 31)] = W[(size_t)(k0 + kk) * N + n0 + (lane & 31)]; }
    LDS_WAIT(); asm volatile("" ::: "memory");
    const int c = lane & 7;
#pragma unroll
    for (int j = 0; j < 4; ++j) { const int n = (lane >> 3) + 8 * j; const LAS float* s = scr + (8 * c) * 33 + n;
        v4u o; o.x = pk2(s[0 * 33], s[1 * 33]); o.y = pk2(s[2 * 33], s[3 * 33]); o.z = pk2(s[4 * 33], s[5 * 33]); o.w = pk2(s[6 * 33], s[7 * 33]);
        *(GAS v4u*)(WT + (size_t)dest_row(map, n0 + n) * K + k0 + 8 * c) = o; }
    LDS_WAIT(); asm volatile("" ::: "memory");
}

struct Args { const void* in[20]; float* out; unsigned char* ws; int ph_lo, ph_hi; };

__global__ void __launch_bounds__(NWAVES * 64, 2) fwd(Args args) {
    extern __shared__ __attribute__((aligned(16))) unsigned char lds[];
    LAS unsigned char* const L = (LAS unsigned char*)lds;
    const int G = gridDim.x, bx = blockIdx.x;
    const int vcu = (G % 8 == 0) ? (bx % 8) * (G / 8) + bx / 8 : bx;
    const int NGW = G * NWAVES;
    typedef __attribute__((address_space(4))) const Args* kargp_t;
#define PHASE_BEGIN() \
    kargp_t ka = (kargp_t)__builtin_amdgcn_kernarg_segment_ptr(); asm volatile("" : "+s"(ka)); \
    unsigned char* const ws = ka->ws; \
    int tid = threadIdx.x; asm volatile("" : "+v"(tid)); \
    const int lane = tid & 63, wave = __builtin_amdgcn_readfirstlane(tid >> 6); const int gw = vcu * NWAVES + wave; (void)gw; (void)lane; (void)ws
#define KIN(T, k) ((const T*)ka->in[k])
    LAS int* const segs = (LAS int*)(L + LT_SEGS); LAS int* const tot = (LAS int*)(L + LT_TOT); LAS int* const basee = (LAS int*)(L + LT_BASE); LAS int* const cnt16 = (LAS int*)(L + LT_CNT);
    LAS unsigned char* const p2e = L + LT_P2E; LAS int* const postab = (LAS int*)(L + LT_POS);
    gu32* const ctl = (gu32*)(args.ws + WS_CTL);

    for (int u = threadIdx.x; u < (LDS_BYTES - LDSCTL_OFF) / 4; u += NWAVES * 64) ((LAS unsigned*)(L + LDSCTL_OFF))[u] = 0u;
    __syncthreads();
    const int lo = args.ph_lo, hi = args.ph_hi;
    XcdBarrier bar; bar.bar = (unsigned*)(ctl + CW_BAR); bar.x = 0; bar.st = nullptr;
    if (hi - lo > 1) bar = xcd_barrier_post((unsigned*)(ctl + CW_BAR), (volatile LAS unsigned*)(L + MISC_OFF) + 8);
#ifndef PHMASK
#define PHMASK 0x1fff
#endif
#define IN(k) (lo <= (k) && (k) < hi)
#define INJ(j) ((((PHMASK) >> (j)) & 1) && IN(pb + (j)))
#ifndef REPEAT_J
#define REPEAT_J (-1)
#endif
#ifndef REPEAT_L
#define REPEAT_L 0
#endif
#ifndef REPEAT_N
#define REPEAT_N 2
#endif
#define REPS(j) ((REPEAT_J == (j) && l == REPEAT_L) ? REPEAT_N : 1)
#define SEAM(k) do { if (IN(k) && IN((k) + 1)) xcd_barrier(bar); } while (0)

#define COMPUTE_SEGMENTS(myrb) do { \
        _Pragma("unroll") for (int q_ = 0; q_ < 2; ++q_) { const int e_ = 2 * wave + q_; int t_ = 0, p_ = 0; \
            _Pragma("unroll") for (int j_ = 0; j_ < 4; ++j_) { const int rb_ = lane + 64 * j_; const int c_ = CNT[rb_ * 16 + e_]; t_ += c_; p_ += (rb_ < (myrb)) ? c_ : 0; } \
            t_ = (int)wave_sum((float)t_); p_ = (int)wave_sum((float)p_); if (lane == 0) { tot[e_] = t_; basee[e_] = p_; } } \
        __syncthreads(); \
        if (tid == 0) { int s_ = 0; for (int e_ = 0; e_ < 16; ++e_) { segs[e_] = s_; s_ += (tot[e_] + 255) & ~255; } segs[16] = s_; } \
        __syncthreads(); \
        if (tid < 160) { const int r_ = tid * 256; int e_ = 0; for (int k_ = 1; k_ < 16; ++k_) if (r_ >= segs[k_]) e_ = k_; p2e[tid] = (unsigned char)e_; } \
        if (tid < 16) basee[tid] += segs[tid]; \
        __syncthreads(); } while (0)

    if (((PHMASK >> 11) & 1) && IN(0)) for (int rp = 0; rp < ((REPEAT_J == 11) ? REPEAT_N : 1); ++rp) {
        PHASE_BEGIN();
        const float* const c_in = KIN(float, 1); const int* const positions = KIN(int, 2); const float* const w_ada = KIN(float, 3); const float* const b_ada = KIN(float, 4);
        const float* const w_in = KIN(float, 7); const float* const w_out = KIN(float, 8); const float* const w_gate = KIN(float, 14); const float* const w_up = KIN(float, 15); const float* const w_down = KIN(float, 16);
        float* const MOD = (float*)(ws + WS_MOD); float* const COS = (float*)(ws + WS_COS); float* const SIN = (float*)(ws + WS_SIN);
        bf16* const WIN = (bf16*)(ws + WS_WIN); bf16* const WOUT = (bf16*)(ws + WS_WOUT); bf16* const WGU = (bf16*)(ws + WS_WGU); bf16* const WDN = (bf16*)(ws + WS_WDN);
        for (int it = bx; it < 96; it += G) {
            const int l = it / 48, cg = it % 48, col = cg * 256 + lane * 4;
            const float* W = w_ada + ((size_t)l * 2048 + wave * 256) * 12288 + col; const float* cc = c_in + wave * 256;
            f32x4 a = (f32x4){0.f, 0.f, 0.f, 0.f};
#pragma unroll 8
            for (int k = 0; k < 256; ++k) { const float cv = cc[k]; const float sv = cv / (1.f + expf(-cv)); a += sv * *(const GAS f32x4*)(W + (size_t)k * 12288); }
            LAS f32x4* red = (LAS f32x4*)L; red[wave * 64 + lane] = a;
            __syncthreads();
            if (tid < 256) { float s = 0.f; const LAS float* rf = (const LAS float*)L;
#pragma unroll
                for (int w = 0; w < 8; ++w) s += rf[(w * 64 + (tid >> 2)) * 4 + (tid & 3)];
                MOD[l * 12288 + cg * 256 + tid] = s + b_ada[l * 12288 + cg * 256 + tid]; }
            __syncthreads();
        }
        { LAS float* scr = (LAS float*)(L + RING_OFF + wave * 16384);
          constexpr int I_IN = 2 * 32 * 192, I_OUT = 2 * 32 * 64, I_G = 32 * 32 * 32, I_D = 32 * 16 * 64, NITEMS = I_IN + I_OUT + 2 * I_G + I_D;
          for (int it = gw; it < NITEMS; it += NGW) {
              int r = it;
              if (r < I_IN) { const int l = r / 6144; p0_transpose_item(w_in + (size_t)l * 2048 * 6144, 2048, 6144, WIN + (size_t)l * 6144 * 2048, 1, scr, r % 6144, lane); continue; } r -= I_IN;
              if (r < I_OUT) { const int l = r / 2048; p0_transpose_item(w_out + (size_t)l * 2048 * 2048, 2048, 2048, WOUT + (size_t)l * 2048 * 2048, 0, scr, r % 2048, lane); continue; } r -= I_OUT;
              if (r < I_G) { const int mt = r / 1024; p0_transpose_item(w_gate + (size_t)mt * 2048 * 1024, 2048, 1024, WGU + (size_t)mt * 2048 * 2048, 2, scr, r % 1024, lane); continue; } r -= I_G;
              if (r < I_G) { const int mt = r / 1024; p0_transpose_item(w_up + (size_t)mt * 2048 * 1024, 2048, 1024, WGU + (size_t)mt * 2048 * 2048, 3, scr, r % 1024, lane); continue; } r -= I_G;
              { const int mt = r / 1024; p0_transpose_item(w_down + (size_t)mt * 1024 * 2048, 1024, 2048, WDN + (size_t)mt * 2048 * 1024, 0, scr, r % 1024, lane); }
          } }
        for (int idx = (vcu * NWAVES * 64 + tid); idx < S_ * 32; idx += G * NWAVES * 64) {
            const int pi = idx >> 5, i = idx & 31; const float inv = (float)exp2(-(double)i * (13.287712379549449 / 32.0)); const float ang = (float)positions[pi] * inv;
            COS[idx] = (float)cos((double)ang); SIN[idx] = (float)sin((double)ang); }
    }
    SEAM(0);

    for (int l = 0; l < DEPTH; ++l) {
        const int pb = 1 + 11 * l;
        const float lam_init = (l == 0) ? 0.2f : 0.35550906759f;
        if (INJ(0)) for (int rp = 0; rp < REPS(0); ++rp) {
            PHASE_BEGIN();
            const float* const x_in = KIN(float, 0); const float* const g_attn = KIN(float, 5); float* const xbuf = ka->out;
            const float* const MOD = (const float*)(ws + WS_MOD); const float* const mod = MOD + l * 12288; bf16* const HB = (bf16*)(ws + WS_H); const bf16* const YB = (const bf16*)(ws + WS_Y);
            f32x4 cA[8], cB[8], cG[8];
#pragma unroll
            for (int j = 0; j < 8; ++j) { const int c4 = lane + 64 * j; const f32x4 g = ((const f32x4*)(g_attn + l * 2048))[c4]; const f32x4 sc = ((const f32x4*)(mod + 2048))[c4];
                cA[j] = g * (1.f + sc); cB[j] = ((const f32x4*)(mod + 0))[c4]; cG[j] = (l > 0) ? ((const f32x4*)(MOD + (l - 1) * 12288 + 10240))[c4] : (f32x4){0.f, 0.f, 0.f, 0.f}; }
            const float* xsrc = (l == 0) ? x_in : xbuf;
            for (int row = gw; row < S_; row += NGW) {
                f32x4 v[8];
#pragma unroll
                for (int j = 0; j < 8; ++j) v[j] = ((const GAS f32x4*)(xsrc + (size_t)row * 2048))[lane + 64 * j];
                if (l > 0) {
#pragma unroll
                    for (int j = 0; j < 8; ++j) { const v2u a = ((const GAS v2u*)(YB + (size_t)(2 * row) * 2048))[lane + 64 * j], b = ((const GAS v2u*)(YB + (size_t)(2 * row + 1) * 2048))[lane + 64 * j];
                        const f32x4 ys = (f32x4){bflo(a.x) + bflo(b.x), bfhi(a.x) + bfhi(b.x), bflo(a.y) + bflo(b.y), bfhi(a.y) + bfhi(b.y)};
                        v[j] += cG[j] * ys; ((GAS f32x4*)(xbuf + (size_t)row * 2048))[lane + 64 * j] = v[j]; }
                }
                float ss = 0.f;
#pragma unroll
                for (int j = 0; j < 8; ++j) ss += (v[j].x * v[j].x + v[j].y * v[j].y) + (v[j].z * v[j].z + v[j].w * v[j].w);
                const float rs = 1.f / sqrtf(wave_sum(ss) * (1.f / 2048.f) + RMS_EPS);
#pragma unroll
                for (int j = 0; j < 8; ++j) { const f32x4 o = v[j] * rs * cA[j] + cB[j]; v2u w; w.x = pk2(o.x, o.y); w.y = pk2(o.z, o.w); ((GAS v2u*)(HB + (size_t)row * 2048))[lane + 64 * j] = w; }
            }
        }
        SEAM(pb + 0);
        if (INJ(1)) for (int rp = 0; rp < REPS(1); ++rp) {
            PHASE_BEGIN();
            bf16* const HB = (bf16*)(ws + WS_H); bf16* const WIN = (bf16*)(ws + WS_WIN); bf16* const PROJ = (bf16*)(ws + WS_PROJ); const float* const COS = (const float*)(ws + WS_COS); const float* const SIN = (const float*)(ws + WS_SIN);
            pg8::DenseSched Sd; Sd.init(HB, WIN + (size_t)l * 6144 * 2048, S_, INW, 2048, G, bx);
            pg8::EpiProj E{PROJ, COS, SIN, attn_body::C2};
            pg8::gemm_phase<pg8::EpiProj, pg8::DenseSched, true, true>(L + RING_OFF, 2048, Sd, E);
        }
        SEAM(pb + 1);
        if (INJ(2)) for (int rp = 0; rp < REPS(2); ++rp) {
            PHASE_BEGIN();
            const bf16* const PROJ = (const bf16*)(ws + WS_PROJ); float* const KMEAN = (float*)(ws + WS_KMEAN);
            for (int t = gw; t < 512; t += NGW) { const int h = t >> 6, j = t & 63; const int rg = lane >> 3, ch = lane & 7;
                float a[8];
#pragma unroll
                for (int e = 0; e < 8; ++e) a[e] = 0.f;
                for (int it = 0; it < 32; ++it) { const v4u w = *(const GAS v4u*)(PROJ + (size_t)(256 * j + 8 * it + rg) * 6144 + C_KB + 64 * h + 8 * ch);
                    a[0] += bflo(w.x); a[1] += bfhi(w.x); a[2] += bflo(w.y); a[3] += bfhi(w.y); a[4] += bflo(w.z); a[5] += bfhi(w.z); a[6] += bflo(w.w); a[7] += bfhi(w.w); }
#pragma unroll
                for (int e = 0; e < 8; ++e) { a[e] += __shfl_xor(a[e], 8); a[e] += __shfl_xor(a[e], 16); a[e] += __shfl_xor(a[e], 32); }
                if (lane < 8) {
#pragma unroll
                    for (int e = 0; e < 8; ++e) KMEAN[(size_t)(h * 64 + j) * 64 + 8 * lane + e] = a[e] * (1.f / 256.f); }
            }
        }
        SEAM(pb + 2);
        if (INJ(3)) for (int rp = 0; rp < REPS(3); ++rp) {
            PHASE_BEGIN();
            const bf16* const PROJ = (const bf16*)(ws + WS_PROJ); const float* const KMEAN = (const float*)(ws + WS_KMEAN); int* const LISTB = (int*)(ws + WS_LIST);
            int* const CNTB = (int*)(ctl + CW_CNTB + l * 512);
            for (int it = vcu; it < 512; it += G) { const int hd = it & 7, qq = it >> 3, qb = (qq & 1) ? 63 - (qq >> 1) : (qq >> 1);
                if (qb == 0) continue;
                LAS float* km = (LAS float*)(L + ATT_KM_OFF);
                __syncthreads();
                for (int k4 = tid; k4 < qb * 16; k4 += NWAVES * 64) ((LAS f32x4*)km)[k4] = ((const GAS f32x4*)(KMEAN + (size_t)hd * 64 * 64))[k4];
                const int q = tid >> 1, dh = tid & 1; float qf[32];
                { const bf16* qrow = PROJ + (size_t)(qb * 256 + q) * 6144 + C_QB + hd * 64 + dh * 32;
#pragma unroll
                  for (int c8 = 0; c8 < 4; ++c8) { const v4u w = *(const GAS v4u*)(qrow + 8 * c8); qf[8 * c8 + 0] = bflo(w.x); qf[8 * c8 + 1] = bfhi(w.x); qf[8 * c8 + 2] = bflo(w.y); qf[8 * c8 + 3] = bfhi(w.y);
                      qf[8 * c8 + 4] = bflo(w.z); qf[8 * c8 + 5] = bfhi(w.z); qf[8 * c8 + 6] = bflo(w.w); qf[8 * c8 + 7] = bfhi(w.w); } }
                __syncthreads();
                float b0 = -INFINITY, b1 = -INFINITY, b2 = -INFINITY; int i0 = -1, i1 = -1, i2 = -1;
                for (int j = 0; j < qb; ++j) { const LAS f32x4* kr = (const LAS f32x4*)(km + j * 64 + dh * 32); float g = 0.f;
#pragma unroll
                    for (int c4 = 0; c4 < 8; ++c4) { const f32x4 kv = kr[c4]; g = fmaf(qf[4 * c4 + 0], kv.x, g); g = fmaf(qf[4 * c4 + 1], kv.y, g); g = fmaf(qf[4 * c4 + 2], kv.z, g); g = fmaf(qf[4 * c4 + 3], kv.w, g); }
                    g += __shfl_xor(g, 1);
                    if (g > b0) { b2 = b1; i2 = i1; b1 = b0; i1 = i0; b0 = g; i0 = j; } else if (g > b1) { b2 = b1; i2 = i1; b1 = g; i1 = j; } else if (g > b2) { b2 = g; i2 = j; } }
                if (dh == 0) { const int row = qb * 256 + q;
                    if (i0 >= 0) { const int p = __hip_atomic_fetch_add(CNTB + hd * 64 + i0, 1, RLX_AGENT); LISTB[(size_t)(hd * 64 + i0) * 16384 + p] = row; }
                    if (i1 >= 0) { const int p = __hip_atomic_fetch_add(CNTB + hd * 64 + i1, 1, RLX_AGENT); LISTB[(size_t)(hd * 64 + i1) * 16384 + p] = row | (1 << 16); }
                    if (i2 >= 0) { const int p = __hip_atomic_fetch_add(CNTB + hd * 64 + i2, 1, RLX_AGENT); LISTB[(size_t)(hd * 64 + i2) * 16384 + p] = row | (2 << 16); } }
            }
        }
        SEAM(pb + 3);
        if (INJ(4)) for (int rp = 0; rp < REPS(4); ++rp) {
            PHASE_BEGIN();
            const bf16* const PROJ = (const bf16*)(ws + WS_PROJ); float* const TB = (float*)(ws + WS_T);
            char* const shm = (char*)lds + RING_OFF;
#if !defined(NO_ATT_C)
#if defined(REPEAT_SKIP_C)
            if (rp == 0)
#endif
            for (int vc = vcu; vc < 256; vc += G) {
                const int st = vc >> 4, hd = st >> 1, mp = st & 1, s = vc & 15;
                const attn_body::bf16* Qp = (const attn_body::bf16*)PROJ + C_QC + hd * 128 + mp * 64; const attn_body::bf16* Kp = (const attn_body::bf16*)PROJ + C_KC + hd * 128 + mp * 64;
                const attn_body::bf16* Vp = (const attn_body::bf16*)PROJ + C_VC + hd * 128; float* Op = TB + (size_t)mp * S_ * 1024 + hd * 128;
                for (int i = 3; i >= 0; --i) { const int qb = 32 * (i >> 1) + ((i & 1) ? 31 - s : s);
                    attn_body::attn_unit128<8>(qb, Qp, Kp, Vp, Op, 1024, shm); }
            }
#endif
            { int t2 = threadIdx.x; asm volatile("" : "+v"(t2));
              LAS int* const ust = (LAS int*)(L + ATT_UST_OFF); LAS int* const wtot = ust + 520; LAS int* const qn = (LAS int*)(L + ATT_QN_OFF);
              const int* const CNTB = (const int*)(ctl + CW_CNTB + l * 512);
              const int nl = CNTB[t2]; const int nch = (8 + ((nl + 31) >> 5) + 15) >> 4;
              int inc = nch;
#pragma unroll
              for (int o = 1; o < 64; o <<= 1) { const int v = __shfl_up(inc, o); if ((t2 & 63) >= o) inc += v; }
              if ((t2 & 63) == 63) wtot[t2 >> 6] = inc;
              __syncthreads();
              int pre = 0;
              for (int w = 0; w < (t2 >> 6); ++w) pre += wtot[w];
              ust[t2 + 1] = pre + inc; if (t2 == 0) ust[0] = 0;
              __syncthreads();
              const int nB = ust[512], nU = nB + 1536;
              gu32* const qhead = ctl + CW_QUEUE + 64 * (l + 2 * rp);
              for (;;) {
                  if (t2 == 0) qn[0] = (int)__hip_atomic_fetch_add(qhead, 1u, RLX_AGENT);
                  __syncthreads();
                  const int u = __builtin_amdgcn_readfirstlane(qn[0]);
                  __syncthreads();
                  if (u >= nU) break;
                  attn_body::BraUnit U;
                  if (u < nB) {
                      int lo_ = 0, hi_ = 512;
                      while (hi_ - lo_ > 1) { const int mid = (lo_ + hi_) >> 1; if (ust[mid] <= u) lo_ = mid; else hi_ = mid; }
                      const int hj = lo_, hd = hj >> 6, jb = hj & 63, c = u - ust[hj]; const int nlist = CNTB[hj]; const int ntile = 8 + ((nlist + 31) >> 5);
                      U.Q = (const attn_body::bf16*)PROJ + C_QB + hd * 64; U.K = (const attn_body::bf16*)PROJ + C_KB + hd * 64; U.V = (const attn_body::bf16*)PROJ + C_VB + hd * 64;
                      U.PO = (attn_body::bf16*)(ws + WS_POB) + hd * 64; U.PL = (float*)(ws + WS_PLB) + hd;
                      U.kbase = 256 * jb; U.kstride = 1; U.t_first = 0; U.nkt = 4; U.nqt = (ntile - 16 * c) < 16 ? (ntile - 16 * c) : 16;
                      U.qbase = 0; U.qstride = 0; U.slotA = 0; U.list = (const int*)(ws + WS_LIST) + (size_t)hj * 16384; U.nlist = nlist; U.tile0 = 16 * c; U.ownrow0 = 256 * jb;
                      attn_body::bra_unit<1>(U, shm);
                  } else {
                      const int a = u - nB, hd = a / 192, r = a % 192, pt = r >> 6, w6 = r & 63; const int dil = (pt == 0) ? 1 : (pt == 1) ? 4 : 16;
                      const int nblk = 64 / dil, rho = w6 / nblk, ib = w6 % nblk;
                      U.Q = (const attn_body::bf16*)PROJ + C_QA + hd * 64; U.K = (const attn_body::bf16*)PROJ + C_KA + hd * 64; U.V = (const attn_body::bf16*)PROJ + C_VA + hd * 64;
                      U.PO = (attn_body::bf16*)(ws + WS_POA) + hd * 64; U.PL = (float*)(ws + WS_PLA) + hd;
                      U.kbase = rho + dil * (256 * ib - 128); U.kstride = dil; U.t_first = (ib == 0) ? 2 : 0; U.nkt = 6; U.nqt = 8;
                      U.qbase = rho + dil * 256 * ib; U.qstride = dil; U.slotA = pt; U.list = nullptr; U.nlist = 0; U.tile0 = 0; U.ownrow0 = 0;
                      attn_body::bra_unit<0>(U, shm);
                  }
              }
            }
        }
        SEAM(pb + 4);
        if (INJ(5)) for (int rp = 0; rp < REPS(5); ++rp) {
            PHASE_BEGIN();
            const float* const lam_q1 = KIN(float, 9); const float* const lam_k1 = KIN(float, 10); const float* const lam_q2 = KIN(float, 11); const float* const lam_k2 = KIN(float, 12); const float* const g_sub = KIN(float, 13);
            const float* const TB = (const float*)(ws + WS_T); bf16* const MERGED = (bf16*)(ws + WS_MERGED);
            const bf16* const POA = (const bf16*)(ws + WS_POA); const bf16* const POB = (const bf16*)(ws + WS_POB); const float* const PLA = (const float*)(ws + WS_PLA); const float* const PLB = (const float*)(ws + WS_PLB);
            const float d1 = wave_sum(lam_q1[l * 64 + lane] * lam_k1[l * 64 + lane]), d2 = wave_sum(lam_q2[l * 64 + lane] * lam_k2[l * 64 + lane]);
            const float lam = expf(d1) - expf(d2) + lam_init;
            const f32x4 gs = ((const f32x4*)(g_sub + l * 128))[lane & 31]; const float osc = 1.f - lam_init;
            for (int row = gw; row < S_; row += NGW) {
                { float ls[3], mx = -INFINITY;
#pragma unroll
                  for (int sl = 0; sl < 3; ++sl) { ls[sl] = PLA[((size_t)sl * S_ + row) * 8 + (lane >> 3)]; mx = fmaxf(mx, ls[sl]); }
                  float acc[8], wsum = 0.f;
#pragma unroll
                  for (int e = 0; e < 8; ++e) acc[e] = 0.f;
#pragma unroll
                  for (int sl = 0; sl < 3; ++sl) { const float wgt = exp2f(ls[sl] - mx); wsum += wgt; const v4u w = ((const GAS v4u*)(POA + ((size_t)sl * S_ + row) * 512))[lane];
                      acc[0] += wgt * bflo(w.x); acc[1] += wgt * bfhi(w.x); acc[2] += wgt * bflo(w.y); acc[3] += wgt * bfhi(w.y); acc[4] += wgt * bflo(w.z); acc[5] += wgt * bfhi(w.z); acc[6] += wgt * bflo(w.w); acc[7] += wgt * bfhi(w.w); }
                  const float iw = 1.f / wsum; v4u o; o.x = pk2(acc[0] * iw, acc[1] * iw); o.y = pk2(acc[2] * iw, acc[3] * iw); o.z = pk2(acc[4] * iw, acc[5] * iw); o.w = pk2(acc[6] * iw, acc[7] * iw);
                  ((GAS v4u*)(MERGED + (size_t)row * 2048))[lane] = o; }
                { const int own = row >> 8, nsel = own < 3 ? own : 3; float ls[4], mx = -INFINITY;
#pragma unroll
                  for (int sl = 0; sl < 4; ++sl) { const bool on = (sl == 3) || (sl < nsel); ls[sl] = on ? PLB[((size_t)sl * S_ + row) * 8 + (lane >> 3)] : -INFINITY; mx = fmaxf(mx, ls[sl]); }
                  float acc[8], wsum = 0.f;
#pragma unroll
                  for (int e = 0; e < 8; ++e) acc[e] = 0.f;
#pragma unroll
                  for (int sl = 0; sl < 4; ++sl) { const bool on = (sl == 3) || (sl < nsel);
                      if (on) { const float wgt = exp2f(ls[sl] - mx); wsum += wgt; const v4u w = ((const GAS v4u*)(POB + ((size_t)sl * S_ + row) * 512))[lane];
                          acc[0] += wgt * bflo(w.x); acc[1] += wgt * bfhi(w.x); acc[2] += wgt * bflo(w.y); acc[3] += wgt * bfhi(w.y); acc[4] += wgt * bflo(w.z); acc[5] += wgt * bfhi(w.z); acc[6] += wgt * bflo(w.w); acc[7] += wgt * bfhi(w.w); } }
                  const float iw = 1.f / wsum; v4u o; o.x = pk2(acc[0] * iw, acc[1] * iw); o.y = pk2(acc[2] * iw, acc[3] * iw); o.z = pk2(acc[4] * iw, acc[5] * iw); o.w = pk2(acc[6] * iw, acc[7] * iw);
                  ((GAS v4u*)(MERGED + (size_t)row * 2048 + 512))[lane] = o; }
#pragma unroll
                for (int j = 0; j < 4; ++j) { const f32x4 a = ((const GAS f32x4*)(TB + (size_t)row * 1024))[lane + 64 * j], b = ((const GAS f32x4*)(TB + (size_t)(S_ + row) * 1024))[lane + 64 * j];
                    const f32x4 v = a - lam * b; float ss = (v.x * v.x + v.y * v.y) + (v.z * v.z + v.w * v.w);
                    ss += __shfl_xor(ss, 1); ss += __shfl_xor(ss, 2); ss += __shfl_xor(ss, 4); ss += __shfl_xor(ss, 8); ss += __shfl_xor(ss, 16);
                    const float rs = 1.f / sqrtf(ss * (1.f / 128.f) + RMS_EPS); const f32x4 o = v * rs * gs * osc;
                    v2u w; w.x = pk2(o.x, o.y); w.y = pk2(o.z, o.w); ((GAS v2u*)(MERGED + (size_t)row * 2048 + 1024))[lane + 64 * j] = w; }
            }
        }
        SEAM(pb + 5);
        if (INJ(6)) for (int rp = 0; rp < REPS(6); ++rp) {
            PHASE_BEGIN();
            const float* const x_in = KIN(float, 0); float* const xbuf = ka->out; const float* const mod = (const float*)(ws + WS_MOD) + l * 12288;
            bf16* const MERGED = (bf16*)(ws + WS_MERGED); bf16* const WOUT = (bf16*)(ws + WS_WOUT);
            pg8::DenseSched Sd; Sd.init(MERGED, WOUT + (size_t)l * 2048 * 2048, S_, 2048, 2048, G, bx);
            pg8::EpiGateRes E{(l == 0) ? x_in : (const float*)xbuf, xbuf, mod + 4096};
            pg8::gemm_phase<pg8::EpiGateRes, pg8::DenseSched, true, true>(L + RING_OFF, 2048, Sd, E);
        }
        SEAM(pb + 6);
        if (INJ(7)) for (int rp = 0; rp < REPS(7); ++rp) {
            PHASE_BEGIN();
            const float* const g_mlp = KIN(float, 6); const float* const w_router = KIN(float, 17); const float* const b_router = KIN(float, 18); const float* const xbuf = ka->out;
            const float* const mod = (const float*)(ws + WS_MOD) + l * 12288; bf16* const HB = (bf16*)(ws + WS_H);
            int* const EID = (int*)(ws + WS_EID); float* const WTS = (float*)(ws + WS_WTS); int* const CNT = (int*)(ws + WS_CNT);
            LAS float* const RW = (LAS float*)L;
            for (int idx = tid; idx < 32768; idx += NWAVES * 64) RW[(idx & 15) * 2048 + (idx >> 4)] = w_router[idx];
            f32x4 cA[8], cB[8];
#pragma unroll
            for (int j = 0; j < 8; ++j) { const int c4 = lane + 64 * j; const f32x4 g = ((const f32x4*)(g_mlp + l * 2048))[c4]; const f32x4 sc = ((const f32x4*)(mod + 8192))[c4];
                cA[j] = g * (1.f + sc); cB[j] = ((const f32x4*)(mod + 6144))[c4]; }
            float br[16];
#pragma unroll
            for (int e = 0; e < 16; ++e) br[e] = b_router[e];
            for (int rb = bx; rb < NROWBLK; rb += G) {
                if (tid < 16) cnt16[tid] = 0;
                __syncthreads();
                for (int i = 0; i < 8; ++i) { const int row = 64 * rb + 8 * wave + i;
                    f32x4 v[8]; float ss = 0.f;
#pragma unroll
                    for (int j = 0; j < 8; ++j) { v[j] = ((const GAS f32x4*)(xbuf + (size_t)row * 2048))[lane + 64 * j]; ss += (v[j].x * v[j].x + v[j].y * v[j].y) + (v[j].z * v[j].z + v[j].w * v[j].w); }
                    const float rs = 1.f / sqrtf(wave_sum(ss) * (1.f / 2048.f) + RMS_EPS);
                    float p[16];
#pragma unroll
                    for (int e = 0; e < 16; ++e) p[e] = 0.f;
#pragma unroll
                    for (int j = 0; j < 8; ++j) { const f32x4 o = v[j] * rs * cA[j] + cB[j]; v2u w; w.x = pk2(o.x, o.y); w.y = pk2(o.z, o.w); ((GAS v2u*)(HB + (size_t)row * 2048))[lane + 64 * j] = w;
#pragma unroll
                        for (int e = 0; e < 16; ++e) { const f32x4 w4 = ((const LAS f32x4*)(RW + e * 2048))[lane + 64 * j]; p[e] += (o.x * w4.x + o.y * w4.y) + (o.z * w4.z + o.w * w4.w); } }
#pragma unroll
                    for (int e = 0; e < 16; ++e) p[e] = wave_sum(p[e]);
                    float sg[16], sv[16];
#pragma unroll
                    for (int e = 0; e < 16; ++e) { sv[e] = 1.f / (1.f + expf(-p[e])); sg[e] = sv[e] + br[e]; }
                    float gsc[4];
#pragma unroll
                    for (int g4 = 0; g4 < 4; ++g4) { const float a = sg[4 * g4], b = sg[4 * g4 + 1], c = sg[4 * g4 + 2], d = sg[4 * g4 + 3];
                        const float h1 = fmaxf(a, b), l1 = fminf(a, b), h2 = fmaxf(c, d), l2 = fminf(c, d); gsc[g4] = fmaxf(h1, h2) + fmaxf(fminf(h1, h2), fmaxf(l1, l2)); }
                    int gi = 0; float gb = gsc[0];
#pragma unroll
                    for (int g4 = 1; g4 < 4; ++g4) if (gsc[g4] > gb) { gb = gsc[g4]; gi = g4; }
                    float cd[4], cs[4];
#pragma unroll
                    for (int k = 0; k < 4; ++k) { cd[k] = (gi == 0) ? sg[k] : (gi == 1) ? sg[4 + k] : (gi == 2) ? sg[8 + k] : sg[12 + k]; cs[k] = (gi == 0) ? sv[k] : (gi == 1) ? sv[4 + k] : (gi == 2) ? sv[8 + k] : sv[12 + k]; }
                    int l0 = 0; float v0 = cd[0], s0 = cs[0];
#pragma unroll
                    for (int k = 1; k < 4; ++k) if (cd[k] > v0) { v0 = cd[k]; l0 = k; s0 = cs[k]; }
                    int l1i = -1; float v1 = -INFINITY, s1 = 0.f;
#pragma unroll
                    for (int k = 0; k < 4; ++k) if (k != l0 && cd[k] > v1) { v1 = cd[k]; l1i = k; s1 = cs[k]; }
                    const int e0 = 4 * gi + l0, e1 = 4 * gi + l1i; const float wsum = s0 + s1;
                    if (lane == 0) { EID[2 * row] = e0; EID[2 * row + 1] = e1; WTS[2 * row] = s0 / wsum; WTS[2 * row + 1] = s1 / wsum; atomicAdd((int*)(cnt16 + e0), 1); atomicAdd((int*)(cnt16 + e1), 1); }
                }
                __syncthreads();
                if (tid < 16) CNT[rb * 16 + tid] = cnt16[tid];
                __syncthreads();
            }
        }
        SEAM(pb + 7);
        if (INJ(8)) for (int rp = 0; rp < REPS(8); ++rp) {
            PHASE_BEGIN();
            const bf16* const HB = (const bf16*)(ws + WS_H); bf16* const XS = (bf16*)(ws + WS_XS);
            const int* const EID = (const int*)(ws + WS_EID); const float* const WTS = (const float*)(ws + WS_WTS); int* const ROWTOK = (int*)(ws + WS_ROWTOK); float* const ROWW = (float*)(ws + WS_ROWW); const int* const CNT = (const int*)(ws + WS_CNT);
            for (int rb = bx; rb < NROWBLK; rb += G) {
                COMPUTE_SEGMENTS(rb);
                if (wave == 0) { const int row = 64 * rb + lane; const int e0 = EID[2 * row], e1 = EID[2 * row + 1]; int p0 = 0, p1 = 0;
                    const unsigned long long lt = (1ull << lane) - 1ull;
                    for (int e = 0; e < 16; ++e) { const unsigned long long m0 = __ballot(e0 == e), m1 = __ballot(e1 == e); const int r = __popcll(m0 & lt) + __popcll(m1 & lt);
                        if (e0 == e) p0 = basee[e] + r; if (e1 == e) p1 = basee[e] + r; }
                    postab[2 * lane] = p0; postab[2 * lane + 1] = p1;
                    ROWTOK[p0] = 2 * row; ROWTOK[p1] = 2 * row + 1; ROWW[p0] = WTS[2 * row]; ROWW[p1] = WTS[2 * row + 1]; }
                __syncthreads();
                for (int i = 0; i < 8; ++i) { const int r = 8 * wave + i, row = 64 * rb + r; const int p0 = postab[2 * r], p1 = postab[2 * r + 1];
#pragma unroll
                    for (int c = 0; c < 4; ++c) { const v4u w = ((const GAS v4u*)(HB + (size_t)row * 2048))[lane + 64 * c]; ((GAS v4u*)(XS + (size_t)p0 * 2048))[lane + 64 * c] = w; ((GAS v4u*)(XS + (size_t)p1 * 2048))[lane + 64 * c] = w; } }
                if (rb < 16) { const int pbeg = segs[rb] + tot[rb], pend = segs[rb + 1];
                    for (int p = pbeg + tid; p < pend; p += NWAVES * 64) { ROWTOK[p] = -1; ROWW[p] = 0.f; } }
                __syncthreads();
            }
        }
        SEAM(pb + 8);
        if (INJ(9)) for (int rp = 0; rp < REPS(9); ++rp) {
            PHASE_BEGIN();
            const int* const CNT = (const int*)(ws + WS_CNT); bf16* const XS = (bf16*)(ws + WS_XS); bf16* const WGU = (bf16*)(ws + WS_WGU); bf16* const ACT = (bf16*)(ws + WS_ACT);
            COMPUTE_SEGMENTS(0);
            pg8::MoeSched Sm; Sm.init(XS, WGU + (size_t)l * 16 * 2048 * 2048, segs[16], 2048, 2048, (size_t)2048 * 2048 * 2, (const PG8_LAS unsigned char*)p2e, G, bx);
            pg8::EpiSwiglu E{ACT};
            pg8::gemm_phase<pg8::EpiSwiglu, pg8::MoeSched, true, true>(L + RING_OFF, 2048, Sm, E);
        }
        SEAM(pb + 9);
        if (INJ(10)) for (int rp = 0; rp < REPS(10); ++rp) {
            PHASE_BEGIN();
            const int* const CNT = (const int*)(ws + WS_CNT); bf16* const ACT = (bf16*)(ws + WS_ACT); bf16* const WDN = (bf16*)(ws + WS_WDN); bf16* const YB = (bf16*)(ws + WS_Y);
            const int* const ROWTOK = (const int*)(ws + WS_ROWTOK); const float* const ROWW = (const float*)(ws + WS_ROWW);
            COMPUTE_SEGMENTS(0);
            pg8::MoeSched Sm; Sm.init(ACT, WDN + (size_t)l * 16 * 2048 * 1024, segs[16], 2048, 1024, (size_t)2048 * 1024 * 2, (const PG8_LAS unsigned char*)p2e, G, bx);
            pg8::EpiDown E{YB, ROWTOK, ROWW};
            pg8::gemm_phase<pg8::EpiDown, pg8::MoeSched, true, true>(L + RING_OFF, 1024, Sm, E);
        }
        SEAM(pb + 10);
    }
    if (((PHMASK >> 12) & 1) && IN(23)) {
        PHASE_BEGIN();
        const float* const g_final = KIN(float, 19); float* const xbuf = ka->out; const float* const MOD = (const float*)(ws + WS_MOD); const bf16* const YB = (const bf16*)(ws + WS_Y);
        f32x4 cA[8], cG[8];
#pragma unroll
        for (int j = 0; j < 8; ++j) { const int c4 = lane + 64 * j; cA[j] = ((const f32x4*)g_final)[c4]; cG[j] = ((const f32x4*)(MOD + 12288 + 10240))[c4]; }
        for (int row = gw; row < S_; row += NGW) {
            f32x4 v[8]; float ss = 0.f;
#pragma unroll
            for (int j = 0; j < 8; ++j) { v[j] = ((const GAS f32x4*)(xbuf + (size_t)row * 2048))[lane + 64 * j];
                const v2u a = ((const GAS v2u*)(YB + (size_t)(2 * row) * 2048))[lane + 64 * j], b = ((const GAS v2u*)(YB + (size_t)(2 * row + 1) * 2048))[lane + 64 * j];
                const f32x4 ys = (f32x4){bflo(a.x) + bflo(b.x), bfhi(a.x) + bfhi(b.x), bflo(a.y) + bflo(b.y), bfhi(a.y) + bfhi(b.y)};
                v[j] += cG[j] * ys; ss += (v[j].x * v[j].x + v[j].y * v[j].y) + (v[j].z * v[j].z + v[j].w * v[j].w); }
            const float rs = 1.f / sqrtf(wave_sum(ss) * (1.f / 2048.f) + RMS_EPS);
#pragma unroll
            for (int j = 0; j < 8; ++j) ((GAS f32x4*)(xbuf + (size_t)row * 2048))[lane + 64 * j] = v[j] * rs * cA[j];
        }
    }
#undef IN
#undef INJ
#undef REPS
#undef PHASE_BEGIN
#undef KIN
#undef SEAM
#undef COMPUTE_SEGMENTS
}

extern "C" void kernel_launch(void* const* d_in, const int* in_sizes, int n_in, void* d_out, int out_size, void* d_ws, size_t ws_size, hipStream_t stream) {
    static int grid = 0;
    if (grid == 0) {
        if (n_in != 20 || in_sizes[0] != S_ * DM_ || out_size != S_ * DM_ || ws_size < WS_END) { fprintf(stderr, "kernel_launch: unexpected shapes or workspace (%d inputs, in0 %d, out %d, ws %zu); nothing launched\n", n_in, n_in > 0 ? in_sizes[0] : -1, out_size, ws_size); grid = -1; return; }
        int dev = 0, cus = 0, per_cu = 0;
        if (hipGetDevice(&dev) != hipSuccess || hipDeviceGetAttribute(&cus, hipDeviceAttributeMultiprocessorCount, dev) != hipSuccess) { grid = -1; return; }
        if (hipFuncSetAttribute((const void*)fwd, hipFuncAttributeMaxDynamicSharedMemorySize, LDS_BYTES) != hipSuccess) { fprintf(stderr, "kernel_launch: hipFuncSetAttribute failed\n"); grid = -1; return; }
        if (hipOccupancyMaxActiveBlocksPerMultiprocessor(&per_cu, (const void*)fwd, NWAVES * 64, LDS_BYTES) != hipSuccess || per_cu < 1) fprintf(stderr, "kernel_launch: occupancy query reports %d blocks per CU\n", per_cu);
        (void)hipGetLastError();
        grid = cus;
    }
    if (grid < 0) return;
    if (hipMemsetAsync((char*)d_ws + WS_CTL, 0, CTL_ZERO_BYTES, stream) != hipSuccess) return;
    Args a{};
    for (int i = 0; i < 20; ++i) a.in[i] = d_in[i];
    a.out = (float*)d_out; a.ws = (unsigned char*)d_ws;
    if (MK_N_LAUNCHES == 1) { a.ph_lo = 0; a.ph_hi = N_PHASES; hipLaunchKernelGGL(fwd, dim3(grid), dim3(NWAVES * 64), LDS_BYTES, stream, a); }
    else for (int p = 0; p < N_PHASES; ++p) { a.ph_lo = p; a.ph_hi = p + 1; hipLaunchKernelGGL(fwd, dim3(grid), dim3(NWAVES * 64), LDS_BYTES, stream, a); }
}
```

```cpp
#include <hip/hip_runtime.h>
#include <hip/hip_bf16.h>
#include <cstdio>
#include <cstdint>
#include <cmath>
namespace pg8 {
#define PG8_LAS __attribute__((address_space(3)))
typedef unsigned short bf16_t;
typedef short bf16x8 __attribute__((ext_vector_type(8)));
typedef float f32x4 __attribute__((ext_vector_type(4)));
typedef unsigned u32x4 __attribute__((ext_vector_type(4)));
constexpr int BM = 256, BK = 64, HALF = 128, HTB = HALF * BK * 2  , STAGE_BYTES = 8 * HTB, NXCD = 8, WGM = 8;

__host__ __device__ __forceinline__ int lds_byte(int r, int c) { const int st = (r >> 4) * 2 + (c >> 5), rr = r & 15, cc = c & 31, ob = rr * 64 + cc * 2; return st * 1024 + (ob ^ (((ob >> 9) & 1) << 5)); }
__host__ __device__ __forceinline__ void stage_rc(int b, int& R, int& C) { const int st = b / 1024, sb = b % 1024, swz = sb ^ (((sb >> 9) & 1) << 5); R = (st >> 1) * 16 + swz / 64; C = (st & 1) * 32 + (swz % 64) / 2; }
__host__ __device__ __forceinline__ int perm32(int rho) { const int n = rho >> 4, i = rho & 15; return 8 * (i >> 2) + 4 * n + (i & 3); }

struct Unit { int pm, pn; };
struct Gemm { const bf16_t* A; const bf16_t* Bt; int M, N, K; };

struct StaticOrder {
    int nM, nN, nwg, G, c;
    __host__ __device__ void init(int M, int N, int G_, int c_) { nM = M / BM; nN = N / BM; nwg = nM * nN; G = G_; c = c_; }
    __host__ __device__ bool next(int i, Unit& u) const {
        const long L = (long)i * G + c; if (L >= nwg) return false;
        int wgid = (int)L; { const int q = nwg / NXCD, r = nwg % NXCD, xcd = wgid % NXCD, off = wgid / NXCD; wgid = (xcd < r ? xcd * (q + 1) : r * (q + 1) + (xcd - r) * q) + off; }
        const int nig = WGM * nN, gid = wgid / nig, fm = gid * WGM, gsz = (nM - fm) < WGM ? (nM - fm) : WGM;
        u.pm = fm + ((wgid % nig) % gsz); u.pn = (wgid % nig) / gsz; return true;
    }
    __device__ __forceinline__ void a_ready(const Unit&) const {}
    __device__ __forceinline__ void done(const Unit&) const {}
};

struct DenseSched {
    const char* A; const char* Bt; size_t tstep; StaticOrder so;
    __device__ __forceinline__ void init(const void* A_, const void* Bt_, int M, int N, int KB, int G, int c) { A = (const char*)A_; Bt = (const char*)Bt_; tstep = (size_t)BM * KB; so.init(M, N, G, c); }
    __device__ __forceinline__ bool next(int i, Unit& u) const { return so.next(i, u); }
    __device__ __forceinline__ const char* a_ptr(const Unit& u) const { return A + (size_t)u.pm * tstep; }
    __device__ __forceinline__ const char* b_ptr(const Unit& u) const { return Bt + (size_t)u.pn * tstep; }
    __device__ __forceinline__ void a_ready(const Unit&) const {}
    __device__ __forceinline__ void done(const Unit&) const {}
};
struct MoeSched {
    const char* A; const char* Bt; size_t tstep, estride; StaticOrder so; const PG8_LAS unsigned char* p2e;
    __device__ __forceinline__ void init(const void* A_, const void* Bt_, int Mpad, int N, int KB, size_t estride_, const PG8_LAS unsigned char* p2e_, int G, int c) {
        A = (const char*)A_; Bt = (const char*)Bt_; tstep = (size_t)BM * KB; estride = estride_; p2e = p2e_; so.init(Mpad, N, G, c); }
    __device__ __forceinline__ bool next(int i, Unit& u) const { return so.next(i, u); }
    __device__ __forceinline__ const char* a_ptr(const Unit& u) const { return A + (size_t)u.pm * tstep; }
    __device__ __forceinline__ const char* b_ptr(const Unit& u) const { const int e = __builtin_amdgcn_readfirstlane((int)p2e[u.pm]); return Bt + (size_t)e * estride + (size_t)u.pn * tstep; }
    __device__ __forceinline__ void a_ready(const Unit&) const {}
    __device__ __forceinline__ void done(const Unit&) const {}
};

__device__ __forceinline__ unsigned pk4_fp8(float a, float b, float c, float d) {
    a = __builtin_fminf(__builtin_fmaxf(a, -448.f), 448.f); b = __builtin_fminf(__builtin_fmaxf(b, -448.f), 448.f); c = __builtin_fminf(__builtin_fmaxf(c, -448.f), 448.f); d = __builtin_fminf(__builtin_fmaxf(d, -448.f), 448.f);
    int w = 0; w = __builtin_amdgcn_cvt_pk_fp8_f32(a, b, w, false); w = __builtin_amdgcn_cvt_pk_fp8_f32(c, d, w, true); return (unsigned)w; }
__device__ __forceinline__ unsigned cvt_pk_bf16(float lo, float hi) { unsigned r; asm volatile("v_cvt_pk_bf16_f32 %0, %1, %2" : "=v"(r) : "v"(lo), "v"(hi)); return r; }

struct EpiProj {
    static constexpr bool PERM = true, AFTER_DRAIN = false;
    bf16_t* O; const float* cosT; const float* sinT; float qscale, oscale;
    __device__ __forceinline__ void operator()(const f32x4 (&acc)[2][2][4][2], const Unit& u, int wr, int wc, int fr, int fq) const {
        const int pn = u.pn;
        const bool isq = (pn < 2) || (pn == 6) || (pn == 7) || (pn >= 12 && pn < 16);
        const bool isk = (pn == 2) || (pn == 3) || (pn == 8) || (pn == 9) || (pn >= 16 && pn < 20);
        const int row0 = u.pm * BM + wr * 64 + fr, col0 = pn * BM + wc * 32 + 8 * fq;
        const int i0 = (wc & 1) * 16 + 4 * fq;
        const float sc = isq ? qscale * oscale : oscale;
#pragma unroll
        for (int ai = 0; ai < 2; ++ai)
#pragma unroll
            for (int m = 0; m < 4; ++m) { const int row = row0 + ai * HALF + m * 16; bf16_t* rowp = O + (size_t)row * 6144 + col0;
                f32x4 cs = (f32x4){1.f, 1.f, 1.f, 1.f}, sn = (f32x4){0.f, 0.f, 0.f, 0.f};
                if (isq || isk) { cs = *(const f32x4*)(cosT + (size_t)row * 32 + i0); sn = *(const f32x4*)(sinT + (size_t)row * 32 + i0); }
#pragma unroll
                for (int bj = 0; bj < 2; ++bj) { const f32x4 v0 = acc[ai][bj][m][0], v1 = acc[ai][bj][m][1];
                    const float a0 = (v0[0] * cs[0] - v0[1] * sn[0]) * sc, b0 = (v0[1] * cs[0] + v0[0] * sn[0]) * sc;
                    const float a1 = (v0[2] * cs[1] - v0[3] * sn[1]) * sc, b1 = (v0[3] * cs[1] + v0[2] * sn[1]) * sc;
                    const float a2 = (v1[0] * cs[2] - v1[1] * sn[2]) * sc, b2 = (v1[1] * cs[2] + v1[0] * sn[2]) * sc;
                    const float a3 = (v1[2] * cs[3] - v1[3] * sn[3]) * sc, b3 = (v1[3] * cs[3] + v1[2] * sn[3]) * sc;
                    u32x4 w; w.x = cvt_pk_bf16(a0, b0); w.y = cvt_pk_bf16(a1, b1); w.z = cvt_pk_bf16(a2, b2); w.w = cvt_pk_bf16(a3, b3);
                    *(u32x4*)(rowp + bj * HALF) = w; } }
    }
};
struct EpiGateRes {
    static constexpr bool PERM = false, AFTER_DRAIN = false;
    const float* base; float* out; const float* gate; float oscale;
    __device__ __forceinline__ void operator()(const f32x4 (&acc)[2][2][4][2], const Unit& u, int wr, int wc, int fr, int fq) const {
        const int col0 = u.pn * BM + wc * 32 + 4 * fq;
        f32x4 gv[2][2];
#pragma unroll
        for (int bj = 0; bj < 2; ++bj)
#pragma unroll
            for (int n = 0; n < 2; ++n) gv[bj][n] = *(const f32x4*)(gate + col0 + bj * HALF + n * 16) * oscale;
#pragma unroll
        for (int ai = 0; ai < 2; ++ai)
#pragma unroll
            for (int m = 0; m < 4; ++m) { const size_t off = (size_t)(u.pm * BM + ai * HALF + wr * 64 + m * 16 + fr) * 2048 + col0;
#pragma unroll
                for (int bj = 0; bj < 2; ++bj)
#pragma unroll
                    for (int n = 0; n < 2; ++n) { const f32x4 bs = *(const f32x4*)(base + off + bj * HALF + n * 16); *(f32x4*)(out + off + bj * HALF + n * 16) = bs + gv[bj][n] * acc[ai][bj][m][n]; } }
    }
};
struct EpiSwiglu {
    static constexpr bool PERM = true, AFTER_DRAIN = false;
    unsigned char* O; float iscale, ascale;
    __device__ __forceinline__ void operator()(const f32x4 (&acc)[2][2][4][2], const Unit& u, int wr, int wc, int fr, int fq) const {
        const int row0 = u.pm * BM + wr * 64 + fr, col0 = u.pn * 128 + wc * 16 + 4 * fq;
#pragma unroll
        for (int ai = 0; ai < 2; ++ai)
#pragma unroll
            for (int m = 0; m < 4; ++m) { unsigned char* rowp = O + (size_t)(row0 + ai * HALF + m * 16) * 1024 + col0;
#pragma unroll
                for (int bj = 0; bj < 2; ++bj) { const f32x4 g = acc[ai][bj][m][0] * iscale, up = acc[ai][bj][m][1] * (iscale * ascale); float r[4];
#pragma unroll
                    for (int j = 0; j < 4; ++j) { const float e = __builtin_amdgcn_exp2f(-1.4426950408889634f * g[j]); r[j] = g[j] * __builtin_amdgcn_rcpf(1.f + e) * up[j]; }
                    *(unsigned*)(rowp + bj * 64) = pk4_fp8(r[0], r[1], r[2], r[3]); } }
    }
};
struct EpiDown {
    static constexpr bool PERM = true, AFTER_DRAIN = false;
    bf16_t* Y; const int* rowtok; const float* roww; float oscale;
    __device__ __forceinline__ void operator()(const f32x4 (&acc)[2][2][4][2], const Unit& u, int wr, int wc, int fr, int fq) const {
        const int row0 = u.pm * BM + wr * 64 + fr, col0 = u.pn * BM + wc * 32 + 8 * fq;
#pragma unroll
        for (int ai = 0; ai < 2; ++ai)
#pragma unroll
            for (int m = 0; m < 4; ++m) { const int pos = row0 + ai * HALF + m * 16; const int tk = rowtok[pos]; const float w8 = roww[pos] * oscale;
                bf16_t* rowp = Y + (size_t)(tk < 0 ? 0 : tk) * 2048 + col0;
#pragma unroll
                for (int bj = 0; bj < 2; ++bj) { const f32x4 v0 = acc[ai][bj][m][0] * w8, v1 = acc[ai][bj][m][1] * w8;
                    u32x4 w; w.x = cvt_pk_bf16(v0[0], v0[1]); w.y = cvt_pk_bf16(v0[2], v0[3]); w.z = cvt_pk_bf16(v1[0], v1[1]); w.w = cvt_pk_bf16(v1[2], v1[3]);
                    if (tk >= 0) *(u32x4*)(rowp + bj * HALF) = w; }
                asm volatile("" ::: "memory"); }
    }
};

template <class Epi, class Sched, bool ALIGN_EPI = false, bool SP2 = false, bool FP8 = false>
__device__ __forceinline__ void gemm_phase(PG8_LAS unsigned char* lds, const int KB  , const Sched& S, const Epi& E, const int wave_s  ) {
    typedef int v4i_t __attribute__((ext_vector_type(4))); typedef int v8i_t __attribute__((ext_vector_type(8)));
    int lane; asm volatile("v_mbcnt_lo_u32_b32 %0, -1, 0\n\tv_mbcnt_hi_u32_b32 %0, -1, %0" : "=v"(lane)); const int wid = wave_s, tid = wid * 64 + lane, wr = wid >> 2, wc = wid & 3, fr = lane & 15, fq = lane >> 4;
    const int nt = KB / (BK * 2);
    unsigned voffA, voffB;
    { int R, C; stage_rc(tid * 16, R, C); const int Rb = Epi::PERM ? ((R & ~31) + perm32(R & 31)) : R; voffA = (unsigned)(R * KB + C * 2); voffB = (unsigned)(Rb * KB + C * 2); }
    const size_t pstep = (size_t)64 * KB;
    const size_t kstep = (size_t)(BK * 2);
    const size_t hstep = (size_t)HALF * KB;
    const unsigned ldsbw = (unsigned)__builtin_amdgcn_readfirstlane((int)((unsigned)(uintptr_t)lds + (unsigned)wid * 1024u));
    const int aoff = lds_byte(wr * 64 + fr, fq * 8), boff = lds_byte(wc * 32 + fr, fq * 8);
#define PG8_SA(b, h) (((b) * 2 + (h)) * HTB)
#define PG8_SB(b, h) ((4 + (b) * 2 + (h)) * HTB)
#define PG8_STAGE1(bufoff, gbase, voff, PI) do { unsigned keep_; \
        asm volatile("s_mov_b32 %0, m0\n\ts_add_i32 m0, %3, %4\n\ts_nop 0\n\tglobal_load_lds_dwordx4 %1, %2\n\ts_mov_b32 m0, %0" : "=&s"(keep_) : "v"(voff), "s"((const char*)(gbase) + (PI) * pstep), "s"(ldsbw), "i"((bufoff) + (PI) * 8192) : "memory", "scc"); } while (0)
#define PG8_STAGE(bufoff, gbase, voff) do { PG8_STAGE1(bufoff, gbase, voff, 0); PG8_STAGE1(bufoff, gbase, voff, 1); } while (0)
#define PG8_LDA(dst, b, h) do { _Pragma("unroll") for (int m = 0; m < 4; ++m) { dst[m].lo = *(const PG8_LAS v4i_t*)(lds + PG8_SA(b, h) + aoff + m * 2048); dst[m].hi = *(const PG8_LAS v4i_t*)(lds + PG8_SA(b, h) + aoff + m * 2048 + 1024); } } while (0)
#define PG8_LDB(dst, b, h) do { _Pragma("unroll") for (int n = 0; n < 2; ++n) { dst[n].lo = *(const PG8_LAS v4i_t*)(lds + PG8_SB(b, h) + boff + n * 2048); dst[n].hi = *(const PG8_LAS v4i_t*)(lds + PG8_SB(b, h) + boff + n * 2048 + 1024); } } while (0)
#define PG8_MMA(ai, bj, At, Bt) do { __builtin_amdgcn_s_setprio(1); _Pragma("unroll") for (int m = 0; m < 4; ++m) _Pragma("unroll") for (int n = 0; n < 2; ++n) { \
        if constexpr (FP8) { acc[ai][bj][m][n] = __builtin_amdgcn_mfma_scale_f32_16x16x128_f8f6f4(Bt[n], At[m], acc[ai][bj][m][n], 0, 0, 0, 0, 0, 0); } \
        else { const v4i_t bl_ = Bt[n].lo, bh_ = Bt[n].hi, al_ = At[m].lo, ah_ = At[m].hi;     \
               acc[ai][bj][m][n] = __builtin_amdgcn_mfma_f32_16x16x32_bf16(__builtin_bit_cast(bf16x8, bl_), __builtin_bit_cast(bf16x8, al_), acc[ai][bj][m][n], 0, 0, 0); \
               acc[ai][bj][m][n] = __builtin_amdgcn_mfma_f32_16x16x32_bf16(__builtin_bit_cast(bf16x8, bh_), __builtin_bit_cast(bf16x8, ah_), acc[ai][bj][m][n], 0, 0, 0); } } \
        __builtin_amdgcn_s_setprio(0); } while (0)
#define PG8_WAIT_V(n) asm volatile("s_waitcnt vmcnt(" #n ")" ::: "memory")
#define PG8_WAIT_L(n) asm volatile("s_waitcnt lgkmcnt(" #n ")" ::: "memory")
#define PG8_BAR __builtin_amdgcn_s_barrier()
#define PG8_SCHED __builtin_amdgcn_sched_barrier(0)
    Unit cur, nxt; int ui = 0;
    if (!S.next(0, cur)) return;
    f32x4 acc[2][2][4][2];
#pragma unroll
    for (int a = 0; a < 2; ++a)
#pragma unroll
        for (int b = 0; b < 2; ++b)
#pragma unroll
            for (int m = 0; m < 4; ++m)
#pragma unroll
                for (int n = 0; n < 2; ++n) acc[a][b][m][n] = (f32x4){0.f, 0.f, 0.f, 0.f};
    v8i_t At[4], B0[2], B1[2];
    const char* cA = S.a_ptr(cur); const char* cB = S.b_ptr(cur);
    S.a_ready(cur);
    if constexpr (SP2) {
        PG8_STAGE(PG8_SB(0, 0), cB, voffB); PG8_STAGE(PG8_SB(0, 1), cB + hstep, voffB); PG8_STAGE(PG8_SA(0, 0), cA, voffA); PG8_STAGE(PG8_SA(0, 1), cA + hstep, voffA);
        if (wr == 1) PG8_BAR;
        PG8_WAIT_V(2); PG8_BAR;
        PG8_STAGE(PG8_SB(1, 0), cB + kstep, voffB); PG8_STAGE(PG8_SA(1, 0), cA + kstep, voffA); PG8_STAGE(PG8_SB(1, 1), cB + hstep + kstep, voffB);
        PG8_WAIT_V(6); PG8_BAR;
    } else {
        PG8_STAGE(PG8_SB(0, 0), cB, voffB); PG8_STAGE(PG8_SA(0, 0), cA, voffA); PG8_STAGE(PG8_SB(0, 1), cB + hstep, voffB); PG8_STAGE(PG8_SA(0, 1), cA + hstep, voffA);
        if (wr == 1) PG8_BAR;
        PG8_WAIT_V(4); PG8_BAR;
        PG8_STAGE(PG8_SB(1, 0), cB + kstep, voffB); PG8_STAGE(PG8_SA(1, 0), cA + kstep, voffA); PG8_STAGE(PG8_SB(1, 1), cB + hstep + kstep, voffB);
        PG8_WAIT_V(6); PG8_BAR;
    }
    for (;;) {
        const bool has_next = S.next(ui + 1, nxt);
        const char* nA = has_next ? S.a_ptr(nxt) : cA; const char* nB = has_next ? S.b_ptr(nxt) : cB;
#pragma unroll 1
        for (int t = 0; t < nt; t += 2) {
            const bool last = (t == nt - 2);
            const char* a1 = cA + (size_t)(t + 1) * kstep;
            const char* a2 = last ? nA : cA + (size_t)(t + 2) * kstep; const char* b2 = last ? nB : cB + (size_t)(t + 2) * kstep;
            const char* a3 = a2 + kstep; const char* b3 = b2 + kstep;
            if (last && has_next) S.a_ready(nxt);
            if constexpr (SP2) {
            PG8_LDB(B0, 0, 0); PG8_LDB(B1, 0, 1); PG8_SCHED; PG8_LDA(At, 0, 0); PG8_STAGE(PG8_SA(1, 1), a1 + hstep, voffA);
            PG8_WAIT_V(8); PG8_WAIT_L(0); PG8_BAR; PG8_MMA(0, 0, At, B0); PG8_MMA(0, 1, At, B1); PG8_BAR; PG8_SCHED;
            PG8_LDA(At, 0, 1); PG8_STAGE(PG8_SB(0, 0), b2, voffB); PG8_STAGE(PG8_SB(0, 1), b2 + hstep, voffB); PG8_STAGE(PG8_SA(0, 0), a2, voffA);
            PG8_WAIT_V(8); PG8_WAIT_L(0); PG8_BAR; PG8_MMA(1, 0, At, B0); PG8_MMA(1, 1, At, B1); PG8_BAR; PG8_SCHED;
            PG8_LDB(B0, 1, 0); PG8_LDB(B1, 1, 1); PG8_SCHED; PG8_LDA(At, 1, 0); PG8_STAGE(PG8_SA(0, 1), a2 + hstep, voffA);
            PG8_WAIT_V(8); PG8_WAIT_L(0); PG8_BAR; PG8_MMA(0, 0, At, B0); PG8_MMA(0, 1, At, B1); PG8_BAR; PG8_SCHED;
            PG8_LDA(At, 1, 1); PG8_STAGE(PG8_SB(1, 0), b3, voffB); PG8_STAGE(PG8_SB(1, 1), b3 + hstep, voffB); PG8_STAGE(PG8_SA(1, 0), a3, voffA);
            PG8_WAIT_V(8); PG8_WAIT_L(0); PG8_BAR; PG8_MMA(1, 0, At, B0); PG8_MMA(1, 1, At, B1); PG8_BAR; PG8_SCHED;
            } else {
            PG8_LDB(B0, 0, 0); PG8_SCHED; PG8_LDA(At, 0, 0); PG8_STAGE(PG8_SA(1, 1), a1 + hstep, voffA);
            PG8_WAIT_L(8); PG8_BAR; PG8_WAIT_L(0); PG8_MMA(0, 0, At, B0); PG8_BAR; PG8_SCHED;
            PG8_LDB(B1, 0, 1); PG8_STAGE(PG8_SB(0, 0), b2, voffB);
            PG8_BAR; PG8_WAIT_L(0); PG8_MMA(0, 1, At, B1); PG8_BAR;
            PG8_LDA(At, 0, 1); PG8_STAGE(PG8_SA(0, 0), a2, voffA);
            PG8_BAR; PG8_WAIT_L(0); PG8_MMA(1, 0, At, B0); PG8_BAR; PG8_SCHED;
            PG8_STAGE(PG8_SB(0, 1), b2 + hstep, voffB);
            PG8_WAIT_V(6); PG8_BAR; PG8_MMA(1, 1, At, B1); PG8_BAR;
            PG8_LDB(B0, 1, 0); PG8_SCHED; PG8_LDA(At, 1, 0); PG8_STAGE(PG8_SA(0, 1), a2 + hstep, voffA);
            PG8_WAIT_L(8); PG8_BAR; PG8_WAIT_L(0); PG8_MMA(0, 0, At, B0); PG8_BAR; PG8_SCHED;
            PG8_LDB(B1, 1, 1); PG8_STAGE(PG8_SB(1, 0), b3, voffB);
            PG8_BAR; PG8_WAIT_L(0); PG8_MMA(0, 1, At, B1); PG8_BAR;
            PG8_LDA(At, 1, 1); PG8_STAGE(PG8_SA(1, 0), a3, voffA);
            PG8_BAR; PG8_WAIT_L(0); PG8_MMA(1, 0, At, B0); PG8_BAR; PG8_SCHED;
            PG8_STAGE(PG8_SB(1, 1), b3 + hstep, voffB);
            PG8_WAIT_V(6); PG8_BAR; PG8_MMA(1, 1, At, B1); PG8_BAR;
            }
        }
        if constexpr (ALIGN_EPI) { if (wr == 0) PG8_BAR; }
        if constexpr (!Epi::AFTER_DRAIN) { int ln_; asm volatile("v_mbcnt_lo_u32_b32 %0, -1, 0\n\tv_mbcnt_hi_u32_b32 %0, -1, %0" : "=v"(ln_));
            E(acc, cur, wr, wc, ln_ & 15, ln_ >> 4); S.done(cur); }
        if (!has_next) break;
#pragma unroll
        for (int a = 0; a < 2; ++a)
#pragma unroll
            for (int b = 0; b < 2; ++b)
#pragma unroll
                for (int m = 0; m < 4; ++m)
#pragma unroll
                    for (int n = 0; n < 2; ++n) acc[a][b][m][n] = (f32x4){0.f, 0.f, 0.f, 0.f};
        cur = nxt; cA = nA; cB = nB; ++ui;
        if constexpr (ALIGN_EPI) { if (wr == 1) PG8_BAR; }
    }
    PG8_WAIT_V(0);
    if constexpr (!ALIGN_EPI) { if (wr == 0) PG8_BAR; }
    PG8_BAR;
    if constexpr (Epi::AFTER_DRAIN) { E.fused(acc, cur, wr, wc, fr, fq, lds, wid, lane); S.done(cur); }
#undef PG8_SA
#undef PG8_SB
#undef PG8_STAGE
#undef PG8_LDA
#undef PG8_LDB
#undef PG8_MMA
#undef PG8_WAIT_V
#undef PG8_WAIT_L
#undef PG8_BAR
#undef PG8_SCHED
}
}

#include <hip/hip_bf16.h>
#include <cmath>
namespace attn_body {
using bf16=__hip_bfloat16;
using bf16x8=__attribute__((ext_vector_type(8)))short;
using s16x4=__attribute__((ext_vector_type(4)))short;
using f32x16=__attribute__((ext_vector_type(16)))float;
using u32x4=__attribute__((ext_vector_type(4)))unsigned;
constexpr int SEQ=16384,D=64,DM=6144;
constexpr int NW=8,QBLK=32,QB=QBLK*NW,KVBLK=64,NQB=SEQ/QB;
constexpr int ATTN_UNIT_ROWS=QB;
__device__ __forceinline__ int crow(int r,int hi){return (r&3)+8*(r>>2)+4*hi;}
#define SBAR() __builtin_amdgcn_sched_barrier(0)
__device__ __forceinline__ void cmask(f32x16&p0,f32x16&p1,int jb,int qrel,int hi){
  const float NEG=-INFINITY; int kb=64*jb+4*hi;
  #pragma unroll
  for(int r=0;r<16;++r){int kv=kb+(r&3)+8*(r>>2); if(kv>qrel)p0[r]=NEG; if(kv+32>qrel)p1[r]=NEG;}
}

constexpr int NSLOT=3, SLOTB=8192;
constexpr int LDS_K=0, LDS_V=NSLOT*SLOTB, LDS_WS=2*NSLOT*SLOTB, LDS_OST=LDS_WS+NW*64*4, LDS_BYTES=LDS_OST+NW*4096;
constexpr float C2=0.125f*1.4426950408889634f;
__device__ __forceinline__ void glds16(const void*gsrc,unsigned lds_dst){unsigned keep;
  asm volatile("s_mov_b32 %0, m0\n\ts_mov_b32 m0, %2\n\ts_nop 0\n\tglobal_load_lds_dwordx4 %1, off\n\ts_mov_b32 m0, %0":"=&s"(keep):"v"(gsrc),"s"(lds_dst):"memory");}
__device__ __forceinline__ void glds16s(const void*sbase,unsigned voff,unsigned lds_dst){unsigned keep;
  asm volatile("s_mov_b32 %0, m0\n\ts_mov_b32 m0, %3\n\ts_nop 0\n\tglobal_load_lds_dwordx4 %1, %2\n\ts_mov_b32 m0, %0":"=&s"(keep):"v"(voff),"s"(sbase),"s"(lds_dst):"memory");}
__device__ __forceinline__ float max3f(float a,float b,float c){float r;asm("v_max3_f32 %0, %1, %2, %3":"=v"(r):"v"(a),"v"(b),"v"(c));return r;}
__device__ __forceinline__ float max2f(float a,float b){float r;asm("v_max_f32_e32 %0, %1, %2":"=v"(r):"v"(a),"v"(b));return r;}
__device__ __forceinline__ float fadd_s(float a,float b){float r;asm("v_add_f32_e32 %0, %1, %2":"=v"(r):"v"(a),"v"(b));return r;}
__device__ __forceinline__ float fsub_s(float a,float b){float r;asm("v_sub_f32_e32 %0, %1, %2":"=v"(r):"v"(a),"v"(b));return r;}
typedef float f32x2_t __attribute__((ext_vector_type(2))); typedef __bf16 bf16x2_t __attribute__((ext_vector_type(2)));
__device__ __forceinline__ unsigned cvtpk_s(float lo,float hi){f32x2_t v={lo,hi};bf16x2_t b=__builtin_convertvector(v,bf16x2_t);return __builtin_bit_cast(unsigned,b);}
#define WAIT_BAR(N) asm volatile("s_waitcnt vmcnt(" #N ") lgkmcnt(0)\n\ts_barrier":::"memory")

__device__ __forceinline__ void rmask(f32x16&p0,f32x16&p1,bool keep){
  const float NEG=-INFINITY;
  #pragma unroll
  for(int r=0;r<16;++r){ p0[r]=keep?p0[r]:NEG; p1[r]=keep?p1[r]:NEG; }
}
__device__ __forceinline__ float abias(int d){
  const int t1=1+((128-d)>>31);
  const int t4=(((d&3)-1)>>31)&(1+((512-d)>>31));
  const int t16=(((d&15)-1)>>31)&(1+((2048-d)>>31));
  const int m=(t1+t4+t16)&~(d>>31);
  return __builtin_amdgcn_logf((float)m);
}
__device__ __forceinline__ void amask(f32x16&p0,f32x16&p1,int dbase){
  #pragma unroll
  for(int r=0;r<16;++r){ int d=dbase-((r&3)+8*(r>>2)); asm volatile("":"+v"(d)); p0[r]+=abias(d); int d2=d-32; asm volatile("":"+v"(d2)); p1[r]+=abias(d2); }
}
__device__ __forceinline__ void qkt(f32x16&p0,f32x16&p1,const char*Kslot,const bf16x8*qr,const f32x16&negm,int r32,int hi){
  const char*kb=Kslot+hi*1024+r32*16;
  #pragma unroll
  for(int d0=0;d0<4;++d0){
    const bf16x8 b0=*reinterpret_cast<const bf16x8*>(kb+d0*2048);
    const bf16x8 b1=*reinterpret_cast<const bf16x8*>(kb+d0*2048+512);
    if(d0==0){p0=__builtin_amdgcn_mfma_f32_32x32x16_bf16(b0,qr[0],negm,0,0,0);p1=__builtin_amdgcn_mfma_f32_32x32x16_bf16(b1,qr[0],negm,0,0,0);}
    else{p0=__builtin_amdgcn_mfma_f32_32x32x16_bf16(b0,qr[d0],p0,0,0,0);p1=__builtin_amdgcn_mfma_f32_32x32x16_bf16(b1,qr[d0],p1,0,0,0);}}
}
typedef __attribute__((address_space(3))) const char* lds_cptr;
typedef short v4i16_t __attribute__((ext_vector_type(4)));
__device__ __forceinline__ void kload8(bf16x8*kf,lds_cptr kp){
  kf[0]=*(const __attribute__((address_space(3))) bf16x8*)(kp);      kf[1]=*(const __attribute__((address_space(3))) bf16x8*)(kp+512);
  kf[2]=*(const __attribute__((address_space(3))) bf16x8*)(kp+2048); kf[3]=*(const __attribute__((address_space(3))) bf16x8*)(kp+2560);
  kf[4]=*(const __attribute__((address_space(3))) bf16x8*)(kp+4096); kf[5]=*(const __attribute__((address_space(3))) bf16x8*)(kp+4608);
  kf[6]=*(const __attribute__((address_space(3))) bf16x8*)(kp+6144); kf[7]=*(const __attribute__((address_space(3))) bf16x8*)(kp+6656);
}
__device__ __forceinline__ void kload2(bf16x8*kf,lds_cptr kp,int j){ kf[2*j]=*(const __attribute__((address_space(3))) bf16x8*)(kp+j*2048); kf[2*j+1]=*(const __attribute__((address_space(3))) bf16x8*)(kp+j*2048+512); }
__device__ __forceinline__ s16x4 vtr(lds_cptr p){ return __builtin_bit_cast(s16x4,__builtin_amdgcn_ds_read_tr16_b64_v4i16((__attribute__((address_space(3))) v4i16_t*)p)); }
__device__ __forceinline__ float rowmax(const f32x16&p0,const f32x16&p1){
  float a=max3f(p0[0],p0[1],p1[0]),b=max3f(p0[2],p0[3],p1[1]);a=max3f(a,p1[2],p1[3]);
  #pragma unroll
  for(int r=4;r<16;r+=4){a=max3f(a,p0[r],p0[r+1]);b=max3f(b,p0[r+2],p0[r+3]);a=max3f(a,p1[r],p1[r+1]);b=max3f(b,p1[r+2],p1[r+3]);}
  const float m=max2f(a,b);
  auto rr=__builtin_amdgcn_permlane32_swap(__float_as_uint(m),__float_as_uint(m),false,false);
  return max2f(__uint_as_float(rr[0]),__uint_as_float(rr[1]));
}
__device__ __forceinline__ void pv(f32x16*o,int vb,bf16x8 pa0,bf16x8 pa1,bf16x8 pa2,bf16x8 pa3){
  #pragma unroll
  for(int d0=0;d0<2;++d0){s16x4 lo[4],hi[4];
    #pragma unroll
    for(int ks=0;ks<4;++ks){
      asm volatile("ds_read_b64_tr_b16 %0,%1 offset:%c2":"=&v"(lo[ks]):"v"(vb),"i"(d0*4096+ks*1024):"memory");
      asm volatile("ds_read_b64_tr_b16 %0,%1 offset:%c2":"=&v"(hi[ks]):"v"(vb),"i"(d0*4096+ks*1024+512):"memory");}
    asm volatile("s_waitcnt lgkmcnt(0)":::"memory");SBAR();
    #define PK(k) (bf16x8){lo[k][0],lo[k][1],lo[k][2],lo[k][3],hi[k][0],hi[k][1],hi[k][2],hi[k][3]}
    o[d0]=__builtin_amdgcn_mfma_f32_32x32x16_bf16(pa0,PK(0),o[d0],0,0,0);
    o[d0]=__builtin_amdgcn_mfma_f32_32x32x16_bf16(pa1,PK(1),o[d0],0,0,0);
    o[d0]=__builtin_amdgcn_mfma_f32_32x32x16_bf16(pa2,PK(2),o[d0],0,0,0);
    o[d0]=__builtin_amdgcn_mfma_f32_32x32x16_bf16(pa3,PK(3),o[d0],0,0,0);
    #undef PK
  }
}

#ifndef ATTN_STORE16
#define ATTN_STORE16(p,v) (*(u32x4*)(p)=(v))
#endif
template<int THRL,int MODE> __device__ __forceinline__ void attn_unit(int qb,int T0,const bf16*Q,const bf16*__restrict__ K,const bf16*__restrict__ V,void*Ov,int opitch,const unsigned long long*sel,char*shm){
  int tid=threadIdx.x; asm volatile("":"+v"(tid)); const int lane=tid&63,r32=lane&31,hi=lane>>5; const int wid=__builtin_amdgcn_readfirstlane(tid>>6);
  const int q0=qb*QB;
  const bf16*Qw=Q+(long)(q0+wid*QBLK)*DM;
  const bf16*Kh=K+(long)T0*KVBLK*DM,*Vh=V+(long)T0*KVBLK*DM;
  const unsigned lds0=(unsigned)(uintptr_t)shm;
  float*wsf=(float*)(shm+LDS_WS)+wid*64;
  const bf16*ksrc=Kh+(long)lane*DM+wid*8;
  const bf16*vsrc=Vh+(long)(16*(wid&3)+(lane>>2))*DM+(wid>>2)*32+(lane&3)*8;
  const unsigned kdst=lds0+LDS_K+wid*1024, vdst=lds0+LDS_V+wid*1024;
  #define DMA_K(t,slot) glds16(ksrc+(long)(t)*KVBLK*DM,(unsigned)__builtin_amdgcn_readfirstlane(kdst+(slot)))
  #define DMA_V(t,slot) glds16(vsrc+(long)(t)*KVBLK*DM,(unsigned)__builtin_amdgcn_readfirstlane(vdst+(slot)))
  const int vb0=(int)(lds0+LDS_V)+((lane>>4)&1)*32+(lane&3)*8+(4*hi+((lane&15)>>2))*64;
  const char*Kbase=shm+LDS_K; bf16x8 kf[8];
  const lds_cptr shm3=(lds_cptr)shm; const lds_cptr kp0=shm3+LDS_K+hi*1024+r32*16; const lds_cptr vp0=shm3+LDS_V+((lane>>4)&1)*32+(lane&3)*8+(4*hi+((lane&15)>>2))*64;
  const int NT=(q0+QB)/KVBLK-T0;
  DMA_K(0,0);DMA_V(0,0);DMA_K(1,SLOTB);
  bf16x8 qr[4];
  #pragma unroll
  for(int d0=0;d0<4;++d0)qr[d0]=*reinterpret_cast<const bf16x8*>(&Qw[(long)r32*DM+d0*16+hi*8]);
  float mhat=0.f,l_reg=0.f;f32x16 o[2];o[0]=f32x16{};o[1]=f32x16{};f32x16 negm=f32x16{};asm volatile("":"+v"(negm));
  const int qrel=wid*QBLK+r32;
  unsigned sel_lo=0u,sel_hi=0u; if(MODE==1){ const unsigned long long sv=sel[qrel]; sel_lo=(unsigned)sv; sel_hi=(unsigned)(sv>>32); }
  const int dq=q0+qrel-4*hi-T0*KVBLK;
  #define RKEEP(t) ((((t)>>2)<32?(sel_lo>>((t)>>2)):(sel_hi>>(((t)>>2)-32)))&1u)
  #define CMASK(P0,P1,t) do{ if(MODE==2){amask(P0,P1,dq-64*(t));} else {int jb_=(t)-(NT-4); if(jb_>=0)cmask(P0,P1,jb_,qrel,hi); else if(MODE==1)rmask(P0,P1,RKEEP(t)!=0u);} }while(0)
  bool resc=false;
  #define START(P0,P1) do{ const float rm=rowmax(P0,P1); resc=false; \
    { const float dl=(MODE==0)?rm:((rm>-3.0e38f)?rm:0.f); mhat=fadd_s(mhat,dl); \
      _Pragma("unroll") for(int r=0;r<16;++r){P0[r]=fsub_s(P0[r],dl);P1[r]=fsub_s(P1[r],dl);} \
      _Pragma("unroll") for(int r=0;r<16;++r)negm[r]=-mhat; asm volatile("":"+v"(negm)); } \
    _Pragma("unroll") for(int r=0;r<16;++r)P0[r]=__builtin_amdgcn_exp2f(P0[r]); }while(0)
  #define RESC() do{ if(resc){ asm volatile("s_waitcnt lgkmcnt(0)":::"memory"); \
      _Pragma("unroll") for(int d_=0;d_<2;++d_) _Pragma("unroll") for(int r=0;r<16;++r)o[d_][r]*=wsf[crow(r,hi)]; } }while(0)
  f32x16 pA0,pA1,pB0,pB1;
  int sl_prev=0,sl_cur=0,sl_next=SLOTB;
  #define ROT() do{sl_prev=sl_cur;sl_cur=sl_next;sl_next=(sl_next==(NSLOT-1)*SLOTB)?0:sl_next+SLOTB;}while(0)
  DMA_K(2,2*SLOTB);
  WAIT_BAR(3);
  qkt(pA0,pA1,Kbase,qr,negm,r32,hi);asm volatile("s_nop 15\n\ts_nop 7":"+v"(pA0),"+v"(pA1));CMASK(pA0,pA1,0);
  START(pA0,pA1);
  _Pragma("unroll") for(int r=0;r<16;++r)pA1[r]=__builtin_amdgcn_exp2f(pA1[r]);
  WAIT_BAR(0);
  DMA_K(3,0);DMA_V(1,SLOTB);
  ROT();
  kload8(kf,kp0+sl_cur);
  WAIT_BAR(2);
  s16x4 vlo[8],vhi[8]; u32x4 pw0,pw1,pw2,pw3;
  #define PKW(P,B) cvtpk_s(P[B],P[B+1])
  #define PAF(k) __builtin_bit_cast(bf16x8,pw##k)
  #define VFR(i) (bf16x8){vlo[i][0],vlo[i][1],vlo[i][2],vlo[i][3],vhi[i][0],vhi[i][1],vhi[i][2],vhi[i][3]}
  #define PIN(x) asm volatile("":"+v"(x))
  #define MX3(a,b,c) __builtin_fmaxf(__builtin_fmaxf((a),(b)),(c))
  #define GAPA(MF,A0,A1,A2,A3,W0,W1,PW) do{ MF; sacc+=A0; sacc+=A1; sacc+=A2; sacc+=A3; PIN(sacc); W0; W1; PIN(PW); SBAR(); }while(0)
  #define EX(v) __builtin_amdgcn_exp2f(v)
  #define GAPB(MF,X,B) do{ MF; X[B]=EX(X[B]); X[B+1]=EX(X[B+1]); X[B+2]=EX(X[B+2]); X[B+3]=EX(X[B+3]); PIN(X); SBAR(); }while(0)
  #define VRD(i) do{ vlo[i]=vtr(vp_+(((i)>>2)*4096+((i)&3)*1024)); vhi[i]=vtr(vp_+(((i)>>2)*4096+((i)&3)*1024+512)); }while(0)
  #define KRD(G,j) do{ if(G){ kload2(kf,kp0+sl_next,j); SBAR(); } }while(0)
  #define STEP(C0,C1,P0,P1,t,GK,GV,GL) do{ SBAR(); \
    const lds_cptr vp_=vp0+sl_prev; \
    VRD(0); SBAR(); float sacc=(P0[0]+P0[1]); \
    GAPA(C0=__builtin_amdgcn_mfma_f32_32x32x16_bf16(kf[0],qr[0],negm,0,0,0), P0[2],P0[3],P0[4],P0[5],     pw0[0]=PKW(P0,0), pw0[1]=PKW(P0,2), pw0); \
    VRD(4); SBAR(); GAPA(C1=__builtin_amdgcn_mfma_f32_32x32x16_bf16(kf[1],qr[0],negm,0,0,0), P0[6],P0[7],P0[8],P0[9],     pw0[2]=PKW(P0,4), pw0[3]=PKW(P0,6), pw0); \
    VRD(1); SBAR(); GAPA(C0=__builtin_amdgcn_mfma_f32_32x32x16_bf16(kf[2],qr[1],C0,0,0,0),   P0[10],P0[11],P0[12],P0[13], pw1[0]=PKW(P0,8), pw1[1]=PKW(P0,10), pw1); \
    VRD(5); SBAR(); GAPA(C1=__builtin_amdgcn_mfma_f32_32x32x16_bf16(kf[3],qr[1],C1,0,0,0),   P0[14],P0[15],P1[0],P1[1],   pw1[2]=PKW(P0,12),pw1[3]=PKW(P0,14), pw1); \
    VRD(2); SBAR(); GAPA(C0=__builtin_amdgcn_mfma_f32_32x32x16_bf16(kf[4],qr[2],C0,0,0,0),   P1[2],P1[3],P1[4],P1[5],     pw2[0]=PKW(P1,0), pw2[1]=PKW(P1,2), pw2); \
    VRD(6); SBAR(); GAPA(C1=__builtin_amdgcn_mfma_f32_32x32x16_bf16(kf[5],qr[2],C1,0,0,0),   P1[6],P1[7],P1[8],P1[9],     pw2[2]=PKW(P1,4), pw2[3]=PKW(P1,6), pw2); \
    VRD(3); SBAR(); GAPA(C0=__builtin_amdgcn_mfma_f32_32x32x16_bf16(kf[6],qr[3],C0,0,0,0),   P1[10],P1[11],P1[12],P1[13], pw3[0]=PKW(P1,8), pw3[1]=PKW(P1,10), pw3); \
    VRD(7); SBAR(); GAPA(C1=__builtin_amdgcn_mfma_f32_32x32x16_bf16(kf[7],qr[3],C1,0,0,0),   P1[14],P1[15],0.f,0.f,       pw3[2]=PKW(P1,12),pw3[3]=PKW(P1,14), pw3); \
    l_reg+=sacc; \
    if(GK){DMA_K((t)+3,sl_cur);} if(GV){DMA_V((t)+1,sl_next);} \
    CMASK(C0,C1,t); \
    { float a=MX3(C0[0],C0[1],C1[0]),b=MX3(C0[2],C0[3],C1[1]); a=MX3(a,C1[2],C1[3]); \
      _Pragma("unroll") for(int r=4;r<16;r+=4){a=MX3(a,C0[r],C0[r+1]);b=MX3(b,C0[r+2],C0[r+3]);a=MX3(a,C1[r],C1[r+1]);b=MX3(b,C1[r+2],C1[r+3]);} \
      float rm=__builtin_fmaxf(a,b); { auto rr=__builtin_amdgcn_permlane32_swap(__float_as_uint(rm),__float_as_uint(rm),false,false); rm=__builtin_fmaxf(__uint_as_float(rr[0]),__uint_as_float(rr[1])); } \
      resc=false; \
      if(__builtin_expect(__any(rm>(float)THRL),0)){ const float dl=__builtin_fmaxf(rm,0.f); mhat+=dl; \
        _Pragma("unroll") for(int r=0;r<16;++r){C0[r]-=dl;C1[r]-=dl;} \
        _Pragma("unroll") for(int r=0;r<16;++r)negm[r]=-mhat; asm volatile("":"+v"(negm)); \
        const float f=__builtin_amdgcn_exp2f(-dl); l_reg*=f; if(hi==0)wsf[r32]=f; resc=true; } } \
    SBAR(); \
    GAPB(o[0]=__builtin_amdgcn_mfma_f32_32x32x16_bf16(PAF(0),VFR(0),o[0],0,0,0), C0,0); \
    GAPB(o[1]=__builtin_amdgcn_mfma_f32_32x32x16_bf16(PAF(0),VFR(4),o[1],0,0,0), C0,4); \
    KRD(GL,0); GAPB(o[0]=__builtin_amdgcn_mfma_f32_32x32x16_bf16(PAF(1),VFR(1),o[0],0,0,0), C0,8); \
    KRD(GL,1); GAPB(o[1]=__builtin_amdgcn_mfma_f32_32x32x16_bf16(PAF(1),VFR(5),o[1],0,0,0), C0,12); \
    KRD(GL,2); GAPB(o[0]=__builtin_amdgcn_mfma_f32_32x32x16_bf16(PAF(2),VFR(2),o[0],0,0,0), C1,0); \
    KRD(GL,3); GAPB(o[1]=__builtin_amdgcn_mfma_f32_32x32x16_bf16(PAF(2),VFR(6),o[1],0,0,0), C1,4); \
    GAPB(o[0]=__builtin_amdgcn_mfma_f32_32x32x16_bf16(PAF(3),VFR(3),o[0],0,0,0), C1,8); \
    GAPB(o[1]=__builtin_amdgcn_mfma_f32_32x32x16_bf16(PAF(3),VFR(7),o[1],0,0,0), C1,12); \
    }while(0)
  int t=1;
  #undef CMASK
  #define CMASK(P0,P1,t) do{ if(MODE==2){amask(P0,P1,dq-64*(t));} else if(MODE==1){rmask(P0,P1,RKEEP(t)!=0u);} }while(0)
  for(;t+5<NT;t+=2){
    STEP(pB0,pB1,pA0,pA1,t,true,true,true);     WAIT_BAR(2); RESC(); ROT();
    STEP(pA0,pA1,pB0,pB1,t+1,true,true,true);   WAIT_BAR(2); RESC(); ROT();
  }
  #undef CMASK
  #define CMASK(P0,P1,t) do{ if(MODE==2){amask(P0,P1,dq-64*(t));} else {int jb_=(t)-(NT-4); if(jb_>=0)cmask(P0,P1,jb_,qrel,hi); else if(MODE==1)rmask(P0,P1,RKEEP(t)!=0u);} }while(0)
  #define ENDW(tt) do{ if((tt)+3<NT){WAIT_BAR(2);} else if((tt)+2<NT){WAIT_BAR(1);} else {WAIT_BAR(0);} }while(0)
  for(;t+1<NT;t+=2){
    STEP(pB0,pB1,pA0,pA1,t,(t+3<NT),(t+1<NT),(t+1<NT));       ENDW(t);   RESC(); ROT();
    STEP(pA0,pA1,pB0,pB1,t+1,(t+4<NT),(t+2<NT),(t+2<NT));     ENDW(t+1); RESC(); ROT();
  }
  STEP(pB0,pB1,pA0,pA1,NT-1,false,false,false); RESC();
  { float sacc=pB0[0]+pB0[1]; _Pragma("unroll") for(int r=2;r<16;++r)sacc+=pB0[r]; _Pragma("unroll") for(int r=0;r<16;++r)sacc+=pB1[r]; l_reg+=sacc;
    pw0=(u32x4){PKW(pB0,0),PKW(pB0,2),PKW(pB0,4),PKW(pB0,6)};pw1=(u32x4){PKW(pB0,8),PKW(pB0,10),PKW(pB0,12),PKW(pB0,14)};pw2=(u32x4){PKW(pB1,0),PKW(pB1,2),PKW(pB1,4),PKW(pB1,6)};pw3=(u32x4){PKW(pB1,8),PKW(pB1,10),PKW(pB1,12),PKW(pB1,14)};
    SBAR(); pv(o,vb0+sl_cur,PAF(0),PAF(1),PAF(2),PAF(3)); }
  #undef PKW
  #undef PAF
  #undef VFR
  #undef PIN
  #undef MX3
  #undef GAPA
  #undef GAPB
  #undef EX
  #undef VRD
  #undef KRD
  #undef STEP
  #undef ENDW
  {auto rr=__builtin_amdgcn_permlane32_swap(__float_as_uint(l_reg),__float_as_uint(l_reg),false,false);l_reg=__uint_as_float(rr[0])+__uint_as_float(rr[1]);}
  if(hi==0)wsf[32+r32]=l_reg;asm volatile("s_waitcnt lgkmcnt(0)":::"memory");
  float rli[16];
  #pragma unroll
  for(int r=0;r<16;++r)rli[r]=__builtin_amdgcn_rcpf(wsf[32+crow(r,hi)]);
  if(MODE==0){ float*Of=(float*)Ov+(long)(q0+wid*QBLK)*opitch;
    #pragma unroll
    for(int r=0;r<16;++r){const int orow=crow(r,hi);
      #pragma unroll
      for(int d0=0;d0<2;++d0)Of[(long)orow*opitch+d0*32+r32]=o[d0][r]*rli[r];} }
  else { bf16*Ow=(bf16*)Ov+(long)(q0+wid*QBLK)*opitch; bf16*stg=(bf16*)(shm+LDS_OST)+wid*2048;
    #pragma unroll
    for(int r=0;r<16;++r){const int orow=crow(r,hi);
      #pragma unroll
      for(int d0=0;d0<2;++d0)stg[orow*64+d0*32+r32]=__float2bfloat16(o[d0][r]*rli[r]);}
    asm volatile("s_waitcnt lgkmcnt(0)":::"memory");
    #pragma unroll
    for(int i=0;i<4;++i){const int row=i*8+(lane>>3),ch=lane&7; const u32x4 v=*(const u32x4*)(stg+row*64+ch*8); ATTN_STORE16(Ow+(long)row*opitch+ch*8,v);} }
  asm volatile("s_waitcnt lgkmcnt(0)\n\ts_barrier":::"memory");
  #undef DMA_K
  #undef DMA_V
  #undef CMASK
  #undef RKEEP
  #undef START
  #undef RESC
  #undef ROT
}
constexpr int ATTN_LDS_BYTES=LDS_BYTES;


constexpr int X_K=0, X_V=3*SLOTB, X_WS=X_V+6*SLOTB, X_LDS_BYTES=X_WS+NW*256;
__device__ __forceinline__ void pv4(f32x16*o,int vb,bf16x8 pa0,bf16x8 pa1,bf16x8 pa2,bf16x8 pa3){
  #pragma unroll
  for(int d0=0;d0<4;++d0){s16x4 lo[4],hi[4];
    #pragma unroll
    for(int ks=0;ks<4;++ks){
      asm volatile("ds_read_b64_tr_b16 %0,%1 offset:%c2":"=&v"(lo[ks]):"v"(vb),"i"(d0*4096+ks*1024):"memory");
      asm volatile("ds_read_b64_tr_b16 %0,%1 offset:%c2":"=&v"(hi[ks]):"v"(vb),"i"(d0*4096+ks*1024+512):"memory");}
    asm volatile("s_waitcnt lgkmcnt(0)":::"memory");SBAR();
    #define PK(k) (bf16x8){lo[k][0],lo[k][1],lo[k][2],lo[k][3],hi[k][0],hi[k][1],hi[k][2],hi[k][3]}
    o[d0]=__builtin_amdgcn_mfma_f32_32x32x16_bf16(pa0,PK(0),o[d0],0,0,0);
    o[d0]=__builtin_amdgcn_mfma_f32_32x32x16_bf16(pa1,PK(1),o[d0],0,0,0);
    o[d0]=__builtin_amdgcn_mfma_f32_32x32x16_bf16(pa2,PK(2),o[d0],0,0,0);
    o[d0]=__builtin_amdgcn_mfma_f32_32x32x16_bf16(pa3,PK(3),o[d0],0,0,0);
    #undef PK
  }
}
template<int THRL> __device__ __forceinline__ void attn_unit128(int qb,const bf16*Q,const bf16*__restrict__ K,const bf16*__restrict__ V,float*O,int opitch,char*shm,const int wid){
  int lane; asm volatile("v_mbcnt_lo_u32_b32 %0, -1, 0\n\tv_mbcnt_hi_u32_b32 %0, -1, %0":"=v"(lane)); const int r32=lane&31,hi=lane>>5;
  const int q0=qb*QB;
  const bf16*Qw=Q+(long)(q0+wid*QBLK)*DM;
  const unsigned lds0=(unsigned)(uintptr_t)shm;
  float*wsf=(float*)(shm+X_WS)+wid*64;
  const unsigned koff=(unsigned)(lane*DM+wid*8)*2u;
  const unsigned voff=(unsigned)((16*(wid&3)+(lane>>2))*DM+(wid>>2)*32+(lane&3)*8)*2u;
  const unsigned kdst=lds0+X_K+wid*1024, vdst=lds0+X_V+wid*1024;
  #define DMA_K(t,slot) glds16s(K+(long)(t)*KVBLK*DM,koff,(unsigned)__builtin_amdgcn_readfirstlane(kdst+(slot)))
  #define DMA_V(t,slot) do{ glds16s(V+(long)(t)*KVBLK*DM,voff,(unsigned)__builtin_amdgcn_readfirstlane(vdst+2*(slot))); glds16s(V+(long)(t)*KVBLK*DM+64,voff,(unsigned)__builtin_amdgcn_readfirstlane(vdst+2*(slot)+8192)); }while(0)
  const int vb0=(int)(lds0+X_V)+((lane>>4)&1)*32+(lane&3)*8+(4*hi+((lane&15)>>2))*64;
  const char*Kbase=shm+X_K; bf16x8 kf[8];
  const lds_cptr shm3=(lds_cptr)shm; const lds_cptr kp0=shm3+X_K+hi*1024+r32*16; const lds_cptr vp0=shm3+X_V+((lane>>4)&1)*32+(lane&3)*8+(4*hi+((lane&15)>>2))*64;
  const int NT=(q0+QB)/KVBLK;
  DMA_K(0,0);DMA_V(0,0);DMA_K(1,SLOTB);
  bf16x8 qr[4];
  #pragma unroll
  for(int d0=0;d0<4;++d0)qr[d0]=*reinterpret_cast<const bf16x8*>(&Qw[(long)r32*DM+d0*16+hi*8]);
  float mhat=0.f,l_reg=0.f;f32x16 o[4];o[0]=f32x16{};o[1]=f32x16{};o[2]=f32x16{};o[3]=f32x16{};
  float zz_=0.f; asm volatile("":"+v"(zz_)); f32x16 negm;
  _Pragma("unroll") for(int r=0;r<16;++r)negm[r]=zz_; asm volatile("":"+v"(negm));
  const int qrel=wid*QBLK+r32;
  #define CMASK(P0,P1,t) do{int jb_=(t)-(NT-4); if(jb_>=0)cmask(P0,P1,jb_,qrel,hi);}while(0)
  bool resc=false;
  #define RESC() do{ if(resc){ asm volatile("s_waitcnt lgkmcnt(0)":::"memory"); \
      _Pragma("unroll") for(int d_=0;d_<4;++d_) _Pragma("unroll") for(int r=0;r<16;++r)o[d_][r]*=wsf[crow(r,hi)]; } }while(0)
  f32x16 C0,C1; u32x4 pw0,pw1,pw2,pw3;
  int sl_prev=0,sl_cur=0,sl_next=SLOTB;
  #define ROT() do{sl_prev=sl_cur;sl_cur=sl_next;sl_next=(sl_next==(NSLOT-1)*SLOTB)?0:sl_next+SLOTB;}while(0)
  #define PKW(P,B) cvtpk_s(P[B],P[B+1])
  DMA_K(2,2*SLOTB);
  WAIT_BAR(4);
  qkt(C0,C1,Kbase,qr,negm,r32,hi);asm volatile("s_nop 15\n\ts_nop 7":"+v"(C0),"+v"(C1));CMASK(C0,C1,0);
  { const float rm=rowmax(C0,C1); const float dl=rm; mhat=fadd_s(mhat,dl);
    _Pragma("unroll") for(int r=0;r<16;++r){C0[r]=fsub_s(C0[r],dl);C1[r]=fsub_s(C1[r],dl);}
    _Pragma("unroll") for(int r=0;r<16;++r)negm[r]=-mhat; asm volatile("":"+v"(negm));
    _Pragma("unroll") for(int r=0;r<16;++r){C0[r]=__builtin_amdgcn_exp2f(C0[r]);C1[r]=__builtin_amdgcn_exp2f(C1[r]);}
    float sacc=C0[0]+C0[1]; _Pragma("unroll") for(int r=2;r<16;++r)sacc+=C0[r]; _Pragma("unroll") for(int r=0;r<16;++r)sacc+=C1[r]; l_reg+=sacc;
    pw0=(u32x4){PKW(C0,0),PKW(C0,2),PKW(C0,4),PKW(C0,6)};pw1=(u32x4){PKW(C0,8),PKW(C0,10),PKW(C0,12),PKW(C0,14)};pw2=(u32x4){PKW(C1,0),PKW(C1,2),PKW(C1,4),PKW(C1,6)};pw3=(u32x4){PKW(C1,8),PKW(C1,10),PKW(C1,12),PKW(C1,14)}; }
  WAIT_BAR(0);
  DMA_K(3,0);DMA_V(1,SLOTB);
  ROT();
  kload8(kf,kp0+sl_cur);
  WAIT_BAR(3);
  s16x4 vlo[8],vhi[8];
  #define PAF(k) __builtin_bit_cast(bf16x8,pw##k)
  #define VFR(i) (bf16x8){vlo[i][0],vlo[i][1],vlo[i][2],vlo[i][3],vhi[i][0],vhi[i][1],vhi[i][2],vhi[i][3]}
  #define PIN(x) asm volatile("":"+v"(x))
  #define MX3(a,b,c) __builtin_fmaxf(__builtin_fmaxf((a),(b)),(c))
  #define EX(v) __builtin_amdgcn_exp2f(v)
  #define VRDF(s,d,ks) do{ vlo[s]=vtr(vp_+((d)*4096+(ks)*1024)); vhi[s]=vtr(vp_+((d)*4096+(ks)*1024+512)); }while(0)
  #define GA(s,MF) do{ VRDF(s,(s)&3,(s)>>2); SBAR(); MF; SBAR(); }while(0)
  #define EX2(X,B) do{ X[B]=EX(X[B]); X[B+1]=EX(X[B+1]); PIN(X); }while(0)
  #define PK1(W,j,X,B) do{ sacc+=X[B]; sacc+=X[B+1]; W[j]=PKW(X,B); PIN(W); PIN(sacc); }while(0)
  #define KRD(G,j) do{ if(G){ kload2(kf,kp0+sl_next,j); } }while(0)
  #define STEP(t,GK,GV,GL) do{ SBAR(); \
    const lds_cptr vp_=vp0+2*sl_prev; \
    GA(0,C0=__builtin_amdgcn_mfma_f32_32x32x16_bf16(kf[0],qr[0],negm,0,0,0)); \
    GA(1,C1=__builtin_amdgcn_mfma_f32_32x32x16_bf16(kf[1],qr[0],negm,0,0,0)); \
    GA(2,C0=__builtin_amdgcn_mfma_f32_32x32x16_bf16(kf[2],qr[1],C0,0,0,0)); \
    GA(3,C1=__builtin_amdgcn_mfma_f32_32x32x16_bf16(kf[3],qr[1],C1,0,0,0)); \
    GA(4,C0=__builtin_amdgcn_mfma_f32_32x32x16_bf16(kf[4],qr[2],C0,0,0,0)); \
    GA(5,C1=__builtin_amdgcn_mfma_f32_32x32x16_bf16(kf[5],qr[2],C1,0,0,0)); \
    GA(6,C0=__builtin_amdgcn_mfma_f32_32x32x16_bf16(kf[6],qr[3],C0,0,0,0)); \
    GA(7,C1=__builtin_amdgcn_mfma_f32_32x32x16_bf16(kf[7],qr[3],C1,0,0,0)); \
    if(GK){DMA_K((t)+3,sl_cur);} if(GV){DMA_V((t)+1,sl_next);} \
    CMASK(C0,C1,t); \
    { float a=MX3(C0[0],C0[1],C1[0]),b=MX3(C0[2],C0[3],C1[1]); a=MX3(a,C1[2],C1[3]); \
      _Pragma("unroll") for(int r=4;r<16;r+=4){a=MX3(a,C0[r],C0[r+1]);b=MX3(b,C0[r+2],C0[r+3]);a=MX3(a,C1[r],C1[r+1]);b=MX3(b,C1[r+2],C1[r+3]);} \
      float rm=__builtin_fmaxf(a,b); { auto rr=__builtin_amdgcn_permlane32_swap(__float_as_uint(rm),__float_as_uint(rm),false,false); rm=__builtin_fmaxf(__uint_as_float(rr[0]),__uint_as_float(rr[1])); } \
      resc=false; \
      if(__builtin_expect(__any(rm>(float)THRL),0)){ const float dl=__builtin_fmaxf(rm,0.f); mhat+=dl; \
        _Pragma("unroll") for(int r=0;r<16;++r){C0[r]-=dl;C1[r]-=dl;} \
        _Pragma("unroll") for(int r=0;r<16;++r)negm[r]=-mhat; asm volatile("":"+v"(negm)); \
        const float f=__builtin_amdgcn_exp2f(-dl); l_reg*=f; if(hi==0)wsf[r32]=f; resc=true; } } \
    SBAR(); \
    float sacc=0.f; u32x4 nw0=(u32x4){0u,0u,0u,0u},nw1=nw0,nw2=nw0,nw3=nw0; \
    o[0]=__builtin_amdgcn_mfma_f32_32x32x16_bf16(PAF(0),VFR(0),o[0],0,0,0); VRDF(0,0,2); EX2(C0,0); SBAR(); \
    o[1]=__builtin_amdgcn_mfma_f32_32x32x16_bf16(PAF(0),VFR(1),o[1],0,0,0); VRDF(1,1,2); EX2(C0,2); SBAR(); \
    o[2]=__builtin_amdgcn_mfma_f32_32x32x16_bf16(PAF(0),VFR(2),o[2],0,0,0); VRDF(2,2,2); EX2(C0,4); SBAR(); \
    o[3]=__builtin_amdgcn_mfma_f32_32x32x16_bf16(PAF(0),VFR(3),o[3],0,0,0); VRDF(3,3,2); EX2(C0,6); SBAR(); \
    o[0]=__builtin_amdgcn_mfma_f32_32x32x16_bf16(PAF(1),VFR(4),o[0],0,0,0); VRDF(4,0,3); EX2(C0,8);  PK1(nw0,0,C0,0); SBAR(); \
    o[1]=__builtin_amdgcn_mfma_f32_32x32x16_bf16(PAF(1),VFR(5),o[1],0,0,0); VRDF(5,1,3); EX2(C0,10); PK1(nw0,1,C0,2); SBAR(); \
    o[2]=__builtin_amdgcn_mfma_f32_32x32x16_bf16(PAF(1),VFR(6),o[2],0,0,0); VRDF(6,2,3); EX2(C0,12); PK1(nw0,2,C0,4); SBAR(); \
    o[3]=__builtin_amdgcn_mfma_f32_32x32x16_bf16(PAF(1),VFR(7),o[3],0,0,0); VRDF(7,3,3); EX2(C0,14); PK1(nw0,3,C0,6); SBAR(); \
    o[0]=__builtin_amdgcn_mfma_f32_32x32x16_bf16(PAF(2),VFR(0),o[0],0,0,0); KRD(GL,0); EX2(C1,0);  PK1(nw1,0,C0,8);  SBAR(); \
    o[1]=__builtin_amdgcn_mfma_f32_32x32x16_bf16(PAF(2),VFR(1),o[1],0,0,0); KRD(GL,1); EX2(C1,2);  PK1(nw1,1,C0,10); SBAR(); \
    o[2]=__builtin_amdgcn_mfma_f32_32x32x16_bf16(PAF(2),VFR(2),o[2],0,0,0); KRD(GL,2); EX2(C1,4);  PK1(nw1,2,C0,12); SBAR(); \
    o[3]=__builtin_amdgcn_mfma_f32_32x32x16_bf16(PAF(2),VFR(3),o[3],0,0,0); KRD(GL,3); EX2(C1,6);  PK1(nw1,3,C0,14); SBAR(); \
    o[0]=__builtin_amdgcn_mfma_f32_32x32x16_bf16(PAF(3),VFR(4),o[0],0,0,0); EX2(C1,8);  PK1(nw2,0,C1,0); SBAR(); \
    o[1]=__builtin_amdgcn_mfma_f32_32x32x16_bf16(PAF(3),VFR(5),o[1],0,0,0); EX2(C1,10); PK1(nw2,1,C1,2); SBAR(); \
    o[2]=__builtin_amdgcn_mfma_f32_32x32x16_bf16(PAF(3),VFR(6),o[2],0,0,0); EX2(C1,12); PK1(nw2,2,C1,4); PK1(nw3,0,C1,8); SBAR(); \
    o[3]=__builtin_amdgcn_mfma_f32_32x32x16_bf16(PAF(3),VFR(7),o[3],0,0,0); EX2(C1,14); PK1(nw2,3,C1,6); PK1(nw3,1,C1,10); SBAR(); \
    PK1(nw3,2,C1,12); PK1(nw3,3,C1,14); l_reg+=sacc; pw0=nw0; pw1=nw1; pw2=nw2; pw3=nw3; \
    }while(0)
  #define ENDW(tt) do{ if((tt)+3<NT){WAIT_BAR(3);} else if((tt)+2<NT){WAIT_BAR(2);} else {WAIT_BAR(0);} }while(0)
  int t=1;
  #undef CMASK
  #define CMASK(P0,P1,t) do{}while(0)
  for(;t<NT-4;++t){ STEP(t,true,true,true); WAIT_BAR(3); RESC(); ROT(); }
  #undef CMASK
  #define CMASK(P0,P1,t) do{int jb_=(t)-(NT-4); if(jb_>=0)cmask(P0,P1,jb_,qrel,hi);}while(0)
  for(;t<NT-1;++t){ STEP(t,(t+3<NT),(t+1<NT),(t+1<NT)); ENDW(t); RESC(); ROT(); }
  STEP(NT-1,false,false,false); RESC();
  SBAR(); pv4(o,vb0+2*sl_cur,PAF(0),PAF(1),PAF(2),PAF(3));
  #undef PKW
  #undef PAF
  #undef VFR
  #undef PIN
  #undef MX3
  #undef EX
  #undef VRDF
  #undef GA
  #undef EX2
  #undef PK1
  #undef KRD
  #undef STEP
  #undef ENDW
  {auto rr=__builtin_amdgcn_permlane32_swap(__float_as_uint(l_reg),__float_as_uint(l_reg),false,false);l_reg=__uint_as_float(rr[0])+__uint_as_float(rr[1]);}
  if(hi==0)wsf[32+r32]=l_reg;asm volatile("s_waitcnt lgkmcnt(0)":::"memory");
  { float*Of=O+(long)(q0+wid*QBLK)*opitch;
    #pragma unroll
    for(int r=0;r<16;++r){const int orow=crow(r,hi); const float rl=__builtin_amdgcn_rcpf(wsf[32+orow]);
      #pragma unroll
      for(int d0=0;d0<4;++d0)Of[(long)orow*opitch+d0*32+r32]=o[d0][r]*rl;} }
  asm volatile("s_waitcnt lgkmcnt(0)\n\ts_barrier":::"memory");
  #undef DMA_K
  #undef DMA_V
  #undef CMASK
  #undef RESC
  #undef ROT
}

constexpr int BRA_MAXKT=6, BRA_K=0, BRA_V=BRA_MAXKT*8192, BRA_WS=2*BRA_MAXKT*8192, BRA_LDS_BYTES=BRA_WS+NW*512;
struct BraUnit {
  const bf16* Q; const bf16* K; const bf16* V;
  bf16* PO; float* PL;
  int kbase, kstride, t_first, nkt;
  int nqt;
  int qbase, qstride, slotA;
  const int* list; int nlist, tile0, ownrow0;
};
#define BMX3(a,b,c) __builtin_fmaxf(__builtin_fmaxf((a),(b)),(c))
template<int MODE> __device__ __forceinline__ void bra_unit(const BraUnit&u,char*shm,const int wid){
  int lane; asm volatile("v_mbcnt_lo_u32_b32 %0, -1, 0\n\tv_mbcnt_hi_u32_b32 %0, -1, %0":"=v"(lane)); const int r32=lane&31,hi=lane>>5;
  const unsigned lds0=(unsigned)(uintptr_t)shm;
  for(int T=u.t_first;T<u.nkt;++T){
    const long krow=u.kbase+(long)u.kstride*(64*T+lane), vrow=u.kbase+(long)u.kstride*(64*T+16*(wid&3)+(lane>>2));
    glds16(u.K+krow*DM+wid*8,(unsigned)__builtin_amdgcn_readfirstlane(lds0+BRA_K+T*8192+wid*1024));
    glds16(u.V+vrow*DM+(wid>>2)*32+(lane&3)*8,(unsigned)__builtin_amdgcn_readfirstlane(lds0+BRA_V+T*8192+wid*1024)); }
  asm volatile("s_waitcnt vmcnt(0)\n\ts_barrier":::"memory");
  float*wsf=(float*)(shm+BRA_WS)+wid*128; int*wsi=(int*)wsf+64;
  const int vbl=(int)(lds0+BRA_V)+((lane>>4)&1)*32+(lane&3)*8+(4*hi+((lane&15)>>2))*64;
  for(int qt=wid;qt<u.nqt;qt+=NW){
    int qrow,ql,Tlo,Thi,slot; bool valid=true,masked=true; unsigned dmax;
    if(MODE==0){ ql=32*qt+r32; qrow=u.qbase+u.qstride*ql; Tlo=(qt>>1)>u.t_first?(qt>>1):u.t_first; Thi=(qt>>1)+2; slot=u.slotA; dmax=128u; }
    else { const int g=u.tile0+qt;
      if(g<8){ ql=32*g+r32; qrow=u.ownrow0+ql; Tlo=0; Thi=g>>1; slot=3; dmax=0x7fffffffu; }
      else { const int e=(g-8)*32+r32; valid=e<u.nlist; const int ent=valid?u.list[e]:0; qrow=ent&0xffff; slot=ent>>16; ql=0; Tlo=0; Thi=3; masked=false; dmax=0x7fffffffu; } }
    bf16x8 qr[4];
    #pragma unroll
    for(int d0=0;d0<4;++d0)qr[d0]=*reinterpret_cast<const bf16x8*>(&u.Q[(long)qrow*DM+d0*16+hi*8]);
    float mhat=0.f,l_reg=0.f; f32x16 o[2]; o[0]=f32x16{}; o[1]=f32x16{}; float zz_=0.f; asm volatile("":"+v"(zz_)); f32x16 negm;
    _Pragma("unroll") for(int r=0;r<16;++r)negm[r]=zz_;
    for(int T=Tlo;T<=Thi;++T){
      f32x16 p0,p1; qkt(p0,p1,shm+BRA_K+T*8192,qr,negm,r32,hi);
      if(masked){ const int db=ql-64*T-4*hi+((MODE==0)?128:0);
        #pragma unroll
        for(int r=0;r<16;++r){ const int d=db-((r&3)+8*(r>>2)); if((unsigned)d>dmax)p0[r]=-INFINITY; if((unsigned)(d-32)>dmax)p1[r]=-INFINITY; } }
      float a=BMX3(p0[0],p0[1],p1[0]),b=BMX3(p0[2],p0[3],p1[1]); a=BMX3(a,p1[2],p1[3]);
      #pragma unroll
      for(int r=4;r<16;r+=4){a=BMX3(a,p0[r],p0[r+1]);b=BMX3(b,p0[r+2],p0[r+3]);a=BMX3(a,p1[r],p1[r+1]);b=BMX3(b,p1[r+2],p1[r+3]);}
      float rm=__builtin_fmaxf(a,b); { auto rr=__builtin_amdgcn_permlane32_swap(__float_as_uint(rm),__float_as_uint(rm),false,false); rm=__builtin_fmaxf(__uint_as_float(rr[0]),__uint_as_float(rr[1])); }
      if(__any(rm>8.f)){ const float dl=(rm>8.f)?rm:0.f; mhat+=dl;
        #pragma unroll
        for(int r=0;r<16;++r){p0[r]-=dl;p1[r]-=dl;}
        #pragma unroll
        for(int r=0;r<16;++r)negm[r]=-mhat;
        const float f=__builtin_amdgcn_exp2f(-dl); l_reg*=f; if(hi==0)wsf[r32]=f;
        asm volatile("s_waitcnt lgkmcnt(0)":::"memory");
        #pragma unroll
        for(int d_=0;d_<2;++d_)
          #pragma unroll
          for(int r=0;r<16;++r)o[d_][r]*=wsf[crow(r,hi)];
        asm volatile("s_waitcnt lgkmcnt(0)":::"memory"); }
      float sacc=0.f;
      #pragma unroll
      for(int r=0;r<16;++r){p0[r]=__builtin_amdgcn_exp2f(p0[r]);p1[r]=__builtin_amdgcn_exp2f(p1[r]);sacc+=p0[r]+p1[r];}
      l_reg+=sacc;
      u32x4 pw0,pw1,pw2,pw3;
      pw0=(u32x4){cvtpk_s(p0[0],p0[1]),cvtpk_s(p0[2],p0[3]),cvtpk_s(p0[4],p0[5]),cvtpk_s(p0[6],p0[7])}; pw1=(u32x4){cvtpk_s(p0[8],p0[9]),cvtpk_s(p0[10],p0[11]),cvtpk_s(p0[12],p0[13]),cvtpk_s(p0[14],p0[15])};
      pw2=(u32x4){cvtpk_s(p1[0],p1[1]),cvtpk_s(p1[2],p1[3]),cvtpk_s(p1[4],p1[5]),cvtpk_s(p1[6],p1[7])}; pw3=(u32x4){cvtpk_s(p1[8],p1[9]),cvtpk_s(p1[10],p1[11]),cvtpk_s(p1[12],p1[13]),cvtpk_s(p1[14],p1[15])};
      SBAR(); pv(o,vbl+T*8192,__builtin_bit_cast(bf16x8,pw0),__builtin_bit_cast(bf16x8,pw1),__builtin_bit_cast(bf16x8,pw2),__builtin_bit_cast(bf16x8,pw3));
    }
    {auto rr=__builtin_amdgcn_permlane32_swap(__float_as_uint(l_reg),__float_as_uint(l_reg),false,false);l_reg=__uint_as_float(rr[0])+__uint_as_float(rr[1]);}
    if(hi==0){ wsf[r32]=l_reg; wsi[r32]=valid?(slot*SEQ+qrow):-1; }
    asm volatile("s_waitcnt lgkmcnt(0)":::"memory");
    if(hi==0&&valid) u.PL[(long)(slot*SEQ+qrow)*8]=mhat+__builtin_amdgcn_logf(l_reg);
    #pragma unroll
    for(int r=0;r<16;++r){ const int orow=crow(r,hi); const float rl=__builtin_amdgcn_rcpf(wsf[orow]); const int dst=wsi[orow];
      if(dst>=0){ bf16*op=u.PO+(long)dst*512+r32; op[0]=__float2bfloat16(o[0][r]*rl); op[32]=__float2bfloat16(o[1][r]*rl); } }
    asm volatile("s_waitcnt lgkmcnt(0)":::"memory");
  }
  asm volatile("s_waitcnt vmcnt(0) lgkmcnt(0)\n\ts_barrier":::"memory");
}
#undef BMX3
#undef SBAR
#undef WAIT_BAR
}


constexpr int NWAVES = 8;
#ifndef MK_N_LAUNCHES
#define MK_N_LAUNCHES 1
#endif
constexpr int N_PHASES = 24;
static_assert(MK_N_LAUNCHES == 1 || MK_N_LAUNCHES == N_PHASES, "MK_N_LAUNCHES is 1 or 24");

constexpr int S_ = 16384, DM_ = 2048, INW = 6144, NEXP = 16, DEXP = 1024, DEPTH = 2, NROWBLK = 256  ;
constexpr int C_QA = 0, C_KA = 512, C_VA = 1024, C_QB = 1536, C_KB = 2048, C_VB = 2560, C_QC = 3072, C_KC = 4096, C_VC = 5120;
constexpr int MAXPOS = 2 * S_ + NEXP * 256;
constexpr float RMS_EPS = 1e-6f;
#ifndef PROJ_FP8
#define PROJ_FP8 0
#endif
#ifndef OUT_FP8
#define OUT_FP8 0
#endif
constexpr float WSC_K2048 = 64.f, WSC_K1024 = 32.f, MSCALE = 4.f  , ASCALE = 2.f  ;

constexpr size_t MiB = 1u << 20;
constexpr size_t WS_CTL = 0, CTL_ZERO_BYTES = 1 * MiB;
constexpr size_t WS_MOD = 1 * MiB;
constexpr size_t WS_COS = 2 * MiB, WS_SIN = 4 * MiB;
constexpr size_t WS_EID = 6 * MiB;
constexpr size_t WS_WTS = WS_EID + 131072;
constexpr size_t WS_ROWTOK = WS_WTS + 131072;
constexpr size_t WS_ROWW = WS_ROWTOK + 163840;
constexpr size_t WS_CNT = WS_ROWW + 163840;
constexpr size_t WS_KMEAN = 8 * MiB;
constexpr size_t WS_WIN = 16 * MiB;
constexpr size_t WS_WOUT = 64 * MiB;
constexpr size_t WS_WGU = 80 * MiB;
constexpr size_t WS_WDN = 336 * MiB;
constexpr size_t WS_H = 464 * MiB;
constexpr size_t WS_PROJ = 528 * MiB;
constexpr size_t WS_MERGED = 720 * MiB;
constexpr size_t WS_T = 784 * MiB;
constexpr size_t WS_ACT = 912 * MiB;
constexpr size_t WS_XS = 984 * MiB;
constexpr size_t WS_POA = WS_ACT;
constexpr size_t WS_POB = WS_POA + 48 * MiB;
constexpr size_t WS_PLA = WS_POB + 64 * MiB;
constexpr size_t WS_PLB = WS_PLA + 2 * MiB;
constexpr size_t WS_LIST = WS_PLB + 2 * MiB;
static_assert(WS_LIST + 32 * MiB <= 1128 * MiB, "partials and lists inside the MoE-only regions");
constexpr size_t WS_Y = WS_PROJ;
constexpr size_t WS_END = 1128 * MiB;
static_assert(WS_XS + (size_t)MAXPOS * 2048 * 2 <= WS_END && WS_ACT + (size_t)MAXPOS * 1024 * 2 <= WS_XS && WS_CNT + 16384 <= WS_KMEAN, "d_ws map");
constexpr int CW_TMO = 0, CW_CODE = 1, CW_BAR = 4096;
constexpr int CW_CNTB = 8192;
constexpr int CW_QUEUE = 8192 + 1024;

constexpr int RING_OFF = 0, RING_BYTES = 131072;
constexpr int LDSCTL_OFF = RING_BYTES, MISC_OFF = LDSCTL_OFF + 320;
constexpr int LT_SEGS = LDSCTL_OFF + 1024;
constexpr int LT_TOT = LT_SEGS + 128;
constexpr int LT_BASE = LT_TOT + 64;
constexpr int LT_CNT = LT_BASE + 64;
constexpr int LT_P2E = LT_CNT + 64;
constexpr int LT_POS = LT_P2E + 160;
constexpr int LDS_BYTES = 147456;
constexpr int ATT_KM_OFF = 0;
constexpr int ATT_UST_OFF = 106496, ATT_QN_OFF = ATT_UST_OFF + 2304;
static_assert(LT_POS + 512 <= LDS_BYTES && attn_body::ATTN_LDS_BYTES <= ATT_UST_OFF && attn_body::X_LDS_BYTES <= ATT_UST_OFF && attn_body::BRA_LDS_BYTES <= ATT_UST_OFF && ATT_QN_OFF + 64 <= RING_BYTES, "LDS map");

#define GAS __attribute__((address_space(1)))
#define LAS __attribute__((address_space(3)))
typedef unsigned short bf16;
typedef unsigned v4u __attribute__((ext_vector_type(4)));
typedef unsigned v2u __attribute__((ext_vector_type(2)));
typedef float f32x4 __attribute__((ext_vector_type(4)));
typedef short bf16x8 __attribute__((ext_vector_type(8)));
typedef GAS unsigned gu32;
#define RLX_AGENT __ATOMIC_RELAXED, __HIP_MEMORY_SCOPE_AGENT
#define LDS_WAIT() asm volatile("s_waitcnt lgkmcnt(0)" ::: "memory")
__device__ __forceinline__ unsigned f2bf(float f) { unsigned u = __builtin_bit_cast(unsigned, f); return (u + 0x7fffu + ((u >> 16) & 1u)) >> 16; }
__device__ __forceinline__ unsigned pk2(float lo, float hi) { return f2bf(lo) | (f2bf(hi) << 16); }
__device__ __forceinline__ float bflo(unsigned w) { return __builtin_bit_cast(float, w << 16); }
__device__ __forceinline__ float bfhi(unsigned w) { return __builtin_bit_cast(float, w & 0xffff0000u); }
__device__ __forceinline__ float shx(float v, int o, int lane) { return __builtin_bit_cast(float, __builtin_amdgcn_ds_bpermute((lane ^ o) << 2, __builtin_bit_cast(int, v))); }
__device__ __forceinline__ int shup_i(int v, int o, int lane) { return __builtin_amdgcn_ds_bpermute(((lane - o) & 63) << 2, v); }
__device__ __forceinline__ float wave_sum(float v, int lane) {
#pragma unroll
    for (int o = 1; o < 64; o <<= 1) v += shx(v, o, lane);
    return v;
}

#define XB_TMO      128
#define XB_XCNT(j)  (256  + 64 * (j))
#define XB_XSUB(j)  (1280 + 64 * (j))
#define XB_XGEN(j)  (2304 + 64 * (j))
#define XB_TOP      3328
#define XB_TOPGEN   3392
#define XCD_BAR_WORDS 3456
#define XB_SPIN_CAP (1u << 18)

__device__ __forceinline__ unsigned xb_ld(unsigned* p)              { return __hip_atomic_load(p, __ATOMIC_RELAXED, __HIP_MEMORY_SCOPE_AGENT); }
__device__ __forceinline__ unsigned xb_add(unsigned* p, unsigned v) { return __hip_atomic_fetch_add(p, v, __ATOMIC_RELAXED, __HIP_MEMORY_SCOPE_AGENT); }
__device__ __forceinline__ unsigned xb_xcc_id() { return (unsigned)__builtin_amdgcn_s_getreg((3 << 11) | 20) & 0xFu; }
#define XB_SPIN(cond, bar) do { unsigned _sp = 0; while (cond) { __builtin_amdgcn_s_sleep(1); \
    if ((++_sp & 255u) == 0u) { if (xb_ld(&(bar)[XB_TMO])) break; if (_sp > XB_SPIN_CAP) { atomicAdd(&(bar)[XB_TMO], 1u); break; } } } } while (0)

struct XcdBarrier {
    unsigned* bar; unsigned x;
    volatile LAS unsigned* st;
};

__device__ __forceinline__ XcdBarrier xcd_barrier_post(unsigned* bar, volatile LAS unsigned* st) {
    XcdBarrier b; b.bar = bar; b.x = xb_xcc_id(); b.st = st;
    if (threadIdx.x == 0) (void)xb_add(&bar[XB_XCNT(b.x)], 1u);
    return b;
}
__device__ __forceinline__ void xcd_barrier_complete(unsigned* bar, unsigned x, unsigned& nloc, unsigned& nx) {
    const unsigned G = gridDim.x * gridDim.y * gridDim.z;
    unsigned sum, cnt, mine, sp = 0u;
    for (;;) {
        sum = 0u; cnt = 0u; mine = 0u;
#pragma unroll
        for (unsigned j = 0; j < 16; ++j) { const unsigned c = xb_ld(&bar[XB_XCNT(j)]); sum += c; cnt += (c > 0u) ? 1u : 0u; mine = (j == x) ? c : mine; }
        if (sum == G) break;
        __builtin_amdgcn_s_sleep(1);
        if ((++sp & 255u) == 0u) { if (xb_ld(&bar[XB_TMO])) break; if (sp > XB_SPIN_CAP) { atomicAdd(&bar[XB_TMO], 1u); break; } }
    }
    nloc = mine > 0u ? mine : 1u; nx = cnt > 0u ? cnt : 1u;
}

__device__ __forceinline__ void xcd_barrier(const XcdBarrier& b) {
    asm volatile("s_waitcnt vmcnt(0)" ::: "memory");
    __syncthreads();
    if (threadIdx.x == 0) {
        unsigned* bar = b.bar; asm volatile("" : "+s"(bar)); unsigned bx_ = b.x; asm volatile("" : "+s"(bx_));
        __builtin_amdgcn_s_waitcnt(0);
        unsigned nloc = b.st[0], nx = b.st[1];
        if (nloc == 0u) { xcd_barrier_complete(bar, bx_, nloc, nx); b.st[0] = nloc; b.st[1] = nx; }
        const unsigned old = xb_add(&bar[XB_XSUB(bx_)], 1u);
        const unsigned gen = old / nloc;
        if (old + 1u == (gen + 1u) * nloc) {
            __builtin_amdgcn_fence(__ATOMIC_RELEASE, "agent");
            asm volatile("s_waitcnt vmcnt(0)" ::: "memory");
            const unsigned og = xb_add(&bar[XB_TOP], 1u);
            const unsigned tg = og / nx;
            if (og + 1u == (tg + 1u) * nx) xb_add(&bar[XB_TOPGEN], 1u);
            else XB_SPIN(xb_ld(&bar[XB_TOPGEN]) == tg, bar);
            __builtin_amdgcn_fence(__ATOMIC_ACQUIRE, "agent");
            xb_add(&bar[XB_XGEN(bx_)], 1u);
            asm volatile("s_waitcnt vmcnt(0)" ::: "memory");
        } else {
            XB_SPIN(xb_ld(&bar[XB_XGEN(bx_)]) == gen, bar);
            __builtin_amdgcn_fence(__ATOMIC_ACQUIRE, "agent");
            asm volatile("s_waitcnt vmcnt(0)" ::: "memory");
        }
    }
    __syncthreads();
}


__device__ __forceinline__ int dest_row(int map, int n) {
    if (map == 1) { const int seg = n >> 9; const bool qk = (seg == 0) || (seg == 1) || (seg == 3) || (seg == 4) || (seg >= 6 && seg <= 9); if (!qk) return n; const int j = n & 63; return (n & ~63) + ((j < 32) ? 2 * j : 2 * (j - 32) + 1); }
    if (map == 2) return 8 * (n >> 2) + (n & 3);
    if (map == 3) return 8 * (n >> 2) + 4 + (n & 3);
    return n;
}
__device__ __forceinline__ void p0_transpose_item(const float* W, int K, int N, unsigned char* WT, int map, float wscale, LAS float* scr, int item, int lane) {
    const int nblk = N / 32, kb = item / nblk, nb = item % nblk, k0 = 64 * kb, n0 = 32 * nb;
#pragma unroll 8
    for (int i = 0; i < 32; ++i) { const int kk = 2 * i + (lane >> 5); scr[kk * 33 + (lane & 31)] = W[(size_t)(k0 + kk) * N + n0 + (lane & 31)] * wscale; }
    LDS_WAIT(); asm volatile("" ::: "memory");
    const int c = lane & 3;
#pragma unroll
    for (int j = 0; j < 2; ++j) { const int n = (lane >> 2) + 16 * j; const LAS float* sp = scr + (16 * c) * 33 + n;
        v4u o; o.x = pg8::pk4_fp8(sp[0 * 33], sp[1 * 33], sp[2 * 33], sp[3 * 33]); o.y = pg8::pk4_fp8(sp[4 * 33], sp[5 * 33], sp[6 * 33], sp[7 * 33]);
        o.z = pg8::pk4_fp8(sp[8 * 33], sp[9 * 33], sp[10 * 33], sp[11 * 33]); o.w = pg8::pk4_fp8(sp[12 * 33], sp[13 * 33], sp[14 * 33], sp[15 * 33]);
        *(GAS v4u*)(WT + (size_t)dest_row(map, n0 + n) * K + k0 + 16 * c) = o; }
    LDS_WAIT(); asm volatile("" ::: "memory");
}

__device__ __forceinline__ void p0_transpose_item16(const float* W, int K, int N, bf16* WT, int map, LAS float* scr, int item, int lane) {
    const int nblk = N / 32, kb = item / nblk, nb = item % nblk, k0 = 64 * kb, n0 = 32 * nb;
#pragma unroll 8
    for (int i = 0; i < 32; ++i) { const int kk = 2 * i + (lane >> 5); scr[kk * 33 + (lane & 31)] = W[(size_t)(k0 + kk) * N + n0 + (lane & 31)]; }
    LDS_WAIT(); asm volatile("" ::: "memory");
    const int c = lane & 7;
#pragma unroll
    for (int j = 0; j < 4; ++j) { const int n = (lane >> 3) + 8 * j; const LAS float* sp = scr + (8 * c) * 33 + n;
        v4u o; o.x = pk2(sp[0 * 33], sp[1 * 33]); o.y = pk2(sp[2 * 33], sp[3 * 33]); o.z = pk2(sp[4 * 33], sp[5 * 33]); o.w = pk2(sp[6 * 33], sp[7 * 33]);
        *(GAS v4u*)(WT + (size_t)dest_row(map, n0 + n) * K + k0 + 8 * c) = o; }
    LDS_WAIT(); asm volatile("" ::: "memory");
}

struct Args { const void* in[20]; float* out; unsigned char* ws; int ph_lo, ph_hi; };

__global__ void __launch_bounds__(NWAVES * 64, 2) fwd(Args args) {
    extern __shared__ __attribute__((aligned(16))) unsigned char lds[];
    LAS unsigned char* const L = (LAS unsigned char*)lds;
    const int kG = gridDim.x, kbx = blockIdx.x;
    const int kwave = __builtin_amdgcn_readfirstlane((int)threadIdx.x >> 6);
    typedef __attribute__((address_space(4))) const Args* kargp_t;
#define PHASE_BEGIN() \
    kargp_t ka = (kargp_t)__builtin_amdgcn_kernarg_segment_ptr(); asm volatile("" : "+s"(ka)); \
    unsigned char* const ws = ka->ws; \
    int lane; asm volatile("v_mbcnt_lo_u32_b32 %0, -1, 0\n\tv_mbcnt_hi_u32_b32 %0, -1, %0" : "=v"(lane)); \
    int G = kG, bx = kbx, wave_s = kwave; asm volatile("" : "+s"(G), "+s"(bx), "+s"(wave_s));     \
    const int vcu = (G % 8 == 0) ? (bx % 8) * (G / 8) + bx / 8 : bx; const int NGW = G * NWAVES; \
    const int wave = wave_s; const int tid = wave * 64 + lane; const int gw = vcu * NWAVES + wave; (void)gw; (void)lane; (void)ws; (void)tid; (void)NGW
#define KIN(T, k) ((const T*)ka->in[k])
    LAS int* const segs = (LAS int*)(L + LT_SEGS); LAS int* const tot = (LAS int*)(L + LT_TOT); LAS int* const basee = (LAS int*)(L + LT_BASE); LAS int* const cnt16 = (LAS int*)(L + LT_CNT);
    LAS unsigned char* const p2e = L + LT_P2E; LAS int* const postab = (LAS int*)(L + LT_POS);
    gu32* const ctl = (gu32*)(args.ws + WS_CTL);

    for (int u = threadIdx.x; u < (LDS_BYTES - LDSCTL_OFF) / 4; u += NWAVES * 64) ((LAS unsigned*)(L + LDSCTL_OFF))[u] = 0u;
    __syncthreads();
    const int lo = args.ph_lo, hi = args.ph_hi;
    XcdBarrier bar; bar.bar = (unsigned*)(ctl + CW_BAR); bar.x = 0; bar.st = nullptr;
    if (hi - lo > 1) bar = xcd_barrier_post((unsigned*)(ctl + CW_BAR), (volatile LAS unsigned*)(L + MISC_OFF) + 8);
#ifndef PHMASK
#define PHMASK 0x1fff
#endif
#define IN(k) (lo <= (k) && (k) < hi)
#define INJ(j) ((((PHMASK) >> (j)) & 1) && IN(pb + (j)))
#ifndef REPEAT_J
#define REPEAT_J (-1)
#endif
#ifndef REPEAT_L
#define REPEAT_L 0
#endif
#ifndef REPEAT_N
#define REPEAT_N 2
#endif
#define REPS(j) ((REPEAT_J == (j) && l == REPEAT_L) ? REPEAT_N : 1)
#define SEAM(k) do { if (IN(k) && IN((k) + 1)) xcd_barrier(bar); } while (0)

#define COMPUTE_SEGMENTS(myrb) do { \
        _Pragma("unroll") for (int q_ = 0; q_ < 2; ++q_) { const int e_ = 2 * wave + q_; int t_ = 0, p_ = 0; \
            _Pragma("unroll") for (int j_ = 0; j_ < 4; ++j_) { const int rb_ = lane + 64 * j_; const int c_ = CNT[rb_ * 16 + e_]; t_ += c_; p_ += (rb_ < (myrb)) ? c_ : 0; } \
            t_ = (int)wave_sum((float)t_, lane); p_ = (int)wave_sum((float)p_, lane); if (lane == 0) { tot[e_] = t_; basee[e_] = p_; } } \
        __syncthreads(); \
        if (tid == 0) { int s_ = 0; for (int e_ = 0; e_ < 16; ++e_) { segs[e_] = s_; s_ += (tot[e_] + 255) & ~255; } segs[16] = s_; } \
        __syncthreads(); \
        if (tid < 160) { const int r_ = tid * 256; int e_ = 0; for (int k_ = 1; k_ < 16; ++k_) if (r_ >= segs[k_]) e_ = k_; p2e[tid] = (unsigned char)e_; } \
        if (tid < 16) basee[tid] += segs[tid]; \
        __syncthreads(); } while (0)

    if (((PHMASK >> 11) & 1) && IN(0)) for (int rp = 0; rp < ((REPEAT_J == 11) ? REPEAT_N : 1); ++rp) {
        PHASE_BEGIN();
        const float* const c_in = KIN(float, 1); const int* const positions = KIN(int, 2); const float* const w_ada = KIN(float, 3); const float* const b_ada = KIN(float, 4);
        const float* const w_in = KIN(float, 7); const float* const w_out = KIN(float, 8); const float* const w_gate = KIN(float, 14); const float* const w_up = KIN(float, 15); const float* const w_down = KIN(float, 16);
        float* const MOD = (float*)(ws + WS_MOD); float* const COS = (float*)(ws + WS_COS); float* const SIN = (float*)(ws + WS_SIN);
        unsigned char* const WIN = ws + WS_WIN; unsigned char* const WOUT = ws + WS_WOUT; unsigned char* const WGU = ws + WS_WGU; unsigned char* const WDN = ws + WS_WDN;
        for (int it = bx; it < 96; it += G) {
            const int l = it / 48, cg = it % 48, col = cg * 256 + lane * 4;
            const float* W = w_ada + ((size_t)l * 2048 + wave * 256) * 12288 + col; const float* cc = c_in + wave * 256;
            f32x4 a = (f32x4){0.f, 0.f, 0.f, 0.f};
#pragma unroll 8
            for (int k = 0; k < 256; ++k) { const float cv = cc[k]; const float sv = cv / (1.f + expf(-cv)); a += sv * *(const GAS f32x4*)(W + (size_t)k * 12288); }
            LAS f32x4* red = (LAS f32x4*)L; red[wave * 64 + lane] = a;
            __syncthreads();
            if (tid < 256) { float s = 0.f; const LAS float* rf = (const LAS float*)L;
#pragma unroll
                for (int w = 0; w < 8; ++w) s += rf[(w * 64 + (tid >> 2)) * 4 + (tid & 3)];
                MOD[l * 12288 + cg * 256 + tid] = s + b_ada[l * 12288 + cg * 256 + tid]; }
            __syncthreads();
        }
        { LAS float* scr = (LAS float*)(L + RING_OFF + wave * 16384);
          constexpr int I_IN = 2 * 32 * 192, I_OUT = 2 * 32 * 64, I_G = 32 * 32 * 32, I_D = 32 * 16 * 64, NITEMS = I_IN + I_OUT + 2 * I_G + I_D;
          for (int it = gw; it < NITEMS; it += NGW) {
              int r = it;
              if (r < I_IN) { const int l = r / 6144;
                  if (PROJ_FP8) p0_transpose_item(w_in + (size_t)l * 2048 * 6144, 2048, 6144, WIN + (size_t)l * 6144 * 2048, 1, WSC_K2048, scr, r % 6144, lane);
                  else p0_transpose_item16(w_in + (size_t)l * 2048 * 6144, 2048, 6144, (bf16*)WIN + (size_t)l * 6144 * 2048, 1, scr, r % 6144, lane);
                  continue; } r -= I_IN;
              if (r < I_OUT) { const int l = r / 2048;
                  if (OUT_FP8) p0_transpose_item(w_out + (size_t)l * 2048 * 2048, 2048, 2048, WOUT + (size_t)l * 2048 * 2048, 0, WSC_K2048, scr, r % 2048, lane);
                  else p0_transpose_item16(w_out + (size_t)l * 2048 * 2048, 2048, 2048, (bf16*)WOUT + (size_t)l * 2048 * 2048, 0, scr, r % 2048, lane);
                  continue; } r -= I_OUT;
              if (r < I_G) { const int mt = r / 1024; p0_transpose_item(w_gate + (size_t)mt * 2048 * 1024, 2048, 1024, WGU + (size_t)mt * 2048 * 2048, 2, WSC_K2048, scr, r % 1024, lane); continue; } r -= I_G;
              if (r < I_G) { const int mt = r / 1024; p0_transpose_item(w_up + (size_t)mt * 2048 * 1024, 2048, 1024, WGU + (size_t)mt * 2048 * 2048, 3, WSC_K2048, scr, r % 1024, lane); continue; } r -= I_G;
              { const int mt = r / 1024; p0_transpose_item(w_down + (size_t)mt * 1024 * 2048, 1024, 2048, WDN + (size_t)mt * 2048 * 1024, 0, WSC_K1024, scr, r % 1024, lane); }
          } }
        for (int idx = (vcu * NWAVES * 64 + tid); idx < S_ * 32; idx += G * NWAVES * 64) {
            const int pi = idx >> 5, i = idx & 31; const float inv = (float)exp2(-(double)i * (13.287712379549449 / 32.0)); const float ang = (float)positions[pi] * inv;
            COS[idx] = (float)cos((double)ang); SIN[idx] = (float)sin((double)ang); }
    }
    SEAM(0);

    for (int l = 0; l < DEPTH; ++l) {
        const int pb = 1 + 11 * l;
        const float lam_init = (l == 0) ? 0.2f : 0.35550906759f;
        if (INJ(0)) for (int rp = 0; rp < REPS(0); ++rp) {
            PHASE_BEGIN();
            const float* const x_in = KIN(float, 0); const float* const g_attn = KIN(float, 5); float* const xbuf = ka->out;
            const float* const MOD = (const float*)(ws + WS_MOD); const float* const mod = MOD + l * 12288; unsigned char* const HB = ws + WS_H; const bf16* const YB = (const bf16*)(ws + WS_Y);
            f32x4 cA[8], cB[8], cG[8];
#pragma unroll
            for (int j = 0; j < 8; ++j) { const int c4 = lane + 64 * j; const f32x4 g = ((const f32x4*)(g_attn + l * 2048))[c4]; const f32x4 sc = ((const f32x4*)(mod + 2048))[c4];
                cA[j] = g * (1.f + sc); cB[j] = ((const f32x4*)(mod + 0))[c4]; cG[j] = (l > 0) ? ((const f32x4*)(MOD + (l - 1) * 12288 + 10240))[c4] : (f32x4){0.f, 0.f, 0.f, 0.f}; }
            const float* xsrc = (l == 0) ? x_in : xbuf;
            for (int row = gw; row < S_; row += NGW) {
                f32x4 v[8];
#pragma unroll
                for (int j = 0; j < 8; ++j) v[j] = ((const GAS f32x4*)(xsrc + (size_t)row * 2048))[lane + 64 * j];
                if (l > 0) {
#pragma unroll
                    for (int j = 0; j < 8; ++j) { const v2u a = ((const GAS v2u*)(YB + (size_t)(2 * row) * 2048))[lane + 64 * j], b = ((const GAS v2u*)(YB + (size_t)(2 * row + 1) * 2048))[lane + 64 * j];
                        const f32x4 ys = (f32x4){bflo(a.x) + bflo(b.x), bfhi(a.x) + bfhi(b.x), bflo(a.y) + bflo(b.y), bfhi(a.y) + bfhi(b.y)};
                        v[j] += cG[j] * ys; ((GAS f32x4*)(xbuf + (size_t)row * 2048))[lane + 64 * j] = v[j]; }
                }
                float ss = 0.f;
#pragma unroll
                for (int j = 0; j < 8; ++j) ss += (v[j].x * v[j].x + v[j].y * v[j].y) + (v[j].z * v[j].z + v[j].w * v[j].w);
                const float rs = 1.f / sqrtf(wave_sum(ss, lane) * (1.f / 2048.f) + RMS_EPS);
#pragma unroll
                for (int j = 0; j < 8; ++j) { const f32x4 o = v[j] * rs * cA[j] + cB[j];
                    if (PROJ_FP8) ((GAS unsigned*)(HB + (size_t)row * 2048))[lane + 64 * j] = pg8::pk4_fp8(o.x, o.y, o.z, o.w);
                    else { v2u w; w.x = pk2(o.x, o.y); w.y = pk2(o.z, o.w); ((GAS v2u*)((bf16*)HB + (size_t)row * 2048))[lane + 64 * j] = w; } }
            }
        }
        SEAM(pb + 0);
        if (INJ(1)) for (int rp = 0; rp < REPS(1); ++rp) {
            PHASE_BEGIN();
            unsigned char* const HB = ws + WS_H; unsigned char* const WIN = ws + WS_WIN; bf16* const PROJ = (bf16*)(ws + WS_PROJ); const float* const COS = (const float*)(ws + WS_COS); const float* const SIN = (const float*)(ws + WS_SIN);
            constexpr int KBP = PROJ_FP8 ? 2048 : 4096;
            pg8::DenseSched Sd; Sd.init(HB, WIN + (size_t)l * 6144 * KBP, S_, INW, KBP, G, bx);
            pg8::EpiProj E{PROJ, COS, SIN, attn_body::C2, PROJ_FP8 ? 1.f / WSC_K2048 : 1.f};
            pg8::gemm_phase<pg8::EpiProj, pg8::DenseSched, true, true, PROJ_FP8 != 0>(L + RING_OFF, KBP, Sd, E, wave_s);
        }
        SEAM(pb + 1);
        if (INJ(2)) for (int rp = 0; rp < REPS(2); ++rp) {
            PHASE_BEGIN();
            const bf16* const PROJ = (const bf16*)(ws + WS_PROJ); float* const KMEAN = (float*)(ws + WS_KMEAN);
            for (int t = gw; t < 512; t += NGW) { const int h = t >> 6, j = t & 63; const int rg = lane >> 3, ch = lane & 7;
                float a[8];
#pragma unroll
                for (int e = 0; e < 8; ++e) a[e] = 0.f;
                for (int it = 0; it < 32; ++it) { const v4u w = *(const GAS v4u*)(PROJ + (size_t)(256 * j + 8 * it + rg) * 6144 + C_KB + 64 * h + 8 * ch);
                    a[0] += bflo(w.x); a[1] += bfhi(w.x); a[2] += bflo(w.y); a[3] += bfhi(w.y); a[4] += bflo(w.z); a[5] += bfhi(w.z); a[6] += bflo(w.w); a[7] += bfhi(w.w); }
#pragma unroll
                for (int e = 0; e < 8; ++e) { a[e] += shx(a[e], 8, lane); a[e] += shx(a[e], 16, lane); a[e] += shx(a[e], 32, lane); }
                if (lane < 8) {
#pragma unroll
                    for (int e = 0; e < 8; ++e) KMEAN[(size_t)(h * 64 + j) * 64 + 8 * lane + e] = a[e] * (1.f / 256.f); }
            }
        }
        SEAM(pb + 2);
        if (INJ(3)) for (int rp = 0; rp < REPS(3); ++rp) {
            PHASE_BEGIN();
            const bf16* const PROJ = (const bf16*)(ws + WS_PROJ); const float* const KMEAN = (const float*)(ws + WS_KMEAN); int* const LISTB = (int*)(ws + WS_LIST);
            int* const CNTB = (int*)(ctl + CW_CNTB + l * 512);
            for (int it = vcu; it < 512; it += G) { const int hd = it & 7, qq = it >> 3, qb = (qq & 1) ? 63 - (qq >> 1) : (qq >> 1);
                if (qb == 0) continue;
                LAS float* km = (LAS float*)(L + ATT_KM_OFF);
                __syncthreads();
                for (int k4 = tid; k4 < qb * 16; k4 += NWAVES * 64) ((LAS f32x4*)km)[k4] = ((const GAS f32x4*)(KMEAN + (size_t)hd * 64 * 64))[k4];
                const int q = tid >> 1, dh = tid & 1; float qf[32];
                { const bf16* qrow = PROJ + (size_t)(qb * 256 + q) * 6144 + C_QB + hd * 64 + dh * 32;
#pragma unroll
                  for (int c8 = 0; c8 < 4; ++c8) { const v4u w = *(const GAS v4u*)(qrow + 8 * c8); qf[8 * c8 + 0] = bflo(w.x); qf[8 * c8 + 1] = bfhi(w.x); qf[8 * c8 + 2] = bflo(w.y); qf[8 * c8 + 3] = bfhi(w.y);
                      qf[8 * c8 + 4] = bflo(w.z); qf[8 * c8 + 5] = bfhi(w.z); qf[8 * c8 + 6] = bflo(w.w); qf[8 * c8 + 7] = bfhi(w.w); } }
                __syncthreads();
                float b0 = -INFINITY, b1 = -INFINITY, b2 = -INFINITY; int i0 = -1, i1 = -1, i2 = -1;
                for (int j = 0; j < qb; ++j) { const LAS f32x4* kr = (const LAS f32x4*)(km + j * 64 + dh * 32); float g = 0.f;
#pragma unroll
                    for (int c4 = 0; c4 < 8; ++c4) { const f32x4 kv = kr[c4]; g = fmaf(qf[4 * c4 + 0], kv.x, g); g = fmaf(qf[4 * c4 + 1], kv.y, g); g = fmaf(qf[4 * c4 + 2], kv.z, g); g = fmaf(qf[4 * c4 + 3], kv.w, g); }
                    g += shx(g, 1, lane);
                    if (g > b0) { b2 = b1; i2 = i1; b1 = b0; i1 = i0; b0 = g; i0 = j; } else if (g > b1) { b2 = b1; i2 = i1; b1 = g; i1 = j; } else if (g > b2) { b2 = g; i2 = j; } }
                if (dh == 0) { const int row = qb * 256 + q;
                    if (i0 >= 0) { const int p = __hip_atomic_fetch_add(CNTB + hd * 64 + i0, 1, RLX_AGENT); LISTB[(size_t)(hd * 64 + i0) * 16384 + p] = row; }
                    if (i1 >= 0) { const int p = __hip_atomic_fetch_add(CNTB + hd * 64 + i1, 1, RLX_AGENT); LISTB[(size_t)(hd * 64 + i1) * 16384 + p] = row | (1 << 16); }
                    if (i2 >= 0) { const int p = __hip_atomic_fetch_add(CNTB + hd * 64 + i2, 1, RLX_AGENT); LISTB[(size_t)(hd * 64 + i2) * 16384 + p] = row | (2 << 16); } }
            }
        }
        SEAM(pb + 3);
        if (INJ(4)) for (int rp = 0; rp < REPS(4); ++rp) {
            PHASE_BEGIN();
            const bf16* const PROJ = (const bf16*)(ws + WS_PROJ); float* const TB = (float*)(ws + WS_T);
            char* const shm = (char*)lds + RING_OFF;
#if !defined(NO_ATT_C)
#if defined(REPEAT_SKIP_C)
            if (rp == 0)
#endif
            for (int vc = vcu; vc < 256; vc += G) {
                const int st = vc >> 4, hd = st >> 1, mp = st & 1, s = vc & 15;
                const attn_body::bf16* Qp = (const attn_body::bf16*)PROJ + C_QC + hd * 128 + mp * 64; const attn_body::bf16* Kp = (const attn_body::bf16*)PROJ + C_KC + hd * 128 + mp * 64;
                const attn_body::bf16* Vp = (const attn_body::bf16*)PROJ + C_VC + hd * 128; float* Op = TB + (size_t)mp * S_ * 1024 + hd * 128;
                for (int i = 3; i >= 0; --i) { const int qb = 32 * (i >> 1) + ((i & 1) ? 31 - s : s);
                    attn_body::attn_unit128<8>(qb, Qp, Kp, Vp, Op, 1024, shm, wave_s); }
            }
#endif
            { int t2; asm volatile("v_mbcnt_lo_u32_b32 %0, -1, 0\n\tv_mbcnt_hi_u32_b32 %0, -1, %0" : "=v"(t2)); t2 += wave_s * 64;
              LAS int* const ust = (LAS int*)(L + ATT_UST_OFF); LAS int* const wtot = ust + 520; LAS int* const qn = (LAS int*)(L + ATT_QN_OFF);
              const int* const CNTB = (const int*)(ctl + CW_CNTB + l * 512);
              const int nl = CNTB[t2]; const int nch = (8 + ((nl + 31) >> 5) + 15) >> 4;
              int inc = nch;
#pragma unroll
              for (int o = 1; o < 64; o <<= 1) { const int v = shup_i(inc, o, t2 & 63); if ((t2 & 63) >= o) inc += v; }
              if ((t2 & 63) == 63) wtot[t2 >> 6] = inc;
              __syncthreads();
              int pre = 0;
              for (int w = 0; w < (t2 >> 6); ++w) pre += wtot[w];
              ust[t2 + 1] = pre + inc; if (t2 == 0) ust[0] = 0;
              __syncthreads();
              const int nB = ust[512], nU = nB + 1536;
              gu32* const qhead = ctl + CW_QUEUE + 64 * (l + 2 * rp);
              for (;;) {
                  if (t2 == 0) qn[0] = (int)__hip_atomic_fetch_add(qhead, 1u, RLX_AGENT);
                  __syncthreads();
                  const int u = __builtin_amdgcn_readfirstlane(qn[0]);
                  __syncthreads();
                  if (u >= nU) break;
                  attn_body::BraUnit U;
                  if (u < nB) {
                      int lo_ = 0, hi_ = 512;
                      while (hi_ - lo_ > 1) { const int mid = (lo_ + hi_) >> 1; if (ust[mid] <= u) lo_ = mid; else hi_ = mid; }
                      const int hj = lo_, hd = hj >> 6, jb = hj & 63, c = u - ust[hj]; const int nlist = CNTB[hj]; const int ntile = 8 + ((nlist + 31) >> 5);
                      U.Q = (const attn_body::bf16*)PROJ + C_QB + hd * 64; U.K = (const attn_body::bf16*)PROJ + C_KB + hd * 64; U.V = (const attn_body::bf16*)PROJ + C_VB + hd * 64;
                      U.PO = (attn_body::bf16*)(ws + WS_POB) + hd * 64; U.PL = (float*)(ws + WS_PLB) + hd;
                      U.kbase = 256 * jb; U.kstride = 1; U.t_first = 0; U.nkt = 4; U.nqt = (ntile - 16 * c) < 16 ? (ntile - 16 * c) : 16;
                      U.qbase = 0; U.qstride = 0; U.slotA = 0; U.list = (const int*)(ws + WS_LIST) + (size_t)hj * 16384; U.nlist = nlist; U.tile0 = 16 * c; U.ownrow0 = 256 * jb;
                      attn_body::bra_unit<1>(U, shm, wave_s);
                  } else {
                      const int a = u - nB, hd = a / 192, r = a % 192, pt = r >> 6, w6 = r & 63; const int dil = (pt == 0) ? 1 : (pt == 1) ? 4 : 16;
                      const int nblk = 64 / dil, rho = w6 / nblk, ib = w6 % nblk;
                      U.Q = (const attn_body::bf16*)PROJ + C_QA + hd * 64; U.K = (const attn_body::bf16*)PROJ + C_KA + hd * 64; U.V = (const attn_body::bf16*)PROJ + C_VA + hd * 64;
                      U.PO = (attn_body::bf16*)(ws + WS_POA) + hd * 64; U.PL = (float*)(ws + WS_PLA) + hd;
                      U.kbase = rho + dil * (256 * ib - 128); U.kstride = dil; U.t_first = (ib == 0) ? 2 : 0; U.nkt = 6; U.nqt = 8;
                      U.qbase = rho + dil * 256 * ib; U.qstride = dil; U.slotA = pt; U.list = nullptr; U.nlist = 0; U.tile0 = 0; U.ownrow0 = 0;
                      attn_body::bra_unit<0>(U, shm, wave_s);
                  }
              }
            }
        }
        SEAM(pb + 4);
        if (INJ(5)) for (int rp = 0; rp < REPS(5); ++rp) {
            PHASE_BEGIN();
            const float* const lam_q1 = KIN(float, 9); const float* const lam_k1 = KIN(float, 10); const float* const lam_q2 = KIN(float, 11); const float* const lam_k2 = KIN(float, 12); const float* const g_sub = KIN(float, 13);
            const float* const TB = (const float*)(ws + WS_T); unsigned char* const MERGED = ws + WS_MERGED;
            const bf16* const POA = (const bf16*)(ws + WS_POA); const bf16* const POB = (const bf16*)(ws + WS_POB); const float* const PLA = (const float*)(ws + WS_PLA); const float* const PLB = (const float*)(ws + WS_PLB);
            const float d1 = wave_sum(lam_q1[l * 64 + lane] * lam_k1[l * 64 + lane], lane), d2 = wave_sum(lam_q2[l * 64 + lane] * lam_k2[l * 64 + lane], lane);
            const float lam = expf(d1) - expf(d2) + lam_init;
            const f32x4 gs = ((const f32x4*)(g_sub + l * 128))[lane & 31]; const float osc = (1.f - lam_init) * (OUT_FP8 ? MSCALE : 1.f);
            for (int row = gw; row < S_; row += NGW) {
                { float ls[3], mx = -INFINITY;
#pragma unroll
                  for (int sl = 0; sl < 3; ++sl) { ls[sl] = PLA[((size_t)sl * S_ + row) * 8 + (lane >> 3)]; mx = fmaxf(mx, ls[sl]); }
                  float acc[8], wsum = 0.f;
#pragma unroll
                  for (int e = 0; e < 8; ++e) acc[e] = 0.f;
#pragma unroll
                  for (int sl = 0; sl < 3; ++sl) { const float wgt = exp2f(ls[sl] - mx); wsum += wgt; const v4u w = ((const GAS v4u*)(POA + ((size_t)sl * S_ + row) * 512))[lane];
                      acc[0] += wgt * bflo(w.x); acc[1] += wgt * bfhi(w.x); acc[2] += wgt * bflo(w.y); acc[3] += wgt * bfhi(w.y); acc[4] += wgt * bflo(w.z); acc[5] += wgt * bfhi(w.z); acc[6] += wgt * bflo(w.w); acc[7] += wgt * bfhi(w.w); }
                  const float iw = (OUT_FP8 ? MSCALE : 1.f) / wsum;
                  if (OUT_FP8) { v2u o; o.x = pg8::pk4_fp8(acc[0] * iw, acc[1] * iw, acc[2] * iw, acc[3] * iw); o.y = pg8::pk4_fp8(acc[4] * iw, acc[5] * iw, acc[6] * iw, acc[7] * iw); ((GAS v2u*)(MERGED + (size_t)row * 2048))[lane] = o; }
                  else { v4u o; o.x = pk2(acc[0] * iw, acc[1] * iw); o.y = pk2(acc[2] * iw, acc[3] * iw); o.z = pk2(acc[4] * iw, acc[5] * iw); o.w = pk2(acc[6] * iw, acc[7] * iw); ((GAS v4u*)((bf16*)MERGED + (size_t)row * 2048))[lane] = o; } }
                { const int own = row >> 8, nsel = own < 3 ? own : 3; float ls[4], mx = -INFINITY;
#pragma unroll
                  for (int sl = 0; sl < 4; ++sl) { const bool on = (sl == 3) || (sl < nsel); ls[sl] = on ? PLB[((size_t)sl * S_ + row) * 8 + (lane >> 3)] : -INFINITY; mx = fmaxf(mx, ls[sl]); }
                  float acc[8], wsum = 0.f;
#pragma unroll
                  for (int e = 0; e < 8; ++e) acc[e] = 0.f;
#pragma unroll
                  for (int sl = 0; sl < 4; ++sl) { const bool on = (sl == 3) || (sl < nsel);
                      if (on) { const float wgt = exp2f(ls[sl] - mx); wsum += wgt; const v4u w = ((const GAS v4u*)(POB + ((size_t)sl * S_ + row) * 512))[lane];
                          acc[0] += wgt * bflo(w.x); acc[1] += wgt * bfhi(w.x); acc[2] += wgt * bflo(w.y); acc[3] += wgt * bfhi(w.y); acc[4] += wgt * bflo(w.z); acc[5] += wgt * bfhi(w.z); acc[6] += wgt * bflo(w.w); acc[7] += wgt * bfhi(w.w); } }
                  const float iw = (OUT_FP8 ? MSCALE : 1.f) / wsum;
                  if (OUT_FP8) { v2u o; o.x = pg8::pk4_fp8(acc[0] * iw, acc[1] * iw, acc[2] * iw, acc[3] * iw); o.y = pg8::pk4_fp8(acc[4] * iw, acc[5] * iw, acc[6] * iw, acc[7] * iw); ((GAS v2u*)(MERGED + (size_t)row * 2048 + 512))[lane] = o; }
                  else { v4u o; o.x = pk2(acc[0] * iw, acc[1] * iw); o.y = pk2(acc[2] * iw, acc[3] * iw); o.z = pk2(acc[4] * iw, acc[5] * iw); o.w = pk2(acc[6] * iw, acc[7] * iw); ((GAS v4u*)((bf16*)MERGED + (size_t)row * 2048 + 512))[lane] = o; } }
#pragma unroll
                for (int j = 0; j < 4; ++j) { const f32x4 a = ((const GAS f32x4*)(TB + (size_t)row * 1024))[lane + 64 * j], b = ((const GAS f32x4*)(TB + (size_t)(S_ + row) * 1024))[lane + 64 * j];
                    const f32x4 v = a - lam * b; float ss = (v.x * v.x + v.y * v.y) + (v.z * v.z + v.w * v.w);
                    ss += shx(ss, 1, lane); ss += shx(ss, 2, lane); ss += shx(ss, 4, lane); ss += shx(ss, 8, lane); ss += shx(ss, 16, lane);
                    const float rs = 1.f / sqrtf(ss * (1.f / 128.f) + RMS_EPS); const f32x4 o = v * rs * gs * osc;
                    if (OUT_FP8) ((GAS unsigned*)(MERGED + (size_t)row * 2048 + 1024))[lane + 64 * j] = pg8::pk4_fp8(o.x, o.y, o.z, o.w);
                    else { v2u w; w.x = pk2(o.x, o.y); w.y = pk2(o.z, o.w); ((GAS v2u*)((bf16*)MERGED + (size_t)row * 2048 + 1024))[lane + 64 * j] = w; } }
            }
        }
        SEAM(pb + 5);
        if (INJ(6)) for (int rp = 0; rp < REPS(6); ++rp) {
            PHASE_BEGIN();
            const float* const x_in = KIN(float, 0); float* const xbuf = ka->out; const float* const mod = (const float*)(ws + WS_MOD) + l * 12288;
            unsigned char* const MERGED = ws + WS_MERGED; unsigned char* const WOUT = ws + WS_WOUT;
            constexpr int KBO = OUT_FP8 ? 2048 : 4096;
            pg8::DenseSched Sd; Sd.init(MERGED, WOUT + (size_t)l * 2048 * KBO, S_, 2048, KBO, G, bx);
            pg8::EpiGateRes E{(l == 0) ? x_in : (const float*)xbuf, xbuf, mod + 4096, OUT_FP8 ? 1.f / (WSC_K2048 * MSCALE) : 1.f};
            pg8::gemm_phase<pg8::EpiGateRes, pg8::DenseSched, true, true, OUT_FP8 != 0>(L + RING_OFF, KBO, Sd, E, wave_s);
        }
        SEAM(pb + 6);
        if (INJ(7)) for (int rp = 0; rp < REPS(7); ++rp) {
            PHASE_BEGIN();
            const float* const g_mlp = KIN(float, 6); const float* const w_router = KIN(float, 17); const float* const b_router = KIN(float, 18); const float* const xbuf = ka->out;
            const float* const mod = (const float*)(ws + WS_MOD) + l * 12288; unsigned char* const HB = ws + WS_H;
            int* const EID = (int*)(ws + WS_EID); float* const WTS = (float*)(ws + WS_WTS); int* const CNT = (int*)(ws + WS_CNT);
            LAS float* const RW = (LAS float*)L;
            for (int idx = tid; idx < 32768; idx += NWAVES * 64) RW[(idx & 15) * 2048 + (idx >> 4)] = w_router[idx];
            f32x4 cA[8], cB[8];
#pragma unroll
            for (int j = 0; j < 8; ++j) { const int c4 = lane + 64 * j; const f32x4 g = ((const f32x4*)(g_mlp + l * 2048))[c4]; const f32x4 sc = ((const f32x4*)(mod + 8192))[c4];
                cA[j] = g * (1.f + sc); cB[j] = ((const f32x4*)(mod + 6144))[c4]; }
            float br[16];
#pragma unroll
            for (int e = 0; e < 16; ++e) br[e] = b_router[e];
            for (int rb = bx; rb < NROWBLK; rb += G) {
                if (tid < 16) cnt16[tid] = 0;
                __syncthreads();
                for (int i = 0; i < 8; ++i) { const int row = 64 * rb + 8 * wave + i;
                    f32x4 v[8]; float ss = 0.f;
#pragma unroll
                    for (int j = 0; j < 8; ++j) { v[j] = ((const GAS f32x4*)(xbuf + (size_t)row * 2048))[lane + 64 * j]; ss += (v[j].x * v[j].x + v[j].y * v[j].y) + (v[j].z * v[j].z + v[j].w * v[j].w); }
                    const float rs = 1.f / sqrtf(wave_sum(ss, lane) * (1.f / 2048.f) + RMS_EPS);
                    float p[16];
#pragma unroll
                    for (int e = 0; e < 16; ++e) p[e] = 0.f;
#pragma unroll
                    for (int j = 0; j < 8; ++j) { const f32x4 o = v[j] * rs * cA[j] + cB[j]; ((GAS unsigned*)(HB + (size_t)row * 2048))[lane + 64 * j] = pg8::pk4_fp8(o.x, o.y, o.z, o.w);
#pragma unroll
                        for (int e = 0; e < 16; ++e) { const f32x4 w4 = ((const LAS f32x4*)(RW + e * 2048))[lane + 64 * j]; p[e] += (o.x * w4.x + o.y * w4.y) + (o.z * w4.z + o.w * w4.w); } }
#pragma unroll
                    for (int e = 0; e < 16; ++e) p[e] = wave_sum(p[e], lane);
                    float sg[16], sv[16];
#pragma unroll
                    for (int e = 0; e < 16; ++e) { sv[e] = 1.f / (1.f + expf(-p[e])); sg[e] = sv[e] + br[e]; }
                    float gsc[4];
#pragma unroll
                    for (int g4 = 0; g4 < 4; ++g4) { const float a = sg[4 * g4], b = sg[4 * g4 + 1], c = sg[4 * g4 + 2], d = sg[4 * g4 + 3];
                        const float h1 = fmaxf(a, b), l1 = fminf(a, b), h2 = fmaxf(c, d), l2 = fminf(c, d); gsc[g4] = fmaxf(h1, h2) + fmaxf(fminf(h1, h2), fmaxf(l1, l2)); }
                    int gi = 0; float gb = gsc[0];
#pragma unroll
                    for (int g4 = 1; g4 < 4; ++g4) if (gsc[g4] > gb) { gb = gsc[g4]; gi = g4; }
                    float cd[4], cs[4];
#pragma unroll
                    for (int k = 0; k < 4; ++k) { cd[k] = (gi == 0) ? sg[k] : (gi == 1) ? sg[4 + k] : (gi == 2) ? sg[8 + k] : sg[12 + k]; cs[k] = (gi == 0) ? sv[k] : (gi == 1) ? sv[4 + k] : (gi == 2) ? sv[8 + k] : sv[12 + k]; }
                    int l0 = 0; float v0 = cd[0], s0 = cs[0];
#pragma unroll
                    for (int k = 1; k < 4; ++k) if (cd[k] > v0) { v0 = cd[k]; l0 = k; s0 = cs[k]; }
                    int l1i = -1; float v1 = -INFINITY, s1 = 0.f;
#pragma unroll
                    for (int k = 0; k < 4; ++k) if (k != l0 && cd[k] > v1) { v1 = cd[k]; l1i = k; s1 = cs[k]; }
                    const int e0 = 4 * gi + l0, e1 = 4 * gi + l1i; const float wsum = s0 + s1;
                    if (lane == 0) { EID[2 * row] = e0; EID[2 * row + 1] = e1; WTS[2 * row] = s0 / wsum; WTS[2 * row + 1] = s1 / wsum; atomicAdd((int*)(cnt16 + e0), 1); atomicAdd((int*)(cnt16 + e1), 1); }
                }
                __syncthreads();
                if (tid < 16) CNT[rb * 16 + tid] = cnt16[tid];
                __syncthreads();
            }
        }
        SEAM(pb + 7);
        if (INJ(8)) for (int rp = 0; rp < REPS(8); ++rp) {
            PHASE_BEGIN();
            const unsigned char* const HB = ws + WS_H; unsigned char* const XS = ws + WS_XS;
            const int* const EID = (const int*)(ws + WS_EID); const float* const WTS = (const float*)(ws + WS_WTS); int* const ROWTOK = (int*)(ws + WS_ROWTOK); float* const ROWW = (float*)(ws + WS_ROWW); const int* const CNT = (const int*)(ws + WS_CNT);
            for (int rb = bx; rb < NROWBLK; rb += G) {
                COMPUTE_SEGMENTS(rb);
                if (wave == 0) { const int row = 64 * rb + lane; const int e0 = EID[2 * row], e1 = EID[2 * row + 1]; int p0 = 0, p1 = 0;
                    const unsigned long long lt = (1ull << lane) - 1ull;
                    for (int e = 0; e < 16; ++e) { const unsigned long long m0 = __ballot(e0 == e), m1 = __ballot(e1 == e); const int r = __popcll(m0 & lt) + __popcll(m1 & lt);
                        if (e0 == e) p0 = basee[e] + r; if (e1 == e) p1 = basee[e] + r; }
                    postab[2 * lane] = p0; postab[2 * lane + 1] = p1;
                    ROWTOK[p0] = 2 * row; ROWTOK[p1] = 2 * row + 1; ROWW[p0] = WTS[2 * row]; ROWW[p1] = WTS[2 * row + 1]; }
                __syncthreads();
                for (int i = 0; i < 8; ++i) { const int r = 8 * wave + i, row = 64 * rb + r; const int p0 = postab[2 * r], p1 = postab[2 * r + 1];
#pragma unroll
                    for (int c = 0; c < 2; ++c) { const v4u w = ((const GAS v4u*)(HB + (size_t)row * 2048))[lane + 64 * c]; ((GAS v4u*)(XS + (size_t)p0 * 2048))[lane + 64 * c] = w; ((GAS v4u*)(XS + (size_t)p1 * 2048))[lane + 64 * c] = w; } }
                if (rb < 16) { const int pbeg = segs[rb] + tot[rb], pend = segs[rb + 1];
                    for (int p = pbeg + tid; p < pend; p += NWAVES * 64) { ROWTOK[p] = -1; ROWW[p] = 0.f; } }
                __syncthreads();
            }
        }
        SEAM(pb + 8);
        if (INJ(9)) for (int rp = 0; rp < REPS(9); ++rp) {
            PHASE_BEGIN();
            const int* const CNT = (const int*)(ws + WS_CNT); unsigned char* const XS = ws + WS_XS; unsigned char* const WGU = ws + WS_WGU; unsigned char* const ACT = ws + WS_ACT;
            COMPUTE_SEGMENTS(0);
            pg8::MoeSched Sm; Sm.init(XS, WGU + (size_t)l * 16 * 2048 * 2048, segs[16], 2048, 2048, (size_t)2048 * 2048, (const PG8_LAS unsigned char*)p2e, G, bx);
            pg8::EpiSwiglu E{ACT, 1.f / WSC_K2048, ASCALE};
            pg8::gemm_phase<pg8::EpiSwiglu, pg8::MoeSched, true, true, true>(L + RING_OFF, 2048, Sm, E, wave_s);
        }
        SEAM(pb + 9);
        if (INJ(10)) for (int rp = 0; rp < REPS(10); ++rp) {
            PHASE_BEGIN();
            const int* const CNT = (const int*)(ws + WS_CNT); unsigned char* const ACT = ws + WS_ACT; unsigned char* const WDN = ws + WS_WDN; bf16* const YB = (bf16*)(ws + WS_Y);
            const int* const ROWTOK = (const int*)(ws + WS_ROWTOK); const float* const ROWW = (const float*)(ws + WS_ROWW);
            COMPUTE_SEGMENTS(0);
            pg8::MoeSched Sm; Sm.init(ACT, WDN + (size_t)l * 16 * 2048 * 1024, segs[16], 2048, 1024, (size_t)2048 * 1024, (const PG8_LAS unsigned char*)p2e, G, bx);
            pg8::EpiDown E{YB, ROWTOK, ROWW, 1.f / (WSC_K1024 * ASCALE)};
            pg8::gemm_phase<pg8::EpiDown, pg8::MoeSched, true, true, true>(L + RING_OFF, 1024, Sm, E, wave_s);
        }
        SEAM(pb + 10);
    }
    if (((PHMASK >> 12) & 1) && IN(23)) {
        PHASE_BEGIN();
        const float* const g_final = KIN(float, 19); float* const xbuf = ka->out; const float* const MOD = (const float*)(ws + WS_MOD); const bf16* const YB = (const bf16*)(ws + WS_Y);
        f32x4 cA[8], cG[8];
#pragma unroll
        for (int j = 0; j < 8; ++j) { const int c4 = lane + 64 * j; cA[j] = ((const f32x4*)g_final)[c4]; cG[j] = ((const f32x4*)(MOD + 12288 + 10240))[c4]; }
        for (int row = gw; row < S_; row += NGW) {
            f32x4 v[8]; float ss = 0.f;
#pragma unroll
            for (int j = 0; j < 8; ++j) { v[j] = ((const GAS f32x4*)(xbuf + (size_t)row * 2048))[lane + 64 * j];
                const v2u a = ((const GAS v2u*)(YB + (size_t)(2 * row) * 2048))[lane + 64 * j], b = ((const GAS v2u*)(YB + (size_t)(2 * row + 1) * 2048))[lane + 64 * j];
                const f32x4 ys = (f32x4){bflo(a.x) + bflo(b.x), bfhi(a.x) + bfhi(b.x), bflo(a.y) + bflo(b.y), bfhi(a.y) + bfhi(b.y)};
                v[j] += cG[j] * ys; ss += (v[j].x * v[j].x + v[j].y * v[j].y) + (v[j].z * v[j].z + v[j].w * v[j].w); }
            const float rs = 1.f / sqrtf(wave_sum(ss, lane) * (1.f / 2048.f) + RMS_EPS);
#pragma unroll
            for (int j = 0; j < 8; ++j) ((GAS f32x4*)(xbuf + (size_t)row * 2048))[lane + 64 * j] = v[j] * rs * cA[j];
        }
    }
#undef IN
#undef INJ
#undef REPS
#undef PHASE_BEGIN
#undef KIN
#undef SEAM
#undef COMPUTE_SEGMENTS
}

extern "C" void kernel_launch(void* const* d_in, const int* in_sizes, int n_in, void* d_out, int out_size, void* d_ws, size_t ws_size, hipStream_t stream) {
    static int grid = 0;
    if (grid == 0) {
        if (n_in != 20 || in_sizes[0] != S_ * DM_ || out_size != S_ * DM_ || ws_size < WS_END) { fprintf(stderr, "kernel_launch: unexpected shapes or workspace (%d inputs, in0 %d, out %d, ws %zu); nothing launched\n", n_in, n_in > 0 ? in_sizes[0] : -1, out_size, ws_size); grid = -1; return; }
        int dev = 0, cus = 0, per_cu = 0;
        if (hipGetDevice(&dev) != hipSuccess || hipDeviceGetAttribute(&cus, hipDeviceAttributeMultiprocessorCount, dev) != hipSuccess) { grid = -1; return; }
        if (hipFuncSetAttribute((const void*)fwd, hipFuncAttributeMaxDynamicSharedMemorySize, LDS_BYTES) != hipSuccess) { fprintf(stderr, "kernel_launch: hipFuncSetAttribute failed\n"); grid = -1; return; }
        if (hipOccupancyMaxActiveBlocksPerMultiprocessor(&per_cu, (const void*)fwd, NWAVES * 64, LDS_BYTES) != hipSuccess || per_cu < 1) fprintf(stderr, "kernel_launch: occupancy query reports %d blocks per CU\n", per_cu);
        (void)hipGetLastError();
        grid = cus;
    }
    if (grid < 0) return;
    if (hipMemsetAsync((char*)d_ws + WS_CTL, 0, CTL_ZERO_BYTES, stream) != hipSuccess) return;
    Args a{};
    for (int i = 0; i < 20; ++i) a.in[i] = d_in[i];
    a.out = (float*)d_out; a.ws = (unsigned char*)d_ws;
    if (MK_N_LAUNCHES == 1) { a.ph_lo = 0; a.ph_hi = N_PHASES; hipLaunchKernelGGL(fwd, dim3(grid), dim3(NWAVES * 64), LDS_BYTES, stream, a); }
    else for (int p = 0; p < N_PHASES; ++p) { a.ph_lo = p; a.ph_hi = p + 1; hipLaunchKernelGGL(fwd, dim3(grid), dim3(NWAVES * 64), LDS_BYTES, stream, a); }
}
```

```cpp
#define PROJ_FP8 1
#define OUT_FP8 1
#include <hip/hip_runtime.h>
#include <hip/hip_bf16.h>
#include <cstdio>
#include <cstdint>
#include <cmath>
namespace pg8 {
#define PG8_LAS __attribute__((address_space(3)))
typedef unsigned short bf16_t;
typedef short bf16x8 __attribute__((ext_vector_type(8)));
typedef float f32x4 __attribute__((ext_vector_type(4)));
typedef unsigned u32x4 __attribute__((ext_vector_type(4)));
constexpr int BM = 256, BK = 64, HALF = 128, HTB = HALF * BK * 2  , STAGE_BYTES = 8 * HTB, NXCD = 8, WGM = 8;

__host__ __device__ __forceinline__ int lds_byte(int r, int c) { const int st = (r >> 4) * 2 + (c >> 5), rr = r & 15, cc = c & 31, ob = rr * 64 + cc * 2; return st * 1024 + (ob ^ (((ob >> 9) & 1) << 5)); }
__host__ __device__ __forceinline__ void stage_rc(int b, int& R, int& C) { const int st = b / 1024, sb = b % 1024, swz = sb ^ (((sb >> 9) & 1) << 5); R = (st >> 1) * 16 + swz / 64; C = (st & 1) * 32 + (swz % 64) / 2; }
__host__ __device__ __forceinline__ int perm32(int rho) { const int n = rho >> 4, i = rho & 15; return 8 * (i >> 2) + 4 * n + (i & 3); }

struct Unit { int pm, pn; };
struct Gemm { const bf16_t* A; const bf16_t* Bt; int M, N, K; };

struct StaticOrder {
    int nM, nN, nwg, G, c;
    __host__ __device__ void init(int M, int N, int G_, int c_) { nM = M / BM; nN = N / BM; nwg = nM * nN; G = G_; c = c_; }
    __host__ __device__ bool next(int i, Unit& u) const {
        const long L = (long)i * G + c; if (L >= nwg) return false;
        int wgid = (int)L; { const int q = nwg / NXCD, r = nwg % NXCD, xcd = wgid % NXCD, off = wgid / NXCD; wgid = (xcd < r ? xcd * (q + 1) : r * (q + 1) + (xcd - r) * q) + off; }
        const int nig = WGM * nN, gid = wgid / nig, fm = gid * WGM, gsz = (nM - fm) < WGM ? (nM - fm) : WGM;
        u.pm = fm + ((wgid % nig) % gsz); u.pn = (wgid % nig) / gsz; return true;
    }
    __device__ __forceinline__ void a_ready(const Unit&) const {}
    __device__ __forceinline__ void done(const Unit&) const {}
};

struct DenseSched {
    const char* A; const char* Bt; size_t tstep; StaticOrder so;
    __device__ __forceinline__ void init(const void* A_, const void* Bt_, int M, int N, int KB, int G, int c) { A = (const char*)A_; Bt = (const char*)Bt_; tstep = (size_t)BM * KB; so.init(M, N, G, c); }
    __device__ __forceinline__ bool next(int i, Unit& u) const { return so.next(i, u); }
    __device__ __forceinline__ const char* a_ptr(const Unit& u) const { return A + (size_t)u.pm * tstep; }
    __device__ __forceinline__ const char* b_ptr(const Unit& u) const { return Bt + (size_t)u.pn * tstep; }
    __device__ __forceinline__ void a_ready(const Unit&) const {}
    __device__ __forceinline__ void done(const Unit&) const {}
};
struct MoeSched {
    const char* A; const char* Bt; size_t tstep, estride; StaticOrder so; const PG8_LAS unsigned char* p2e;
    __device__ __forceinline__ void init(const void* A_, const void* Bt_, int Mpad, int N, int KB, size_t estride_, const PG8_LAS unsigned char* p2e_, int G, int c) {
        A = (const char*)A_; Bt = (const char*)Bt_; tstep = (size_t)BM * KB; estride = estride_; p2e = p2e_; so.init(Mpad, N, G, c); }
    __device__ __forceinline__ bool next(int i, Unit& u) const { return so.next(i, u); }
    __device__ __forceinline__ const char* a_ptr(const Unit& u) const { return A + (size_t)u.pm * tstep; }
    __device__ __forceinline__ const char* b_ptr(const Unit& u) const { const int e = __builtin_amdgcn_readfirstlane((int)p2e[u.pm]); return Bt + (size_t)e * estride + (size_t)u.pn * tstep; }
    __device__ __forceinline__ void a_ready(const Unit&) const {}
    __device__ __forceinline__ void done(const Unit&) const {}
};

__device__ __forceinline__ unsigned pk4_fp8(float a, float b, float c, float d) {
    a = __builtin_fminf(__builtin_fmaxf(a, -448.f), 448.f); b = __builtin_fminf(__builtin_fmaxf(b, -448.f), 448.f); c = __builtin_fminf(__builtin_fmaxf(c, -448.f), 448.f); d = __builtin_fminf(__builtin_fmaxf(d, -448.f), 448.f);
    int w = 0; w = __builtin_amdgcn_cvt_pk_fp8_f32(a, b, w, false); w = __builtin_amdgcn_cvt_pk_fp8_f32(c, d, w, true); return (unsigned)w; }
__device__ __forceinline__ unsigned cvt_pk_bf16(float lo, float hi) { unsigned r; asm volatile("v_cvt_pk_bf16_f32 %0, %1, %2" : "=v"(r) : "v"(lo), "v"(hi)); return r; }

struct EpiProj {
    static constexpr bool PERM = true, AFTER_DRAIN = false;
    bf16_t* O; const float* cosT; const float* sinT; float qscale, oscale;
    __device__ __forceinline__ void operator()(const f32x4 (&acc)[2][2][4][2], const Unit& u, int wr, int wc, int fr, int fq) const {
        const int pn = u.pn;
        const bool isq = (pn < 2) || (pn == 6) || (pn == 7) || (pn >= 12 && pn < 16);
        const bool isk = (pn == 2) || (pn == 3) || (pn == 8) || (pn == 9) || (pn >= 16 && pn < 20);
        const int row0 = u.pm * BM + wr * 64 + fr, col0 = pn * BM + wc * 32 + 8 * fq;
        const int i0 = (wc & 1) * 16 + 4 * fq;
        const float sc = isq ? qscale * oscale : oscale;
#pragma unroll
        for (int ai = 0; ai < 2; ++ai)
#pragma unroll
            for (int m = 0; m < 4; ++m) { const int row = row0 + ai * HALF + m * 16; bf16_t* rowp = O + (size_t)row * 6144 + col0;
                f32x4 cs = (f32x4){1.f, 1.f, 1.f, 1.f}, sn = (f32x4){0.f, 0.f, 0.f, 0.f};
                if (isq || isk) { cs = *(const f32x4*)(cosT + (size_t)row * 32 + i0); sn = *(const f32x4*)(sinT + (size_t)row * 32 + i0); }
#pragma unroll
                for (int bj = 0; bj < 2; ++bj) { const f32x4 v0 = acc[ai][bj][m][0], v1 = acc[ai][bj][m][1];
                    const float a0 = (v0[0] * cs[0] - v0[1] * sn[0]) * sc, b0 = (v0[1] * cs[0] + v0[0] * sn[0]) * sc;
                    const float a1 = (v0[2] * cs[1] - v0[3] * sn[1]) * sc, b1 = (v0[3] * cs[1] + v0[2] * sn[1]) * sc;
                    const float a2 = (v1[0] * cs[2] - v1[1] * sn[2]) * sc, b2 = (v1[1] * cs[2] + v1[0] * sn[2]) * sc;
                    const float a3 = (v1[2] * cs[3] - v1[3] * sn[3]) * sc, b3 = (v1[3] * cs[3] + v1[2] * sn[3]) * sc;
                    u32x4 w; w.x = cvt_pk_bf16(a0, b0); w.y = cvt_pk_bf16(a1, b1); w.z = cvt_pk_bf16(a2, b2); w.w = cvt_pk_bf16(a3, b3);
                    *(u32x4*)(rowp + bj * HALF) = w; } }
    }
};
struct EpiGateRes {
    static constexpr bool PERM = false, AFTER_DRAIN = false;
    const float* base; float* out; const float* gate; float oscale;
    __device__ __forceinline__ void operator()(const f32x4 (&acc)[2][2][4][2], const Unit& u, int wr, int wc, int fr, int fq) const {
        const int col0 = u.pn * BM + wc * 32 + 4 * fq;
        f32x4 gv[2][2];
#pragma unroll
        for (int bj = 0; bj < 2; ++bj)
#pragma unroll
            for (int n = 0; n < 2; ++n) gv[bj][n] = *(const f32x4*)(gate + col0 + bj * HALF + n * 16) * oscale;
#pragma unroll
        for (int ai = 0; ai < 2; ++ai)
#pragma unroll
            for (int m = 0; m < 4; ++m) { const size_t off = (size_t)(u.pm * BM + ai * HALF + wr * 64 + m * 16 + fr) * 2048 + col0;
#pragma unroll
                for (int bj = 0; bj < 2; ++bj)
#pragma unroll
                    for (int n = 0; n < 2; ++n) { const f32x4 bs = *(const f32x4*)(base + off + bj * HALF + n * 16); *(f32x4*)(out + off + bj * HALF + n * 16) = bs + gv[bj][n] * acc[ai][bj][m][n]; } }
    }
};
struct EpiSwiglu {
    static constexpr bool PERM = true, AFTER_DRAIN = false;
    unsigned char* O; float iscale, ascale;
    __device__ __forceinline__ void operator()(const f32x4 (&acc)[2][2][4][2], const Unit& u, int wr, int wc, int fr, int fq) const {
        const int row0 = u.pm * BM + wr * 64 + fr, col0 = u.pn * 128 + wc * 16 + 4 * fq;
#pragma unroll
        for (int ai = 0; ai < 2; ++ai)
#pragma unroll
            for (int m = 0; m < 4; ++m) { unsigned char* rowp = O + (size_t)(row0 + ai * HALF + m * 16) * 1024 + col0;
#pragma unroll
                for (int bj = 0; bj < 2; ++bj) { const f32x4 g = acc[ai][bj][m][0] * iscale, up = acc[ai][bj][m][1] * (iscale * ascale); float r[4];
#pragma unroll
                    for (int j = 0; j < 4; ++j) { const float e = __builtin_amdgcn_exp2f(-1.4426950408889634f * g[j]); r[j] = g[j] * __builtin_amdgcn_rcpf(1.f + e) * up[j]; }
                    *(unsigned*)(rowp + bj * 64) = pk4_fp8(r[0], r[1], r[2], r[3]); } }
    }
};
struct EpiDown {
    static constexpr bool PERM = true, AFTER_DRAIN = false;
    bf16_t* Y; const int* rowtok; const float* roww; float oscale;
    __device__ __forceinline__ void operator()(const f32x4 (&acc)[2][2][4][2], const Unit& u, int wr, int wc, int fr, int fq) const {
        const int row0 = u.pm * BM + wr * 64 + fr, col0 = u.pn * BM + wc * 32 + 8 * fq;
#pragma unroll
        for (int ai = 0; ai < 2; ++ai)
#pragma unroll
            for (int m = 0; m < 4; ++m) { const int pos = row0 + ai * HALF + m * 16; const int tk = rowtok[pos]; const float w8 = roww[pos] * oscale;
                bf16_t* rowp = Y + (size_t)(tk < 0 ? 0 : tk) * 2048 + col0;
#pragma unroll
                for (int bj = 0; bj < 2; ++bj) { const f32x4 v0 = acc[ai][bj][m][0] * w8, v1 = acc[ai][bj][m][1] * w8;
                    u32x4 w; w.x = cvt_pk_bf16(v0[0], v0[1]); w.y = cvt_pk_bf16(v0[2], v0[3]); w.z = cvt_pk_bf16(v1[0], v1[1]); w.w = cvt_pk_bf16(v1[2], v1[3]);
                    if (tk >= 0) *(u32x4*)(rowp + bj * HALF) = w; }
                asm volatile("" ::: "memory"); }
    }
};

template <class Epi, class Sched, bool ALIGN_EPI = false, bool SP2 = false, bool FP8 = false>
__device__ __forceinline__ void gemm_phase(PG8_LAS unsigned char* lds, const int KB  , const Sched& S, const Epi& E, const int wave_s  ) {
    typedef int v4i_t __attribute__((ext_vector_type(4))); typedef int v8i_t __attribute__((ext_vector_type(8)));
    int lane; asm volatile("v_mbcnt_lo_u32_b32 %0, -1, 0\n\tv_mbcnt_hi_u32_b32 %0, -1, %0" : "=v"(lane)); const int wid = wave_s, tid = wid * 64 + lane, wr = wid >> 2, wc = wid & 3, fr = lane & 15, fq = lane >> 4;
    const int nt = KB / (BK * 2);
    unsigned voffA, voffB;
    { int R, C; stage_rc(tid * 16, R, C); const int Rb = Epi::PERM ? ((R & ~31) + perm32(R & 31)) : R; voffA = (unsigned)(R * KB + C * 2); voffB = (unsigned)(Rb * KB + C * 2); }
    const size_t pstep = (size_t)64 * KB;
    const size_t kstep = (size_t)(BK * 2);
    const size_t hstep = (size_t)HALF * KB;
    const unsigned ldsbw = (unsigned)__builtin_amdgcn_readfirstlane((int)((unsigned)(uintptr_t)lds + (unsigned)wid * 1024u));
    const int aoff = lds_byte(wr * 64 + fr, fq * 8), boff = lds_byte(wc * 32 + fr, fq * 8);
#define PG8_SA(b, h) (((b) * 2 + (h)) * HTB)
#define PG8_SB(b, h) ((4 + (b) * 2 + (h)) * HTB)
#define PG8_STAGE1(bufoff, gbase, voff, PI) do { unsigned keep_; \
        asm volatile("s_mov_b32 %0, m0\n\ts_add_i32 m0, %3, %4\n\ts_nop 0\n\tglobal_load_lds_dwordx4 %1, %2\n\ts_mov_b32 m0, %0" : "=&s"(keep_) : "v"(voff), "s"((const char*)(gbase) + (PI) * pstep), "s"(ldsbw), "i"((bufoff) + (PI) * 8192) : "memory", "scc"); } while (0)
#define PG8_STAGE(bufoff, gbase, voff) do { PG8_STAGE1(bufoff, gbase, voff, 0); PG8_STAGE1(bufoff, gbase, voff, 1); } while (0)
#define PG8_LDA(dst, b, h) do { _Pragma("unroll") for (int m = 0; m < 4; ++m) { dst[m].lo = *(const PG8_LAS v4i_t*)(lds + PG8_SA(b, h) + aoff + m * 2048); dst[m].hi = *(const PG8_LAS v4i_t*)(lds + PG8_SA(b, h) + aoff + m * 2048 + 1024); } } while (0)
#define PG8_LDB(dst, b, h) do { _Pragma("unroll") for (int n = 0; n < 2; ++n) { dst[n].lo = *(const PG8_LAS v4i_t*)(lds + PG8_SB(b, h) + boff + n * 2048); dst[n].hi = *(const PG8_LAS v4i_t*)(lds + PG8_SB(b, h) + boff + n * 2048 + 1024); } } while (0)
#define PG8_MMA(ai, bj, At, Bt) do { __builtin_amdgcn_s_setprio(1); _Pragma("unroll") for (int m = 0; m < 4; ++m) _Pragma("unroll") for (int n = 0; n < 2; ++n) { \
        if constexpr (FP8) { acc[ai][bj][m][n] = __builtin_amdgcn_mfma_scale_f32_16x16x128_f8f6f4(Bt[n], At[m], acc[ai][bj][m][n], 0, 0, 0, 0, 0, 0); } \
        else { const v4i_t bl_ = Bt[n].lo, bh_ = Bt[n].hi, al_ = At[m].lo, ah_ = At[m].hi;     \
               acc[ai][bj][m][n] = __builtin_amdgcn_mfma_f32_16x16x32_bf16(__builtin_bit_cast(bf16x8, bl_), __builtin_bit_cast(bf16x8, al_), acc[ai][bj][m][n], 0, 0, 0); \
               acc[ai][bj][m][n] = __builtin_amdgcn_mfma_f32_16x16x32_bf16(__builtin_bit_cast(bf16x8, bh_), __builtin_bit_cast(bf16x8, ah_), acc[ai][bj][m][n], 0, 0, 0); } } \
        __builtin_amdgcn_s_setprio(0); } while (0)
#define PG8_WAIT_V(n) asm volatile("s_waitcnt vmcnt(" #n ")" ::: "memory")
#define PG8_WAIT_L(n) asm volatile("s_waitcnt lgkmcnt(" #n ")" ::: "memory")
#define PG8_BAR __builtin_amdgcn_s_barrier()
#define PG8_SCHED __builtin_amdgcn_sched_barrier(0)
    Unit cur, nxt; int ui = 0;
    if (!S.next(0, cur)) return;
    f32x4 acc[2][2][4][2];
#pragma unroll
    for (int a = 0; a < 2; ++a)
#pragma unroll
        for (int b = 0; b < 2; ++b)
#pragma unroll
            for (int m = 0; m < 4; ++m)
#pragma unroll
                for (int n = 0; n < 2; ++n) acc[a][b][m][n] = (f32x4){0.f, 0.f, 0.f, 0.f};
    v8i_t At[4], B0[2], B1[2];
    const char* cA = S.a_ptr(cur); const char* cB = S.b_ptr(cur);
    S.a_ready(cur);
    if constexpr (SP2) {
        PG8_STAGE(PG8_SB(0, 0), cB, voffB); PG8_STAGE(PG8_SB(0, 1), cB + hstep, voffB); PG8_STAGE(PG8_SA(0, 0), cA, voffA); PG8_STAGE(PG8_SA(0, 1), cA + hstep, voffA);
        if (wr == 1) PG8_BAR;
        PG8_WAIT_V(2); PG8_BAR;
        PG8_STAGE(PG8_SB(1, 0), cB + kstep, voffB); PG8_STAGE(PG8_SA(1, 0), cA + kstep, voffA); PG8_STAGE(PG8_SB(1, 1), cB + hstep + kstep, voffB);
        PG8_WAIT_V(6); PG8_BAR;
    } else {
        PG8_STAGE(PG8_SB(0, 0), cB, voffB); PG8_STAGE(PG8_SA(0, 0), cA, voffA); PG8_STAGE(PG8_SB(0, 1), cB + hstep, voffB); PG8_STAGE(PG8_SA(0, 1), cA + hstep, voffA);
        if (wr == 1) PG8_BAR;
        PG8_WAIT_V(4); PG8_BAR;
        PG8_STAGE(PG8_SB(1, 0), cB + kstep, voffB); PG8_STAGE(PG8_SA(1, 0), cA + kstep, voffA); PG8_STAGE(PG8_SB(1, 1), cB + hstep + kstep, voffB);
        PG8_WAIT_V(6); PG8_BAR;
    }
    for (;;) {
        const bool has_next = S.next(ui + 1, nxt);
        const char* nA = has_next ? S.a_ptr(nxt) : cA; const char* nB = has_next ? S.b_ptr(nxt) : cB;
#pragma unroll 1
        for (int t = 0; t < nt; t += 2) {
            const bool last = (t == nt - 2);
            const char* a1 = cA + (size_t)(t + 1) * kstep;
            const char* a2 = last ? nA : cA + (size_t)(t + 2) * kstep; const char* b2 = last ? nB : cB + (size_t)(t + 2) * kstep;
            const char* a3 = a2 + kstep; const char* b3 = b2 + kstep;
            if (last && has_next) S.a_ready(nxt);
            if constexpr (SP2) {
            PG8_LDB(B0, 0, 0); PG8_LDB(B1, 0, 1); PG8_SCHED; PG8_LDA(At, 0, 0); PG8_STAGE(PG8_SA(1, 1), a1 + hstep, voffA);
            PG8_WAIT_V(8); PG8_WAIT_L(0); PG8_BAR; PG8_MMA(0, 0, At, B0); PG8_MMA(0, 1, At, B1); PG8_BAR; PG8_SCHED;
            PG8_LDA(At, 0, 1); PG8_STAGE(PG8_SB(0, 0), b2, voffB); PG8_STAGE(PG8_SB(0, 1), b2 + hstep, voffB); PG8_STAGE(PG8_SA(0, 0), a2, voffA);
            PG8_WAIT_V(8); PG8_WAIT_L(0); PG8_BAR; PG8_MMA(1, 0, At, B0); PG8_MMA(1, 1, At, B1); PG8_BAR; PG8_SCHED;
            PG8_LDB(B0, 1, 0); PG8_LDB(B1, 1, 1); PG8_SCHED; PG8_LDA(At, 1, 0); PG8_STAGE(PG8_SA(0, 1), a2 + hstep, voffA);
            PG8_WAIT_V(8); PG8_WAIT_L(0); PG8_BAR; PG8_MMA(0, 0, At, B0); PG8_MMA(0, 1, At, B1); PG8_BAR; PG8_SCHED;
            PG8_LDA(At, 1, 1); PG8_STAGE(PG8_SB(1, 0), b3, voffB); PG8_STAGE(PG8_SB(1, 1), b3 + hstep, voffB); PG8_STAGE(PG8_SA(1, 0), a3, voffA);
            PG8_WAIT_V(8); PG8_WAIT_L(0); PG8_BAR; PG8_MMA(1, 0, At, B0); PG8_MMA(1, 1, At, B1); PG8_BAR; PG8_SCHED;
            } else {
            PG8_LDB(B0, 0, 0); PG8_SCHED; PG8_LDA(At, 0, 0); PG8_STAGE(PG8_SA(1, 1), a1 + hstep, voffA);
            PG8_WAIT_L(8); PG8_BAR; PG8_WAIT_L(0); PG8_MMA(0, 0, At, B0); PG8_BAR; PG8_SCHED;
            PG8_LDB(B1, 0, 1); PG8_STAGE(PG8_SB(0, 0), b2, voffB);
            PG8_BAR; PG8_WAIT_L(0); PG8_MMA(0, 1, At, B1); PG8_BAR;
            PG8_LDA(At, 0, 1); PG8_STAGE(PG8_SA(0, 0), a2, voffA);
            PG8_BAR; PG8_WAIT_L(0); PG8_MMA(1, 0, At, B0); PG8_BAR; PG8_SCHED;
            PG8_STAGE(PG8_SB(0, 1), b2 + hstep, voffB);
            PG8_WAIT_V(6); PG8_BAR; PG8_MMA(1, 1, At, B1); PG8_BAR;
            PG8_LDB(B0, 1, 0); PG8_SCHED; PG8_LDA(At, 1, 0); PG8_STAGE(PG8_SA(0, 1), a2 + hstep, voffA);
            PG8_WAIT_L(8); PG8_BAR; PG8_WAIT_L(0); PG8_MMA(0, 0, At, B0); PG8_BAR; PG8_SCHED;
            PG8_LDB(B1, 1, 1); PG8_STAGE(PG8_SB(1, 0), b3, voffB);
            PG8_BAR; PG8_WAIT_L(0); PG8_MMA(0, 1, At, B1); PG8_BAR;
            PG8_LDA(At, 1, 1); PG8_STAGE(PG8_SA(1, 0), a3, voffA);
            PG8_BAR; PG8_WAIT_L(0); PG8_MMA(1, 0, At, B0); PG8_BAR; PG8_SCHED;
            PG8_STAGE(PG8_SB(1, 1), b3 + hstep, voffB);
            PG8_WAIT_V(6); PG8_BAR; PG8_MMA(1, 1, At, B1); PG8_BAR;
            }
        }
        if constexpr (ALIGN_EPI) { if (wr == 0) PG8_BAR; }
        if constexpr (!Epi::AFTER_DRAIN) { int ln_; asm volatile("v_mbcnt_lo_u32_b32 %0, -1, 0\n\tv_mbcnt_hi_u32_b32 %0, -1, %0" : "=v"(ln_));
            E(acc, cur, wr, wc, ln_ & 15, ln_ >> 4); S.done(cur); }
        if (!has_next) break;
#pragma unroll
        for (int a = 0; a < 2; ++a)
#pragma unroll
            for (int b = 0; b < 2; ++b)
#pragma unroll
                for (int m = 0; m < 4; ++m)
#pragma unroll
                    for (int n = 0; n < 2; ++n) acc[a][b][m][n] = (f32x4){0.f, 0.f, 0.f, 0.f};
        cur = nxt; cA = nA; cB = nB; ++ui;
        if constexpr (ALIGN_EPI) { if (wr == 1) PG8_BAR; }
    }
    PG8_WAIT_V(0);
    if constexpr (!ALIGN_EPI) { if (wr == 0) PG8_BAR; }
    PG8_BAR;
    if constexpr (Epi::AFTER_DRAIN) { E.fused(acc, cur, wr, wc, fr, fq, lds, wid, lane); S.done(cur); }
#undef PG8_SA
#undef PG8_SB
#undef PG8_STAGE
#undef PG8_LDA
#undef PG8_LDB
#undef PG8_MMA
#undef PG8_WAIT_V
#undef PG8_WAIT_L
#undef PG8_BAR
#undef PG8_SCHED
}
}

#include <hip/hip_bf16.h>
#include <cmath>
namespace attn_body {
using bf16=__hip_bfloat16;
using bf16x8=__attribute__((ext_vector_type(8)))short;
using s16x4=__attribute__((ext_vector_type(4)))short;
using f32x16=__attribute__((ext_vector_type(16)))float;
using u32x4=__attribute__((ext_vector_type(4)))unsigned;
constexpr int SEQ=16384,D=64,DM=6144;
constexpr int NW=8,QBLK=32,QB=QBLK*NW,KVBLK=64,NQB=SEQ/QB;
constexpr int ATTN_UNIT_ROWS=QB;
__device__ __forceinline__ int crow(int r,int hi){return (r&3)+8*(r>>2)+4*hi;}
#define SBAR() __builtin_amdgcn_sched_barrier(0)
__device__ __forceinline__ void cmask(f32x16&p0,f32x16&p1,int jb,int qrel,int hi){
  const float NEG=-INFINITY; int kb=64*jb+4*hi;
  #pragma unroll
  for(int r=0;r<16;++r){int kv=kb+(r&3)+8*(r>>2); if(kv>qrel)p0[r]=NEG; if(kv+32>qrel)p1[r]=NEG;}
}

constexpr int NSLOT=3, SLOTB=8192;
constexpr int LDS_K=0, LDS_V=NSLOT*SLOTB, LDS_WS=2*NSLOT*SLOTB, LDS_OST=LDS_WS+NW*64*4, LDS_BYTES=LDS_OST+NW*4096;
constexpr float C2=0.125f*1.4426950408889634f;
__device__ __forceinline__ void glds16(const void*gsrc,unsigned lds_dst){unsigned keep;
  asm volatile("s_mov_b32 %0, m0\n\ts_mov_b32 m0, %2\n\ts_nop 0\n\tglobal_load_lds_dwordx4 %1, off\n\ts_mov_b32 m0, %0":"=&s"(keep):"v"(gsrc),"s"(lds_dst):"memory");}
__device__ __forceinline__ void glds16s(const void*sbase,unsigned voff,unsigned lds_dst){unsigned keep;
  asm volatile("s_mov_b32 %0, m0\n\ts_mov_b32 m0, %3\n\ts_nop 0\n\tglobal_load_lds_dwordx4 %1, %2\n\ts_mov_b32 m0, %0":"=&s"(keep):"v"(voff),"s"(sbase),"s"(lds_dst):"memory");}
__device__ __forceinline__ float max3f(float a,float b,float c){float r;asm("v_max3_f32 %0, %1, %2, %3":"=v"(r):"v"(a),"v"(b),"v"(c));return r;}
__device__ __forceinline__ float max2f(float a,float b){float r;asm("v_max_f32_e32 %0, %1, %2":"=v"(r):"v"(a),"v"(b));return r;}
__device__ __forceinline__ float fadd_s(float a,float b){float r;asm("v_add_f32_e32 %0, %1, %2":"=v"(r):"v"(a),"v"(b));return r;}
__device__ __forceinline__ float fsub_s(float a,float b){float r;asm("v_sub_f32_e32 %0, %1, %2":"=v"(r):"v"(a),"v"(b));return r;}
typedef float f32x2_t __attribute__((ext_vector_type(2))); typedef __bf16 bf16x2_t __attribute__((ext_vector_type(2)));
__device__ __forceinline__ unsigned cvtpk_s(float lo,float hi){f32x2_t v={lo,hi};bf16x2_t b=__builtin_convertvector(v,bf16x2_t);return __builtin_bit_cast(unsigned,b);}
#define WAIT_BAR(N) asm volatile("s_waitcnt vmcnt(" #N ") lgkmcnt(0)\n\ts_barrier":::"memory")

__device__ __forceinline__ void rmask(f32x16&p0,f32x16&p1,bool keep){
  const float NEG=-INFINITY;
  #pragma unroll
  for(int r=0;r<16;++r){ p0[r]=keep?p0[r]:NEG; p1[r]=keep?p1[r]:NEG; }
}
__device__ __forceinline__ float abias(int d){
  const int t1=1+((128-d)>>31);
  const int t4=(((d&3)-1)>>31)&(1+((512-d)>>31));
  const int t16=(((d&15)-1)>>31)&(1+((2048-d)>>31));
  const int m=(t1+t4+t16)&~(d>>31);
  return __builtin_amdgcn_logf((float)m);
}
__device__ __forceinline__ void amask(f32x16&p0,f32x16&p1,int dbase){
  #pragma unroll
  for(int r=0;r<16;++r){ int d=dbase-((r&3)+8*(r>>2)); asm volatile("":"+v"(d)); p0[r]+=abias(d); int d2=d-32; asm volatile("":"+v"(d2)); p1[r]+=abias(d2); }
}
__device__ __forceinline__ void qkt(f32x16&p0,f32x16&p1,const char*Kslot,const bf16x8*qr,const f32x16&negm,int r32,int hi){
  const char*kb=Kslot+hi*1024+r32*16;
  #pragma unroll
  for(int d0=0;d0<4;++d0){
    const bf16x8 b0=*reinterpret_cast<const bf16x8*>(kb+d0*2048);
    const bf16x8 b1=*reinterpret_cast<const bf16x8*>(kb+d0*2048+512);
    if(d0==0){p0=__builtin_amdgcn_mfma_f32_32x32x16_bf16(b0,qr[0],negm,0,0,0);p1=__builtin_amdgcn_mfma_f32_32x32x16_bf16(b1,qr[0],negm,0,0,0);}
    else{p0=__builtin_amdgcn_mfma_f32_32x32x16_bf16(b0,qr[d0],p0,0,0,0);p1=__builtin_amdgcn_mfma_f32_32x32x16_bf16(b1,qr[d0],p1,0,0,0);}}
}
typedef __attribute__((address_space(3))) const char* lds_cptr;
typedef short v4i16_t __attribute__((ext_vector_type(4)));
__device__ __forceinline__ void kload8(bf16x8*kf,lds_cptr kp){
  kf[0]=*(const __attribute__((address_space(3))) bf16x8*)(kp);      kf[1]=*(const __attribute__((address_space(3))) bf16x8*)(kp+512);
  kf[2]=*(const __attribute__((address_space(3))) bf16x8*)(kp+2048); kf[3]=*(const __attribute__((address_space(3))) bf16x8*)(kp+2560);
  kf[4]=*(const __attribute__((address_space(3))) bf16x8*)(kp+4096); kf[5]=*(const __attribute__((address_space(3))) bf16x8*)(kp+4608);
  kf[6]=*(const __attribute__((address_space(3))) bf16x8*)(kp+6144); kf[7]=*(const __attribute__((address_space(3))) bf16x8*)(kp+6656);
}
__device__ __forceinline__ void kload2(bf16x8*kf,lds_cptr kp,int j){ kf[2*j]=*(const __attribute__((address_space(3))) bf16x8*)(kp+j*2048); kf[2*j+1]=*(const __attribute__((address_space(3))) bf16x8*)(kp+j*2048+512); }
__device__ __forceinline__ s16x4 vtr(lds_cptr p){ return __builtin_bit_cast(s16x4,__builtin_amdgcn_ds_read_tr16_b64_v4i16((__attribute__((address_space(3))) v4i16_t*)p)); }
__device__ __forceinline__ float rowmax(const f32x16&p0,const f32x16&p1){
  float a=max3f(p0[0],p0[1],p1[0]),b=max3f(p0[2],p0[3],p1[1]);a=max3f(a,p1[2],p1[3]);
  #pragma unroll
  for(int r=4;r<16;r+=4){a=max3f(a,p0[r],p0[r+1]);b=max3f(b,p0[r+2],p0[r+3]);a=max3f(a,p1[r],p1[r+1]);b=max3f(b,p1[r+2],p1[r+3]);}
  const float m=max2f(a,b);
  auto rr=__builtin_amdgcn_permlane32_swap(__float_as_uint(m),__float_as_uint(m),false,false);
  return max2f(__uint_as_float(rr[0]),__uint_as_float(rr[1]));
}
__device__ __forceinline__ void pv(f32x16*o,int vb,bf16x8 pa0,bf16x8 pa1,bf16x8 pa2,bf16x8 pa3){
  #pragma unroll
  for(int d0=0;d0<2;++d0){s16x4 lo[4],hi[4];
    #pragma unroll
    for(int ks=0;ks<4;++ks){
      asm volatile("ds_read_b64_tr_b16 %0,%1 offset:%c2":"=&v"(lo[ks]):"v"(vb),"i"(d0*4096+ks*1024):"memory");
      asm volatile("ds_read_b64_tr_b16 %0,%1 offset:%c2":"=&v"(hi[ks]):"v"(vb),"i"(d0*4096+ks*1024+512):"memory");}
    asm volatile("s_waitcnt lgkmcnt(0)":::"memory");SBAR();
    #define PK(k) (bf16x8){lo[k][0],lo[k][1],lo[k][2],lo[k][3],hi[k][0],hi[k][1],hi[k][2],hi[k][3]}
    o[d0]=__builtin_amdgcn_mfma_f32_32x32x16_bf16(pa0,PK(0),o[d0],0,0,0);
    o[d0]=__builtin_amdgcn_mfma_f32_32x32x16_bf16(pa1,PK(1),o[d0],0,0,0);
    o[d0]=__builtin_amdgcn_mfma_f32_32x32x16_bf16(pa2,PK(2),o[d0],0,0,0);
    o[d0]=__builtin_amdgcn_mfma_f32_32x32x16_bf16(pa3,PK(3),o[d0],0,0,0);
    #undef PK
  }
}

#ifndef ATTN_STORE16
#define ATTN_STORE16(p,v) (*(u32x4*)(p)=(v))
#endif
template<int THRL,int MODE> __device__ __forceinline__ void attn_unit(int qb,int T0,const bf16*Q,const bf16*__restrict__ K,const bf16*__restrict__ V,void*Ov,int opitch,const unsigned long long*sel,char*shm){
  int tid=threadIdx.x; asm volatile("":"+v"(tid)); const int lane=tid&63,r32=lane&31,hi=lane>>5; const int wid=__builtin_amdgcn_readfirstlane(tid>>6);
  const int q0=qb*QB;
  const bf16*Qw=Q+(long)(q0+wid*QBLK)*DM;
  const bf16*Kh=K+(long)T0*KVBLK*DM,*Vh=V+(long)T0*KVBLK*DM;
  const unsigned lds0=(unsigned)(uintptr_t)shm;
  float*wsf=(float*)(shm+LDS_WS)+wid*64;
  const bf16*ksrc=Kh+(long)lane*DM+wid*8;
  const bf16*vsrc=Vh+(long)(16*(wid&3)+(lane>>2))*DM+(wid>>2)*32+(lane&3)*8;
  const unsigned kdst=lds0+LDS_K+wid*1024, vdst=lds0+LDS_V+wid*1024;
  #define DMA_K(t,slot) glds16(ksrc+(long)(t)*KVBLK*DM,(unsigned)__builtin_amdgcn_readfirstlane(kdst+(slot)))
  #define DMA_V(t,slot) glds16(vsrc+(long)(t)*KVBLK*DM,(unsigned)__builtin_amdgcn_readfirstlane(vdst+(slot)))
  const int vb0=(int)(lds0+LDS_V)+((lane>>4)&1)*32+(lane&3)*8+(4*hi+((lane&15)>>2))*64;
  const char*Kbase=shm+LDS_K; bf16x8 kf[8];
  const lds_cptr shm3=(lds_cptr)shm; const lds_cptr kp0=shm3+LDS_K+hi*1024+r32*16; const lds_cptr vp0=shm3+LDS_V+((lane>>4)&1)*32+(lane&3)*8+(4*hi+((lane&15)>>2))*64;
  const int NT=(q0+QB)/KVBLK-T0;
  DMA_K(0,0);DMA_V(0,0);DMA_K(1,SLOTB);
  bf16x8 qr[4];
  #pragma unroll
  for(int d0=0;d0<4;++d0)qr[d0]=*reinterpret_cast<const bf16x8*>(&Qw[(long)r32*DM+d0*16+hi*8]);
  float mhat=0.f,l_reg=0.f;f32x16 o[2];o[0]=f32x16{};o[1]=f32x16{};f32x16 negm=f32x16{};asm volatile("":"+v"(negm));
  const int qrel=wid*QBLK+r32;
  unsigned sel_lo=0u,sel_hi=0u; if(MODE==1){ const unsigned long long sv=sel[qrel]; sel_lo=(unsigned)sv; sel_hi=(unsigned)(sv>>32); }
  const int dq=q0+qrel-4*hi-T0*KVBLK;
  #define RKEEP(t) ((((t)>>2)<32?(sel_lo>>((t)>>2)):(sel_hi>>(((t)>>2)-32)))&1u)
  #define CMASK(P0,P1,t) do{ if(MODE==2){amask(P0,P1,dq-64*(t));} else {int jb_=(t)-(NT-4); if(jb_>=0)cmask(P0,P1,jb_,qrel,hi); else if(MODE==1)rmask(P0,P1,RKEEP(t)!=0u);} }while(0)
  bool resc=false;
  #define START(P0,P1) do{ const float rm=rowmax(P0,P1); resc=false; \
    { const float dl=(MODE==0)?rm:((rm>-3.0e38f)?rm:0.f); mhat=fadd_s(mhat,dl); \
      _Pragma("unroll") for(int r=0;r<16;++r){P0[r]=fsub_s(P0[r],dl);P1[r]=fsub_s(P1[r],dl);} \
      _Pragma("unroll") for(int r=0;r<16;++r)negm[r]=-mhat; asm volatile("":"+v"(negm)); } \
    _Pragma("unroll") for(int r=0;r<16;++r)P0[r]=__builtin_amdgcn_exp2f(P0[r]); }while(0)
  #define RESC() do{ if(resc){ asm volatile("s_waitcnt lgkmcnt(0)":::"memory"); \
      _Pragma("unroll") for(int d_=0;d_<2;++d_) _Pragma("unroll") for(int r=0;r<16;++r)o[d_][r]*=wsf[crow(r,hi)]; } }while(0)
  f32x16 pA0,pA1,pB0,pB1;
  int sl_prev=0,sl_cur=0,sl_next=SLOTB;
  #define ROT() do{sl_prev=sl_cur;sl_cur=sl_next;sl_next=(sl_next==(NSLOT-1)*SLOTB)?0:sl_next+SLOTB;}while(0)
  DMA_K(2,2*SLOTB);
  WAIT_BAR(3);
  qkt(pA0,pA1,Kbase,qr,negm,r32,hi);asm volatile("s_nop 15\n\ts_nop 7":"+v"(pA0),"+v"(pA1));CMASK(pA0,pA1,0);
  START(pA0,pA1);
  _Pragma("unroll") for(int r=0;r<16;++r)pA1[r]=__builtin_amdgcn_exp2f(pA1[r]);
  WAIT_BAR(0);
  DMA_K(3,0);DMA_V(1,SLOTB);
  ROT();
  kload8(kf,kp0+sl_cur);
  WAIT_BAR(2);
  s16x4 vlo[8],vhi[8]; u32x4 pw0,pw1,pw2,pw3;
  #define PKW(P,B) cvtpk_s(P[B],P[B+1])
  #define PAF(k) __builtin_bit_cast(bf16x8,pw##k)
  #define VFR(i) (bf16x8){vlo[i][0],vlo[i][1],vlo[i][2],vlo[i][3],vhi[i][0],vhi[i][1],vhi[i][2],vhi[i][3]}
  #define PIN(x) asm volatile("":"+v"(x))
  #define MX3(a,b,c) __builtin_fmaxf(__builtin_fmaxf((a),(b)),(c))
  #define GAPA(MF,A0,A1,A2,A3,W0,W1,PW) do{ MF; sacc+=A0; sacc+=A1; sacc+=A2; sacc+=A3; PIN(sacc); W0; W1; PIN(PW); SBAR(); }while(0)
  #define EX(v) __builtin_amdgcn_exp2f(v)
  #define GAPB(MF,X,B) do{ MF; X[B]=EX(X[B]); X[B+1]=EX(X[B+1]); X[B+2]=EX(X[B+2]); X[B+3]=EX(X[B+3]); PIN(X); SBAR(); }while(0)
  #define VRD(i) do{ vlo[i]=vtr(vp_+(((i)>>2)*4096+((i)&3)*1024)); vhi[i]=vtr(vp_+(((i)>>2)*4096+((i)&3)*1024+512)); }while(0)
  #define KRD(G,j) do{ if(G){ kload2(kf,kp0+sl_next,j); SBAR(); } }while(0)
  #define STEP(C0,C1,P0,P1,t,GK,GV,GL) do{ SBAR(); \
    const lds_cptr vp_=vp0+sl_prev; \
    VRD(0); SBAR(); float sacc=(P0[0]+P0[1]); \
    GAPA(C0=__builtin_amdgcn_mfma_f32_32x32x16_bf16(kf[0],qr[0],negm,0,0,0), P0[2],P0[3],P0[4],P0[5],     pw0[0]=PKW(P0,0), pw0[1]=PKW(P0,2), pw0); \
    VRD(4); SBAR(); GAPA(C1=__builtin_amdgcn_mfma_f32_32x32x16_bf16(kf[1],qr[0],negm,0,0,0), P0[6],P0[7],P0[8],P0[9],     pw0[2]=PKW(P0,4), pw0[3]=PKW(P0,6), pw0); \
    VRD(1); SBAR(); GAPA(C0=__builtin_amdgcn_mfma_f32_32x32x16_bf16(kf[2],qr[1],C0,0,0,0),   P0[10],P0[11],P0[12],P0[13], pw1[0]=PKW(P0,8), pw1[1]=PKW(P0,10), pw1); \
    VRD(5); SBAR(); GAPA(C1=__builtin_amdgcn_mfma_f32_32x32x16_bf16(kf[3],qr[1],C1,0,0,0),   P0[14],P0[15],P1[0],P1[1],   pw1[2]=PKW(P0,12),pw1[3]=PKW(P0,14), pw1); \
    VRD(2); SBAR(); GAPA(C0=__builtin_amdgcn_mfma_f32_32x32x16_bf16(kf[4],qr[2],C0,0,0,0),   P1[2],P1[3],P1[4],P1[5],     pw2[0]=PKW(P1,0), pw2[1]=PKW(P1,2), pw2); \
    VRD(6); SBAR(); GAPA(C1=__builtin_amdgcn_mfma_f32_32x32x16_bf16(kf[5],qr[2],C1,0,0,0),   P1[6],P1[7],P1[8],P1[9],     pw2[2]=PKW(P1,4), pw2[3]=PKW(P1,6), pw2); \
    VRD(3); SBAR(); GAPA(C0=__builtin_amdgcn_mfma_f32_32x32x16_bf16(kf[6],qr[3],C0,0,0,0),   P1[10],P1[11],P1[12],P1[13], pw3[0]=PKW(P1,8), pw3[1]=PKW(P1,10), pw3); \
    VRD(7); SBAR(); GAPA(C1=__builtin_amdgcn_mfma_f32_32x32x16_bf16(kf[7],qr[3],C1,0,0,0),   P1[14],P1[15],0.f,0.f,       pw3[2]=PKW(P1,12),pw3[3]=PKW(P1,14), pw3); \
    l_reg+=sacc; \
    if(GK){DMA_K((t)+3,sl_cur);} if(GV){DMA_V((t)+1,sl_next);} \
    CMASK(C0,C1,t); \
    { float a=MX3(C0[0],C0[1],C1[0]),b=MX3(C0[2],C0[3],C1[1]); a=MX3(a,C1[2],C1[3]); \
      _Pragma("unroll") for(int r=4;r<16;r+=4){a=MX3(a,C0[r],C0[r+1]);b=MX3(b,C0[r+2],C0[r+3]);a=MX3(a,C1[r],C1[r+1]);b=MX3(b,C1[r+2],C1[r+3]);} \
      float rm=__builtin_fmaxf(a,b); { auto rr=__builtin_amdgcn_permlane32_swap(__float_as_uint(rm),__float_as_uint(rm),false,false); rm=__builtin_fmaxf(__uint_as_float(rr[0]),__uint_as_float(rr[1])); } \
      resc=false; \
      if(__builtin_expect(__any(rm>(float)THRL),0)){ const float dl=__builtin_fmaxf(rm,0.f); mhat+=dl; \
        _Pragma("unroll") for(int r=0;r<16;++r){C0[r]-=dl;C1[r]-=dl;} \
        _Pragma("unroll") for(int r=0;r<16;++r)negm[r]=-mhat; asm volatile("":"+v"(negm)); \
        const float f=__builtin_amdgcn_exp2f(-dl); l_reg*=f; if(hi==0)wsf[r32]=f; resc=true; } } \
    SBAR(); \
    GAPB(o[0]=__builtin_amdgcn_mfma_f32_32x32x16_bf16(PAF(0),VFR(0),o[0],0,0,0), C0,0); \
    GAPB(o[1]=__builtin_amdgcn_mfma_f32_32x32x16_bf16(PAF(0),VFR(4),o[1],0,0,0), C0,4); \
    KRD(GL,0); GAPB(o[0]=__builtin_amdgcn_mfma_f32_32x32x16_bf16(PAF(1),VFR(1),o[0],0,0,0), C0,8); \
    KRD(GL,1); GAPB(o[1]=__builtin_amdgcn_mfma_f32_32x32x16_bf16(PAF(1),VFR(5),o[1],0,0,0), C0,12); \
    KRD(GL,2); GAPB(o[0]=__builtin_amdgcn_mfma_f32_32x32x16_bf16(PAF(2),VFR(2),o[0],0,0,0), C1,0); \
    KRD(GL,3); GAPB(o[1]=__builtin_amdgcn_mfma_f32_32x32x16_bf16(PAF(2),VFR(6),o[1],0,0,0), C1,4); \
    GAPB(o[0]=__builtin_amdgcn_mfma_f32_32x32x16_bf16(PAF(3),VFR(3),o[0],0,0,0), C1,8); \
    GAPB(o[1]=__builtin_amdgcn_mfma_f32_32x32x16_bf16(PAF(3),VFR(7),o[1],0,0,0), C1,12); \
    }while(0)
  int t=1;
  #undef CMASK
  #define CMASK(P0,P1,t) do{ if(MODE==2){amask(P0,P1,dq-64*(t));} else if(MODE==1){rmask(P0,P1,RKEEP(t)!=0u);} }while(0)
  for(;t+5<NT;t+=2){
    STEP(pB0,pB1,pA0,pA1,t,true,true,true);     WAIT_BAR(2); RESC(); ROT();
    STEP(pA0,pA1,pB0,pB1,t+1,true,true,true);   WAIT_BAR(2); RESC(); ROT();
  }
  #undef CMASK
  #define CMASK(P0,P1,t) do{ if(MODE==2){amask(P0,P1,dq-64*(t));} else {int jb_=(t)-(NT-4); if(jb_>=0)cmask(P0,P1,jb_,qrel,hi); else if(MODE==1)rmask(P0,P1,RKEEP(t)!=0u);} }while(0)
  #define ENDW(tt) do{ if((tt)+3<NT){WAIT_BAR(2);} else if((tt)+2<NT){WAIT_BAR(1);} else {WAIT_BAR(0);} }while(0)
  for(;t+1<NT;t+=2){
    STEP(pB0,pB1,pA0,pA1,t,(t+3<NT),(t+1<NT),(t+1<NT));       ENDW(t);   RESC(); ROT();
    STEP(pA0,pA1,pB0,pB1,t+1,(t+4<NT),(t+2<NT),(t+2<NT));     ENDW(t+1); RESC(); ROT();
  }
  STEP(pB0,pB1,pA0,pA1,NT-1,false,false,false); RESC();
  { float sacc=pB0[0]+pB0[1]; _Pragma("unroll") for(int r=2;r<16;++r)sacc+=pB0[r]; _Pragma("unroll") for(int r=0;r<16;++r)sacc+=pB1[r]; l_reg+=sacc;
    pw0=(u32x4){PKW(pB0,0),PKW(pB0,2),PKW(pB0,4),PKW(pB0,6)};pw1=(u32x4){PKW(pB0,8),PKW(pB0,10),PKW(pB0,12),PKW(pB0,14)};pw2=(u32x4){PKW(pB1,0),PKW(pB1,2),PKW(pB1,4),PKW(pB1,6)};pw3=(u32x4){PKW(pB1,8),PKW(pB1,10),PKW(pB1,12),PKW(pB1,14)};
    SBAR(); pv(o,vb0+sl_cur,PAF(0),PAF(1),PAF(2),PAF(3)); }
  #undef PKW
  #undef PAF
  #undef VFR
  #undef PIN
  #undef MX3
  #undef GAPA
  #undef GAPB
  #undef EX
  #undef VRD
  #undef KRD
  #undef STEP
  #undef ENDW
  {auto rr=__builtin_amdgcn_permlane32_swap(__float_as_uint(l_reg),__float_as_uint(l_reg),false,false);l_reg=__uint_as_float(rr[0])+__uint_as_float(rr[1]);}
  if(hi==0)wsf[32+r32]=l_reg;asm volatile("s_waitcnt lgkmcnt(0)":::"memory");
  float rli[16];
  #pragma unroll
  for(int r=0;r<16;++r)rli[r]=__builtin_amdgcn_rcpf(wsf[32+crow(r,hi)]);
  if(MODE==0){ float*Of=(float*)Ov+(long)(q0+wid*QBLK)*opitch;
    #pragma unroll
    for(int r=0;r<16;++r){const int orow=crow(r,hi);
      #pragma unroll
      for(int d0=0;d0<2;++d0)Of[(long)orow*opitch+d0*32+r32]=o[d0][r]*rli[r];} }
  else { bf16*Ow=(bf16*)Ov+(long)(q0+wid*QBLK)*opitch; bf16*stg=(bf16*)(shm+LDS_OST)+wid*2048;
    #pragma unroll
    for(int r=0;r<16;++r){const int orow=crow(r,hi);
      #pragma unroll
      for(int d0=0;d0<2;++d0)stg[orow*64+d0*32+r32]=__float2bfloat16(o[d0][r]*rli[r]);}
    asm volatile("s_waitcnt lgkmcnt(0)":::"memory");
    #pragma unroll
    for(int i=0;i<4;++i){const int row=i*8+(lane>>3),ch=lane&7; const u32x4 v=*(const u32x4*)(stg+row*64+ch*8); ATTN_STORE16(Ow+(long)row*opitch+ch*8,v);} }
  asm volatile("s_waitcnt lgkmcnt(0)\n\ts_barrier":::"memory");
  #undef DMA_K
  #undef DMA_V
  #undef CMASK
  #undef RKEEP
  #undef START
  #undef RESC
  #undef ROT
}
constexpr int ATTN_LDS_BYTES=LDS_BYTES;


constexpr int X_K=0, X_V=3*SLOTB, X_WS=X_V+6*SLOTB, X_LDS_BYTES=X_WS+NW*256;
__device__ __forceinline__ void pv4(f32x16*o,int vb,bf16x8 pa0,bf16x8 pa1,bf16x8 pa2,bf16x8 pa3){
  #pragma unroll
  for(int d0=0;d0<4;++d0){s16x4 lo[4],hi[4];
    #pragma unroll
    for(int ks=0;ks<4;++ks){
      asm volatile("ds_read_b64_tr_b16 %0,%1 offset:%c2":"=&v"(lo[ks]):"v"(vb),"i"(d0*4096+ks*1024):"memory");
      asm volatile("ds_read_b64_tr_b16 %0,%1 offset:%c2":"=&v"(hi[ks]):"v"(vb),"i"(d0*4096+ks*1024+512):"memory");}
    asm volatile("s_waitcnt lgkmcnt(0)":::"memory");SBAR();
    #define PK(k) (bf16x8){lo[k][0],lo[k][1],lo[k][2],lo[k][3],hi[k][0],hi[k][1],hi[k][2],hi[k][3]}
    o[d0]=__builtin_amdgcn_mfma_f32_32x32x16_bf16(pa0,PK(0),o[d0],0,0,0);
    o[d0]=__builtin_amdgcn_mfma_f32_32x32x16_bf16(pa1,PK(1),o[d0],0,0,0);
    o[d0]=__builtin_amdgcn_mfma_f32_32x32x16_bf16(pa2,PK(2),o[d0],0,0,0);
    o[d0]=__builtin_amdgcn_mfma_f32_32x32x16_bf16(pa3,PK(3),o[d0],0,0,0);
    #undef PK
  }
}
template<int THRL> __device__ __forceinline__ void attn_unit128(int qb,const bf16*Q,const bf16*__restrict__ K,const bf16*__restrict__ V,float*O,int opitch,char*shm,const int wid){
  int lane; asm volatile("v_mbcnt_lo_u32_b32 %0, -1, 0\n\tv_mbcnt_hi_u32_b32 %0, -1, %0":"=v"(lane)); const int r32=lane&31,hi=lane>>5;
  const int q0=qb*QB;
  const bf16*Qw=Q+(long)(q0+wid*QBLK)*DM;
  const unsigned lds0=(unsigned)(uintptr_t)shm;
  float*wsf=(float*)(shm+X_WS)+wid*64;
  const unsigned koff=(unsigned)(lane*DM+wid*8)*2u;
  const unsigned voff=(unsigned)((16*(wid&3)+(lane>>2))*DM+(wid>>2)*32+(lane&3)*8)*2u;
  const unsigned kdst=lds0+X_K+wid*1024, vdst=lds0+X_V+wid*1024;
  #define DMA_K(t,slot) glds16s(K+(long)(t)*KVBLK*DM,koff,(unsigned)__builtin_amdgcn_readfirstlane(kdst+(slot)))
  #define DMA_V(t,slot) do{ glds16s(V+(long)(t)*KVBLK*DM,voff,(unsigned)__builtin_amdgcn_readfirstlane(vdst+2*(slot))); glds16s(V+(long)(t)*KVBLK*DM+64,voff,(unsigned)__builtin_amdgcn_readfirstlane(vdst+2*(slot)+8192)); }while(0)
  const int vb0=(int)(lds0+X_V)+((lane>>4)&1)*32+(lane&3)*8+(4*hi+((lane&15)>>2))*64;
  const char*Kbase=shm+X_K; bf16x8 kf[8];
  const lds_cptr shm3=(lds_cptr)shm; const lds_cptr kp0=shm3+X_K+hi*1024+r32*16; const lds_cptr vp0=shm3+X_V+((lane>>4)&1)*32+(lane&3)*8+(4*hi+((lane&15)>>2))*64;
  const int NT=(q0+QB)/KVBLK;
  DMA_K(0,0);DMA_V(0,0);DMA_K(1,SLOTB);
  bf16x8 qr[4];
  #pragma unroll
  for(int d0=0;d0<4;++d0)qr[d0]=*reinterpret_cast<const bf16x8*>(&Qw[(long)r32*DM+d0*16+hi*8]);
  float mhat=0.f,l_reg=0.f;f32x16 o[4];o[0]=f32x16{};o[1]=f32x16{};o[2]=f32x16{};o[3]=f32x16{};
  float zz_=0.f; asm volatile("":"+v"(zz_)); f32x16 negm;
  _Pragma("unroll") for(int r=0;r<16;++r)negm[r]=zz_; asm volatile("":"+v"(negm));
  const int qrel=wid*QBLK+r32;
  #define CMASK(P0,P1,t) do{int jb_=(t)-(NT-4); if(jb_>=0)cmask(P0,P1,jb_,qrel,hi);}while(0)
  bool resc=false;
  #define RESC() do{ if(resc){ asm volatile("s_waitcnt lgkmcnt(0)":::"memory"); \
      _Pragma("unroll") for(int d_=0;d_<4;++d_) _Pragma("unroll") for(int r=0;r<16;++r)o[d_][r]*=wsf[crow(r,hi)]; } }while(0)
  f32x16 C0,C1; u32x4 pw0,pw1,pw2,pw3;
  int sl_prev=0,sl_cur=0,sl_next=SLOTB;
  #define ROT() do{sl_prev=sl_cur;sl_cur=sl_next;sl_next=(sl_next==(NSLOT-1)*SLOTB)?0:sl_next+SLOTB;}while(0)
  #define PKW(P,B) cvtpk_s(P[B],P[B+1])
  DMA_K(2,2*SLOTB);
  WAIT_BAR(4);
  qkt(C0,C1,Kbase,qr,negm,r32,hi);asm volatile("s_nop 15\n\ts_nop 7":"+v"(C0),"+v"(C1));CMASK(C0,C1,0);
  { const float rm=rowmax(C0,C1); const float dl=rm; mhat=fadd_s(mhat,dl);
    _Pragma("unroll") for(int r=0;r<16;++r){C0[r]=fsub_s(C0[r],dl);C1[r]=fsub_s(C1[r],dl);}
    _Pragma("unroll") for(int r=0;r<16;++r)negm[r]=-mhat; asm volatile("":"+v"(negm));
    _Pragma("unroll") for(int r=0;r<16;++r){C0[r]=__builtin_amdgcn_exp2f(C0[r]);C1[r]=__builtin_amdgcn_exp2f(C1[r]);}
    float sacc=C0[0]+C0[1]; _Pragma("unroll") for(int r=2;r<16;++r)sacc+=C0[r]; _Pragma("unroll") for(int r=0;r<16;++r)sacc+=C1[r]; l_reg+=sacc;
    pw0=(u32x4){PKW(C0,0),PKW(C0,2),PKW(C0,4),PKW(C0,6)};pw1=(u32x4){PKW(C0,8),PKW(C0,10),PKW(C0,12),PKW(C0,14)};pw2=(u32x4){PKW(C1,0),PKW(C1,2),PKW(C1,4),PKW(C1,6)};pw3=(u32x4){PKW(C1,8),PKW(C1,10),PKW(C1,12),PKW(C1,14)}; }
  WAIT_BAR(0);
  DMA_K(3,0);DMA_V(1,SLOTB);
  ROT();
  kload8(kf,kp0+sl_cur);
  WAIT_BAR(3);
  s16x4 vlo[8],vhi[8];
  #define PAF(k) __builtin_bit_cast(bf16x8,pw##k)
  #define VFR(i) (bf16x8){vlo[i][0],vlo[i][1],vlo[i][2],vlo[i][3],vhi[i][0],vhi[i][1],vhi[i][2],vhi[i][3]}
  #define PIN(x) asm volatile("":"+v"(x))
  #define MX3(a,b,c) __builtin_fmaxf(__builtin_fmaxf((a),(b)),(c))
  #define EX(v) __builtin_amdgcn_exp2f(v)
  #define VRDF(s,d,ks) do{ vlo[s]=vtr(vp_+((d)*4096+(ks)*1024)); vhi[s]=vtr(vp_+((d)*4096+(ks)*1024+512)); }while(0)
  #define GA(s,MF) do{ VRDF(s,(s)&3,(s)>>2); SBAR(); MF; SBAR(); }while(0)
  #define EX2(X,B) do{ X[B]=EX(X[B]); X[B+1]=EX(X[B+1]); PIN(X); }while(0)
  #define PK1(W,j,X,B) do{ sacc+=X[B]; sacc+=X[B+1]; W[j]=PKW(X,B); PIN(W); PIN(sacc); }while(0)
  #define KRD(G,j) do{ if(G){ kload2(kf,kp0+sl_next,j); } }while(0)
  #define STEP(t,GK,GV,GL) do{ SBAR(); \
    const lds_cptr vp_=vp0+2*sl_prev; \
    GA(0,C0=__builtin_amdgcn_mfma_f32_32x32x16_bf16(kf[0],qr[0],negm,0,0,0)); \
    GA(1,C1=__builtin_amdgcn_mfma_f32_32x32x16_bf16(kf[1],qr[0],negm,0,0,0)); \
    GA(2,C0=__builtin_amdgcn_mfma_f32_32x32x16_bf16(kf[2],qr[1],C0,0,0,0)); \
    GA(3,C1=__builtin_amdgcn_mfma_f32_32x32x16_bf16(kf[3],qr[1],C1,0,0,0)); \
    GA(4,C0=__builtin_amdgcn_mfma_f32_32x32x16_bf16(kf[4],qr[2],C0,0,0,0)); \
    GA(5,C1=__builtin_amdgcn_mfma_f32_32x32x16_bf16(kf[5],qr[2],C1,0,0,0)); \
    GA(6,C0=__builtin_amdgcn_mfma_f32_32x32x16_bf16(kf[6],qr[3],C0,0,0,0)); \
    GA(7,C1=__builtin_amdgcn_mfma_f32_32x32x16_bf16(kf[7],qr[3],C1,0,0,0)); \
    if(GK){DMA_K((t)+3,sl_cur);} if(GV){DMA_V((t)+1,sl_next);} \
    CMASK(C0,C1,t); \
    { float a=MX3(C0[0],C0[1],C1[0]),b=MX3(C0[2],C0[3],C1[1]); a=MX3(a,C1[2],C1[3]); \
      _Pragma("unroll") for(int r=4;r<16;r+=4){a=MX3(a,C0[r],C0[r+1]);b=MX3(b,C0[r+2],C0[r+3]);a=MX3(a,C1[r],C1[r+1]);b=MX3(b,C1[r+2],C1[r+3]);} \
      float rm=__builtin_fmaxf(a,b); { auto rr=__builtin_amdgcn_permlane32_swap(__float_as_uint(rm),__float_as_uint(rm),false,false); rm=__builtin_fmaxf(__uint_as_float(rr[0]),__uint_as_float(rr[1])); } \
      resc=false; \
      if(__builtin_expect(__any(rm>(float)THRL),0)){ const float dl=__builtin_fmaxf(rm,0.f); mhat+=dl; \
        _Pragma("unroll") for(int r=0;r<16;++r){C0[r]-=dl;C1[r]-=dl;} \
        _Pragma("unroll") for(int r=0;r<16;++r)negm[r]=-mhat; asm volatile("":"+v"(negm)); \
        const float f=__builtin_amdgcn_exp2f(-dl); l_reg*=f; if(hi==0)wsf[r32]=f; resc=true; } } \
    SBAR(); \
    float sacc=0.f; u32x4 nw0=(u32x4){0u,0u,0u,0u},nw1=nw0,nw2=nw0,nw3=nw0; \
    o[0]=__builtin_amdgcn_mfma_f32_32x32x16_bf16(PAF(0),VFR(0),o[0],0,0,0); VRDF(0,0,2); EX2(C0,0); SBAR(); \
    o[1]=__builtin_amdgcn_mfma_f32_32x32x16_bf16(PAF(0),VFR(1),o[1],0,0,0); VRDF(1,1,2); EX2(C0,2); SBAR(); \
    o[2]=__builtin_amdgcn_mfma_f32_32x32x16_bf16(PAF(0),VFR(2),o[2],0,0,0); VRDF(2,2,2); EX2(C0,4); SBAR(); \
    o[3]=__builtin_amdgcn_mfma_f32_32x32x16_bf16(PAF(0),VFR(3),o[3],0,0,0); VRDF(3,3,2); EX2(C0,6); SBAR(); \
    o[0]=__builtin_amdgcn_mfma_f32_32x32x16_bf16(PAF(1),VFR(4),o[0],0,0,0); VRDF(4,0,3); EX2(C0,8);  PK1(nw0,0,C0,0); SBAR(); \
    o[1]=__builtin_amdgcn_mfma_f32_32x32x16_bf16(PAF(1),VFR(5),o[1],0,0,0); VRDF(5,1,3); EX2(C0,10); PK1(nw0,1,C0,2); SBAR(); \
    o[2]=__builtin_amdgcn_mfma_f32_32x32x16_bf16(PAF(1),VFR(6),o[2],0,0,0); VRDF(6,2,3); EX2(C0,12); PK1(nw0,2,C0,4); SBAR(); \
    o[3]=__builtin_amdgcn_mfma_f32_32x32x16_bf16(PAF(1),VFR(7),o[3],0,0,0); VRDF(7,3,3); EX2(C0,14); PK1(nw0,3,C0,6); SBAR(); \
    o[0]=__builtin_amdgcn_mfma_f32_32x32x16_bf16(PAF(2),VFR(0),o[0],0,0,0); KRD(GL,0); EX2(C1,0);  PK1(nw1,0,C0,8);  SBAR(); \
    o[1]=__builtin_amdgcn_mfma_f32_32x32x16_bf16(PAF(2),VFR(1),o[1],0,0,0); KRD(GL,1); EX2(C1,2);  PK1(nw1,1,C0,10); SBAR(); \
    o[2]=__builtin_amdgcn_mfma_f32_32x32x16_bf16(PAF(2),VFR(2),o[2],0,0,0); KRD(GL,2); EX2(C1,4);  PK1(nw1,2,C0,12); SBAR(); \
    o[3]=__builtin_amdgcn_mfma_f32_32x32x16_bf16(PAF(2),VFR(3),o[3],0,0,0); KRD(GL,3); EX2(C1,6);  PK1(nw1,3,C0,14); SBAR(); \
    o[0]=__builtin_amdgcn_mfma_f32_32x32x16_bf16(PAF(3),VFR(4),o[0],0,0,0); EX2(C1,8);  PK1(nw2,0,C1,0); SBAR(); \
    o[1]=__builtin_amdgcn_mfma_f32_32x32x16_bf16(PAF(3),VFR(5),o[1],0,0,0); EX2(C1,10); PK1(nw2,1,C1,2); SBAR(); \
    o[2]=__builtin_amdgcn_mfma_f32_32x32x16_bf16(PAF(3),VFR(6),o[2],0,0,0); EX2(C1,12); PK1(nw2,2,C1,4); PK1(nw3,0,C1,8); SBAR(); \
    o[3]=__builtin_amdgcn_mfma_f32_32x32x16_bf16(PAF(3),VFR(7),o[3],0,0,0); EX2(C1,14); PK1(nw2,3,C1,6); PK1(nw3,1,C1,10); SBAR(); \
    PK1(nw3,2,C1,12); PK1(nw3,3,C1,14); l_reg+=sacc; pw0=nw0; pw1=nw1; pw2=nw2; pw3=nw3; \
    }while(0)
  #define ENDW(tt) do{ if((tt)+3<NT){WAIT_BAR(3);} else if((tt)+2<NT){WAIT_BAR(2);} else {WAIT_BAR(0);} }while(0)
  int t=1;
  #undef CMASK
  #define CMASK(P0,P1,t) do{}while(0)
  for(;t<NT-4;++t){ STEP(t,true,true,true); WAIT_BAR(3); RESC(); ROT(); }
  #undef CMASK
  #define CMASK(P0,P1,t) do{int jb_=(t)-(NT-4); if(jb_>=0)cmask(P0,P1,jb_,qrel,hi);}while(0)
  for(;t<NT-1;++t){ STEP(t,(t+3<NT),(t+1<NT),(t+1<NT)); ENDW(t); RESC(); ROT(); }
  STEP(NT-1,false,false,false); RESC();
  SBAR(); pv4(o,vb0+2*sl_cur,PAF(0),PAF(1),PAF(2),PAF(3));
  #undef PKW
  #undef PAF
  #undef VFR
  #undef PIN
  #undef MX3
  #undef EX
  #undef VRDF
  #undef GA
  #undef EX2
  #undef PK1
  #undef KRD
  #undef STEP
  #undef ENDW
  {auto rr=__builtin_amdgcn_permlane32_swap(__float_as_uint(l_reg),__float_as_uint(l_reg),false,false);l_reg=__uint_as_float(rr[0])+__uint_as_float(rr[1]);}
  if(hi==0)wsf[32+r32]=l_reg;asm volatile("s_waitcnt lgkmcnt(0)":::"memory");
  { float*Of=O+(long)(q0+wid*QBLK)*opitch;
    #pragma unroll
    for(int r=0;r<16;++r){const int orow=crow(r,hi); const float rl=__builtin_amdgcn_rcpf(wsf[32+orow]);
      #pragma unroll
      for(int d0=0;d0<4;++d0)Of[(long)orow*opitch+d0*32+r32]=o[d0][r]*rl;} }
  asm volatile("s_waitcnt lgkmcnt(0)\n\ts_barrier":::"memory");
  #undef DMA_K
  #undef DMA_V
  #undef CMASK
  #undef RESC
  #undef ROT
}

constexpr int BRA_MAXKT=6, BRA_K=0, BRA_V=BRA_MAXKT*8192, BRA_WS=2*BRA_MAXKT*8192, BRA_LDS_BYTES=BRA_WS+NW*512;
struct BraUnit {
  const bf16* Q; const bf16* K; const bf16* V;
  bf16* PO; float* PL;
  int kbase, kstride, t_first, nkt;
  int nqt;
  int qbase, qstride, slotA;
  const int* list; int nlist, tile0, ownrow0;
};
#define BMX3(a,b,c) __builtin_fmaxf(__builtin_fmaxf((a),(b)),(c))
template<int MODE> __device__ __forceinline__ void bra_unit(const BraUnit&u,char*shm,const int wid){
  int lane; asm volatile("v_mbcnt_lo_u32_b32 %0, -1, 0\n\tv_mbcnt_hi_u32_b32 %0, -1, %0":"=v"(lane)); const int r32=lane&31,hi=lane>>5;
  const unsigned lds0=(unsigned)(uintptr_t)shm;
  for(int T=u.t_first;T<u.nkt;++T){
    const long krow=u.kbase+(long)u.kstride*(64*T+lane), vrow=u.kbase+(long)u.kstride*(64*T+16*(wid&3)+(lane>>2));
    glds16(u.K+krow*DM+wid*8,(unsigned)__builtin_amdgcn_readfirstlane(lds0+BRA_K+T*8192+wid*1024));
    glds16(u.V+vrow*DM+(wid>>2)*32+(lane&3)*8,(unsigned)__builtin_amdgcn_readfirstlane(lds0+BRA_V+T*8192+wid*1024)); }
  asm volatile("s_waitcnt vmcnt(0)\n\ts_barrier":::"memory");
  float*wsf=(float*)(shm+BRA_WS)+wid*128; int*wsi=(int*)wsf+64;
  const int vbl=(int)(lds0+BRA_V)+((lane>>4)&1)*32+(lane&3)*8+(4*hi+((lane&15)>>2))*64;
  for(int qt=wid;qt<u.nqt;qt+=NW){
    int qrow,ql,Tlo,Thi,slot; bool valid=true,masked=true; unsigned dmax;
    if(MODE==0){ ql=32*qt+r32; qrow=u.qbase+u.qstride*ql; Tlo=(qt>>1)>u.t_first?(qt>>1):u.t_first; Thi=(qt>>1)+2; slot=u.slotA; dmax=128u; }
    else { const int g=u.tile0+qt;
      if(g<8){ ql=32*g+r32; qrow=u.ownrow0+ql; Tlo=0; Thi=g>>1; slot=3; dmax=0x7fffffffu; }
      else { const int e=(g-8)*32+r32; valid=e<u.nlist; const int ent=valid?u.list[e]:0; qrow=ent&0xffff; slot=ent>>16; ql=0; Tlo=0; Thi=3; masked=false; dmax=0x7fffffffu; } }
    bf16x8 qr[4];
    #pragma unroll
    for(int d0=0;d0<4;++d0)qr[d0]=*reinterpret_cast<const bf16x8*>(&u.Q[(long)qrow*DM+d0*16+hi*8]);
    float mhat=0.f,l_reg=0.f; f32x16 o[2]; o[0]=f32x16{}; o[1]=f32x16{}; float zz_=0.f; asm volatile("":"+v"(zz_)); f32x16 negm;
    _Pragma("unroll") for(int r=0;r<16;++r)negm[r]=zz_;
    for(int T=Tlo;T<=Thi;++T){
      f32x16 p0,p1; qkt(p0,p1,shm+BRA_K+T*8192,qr,negm,r32,hi);
      if(masked){ const int db=ql-64*T-4*hi+((MODE==0)?128:0);
        #pragma unroll
        for(int r=0;r<16;++r){ const int d=db-((r&3)+8*(r>>2)); if((unsigned)d>dmax)p0[r]=-INFINITY; if((unsigned)(d-32)>dmax)p1[r]=-INFINITY; } }
      float a=BMX3(p0[0],p0[1],p1[0]),b=BMX3(p0[2],p0[3],p1[1]); a=BMX3(a,p1[2],p1[3]);
      #pragma unroll
      for(int r=4;r<16;r+=4){a=BMX3(a,p0[r],p0[r+1]);b=BMX3(b,p0[r+2],p0[r+3]);a=BMX3(a,p1[r],p1[r+1]);b=BMX3(b,p1[r+2],p1[r+3]);}
      float rm=__builtin_fmaxf(a,b); { auto rr=__builtin_amdgcn_permlane32_swap(__float_as_uint(rm),__float_as_uint(rm),false,false); rm=__builtin_fmaxf(__uint_as_float(rr[0]),__uint_as_float(rr[1])); }
      if(__any(rm>8.f)){ const float dl=(rm>8.f)?rm:0.f; mhat+=dl;
        #pragma unroll
        for(int r=0;r<16;++r){p0[r]-=dl;p1[r]-=dl;}
        #pragma unroll
        for(int r=0;r<16;++r)negm[r]=-mhat;
        const float f=__builtin_amdgcn_exp2f(-dl); l_reg*=f; if(hi==0)wsf[r32]=f;
        asm volatile("s_waitcnt lgkmcnt(0)":::"memory");
        #pragma unroll
        for(int d_=0;d_<2;++d_)
          #pragma unroll
          for(int r=0;r<16;++r)o[d_][r]*=wsf[crow(r,hi)];
        asm volatile("s_waitcnt lgkmcnt(0)":::"memory"); }
      float sacc=0.f;
      #pragma unroll
      for(int r=0;r<16;++r){p0[r]=__builtin_amdgcn_exp2f(p0[r]);p1[r]=__builtin_amdgcn_exp2f(p1[r]);sacc+=p0[r]+p1[r];}
      l_reg+=sacc;
      u32x4 pw0,pw1,pw2,pw3;
      pw0=(u32x4){cvtpk_s(p0[0],p0[1]),cvtpk_s(p0[2],p0[3]),cvtpk_s(p0[4],p0[5]),cvtpk_s(p0[6],p0[7])}; pw1=(u32x4){cvtpk_s(p0[8],p0[9]),cvtpk_s(p0[10],p0[11]),cvtpk_s(p0[12],p0[13]),cvtpk_s(p0[14],p0[15])};
      pw2=(u32x4){cvtpk_s(p1[0],p1[1]),cvtpk_s(p1[2],p1[3]),cvtpk_s(p1[4],p1[5]),cvtpk_s(p1[6],p1[7])}; pw3=(u32x4){cvtpk_s(p1[8],p1[9]),cvtpk_s(p1[10],p1[11]),cvtpk_s(p1[12],p1[13]),cvtpk_s(p1[14],p1[15])};
      SBAR(); pv(o,vbl+T*8192,__builtin_bit_cast(bf16x8,pw0),__builtin_bit_cast(bf16x8,pw1),__builtin_bit_cast(bf16x8,pw2),__builtin_bit_cast(bf16x8,pw3));
    }
    {auto rr=__builtin_amdgcn_permlane32_swap(__float_as_uint(l_reg),__float_as_uint(l_reg),false,false);l_reg=__uint_as_float(rr[0])+__uint_as_float(rr[1]);}
    if(hi==0){ wsf[r32]=l_reg; wsi[r32]=valid?(slot*SEQ+qrow):-1; }
    asm volatile("s_waitcnt lgkmcnt(0)":::"memory");
    if(hi==0&&valid) u.PL[(long)(slot*SEQ+qrow)*8]=mhat+__builtin_amdgcn_logf(l_reg);
    #pragma unroll
    for(int r=0;r<16;++r){ const int orow=crow(r,hi); const float rl=__builtin_amdgcn_rcpf(wsf[orow]); const int dst=wsi[orow];
      if(dst>=0){ bf16*op=u.PO+(long)dst*512+r32; op[0]=__float2bfloat16(o[0][r]*rl); op[32]=__float2bfloat16(o[1][r]*rl); } }
    asm volatile("s_waitcnt lgkmcnt(0)":::"memory");
  }
  asm volatile("s_waitcnt vmcnt(0) lgkmcnt(0)\n\ts_barrier":::"memory");
}
#undef BMX3
#undef SBAR
#undef WAIT_BAR
}


constexpr int NWAVES = 8;
#ifndef MK_N_LAUNCHES
#define MK_N_LAUNCHES 1
#endif
constexpr int N_PHASES = 24;
static_assert(MK_N_LAUNCHES == 1 || MK_N_LAUNCHES == N_PHASES, "MK_N_LAUNCHES is 1 or 24");

constexpr int S_ = 16384, DM_ = 2048, INW = 6144, NEXP = 16, DEXP = 1024, DEPTH = 2, NROWBLK = 256  ;
constexpr int C_QA = 0, C_KA = 512, C_VA = 1024, C_QB = 1536, C_KB = 2048, C_VB = 2560, C_QC = 3072, C_KC = 4096, C_VC = 5120;
constexpr int MAXPOS = 2 * S_ + NEXP * 256;
constexpr float RMS_EPS = 1e-6f;
#ifndef PROJ_FP8
#define PROJ_FP8 0
#endif
#ifndef OUT_FP8
#define OUT_FP8 0
#endif
constexpr float WSC_K2048 = 64.f, WSC_K1024 = 32.f, MSCALE = 4.f  , ASCALE = 2.f  ;

constexpr size_t MiB = 1u << 20;
constexpr size_t WS_CTL = 0, CTL_ZERO_BYTES = 1 * MiB;
constexpr size_t WS_MOD = 1 * MiB;
constexpr size_t WS_COS = 2 * MiB, WS_SIN = 4 * MiB;
constexpr size_t WS_EID = 6 * MiB;
constexpr size_t WS_WTS = WS_EID + 131072;
constexpr size_t WS_ROWTOK = WS_WTS + 131072;
constexpr size_t WS_ROWW = WS_ROWTOK + 163840;
constexpr size_t WS_CNT = WS_ROWW + 163840;
constexpr size_t WS_KMEAN = 8 * MiB;
constexpr size_t WS_WIN = 16 * MiB;
constexpr size_t WS_WOUT = 64 * MiB;
constexpr size_t WS_WGU = 80 * MiB;
constexpr size_t WS_WDN = 336 * MiB;
constexpr size_t WS_H = 464 * MiB;
constexpr size_t WS_PROJ = 528 * MiB;
constexpr size_t WS_MERGED = 720 * MiB;
constexpr size_t WS_T = 784 * MiB;
constexpr size_t WS_ACT = 912 * MiB;
constexpr size_t WS_XS = 984 * MiB;
constexpr size_t WS_POA = WS_ACT;
constexpr size_t WS_POB = WS_POA + 48 * MiB;
constexpr size_t WS_PLA = WS_POB + 64 * MiB;
constexpr size_t WS_PLB = WS_PLA + 2 * MiB;
constexpr size_t WS_LIST = WS_PLB + 2 * MiB;
static_assert(WS_LIST + 32 * MiB <= 1128 * MiB, "partials and lists inside the MoE-only regions");
constexpr size_t WS_Y = WS_PROJ;
constexpr size_t WS_END = 1128 * MiB;
static_assert(WS_XS + (size_t)MAXPOS * 2048 * 2 <= WS_END && WS_ACT + (size_t)MAXPOS * 1024 * 2 <= WS_XS && WS_CNT + 16384 <= WS_KMEAN, "d_ws map");
constexpr int CW_TMO = 0, CW_CODE = 1, CW_BAR = 4096;
constexpr int CW_CNTB = 8192;
constexpr int CW_QUEUE = 8192 + 1024;

constexpr int RING_OFF = 0, RING_BYTES = 131072;
constexpr int LDSCTL_OFF = RING_BYTES, MISC_OFF = LDSCTL_OFF + 320;
constexpr int LT_SEGS = LDSCTL_OFF + 1024;
constexpr int LT_TOT = LT_SEGS + 128;
constexpr int LT_BASE = LT_TOT + 64;
constexpr int LT_CNT = LT_BASE + 64;
constexpr int LT_P2E = LT_CNT + 64;
constexpr int LT_POS = LT_P2E + 160;
constexpr int LDS_BYTES = 147456;
constexpr int ATT_KM_OFF = 0;
constexpr int ATT_UST_OFF = 106496, ATT_QN_OFF = ATT_UST_OFF + 2304;
static_assert(LT_POS + 512 <= LDS_BYTES && attn_body::ATTN_LDS_BYTES <= ATT_UST_OFF && attn_body::X_LDS_BYTES <= ATT_UST_OFF && attn_body::BRA_LDS_BYTES <= ATT_UST_OFF && ATT_QN_OFF + 64 <= RING_BYTES, "LDS map");

#define GAS __attribute__((address_space(1)))
#define LAS __attribute__((address_space(3)))
typedef unsigned short bf16;
typedef unsigned v4u __attribute__((ext_vector_type(4)));
typedef unsigned v2u __attribute__((ext_vector_type(2)));
typedef float f32x4 __attribute__((ext_vector_type(4)));
typedef short bf16x8 __attribute__((ext_vector_type(8)));
typedef GAS unsigned gu32;
#define RLX_AGENT __ATOMIC_RELAXED, __HIP_MEMORY_SCOPE_AGENT
#define LDS_WAIT() asm volatile("s_waitcnt lgkmcnt(0)" ::: "memory")
__device__ __forceinline__ unsigned f2bf(float f) { unsigned u = __builtin_bit_cast(unsigned, f); return (u + 0x7fffu + ((u >> 16) & 1u)) >> 16; }
__device__ __forceinline__ unsigned pk2(float lo, float hi) { return f2bf(lo) | (f2bf(hi) << 16); }
__device__ __forceinline__ float bflo(unsigned w) { return __builtin_bit_cast(float, w << 16); }
__device__ __forceinline__ float bfhi(unsigned w) { return __builtin_bit_cast(float, w & 0xffff0000u); }
__device__ __forceinline__ float shx(float v, int o, int lane) { return __builtin_bit_cast(float, __builtin_amdgcn_ds_bpermute((lane ^ o) << 2, __builtin_bit_cast(int, v))); }
__device__ __forceinline__ int shup_i(int v, int o, int lane) { return __builtin_amdgcn_ds_bpermute(((lane - o) & 63) << 2, v); }
__device__ __forceinline__ float wave_sum(float v, int lane) {
#pragma unroll
    for (int o = 1; o < 64; o <<= 1) v += shx(v, o, lane);
    return v;
}

#define XB_TMO      128
#define XB_XCNT(j)  (256  + 64 * (j))
#define XB_XSUB(j)  (1280 + 64 * (j))
#define XB_XGEN(j)  (2304 + 64 * (j))
#define XB_TOP      3328
#define XB_TOPGEN   3392
#define XCD_BAR_WORDS 3456
#define XB_SPIN_CAP (1u << 18)

__device__ __forceinline__ unsigned xb_ld(unsigned* p)              { return __hip_atomic_load(p, __ATOMIC_RELAXED, __HIP_MEMORY_SCOPE_AGENT); }
__device__ __forceinline__ unsigned xb_add(unsigned* p, unsigned v) { return __hip_atomic_fetch_add(p, v, __ATOMIC_RELAXED, __HIP_MEMORY_SCOPE_AGENT); }
__device__ __forceinline__ unsigned xb_xcc_id() { return (unsigned)__builtin_amdgcn_s_getreg((3 << 11) | 20) & 0xFu; }
#define XB_SPIN(cond, bar) do { unsigned _sp = 0; while (cond) { __builtin_amdgcn_s_sleep(1); \
    if ((++_sp & 255u) == 0u) { if (xb_ld(&(bar)[XB_TMO])) break; if (_sp > XB_SPIN_CAP) { atomicAdd(&(bar)[XB_TMO], 1u); break; } } } } while (0)

struct XcdBarrier {
    unsigned* bar; unsigned x;
    volatile LAS unsigned* st;
};

__device__ __forceinline__ XcdBarrier xcd_barrier_post(unsigned* bar, volatile LAS unsigned* st) {
    XcdBarrier b; b.bar = bar; b.x = xb_xcc_id(); b.st = st;
    if (threadIdx.x == 0) (void)xb_add(&bar[XB_XCNT(b.x)], 1u);
    return b;
}
__device__ __forceinline__ void xcd_barrier_complete(unsigned* bar, unsigned x, unsigned& nloc, unsigned& nx) {
    const unsigned G = gridDim.x * gridDim.y * gridDim.z;
    unsigned sum, cnt, mine, sp = 0u;
    for (;;) {
        sum = 0u; cnt = 0u; mine = 0u;
#pragma unroll
        for (unsigned j = 0; j < 16; ++j) { const unsigned c = xb_ld(&bar[XB_XCNT(j)]); sum += c; cnt += (c > 0u) ? 1u : 0u; mine = (j == x) ? c : mine; }
        if (sum == G) break;
        __builtin_amdgcn_s_sleep(1);
        if ((++sp & 255u) == 0u) { if (xb_ld(&bar[XB_TMO])) break; if (sp > XB_SPIN_CAP) { atomicAdd(&bar[XB_TMO], 1u); break; } }
    }
    nloc = mine > 0u ? mine : 1u; nx = cnt > 0u ? cnt : 1u;
}

__device__ __forceinline__ void xcd_barrier(const XcdBarrier& b) {
    asm volatile("s_waitcnt vmcnt(0)" ::: "memory");
    __syncthreads();
    if (threadIdx.x == 0) {
        unsigned* bar = b.bar; asm volatile("" : "+s"(bar)); unsigned bx_ = b.x; asm volatile("" : "+s"(bx_));
        __builtin_amdgcn_s_waitcnt(0);
        unsigned nloc = b.st[0], nx = b.st[1];
        if (nloc == 0u) { xcd_barrier_complete(bar, bx_, nloc, nx); b.st[0] = nloc; b.st[1] = nx; }
        const unsigned old = xb_add(&bar[XB_XSUB(bx_)], 1u);
        const unsigned gen = old / nloc;
        if (old + 1u == (gen + 1u) * nloc) {
            __builtin_amdgcn_fence(__ATOMIC_RELEASE, "agent");
            asm volatile("s_waitcnt vmcnt(0)" ::: "memory");
            const unsigned og = xb_add(&bar[XB_TOP], 1u);
            const unsigned tg = og / nx;
            if (og + 1u == (tg + 1u) * nx) xb_add(&bar[XB_TOPGEN], 1u);
            else XB_SPIN(xb_ld(&bar[XB_TOPGEN]) == tg, bar);
            __builtin_amdgcn_fence(__ATOMIC_ACQUIRE, "agent");
            xb_add(&bar[XB_XGEN(bx_)], 1u);
            asm volatile("s_waitcnt vmcnt(0)" ::: "memory");
        } else {
            XB_SPIN(xb_ld(&bar[XB_XGEN(bx_)]) == gen, bar);
            __builtin_amdgcn_fence(__ATOMIC_ACQUIRE, "agent");
            asm volatile("s_waitcnt vmcnt(0)" ::: "memory");
        }
    }
    __syncthreads();
}


__device__ __forceinline__ int dest_row(int map, int n) {
    if (map == 1) { const int seg = n >> 9; const bool qk = (seg == 0) || (seg == 1) || (seg == 3) || (seg == 4) || (seg >= 6 && seg <= 9); if (!qk) return n; const int j = n & 63; return (n & ~63) + ((j < 32) ? 2 * j : 2 * (j - 32) + 1); }
    if (map == 2) return 8 * (n >> 2) + (n & 3);
    if (map == 3) return 8 * (n >> 2) + 4 + (n & 3);
    return n;
}
__device__ __forceinline__ void p0_transpose_item(const float* W, int K, int N, unsigned char* WT, int map, float wscale, LAS float* scr, int item, int lane) {
    const int nblk = N / 32, kb = item / nblk, nb = item % nblk, k0 = 64 * kb, n0 = 32 * nb;
#pragma unroll 8
    for (int i = 0; i < 32; ++i) { const int kk = 2 * i + (lane >> 5); scr[kk * 33 + (lane & 31)] = W[(size_t)(k0 + kk) * N + n0 + (lane & 31)] * wscale; }
    LDS_WAIT(); asm volatile("" ::: "memory");
    const int c = lane & 3;
#pragma unroll
    for (int j = 0; j < 2; ++j) { const int n = (lane >> 2) + 16 * j; const LAS float* sp = scr + (16 * c) * 33 + n;
        v4u o; o.x = pg8::pk4_fp8(sp[0 * 33], sp[1 * 33], sp[2 * 33], sp[3 * 33]); o.y = pg8::pk4_fp8(sp[4 * 33], sp[5 * 33], sp[6 * 33], sp[7 * 33]);
        o.z = pg8::pk4_fp8(sp[8 * 33], sp[9 * 33], sp[10 * 33], sp[11 * 33]); o.w = pg8::pk4_fp8(sp[12 * 33], sp[13 * 33], sp[14 * 33], sp[15 * 33]);
        *(GAS v4u*)(WT + (size_t)dest_row(map, n0 + n) * K + k0 + 16 * c) = o; }
    LDS_WAIT(); asm volatile("" ::: "memory");
}

__device__ __forceinline__ void p0_transpose_item16(const float* W, int K, int N, bf16* WT, int map, LAS float* scr, int item, int lane) {
    const int nblk = N / 32, kb = item / nblk, nb = item % nblk, k0 = 64 * kb, n0 = 32 * nb;
#pragma unroll 8
    for (int i = 0; i < 32; ++i) { const int kk = 2 * i + (lane >> 5); scr[kk * 33 + (lane & 31)] = W[(size_t)(k0 + kk) * N + n0 + (lane & 31)]; }
    LDS_WAIT(); asm volatile("" ::: "memory");
    const int c = lane & 7;
#pragma unroll
    for (int j = 0; j < 4; ++j) { const int n = (lane >> 3) + 8 * j; const LAS float* sp = scr + (8 * c) * 33 + n;
        v4u o; o.x = pk2(sp[0 * 33], sp[1 * 33]); o.y = pk2(sp[2 * 33], sp[3 * 33]); o.z = pk2(sp[4 * 33], sp[5 * 33]); o.w = pk2(sp[6 * 33], sp[7 * 33]);
        *(GAS v4u*)(WT + (size_t)dest_row(map, n0 + n) * K + k0 + 8 * c) = o; }
    LDS_WAIT(); asm volatile("" ::: "memory");
}

struct Args { const void* in[20]; float* out; unsigned char* ws; int ph_lo, ph_hi; };

__global__ void __launch_bounds__(NWAVES * 64, 2) fwd(Args args) {
    extern __shared__ __attribute__((aligned(16))) unsigned char lds[];
    LAS unsigned char* const L = (LAS unsigned char*)lds;
    const int kG = gridDim.x, kbx = blockIdx.x;
    const int kwave = __builtin_amdgcn_readfirstlane((int)threadIdx.x >> 6);
    typedef __attribute__((address_space(4))) const Args* kargp_t;
#define PHASE_BEGIN() \
    kargp_t ka = (kargp_t)__builtin_amdgcn_kernarg_segment_ptr(); asm volatile("" : "+s"(ka)); \
    unsigned char* const ws = ka->ws; \
    int lane; asm volatile("v_mbcnt_lo_u32_b32 %0, -1, 0\n\tv_mbcnt_hi_u32_b32 %0, -1, %0" : "=v"(lane)); \
    int G = kG, bx = kbx, wave_s = kwave; asm volatile("" : "+s"(G), "+s"(bx), "+s"(wave_s));     \
    const int vcu = (G % 8 == 0) ? (bx % 8) * (G / 8) + bx / 8 : bx; const int NGW = G * NWAVES; \
    const int wave = wave_s; const int tid = wave * 64 + lane; const int gw = vcu * NWAVES + wave; (void)gw; (void)lane; (void)ws; (void)tid; (void)NGW
#define KIN(T, k) ((const T*)ka->in[k])
    LAS int* const segs = (LAS int*)(L + LT_SEGS); LAS int* const tot = (LAS int*)(L + LT_TOT); LAS int* const basee = (LAS int*)(L + LT_BASE); LAS int* const cnt16 = (LAS int*)(L + LT_CNT);
    LAS unsigned char* const p2e = L + LT_P2E; LAS int* const postab = (LAS int*)(L + LT_POS);
    gu32* const ctl = (gu32*)(args.ws + WS_CTL);

    for (int u = threadIdx.x; u < (LDS_BYTES - LDSCTL_OFF) / 4; u += NWAVES * 64) ((LAS unsigned*)(L + LDSCTL_OFF))[u] = 0u;
    __syncthreads();
    const int lo = args.ph_lo, hi = args.ph_hi;
    XcdBarrier bar; bar.bar = (unsigned*)(ctl + CW_BAR); bar.x = 0; bar.st = nullptr;
    if (hi - lo > 1) bar = xcd_barrier_post((unsigned*)(ctl + CW_BAR), (volatile LAS unsigned*)(L + MISC_OFF) + 8);
#ifndef PHMASK
#define PHMASK 0x1fff
#endif
#define IN(k) (lo <= (k) && (k) < hi)
#define INJ(j) ((((PHMASK) >> (j)) & 1) && IN(pb + (j)))
#ifndef REPEAT_J
#define REPEAT_J (-1)
#endif
#ifndef REPEAT_L
#define REPEAT_L 0
#endif
#ifndef REPEAT_N
#define REPEAT_N 2
#endif
#define REPS(j) ((REPEAT_J == (j) && l == REPEAT_L) ? REPEAT_N : 1)
#define SEAM(k) do { if (IN(k) && IN((k) + 1)) xcd_barrier(bar); } while (0)

#define COMPUTE_SEGMENTS(myrb) do { \
        _Pragma("unroll") for (int q_ = 0; q_ < 2; ++q_) { const int e_ = 2 * wave + q_; int t_ = 0, p_ = 0; \
            _Pragma("unroll") for (int j_ = 0; j_ < 4; ++j_) { const int rb_ = lane + 64 * j_; const int c_ = CNT[rb_ * 16 + e_]; t_ += c_; p_ += (rb_ < (myrb)) ? c_ : 0; } \
            t_ = (int)wave_sum((float)t_, lane); p_ = (int)wave_sum((float)p_, lane); if (lane == 0) { tot[e_] = t_; basee[e_] = p_; } } \
        __syncthreads(); \
        if (tid == 0) { int s_ = 0; for (int e_ = 0; e_ < 16; ++e_) { segs[e_] = s_; s_ += (tot[e_] + 255) & ~255; } segs[16] = s_; } \
        __syncthreads(); \
        if (tid < 160) { const int r_ = tid * 256; int e_ = 0; for (int k_ = 1; k_ < 16; ++k_) if (r_ >= segs[k_]) e_ = k_; p2e[tid] = (unsigned char)e_; } \
        if (tid < 16) basee[tid] += segs[tid]; \
        __syncthreads(); } while (0)

    if (((PHMASK >> 11) & 1) && IN(0)) for (int rp = 0; rp < ((REPEAT_J == 11) ? REPEAT_N : 1); ++rp) {
        PHASE_BEGIN();
        const float* const c_in = KIN(float, 1); const int* const positions = KIN(int, 2); const float* const w_ada = KIN(float, 3); const float* const b_ada = KIN(float, 4);
        const float* const w_in = KIN(float, 7); const float* const w_out = KIN(float, 8); const float* const w_gate = KIN(float, 14); const float* const w_up = KIN(float, 15); const float* const w_down = KIN(float, 16);
        float* const MOD = (float*)(ws + WS_MOD); float* const COS = (float*)(ws + WS_COS); float* const SIN = (float*)(ws + WS_SIN);
        unsigned char* const WIN = ws + WS_WIN; unsigned char* const WOUT = ws + WS_WOUT; unsigned char* const WGU = ws + WS_WGU; unsigned char* const WDN = ws + WS_WDN;
        for (int it = bx; it < 96; it += G) {
            const int l = it / 48, cg = it % 48, col = cg * 256 + lane * 4;
            const float* W = w_ada + ((size_t)l * 2048 + wave * 256) * 12288 + col; const float* cc = c_in + wave * 256;
            f32x4 a = (f32x4){0.f, 0.f, 0.f, 0.f};
#pragma unroll 8
            for (int k = 0; k < 256; ++k) { const float cv = cc[k]; const float sv = cv / (1.f + expf(-cv)); a += sv * *(const GAS f32x4*)(W + (size_t)k * 12288); }
            LAS f32x4* red = (LAS f32x4*)L; red[wave * 64 + lane] = a;
            __syncthreads();
            if (tid < 256) { float s = 0.f; const LAS float* rf = (const LAS float*)L;
#pragma unroll
                for (int w = 0; w < 8; ++w) s += rf[(w * 64 + (tid >> 2)) * 4 + (tid & 3)];
                MOD[l * 12288 + cg * 256 + tid] = s + b_ada[l * 12288 + cg * 256 + tid]; }
            __syncthreads();
        }
        { LAS float* scr = (LAS float*)(L + RING_OFF + wave * 16384);
          constexpr int I_IN = 2 * 32 * 192, I_OUT = 2 * 32 * 64, I_G = 32 * 32 * 32, I_D = 32 * 16 * 64, NITEMS = I_IN + I_OUT + 2 * I_G + I_D;
          for (int it = gw; it < NITEMS; it += NGW) {
              int r = it;
              if (r < I_IN) { const int l = r / 6144;
                  if (PROJ_FP8) p0_transpose_item(w_in + (size_t)l * 2048 * 6144, 2048, 6144, WIN + (size_t)l * 6144 * 2048, 1, WSC_K2048, scr, r % 6144, lane);
                  else p0_transpose_item16(w_in + (size_t)l * 2048 * 6144, 2048, 6144, (bf16*)WIN + (size_t)l * 6144 * 2048, 1, scr, r % 6144, lane);
                  continue; } r -= I_IN;
              if (r < I_OUT) { const int l = r / 2048;
                  if (OUT_FP8) p0_transpose_item(w_out + (size_t)l * 2048 * 2048, 2048, 2048, WOUT + (size_t)l * 2048 * 2048, 0, WSC_K2048, scr, r % 2048, lane);
                  else p0_transpose_item16(w_out + (size_t)l * 2048 * 2048, 2048, 2048, (bf16*)WOUT + (size_t)l * 2048 * 2048, 0, scr, r % 2048, lane);
                  continue; } r -= I_OUT;
              if (r < I_G) { const int mt = r / 1024; p0_transpose_item(w_gate + (size_t)mt * 2048 * 1024, 2048, 1024, WGU + (size_t)mt * 2048 * 2048, 2, WSC_K2048, scr, r % 1024, lane); continue; } r -= I_G;
              if (r < I_G) { const int mt = r / 1024; p0_transpose_item(w_up + (size_t)mt * 2048 * 1024, 2048, 1024, WGU + (size_t)mt * 2048 * 2048, 3, WSC_K2048, scr, r % 1024, lane); continue; } r -= I_G;
              { const int mt = r / 1024; p0_transpose_item(w_down + (size_t)mt * 1024 * 2048, 1024, 2048, WDN + (size_t)mt * 2048 * 1024, 0, WSC_K1024, scr, r % 1024, lane); }
          } }
        for (int idx = (vcu * NWAVES * 64 + tid); idx < S_ * 32; idx += G * NWAVES * 64) {
            const int pi = idx >> 5, i = idx & 31; const float inv = (float)exp2(-(double)i * (13.287712379549449 / 32.0)); const float ang = (float)positions[pi] * inv;
            COS[idx] = (float)cos((double)ang); SIN[idx] = (float)sin((double)ang); }
    }
    SEAM(0);

    for (int l = 0; l < DEPTH; ++l) {
        const int pb = 1 + 11 * l;
        const float lam_init = (l == 0) ? 0.2f : 0.35550906759f;
        if (INJ(0)) for (int rp = 0; rp < REPS(0); ++rp) {
            PHASE_BEGIN();
            const float* const x_in = KIN(float, 0); const float* const g_attn = KIN(float, 5); float* const xbuf = ka->out;
            const float* const MOD = (const float*)(ws + WS_MOD); const float* const mod = MOD + l * 12288; unsigned char* const HB = ws + WS_H; const bf16* const YB = (const bf16*)(ws + WS_Y);
            f32x4 cA[8], cB[8], cG[8];
#pragma unroll
            for (int j = 0; j < 8; ++j) { const int c4 = lane + 64 * j; const f32x4 g = ((const f32x4*)(g_attn + l * 2048))[c4]; const f32x4 sc = ((const f32x4*)(mod + 2048))[c4];
                cA[j] = g * (1.f + sc); cB[j] = ((const f32x4*)(mod + 0))[c4]; cG[j] = (l > 0) ? ((const f32x4*)(MOD + (l - 1) * 12288 + 10240))[c4] : (f32x4){0.f, 0.f, 0.f, 0.f}; }
            const float* xsrc = (l == 0) ? x_in : xbuf;
            for (int row = gw; row < S_; row += NGW) {
                f32x4 v[8];
#pragma unroll
                for (int j = 0; j < 8; ++j) v[j] = ((const GAS f32x4*)(xsrc + (size_t)row * 2048))[lane + 64 * j];
                if (l > 0) {
#pragma unroll
                    for (int j = 0; j < 8; ++j) { const v2u a = ((const GAS v2u*)(YB + (size_t)(2 * row) * 2048))[lane + 64 * j], b = ((const GAS v2u*)(YB + (size_t)(2 * row + 1) * 2048))[lane + 64 * j];
                        const f32x4 ys = (f32x4){bflo(a.x) + bflo(b.x), bfhi(a.x) + bfhi(b.x), bflo(a.y) + bflo(b.y), bfhi(a.y) + bfhi(b.y)};
                        v[j] += cG[j] * ys; ((GAS f32x4*)(xbuf + (size_t)row * 2048))[lane + 64 * j] = v[j]; }
                }
                float ss = 0.f;
#pragma unroll
                for (int j = 0; j < 8; ++j) ss += (v[j].x * v[j].x + v[j].y * v[j].y) + (v[j].z * v[j].z + v[j].w * v[j].w);
                const float rs = 1.f / sqrtf(wave_sum(ss, lane) * (1.f / 2048.f) + RMS_EPS);
#pragma unroll
                for (int j = 0; j < 8; ++j) { const f32x4 o = v[j] * rs * cA[j] + cB[j];
                    if (PROJ_FP8) ((GAS unsigned*)(HB + (size_t)row * 2048))[lane + 64 * j] = pg8::pk4_fp8(o.x, o.y, o.z, o.w);
                    else { v2u w; w.x = pk2(o.x, o.y); w.y = pk2(o.z, o.w); ((GAS v2u*)((bf16*)HB + (size_t)row * 2048))[lane + 64 * j] = w; } }
            }
        }
        SEAM(pb + 0);
        if (INJ(1)) for (int rp = 0; rp < REPS(1); ++rp) {
            PHASE_BEGIN();
            unsigned char* const HB = ws + WS_H; unsigned char* const WIN = ws + WS_WIN; bf16* const PROJ = (bf16*)(ws + WS_PROJ); const float* const COS = (const float*)(ws + WS_COS); const float* const SIN = (const float*)(ws + WS_SIN);
            constexpr int KBP = PROJ_FP8 ? 2048 : 4096;
            pg8::DenseSched Sd; Sd.init(HB, WIN + (size_t)l * 6144 * KBP, S_, INW, KBP, G, bx);
            pg8::EpiProj E{PROJ, COS, SIN, attn_body::C2, PROJ_FP8 ? 1.f / WSC_K2048 : 1.f};
            pg8::gemm_phase<pg8::EpiProj, pg8::DenseSched, true, true, PROJ_FP8 != 0>(L + RING_OFF, KBP, Sd, E, wave_s);
        }
        SEAM(pb + 1);
        if (INJ(2)) for (int rp = 0; rp < REPS(2); ++rp) {
            PHASE_BEGIN();
            const bf16* const PROJ = (const bf16*)(ws + WS_PROJ); float* const KMEAN = (float*)(ws + WS_KMEAN);
            for (int t = gw; t < 512; t += NGW) { const int h = t >> 6, j = t & 63; const int rg = lane >> 3, ch = lane & 7;
                float a[8];
#pragma unroll
                for (int e = 0; e < 8; ++e) a[e] = 0.f;
                for (int it = 0; it < 32; ++it) { const v4u w = *(const GAS v4u*)(PROJ + (size_t)(256 * j + 8 * it + rg) * 6144 + C_KB + 64 * h + 8 * ch);
                    a[0] += bflo(w.x); a[1] += bfhi(w.x); a[2] += bflo(w.y); a[3] += bfhi(w.y); a[4] += bflo(w.z); a[5] += bfhi(w.z); a[6] += bflo(w.w); a[7] += bfhi(w.w); }
#pragma unroll
                for (int e = 0; e < 8; ++e) { a[e] += shx(a[e], 8, lane); a[e] += shx(a[e], 16, lane); a[e] += shx(a[e], 32, lane); }
                if (lane < 8) {
#pragma unroll
                    for (int e = 0; e < 8; ++e) KMEAN[(size_t)(h * 64 + j) * 64 + 8 * lane + e] = a[e] * (1.f / 256.f); }
            }
        }
        SEAM(pb + 2);
        if (INJ(3)) for (int rp = 0; rp < REPS(3); ++rp) {
            PHASE_BEGIN();
            const bf16* const PROJ = (const bf16*)(ws + WS_PROJ); const float* const KMEAN = (const float*)(ws + WS_KMEAN); int* const LISTB = (int*)(ws + WS_LIST);
            int* const CNTB = (int*)(ctl + CW_CNTB + l * 512);
            for (int it = vcu; it < 512; it += G) { const int hd = it & 7, qq = it >> 3, qb = (qq & 1) ? 63 - (qq >> 1) : (qq >> 1);
                if (qb == 0) continue;
                LAS float* km = (LAS float*)(L + ATT_KM_OFF);
                __syncthreads();
                for (int k4 = tid; k4 < qb * 16; k4 += NWAVES * 64) ((LAS f32x4*)km)[k4] = ((const GAS f32x4*)(KMEAN + (size_t)hd * 64 * 64))[k4];
                const int q = tid >> 1, dh = tid & 1; float qf[32];
                { const bf16* qrow = PROJ + (size_t)(qb * 256 + q) * 6144 + C_QB + hd * 64 + dh * 32;
#pragma unroll
                  for (int c8 = 0; c8 < 4; ++c8) { const v4u w = *(const GAS v4u*)(qrow + 8 * c8); qf[8 * c8 + 0] = bflo(w.x); qf[8 * c8 + 1] = bfhi(w.x); qf[8 * c8 + 2] = bflo(w.y); qf[8 * c8 + 3] = bfhi(w.y);
                      qf[8 * c8 + 4] = bflo(w.z); qf[8 * c8 + 5] = bfhi(w.z); qf[8 * c8 + 6] = bflo(w.w); qf[8 * c8 + 7] = bfhi(w.w); } }
                __syncthreads();
                float b0 = -INFINITY, b1 = -INFINITY, b2 = -INFINITY; int i0 = -1, i1 = -1, i2 = -1;
                for (int j = 0; j < qb; ++j) { const LAS f32x4* kr = (const LAS f32x4*)(km + j * 64 + dh * 32); float g = 0.f;
#pragma unroll
                    for (int c4 = 0; c4 < 8; ++c4) { const f32x4 kv = kr[c4]; g = fmaf(qf[4 * c4 + 0], kv.x, g); g = fmaf(qf[4 * c4 + 1], kv.y, g); g = fmaf(qf[4 * c4 + 2], kv.z, g); g = fmaf(qf[4 * c4 + 3], kv.w, g); }
                    g += shx(g, 1, lane);
                    if (g > b0) { b2 = b1; i2 = i1; b1 = b0; i1 = i0; b0 = g; i0 = j; } else if (g > b1) { b2 = b1; i2 = i1; b1 = g; i1 = j; } else if (g > b2) { b2 = g; i2 = j; } }
                if (dh == 0) { const int row = qb * 256 + q;
                    if (i0 >= 0) { const int p = __hip_atomic_fetch_add(CNTB + hd * 64 + i0, 1, RLX_AGENT); LISTB[(size_t)(hd * 64 + i0) * 16384 + p] = row; }
                    if (i1 >= 0) { const int p = __hip_atomic_fetch_add(CNTB + hd * 64 + i1, 1, RLX_AGENT); LISTB[(size_t)(hd * 64 + i1) * 16384 + p] = row | (1 << 16); }
                    if (i2 >= 0) { const int p = __hip_atomic_fetch_add(CNTB + hd * 64 + i2, 1, RLX_AGENT); LISTB[(size_t)(hd * 64 + i2) * 16384 + p] = row | (2 << 16); } }
            }
        }
        SEAM(pb + 3);
        if (INJ(4)) for (int rp = 0; rp < REPS(4); ++rp) {
            PHASE_BEGIN();
            const bf16* const PROJ = (const bf16*)(ws + WS_PROJ); float* const TB = (float*)(ws + WS_T);
            char* const shm = (char*)lds + RING_OFF;
#if !defined(NO_ATT_C)
#if defined(REPEAT_SKIP_C)
            if (rp == 0)
#endif
            for (int vc = vcu; vc < 256; vc += G) {
                const int st = vc >> 4, hd = st >> 1, mp = st & 1, s = vc & 15;
                const attn_body::bf16* Qp = (const attn_body::bf16*)PROJ + C_QC + hd * 128 + mp * 64; const attn_body::bf16* Kp = (const attn_body::bf16*)PROJ + C_KC + hd * 128 + mp * 64;
                const attn_body::bf16* Vp = (const attn_body::bf16*)PROJ + C_VC + hd * 128; float* Op = TB + (size_t)mp * S_ * 1024 + hd * 128;
                for (int i = 3; i >= 0; --i) { const int qb = 32 * (i >> 1) + ((i & 1) ? 31 - s : s);
                    attn_body::attn_unit128<8>(qb, Qp, Kp, Vp, Op, 1024, shm, wave_s); }
            }
#endif
            { int t2; asm volatile("v_mbcnt_lo_u32_b32 %0, -1, 0\n\tv_mbcnt_hi_u32_b32 %0, -1, %0" : "=v"(t2)); t2 += wave_s * 64;
              LAS int* const ust = (LAS int*)(L + ATT_UST_OFF); LAS int* const wtot = ust + 520; LAS int* const qn = (LAS int*)(L + ATT_QN_OFF);
              const int* const CNTB = (const int*)(ctl + CW_CNTB + l * 512);
              const int nl = CNTB[t2]; const int nch = (8 + ((nl + 31) >> 5) + 15) >> 4;
              int inc = nch;
#pragma unroll
              for (int o = 1; o < 64; o <<= 1) { const int v = shup_i(inc, o, t2 & 63); if ((t2 & 63) >= o) inc += v; }
              if ((t2 & 63) == 63) wtot[t2 >> 6] = inc;
              __syncthreads();
              int pre = 0;
              for (int w = 0; w < (t2 >> 6); ++w) pre += wtot[w];
              ust[t2 + 1] = pre + inc; if (t2 == 0) ust[0] = 0;
              __syncthreads();
              const int nB = ust[512], nU = nB + 1536;
              gu32* const qhead = ctl + CW_QUEUE + 64 * (l + 2 * rp);
              for (;;) {
                  if (t2 == 0) qn[0] = (int)__hip_atomic_fetch_add(qhead, 1u, RLX_AGENT);
                  __syncthreads();
                  const int u = __builtin_amdgcn_readfirstlane(qn[0]);
                  __syncthreads();
                  if (u >= nU) break;
                  attn_body::BraUnit U;
                  if (u < nB) {
                      int lo_ = 0, hi_ = 512;
                      while (hi_ - lo_ > 1) { const int mid = (lo_ + hi_) >> 1; if (ust[mid] <= u) lo_ = mid; else hi_ = mid; }
                      const int hj = lo_, hd = hj >> 6, jb = hj & 63, c = u - ust[hj]; const int nlist = CNTB[hj]; const int ntile = 8 + ((nlist + 31) >> 5);
                      U.Q = (const attn_body::bf16*)PROJ + C_QB + hd * 64; U.K = (const attn_body::bf16*)PROJ + C_KB + hd * 64; U.V = (const attn_body::bf16*)PROJ + C_VB + hd * 64;
                      U.PO = (attn_body::bf16*)(ws + WS_POB) + hd * 64; U.PL = (float*)(ws + WS_PLB) + hd;
                      U.kbase = 256 * jb; U.kstride = 1; U.t_first = 0; U.nkt = 4; U.nqt = (ntile - 16 * c) < 16 ? (ntile - 16 * c) : 16;
                      U.qbase = 0; U.qstride = 0; U.slotA = 0; U.list = (const int*)(ws + WS_LIST) + (size_t)hj * 16384; U.nlist = nlist; U.tile0 = 16 * c; U.ownrow0 = 256 * jb;
                      attn_body::bra_unit<1>(U, shm, wave_s);
                  } else {
                      const int a = u - nB, hd = a / 192, r = a % 192, pt = r >> 6, w6 = r & 63; const int dil = (pt == 0) ? 1 : (pt == 1) ? 4 : 16;
                      const int nblk = 64 / dil, rho = w6 / nblk, ib = w6 % nblk;
                      U.Q = (const attn_body::bf16*)PROJ + C_QA + hd * 64; U.K = (const attn_body::bf16*)PROJ + C_KA + hd * 64; U.V = (const attn_body::bf16*)PROJ + C_VA + hd * 64;
                      U.PO = (attn_body::bf16*)(ws + WS_POA) + hd * 64; U.PL = (float*)(ws + WS_PLA) + hd;
                      U.kbase = rho + dil * (256 * ib - 128); U.kstride = dil; U.t_first = (ib == 0) ? 2 : 0; U.nkt = 6; U.nqt = 8;
                      U.qbase = rho + dil * 256 * ib; U.qstride = dil; U.slotA = pt; U.list = nullptr; U.nlist = 0; U.tile0 = 0; U.ownrow0 = 0;
                      attn_body::bra_unit<0>(U, shm, wave_s);
                  }
              }
            }
        }
        SEAM(pb + 4);
        if (INJ(5)) for (int rp = 0; rp < REPS(5); ++rp) {
            PHASE_BEGIN();
            const float* const lam_q1 = KIN(float, 9); const float* const lam_k1 = KIN(float, 10); const float* const lam_q2 = KIN(float, 11); const float* const lam_k2 = KIN(float, 12); const float* const g_sub = KIN(float, 13);
            const float* const TB = (const float*)(ws + WS_T); unsigned char* const MERGED = ws + WS_MERGED;
            const bf16* const POA = (const bf16*)(ws + WS_POA); const bf16* const POB = (const bf16*)(ws + WS_POB); const float* const PLA = (const float*)(ws + WS_PLA); const float* const PLB = (const float*)(ws + WS_PLB);
            const float d1 = wave_sum(lam_q1[l * 64 + lane] * lam_k1[l * 64 + lane], lane), d2 = wave_sum(lam_q2[l * 64 + lane] * lam_k2[l * 64 + lane], lane);
            const float lam = expf(d1) - expf(d2) + lam_init;
            const f32x4 gs = ((const f32x4*)(g_sub + l * 128))[lane & 31]; const float osc = (1.f - lam_init) * (OUT_FP8 ? MSCALE : 1.f);
            for (int row = gw; row < S_; row += NGW) {
                { float ls[3], mx = -INFINITY;
#pragma unroll
                  for (int sl = 0; sl < 3; ++sl) { ls[sl] = PLA[((size_t)sl * S_ + row) * 8 + (lane >> 3)]; mx = fmaxf(mx, ls[sl]); }
                  float acc[8], wsum = 0.f;
#pragma unroll
                  for (int e = 0; e < 8; ++e) acc[e] = 0.f;
#pragma unroll
                  for (int sl = 0; sl < 3; ++sl) { const float wgt = exp2f(ls[sl] - mx); wsum += wgt; const v4u w = ((const GAS v4u*)(POA + ((size_t)sl * S_ + row) * 512))[lane];
                      acc[0] += wgt * bflo(w.x); acc[1] += wgt * bfhi(w.x); acc[2] += wgt * bflo(w.y); acc[3] += wgt * bfhi(w.y); acc[4] += wgt * bflo(w.z); acc[5] += wgt * bfhi(w.z); acc[6] += wgt * bflo(w.w); acc[7] += wgt * bfhi(w.w); }
                  const float iw = (OUT_FP8 ? MSCALE : 1.f) / wsum;
                  if (OUT_FP8) { v2u o; o.x = pg8::pk4_fp8(acc[0] * iw, acc[1] * iw, acc[2] * iw, acc[3] * iw); o.y = pg8::pk4_fp8(acc[4] * iw, acc[5] * iw, acc[6] * iw, acc[7] * iw); ((GAS v2u*)(MERGED + (size_t)row * 2048))[lane] = o; }
                  else { v4u o; o.x = pk2(acc[0] * iw, acc[1] * iw); o.y = pk2(acc[2] * iw, acc[3] * iw); o.z = pk2(acc[4] * iw, acc[5] * iw); o.w = pk2(acc[6] * iw, acc[7] * iw); ((GAS v4u*)((bf16*)MERGED + (size_t)row * 2048))[lane] = o; } }
                { const int own = row >> 8, nsel = own < 3 ? own : 3; float ls[4], mx = -INFINITY;
#pragma unroll
                  for (int sl = 0; sl < 4; ++sl) { const bool on = (sl == 3) || (sl < nsel); ls[sl] = on ? PLB[((size_t)sl * S_ + row) * 8 + (lane >> 3)] : -INFINITY; mx = fmaxf(mx, ls[sl]); }
                  float acc[8], wsum = 0.f;
#pragma unroll
                  for (int e = 0; e < 8; ++e) acc[e] = 0.f;
#pragma unroll
                  for (int sl = 0; sl < 4; ++sl) { const bool on = (sl == 3) || (sl < nsel);
                      if (on) { const float wgt = exp2f(ls[sl] - mx); wsum += wgt; const v4u w = ((const GAS v4u*)(POB + ((size_t)sl * S_ + row) * 512))[lane];
                          acc[0] += wgt * bflo(w.x); acc[1] += wgt * bfhi(w.x); acc[2] += wgt * bflo(w.y); acc[3] += wgt * bfhi(w.y); acc[4] += wgt * bflo(w.z); acc[5] += wgt * bfhi(w.z); acc[6] += wgt * bflo(w.w); acc[7] += wgt * bfhi(w.w); } }
                  const float iw = (OUT_FP8 ? MSCALE : 1.f) / wsum;
                  if (OUT_FP8) { v2u o; o.x = pg8::pk4_fp8(acc[0] * iw, acc[1] * iw, acc[2] * iw, acc[3] * iw); o.y = pg8::pk4_fp8(acc[4] * iw, acc[5] * iw, acc[6] * iw, acc[7] * iw); ((GAS v2u*)(MERGED + (size_t)row * 2048 + 512))[lane] = o; }
                  else { v4u o; o.x = pk2(acc[0] * iw, acc[1] * iw); o.y = pk2(acc[2] * iw, acc[3] * iw); o.z = pk2(acc[4] * iw, acc[5] * iw); o.w = pk2(acc[6] * iw, acc[7] * iw); ((GAS v4u*)((bf16*)MERGED + (size_t)row * 2048 + 512))[lane] = o; } }
#pragma unroll
                for (int j = 0; j < 4; ++j) { const f32x4 a = ((const GAS f32x4*)(TB + (size_t)row * 1024))[lane + 64 * j], b = ((const GAS f32x4*)(TB + (size_t)(S_ + row) * 1024))[lane + 64 * j];
                    const f32x4 v = a - lam * b; float ss = (v.x * v.x + v.y * v.y) + (v.z * v.z + v.w * v.w);
                    ss += shx(ss, 1, lane); ss += shx(ss, 2, lane); ss += shx(ss, 4, lane); ss += shx(ss, 8, lane); ss += shx(ss, 16, lane);
                    const float rs = 1.f / sqrtf(ss * (1.f / 128.f) + RMS_EPS); const f32x4 o = v * rs * gs * osc;
                    if (OUT_FP8) ((GAS unsigned*)(MERGED + (size_t)row * 2048 + 1024))[lane + 64 * j] = pg8::pk4_fp8(o.x, o.y, o.z, o.w);
                    else { v2u w; w.x = pk2(o.x, o.y); w.y = pk2(o.z, o.w); ((GAS v2u*)((bf16*)MERGED + (size_t)row * 2048 + 1024))[lane + 64 * j] = w; } }
            }
        }
        SEAM(pb + 5);
        if (INJ(6)) for (int rp = 0; rp < REPS(6); ++rp) {
            PHASE_BEGIN();
            const float* const x_in = KIN(float, 0); float* const xbuf = ka->out; const float* const mod = (const float*)(ws + WS_MOD) + l * 12288;
            unsigned char* const MERGED = ws + WS_MERGED; unsigned char* const WOUT = ws + WS_WOUT;
            constexpr int KBO = OUT_FP8 ? 2048 : 4096;
            pg8::DenseSched Sd; Sd.init(MERGED, WOUT + (size_t)l * 2048 * KBO, S_, 2048, KBO, G, bx);
            pg8::EpiGateRes E{(l == 0) ? x_in : (const float*)xbuf, xbuf, mod + 4096, OUT_FP8 ? 1.f / (WSC_K2048 * MSCALE) : 1.f};
            pg8::gemm_phase<pg8::EpiGateRes, pg8::DenseSched, true, true, OUT_FP8 != 0>(L + RING_OFF, KBO, Sd, E, wave_s);
        }
        SEAM(pb + 6);
        if (INJ(7)) for (int rp = 0; rp < REPS(7); ++rp) {
            PHASE_BEGIN();
            const float* const g_mlp = KIN(float, 6); const float* const w_router = KIN(float, 17); const float* const b_router = KIN(float, 18); const float* const xbuf = ka->out;
            const float* const mod = (const float*)(ws + WS_MOD) + l * 12288; unsigned char* const HB = ws + WS_H;
            int* const EID = (int*)(ws + WS_EID); float* const WTS = (float*)(ws + WS_WTS); int* const CNT = (int*)(ws + WS_CNT);
            LAS float* const RW = (LAS float*)L;
            for (int idx = tid; idx < 32768; idx += NWAVES * 64) RW[(idx & 15) * 2048 + (idx >> 4)] = w_router[idx];
            f32x4 cA[8], cB[8];
#pragma unroll
            for (int j = 0; j < 8; ++j) { const int c4 = lane + 64 * j; const f32x4 g = ((const f32x4*)(g_mlp + l * 2048))[c4]; const f32x4 sc = ((const f32x4*)(mod + 8192))[c4];
                cA[j] = g * (1.f + sc); cB[j] = ((const f32x4*)(mod + 6144))[c4]; }
            float br[16];
#pragma unroll
            for (int e = 0; e < 16; ++e) br[e] = b_router[e];
            for (int rb = bx; rb < NROWBLK; rb += G) {
                if (tid < 16) cnt16[tid] = 0;
                __syncthreads();
                for (int i = 0; i < 8; ++i) { const int row = 64 * rb + 8 * wave + i;
                    f32x4 v[8]; float ss = 0.f;
#pragma unroll
                    for (int j = 0; j < 8; ++j) { v[j] = ((const GAS f32x4*)(xbuf + (size_t)row * 2048))[lane + 64 * j]; ss += (v[j].x * v[j].x + v[j].y * v[j].y) + (v[j].z * v[j].z + v[j].w * v[j].w); }
                    const float rs = 1.f / sqrtf(wave_sum(ss, lane) * (1.f / 2048.f) + RMS_EPS);
                    float p[16];
#pragma unroll
                    for (int e = 0; e < 16; ++e) p[e] = 0.f;
#pragma unroll
                    for (int j = 0; j < 8; ++j) { const f32x4 o = v[j] * rs * cA[j] + cB[j]; ((GAS unsigned*)(HB + (size_t)row * 2048))[lane + 64 * j] = pg8::pk4_fp8(o.x, o.y, o.z, o.w);
#pragma unroll
                        for (int e = 0; e < 16; ++e) { const f32x4 w4 = ((const LAS f32x4*)(RW + e * 2048))[lane + 64 * j]; p[e] += (o.x * w4.x + o.y * w4.y) + (o.z * w4.z + o.w * w4.w); } }
#pragma unroll
                    for (int e = 0; e < 16; ++e) p[e] = wave_sum(p[e], lane);
                    float sg[16], sv[16];
#pragma unroll
                    for (int e = 0; e < 16; ++e) { sv[e] = 1.f / (1.f + expf(-p[e])); sg[e] = sv[e] + br[e]; }
                    float gsc[4];
#pragma unroll
                    for (int g4 = 0; g4 < 4; ++g4) { const float a = sg[4 * g4], b = sg[4 * g4 + 1], c = sg[4 * g4 + 2], d = sg[4 * g4 + 3];
                        const float h1 = fmaxf(a, b), l1 = fminf(a, b), h2 = fmaxf(c, d), l2 = fminf(c, d); gsc[g4] = fmaxf(h1, h2) + fmaxf(fminf(h1, h2), fmaxf(l1, l2)); }
                    int gi = 0; float gb = gsc[0];
#pragma unroll
                    for (int g4 = 1; g4 < 4; ++g4) if (gsc[g4] > gb) { gb = gsc[g4]; gi = g4; }
                    float cd[4], cs[4];
#pragma unroll
                    for (int k = 0; k < 4; ++k) { cd[k] = (gi == 0) ? sg[k] : (gi == 1) ? sg[4 + k] : (gi == 2) ? sg[8 + k] : sg[12 + k]; cs[k] = (gi == 0) ? sv[k] : (gi == 1) ? sv[4 + k] : (gi == 2) ? sv[8 + k] : sv[12 + k]; }
                    int l0 = 0; float v0 = cd[0], s0 = cs[0];
#pragma unroll
                    for (int k = 1; k < 4; ++k) if (cd[k] > v0) { v0 = cd[k]; l0 = k; s0 = cs[k]; }
                    int l1i = -1; float v1 = -INFINITY, s1 = 0.f;
#pragma unroll
                    for (int k = 0; k < 4; ++k) if (k != l0 && cd[k] > v1) { v1 = cd[k]; l1i = k; s1 = cs[k]; }
                    const int e0 = 4 * gi + l0, e1 = 4 * gi + l1i; const float wsum = s0 + s1;
                    if (lane == 0) { EID[2 * row] = e0; EID[2 * row + 1] = e1; WTS[2 * row] = s0 / wsum; WTS[2 * row + 1] = s1 / wsum; atomicAdd((int*)(cnt16 + e0), 1); atomicAdd((int*)(cnt16 + e1), 1); }
                }
                __syncthreads();
                if (tid < 16) CNT[rb * 16 + tid] = cnt16[tid];
                __syncthreads();
            }
        }
        SEAM(pb + 7);
        if (INJ(8)) for (int rp = 0; rp < REPS(8); ++rp) {
            PHASE_BEGIN();
            const unsigned char* const HB = ws + WS_H; unsigned char* const XS = ws + WS_XS;
            const int* const EID = (const int*)(ws + WS_EID); const float* const WTS = (const float*)(ws + WS_WTS); int* const ROWTOK = (int*)(ws + WS_ROWTOK); float* const ROWW = (float*)(ws + WS_ROWW); const int* const CNT = (const int*)(ws + WS_CNT);
            for (int rb = bx; rb < NROWBLK; rb += G) {
                COMPUTE_SEGMENTS(rb);
                if (wave == 0) { const int row = 64 * rb + lane; const int e0 = EID[2 * row], e1 = EID[2 * row + 1]; int p0 = 0, p1 = 0;
                    const unsigned long long lt = (1ull << lane) - 1ull;
                    for (int e = 0; e < 16; ++e) { const unsigned long long m0 = __ballot(e0 == e), m1 = __ballot(e1 == e); const int r = __popcll(m0 & lt) + __popcll(m1 & lt);
                        if (e0 == e) p0 = basee[e] + r; if (e1 == e) p1 = basee[e] + r; }
                    postab[2 * lane] = p0; postab[2 * lane + 1] = p1;
                    ROWTOK[p0] = 2 * row; ROWTOK[p1] = 2 * row + 1; ROWW[p0] = WTS[2 * row]; ROWW[p1] = WTS[2 * row + 1]; }
                __syncthreads();
                for (int i = 0; i < 8; ++i) { const int r = 8 * wave + i, row = 64 * rb + r; const int p0 = postab[2 * r], p1 = postab[2 * r + 1];
#pragma unroll
                    for (int c = 0; c < 2; ++c) { const v4u w = ((const GAS v4u*)(HB + (size_t)row * 2048))[lane + 64 * c]; ((GAS v4u*)(XS + (size_t)p0 * 2048))[lane + 64 * c] = w; ((GAS v4u*)(XS + (size_t)p1 * 2048))[lane + 64 * c] = w; } }
                if (rb < 16) { const int pbeg = segs[rb] + tot[rb], pend = segs[rb + 1];
                    for (int p = pbeg + tid; p < pend; p += NWAVES * 64) { ROWTOK[p] = -1; ROWW[p] = 0.f; } }
                __syncthreads();
            }
        }
        SEAM(pb + 8);
        if (INJ(9)) for (int rp = 0; rp < REPS(9); ++rp) {
            PHASE_BEGIN();
            const int* const CNT = (const int*)(ws + WS_CNT); unsigned char* const XS = ws + WS_XS; unsigned char* const WGU = ws + WS_WGU; unsigned char* const ACT = ws + WS_ACT;
            COMPUTE_SEGMENTS(0);
            pg8::MoeSched Sm; Sm.init(XS, WGU + (size_t)l * 16 * 2048 * 2048, segs[16], 2048, 2048, (size_t)2048 * 2048, (const PG8_LAS unsigned char*)p2e, G, bx);
            pg8::EpiSwiglu E{ACT, 1.f / WSC_K2048, ASCALE};
            pg8::gemm_phase<pg8::EpiSwiglu, pg8::MoeSched, true, true, true>(L + RING_OFF, 2048, Sm, E, wave_s);
        }
        SEAM(pb + 9);
        if (INJ(10)) for (int rp = 0; rp < REPS(10); ++rp) {
            PHASE_BEGIN();
            const int* const CNT = (const int*)(ws + WS_CNT); unsigned char* const ACT = ws + WS_ACT; unsigned char* const WDN = ws + WS_WDN; bf16* const YB = (bf16*)(ws + WS_Y);
            const int* const ROWTOK = (const int*)(ws + WS_ROWTOK); const float* const ROWW = (const float*)(ws + WS_ROWW);
            COMPUTE_SEGMENTS(0);
            pg8::MoeSched Sm; Sm.init(ACT, WDN + (size_t)l * 16 * 2048 * 1024, segs[16], 2048, 1024, (size_t)2048 * 1024, (const PG8_LAS unsigned char*)p2e, G, bx);
            pg8::EpiDown E{YB, ROWTOK, ROWW, 1.f / (WSC_K1024 * ASCALE)};
            pg8::gemm_phase<pg8::EpiDown, pg8::MoeSched, true, true, true>(L + RING_OFF, 1024, Sm, E, wave_s);
        }
        SEAM(pb + 10);
    }
    if (((PHMASK >> 12) & 1) && IN(23)) {
        PHASE_BEGIN();
        const float* const g_final = KIN(float, 19); float* const xbuf = ka->out; const float* const MOD = (const float*)(ws + WS_MOD); const bf16* const YB = (const bf16*)(ws + WS_Y);
        f32x4 cA[8], cG[8];
#pragma unroll
        for (int j = 0; j < 8; ++j) { const int c4 = lane + 64 * j; cA[j] = ((const f32x4*)g_final)[c4]; cG[j] = ((const f32x4*)(MOD + 12288 + 10240))[c4]; }
        for (int row = gw; row < S_; row += NGW) {
            f32x4 v[8]; float ss = 0.f;
#pragma unroll
            for (int j = 0; j < 8; ++j) { v[j] = ((const GAS f32x4*)(xbuf + (size_t)row * 2048))[lane + 64 * j];
                const v2u a = ((const GAS v2u*)(YB + (size_t)(2 * row) * 2048))[lane + 64 * j], b = ((const GAS v2u*)(YB + (size_t)(2 * row + 1) * 2048))[lane + 64 * j];
                const f32x4 ys = (f32x4){bflo(a.x) + bflo(b.x), bfhi(a.x) + bfhi(b.x), bflo(a.y) + bflo(b.y), bfhi(a.y) + bfhi(b.y)};
                v[j] += cG[j] * ys; ss += (v[j].x * v[j].x + v[j].y * v[j].y) + (v[j].z * v[j].z + v[j].w * v[j].w); }
            const float rs = 1.f / sqrtf(wave_sum(ss, lane) * (1.f / 2048.f) + RMS_EPS);
#pragma unroll
            for (int j = 0; j < 8; ++j) ((GAS f32x4*)(xbuf + (size_t)row * 2048))[lane + 64 * j] = v[j] * rs * cA[j];
        }
    }
#undef IN
#undef INJ
#undef REPS
#undef PHASE_BEGIN
#undef KIN
#undef SEAM
#undef COMPUTE_SEGMENTS
}

extern "C" void kernel_launch(void* const* d_in, const int* in_sizes, int n_in, void* d_out, int out_size, void* d_ws, size_t ws_size, hipStream_t stream) {
    static int grid = 0;
    if (grid == 0) {
        if (n_in != 20 || in_sizes[0] != S_ * DM_ || out_size != S_ * DM_ || ws_size < WS_END) { fprintf(stderr, "kernel_launch: unexpected shapes or workspace (%d inputs, in0 %d, out %d, ws %zu); nothing launched\n", n_in, n_in > 0 ? in_sizes[0] : -1, out_size, ws_size); grid = -1; return; }
        int dev = 0, cus = 0, per_cu = 0;
        if (hipGetDevice(&dev) != hipSuccess || hipDeviceGetAttribute(&cus, hipDeviceAttributeMultiprocessorCount, dev) != hipSuccess) { grid = -1; return; }
        if (hipFuncSetAttribute((const void*)fwd, hipFuncAttributeMaxDynamicSharedMemorySize, LDS_BYTES) != hipSuccess) { fprintf(stderr, "kernel_launch: hipFuncSetAttribute failed\n"); grid = -1; return; }
        if (hipOccupancyMaxActiveBlocksPerMultiprocessor(&per_cu, (const void*)fwd, NWAVES * 64, LDS_BYTES) != hipSuccess || per_cu < 1) fprintf(stderr, "kernel_launch: occupancy query reports %d blocks per CU\n", per_cu);
        (void)hipGetLastError();
        grid = cus;
    }
    if (grid < 0) return;
    if (hipMemsetAsync((char*)d_ws + WS_CTL, 0, CTL_ZERO_BYTES, stream) != hipSuccess) return;
    Args a{};
    for (int i = 0; i < 20; ++i) a.in[i] = d_in[i];
    a.out = (float*)d_out; a.ws = (unsigned char*)d_ws;
    if (MK_N_LAUNCHES == 1) { a.ph_lo = 0; a.ph_hi = N_PHASES; hipLaunchKernelGGL(fwd, dim3(grid), dim3(NWAVES * 64), LDS_BYTES, stream, a); }
    else for (int p = 0; p < N_PHASES; ++p) { a.ph_lo = p; a.ph_hi = p + 1; hipLaunchKernelGGL(fwd, dim3(grid), dim3(NWAVES * 64), LDS_BYTES, stream, a); }
}
```

```cpp
#include <hip/hip_runtime.h>
#include <hip/hip_bf16.h>
#include <cstdio>
#include <cstdint>
#include <cmath>
namespace pg8 {
#define PG8_LAS __attribute__((address_space(3)))
typedef unsigned short bf16_t;
typedef short bf16x8 __attribute__((ext_vector_type(8)));
typedef float f32x4 __attribute__((ext_vector_type(4)));
typedef unsigned u32x4 __attribute__((ext_vector_type(4)));
constexpr int BM = 256, BK = 64, HALF = 128, HTB = HALF * BK * 2  , STAGE_BYTES = 8 * HTB, NXCD = 8, WGM = 8;

__host__ __device__ __forceinline__ int lds_byte(int r, int c) { const int st = (r >> 4) * 2 + (c >> 5), rr = r & 15, cc = c & 31, ob = rr * 64 + cc * 2; return st * 1024 + (ob ^ (((ob >> 9) & 1) << 5)); }
__host__ __device__ __forceinline__ void stage_rc(int b, int& R, int& C) { const int st = b / 1024, sb = b % 1024, swz = sb ^ (((sb >> 9) & 1) << 5); R = (st >> 1) * 16 + swz / 64; C = (st & 1) * 32 + (swz % 64) / 2; }
__host__ __device__ __forceinline__ int perm32(int rho) { const int n = rho >> 4, i = rho & 15; return 8 * (i >> 2) + 4 * n + (i & 3); }

struct Unit { int pm, pn; };
struct Gemm { const bf16_t* A; const bf16_t* Bt; int M, N, K; };

struct StaticOrder {
    int nM, nN, nwg, G, c;
    __host__ __device__ void init(int M, int N, int G_, int c_) { nM = M / BM; nN = N / BM; nwg = nM * nN; G = G_; c = c_; }
    __host__ __device__ bool next(int i, Unit& u) const {
        const long L = (long)i * G + c; if (L >= nwg) return false;
        int wgid = (int)L; { const int q = nwg / NXCD, r = nwg % NXCD, xcd = wgid % NXCD, off = wgid / NXCD; wgid = (xcd < r ? xcd * (q + 1) : r * (q + 1) + (xcd - r) * q) + off; }
        const int nig = WGM * nN, gid = wgid / nig, fm = gid * WGM, gsz = (nM - fm) < WGM ? (nM - fm) : WGM;
        u.pm = fm + ((wgid % nig) % gsz); u.pn = (wgid % nig) / gsz; return true;
    }
    __device__ __forceinline__ void a_ready(const Unit&) const {}
    __device__ __forceinline__ void done(const Unit&) const {}
};

struct DenseSched {
    const char* A; const char* Bt; size_t tstep; StaticOrder so;
    __device__ __forceinline__ void init(const void* A_, const void* Bt_, int M, int N, int KB, int G, int c) { A = (const char*)A_; Bt = (const char*)Bt_; tstep = (size_t)BM * KB; so.init(M, N, G, c); }
    __device__ __forceinline__ bool next(int i, Unit& u) const { return so.next(i, u); }
    __device__ __forceinline__ const char* a_ptr(const Unit& u) const { return A + (size_t)u.pm * tstep; }
    __device__ __forceinline__ const char* b_ptr(const Unit& u) const { return Bt + (size_t)u.pn * tstep; }
    __device__ __forceinline__ void a_ready(const Unit&) const {}
    __device__ __forceinline__ void done(const Unit&) const {}
};
struct MoeSched {
    const char* A; const char* Bt; size_t tstep, estride; StaticOrder so; const PG8_LAS unsigned char* p2e;
    __device__ __forceinline__ void init(const void* A_, const void* Bt_, int Mpad, int N, int KB, size_t estride_, const PG8_LAS unsigned char* p2e_, int G, int c) {
        A = (const char*)A_; Bt = (const char*)Bt_; tstep = (size_t)BM * KB; estride = estride_; p2e = p2e_; so.init(Mpad, N, G, c); }
    __device__ __forceinline__ bool next(int i, Unit& u) const { return so.next(i, u); }
    __device__ __forceinline__ const char* a_ptr(const Unit& u) const { return A + (size_t)u.pm * tstep; }
    __device__ __forceinline__ const char* b_ptr(const Unit& u) const { const int e = __builtin_amdgcn_readfirstlane((int)p2e[u.pm]); return Bt + (size_t)e * estride + (size_t)u.pn * tstep; }
    __device__ __forceinline__ void a_ready(const Unit&) const {}
    __device__ __forceinline__ void done(const Unit&) const {}
};

__device__ __forceinline__ unsigned pk4_fp8(float a, float b, float c, float d) {
    a = __builtin_fminf(__builtin_fmaxf(a, -448.f), 448.f); b = __builtin_fminf(__builtin_fmaxf(b, -448.f), 448.f); c = __builtin_fminf(__builtin_fmaxf(c, -448.f), 448.f); d = __builtin_fminf(__builtin_fmaxf(d, -448.f), 448.f);
    int w = 0; w = __builtin_amdgcn_cvt_pk_fp8_f32(a, b, w, false); w = __builtin_amdgcn_cvt_pk_fp8_f32(c, d, w, true); return (unsigned)w; }
__device__ __forceinline__ unsigned cvt_pk_bf16(float lo, float hi) { unsigned r; asm volatile("v_cvt_pk_bf16_f32 %0, %1, %2" : "=v"(r) : "v"(lo), "v"(hi)); return r; }

struct EpiProj {
    static constexpr bool PERM = true, AFTER_DRAIN = false;
    bf16_t* O; const float* cosT; const float* sinT; float qscale, oscale;
    __device__ __forceinline__ void operator()(const f32x4 (&acc)[2][2][4][2], const Unit& u, int wr, int wc, int fr, int fq) const {
        const int pn = u.pn;
        const bool isq = (pn < 2) || (pn == 6) || (pn == 7) || (pn >= 12 && pn < 16);
        const bool isk = (pn == 2) || (pn == 3) || (pn == 8) || (pn == 9) || (pn >= 16 && pn < 20);
        const int row0 = u.pm * BM + wr * 64 + fr, col0 = pn * BM + wc * 32 + 8 * fq;
        const int i0 = (wc & 1) * 16 + 4 * fq;
        const float sc = isq ? qscale * oscale : oscale;
#pragma unroll
        for (int ai = 0; ai < 2; ++ai)
#pragma unroll
            for (int m = 0; m < 4; ++m) { const int row = row0 + ai * HALF + m * 16; bf16_t* rowp = O + (size_t)row * 6144 + col0;
                f32x4 cs = (f32x4){1.f, 1.f, 1.f, 1.f}, sn = (f32x4){0.f, 0.f, 0.f, 0.f};
                if (isq || isk) { cs = *(const f32x4*)(cosT + (size_t)row * 32 + i0); sn = *(const f32x4*)(sinT + (size_t)row * 32 + i0); }
#pragma unroll
                for (int bj = 0; bj < 2; ++bj) { const f32x4 v0 = acc[ai][bj][m][0], v1 = acc[ai][bj][m][1];
                    const float a0 = (v0[0] * cs[0] - v0[1] * sn[0]) * sc, b0 = (v0[1] * cs[0] + v0[0] * sn[0]) * sc;
                    const float a1 = (v0[2] * cs[1] - v0[3] * sn[1]) * sc, b1 = (v0[3] * cs[1] + v0[2] * sn[1]) * sc;
                    const float a2 = (v1[0] * cs[2] - v1[1] * sn[2]) * sc, b2 = (v1[1] * cs[2] + v1[0] * sn[2]) * sc;
                    const float a3 = (v1[2] * cs[3] - v1[3] * sn[3]) * sc, b3 = (v1[3] * cs[3] + v1[2] * sn[3]) * sc;
                    u32x4 w; w.x = cvt_pk_bf16(a0, b0); w.y = cvt_pk_bf16(a1, b1); w.z = cvt_pk_bf16(a2, b2); w.w = cvt_pk_bf16(a3, b3);
                    *(u32x4*)(rowp + bj * HALF) = w; } }
    }
};
template <bool BASE_F32> struct EpiGateRes {
    static constexpr bool PERM = true, AFTER_DRAIN = false;
    const void* base; bf16_t* out; const float* gate; float oscale;
    __device__ __forceinline__ void operator()(const f32x4 (&acc)[2][2][4][2], const Unit& u, int wr, int wc, int fr, int fq) const {
        const int col0 = u.pn * BM + wc * 32 + 8 * fq;
        f32x4 gv[2][2];
#pragma unroll
        for (int bj = 0; bj < 2; ++bj)
#pragma unroll
            for (int n = 0; n < 2; ++n) gv[bj][n] = *(const f32x4*)(gate + col0 + bj * HALF + n * 4) * oscale;
#pragma unroll
        for (int ai = 0; ai < 2; ++ai)
#pragma unroll
            for (int m = 0; m < 4; ++m) { const size_t off = (size_t)(u.pm * BM + ai * HALF + wr * 64 + m * 16 + fr) * 2048 + col0;
#pragma unroll
                for (int bj = 0; bj < 2; ++bj) { f32x4 b0, b1;
                    if (BASE_F32) { b0 = *(const f32x4*)((const float*)base + off + bj * HALF); b1 = *(const f32x4*)((const float*)base + off + bj * HALF + 4); }
                    else { const u32x4 w = *(const u32x4*)((const bf16_t*)base + off + bj * HALF);
                        b0 = (f32x4){__builtin_bit_cast(float, w.x << 16), __builtin_bit_cast(float, w.x & 0xffff0000u), __builtin_bit_cast(float, w.y << 16), __builtin_bit_cast(float, w.y & 0xffff0000u)};
                        b1 = (f32x4){__builtin_bit_cast(float, w.z << 16), __builtin_bit_cast(float, w.z & 0xffff0000u), __builtin_bit_cast(float, w.w << 16), __builtin_bit_cast(float, w.w & 0xffff0000u)}; }
                    const f32x4 v0 = b0 + gv[bj][0] * acc[ai][bj][m][0], v1 = b1 + gv[bj][1] * acc[ai][bj][m][1];
                    u32x4 w; w.x = cvt_pk_bf16(v0[0], v0[1]); w.y = cvt_pk_bf16(v0[2], v0[3]); w.z = cvt_pk_bf16(v1[0], v1[1]); w.w = cvt_pk_bf16(v1[2], v1[3]);
                    *(u32x4*)(out + off + bj * HALF) = w; }
                asm volatile("" ::: "memory"); }
    }
};
struct EpiSwiglu {
    static constexpr bool PERM = true, AFTER_DRAIN = false;
    unsigned char* O; float iscale, ascale;
    __device__ __forceinline__ void operator()(const f32x4 (&acc)[2][2][4][2], const Unit& u, int wr, int wc, int fr, int fq) const {
        const int row0 = u.pm * BM + wr * 64 + fr, col0 = u.pn * 128 + wc * 16 + 4 * fq;
#pragma unroll
        for (int ai = 0; ai < 2; ++ai)
#pragma unroll
            for (int m = 0; m < 4; ++m) { unsigned char* rowp = O + (size_t)(row0 + ai * HALF + m * 16) * 1024 + col0;
#pragma unroll
                for (int bj = 0; bj < 2; ++bj) { const f32x4 g = acc[ai][bj][m][0] * iscale, up = acc[ai][bj][m][1] * (iscale * ascale); float r[4];
#pragma unroll
                    for (int j = 0; j < 4; ++j) { const float e = __builtin_amdgcn_exp2f(-1.4426950408889634f * g[j]); r[j] = g[j] * __builtin_amdgcn_rcpf(1.f + e) * up[j]; }
                    *(unsigned*)(rowp + bj * 64) = pk4_fp8(r[0], r[1], r[2], r[3]); } }
    }
};
struct EpiDown {
    static constexpr bool PERM = true, AFTER_DRAIN = false;
    bf16_t* Y; const int* rowtok; const float* roww; float oscale;
    __device__ __forceinline__ void operator()(const f32x4 (&acc)[2][2][4][2], const Unit& u, int wr, int wc, int fr, int fq) const {
        const int row0 = u.pm * BM + wr * 64 + fr, col0 = u.pn * BM + wc * 32 + 8 * fq;
#pragma unroll
        for (int ai = 0; ai < 2; ++ai)
#pragma unroll
            for (int m = 0; m < 4; ++m) { const int pos = row0 + ai * HALF + m * 16; const int tk = rowtok[pos]; const float w8 = roww[pos] * oscale;
                bf16_t* rowp = Y + (size_t)(tk < 0 ? 0 : tk) * 2048 + col0;
#pragma unroll
                for (int bj = 0; bj < 2; ++bj) { const f32x4 v0 = acc[ai][bj][m][0] * w8, v1 = acc[ai][bj][m][1] * w8;
                    u32x4 w; w.x = cvt_pk_bf16(v0[0], v0[1]); w.y = cvt_pk_bf16(v0[2], v0[3]); w.z = cvt_pk_bf16(v1[0], v1[1]); w.w = cvt_pk_bf16(v1[2], v1[3]);
                    if (tk >= 0) *(u32x4*)(rowp + bj * HALF) = w; }
                asm volatile("" ::: "memory"); }
    }
};

template <class Epi, class Sched, bool ALIGN_EPI = false, bool SP2 = false, bool FP8 = false>
__device__ __forceinline__ void gemm_phase(PG8_LAS unsigned char* lds, const int KB  , const Sched& S, const Epi& E, const int wave_s  ) {
    typedef int v4i_t __attribute__((ext_vector_type(4))); typedef int v8i_t __attribute__((ext_vector_type(8)));
    int lane; asm volatile("v_mbcnt_lo_u32_b32 %0, -1, 0\n\tv_mbcnt_hi_u32_b32 %0, -1, %0" : "=v"(lane)); const int wid = wave_s, tid = wid * 64 + lane, wr = wid >> 2, wc = wid & 3, fr = lane & 15, fq = lane >> 4;
    const int nt = KB / (BK * 2);
    unsigned voffA, voffB;
    { int R, C; stage_rc(tid * 16, R, C); const int Rb = Epi::PERM ? ((R & ~31) + perm32(R & 31)) : R; voffA = (unsigned)(R * KB + C * 2); voffB = (unsigned)(Rb * KB + C * 2); }
    const size_t pstep = (size_t)64 * KB;
    const size_t kstep = (size_t)(BK * 2);
    const size_t hstep = (size_t)HALF * KB;
    const unsigned ldsbw = (unsigned)__builtin_amdgcn_readfirstlane((int)((unsigned)(uintptr_t)lds + (unsigned)wid * 1024u));
    const int aoff = lds_byte(wr * 64 + fr, fq * 8), boff = lds_byte(wc * 32 + fr, fq * 8);
#define PG8_SA(b, h) (((b) * 2 + (h)) * HTB)
#define PG8_SB(b, h) ((4 + (b) * 2 + (h)) * HTB)
#define PG8_STAGE1(bufoff, gbase, voff, PI) do { unsigned keep_; \
        asm volatile("s_mov_b32 %0, m0\n\ts_add_i32 m0, %3, %4\n\ts_nop 0\n\tglobal_load_lds_dwordx4 %1, %2\n\ts_mov_b32 m0, %0" : "=&s"(keep_) : "v"(voff), "s"((const char*)(gbase) + (PI) * pstep), "s"(ldsbw), "i"((bufoff) + (PI) * 8192) : "memory", "scc"); } while (0)
#define PG8_STAGE(bufoff, gbase, voff) do { PG8_STAGE1(bufoff, gbase, voff, 0); PG8_STAGE1(bufoff, gbase, voff, 1); } while (0)
#define PG8_LDA(dst, b, h) do { _Pragma("unroll") for (int m = 0; m < 4; ++m) { dst[m].lo = *(const PG8_LAS v4i_t*)(lds + PG8_SA(b, h) + aoff + m * 2048); dst[m].hi = *(const PG8_LAS v4i_t*)(lds + PG8_SA(b, h) + aoff + m * 2048 + 1024); } } while (0)
#define PG8_LDB(dst, b, h) do { _Pragma("unroll") for (int n = 0; n < 2; ++n) { dst[n].lo = *(const PG8_LAS v4i_t*)(lds + PG8_SB(b, h) + boff + n * 2048); dst[n].hi = *(const PG8_LAS v4i_t*)(lds + PG8_SB(b, h) + boff + n * 2048 + 1024); } } while (0)
#define PG8_MMA(ai, bj, At, Bt) do { __builtin_amdgcn_s_setprio(1); _Pragma("unroll") for (int m = 0; m < 4; ++m) _Pragma("unroll") for (int n = 0; n < 2; ++n) { \
        if constexpr (FP8) { acc[ai][bj][m][n] = __builtin_amdgcn_mfma_scale_f32_16x16x128_f8f6f4(Bt[n], At[m], acc[ai][bj][m][n], 0, 0, 0, 0, 0, 0); } \
        else { const v4i_t bl_ = Bt[n].lo, bh_ = Bt[n].hi, al_ = At[m].lo, ah_ = At[m].hi;     \
               acc[ai][bj][m][n] = __builtin_amdgcn_mfma_f32_16x16x32_bf16(__builtin_bit_cast(bf16x8, bl_), __builtin_bit_cast(bf16x8, al_), acc[ai][bj][m][n], 0, 0, 0); \
               acc[ai][bj][m][n] = __builtin_amdgcn_mfma_f32_16x16x32_bf16(__builtin_bit_cast(bf16x8, bh_), __builtin_bit_cast(bf16x8, ah_), acc[ai][bj][m][n], 0, 0, 0); } } \
        __builtin_amdgcn_s_setprio(0); } while (0)
#define PG8_WAIT_V(n) asm volatile("s_waitcnt vmcnt(" #n ")" ::: "memory")
#define PG8_WAIT_L(n) asm volatile("s_waitcnt lgkmcnt(" #n ")" ::: "memory")
#define PG8_BAR __builtin_amdgcn_s_barrier()
#define PG8_SCHED __builtin_amdgcn_sched_barrier(0)
    Unit cur, nxt; int ui = 0;
    if (!S.next(0, cur)) return;
    f32x4 acc[2][2][4][2];
#pragma unroll
    for (int a = 0; a < 2; ++a)
#pragma unroll
        for (int b = 0; b < 2; ++b)
#pragma unroll
            for (int m = 0; m < 4; ++m)
#pragma unroll
                for (int n = 0; n < 2; ++n) acc[a][b][m][n] = (f32x4){0.f, 0.f, 0.f, 0.f};
    v8i_t At[4], B0[2], B1[2];
    const char* cA = S.a_ptr(cur); const char* cB = S.b_ptr(cur);
    S.a_ready(cur);
    if constexpr (SP2) {
        PG8_STAGE(PG8_SB(0, 0), cB, voffB); PG8_STAGE(PG8_SB(0, 1), cB + hstep, voffB); PG8_STAGE(PG8_SA(0, 0), cA, voffA); PG8_STAGE(PG8_SA(0, 1), cA + hstep, voffA);
        if (wr == 1) PG8_BAR;
        PG8_WAIT_V(2); PG8_BAR;
        PG8_STAGE(PG8_SB(1, 0), cB + kstep, voffB); PG8_STAGE(PG8_SA(1, 0), cA + kstep, voffA); PG8_STAGE(PG8_SB(1, 1), cB + hstep + kstep, voffB);
        PG8_WAIT_V(6); PG8_BAR;
    } else {
        PG8_STAGE(PG8_SB(0, 0), cB, voffB); PG8_STAGE(PG8_SA(0, 0), cA, voffA); PG8_STAGE(PG8_SB(0, 1), cB + hstep, voffB); PG8_STAGE(PG8_SA(0, 1), cA + hstep, voffA);
        if (wr == 1) PG8_BAR;
        PG8_WAIT_V(4); PG8_BAR;
        PG8_STAGE(PG8_SB(1, 0), cB + kstep, voffB); PG8_STAGE(PG8_SA(1, 0), cA + kstep, voffA); PG8_STAGE(PG8_SB(1, 1), cB + hstep + kstep, voffB);
        PG8_WAIT_V(6); PG8_BAR;
    }
    for (;;) {
        const bool has_next = S.next(ui + 1, nxt);
        const char* nA = has_next ? S.a_ptr(nxt) : cA; const char* nB = has_next ? S.b_ptr(nxt) : cB;
#pragma unroll 1
        for (int t = 0; t < nt; t += 2) {
            const bool last = (t == nt - 2);
            const char* a1 = cA + (size_t)(t + 1) * kstep;
            const char* a2 = last ? nA : cA + (size_t)(t + 2) * kstep; const char* b2 = last ? nB : cB + (size_t)(t + 2) * kstep;
            const char* a3 = a2 + kstep; const char* b3 = b2 + kstep;
            if (last && has_next) S.a_ready(nxt);
            if constexpr (SP2) {
            PG8_LDB(B0, 0, 0); PG8_LDB(B1, 0, 1); PG8_SCHED; PG8_LDA(At, 0, 0); PG8_STAGE(PG8_SA(1, 1), a1 + hstep, voffA);
            PG8_WAIT_V(8); PG8_WAIT_L(0); PG8_BAR; PG8_MMA(0, 0, At, B0); PG8_MMA(0, 1, At, B1); PG8_BAR; PG8_SCHED;
            PG8_LDA(At, 0, 1); PG8_STAGE(PG8_SB(0, 0), b2, voffB); PG8_STAGE(PG8_SB(0, 1), b2 + hstep, voffB); PG8_STAGE(PG8_SA(0, 0), a2, voffA);
            PG8_WAIT_V(8); PG8_WAIT_L(0); PG8_BAR; PG8_MMA(1, 0, At, B0); PG8_MMA(1, 1, At, B1); PG8_BAR; PG8_SCHED;
            PG8_LDB(B0, 1, 0); PG8_LDB(B1, 1, 1); PG8_SCHED; PG8_LDA(At, 1, 0); PG8_STAGE(PG8_SA(0, 1), a2 + hstep, voffA);
            PG8_WAIT_V(8); PG8_WAIT_L(0); PG8_BAR; PG8_MMA(0, 0, At, B0); PG8_MMA(0, 1, At, B1); PG8_BAR; PG8_SCHED;
            PG8_LDA(At, 1, 1); PG8_STAGE(PG8_SB(1, 0), b3, voffB); PG8_STAGE(PG8_SB(1, 1), b3 + hstep, voffB); PG8_STAGE(PG8_SA(1, 0), a3, voffA);
            PG8_WAIT_V(8); PG8_WAIT_L(0); PG8_BAR; PG8_MMA(1, 0, At, B0); PG8_MMA(1, 1, At, B1); PG8_BAR; PG8_SCHED;
            } else {
            PG8_LDB(B0, 0, 0); PG8_SCHED; PG8_LDA(At, 0, 0); PG8_STAGE(PG8_SA(1, 1), a1 + hstep, voffA);
            PG8_WAIT_L(8); PG8_BAR; PG8_WAIT_L(0); PG8_MMA(0, 0, At, B0); PG8_BAR; PG8_SCHED;
            PG8_LDB(B1, 0, 1); PG8_STAGE(PG8_SB(0, 0), b2, voffB);
            PG8_BAR; PG8_WAIT_L(0); PG8_MMA(0, 1, At, B1); PG8_BAR;
            PG8_LDA(At, 0, 1); PG8_STAGE(PG8_SA(0, 0), a2, voffA);
            PG8_BAR; PG8_WAIT_L(0); PG8_MMA(1, 0, At, B0); PG8_BAR; PG8_SCHED;
            PG8_STAGE(PG8_SB(0, 1), b2 + hstep, voffB);
            PG8_WAIT_V(6); PG8_BAR; PG8_MMA(1, 1, At, B1); PG8_BAR;
            PG8_LDB(B0, 1, 0); PG8_SCHED; PG8_LDA(At, 1, 0); PG8_STAGE(PG8_SA(0, 1), a2 + hstep, voffA);
            PG8_WAIT_L(8); PG8_BAR; PG8_WAIT_L(0); PG8_MMA(0, 0, At, B0); PG8_BAR; PG8_SCHED;
            PG8_LDB(B1, 1, 1); PG8_STAGE(PG8_SB(1, 0), b3, voffB);
            PG8_BAR; PG8_WAIT_L(0); PG8_MMA(0, 1, At, B1); PG8_BAR;
            PG8_LDA(At, 1, 1); PG8_STAGE(PG8_SA(1, 0), a3, voffA);
            PG8_BAR; PG8_WAIT_L(0); PG8_MMA(1, 0, At, B0); PG8_BAR; PG8_SCHED;
            PG8_STAGE(PG8_SB(1, 1), b3 + hstep, voffB);
            PG8_WAIT_V(6); PG8_BAR; PG8_MMA(1, 1, At, B1); PG8_BAR;
            }
        }
        if constexpr (ALIGN_EPI) { if (wr == 0) PG8_BAR; }
        if constexpr (!Epi::AFTER_DRAIN) { int ln_; asm volatile("v_mbcnt_lo_u32_b32 %0, -1, 0\n\tv_mbcnt_hi_u32_b32 %0, -1, %0" : "=v"(ln_));
            E(acc, cur, wr, wc, ln_ & 15, ln_ >> 4); S.done(cur); }
        if (!has_next) break;
#pragma unroll
        for (int a = 0; a < 2; ++a)
#pragma unroll
            for (int b = 0; b < 2; ++b)
#pragma unroll
                for (int m = 0; m < 4; ++m)
#pragma unroll
                    for (int n = 0; n < 2; ++n) acc[a][b][m][n] = (f32x4){0.f, 0.f, 0.f, 0.f};
        cur = nxt; cA = nA; cB = nB; ++ui;
        if constexpr (ALIGN_EPI) { if (wr == 1) PG8_BAR; }
    }
    PG8_WAIT_V(0);
    if constexpr (!ALIGN_EPI) { if (wr == 0) PG8_BAR; }
    PG8_BAR;
    if constexpr (Epi::AFTER_DRAIN) { E.fused(acc, cur, wr, wc, fr, fq, lds, wid, lane); S.done(cur); }
#undef PG8_SA
#undef PG8_SB
#undef PG8_STAGE
#undef PG8_LDA
#undef PG8_LDB
#undef PG8_MMA
#undef PG8_WAIT_V
#undef PG8_WAIT_L
#undef PG8_BAR
#undef PG8_SCHED
}
}

constexpr float WSC_K2048 = 64.f, WSC_K1024 = 32.f, MSCALE = 4.f  , ASCALE = 2.f  ;
__device__ __forceinline__ int dest_row(int map, int n) {
    if (map == 1) { const int seg = n >> 9; const bool qk = (seg == 0) || (seg == 1) || (seg == 3) || (seg == 4) || (seg >= 6 && seg <= 9); if (!qk) return n; const int j = n & 63; return (n & ~63) + ((j < 32) ? 2 * j : 2 * (j - 32) + 1); }
    if (map == 2) return 8 * (n >> 2) + (n & 3);
    if (map == 3) return 8 * (n >> 2) + 4 + (n & 3);
    return n;
}
namespace wconv {
constexpr size_t D_WIN = (size_t)16 << 20, D_WOUT = (size_t)64 << 20, D_WGU = (size_t)80 << 20, D_WDN = (size_t)336 << 20;
struct Tab { const float* w_in; const float* w_out; const float* w_gate; const float* w_up; const float* w_down; unsigned char* ws; int l, n_out, total; };
struct State { int idx, staged, ctr, stride; };
struct Op { const float* src; unsigned char* dst; int N, K, map, n0; float wsc; };
__device__ __forceinline__ void decode(const Tab& T, int idx, Op& o) {
    int r = idx; const int l = T.l;
    if (r < T.n_out) { const int kb = r >> 5, nb = r & 31; o.N = 2048; o.K = 2048; o.map = 0; o.wsc = WSC_K2048; o.n0 = 64 * nb;
        o.src = T.w_out + (size_t)l * 2048 * 2048 + (size_t)(16 * kb) * 2048 + 64 * nb; o.dst = T.ws + D_WOUT + (size_t)l * 2048 * 4096 + 16 * kb; return; }
    r -= T.n_out;
    if (r < 65536) { const int up = r >> 15; r &= 32767; const int mt = l * 16 + (r >> 11), item = r & 2047, kb = item >> 4, nb = item & 15; o.N = 1024; o.K = 2048; o.map = 2 + up; o.wsc = WSC_K2048; o.n0 = 64 * nb;
        o.src = (up ? T.w_up : T.w_gate) + (size_t)mt * 2048 * 1024 + (size_t)(16 * kb) * 1024 + 64 * nb; o.dst = T.ws + D_WGU + (size_t)mt * 2048 * 2048 + 16 * kb; return; }
    r -= 65536;
    if (r < 32768) { const int mt = l * 16 + (r >> 11), item = r & 2047, kb = item >> 5, nb = item & 31; o.N = 2048; o.K = 1024; o.map = 0; o.wsc = WSC_K1024; o.n0 = 64 * nb;
        o.src = T.w_down + (size_t)mt * 1024 * 2048 + (size_t)(16 * kb) * 2048 + 64 * nb; o.dst = T.ws + D_WDN + (size_t)mt * 2048 * 1024 + 16 * kb; return; }
    r -= 32768;
    { const int kb = r / 96, nb = r - 96 * kb; o.N = 6144; o.K = 2048; o.map = 1; o.wsc = WSC_K2048; o.n0 = 64 * nb;
      o.src = T.w_in + (size_t)2048 * 6144 + (size_t)(16 * kb) * 6144 + 64 * nb; o.dst = T.ws + D_WIN + (size_t)6144 * 2048 + 16 * kb; }
}
__device__ __forceinline__ void dma16(const void* sbase, unsigned voff, unsigned lds_dst) { unsigned keep;
    asm volatile("s_mov_b32 %0, m0\n\ts_mov_b32 m0, %3\n\ts_nop 0\n\tglobal_load_lds_dwordx4 %1, %2\n\ts_mov_b32 m0, %0" : "=&s"(keep) : "v"(voff), "s"(sbase), "s"(lds_dst) : "memory"); }
__device__ __forceinline__ void issue(const Tab& T, int idx, unsigned stage, int lane) {
    Op o; decode(T, idx, o);
    const unsigned voff = (unsigned)((lane >> 4) * o.N * 4 + (lane & 15) * 16);
#pragma unroll
    for (int j = 0; j < 4; ++j) dma16(o.src + (size_t)(4 * j) * o.N, voff, (unsigned)__builtin_amdgcn_readfirstlane(stage + 1024u * j));
}
__device__ __forceinline__ void finish(const Tab& T, int idx, unsigned stage, int lane) {
    Op o; decode(T, idx, o);
    typedef __attribute__((address_space(3))) const float* lfp; const lfp sp = (lfp)(uintptr_t)(stage + 4u * lane);
    float f[16];
#pragma unroll
    for (int k = 0; k < 16; ++k) f[k] = sp[64 * k] * o.wsc;
    typedef unsigned u4 __attribute__((ext_vector_type(4)));
    u4 w; w.x = pg8::pk4_fp8(f[0], f[1], f[2], f[3]); w.y = pg8::pk4_fp8(f[4], f[5], f[6], f[7]); w.z = pg8::pk4_fp8(f[8], f[9], f[10], f[11]); w.w = pg8::pk4_fp8(f[12], f[13], f[14], f[15]);
    *(__attribute__((address_space(1))) u4*)(o.dst + (size_t)dest_row(o.map, o.n0 + lane) * o.K) = w;
}
__device__ __forceinline__ void micro(const Tab& T, State& s, unsigned stage, int lane) {
    finish(T, s.staged, stage, lane);
    asm volatile("s_waitcnt lgkmcnt(0)" ::: "memory");
    issue(T, s.idx, stage, lane); s.staged = s.idx; s.idx += s.stride;
}
}

#include <hip/hip_bf16.h>
#include <cmath>
namespace attn_body {
using bf16=__hip_bfloat16;
using bf16x8=__attribute__((ext_vector_type(8)))short;
using s16x4=__attribute__((ext_vector_type(4)))short;
using f32x16=__attribute__((ext_vector_type(16)))float;
using u32x4=__attribute__((ext_vector_type(4)))unsigned;
constexpr int SEQ=16384,D=64,DM=6144;
constexpr int NW=8,QBLK=32,QB=QBLK*NW,KVBLK=64,NQB=SEQ/QB;
constexpr int ATTN_UNIT_ROWS=QB;
__device__ __forceinline__ int crow(int r,int hi){return (r&3)+8*(r>>2)+4*hi;}
#define SBAR() __builtin_amdgcn_sched_barrier(0)
__device__ __forceinline__ void cmask(f32x16&p0,f32x16&p1,int jb,int qrel,int hi){
  const float NEG=-INFINITY; int kb=64*jb+4*hi;
  #pragma unroll
  for(int r=0;r<16;++r){int kv=kb+(r&3)+8*(r>>2); if(kv>qrel)p0[r]=NEG; if(kv+32>qrel)p1[r]=NEG;}
}

constexpr int NSLOT=3, SLOTB=8192;
constexpr int LDS_K=0, LDS_V=NSLOT*SLOTB, LDS_WS=2*NSLOT*SLOTB, LDS_OST=LDS_WS+NW*64*4, LDS_BYTES=LDS_OST+NW*4096;
constexpr float C2=0.125f*1.4426950408889634f;
__device__ __forceinline__ void glds16(const void*gsrc,unsigned lds_dst){unsigned keep;
  asm volatile("s_mov_b32 %0, m0\n\ts_mov_b32 m0, %2\n\ts_nop 0\n\tglobal_load_lds_dwordx4 %1, off\n\ts_mov_b32 m0, %0":"=&s"(keep):"v"(gsrc),"s"(lds_dst):"memory");}
__device__ __forceinline__ void glds16s(const void*sbase,unsigned voff,unsigned lds_dst){unsigned keep;
  asm volatile("s_mov_b32 %0, m0\n\ts_mov_b32 m0, %3\n\ts_nop 0\n\tglobal_load_lds_dwordx4 %1, %2\n\ts_mov_b32 m0, %0":"=&s"(keep):"v"(voff),"s"(sbase),"s"(lds_dst):"memory");}
__device__ __forceinline__ float max3f(float a,float b,float c){float r;asm("v_max3_f32 %0, %1, %2, %3":"=v"(r):"v"(a),"v"(b),"v"(c));return r;}
__device__ __forceinline__ float max2f(float a,float b){float r;asm("v_max_f32_e32 %0, %1, %2":"=v"(r):"v"(a),"v"(b));return r;}
__device__ __forceinline__ float fadd_s(float a,float b){float r;asm("v_add_f32_e32 %0, %1, %2":"=v"(r):"v"(a),"v"(b));return r;}
__device__ __forceinline__ float fsub_s(float a,float b){float r;asm("v_sub_f32_e32 %0, %1, %2":"=v"(r):"v"(a),"v"(b));return r;}
typedef float f32x2_t __attribute__((ext_vector_type(2))); typedef __bf16 bf16x2_t __attribute__((ext_vector_type(2)));
__device__ __forceinline__ unsigned cvtpk_s(float lo,float hi){f32x2_t v={lo,hi};bf16x2_t b=__builtin_convertvector(v,bf16x2_t);return __builtin_bit_cast(unsigned,b);}
#define WAIT_BAR(N) asm volatile("s_waitcnt vmcnt(" #N ") lgkmcnt(0)\n\ts_barrier":::"memory")

__device__ __forceinline__ void qkt(f32x16&p0,f32x16&p1,const char*Kslot,const bf16x8*qr,const f32x16&negm,int r32,int hi){
  const char*kb=Kslot+hi*1024+r32*16;
  #pragma unroll
  for(int d0=0;d0<4;++d0){
    const bf16x8 b0=*reinterpret_cast<const bf16x8*>(kb+d0*2048);
    const bf16x8 b1=*reinterpret_cast<const bf16x8*>(kb+d0*2048+512);
    if(d0==0){p0=__builtin_amdgcn_mfma_f32_32x32x16_bf16(b0,qr[0],negm,0,0,0);p1=__builtin_amdgcn_mfma_f32_32x32x16_bf16(b1,qr[0],negm,0,0,0);}
    else{p0=__builtin_amdgcn_mfma_f32_32x32x16_bf16(b0,qr[d0],p0,0,0,0);p1=__builtin_amdgcn_mfma_f32_32x32x16_bf16(b1,qr[d0],p1,0,0,0);}}
}
__device__ __forceinline__ void qkt_rm(f32x16&p0,f32x16&p1,const char*Kslot,const int ka,const bf16x8*qr,const f32x16&negm){
  #pragma unroll
  for(int d0=0;d0<4;++d0){ const char*kb=Kslot+(ka^(d0<<5));
    const bf16x8 b0=*reinterpret_cast<const bf16x8*>(kb);
    const bf16x8 b1=*reinterpret_cast<const bf16x8*>(kb+4096);
    if(d0==0){p0=__builtin_amdgcn_mfma_f32_32x32x16_bf16(b0,qr[0],negm,0,0,0);p1=__builtin_amdgcn_mfma_f32_32x32x16_bf16(b1,qr[0],negm,0,0,0);}
    else{p0=__builtin_amdgcn_mfma_f32_32x32x16_bf16(b0,qr[d0],p0,0,0,0);p1=__builtin_amdgcn_mfma_f32_32x32x16_bf16(b1,qr[d0],p1,0,0,0);}}
}
typedef __attribute__((address_space(3))) const char* lds_cptr;
typedef short v4i16_t __attribute__((ext_vector_type(4)));
__device__ __forceinline__ void kload8(bf16x8*kf,lds_cptr kp){
  kf[0]=*(const __attribute__((address_space(3))) bf16x8*)(kp);      kf[1]=*(const __attribute__((address_space(3))) bf16x8*)(kp+512);
  kf[2]=*(const __attribute__((address_space(3))) bf16x8*)(kp+2048); kf[3]=*(const __attribute__((address_space(3))) bf16x8*)(kp+2560);
  kf[4]=*(const __attribute__((address_space(3))) bf16x8*)(kp+4096); kf[5]=*(const __attribute__((address_space(3))) bf16x8*)(kp+4608);
  kf[6]=*(const __attribute__((address_space(3))) bf16x8*)(kp+6144); kf[7]=*(const __attribute__((address_space(3))) bf16x8*)(kp+6656);
}
__device__ __forceinline__ void kload2(bf16x8*kf,lds_cptr kp,int j){ kf[2*j]=*(const __attribute__((address_space(3))) bf16x8*)(kp+j*2048); kf[2*j+1]=*(const __attribute__((address_space(3))) bf16x8*)(kp+j*2048+512); }
__device__ __forceinline__ s16x4 vtr(lds_cptr p){ return __builtin_bit_cast(s16x4,__builtin_amdgcn_ds_read_tr16_b64_v4i16((__attribute__((address_space(3))) v4i16_t*)p)); }
__device__ __forceinline__ float rowmax(const f32x16&p0,const f32x16&p1){
  float a=max3f(p0[0],p0[1],p1[0]),b=max3f(p0[2],p0[3],p1[1]);a=max3f(a,p1[2],p1[3]);
  #pragma unroll
  for(int r=4;r<16;r+=4){a=max3f(a,p0[r],p0[r+1]);b=max3f(b,p0[r+2],p0[r+3]);a=max3f(a,p1[r],p1[r+1]);b=max3f(b,p1[r+2],p1[r+3]);}
  const float m=max2f(a,b);
  auto rr=__builtin_amdgcn_permlane32_swap(__float_as_uint(m),__float_as_uint(m),false,false);
  return max2f(__uint_as_float(rr[0]),__uint_as_float(rr[1]));
}
__device__ __forceinline__ void pv(f32x16*o,int vb,bf16x8 pa0,bf16x8 pa1,bf16x8 pa2,bf16x8 pa3){
  #pragma unroll
  for(int d0=0;d0<2;++d0){s16x4 lo[4],hi[4];
    #pragma unroll
    for(int ks=0;ks<4;++ks){
      asm volatile("ds_read_b64_tr_b16 %0,%1 offset:%c2":"=&v"(lo[ks]):"v"(vb),"i"(d0*4096+ks*1024):"memory");
      asm volatile("ds_read_b64_tr_b16 %0,%1 offset:%c2":"=&v"(hi[ks]):"v"(vb),"i"(d0*4096+ks*1024+512):"memory");}
    asm volatile("s_waitcnt lgkmcnt(0)":::"memory");SBAR();
    #define PK(k) (bf16x8){lo[k][0],lo[k][1],lo[k][2],lo[k][3],hi[k][0],hi[k][1],hi[k][2],hi[k][3]}
    o[d0]=__builtin_amdgcn_mfma_f32_32x32x16_bf16(pa0,PK(0),o[d0],0,0,0);
    o[d0]=__builtin_amdgcn_mfma_f32_32x32x16_bf16(pa1,PK(1),o[d0],0,0,0);
    o[d0]=__builtin_amdgcn_mfma_f32_32x32x16_bf16(pa2,PK(2),o[d0],0,0,0);
    o[d0]=__builtin_amdgcn_mfma_f32_32x32x16_bf16(pa3,PK(3),o[d0],0,0,0);
    #undef PK
  }
}

constexpr int ATTN_LDS_BYTES=LDS_BYTES;


#ifndef ATT_STAGGER
#define ATT_STAGGER 0
#endif
constexpr int XSLOTS=4, X_K=0, X_V=XSLOTS*SLOTB, X_WS=X_V+2*XSLOTS*SLOTB, X_LDS_BYTES=X_WS+NW*256;
__device__ __forceinline__ void pv4(f32x16*o,int vb,bf16x8 pa0,bf16x8 pa1,bf16x8 pa2,bf16x8 pa3){
  #pragma unroll
  for(int d0=0;d0<4;++d0){s16x4 lo[4],hi[4];
    #pragma unroll
    for(int ks=0;ks<4;++ks){
      asm volatile("ds_read_b64_tr_b16 %0,%1 offset:%c2":"=&v"(lo[ks]):"v"(vb),"i"(d0*4096+ks*1024):"memory");
      asm volatile("ds_read_b64_tr_b16 %0,%1 offset:%c2":"=&v"(hi[ks]):"v"(vb),"i"(d0*4096+ks*1024+512):"memory");}
    asm volatile("s_waitcnt lgkmcnt(0)":::"memory");SBAR();
    #define PK(k) (bf16x8){lo[k][0],lo[k][1],lo[k][2],lo[k][3],hi[k][0],hi[k][1],hi[k][2],hi[k][3]}
    o[d0]=__builtin_amdgcn_mfma_f32_32x32x16_bf16(pa0,PK(0),o[d0],0,0,0);
    o[d0]=__builtin_amdgcn_mfma_f32_32x32x16_bf16(pa1,PK(1),o[d0],0,0,0);
    o[d0]=__builtin_amdgcn_mfma_f32_32x32x16_bf16(pa2,PK(2),o[d0],0,0,0);
    o[d0]=__builtin_amdgcn_mfma_f32_32x32x16_bf16(pa3,PK(3),o[d0],0,0,0);
    #undef PK
  }
}
template<int THRL> __device__ __forceinline__ void attn_unit128(int qb,const bf16*Q,const bf16*__restrict__ K,const bf16*__restrict__ V,bf16*O,int opitch,char*shm,const int wid){
  int lane; asm volatile("v_mbcnt_lo_u32_b32 %0, -1, 0\n\tv_mbcnt_hi_u32_b32 %0, -1, %0":"=v"(lane)); const int r32=lane&31,hi=lane>>5;
  const int q0=qb*QB;
  const bf16*Qw=Q+(long)(q0+wid*QBLK)*DM;
  const unsigned lds0=(unsigned)(uintptr_t)shm;
  float*wsf=(float*)(shm+X_WS)+wid*64;
  const unsigned koff=(unsigned)(lane*DM+wid*8)*2u;
  const unsigned voff=(unsigned)((16*(wid&3)+(lane>>2))*DM+(wid>>2)*32+(lane&3)*8)*2u;
  const unsigned kdst=lds0+X_K+wid*1024, vdst=lds0+X_V+wid*1024;
  #define DMA_K(t,slot) glds16s(K+(long)(t)*KVBLK*DM,koff,(unsigned)__builtin_amdgcn_readfirstlane(kdst+(slot)))
  #define DMA_V(t,slot) do{ glds16s(V+(long)(t)*KVBLK*DM,voff,(unsigned)__builtin_amdgcn_readfirstlane(vdst+2*(slot))); glds16s(V+(long)(t)*KVBLK*DM+64,voff,(unsigned)__builtin_amdgcn_readfirstlane(vdst+2*(slot)+8192)); }while(0)
  const int vb0=(int)(lds0+X_V)+((lane>>4)&1)*32+(lane&3)*8+(4*hi+((lane&15)>>2))*64;
  const char*Kbase=shm+X_K; bf16x8 kf[8];
  const lds_cptr shm3=(lds_cptr)shm; const lds_cptr kp0=shm3+X_K+hi*1024+r32*16; const lds_cptr vp0=shm3+X_V+((lane>>4)&1)*32+(lane&3)*8+(4*hi+((lane&15)>>2))*64;
  const int NT=(q0+QB)/KVBLK;
  DMA_K(0,0);DMA_V(0,0);DMA_K(1,SLOTB);
  bf16x8 qr[4];
  #pragma unroll
  for(int d0=0;d0<4;++d0)qr[d0]=*reinterpret_cast<const bf16x8*>(&Qw[(long)r32*DM+d0*16+hi*8]);
  float mhat=0.f,l_reg=0.f;f32x16 o[4];o[0]=f32x16{};o[1]=f32x16{};o[2]=f32x16{};o[3]=f32x16{};
  float zz_=0.f; asm volatile("":"+v"(zz_)); f32x16 negm;
  _Pragma("unroll") for(int r=0;r<16;++r)negm[r]=zz_; asm volatile("":"+v"(negm));
  const int qrel=wid*QBLK+r32;
  #define CMASK(P0,P1,t) do{int jb_=(t)-(NT-4); if(jb_>=0)cmask(P0,P1,jb_,qrel,hi);}while(0)
  bool resc=false;
  #define RESC() do{ if(resc){ asm volatile("s_waitcnt lgkmcnt(0)":::"memory"); \
      _Pragma("unroll") for(int d_=0;d_<4;++d_) _Pragma("unroll") for(int r=0;r<16;++r)o[d_][r]*=wsf[crow(r,hi)]; } }while(0)
  f32x16 C0,C1; u32x4 pw0,pw1,pw2,pw3;
  int sl_prev=0,sl_cur=0,sl_next=SLOTB;
  #define ROT() do{sl_prev=sl_cur;sl_cur=sl_next;sl_next=(sl_next==(XSLOTS-1)*SLOTB)?0:sl_next+SLOTB;}while(0)
  #define PKW(P,B) cvtpk_s(P[B],P[B+1])
  DMA_K(2,2*SLOTB);
  WAIT_BAR(4);
  qkt(C0,C1,Kbase,qr,negm,r32,hi);asm volatile("s_nop 15\n\ts_nop 7":"+v"(C0),"+v"(C1));CMASK(C0,C1,0);
  { const float rm=rowmax(C0,C1); const float dl=rm; mhat=fadd_s(mhat,dl);
    _Pragma("unroll") for(int r=0;r<16;++r){C0[r]=fsub_s(C0[r],dl);C1[r]=fsub_s(C1[r],dl);}
    _Pragma("unroll") for(int r=0;r<16;++r)negm[r]=-mhat; asm volatile("":"+v"(negm));
    _Pragma("unroll") for(int r=0;r<16;++r){C0[r]=__builtin_amdgcn_exp2f(C0[r]);C1[r]=__builtin_amdgcn_exp2f(C1[r]);}
    float sacc=C0[0]+C0[1]; _Pragma("unroll") for(int r=2;r<16;++r)sacc+=C0[r]; _Pragma("unroll") for(int r=0;r<16;++r)sacc+=C1[r]; l_reg+=sacc;
    pw0=(u32x4){PKW(C0,0),PKW(C0,2),PKW(C0,4),PKW(C0,6)};pw1=(u32x4){PKW(C0,8),PKW(C0,10),PKW(C0,12),PKW(C0,14)};pw2=(u32x4){PKW(C1,0),PKW(C1,2),PKW(C1,4),PKW(C1,6)};pw3=(u32x4){PKW(C1,8),PKW(C1,10),PKW(C1,12),PKW(C1,14)}; }
  WAIT_BAR(0);
  DMA_K(3,3*SLOTB);DMA_V(1,SLOTB);
  ROT();
  kload8(kf,kp0+sl_cur);
  WAIT_BAR(3);
  s16x4 vlo[8],vhi[8];
  #define PAF(k) __builtin_bit_cast(bf16x8,pw##k)
  #define VFR(i) (bf16x8){vlo[i][0],vlo[i][1],vlo[i][2],vlo[i][3],vhi[i][0],vhi[i][1],vhi[i][2],vhi[i][3]}
  #define PIN(x) asm volatile("":"+v"(x))
  #define MX3(a,b,c) __builtin_fmaxf(__builtin_fmaxf((a),(b)),(c))
  #define EX(v) __builtin_amdgcn_exp2f(v)
  #define VRDF(s,d,ks) do{ vlo[s]=vtr(vp_+((d)*4096+(ks)*1024)); vhi[s]=vtr(vp_+((d)*4096+(ks)*1024+512)); }while(0)
  #define GA(s,MF) do{ VRDF(s,(s)&3,(s)>>2); SBAR(); MF; SBAR(); }while(0)
  #define EX2(X,B) do{ X[B]=EX(X[B]); X[B+1]=EX(X[B+1]); PIN(X); }while(0)
  #define PK1(W,j,X,B) do{ sacc+=X[B]; sacc+=X[B+1]; W[j]=PKW(X,B); PIN(W); PIN(sacc); }while(0)
  #define KRD(G,j) do{ if(G){ kload2(kf,kp0+sl_next,j); } }while(0)
  #define STEP(t,GK,GV,GL) do{ SBAR(); \
    const lds_cptr vp_=vp0+2*sl_prev; \
    GA(0,C0=__builtin_amdgcn_mfma_f32_32x32x16_bf16(kf[0],qr[0],negm,0,0,0)); \
    GA(1,C1=__builtin_amdgcn_mfma_f32_32x32x16_bf16(kf[1],qr[0],negm,0,0,0)); \
    GA(2,C0=__builtin_amdgcn_mfma_f32_32x32x16_bf16(kf[2],qr[1],C0,0,0,0)); \
    GA(3,C1=__builtin_amdgcn_mfma_f32_32x32x16_bf16(kf[3],qr[1],C1,0,0,0)); \
    GA(4,C0=__builtin_amdgcn_mfma_f32_32x32x16_bf16(kf[4],qr[2],C0,0,0,0)); \
    GA(5,C1=__builtin_amdgcn_mfma_f32_32x32x16_bf16(kf[5],qr[2],C1,0,0,0)); \
    GA(6,C0=__builtin_amdgcn_mfma_f32_32x32x16_bf16(kf[6],qr[3],C0,0,0,0)); \
    GA(7,C1=__builtin_amdgcn_mfma_f32_32x32x16_bf16(kf[7],qr[3],C1,0,0,0)); \
    if(GK){DMA_K((t)+3,sl_prev);} if(GV){DMA_V((t)+1,sl_next);} \
    CMASK(C0,C1,t); \
    { float a=MX3(C0[0],C0[1],C1[0]),b=MX3(C0[2],C0[3],C1[1]); a=MX3(a,C1[2],C1[3]); \
      _Pragma("unroll") for(int r=4;r<16;r+=4){a=MX3(a,C0[r],C0[r+1]);b=MX3(b,C0[r+2],C0[r+3]);a=MX3(a,C1[r],C1[r+1]);b=MX3(b,C1[r+2],C1[r+3]);} \
      float rm=__builtin_fmaxf(a,b); { auto rr=__builtin_amdgcn_permlane32_swap(__float_as_uint(rm),__float_as_uint(rm),false,false); rm=__builtin_fmaxf(__uint_as_float(rr[0]),__uint_as_float(rr[1])); } \
      resc=false; \
      if(__builtin_expect(__any(rm>(float)THRL),0)){ const float dl=__builtin_fmaxf(rm,0.f); mhat+=dl; \
        _Pragma("unroll") for(int r=0;r<16;++r){C0[r]-=dl;C1[r]-=dl;} \
        _Pragma("unroll") for(int r=0;r<16;++r)negm[r]=-mhat; asm volatile("":"+v"(negm)); \
        const float f=__builtin_amdgcn_exp2f(-dl); l_reg*=f; if(hi==0)wsf[r32]=f; resc=true; } } \
    SBAR(); MIDBAR(t); \
    float sacc=0.f; u32x4 nw0=(u32x4){0u,0u,0u,0u},nw1=nw0,nw2=nw0,nw3=nw0; \
    o[0]=__builtin_amdgcn_mfma_f32_32x32x16_bf16(PAF(0),VFR(0),o[0],0,0,0); VRDF(0,0,2); EX2(C0,0); SBAR(); \
    o[1]=__builtin_amdgcn_mfma_f32_32x32x16_bf16(PAF(0),VFR(1),o[1],0,0,0); VRDF(1,1,2); EX2(C0,2); SBAR(); \
    o[2]=__builtin_amdgcn_mfma_f32_32x32x16_bf16(PAF(0),VFR(2),o[2],0,0,0); VRDF(2,2,2); EX2(C0,4); SBAR(); \
    o[3]=__builtin_amdgcn_mfma_f32_32x32x16_bf16(PAF(0),VFR(3),o[3],0,0,0); VRDF(3,3,2); EX2(C0,6); SBAR(); \
    o[0]=__builtin_amdgcn_mfma_f32_32x32x16_bf16(PAF(1),VFR(4),o[0],0,0,0); VRDF(4,0,3); EX2(C0,8);  PK1(nw0,0,C0,0); SBAR(); \
    o[1]=__builtin_amdgcn_mfma_f32_32x32x16_bf16(PAF(1),VFR(5),o[1],0,0,0); VRDF(5,1,3); EX2(C0,10); PK1(nw0,1,C0,2); SBAR(); \
    o[2]=__builtin_amdgcn_mfma_f32_32x32x16_bf16(PAF(1),VFR(6),o[2],0,0,0); VRDF(6,2,3); EX2(C0,12); PK1(nw0,2,C0,4); SBAR(); \
    o[3]=__builtin_amdgcn_mfma_f32_32x32x16_bf16(PAF(1),VFR(7),o[3],0,0,0); VRDF(7,3,3); EX2(C0,14); PK1(nw0,3,C0,6); SBAR(); \
    o[0]=__builtin_amdgcn_mfma_f32_32x32x16_bf16(PAF(2),VFR(0),o[0],0,0,0); KRD(GL,0); EX2(C1,0);  PK1(nw1,0,C0,8);  SBAR(); \
    o[1]=__builtin_amdgcn_mfma_f32_32x32x16_bf16(PAF(2),VFR(1),o[1],0,0,0); KRD(GL,1); EX2(C1,2);  PK1(nw1,1,C0,10); SBAR(); \
    o[2]=__builtin_amdgcn_mfma_f32_32x32x16_bf16(PAF(2),VFR(2),o[2],0,0,0); KRD(GL,2); EX2(C1,4);  PK1(nw1,2,C0,12); SBAR(); \
    o[3]=__builtin_amdgcn_mfma_f32_32x32x16_bf16(PAF(2),VFR(3),o[3],0,0,0); KRD(GL,3); EX2(C1,6);  PK1(nw1,3,C0,14); SBAR(); \
    o[0]=__builtin_amdgcn_mfma_f32_32x32x16_bf16(PAF(3),VFR(4),o[0],0,0,0); EX2(C1,8);  PK1(nw2,0,C1,0); SBAR(); \
    o[1]=__builtin_amdgcn_mfma_f32_32x32x16_bf16(PAF(3),VFR(5),o[1],0,0,0); EX2(C1,10); PK1(nw2,1,C1,2); SBAR(); \
    o[2]=__builtin_amdgcn_mfma_f32_32x32x16_bf16(PAF(3),VFR(6),o[2],0,0,0); EX2(C1,12); PK1(nw2,2,C1,4); PK1(nw3,0,C1,8); SBAR(); \
    o[3]=__builtin_amdgcn_mfma_f32_32x32x16_bf16(PAF(3),VFR(7),o[3],0,0,0); EX2(C1,14); PK1(nw2,3,C1,6); PK1(nw3,1,C1,10); SBAR(); \
    PK1(nw3,2,C1,12); PK1(nw3,3,C1,14); l_reg+=sacc; pw0=nw0; pw1=nw1; pw2=nw2; pw3=nw3; \
    }while(0)
  #define ENDW(tt) do{ if((tt)+3<NT){WAIT_BAR(3);} else if((tt)+2<NT){WAIT_BAR(2);} else {WAIT_BAR(0);} }while(0)
  int t=1;
  #undef CMASK
  #define CMASK(P0,P1,t) do{}while(0)
  const bool grpB=ATT_STAGGER&&(wid>=4);
  #define MIDBAR(tt) do{ if(grpB){ WAIT_BAR(3); } }while(0)
  for(;t<NT-4;++t){ STEP(t,true,true,true); if(!grpB){ WAIT_BAR(3); } RESC(); ROT(); }
  #undef MIDBAR
  #undef CMASK
  #define CMASK(P0,P1,t) do{int jb_=(t)-(NT-4); if(jb_>=0)cmask(P0,P1,jb_,qrel,hi);}while(0)
  #define MIDBAR(tt) do{ if(grpB){ ENDW(tt); } }while(0)
  for(;t<NT-1;++t){ STEP(t,(t+3<NT),(t+1<NT),(t+1<NT)); if(!grpB){ ENDW(t); } RESC(); ROT(); }
  #undef MIDBAR
  #define MIDBAR(tt) do{}while(0)
  STEP(NT-1,false,false,false); RESC();
  #undef MIDBAR
  SBAR(); pv4(o,vb0+2*sl_cur,PAF(0),PAF(1),PAF(2),PAF(3));
  #undef PKW
  #undef PAF
  #undef VFR
  #undef PIN
  #undef MX3
  #undef EX
  #undef VRDF
  #undef GA
  #undef EX2
  #undef PK1
  #undef KRD
  #undef STEP
  #undef ENDW
  {auto rr=__builtin_amdgcn_permlane32_swap(__float_as_uint(l_reg),__float_as_uint(l_reg),false,false);l_reg=__uint_as_float(rr[0])+__uint_as_float(rr[1]);}
  if(hi==0)wsf[32+r32]=l_reg;asm volatile("s_waitcnt lgkmcnt(0)":::"memory");
  { bf16*Of=O+(long)(q0+wid*QBLK)*opitch;
    #pragma unroll
    for(int r=0;r<16;++r){const int orow=crow(r,hi); const float rl=__builtin_amdgcn_rcpf(wsf[32+orow]);
      #pragma unroll
      for(int d0=0;d0<4;++d0)Of[(long)orow*opitch+d0*32+r32]=__float2bfloat16(o[d0][r]*rl);} }
  asm volatile("s_waitcnt lgkmcnt(0)\n\ts_barrier":::"memory");
  #undef DMA_K
  #undef DMA_V
  #undef CMASK
  #undef RESC
  #undef ROT
}

typedef int v8i_t __attribute__((ext_vector_type(8))); typedef int v4i_t __attribute__((ext_vector_type(4)));
constexpr float PV8_VSCALE=16.f, PV8_PBIAS=3.f;
constexpr int Y_K=0, Y_V=XSLOTS*SLOTB, Y_WS=Y_V+XSLOTS*SLOTB, Y_LDS_BYTES=Y_WS+NW*256;
template<int THRL,bool HOST> __device__ __forceinline__ void attn_unit128p8(int qb,const bf16*Q,const bf16*__restrict__ K,const unsigned char*__restrict__ VT,bf16*O,int opitch,char*shm,const int wid,const wconv::Tab&wct,wconv::State&wcs,const unsigned wstage){
  int lane; asm volatile("v_mbcnt_lo_u32_b32 %0, -1, 0\n\tv_mbcnt_hi_u32_b32 %0, -1, %0":"=v"(lane)); const int r32=lane&31,hi=lane>>5;
  const int q0=qb*QB;
  const bf16*Qw=Q+(long)(q0+wid*QBLK)*DM;
  const unsigned lds0=(unsigned)(uintptr_t)shm;
  float*wsf=(float*)(shm+Y_WS)+wid*64;
  const unsigned koff=(unsigned)(lane*DM+wid*8)*2u;
  const unsigned voff=(unsigned)(wid*1024+lane*16);
  const unsigned kdst=lds0+Y_K+wid*1024, vdst=lds0+Y_V+wid*1024;
  #define DMA_K(t,slot) glds16s(K+(long)(t)*KVBLK*DM,koff,(unsigned)__builtin_amdgcn_readfirstlane(kdst+(slot)))
  #define DMA_V(t,slot) glds16s(VT+(long)(t)*8192,voff,(unsigned)__builtin_amdgcn_readfirstlane(vdst+(slot)))
  const char*Kbase=shm+Y_K; bf16x8 kf[8];
  const lds_cptr shm3=(lds_cptr)shm; const lds_cptr kp0=shm3+Y_K+hi*1024+r32*16;
  const int sw_=(r32>>2)&3; const lds_cptr vq0=shm3+Y_V+r32*64+((2*hi)^sw_)*16, vq1=shm3+Y_V+r32*64+(((2*hi)^sw_)^1)*16;
  const int NT=(q0+QB)/KVBLK;
  DMA_K(0,0);DMA_V(0,0);DMA_K(1,SLOTB);
  bf16x8 qr[4];
  #pragma unroll
  for(int d0=0;d0<4;++d0)qr[d0]=*reinterpret_cast<const bf16x8*>(&Qw[(long)r32*DM+d0*16+hi*8]);
  float mhat=0.f,l_reg=0.f;f32x16 o[4];o[0]=f32x16{};o[1]=f32x16{};o[2]=f32x16{};o[3]=f32x16{};
  float zz_=0.f; asm volatile("":"+v"(zz_)); f32x16 negm;
  _Pragma("unroll") for(int r=0;r<16;++r)negm[r]=zz_; asm volatile("":"+v"(negm));
  const int qrel=wid*QBLK+r32;
  #define CMASK(P0,P1,t) do{int jb_=(t)-(NT-4); if(jb_>=0)cmask(P0,P1,jb_,qrel,hi);}while(0)
  bool resc=false;
  #define RESC() do{ if(resc){ asm volatile("s_waitcnt lgkmcnt(0)":::"memory"); \
      _Pragma("unroll") for(int d_=0;d_<4;++d_) _Pragma("unroll") for(int r=0;r<16;++r)o[d_][r]*=wsf[crow(r,hi)]; } }while(0)
  f32x16 C0,C1; v8i_t pw;
  int sl_prev=0,sl_cur=0,sl_next=SLOTB;
  #define ROT() do{sl_prev=sl_cur;sl_cur=sl_next;sl_next=(sl_next==(XSLOTS-1)*SLOTB)?0:sl_next+SLOTB;}while(0)
  #define PK8(X,B) ({ int w_; asm volatile("":"=v"(w_)); w_=__builtin_amdgcn_cvt_pk_fp8_f32(X[B],X[(B)+1],w_,false); __builtin_amdgcn_cvt_pk_fp8_f32(X[(B)+2],X[(B)+3],w_,true); })
  #define PKALL() do{ pw=(v8i_t){PK8(C0,0),PK8(C0,4),PK8(C0,8),PK8(C0,12),PK8(C1,0),PK8(C1,4),PK8(C1,8),PK8(C1,12)}; }while(0)
  DMA_K(2,2*SLOTB);
  WAIT_BAR(3);
  qkt(C0,C1,Kbase,qr,negm,r32,hi);asm volatile("s_nop 15\n\ts_nop 7":"+v"(C0),"+v"(C1));CMASK(C0,C1,0);
  { const float rm=rowmax(C0,C1); const float dl=rm-PV8_PBIAS; mhat=fadd_s(mhat,dl);
    _Pragma("unroll") for(int r=0;r<16;++r){C0[r]=fsub_s(C0[r],dl);C1[r]=fsub_s(C1[r],dl);}
    _Pragma("unroll") for(int r=0;r<16;++r)negm[r]=-mhat; asm volatile("":"+v"(negm));
    _Pragma("unroll") for(int r=0;r<16;++r){C0[r]=__builtin_amdgcn_exp2f(C0[r]);C1[r]=__builtin_amdgcn_exp2f(C1[r]);}
    float sacc=C0[0]+C0[1]; _Pragma("unroll") for(int r=2;r<16;++r)sacc+=C0[r]; _Pragma("unroll") for(int r=0;r<16;++r)sacc+=C1[r]; l_reg+=sacc;
    pw=(v8i_t){PK8(C0,0),PK8(C0,4),PK8(C0,8),PK8(C0,12),PK8(C1,0),PK8(C1,4),PK8(C1,8),PK8(C1,12)}; }
  WAIT_BAR(0);
  DMA_K(3,3*SLOTB);DMA_V(1,SLOTB);
  ROT();
  kload8(kf,kp0+sl_cur);
  WAIT_BAR(2);
  v8i_t vf[4];
  #define PIN(x) asm volatile("":"+v"(x))
  #define MX3(a,b,c) __builtin_fmaxf(__builtin_fmaxf((a),(b)),(c))
  #define EX(v) __builtin_amdgcn_exp2f(v)
  #define VRL(d) do{ vf[d].lo=*(const __attribute__((address_space(3))) v4i_t*)(vq0+sl_prev+(d)*2048); }while(0)
  #define VRH(d) do{ vf[d].hi=*(const __attribute__((address_space(3))) v4i_t*)(vq1+sl_prev+(d)*2048); }while(0)
  #define EX8(X,B) do{ _Pragma("unroll") for(int e_=0;e_<8;++e_)X[(B)+e_]=EX(X[(B)+e_]); PIN(X); }while(0)
  #define SM8(X,B) do{ _Pragma("unroll") for(int e_=0;e_<8;++e_)sacc+=X[(B)+e_]; PIN(sacc); }while(0)
  #define KRD(G,j) do{ if(G){ kload2(kf,kp0+sl_next,j); } }while(0)
  #define MF8(d) o[d]=__builtin_amdgcn_mfma_scale_f32_32x32x64_f8f6f4(pw,vf[d],o[d],0,0,0,0,0,0)
  #define STEP(t,GK,GV,GL) do{ SBAR(); \
    VRL(0); SBAR(); C0=__builtin_amdgcn_mfma_f32_32x32x16_bf16(kf[0],qr[0],negm,0,0,0); SBAR(); \
    VRH(0); SBAR(); C1=__builtin_amdgcn_mfma_f32_32x32x16_bf16(kf[1],qr[0],negm,0,0,0); SBAR(); \
    VRL(1); SBAR(); C0=__builtin_amdgcn_mfma_f32_32x32x16_bf16(kf[2],qr[1],C0,0,0,0); SBAR(); \
    VRH(1); SBAR(); C1=__builtin_amdgcn_mfma_f32_32x32x16_bf16(kf[3],qr[1],C1,0,0,0); SBAR(); \
    VRL(2); SBAR(); C0=__builtin_amdgcn_mfma_f32_32x32x16_bf16(kf[4],qr[2],C0,0,0,0); SBAR(); \
    VRH(2); SBAR(); C1=__builtin_amdgcn_mfma_f32_32x32x16_bf16(kf[5],qr[2],C1,0,0,0); SBAR(); \
    VRL(3); SBAR(); C0=__builtin_amdgcn_mfma_f32_32x32x16_bf16(kf[6],qr[3],C0,0,0,0); SBAR(); \
    VRH(3); SBAR(); C1=__builtin_amdgcn_mfma_f32_32x32x16_bf16(kf[7],qr[3],C1,0,0,0); SBAR(); \
    if(GK){DMA_K((t)+3,sl_prev);} if(GV){DMA_V((t)+1,sl_next);} \
    CMASK(C0,C1,t); \
    SBAR(); \
    float sacc=0.f; \
    MF8(0); KRD(GL,0); EX8(C0,0); SM8(C0,0); SBAR(); \
    MF8(1); KRD(GL,1); EX8(C0,8); SM8(C0,8); SBAR(); \
    MF8(2); KRD(GL,2); EX8(C1,0); SM8(C1,0); SBAR(); \
    MF8(3); KRD(GL,3); EX8(C1,8); SM8(C1,8); SBAR(); \
    PKALL(); \
    resc=false; \
    if(__builtin_expect(__any(sacc>256.f),0)){                  \
      float a=MX3(C0[0],C0[1],C1[0]),b=MX3(C0[2],C0[3],C1[1]); a=MX3(a,C1[2],C1[3]); \
      _Pragma("unroll") for(int r=4;r<16;r+=4){a=MX3(a,C0[r],C0[r+1]);b=MX3(b,C0[r+2],C0[r+3]);a=MX3(a,C1[r],C1[r+1]);b=MX3(b,C1[r+2],C1[r+3]);} \
      float rm=__builtin_fmaxf(a,b); { auto rr=__builtin_amdgcn_permlane32_swap(__float_as_uint(rm),__float_as_uint(rm),false,false); rm=__builtin_fmaxf(__uint_as_float(rr[0]),__uint_as_float(rr[1])); } \
      const float dl=__builtin_fmaxf(__builtin_amdgcn_logf(rm)-PV8_PBIAS,0.f); mhat+=dl; \
      _Pragma("unroll") for(int r=0;r<16;++r)negm[r]=-mhat; asm volatile("":"+v"(negm)); \
      const float f=__builtin_amdgcn_exp2f(-dl); l_reg*=f; sacc*=f; if(hi==0)wsf[r32]=f; resc=true; \
      _Pragma("unroll") for(int r=0;r<16;++r){C0[r]*=f;C1[r]*=f;} \
      PKALL(); } \
    l_reg+=sacc; \
    }while(0)
  #define ENDW(tt) do{ if((tt)+3<NT){WAIT_BAR(2);} else if((tt)+2<NT){WAIT_BAR(1);} else {WAIT_BAR(0);} }while(0)
  int t=1;
  #undef CMASK
  #define CMASK(P0,P1,t) do{}while(0)
  for(;t<NT-4;++t){ STEP(t,true,true,true);
    if(HOST&&((wcs.ctr++&7)==0)&&wcs.idx<wct.total){ wconv::micro(wct,wcs,wstage,lane); WAIT_BAR(7); }
    else{ WAIT_BAR(2); }
    RESC(); ROT(); }
  #undef CMASK
  #define CMASK(P0,P1,t) do{int jb_=(t)-(NT-4); if(jb_>=0)cmask(P0,P1,jb_,qrel,hi);}while(0)
  for(;t<NT-1;++t){ STEP(t,(t+3<NT),(t+1<NT),(t+1<NT)); ENDW(t); RESC(); ROT(); }
  STEP(NT-1,false,false,false); RESC();
  { sl_prev=sl_cur; SBAR();
    VRL(0);VRH(0);VRL(1);VRH(1);VRL(2);VRH(2);VRL(3);VRH(3); SBAR(); MF8(0);MF8(1);MF8(2);MF8(3); }
  #undef PK8
  #undef PKALL
  #undef PIN
  #undef MX3
  #undef EX
  #undef VRL
  #undef VRH
  #undef EX8
  #undef SM8
  #undef KRD
  #undef MF8
  #undef STEP
  #undef ENDW
  {auto rr=__builtin_amdgcn_permlane32_swap(__float_as_uint(l_reg),__float_as_uint(l_reg),false,false);l_reg=__uint_as_float(rr[0])+__uint_as_float(rr[1]);}
  if(hi==0)wsf[32+r32]=l_reg;asm volatile("s_waitcnt lgkmcnt(0)":::"memory");
  { bf16*Of=O+(long)(q0+wid*QBLK)*opitch;
    #pragma unroll
    for(int r=0;r<16;++r){const int orow=crow(r,hi); const float rl=__builtin_amdgcn_rcpf(wsf[32+orow])*(1.f/PV8_VSCALE);
      #pragma unroll
      for(int d0=0;d0<4;++d0)Of[(long)orow*opitch+d0*32+r32]=__float2bfloat16(o[d0][r]*rl);} }
  asm volatile("s_waitcnt lgkmcnt(0)\n\ts_barrier":::"memory");
  #undef DMA_K
  #undef DMA_V
  #undef CMASK
  #undef RESC
  #undef ROT
}

template<int THRL,bool HOST> __device__ __forceinline__ void attn_unit128q8(int qb,const bf16*Q,const unsigned char*__restrict__ K8,const unsigned char*__restrict__ VT,bf16*O,int opitch,char*shm,const int wid,const wconv::Tab&wct,wconv::State&wcs,const unsigned wstage){
  int lane; asm volatile("v_mbcnt_lo_u32_b32 %0, -1, 0\n\tv_mbcnt_hi_u32_b32 %0, -1, %0":"=v"(lane)); const int r32=lane&31,hi=lane>>5;
  const int q0=qb*QB;
  const bf16*Qw=Q+(long)(q0+wid*QBLK)*DM;
  const unsigned lds0=(unsigned)(uintptr_t)shm;
  float*wsf=(float*)(shm+Y_WS)+wid*64;
  const unsigned koff=(unsigned)((wid&3)*1024+lane*16);
  const unsigned voff=(unsigned)(wid*1024+lane*16);
  const unsigned kdst=lds0+Y_K+(wid&3)*1024, vdst=lds0+Y_V+wid*1024;
  #define DMA_K(t,slot) glds16s(K8+(long)(t)*4096,koff,(unsigned)__builtin_amdgcn_readfirstlane(kdst+(slot)))
  #define DMA_V(t,slot) glds16s(VT+(long)(t)*8192,voff,(unsigned)__builtin_amdgcn_readfirstlane(vdst+(slot)))
  v8i_t kf8[2];
  const lds_cptr shm3=(lds_cptr)shm;
  const int sw_=(r32>>2)&3; const lds_cptr vq0=shm3+Y_V+r32*64+((2*hi)^sw_)*16, vq1=shm3+Y_V+r32*64+(((2*hi)^sw_)^1)*16; const lds_cptr kq0=vq0+(Y_K-Y_V), kq1=vq1+(Y_K-Y_V);
  const int NT=(q0+QB)/KVBLK;
  DMA_K(0,0);DMA_V(0,0);DMA_K(1,SLOTB);
  v8i_t q8;
  { u32x4 w_[4];
    #pragma unroll
    for(int i=0;i<4;++i)w_[i]=*reinterpret_cast<const u32x4*>(&Qw[(long)r32*DM+hi*32+8*i]);
    #define BL(x) __uint_as_float((x)<<16)
    #define BH(x) __uint_as_float((x)&0xffff0000u)
    #define Q4(a,b) ({ int w2_=0; w2_=__builtin_amdgcn_cvt_pk_fp8_f32(BL(a),BH(a),w2_,false); __builtin_amdgcn_cvt_pk_fp8_f32(BL(b),BH(b),w2_,true); })
    q8=(v8i_t){Q4(w_[0][0],w_[0][1]),Q4(w_[0][2],w_[0][3]),Q4(w_[1][0],w_[1][1]),Q4(w_[1][2],w_[1][3]),Q4(w_[2][0],w_[2][1]),Q4(w_[2][2],w_[2][3]),Q4(w_[3][0],w_[3][1]),Q4(w_[3][2],w_[3][3])};
    #undef BL
    #undef BH
    #undef Q4
  }
  #define KLD(b,sl) do{ kf8[b].lo=*(const __attribute__((address_space(3))) v4i_t*)(kq0+(sl)+(b)*2048); kf8[b].hi=*(const __attribute__((address_space(3))) v4i_t*)(kq1+(sl)+(b)*2048); }while(0)
  #define QK8(b) __builtin_amdgcn_mfma_scale_f32_32x32x64_f8f6f4(kf8[b],q8,negm,0,0,0,0,0,0)
  float mhat=0.f,l_reg=0.f;f32x16 o[4];o[0]=f32x16{};o[1]=f32x16{};o[2]=f32x16{};o[3]=f32x16{};
  float zz_=0.f; asm volatile("":"+v"(zz_)); f32x16 negm;
  _Pragma("unroll") for(int r=0;r<16;++r)negm[r]=zz_; asm volatile("":"+v"(negm));
  const int qrel=wid*QBLK+r32;
  #define CMASK(P0,P1,t) do{int jb_=(t)-(NT-4); if(jb_>=0)cmask(P0,P1,jb_,qrel,hi);}while(0)
  bool resc=false;
  #define RESC() do{ if(resc){ asm volatile("s_waitcnt lgkmcnt(0)":::"memory"); \
      _Pragma("unroll") for(int d_=0;d_<4;++d_) _Pragma("unroll") for(int r=0;r<16;++r)o[d_][r]*=wsf[crow(r,hi)]; } }while(0)
  f32x16 C0,C1; v8i_t pw;
  int sl_prev=0,sl_cur=0,sl_next=SLOTB;
  #define ROT() do{sl_prev=sl_cur;sl_cur=sl_next;sl_next=(sl_next==(XSLOTS-1)*SLOTB)?0:sl_next+SLOTB;}while(0)
  #define PK8(X,B) ({ int w_; asm volatile("":"=v"(w_)); w_=__builtin_amdgcn_cvt_pk_fp8_f32(X[B],X[(B)+1],w_,false); __builtin_amdgcn_cvt_pk_fp8_f32(X[(B)+2],X[(B)+3],w_,true); })
  #define PKALL() do{ pw=(v8i_t){PK8(C0,0),PK8(C0,4),PK8(C0,8),PK8(C0,12),PK8(C1,0),PK8(C1,4),PK8(C1,8),PK8(C1,12)}; }while(0)
  DMA_K(2,2*SLOTB);
  WAIT_BAR(3);
  KLD(0,0);KLD(1,0);asm volatile("s_waitcnt lgkmcnt(0)":::"memory"); C0=QK8(0); C1=QK8(1); asm volatile("s_nop 15\n\ts_nop 7":"+v"(C0),"+v"(C1));CMASK(C0,C1,0);
  { const float rm=rowmax(C0,C1); const float dl=rm-PV8_PBIAS; mhat=fadd_s(mhat,dl);
    _Pragma("unroll") for(int r=0;r<16;++r){C0[r]=fsub_s(C0[r],dl);C1[r]=fsub_s(C1[r],dl);}
    _Pragma("unroll") for(int r=0;r<16;++r)negm[r]=-mhat; asm volatile("":"+v"(negm));
    _Pragma("unroll") for(int r=0;r<16;++r){C0[r]=__builtin_amdgcn_exp2f(C0[r]);C1[r]=__builtin_amdgcn_exp2f(C1[r]);}
    float sacc=C0[0]+C0[1]; _Pragma("unroll") for(int r=2;r<16;++r)sacc+=C0[r]; _Pragma("unroll") for(int r=0;r<16;++r)sacc+=C1[r]; l_reg+=sacc;
    pw=(v8i_t){PK8(C0,0),PK8(C0,4),PK8(C0,8),PK8(C0,12),PK8(C1,0),PK8(C1,4),PK8(C1,8),PK8(C1,12)}; }
  WAIT_BAR(0);
  DMA_K(3,3*SLOTB);DMA_V(1,SLOTB);
  ROT();
  KLD(0,sl_cur);KLD(1,sl_cur);
  WAIT_BAR(2);
  v8i_t vf[4];
  #define PIN(x) asm volatile("":"+v"(x))
  #define MX3(a,b,c) __builtin_fmaxf(__builtin_fmaxf((a),(b)),(c))
  #define EX(v) __builtin_amdgcn_exp2f(v)
  #define VRL(d) do{ vf[d].lo=*(const __attribute__((address_space(3))) v4i_t*)(vq0+sl_prev+(d)*2048); }while(0)
  #define VRH(d) do{ vf[d].hi=*(const __attribute__((address_space(3))) v4i_t*)(vq1+sl_prev+(d)*2048); }while(0)
  #define EX8(X,B) do{ _Pragma("unroll") for(int e_=0;e_<8;++e_)X[(B)+e_]=EX(X[(B)+e_]); PIN(X); }while(0)
  #define SM8(X,B) do{ _Pragma("unroll") for(int e_=0;e_<8;++e_)sacc+=X[(B)+e_]; PIN(sacc); }while(0)
  #define KRD(G,j) do{ if((G)&&(j)<2){ KLD(j,sl_next); } }while(0)
  #define MF8(d) o[d]=__builtin_amdgcn_mfma_scale_f32_32x32x64_f8f6f4(pw,vf[d],o[d],0,0,0,0,0,0)
  #define STEP(t,GK,GV,GL) do{ SBAR(); \
    VRL(0); VRH(0); VRL(1); VRH(1); SBAR(); C0=QK8(0); SBAR(); \
    VRL(2); VRH(2); VRL(3); VRH(3); SBAR(); C1=QK8(1); SBAR(); \
    if(GK){DMA_K((t)+3,sl_prev);} if(GV){DMA_V((t)+1,sl_next);} \
    CMASK(C0,C1,t); \
    SBAR(); \
    float sacc=0.f; \
    MF8(0); KRD(GL,0); EX8(C0,0); SM8(C0,0); SBAR(); \
    MF8(1); KRD(GL,1); EX8(C0,8); SM8(C0,8); SBAR(); \
    MF8(2); KRD(GL,2); EX8(C1,0); SM8(C1,0); SBAR(); \
    MF8(3); KRD(GL,3); EX8(C1,8); SM8(C1,8); SBAR(); \
    PKALL(); \
    resc=false; \
    if(__builtin_expect(__any(sacc>256.f),0)){                  \
      float a=MX3(C0[0],C0[1],C1[0]),b=MX3(C0[2],C0[3],C1[1]); a=MX3(a,C1[2],C1[3]); \
      _Pragma("unroll") for(int r=4;r<16;r+=4){a=MX3(a,C0[r],C0[r+1]);b=MX3(b,C0[r+2],C0[r+3]);a=MX3(a,C1[r],C1[r+1]);b=MX3(b,C1[r+2],C1[r+3]);} \
      float rm=__builtin_fmaxf(a,b); { auto rr=__builtin_amdgcn_permlane32_swap(__float_as_uint(rm),__float_as_uint(rm),false,false); rm=__builtin_fmaxf(__uint_as_float(rr[0]),__uint_as_float(rr[1])); } \
      const float dl=__builtin_fmaxf(__builtin_amdgcn_logf(rm)-PV8_PBIAS,0.f); mhat+=dl; \
      _Pragma("unroll") for(int r=0;r<16;++r)negm[r]=-mhat; asm volatile("":"+v"(negm)); \
      const float f=__builtin_amdgcn_exp2f(-dl); l_reg*=f; sacc*=f; if(hi==0)wsf[r32]=f; resc=true; \
      _Pragma("unroll") for(int r=0;r<16;++r){C0[r]*=f;C1[r]*=f;} \
      PKALL(); } \
    l_reg+=sacc; \
    }while(0)
  #define ENDW(tt) do{ if((tt)+3<NT){WAIT_BAR(2);} else if((tt)+2<NT){WAIT_BAR(1);} else {WAIT_BAR(0);} }while(0)
  int t=1;
  #undef CMASK
  #define CMASK(P0,P1,t) do{}while(0)
  for(;t<NT-4;++t){ STEP(t,true,true,true);
    if(HOST&&((wcs.ctr++&7)==0)&&wcs.idx<wct.total){ wconv::micro(wct,wcs,wstage,lane); WAIT_BAR(7); }
    else{ WAIT_BAR(2); }
    RESC(); ROT(); }
  #undef CMASK
  #define CMASK(P0,P1,t) do{int jb_=(t)-(NT-4); if(jb_>=0)cmask(P0,P1,jb_,qrel,hi);}while(0)
  for(;t<NT-1;++t){ STEP(t,(t+3<NT),(t+1<NT),(t+1<NT)); ENDW(t); RESC(); ROT(); }
  STEP(NT-1,false,false,false); RESC();
  { sl_prev=sl_cur; SBAR();
    VRL(0);VRH(0);VRL(1);VRH(1);VRL(2);VRH(2);VRL(3);VRH(3); SBAR(); MF8(0);MF8(1);MF8(2);MF8(3); }
  #undef PK8
  #undef PKALL
  #undef PIN
  #undef MX3
  #undef EX
  #undef VRL
  #undef VRH
  #undef EX8
  #undef SM8
  #undef KRD
  #undef KLD
  #undef QK8
  #undef MF8
  #undef STEP
  #undef ENDW
  {auto rr=__builtin_amdgcn_permlane32_swap(__float_as_uint(l_reg),__float_as_uint(l_reg),false,false);l_reg=__uint_as_float(rr[0])+__uint_as_float(rr[1]);}
  if(hi==0)wsf[32+r32]=l_reg;asm volatile("s_waitcnt lgkmcnt(0)":::"memory");
  { bf16*Of=O+(long)(q0+wid*QBLK)*opitch;
    #pragma unroll
    for(int r=0;r<16;++r){const int orow=crow(r,hi); const float rl=__builtin_amdgcn_rcpf(wsf[32+orow])*(1.f/PV8_VSCALE);
      #pragma unroll
      for(int d0=0;d0<4;++d0)Of[(long)orow*opitch+d0*32+r32]=__float2bfloat16(o[d0][r]*rl);} }
  asm volatile("s_waitcnt lgkmcnt(0)\n\ts_barrier":::"memory");
  #undef DMA_K
  #undef DMA_V
  #undef CMASK
  #undef RESC
  #undef ROT
}


constexpr int R_K=0, R_V=32768, R_KG=16384, R_VG=32768, R_LDS_BYTES=R_V+2*R_VG;
template<int THRL,bool HOST> __device__ __forceinline__ void attn_unit128r8(int qb,const bf16*Q,const unsigned char*__restrict__ K8,const unsigned char*__restrict__ VT,bf16*O,int opitch,char*shm,float*wsf0,const int wid,const wconv::Tab&wct,wconv::State&wcs,const unsigned wstage){
  int lane; asm volatile("v_mbcnt_lo_u32_b32 %0, -1, 0\n\tv_mbcnt_hi_u32_b32 %0, -1, %0":"=v"(lane)); const int r32=lane&31,hi=lane>>5;
  const int q0=qb*QB;
  const bf16*Qw=Q+(long)(q0+wid*QBLK)*DM;
  const unsigned lds0=(unsigned)(uintptr_t)shm;
  float*wsf=wsf0+wid*64;
  const unsigned poff=(unsigned)(wid*1024+lane*16);
  const unsigned pdst=lds0+wid*1024;
  #define SEND_K(g,np) do{ const unsigned char*s_=K8+(long)(4*(g)+2)*4096; const unsigned d_=pdst+R_K+(((g)+2)&1)*R_KG; \
      glds16s(s_,poff,(unsigned)__builtin_amdgcn_readfirstlane(d_)); if((np)>1){ glds16s(s_+8192,poff,(unsigned)__builtin_amdgcn_readfirstlane(d_+8192)); } }while(0)
  #define SEND_V(g) do{ const unsigned char*s_=VT+(long)(4*(g))*8192; const unsigned d_=pdst+R_V+((g)&1)*R_VG; \
      _Pragma("unroll") for(int j_=0;j_<4;++j_) glds16s(s_+j_*8192,poff,(unsigned)__builtin_amdgcn_readfirstlane(d_+j_*8192)); }while(0)
  v8i_t kf8[2];
  const lds_cptr shm3=(lds_cptr)shm;
  const int sw_=(r32>>2)&3; const lds_cptr vq0=shm3+R_V+r32*64+((2*hi)^sw_)*16, vq1=shm3+R_V+r32*64+(((2*hi)^sw_)^1)*16; const lds_cptr kq0=vq0+(R_K-R_V), kq1=vq1+(R_K-R_V);
  const int NT=(q0+QB)/KVBLK;
  glds16s(K8,poff,(unsigned)__builtin_amdgcn_readfirstlane(pdst+R_K+R_KG));
  v8i_t q8;
  { u32x4 w_[4];
    #pragma unroll
    for(int i=0;i<4;++i)w_[i]=*reinterpret_cast<const u32x4*>(&Qw[(long)r32*DM+hi*32+8*i]);
    SEND_V(0); SEND_K(0,(qb>0)?2:1);
    #define BL(x) __uint_as_float((x)<<16)
    #define BH(x) __uint_as_float((x)&0xffff0000u)
    #define Q4(a,b) ({ int w2_=0; w2_=__builtin_amdgcn_cvt_pk_fp8_f32(BL(a),BH(a),w2_,false); __builtin_amdgcn_cvt_pk_fp8_f32(BL(b),BH(b),w2_,true); })
    q8=(v8i_t){Q4(w_[0][0],w_[0][1]),Q4(w_[0][2],w_[0][3]),Q4(w_[1][0],w_[1][1]),Q4(w_[1][2],w_[1][3]),Q4(w_[2][0],w_[2][1]),Q4(w_[2][2],w_[2][3]),Q4(w_[3][0],w_[3][1]),Q4(w_[3][2],w_[3][3])};
    #undef BL
    #undef BH
    #undef Q4
  }
  #define KLD(b,ko) do{ kf8[b].lo=*(const __attribute__((address_space(3))) v4i_t*)(kq0+(ko)+(b)*2048); kf8[b].hi=*(const __attribute__((address_space(3))) v4i_t*)(kq1+(ko)+(b)*2048); }while(0)
  #define QK8(b) __builtin_amdgcn_mfma_scale_f32_32x32x64_f8f6f4(kf8[b],q8,negm,0,0,0,0,0,0)
  float mhat=0.f,l_reg=0.f;f32x16 o[4];o[0]=f32x16{};o[1]=f32x16{};o[2]=f32x16{};o[3]=f32x16{};
  float zz_=0.f; asm volatile("":"+v"(zz_)); f32x16 negm;
  _Pragma("unroll") for(int r=0;r<16;++r)negm[r]=zz_; asm volatile("":"+v"(negm));
  const int qrel=wid*QBLK+r32;
  #define CMASK(P0,P1,t) do{int jb_=(t)-(NT-4); if(jb_>=0)cmask(P0,P1,jb_,qrel,hi);}while(0)
  bool resc=false;
  #define RESC() do{ if(resc){ asm volatile("s_waitcnt lgkmcnt(0)":::"memory"); \
      _Pragma("unroll") for(int d_=0;d_<4;++d_) _Pragma("unroll") for(int r=0;r<16;++r)o[d_][r]*=wsf[crow(r,hi)]; } }while(0)
  f32x16 C0,C1; v8i_t pw;
  #define PK8(X,B) ({ int w_; asm volatile("":"=v"(w_)); w_=__builtin_amdgcn_cvt_pk_fp8_f32(X[B],X[(B)+1],w_,false); __builtin_amdgcn_cvt_pk_fp8_f32(X[(B)+2],X[(B)+3],w_,true); })
  #define PKALL() do{ pw=(v8i_t){PK8(C0,0),PK8(C0,4),PK8(C0,8),PK8(C0,12),PK8(C1,0),PK8(C1,4),PK8(C1,8),PK8(C1,12)}; }while(0)
  if(qb>0){ WAIT_BAR(6); } else { WAIT_BAR(5); }
  KLD(0,R_KG);KLD(1,R_KG);asm volatile("s_waitcnt lgkmcnt(0)":::"memory"); C0=QK8(0); C1=QK8(1); asm volatile("s_nop 15\n\ts_nop 7":"+v"(C0),"+v"(C1));CMASK(C0,C1,0);
  { const float rm=rowmax(C0,C1); const float dl=rm-PV8_PBIAS; mhat=fadd_s(mhat,dl);
    _Pragma("unroll") for(int r=0;r<16;++r){C0[r]=fsub_s(C0[r],dl);C1[r]=fsub_s(C1[r],dl);}
    _Pragma("unroll") for(int r=0;r<16;++r)negm[r]=-mhat; asm volatile("":"+v"(negm));
    _Pragma("unroll") for(int r=0;r<16;++r){C0[r]=__builtin_amdgcn_exp2f(C0[r]);C1[r]=__builtin_amdgcn_exp2f(C1[r]);}
    float sacc=C0[0]+C0[1]; _Pragma("unroll") for(int r=2;r<16;++r)sacc+=C0[r]; _Pragma("unroll") for(int r=0;r<16;++r)sacc+=C1[r]; l_reg+=sacc;
    pw=(v8i_t){PK8(C0,0),PK8(C0,4),PK8(C0,8),PK8(C0,12),PK8(C1,0),PK8(C1,4),PK8(C1,8),PK8(C1,12)}; }
  KLD(0,R_KG+4096);KLD(1,R_KG+4096);
  WAIT_BAR(0);
  v8i_t vf[4];
  #define PIN(x) asm volatile("":"+v"(x))
  #define MX3(a,b,c) __builtin_fmaxf(__builtin_fmaxf((a),(b)),(c))
  #define EX(v) __builtin_amdgcn_exp2f(v)
  #define VRL(d,vo) do{ vf[d].lo=*(const __attribute__((address_space(3))) v4i_t*)(vq0+(vo)+(d)*2048); }while(0)
  #define VRH(d,vo) do{ vf[d].hi=*(const __attribute__((address_space(3))) v4i_t*)(vq1+(vo)+(d)*2048); }while(0)
  #define EX8(X,B) do{ _Pragma("unroll") for(int e_=0;e_<8;++e_)X[(B)+e_]=EX(X[(B)+e_]); PIN(X); }while(0)
  #define SM8(X,B) do{ _Pragma("unroll") for(int e_=0;e_<8;++e_)sacc+=X[(B)+e_]; PIN(sacc); }while(0)
  #define KRD(G,j,ko) do{ if((G)&&(j)<2){ KLD(j,ko); } }while(0)
  #define MF8(d) o[d]=__builtin_amdgcn_mfma_scale_f32_32x32x64_f8f6f4(pw,vf[d],o[d],0,0,0,0,0,0)
  #define STEP(t,vo,ko,GL) do{ SBAR(); \
    VRL(0,vo); VRH(0,vo); VRL(1,vo); VRH(1,vo); SBAR(); C0=QK8(0); SBAR(); \
    VRL(2,vo); VRH(2,vo); VRL(3,vo); VRH(3,vo); SBAR(); C1=QK8(1); SBAR(); \
    CMASK(C0,C1,t); \
    SBAR(); \
    float sacc=0.f; \
    MF8(0); KRD(GL,0,ko); EX8(C0,0); SM8(C0,0); SBAR(); \
    MF8(1); KRD(GL,1,ko); EX8(C0,8); SM8(C0,8); SBAR(); \
    MF8(2); EX8(C1,0); SM8(C1,0); SBAR(); \
    MF8(3); EX8(C1,8); SM8(C1,8); SBAR(); \
    PKALL(); \
    resc=false; \
    if(__builtin_expect(__any(sacc>128.f),0)){                  \
      float a=MX3(C0[0],C0[1],C1[0]),b=MX3(C0[2],C0[3],C1[1]); a=MX3(a,C1[2],C1[3]); \
      _Pragma("unroll") for(int r=4;r<16;r+=4){a=MX3(a,C0[r],C0[r+1]);b=MX3(b,C0[r+2],C0[r+3]);a=MX3(a,C1[r],C1[r+1]);b=MX3(b,C1[r+2],C1[r+3]);} \
      float rm=__builtin_fmaxf(a,b); { auto rr=__builtin_amdgcn_permlane32_swap(__float_as_uint(rm),__float_as_uint(rm),false,false); rm=__builtin_fmaxf(__uint_as_float(rr[0]),__uint_as_float(rr[1])); } \
      const float dl=__builtin_fmaxf(__builtin_amdgcn_logf(rm)-PV8_PBIAS,0.f); mhat+=dl; \
      _Pragma("unroll") for(int r=0;r<16;++r)negm[r]=-mhat; asm volatile("":"+v"(negm)); \
      const float f=__builtin_amdgcn_exp2f(-dl); l_reg*=f; sacc*=f; if(hi==0)wsf[r32]=f; resc=true; \
      _Pragma("unroll") for(int r=0;r<16;++r){C0[r]*=f;C1[r]*=f;} \
      PKALL(); } \
    l_reg+=sacc; \
    RESC(); \
    }while(0)
  #define QUAD(g) do{ const int vs_=((g)&1)*R_VG, ks_=((g)&1)*R_KG; const int t0_=4*(g)+1; \
      STEP(t0_,vs_,ks_,true); STEP(t0_+1,vs_+8192,ks_+4096,true); STEP(t0_+2,vs_+16384,ks_+8192,true); STEP(t0_+3,vs_+24576,ks_+12288,true); }while(0)
  int g=0;
  #undef CMASK
  #define CMASK(P0,P1,t) do{}while(0)
  for(;g<qb-1;++g){
    SEND_K(g+1,2); SEND_V(g+1);
    QUAD(g);
    if(HOST&&((wcs.ctr++&1)==0)&&wcs.idx<wct.total){ wconv::micro(wct,wcs,wstage,lane); WAIT_BAR(5); }
    else{ WAIT_BAR(0); }
  }
  #undef CMASK
  #define CMASK(P0,P1,t) do{int jb_=(t)-(NT-4); if(jb_>=0)cmask(P0,P1,jb_,qrel,hi);}while(0)
  if(g<qb){
    SEND_K(g+1,1); SEND_V(g+1);
    QUAD(g);
    WAIT_BAR(0); ++g; }
  { const int vs_=(g&1)*R_VG, ks_=(g&1)*R_KG;
    STEP(NT-3,vs_,ks_,true); STEP(NT-2,vs_+8192,ks_+4096,true); STEP(NT-1,vs_+16384,0,false);
    SBAR(); VRL(0,vs_+24576);VRH(0,vs_+24576);VRL(1,vs_+24576);VRH(1,vs_+24576);VRL(2,vs_+24576);VRH(2,vs_+24576);VRL(3,vs_+24576);VRH(3,vs_+24576); SBAR(); MF8(0);MF8(1);MF8(2);MF8(3); }
  #undef QUAD
  #undef PK8
  #undef PKALL
  #undef PIN
  #undef MX3
  #undef EX
  #undef VRL
  #undef VRH
  #undef EX8
  #undef SM8
  #undef KRD
  #undef KLD
  #undef QK8
  #undef MF8
  #undef STEP
  {auto rr=__builtin_amdgcn_permlane32_swap(__float_as_uint(l_reg),__float_as_uint(l_reg),false,false);l_reg=__uint_as_float(rr[0])+__uint_as_float(rr[1]);}
  if(hi==0)wsf[32+r32]=l_reg;asm volatile("s_waitcnt lgkmcnt(0)":::"memory");
  { bf16*Of=O+(long)(q0+wid*QBLK)*opitch;
    #pragma unroll
    for(int r=0;r<16;++r){const int orow=crow(r,hi); const float rl=__builtin_amdgcn_rcpf(wsf[32+orow])*(1.f/PV8_VSCALE);
      #pragma unroll
      for(int d0=0;d0<4;++d0)Of[(long)orow*opitch+d0*32+r32]=__float2bfloat16(o[d0][r]*rl);} }
  asm volatile("s_waitcnt lgkmcnt(0)\n\ts_barrier":::"memory");
  #undef SEND_K
  #undef SEND_V
  #undef CMASK
  #undef RESC
}

template<int THRL,bool HOST> __device__ __forceinline__ void attn_unit128r9(int qb,const bf16*Q,const unsigned char*__restrict__ K8,const unsigned char*__restrict__ VT,bf16*O,int opitch,char*shm,float*wsf0,const int wid,const wconv::Tab&wct,wconv::State&wcs,const unsigned wstage){
  int lane; asm volatile("v_mbcnt_lo_u32_b32 %0, -1, 0\n\tv_mbcnt_hi_u32_b32 %0, -1, %0":"=v"(lane)); const int r32=lane&31,hi=lane>>5;
  const int q0=qb*QB;
  const bf16*Qw=Q+(long)(q0+wid*QBLK)*DM;
  const unsigned lds0=(unsigned)(uintptr_t)shm;
  float*wsf=wsf0+wid*64;
  const unsigned poff=(unsigned)(wid*1024+lane*16);
  const unsigned pdst=lds0+wid*1024;
  #define SEND_K(g,np) do{ const unsigned char*s_=K8+(long)(4*(g)+2)*4096; const unsigned d_=pdst+R_K+(((g)+2)&1)*R_KG; \
      glds16s(s_,poff,(unsigned)__builtin_amdgcn_readfirstlane(d_)); if((np)>1){ glds16s(s_+8192,poff,(unsigned)__builtin_amdgcn_readfirstlane(d_+8192)); } }while(0)
  #define SEND_V(g) do{ const unsigned char*s_=VT+(long)(4*(g))*8192; const unsigned d_=pdst+R_V+((g)&1)*R_VG; \
      _Pragma("unroll") for(int j_=0;j_<4;++j_) glds16s(s_+j_*8192,poff,(unsigned)__builtin_amdgcn_readfirstlane(d_+j_*8192)); }while(0)
  v8i_t kf8[2];
  const lds_cptr shm3=(lds_cptr)shm;
  const int sw_=(r32>>2)&3; const lds_cptr vq0=shm3+R_V+r32*64+((2*hi)^sw_)*16, vq1=shm3+R_V+r32*64+(((2*hi)^sw_)^1)*16; const lds_cptr kq0=vq0+(R_K-R_V), kq1=vq1+(R_K-R_V);
  const int NT=(q0+QB)/KVBLK;
  glds16s(K8,poff,(unsigned)__builtin_amdgcn_readfirstlane(pdst+R_K+R_KG));
  v8i_t q8;
  { u32x4 w_[4];
    #pragma unroll
    for(int i=0;i<4;++i)w_[i]=*reinterpret_cast<const u32x4*>(&Qw[(long)r32*DM+hi*32+8*i]);
    SEND_V(0); SEND_K(0,(qb>0)?2:1);
    #define BL(x) __uint_as_float((x)<<16)
    #define BH(x) __uint_as_float((x)&0xffff0000u)
    #define Q4(a,b) ({ int w2_=0; w2_=__builtin_amdgcn_cvt_pk_fp8_f32(BL(a),BH(a),w2_,false); __builtin_amdgcn_cvt_pk_fp8_f32(BL(b),BH(b),w2_,true); })
    q8=(v8i_t){Q4(w_[0][0],w_[0][1]),Q4(w_[0][2],w_[0][3]),Q4(w_[1][0],w_[1][1]),Q4(w_[1][2],w_[1][3]),Q4(w_[2][0],w_[2][1]),Q4(w_[2][2],w_[2][3]),Q4(w_[3][0],w_[3][1]),Q4(w_[3][2],w_[3][3])};
    #undef BL
    #undef BH
    #undef Q4
  }
  #define KLD(b,ko) do{ kf8[b].lo=*(const __attribute__((address_space(3))) v4i_t*)(kq0+(ko)+(b)*2048); kf8[b].hi=*(const __attribute__((address_space(3))) v4i_t*)(kq1+(ko)+(b)*2048); }while(0)
  #define QK8(b) __builtin_amdgcn_mfma_scale_f32_32x32x64_f8f6f4(kf8[b],q8,negm,0,0,0,0,0,0)
  float mhat=0.f;f32x16 o[4];
  typedef float f32x4s __attribute__((ext_vector_type(4)));
  const int bs_=((lane&15)==((lane>>4)&1))?0x38383838:0; const v8i_t bsel=(v8i_t){bs_,bs_,bs_,bs_,bs_,bs_,bs_,bs_};
  f32x4s lacc=(f32x4s){0.f,0.f,0.f,0.f},dsum=(f32x4s){0.f,0.f,0.f,0.f};
  #define SUMP() dsum=__builtin_amdgcn_mfma_scale_f32_16x16x128_f8f6f4(pw,bsel,(f32x4s){0.f,0.f,0.f,0.f},0,0,0,0,0,0)
o[0]=f32x16{};o[1]=f32x16{};o[2]=f32x16{};o[3]=f32x16{};
  float zz_=0.f; asm volatile("":"+v"(zz_)); f32x16 negm;
  _Pragma("unroll") for(int r=0;r<16;++r)negm[r]=zz_; asm volatile("":"+v"(negm));
  const int qrel=wid*QBLK+r32;
  #define CMASK(P0,P1,t) do{int jb_=(t)-(NT-4); if(jb_>=0)cmask(P0,P1,jb_,qrel,hi);}while(0)
  bool resc=false;
  #define RESC() do{ if(resc){ asm volatile("s_waitcnt lgkmcnt(0)":::"memory"); \
      _Pragma("unroll") for(int d_=0;d_<4;++d_) _Pragma("unroll") for(int r=0;r<16;++r)o[d_][r]*=wsf[crow(r,hi)]; } }while(0)
  f32x16 C0,C1; v8i_t pw;
  #define PK8(X,B) ({ int w_; asm volatile("":"=v"(w_)); w_=__builtin_amdgcn_cvt_pk_fp8_f32(X[B],X[(B)+1],w_,false); __builtin_amdgcn_cvt_pk_fp8_f32(X[(B)+2],X[(B)+3],w_,true); })
  #define PKALL() do{ pw=(v8i_t){PK8(C0,0),PK8(C0,4),PK8(C0,8),PK8(C0,12),PK8(C1,0),PK8(C1,4),PK8(C1,8),PK8(C1,12)}; }while(0)
  if(qb>0){ WAIT_BAR(6); } else { WAIT_BAR(5); }
  KLD(0,R_KG);KLD(1,R_KG);asm volatile("s_waitcnt lgkmcnt(0)":::"memory"); C0=QK8(0); C1=QK8(1); asm volatile("s_nop 15\n\ts_nop 7":"+v"(C0),"+v"(C1));CMASK(C0,C1,0);
  { const float rm=rowmax(C0,C1); const float dl=rm-PV8_PBIAS; mhat=fadd_s(mhat,dl);
    _Pragma("unroll") for(int r=0;r<16;++r){C0[r]=fsub_s(C0[r],dl);C1[r]=fsub_s(C1[r],dl);}
    _Pragma("unroll") for(int r=0;r<16;++r)negm[r]=-mhat; asm volatile("":"+v"(negm));
    _Pragma("unroll") for(int r=0;r<16;++r){C0[r]=__builtin_amdgcn_exp2f(C0[r]);C1[r]=__builtin_amdgcn_exp2f(C1[r]);}
    pw=(v8i_t){PK8(C0,0),PK8(C0,4),PK8(C0,8),PK8(C0,12),PK8(C1,0),PK8(C1,4),PK8(C1,8),PK8(C1,12)}; SUMP(); }
  KLD(0,R_KG+4096);KLD(1,R_KG+4096);
  WAIT_BAR(0);
  v8i_t vf[4];
  #define PIN(x) asm volatile("":"+v"(x))
  #define MX3(a,b,c) __builtin_fmaxf(__builtin_fmaxf((a),(b)),(c))
  #define EX(v) __builtin_amdgcn_exp2f(v)
  #define VRL(d,vo) do{ vf[d].lo=*(const __attribute__((address_space(3))) v4i_t*)(vq0+(vo)+(d)*2048); }while(0)
  #define VRH(d,vo) do{ vf[d].hi=*(const __attribute__((address_space(3))) v4i_t*)(vq1+(vo)+(d)*2048); }while(0)
  #define EX8(X,B) do{ _Pragma("unroll") for(int e_=0;e_<8;++e_)X[(B)+e_]=EX(X[(B)+e_]); PIN(X); }while(0)
  #define SM8(X,B) do{ _Pragma("unroll") for(int e_=0;e_<8;++e_)sacc+=X[(B)+e_]; PIN(sacc); }while(0)
  #define KRD(G,j,ko) do{ if((G)&&(j)<2){ KLD(j,ko); } }while(0)
  #define MF8(d) o[d]=__builtin_amdgcn_mfma_scale_f32_32x32x64_f8f6f4(pw,vf[d],o[d],0,0,0,0,0,0)
  #define CHECKP() do{ resc=false; \
    const float dm_=__builtin_fmaxf(__builtin_fmaxf(dsum[0],dsum[1]),__builtin_fmaxf(dsum[2],dsum[3])); \
    if(__builtin_expect(__any(!(dm_<256.f)),0)){ \
      float a=MX3(C0[0],C0[1],C1[0]),b=MX3(C0[2],C0[3],C1[1]); a=MX3(a,C1[2],C1[3]); \
      _Pragma("unroll") for(int r=4;r<16;r+=4){a=MX3(a,C0[r],C0[r+1]);b=MX3(b,C0[r+2],C0[r+3]);a=MX3(a,C1[r],C1[r+1]);b=MX3(b,C1[r+2],C1[r+3]);} \
      float rm=__builtin_fmaxf(a,b); { auto rr=__builtin_amdgcn_permlane32_swap(__float_as_uint(rm),__float_as_uint(rm),false,false); rm=__builtin_fmaxf(__uint_as_float(rr[0]),__uint_as_float(rr[1])); } \
      const float dl=__builtin_fmaxf(__builtin_amdgcn_logf(rm)-PV8_PBIAS,0.f); mhat+=dl; \
      _Pragma("unroll") for(int r=0;r<16;++r)negm[r]=-mhat; asm volatile("":"+v"(negm)); \
      const float f=__builtin_amdgcn_exp2f(-dl); if(hi==0)wsf[r32]=f; resc=true; \
      _Pragma("unroll") for(int r=0;r<16;++r){C0[r]*=f;C1[r]*=f;} \
      PKALL(); SUMP(); \
      asm volatile("s_waitcnt lgkmcnt(0)":::"memory"); \
      { const int qb_=(lane&15)*16+4*(lane>>4); _Pragma("unroll") for(int j_=0;j_<4;++j_)lacc[j_]*=wsf[(qb_+j_)&31]; } \
      _Pragma("unroll") for(int d_=0;d_<4;++d_) _Pragma("unroll") for(int r=0;r<16;++r)o[d_][r]*=wsf[crow(r,hi)]; } \
    lacc+=dsum; }while(0)
  #define STEP(t,vo,ko,GL) do{ SBAR(); \
    VRL(0,vo); VRH(0,vo); VRL(1,vo); VRH(1,vo); VRL(2,vo); VRH(2,vo); VRL(3,vo); VRH(3,vo); SBAR(); \
    CHECKP(); SBAR(); \
    C0=QK8(0); SBAR(); C1=QK8(1); SBAR(); \
    CMASK(C0,C1,t); \
    SBAR(); \
    MF8(0); KRD(GL,0,ko); EX8(C0,0); SBAR(); \
    MF8(1); KRD(GL,1,ko); EX8(C0,8); SBAR(); \
    MF8(2); EX8(C1,0); SBAR(); \
    MF8(3); EX8(C1,8); SBAR(); \
    PKALL(); SUMP(); \
    }while(0)
  #define QUAD(g) do{ const int vs_=((g)&1)*R_VG, ks_=((g)&1)*R_KG; const int t0_=4*(g)+1; \
      STEP(t0_,vs_,ks_,true); STEP(t0_+1,vs_+8192,ks_+4096,true); STEP(t0_+2,vs_+16384,ks_+8192,true); STEP(t0_+3,vs_+24576,ks_+12288,true); }while(0)
  int g=0;
  #undef CMASK
  #define CMASK(P0,P1,t) do{}while(0)
  for(;g<qb-1;++g){
    SEND_K(g+1,2); SEND_V(g+1);
    QUAD(g);
    if(HOST&&((wcs.ctr++&1)==0)&&wcs.idx<wct.total){ wconv::micro(wct,wcs,wstage,lane); WAIT_BAR(5); }
    else{ WAIT_BAR(0); }
  }
  #undef CMASK
  #define CMASK(P0,P1,t) do{int jb_=(t)-(NT-4); if(jb_>=0)cmask(P0,P1,jb_,qrel,hi);}while(0)
  if(g<qb){
    SEND_K(g+1,1); SEND_V(g+1);
    QUAD(g);
    WAIT_BAR(0); ++g; }
  { const int vs_=(g&1)*R_VG, ks_=(g&1)*R_KG;
    STEP(NT-3,vs_,ks_,true); STEP(NT-2,vs_+8192,ks_+4096,true); STEP(NT-1,vs_+16384,0,false);
    SBAR(); CHECKP(); SBAR(); VRL(0,vs_+24576);VRH(0,vs_+24576);VRL(1,vs_+24576);VRH(1,vs_+24576);VRL(2,vs_+24576);VRH(2,vs_+24576);VRL(3,vs_+24576);VRH(3,vs_+24576); SBAR(); MF8(0);MF8(1);MF8(2);MF8(3); }
  #undef QUAD
  #undef PK8
  #undef PKALL
  #undef PIN
  #undef MX3
  #undef EX
  #undef VRL
  #undef VRH
  #undef EX8
  #undef SM8
  #undef KRD
  #undef KLD
  #undef QK8
  #undef MF8
  #undef STEP
  #undef CHECKP
  #undef SUMP
  if((lane&15)<2){ const int qb_=(lane&15)*16+4*(lane>>4); _Pragma("unroll") for(int j_=0;j_<4;++j_)wsf[32+qb_+j_]=lacc[j_]; }
  asm volatile("s_waitcnt lgkmcnt(0)":::"memory");
  { bf16*Of=O+(long)(q0+wid*QBLK)*opitch;
    #pragma unroll
    for(int r=0;r<16;++r){const int orow=crow(r,hi); const float rl=__builtin_amdgcn_rcpf(wsf[32+orow])*(1.f/PV8_VSCALE);
      #pragma unroll
      for(int d0=0;d0<4;++d0)Of[(long)orow*opitch+d0*32+r32]=__float2bfloat16(o[d0][r]*rl);} }
  asm volatile("s_waitcnt lgkmcnt(0)\n\ts_barrier":::"memory");
  #undef SEND_K
  #undef SEND_V
  #undef CMASK
  #undef RESC
}


constexpr int BRA_NKT=4, BRA_GRP_BYTES=2*BRA_NKT*8192;
__device__ __forceinline__ void grp_bar(__attribute__((address_space(3))) unsigned* gb,int lane){
  asm volatile("s_waitcnt vmcnt(0) lgkmcnt(0)":::"memory");
  if(lane==0){
    const unsigned g0=__hip_atomic_load(gb+1,__ATOMIC_RELAXED,__HIP_MEMORY_SCOPE_WORKGROUP);
    const unsigned old=__hip_atomic_fetch_add(gb,1u,__ATOMIC_ACQ_REL,__HIP_MEMORY_SCOPE_WORKGROUP);
    if(old==3u){ __hip_atomic_store(gb,0u,__ATOMIC_RELAXED,__HIP_MEMORY_SCOPE_WORKGROUP); __hip_atomic_store(gb+1,g0+1u,__ATOMIC_RELEASE,__HIP_MEMORY_SCOPE_WORKGROUP); }
    else { unsigned sp=0; while(__hip_atomic_load(gb+1,__ATOMIC_ACQUIRE,__HIP_MEMORY_SCOPE_WORKGROUP)==g0){ __builtin_amdgcn_s_sleep(1); if(++sp>(1u<<24))break; } } }
  asm volatile("s_waitcnt lgkmcnt(0)":::"memory");
}
__device__ __forceinline__ void grp_bar_nv(__attribute__((address_space(3))) unsigned* gb,int lane){
  asm volatile("s_waitcnt lgkmcnt(0)":::"memory");
  if(lane==0){
    const unsigned g0=__hip_atomic_load(gb+1,__ATOMIC_RELAXED,__HIP_MEMORY_SCOPE_WORKGROUP);
    const unsigned old=__hip_atomic_fetch_add(gb,1u,__ATOMIC_ACQ_REL,__HIP_MEMORY_SCOPE_WORKGROUP);
    if(old==3u){ __hip_atomic_store(gb,0u,__ATOMIC_RELAXED,__HIP_MEMORY_SCOPE_WORKGROUP); __hip_atomic_store(gb+1,g0+1u,__ATOMIC_RELEASE,__HIP_MEMORY_SCOPE_WORKGROUP); }
    else { unsigned sp=0; while(__hip_atomic_load(gb+1,__ATOMIC_ACQUIRE,__HIP_MEMORY_SCOPE_WORKGROUP)==g0){ __builtin_amdgcn_s_sleep(1); if(++sp>(1u<<24))break; } } }
  asm volatile("s_waitcnt lgkmcnt(0)":::"memory");
}
struct BraUnit {
  const bf16* Q; const bf16* K; const bf16* V;
  bf16* PO; float* PL;
  int kbase, kstride, t_first, nkt;
  int nqt;
  int qbase, qstride, slotA;
  const int* list; int nlist, tile0, ownrow0;
};
#define BMX3(a,b,c) __builtin_fmaxf(__builtin_fmaxf((a),(b)),(c))
template<int MODE,int ABL=0> __device__ __forceinline__ void bra_unit(const BraUnit&u,char*shm  ,float*wsf  ,char*ost  ,__attribute__((address_space(3))) unsigned*gb,const int wg  ,__attribute__((address_space(3))) int*gqn  ,const int unext  ){
  int lane; asm volatile("v_mbcnt_lo_u32_b32 %0, -1, 0\n\tv_mbcnt_hi_u32_b32 %0, -1, %0":"=v"(lane)); const int r32=lane&31,hi=lane>>5;
  const unsigned lds0=(unsigned)(uintptr_t)shm;
  constexpr int BRA_K=0, BRA_V=BRA_NKT*8192;
  if(!(ABL&4)) for(int T=u.t_first;T<u.nkt;++T){
    #pragma unroll
    for(int pi=0;pi<2;++pi){ const int p=wg+4*pi;
      const long krow=u.kbase+(long)u.kstride*(64*T+8*p+(lane>>3)), vrow=u.kbase+(long)u.kstride*(64*T+16*(p&3)+(lane>>2));
      glds16(u.K+krow*DM+(((lane&7)^((4*p+(lane>>4))&7))*8),(unsigned)__builtin_amdgcn_readfirstlane(lds0+BRA_K+T*8192+p*1024));
      glds16(u.V+vrow*DM+(p>>2)*32+(lane&3)*8,(unsigned)__builtin_amdgcn_readfirstlane(lds0+BRA_V+T*8192+p*1024)); } }
  int qrow_[2],ql_[2],Tlo_[2],Thi_[2],slot_[2]; bool valid_[2],masked_[2],have_[2]; bf16x8 qr_[2][4];
  #pragma unroll
  for(int i=0;i<2;++i){ const int qt=wg+4*i; have_[i]=qt<u.nqt; valid_[i]=have_[i]; masked_[i]=true; qrow_[i]=0; ql_[i]=0; Tlo_[i]=0; Thi_[i]=-1; slot_[i]=0;
    if(have_[i]){
      if(MODE==0){ ql_[i]=32*qt+r32; qrow_[i]=u.qbase+u.qstride*ql_[i]; Tlo_[i]=(qt>>1)>u.t_first?(qt>>1):u.t_first; Thi_[i]=(qt>>1)+2; slot_[i]=u.slotA; }
      else { const int g=u.tile0+qt;
        if(g<8){ ql_[i]=32*g+r32; qrow_[i]=u.ownrow0+ql_[i]; Tlo_[i]=0; Thi_[i]=g>>1; slot_[i]=3; }
        else { const int e=(g-8)*32+r32; valid_[i]=e<u.nlist; const int ent=valid_[i]?u.list[e]:0; qrow_[i]=ent&0xffff; slot_[i]=ent>>16; Tlo_[i]=0; Thi_[i]=3; masked_[i]=false; } }
      #pragma unroll
      for(int d0=0;d0<4;++d0){ if(!(ABL&8)) qr_[i][d0]=*reinterpret_cast<const bf16x8*>(&u.Q[(long)qrow_[i]*DM+d0*16+hi*8]); else qr_[i][d0]=bf16x8{}; } } }
  grp_bar(gb,lane);
  if(wg==0&&lane==0)*gqn=unext;
  int*wsi=(int*)wsf+64;
  const int kaddr=r32*128+((hi^((r32>>1)&7))<<4);
  const int vbl=(int)(lds0+BRA_V)+((lane>>4)&1)*32+(lane&3)*8+(4*hi+((lane&15)>>2))*64;
  const unsigned dmax=(MODE==0)?128u:0x7fffffffu;
  #pragma unroll
  for(int i=0;i<2;++i){ if(!have_[i])continue;
    const int qrow=qrow_[i],ql=ql_[i],Tlo=Tlo_[i],Thi=Thi_[i],slot=slot_[i]; const bool valid=valid_[i],masked=masked_[i];
    bf16x8 qr[4];
    #pragma unroll
    for(int d0=0;d0<4;++d0)qr[d0]=qr_[i][d0];
    float mhat=0.f,l_reg=0.f; f32x16 o[2]; o[0]=f32x16{}; o[1]=f32x16{}; float zz_=0.f; asm volatile("":"+v"(zz_)); f32x16 negm;
    _Pragma("unroll") for(int r=0;r<16;++r)negm[r]=zz_;
    if(!(ABL&2)) for(int T=Tlo;T<=Thi;++T){
      f32x16 p0,p1; qkt_rm(p0,p1,shm+BRA_K+T*8192,kaddr,qr,negm);
      if(masked){ const int db=ql-64*T-4*hi+((MODE==0)?128:0);
        #pragma unroll
        for(int r=0;r<16;++r){ const int d=db-((r&3)+8*(r>>2)); if((unsigned)d>dmax)p0[r]=-INFINITY; if((unsigned)(d-32)>dmax)p1[r]=-INFINITY; } }
      float a=BMX3(p0[0],p0[1],p1[0]),b=BMX3(p0[2],p0[3],p1[1]); a=BMX3(a,p1[2],p1[3]);
      #pragma unroll
      for(int r=4;r<16;r+=4){a=BMX3(a,p0[r],p0[r+1]);b=BMX3(b,p0[r+2],p0[r+3]);a=BMX3(a,p1[r],p1[r+1]);b=BMX3(b,p1[r+2],p1[r+3]);}
      float rm=__builtin_fmaxf(a,b); { auto rr=__builtin_amdgcn_permlane32_swap(__float_as_uint(rm),__float_as_uint(rm),false,false); rm=__builtin_fmaxf(__uint_as_float(rr[0]),__uint_as_float(rr[1])); }
      if(__any(rm>8.f)){ const float dl=(rm>8.f)?rm:0.f; mhat+=dl;
        #pragma unroll
        for(int r=0;r<16;++r){p0[r]-=dl;p1[r]-=dl;}
        #pragma unroll
        for(int r=0;r<16;++r)negm[r]=-mhat;
        const float f=__builtin_amdgcn_exp2f(-dl); l_reg*=f; if(hi==0)wsf[r32]=f;
        asm volatile("s_waitcnt lgkmcnt(0)":::"memory");
        #pragma unroll
        for(int d_=0;d_<2;++d_)
          #pragma unroll
          for(int r=0;r<16;++r)o[d_][r]*=wsf[crow(r,hi)];
        asm volatile("s_waitcnt lgkmcnt(0)":::"memory"); }
      float sacc=0.f;
      #pragma unroll
      for(int r=0;r<16;++r){p0[r]=__builtin_amdgcn_exp2f(p0[r]);p1[r]=__builtin_amdgcn_exp2f(p1[r]);sacc+=p0[r]+p1[r];}
      l_reg+=sacc;
      u32x4 pw0,pw1,pw2,pw3;
      pw0=(u32x4){cvtpk_s(p0[0],p0[1]),cvtpk_s(p0[2],p0[3]),cvtpk_s(p0[4],p0[5]),cvtpk_s(p0[6],p0[7])}; pw1=(u32x4){cvtpk_s(p0[8],p0[9]),cvtpk_s(p0[10],p0[11]),cvtpk_s(p0[12],p0[13]),cvtpk_s(p0[14],p0[15])};
      pw2=(u32x4){cvtpk_s(p1[0],p1[1]),cvtpk_s(p1[2],p1[3]),cvtpk_s(p1[4],p1[5]),cvtpk_s(p1[6],p1[7])}; pw3=(u32x4){cvtpk_s(p1[8],p1[9]),cvtpk_s(p1[10],p1[11]),cvtpk_s(p1[12],p1[13]),cvtpk_s(p1[14],p1[15])};
      SBAR(); pv(o,vbl+T*8192,__builtin_bit_cast(bf16x8,pw0),__builtin_bit_cast(bf16x8,pw1),__builtin_bit_cast(bf16x8,pw2),__builtin_bit_cast(bf16x8,pw3));
    }
    {auto rr=__builtin_amdgcn_permlane32_swap(__float_as_uint(l_reg),__float_as_uint(l_reg),false,false);l_reg=__uint_as_float(rr[0])+__uint_as_float(rr[1]);}
    if(hi==0){ wsf[r32]=l_reg; wsi[r32]=valid?(slot*SEQ+qrow):-1; }
    asm volatile("s_waitcnt lgkmcnt(0)":::"memory");
    if(!(ABL&1)) if(hi==0&&valid) u.PL[(long)(slot*SEQ+qrow)*8]=mhat+__builtin_amdgcn_logf(l_reg);
    if(!(ABL&1)) { float rl_[16];
      #pragma unroll
      for(int r=0;r<16;++r)rl_[r]=__builtin_amdgcn_rcpf(wsf[crow(r,hi)]);
      typedef __attribute__((address_space(3))) unsigned short* lds_u16p; typedef unsigned u32x4s __attribute__((ext_vector_type(4)));
      const lds_u16p wp=(lds_u16p)(uintptr_t)(unsigned)(uintptr_t)ost + r32; const int rrow=lane>>2, rch=lane&3;
      #pragma unroll
      for(int d_=0;d_<2;++d_){
        #pragma unroll
        for(int r=0;r<16;++r)wp[crow(r,hi)*32]=(unsigned short)(cvtpk_s(o[d_][r]*rl_[r],0.f)&0xffffu);
        asm volatile("s_waitcnt lgkmcnt(0)":::"memory");
        #pragma unroll
        for(int p=0;p<2;++p){ const int row=16*p+rrow; const u32x4s w=*(const __attribute__((address_space(3))) u32x4s*)((lds_cptr)ost+row*64+rch*16); const int dst=wsi[row];
          if(dst>=0) *(__attribute__((address_space(1))) u32x4s*)(u.PO+(long)dst*512+d_*32+rch*8)=w; }
        asm volatile("s_waitcnt lgkmcnt(0)":::"memory"); } }
  }
}
#undef BMX3
#undef SBAR
#undef WAIT_BAR
}


constexpr int NWAVES = 8;
#ifndef MK_N_LAUNCHES
#define MK_N_LAUNCHES 1
#endif
constexpr int N_PHASES = 24;
static_assert(MK_N_LAUNCHES == 1 || MK_N_LAUNCHES == N_PHASES, "MK_N_LAUNCHES is 1 or 24");

constexpr int S_ = 16384, DM_ = 2048, INW = 6144, NEXP = 16, DEXP = 1024, DEPTH = 2, NROWBLK = 256  ;
constexpr int C_QA = 0, C_KA = 512, C_VA = 1024, C_QB = 1536, C_KB = 2048, C_VB = 2560, C_QC = 3072, C_KC = 4096, C_VC = 5120;
constexpr int MAXPOS = 2 * S_ + NEXP * 256;
constexpr float RMS_EPS = 1e-6f;
#ifndef ATT_PV8
#define ATT_PV8 1
#endif
constexpr float VT8_SCALE = 16.f;
#ifndef ATT_QK8
#define ATT_QK8 1
#endif
#ifndef ATT_R8
#define ATT_R8 1
#endif
#ifndef ABLV
#define ABLV 0
#endif
#ifndef ATT_SUMMFMA
#define ATT_SUMMFMA 0
#endif
#ifndef WC_INLOOP
#define WC_INLOOP 1
#endif
#ifndef GEMM_SP2
#define GEMM_SP2 true
#endif
#ifndef PROJ_FP8
#define PROJ_FP8 1
#endif
#ifndef OUT_FP8
#define OUT_FP8 3
#endif

constexpr size_t MiB = 1u << 20;
constexpr size_t WS_CTL = 0, CTL_ZERO_BYTES = 1 * MiB;
constexpr size_t WS_MOD = 1 * MiB;
constexpr size_t WS_COS = 2 * MiB, WS_SIN = 4 * MiB;
constexpr size_t WS_EID = 6 * MiB;
constexpr size_t WS_WTS = WS_EID + 131072;
constexpr size_t WS_ROWTOK = WS_WTS + 131072;
constexpr size_t WS_ROWW = WS_ROWTOK + 163840;
constexpr size_t WS_CNT = WS_ROWW + 163840;
constexpr size_t WS_KMEAN = 8 * MiB;
constexpr size_t WS_WIN = 16 * MiB;
constexpr size_t WS_WOUT = 64 * MiB;
constexpr size_t WS_WGU = 80 * MiB;
constexpr size_t WS_WDN = 336 * MiB;
constexpr size_t WS_H = 464 * MiB;
constexpr size_t WS_PROJ = 528 * MiB;
constexpr size_t WS_MERGED = 720 * MiB;
constexpr size_t WS_T = 784 * MiB;
constexpr size_t WS_VT8 = 848 * MiB;
constexpr size_t WS_K8 = 864 * MiB;
constexpr size_t WS_ACT = 912 * MiB;
constexpr size_t WS_XS = 984 * MiB;
constexpr size_t WS_POA = WS_ACT;
constexpr size_t WS_POB = WS_POA + 48 * MiB;
constexpr size_t WS_PLA = WS_POB + 64 * MiB;
constexpr size_t WS_PLB = WS_PLA + 2 * MiB;
constexpr size_t WS_LIST = WS_PLB + 2 * MiB;
static_assert(WS_LIST + 32 * MiB <= 1128 * MiB, "partials and lists inside the MoE-only regions");
constexpr size_t WS_Y = WS_PROJ;
constexpr size_t WS_XB = 1128 * MiB;
constexpr size_t WS_END = 1192 * MiB;
static_assert(WS_WIN == wconv::D_WIN && WS_WOUT == wconv::D_WOUT && WS_WGU == wconv::D_WGU && WS_WDN == wconv::D_WDN, "wconv destinations");
static_assert(WS_XS + (size_t)MAXPOS * 2048 * 2 <= WS_END && WS_ACT + (size_t)MAXPOS * 1024 * 2 <= WS_XS && WS_CNT + 16384 <= WS_KMEAN, "d_ws map");
constexpr int CW_TMO = 0, CW_CODE = 1, CW_BAR = 4096;
constexpr int CW_CNTB = 65536, CNTB_PITCH = 32;
constexpr int CW_SELDONE = 8192 + 2048;
constexpr int CW_QUEUE = 8192 + 1024;

constexpr int RING_OFF = 0, RING_BYTES = 131072;
constexpr int LDSCTL_OFF = RING_BYTES, MISC_OFF = LDSCTL_OFF + 320;
constexpr int LT_SEGS = LDSCTL_OFF + 1024;
constexpr int LT_TOT = LT_SEGS + 128;
constexpr int LT_BASE = LT_TOT + 64;
constexpr int LT_CNT = LT_BASE + 64;
constexpr int LT_P2E = LT_CNT + 64;
constexpr int LT_POS = LT_P2E + 160;
constexpr int LDS_BYTES = 163840;
constexpr int ATT_OST_OFF = 147456;
constexpr int ATT_KM_OFF = 0;
constexpr int ATT_WSF_OFF = LDSCTL_OFF + 4096;
constexpr int ATT_UST_OFF = LDSCTL_OFF + 8192, ATT_QN_OFF = ATT_UST_OFF + 2304, ATT_GB_OFF = ATT_QN_OFF + 128;
static_assert(attn_body::R_LDS_BYTES + 32768 <= RING_BYTES, "attention unit key-tile groups + weight-copy stage");
static_assert(LT_POS + 512 <= LDSCTL_OFF + 4096 && attn_body::ATTN_LDS_BYTES <= RING_BYTES && attn_body::X_LDS_BYTES <= RING_BYTES && 2 * attn_body::BRA_GRP_BYTES <= RING_BYTES && ATT_GB_OFF + 64 <= LDS_BYTES, "LDS map");

#define GAS __attribute__((address_space(1)))
#define LAS __attribute__((address_space(3)))
typedef unsigned short bf16;
typedef unsigned v4u __attribute__((ext_vector_type(4)));
typedef unsigned v2u __attribute__((ext_vector_type(2)));
typedef float f32x4 __attribute__((ext_vector_type(4)));
typedef short bf16x8 __attribute__((ext_vector_type(8)));
typedef GAS unsigned gu32;
#define RLX_AGENT __ATOMIC_RELAXED, __HIP_MEMORY_SCOPE_AGENT
#define LDS_WAIT() asm volatile("s_waitcnt lgkmcnt(0)" ::: "memory")
__device__ __forceinline__ unsigned f2bf(float f) { unsigned u = __builtin_bit_cast(unsigned, f); return (u + 0x7fffu + ((u >> 16) & 1u)) >> 16; }
__device__ __forceinline__ unsigned pk2(float lo, float hi) { return f2bf(lo) | (f2bf(hi) << 16); }
__device__ __forceinline__ float bflo(unsigned w) { return __builtin_bit_cast(float, w << 16); }
__device__ __forceinline__ float bfhi(unsigned w) { return __builtin_bit_cast(float, w & 0xffff0000u); }
#ifndef USE_NT
#define USE_NT 1
#endif
#if USE_NT
#define NTL(p) __builtin_nontemporal_load(p)
#define NTS(v, p) __builtin_nontemporal_store((v), (p))
#else
#define NTL(p) (*(p))
#define NTS(v, p) (*(p) = (v))
#endif
__device__ __forceinline__ float shx(float v, int o, int lane) { return __builtin_bit_cast(float, __builtin_amdgcn_ds_bpermute((lane ^ o) << 2, __builtin_bit_cast(int, v))); }
__device__ __forceinline__ int shup_i(int v, int o, int lane) { return __builtin_amdgcn_ds_bpermute(((lane - o) & 63) << 2, v); }
__device__ __forceinline__ float wave_sum(float v, int lane) {
#pragma unroll
    for (int o = 1; o < 64; o <<= 1) v += shx(v, o, lane);
    return v;
}

#define XB_TMO      128
#define XB_XCNT(j)  (256  + 64 * (j))
#define XB_XSUB(j)  (1280 + 64 * (j))
#define XB_XGEN(j)  (2304 + 64 * (j))
#define XB_TOP      3328
#define XB_TOPGEN   3392
#define XCD_BAR_WORDS 3456
#define XB_SPIN_CAP (1u << 18)

__device__ __forceinline__ unsigned xb_ld(unsigned* p)              { return __hip_atomic_load(p, __ATOMIC_RELAXED, __HIP_MEMORY_SCOPE_AGENT); }
__device__ __forceinline__ unsigned xb_add(unsigned* p, unsigned v) { return __hip_atomic_fetch_add(p, v, __ATOMIC_RELAXED, __HIP_MEMORY_SCOPE_AGENT); }
__device__ __forceinline__ unsigned xb_xcc_id() { return (unsigned)__builtin_amdgcn_s_getreg((3 << 11) | 20) & 0xFu; }
#define XB_SPIN(cond, bar) do { unsigned _sp = 0; while (cond) { __builtin_amdgcn_s_sleep(1); \
    if ((++_sp & 255u) == 0u) { if (xb_ld(&(bar)[XB_TMO])) break; if (_sp > XB_SPIN_CAP) { atomicAdd(&(bar)[XB_TMO], 1u); break; } } } } while (0)

struct XcdBarrier {
    unsigned* bar; unsigned x;
    volatile LAS unsigned* st;
};

__device__ __forceinline__ XcdBarrier xcd_barrier_post(unsigned* bar, volatile LAS unsigned* st) {
    XcdBarrier b; b.bar = bar; b.x = xb_xcc_id(); b.st = st;
    if (threadIdx.x == 0) (void)xb_add(&bar[XB_XCNT(b.x)], 1u);
    return b;
}
__device__ __forceinline__ void xcd_barrier_complete(unsigned* bar, unsigned x, unsigned& nloc, unsigned& nx) {
    const unsigned G = gridDim.x * gridDim.y * gridDim.z;
    unsigned sum, cnt, mine, sp = 0u;
    for (;;) {
        sum = 0u; cnt = 0u; mine = 0u;
#pragma unroll
        for (unsigned j = 0; j < 16; ++j) { const unsigned c = xb_ld(&bar[XB_XCNT(j)]); sum += c; cnt += (c > 0u) ? 1u : 0u; mine = (j == x) ? c : mine; }
        if (sum == G) break;
        __builtin_amdgcn_s_sleep(1);
        if ((++sp & 255u) == 0u) { if (xb_ld(&bar[XB_TMO])) break; if (sp > XB_SPIN_CAP) { atomicAdd(&bar[XB_TMO], 1u); break; } }
    }
    nloc = mine > 0u ? mine : 1u; nx = cnt > 0u ? cnt : 1u;
}

__device__ __forceinline__ void xcd_barrier(const XcdBarrier& b) {
    asm volatile("s_waitcnt vmcnt(0)" ::: "memory");
    __syncthreads();
    if (threadIdx.x == 0) {
        unsigned* bar = b.bar; asm volatile("" : "+s"(bar)); unsigned bx_ = b.x; asm volatile("" : "+s"(bx_));
        __builtin_amdgcn_s_waitcnt(0);
        unsigned nloc = b.st[0], nx = b.st[1];
        if (nloc == 0u) { xcd_barrier_complete(bar, bx_, nloc, nx); b.st[0] = nloc; b.st[1] = nx; }
        const unsigned old = xb_add(&bar[XB_XSUB(bx_)], 1u);
        const unsigned gen = old / nloc;
        if (old + 1u == (gen + 1u) * nloc) {
            __builtin_amdgcn_fence(__ATOMIC_RELEASE, "agent");
            asm volatile("s_waitcnt vmcnt(0)" ::: "memory");
            const unsigned og = xb_add(&bar[XB_TOP], 1u);
            const unsigned tg = og / nx;
            if (og + 1u == (tg + 1u) * nx) xb_add(&bar[XB_TOPGEN], 1u);
            else XB_SPIN(xb_ld(&bar[XB_TOPGEN]) == tg, bar);
            __builtin_amdgcn_fence(__ATOMIC_ACQUIRE, "agent");
            xb_add(&bar[XB_XGEN(bx_)], 1u);
            asm volatile("s_waitcnt vmcnt(0)" ::: "memory");
        } else {
            XB_SPIN(xb_ld(&bar[XB_XGEN(bx_)]) == gen, bar);
            __builtin_amdgcn_fence(__ATOMIC_ACQUIRE, "agent");
            asm volatile("s_waitcnt vmcnt(0)" ::: "memory");
        }
    }
    __syncthreads();
}


struct TItem { const float* W; unsigned char* WT; int K, N, map, item, b16; float wsc; };
__device__ __forceinline__ void titem_load(const TItem& t, float (&tv)[32], int lane) {
    const int nblk = t.N / 32, kb = t.item / nblk, nb = t.item % nblk, k0 = 64 * kb, n0 = 32 * nb;
#pragma unroll
    for (int i = 0; i < 32; ++i) tv[i] = t.W[(size_t)(k0 + 2 * i + (lane >> 5)) * t.N + n0 + (lane & 31)];
}
__device__ __forceinline__ void titem_finish(const TItem& t, const float (&tv)[32], LAS float* scr, int lane) {
    const int nblk = t.N / 32, kb = t.item / nblk, nb = t.item % nblk, k0 = 64 * kb, n0 = 32 * nb;
#pragma unroll
    for (int i = 0; i < 32; ++i) scr[(2 * i + (lane >> 5)) * 33 + (lane & 31)] = tv[i] * t.wsc;
    LDS_WAIT(); asm volatile("" ::: "memory");
    if (t.b16) { const int c = lane & 7;
#pragma unroll
        for (int j = 0; j < 4; ++j) { const int n = (lane >> 3) + 8 * j; const LAS float* sp = scr + (8 * c) * 33 + n;
            v4u o; o.x = pk2(sp[0 * 33], sp[1 * 33]); o.y = pk2(sp[2 * 33], sp[3 * 33]); o.z = pk2(sp[4 * 33], sp[5 * 33]); o.w = pk2(sp[6 * 33], sp[7 * 33]);
            *(GAS v4u*)((bf16*)t.WT + (size_t)dest_row(t.map, n0 + n) * t.K + k0 + 8 * c) = o; }
    } else { const int c = lane & 3;
#pragma unroll
        for (int j = 0; j < 2; ++j) { const int n = (lane >> 2) + 16 * j; const LAS float* sp = scr + (16 * c) * 33 + n;
            v4u o; o.x = pg8::pk4_fp8(sp[0 * 33], sp[1 * 33], sp[2 * 33], sp[3 * 33]); o.y = pg8::pk4_fp8(sp[4 * 33], sp[5 * 33], sp[6 * 33], sp[7 * 33]);
            o.z = pg8::pk4_fp8(sp[8 * 33], sp[9 * 33], sp[10 * 33], sp[11 * 33]); o.w = pg8::pk4_fp8(sp[12 * 33], sp[13 * 33], sp[14 * 33], sp[15 * 33]);
            *(GAS v4u*)(t.WT + (size_t)dest_row(t.map, n0 + n) * t.K + k0 + 16 * c) = o; } }
    LDS_WAIT(); asm volatile("" ::: "memory");
}

struct Args { const void* in[20]; float* out; unsigned char* ws; int ph_lo, ph_hi; };

__global__ void __launch_bounds__(NWAVES * 64, 2) fwd(Args args) {
    extern __shared__ __attribute__((aligned(16))) unsigned char lds[];
    LAS unsigned char* const L = (LAS unsigned char*)lds;
    const int kG = gridDim.x, kbx = blockIdx.x;
    const int kwave = __builtin_amdgcn_readfirstlane((int)threadIdx.x >> 6);
    typedef __attribute__((address_space(4))) const Args* kargp_t;
#define PHASE_BEGIN() \
    kargp_t ka = (kargp_t)__builtin_amdgcn_kernarg_segment_ptr(); asm volatile("" : "+s"(ka)); \
    unsigned char* const ws = ka->ws; \
    int lane; asm volatile("v_mbcnt_lo_u32_b32 %0, -1, 0\n\tv_mbcnt_hi_u32_b32 %0, -1, %0" : "=v"(lane)); \
    int G = kG, bx = kbx, wave_s = kwave; asm volatile("" : "+s"(G), "+s"(bx), "+s"(wave_s));     \
    const int vcu = (G % 8 == 0) ? (bx % 8) * (G / 8) + bx / 8 : bx; const int NGW = G * NWAVES; \
    const int wave = wave_s; const int tid = wave * 64 + lane; const int gw = vcu * NWAVES + wave; (void)gw; (void)lane; (void)ws; (void)tid; (void)NGW
#define KIN(T, k) ((const T*)ka->in[k])
    LAS int* const segs = (LAS int*)(L + LT_SEGS); LAS int* const tot = (LAS int*)(L + LT_TOT); LAS int* const basee = (LAS int*)(L + LT_BASE); LAS int* const cnt16 = (LAS int*)(L + LT_CNT);
    LAS unsigned char* const p2e = L + LT_P2E; LAS int* const postab = (LAS int*)(L + LT_POS);
    gu32* const ctl = (gu32*)(args.ws + WS_CTL);

    for (int u = threadIdx.x; u < (LDS_BYTES - LDSCTL_OFF) / 4; u += NWAVES * 64) ((LAS unsigned*)(L + LDSCTL_OFF))[u] = 0u;
    __syncthreads();
    const int lo = args.ph_lo, hi = args.ph_hi;
    XcdBarrier bar; bar.bar = (unsigned*)(ctl + CW_BAR); bar.x = 0; bar.st = nullptr;
    if (hi - lo > 1) bar = xcd_barrier_post((unsigned*)(ctl + CW_BAR), (volatile LAS unsigned*)(L + MISC_OFF) + 8);
#ifndef PHMASK
#define PHMASK 0x1fff
#endif
#define IN(k) (lo <= (k) && (k) < hi)
#define INJ(j) ((((PHMASK) >> (j)) & 1) && IN(pb + (j)))
#ifndef REPEAT_J
#define REPEAT_J (-1)
#endif
#ifndef REPEAT_L
#define REPEAT_L 0
#endif
#ifndef REPEAT_N
#define REPEAT_N 2
#endif
#define REPS(j) ((REPEAT_J == (j) && l == REPEAT_L) ? REPEAT_N : 1)
#if defined(STAMP_A)
    LAS unsigned long long* const stamps = (LAS unsigned long long*)(L + LDSCTL_OFF + 2048); int n_stamp = 0;
#define STAMP() do { if (kbx == 0 && threadIdx.x == 0) stamps[n_stamp] = __builtin_amdgcn_s_memrealtime(); ++n_stamp; } while (0)
    STAMP();
#else
#define STAMP() do { } while (0)
#endif
#define SEAM(k) do { if (IN(k) && IN((k) + 1)) { xcd_barrier(bar); STAMP(); } } while (0)

#define COMPUTE_SEGMENTS(myrb) do { \
        _Pragma("unroll") for (int q_ = 0; q_ < 2; ++q_) { const int e_ = 2 * wave + q_; int t_ = 0, p_ = 0; \
            _Pragma("unroll") for (int j_ = 0; j_ < 4; ++j_) { const int rb_ = lane + 64 * j_; const int c_ = CNT[rb_ * 16 + e_]; t_ += c_; p_ += (rb_ < (myrb)) ? c_ : 0; } \
            t_ = (int)wave_sum((float)t_, lane); p_ = (int)wave_sum((float)p_, lane); if (lane == 0) { tot[e_] = t_; basee[e_] = p_; } } \
        __syncthreads(); \
        if (tid == 0) { int s_ = 0; for (int e_ = 0; e_ < 16; ++e_) { segs[e_] = s_; s_ += (tot[e_] + 255) & ~255; } segs[16] = s_; } \
        __syncthreads(); \
        if (tid < 160) { const int r_ = tid * 256; int e_ = 0; for (int k_ = 1; k_ < 16; ++k_) if (r_ >= segs[k_]) e_ = k_; p2e[tid] = (unsigned char)e_; } \
        if (tid < 16) basee[tid] += segs[tid]; \
        __syncthreads(); } while (0)

    if (((PHMASK >> 11) & 1) && IN(0)) for (int rp = 0; rp < ((REPEAT_J == 11) ? REPEAT_N : 1); ++rp) {
        PHASE_BEGIN();
        const float* const c_in = KIN(float, 1); const int* const positions = KIN(int, 2); const float* const w_ada = KIN(float, 3); const float* const b_ada = KIN(float, 4);
        const float* const w_in = KIN(float, 7); const float* const w_out = KIN(float, 8); const float* const w_gate = KIN(float, 14); const float* const w_up = KIN(float, 15); const float* const w_down = KIN(float, 16);
        float* const MOD = (float*)(ws + WS_MOD); float* const COS = (float*)(ws + WS_COS); float* const SIN = (float*)(ws + WS_SIN);
        unsigned char* const WIN = ws + WS_WIN; unsigned char* const WOUT = ws + WS_WOUT; unsigned char* const WGU = ws + WS_WGU; unsigned char* const WDN = ws + WS_WDN;
        for (int it = bx; it < 192; it += G) {
            const int l = it / 96, cg = it % 96, col = cg * 128 + lane * 2;
            const float* W = w_ada + ((size_t)l * 2048 + wave * 256) * 12288 + col; const float* cc = c_in + wave * 256;
            typedef float f32x2 __attribute__((ext_vector_type(2)));
            f32x2 a = (f32x2){0.f, 0.f};
#pragma unroll 32
            for (int k = 0; k < 256; ++k) { const float cv = cc[k]; const float sv = cv / (1.f + expf(-cv)); a += sv * *(const GAS f32x2*)(W + (size_t)k * 12288); }
            LAS f32x2* red = (LAS f32x2*)L; red[wave * 64 + lane] = a;
            __syncthreads();
            if (tid < 128) { float s = 0.f; const LAS float* rf = (const LAS float*)L;
#pragma unroll
                for (int w = 0; w < 8; ++w) s += rf[(w * 64 + (tid >> 1)) * 2 + (tid & 1)];
                MOD[l * 12288 + cg * 128 + tid] = s + b_ada[l * 12288 + cg * 128 + tid]; }
            __syncthreads();
        }
        { LAS float* scr = (LAS float*)(L + RING_OFF + wave * 16384);
          constexpr int I_IN = (PROJ_FP8 ? 1 : 2) * 32 * 192, N_OUT16 = 2 - ((OUT_FP8 & 1) + ((OUT_FP8 >> 1) & 1)), I_OUT = N_OUT16 * 32 * 64, NITEMS = I_IN + I_OUT;
#define TDECODE(T, it_) do { int r = (it_); \
              if (r < I_IN) { const int l_ = r / 6144; T.W = w_in + (size_t)l_ * 2048 * 6144; T.K = 2048; T.N = 6144; T.map = 1; T.item = r % 6144; T.b16 = PROJ_FP8 ? 0 : 1; T.wsc = PROJ_FP8 ? WSC_K2048 : 1.f; T.WT = WIN + (size_t)l_ * 6144 * (PROJ_FP8 ? 2048 : 4096); break; } r -= I_IN; \
              { const int l_ = (r / 2048 == 0) ? ((OUT_FP8 & 1) ? 1 : 0) : 1; T.W = w_out + (size_t)l_ * 2048 * 2048; T.K = 2048; T.N = 2048; T.map = 0; T.item = r % 2048; T.b16 = 1; T.wsc = 1.f; T.WT = WOUT + (size_t)l_ * 2048 * 4096; } } while (0)
          gu32* const tq = ctl + CW_QUEUE + 256;
          for (;;) {
              int c0 = 0; if (lane == 0) c0 = (int)__hip_atomic_fetch_add(tq, 1u, RLX_AGENT);
              c0 = __builtin_amdgcn_readfirstlane(c0) * 16; if (c0 >= NITEMS) break;
              const int c1 = (c0 + 16 < NITEMS) ? c0 + 16 : NITEMS;
              TItem cur; TDECODE(cur, c0); float tv[32]; titem_load(cur, tv, lane);
              for (int it = c0; it < c1; ++it) {
                  TItem nxt = cur; float tn[32]; const bool hn = it + 1 < c1;
                  if (hn) { TDECODE(nxt, it + 1); titem_load(nxt, tn, lane); }
                  titem_finish(cur, tv, scr, lane);
                  if (hn) { cur = nxt;
#pragma unroll
                      for (int i = 0; i < 32; ++i) tv[i] = tn[i]; }
              }
          }
#undef TDECODE
        }
        for (int idx = (vcu * NWAVES * 64 + tid); idx < S_ * 32; idx += G * NWAVES * 64) {
            const int pi = idx >> 5, i = idx & 31; const float inv = (float)exp2(-(double)i * (13.287712379549449 / 32.0)); const float ang = (float)positions[pi] * inv;
            COS[idx] = cosf(ang); SIN[idx] = sinf(ang); }
    }
    SEAM(0);

#if defined(EXTRA_BARRIERS)
    if (lo == 0 && hi - lo > 1) for (int xb = 0; xb < EXTRA_BARRIERS; ++xb) xcd_barrier(bar);
#endif
    for (int l = 0; l < DEPTH; ++l) {
        const int pb = 1 + 11 * l;
        const float lam_init = (l == 0) ? 0.2f : 0.35550906759f;
        if (INJ(0)) for (int rp = 0; rp < REPS(0); ++rp) {
            PHASE_BEGIN();
            const float* const x_in = KIN(float, 0); const float* const g_attn = KIN(float, 5); bf16* const xbuf = (bf16*)(ws + WS_XB);
            const float* const MOD = (const float*)(ws + WS_MOD); const float* const mod = MOD + l * 12288; unsigned char* const HB = ws + WS_H; const bf16* const YB = (const bf16*)(ws + WS_Y);
            LAS f32x4* const cAl = (LAS f32x4*)L; LAS f32x4* const cBl = cAl + 512; LAS f32x4* const cGl = cAl + 1024;
            { const int c4 = tid; const f32x4 g = ((const f32x4*)(g_attn + l * 2048))[c4]; const f32x4 sc = ((const f32x4*)(mod + 2048))[c4];
              cAl[c4] = g * (1.f + sc); cBl[c4] = ((const f32x4*)(mod + 0))[c4]; cGl[c4] = (l > 0) ? ((const f32x4*)(MOD + (l - 1) * 12288 + 10240))[c4] : (f32x4){0.f, 0.f, 0.f, 0.f}; }
            __syncthreads();
#define XLOAD(WY_, dst, r_) do { if (WY_) { const v2u xw_ = NTL((const GAS v2u*)(xbuf + (size_t)(r_) * 2048) + (lane + 64 * j)); dst = (f32x4){bflo(xw_.x), bfhi(xw_.x), bflo(xw_.y), bfhi(xw_.y)}; } \
                              else dst = NTL((const GAS f32x4*)(x_in + (size_t)(r_) * 2048) + (lane + 64 * j)); } while (0)
#define NORM_LOOP(WITH_Y) do { \
            f32x4 nv[8]; v2u na[8], nb[8]; \
            _Pragma("unroll") for (int j = 0; j < 8; ++j) { XLOAD(WITH_Y, nv[j], gw); \
                if (WITH_Y) { na[j] = NTL((const GAS v2u*)(YB + (size_t)(2 * gw) * 2048) + (lane + 64 * j)); nb[j] = NTL((const GAS v2u*)(YB + (size_t)(2 * gw + 1) * 2048) + (lane + 64 * j)); } } \
            for (int row = gw; row < S_; row += NGW) { \
                f32x4 v[8]; \
                _Pragma("unroll") for (int j = 0; j < 8; ++j) v[j] = nv[j]; \
                if (WITH_Y) { \
                    _Pragma("unroll") for (int j = 0; j < 8; ++j) { const v2u a = na[j], b = nb[j]; \
                        const f32x4 ys = (f32x4){bflo(a.x) + bflo(b.x), bfhi(a.x) + bfhi(b.x), bflo(a.y) + bflo(b.y), bfhi(a.y) + bfhi(b.y)}; \
                        v[j] += cGl[lane + 64 * j] * ys; v2u xo_; xo_.x = pk2(v[j].x, v[j].y); xo_.y = pk2(v[j].z, v[j].w); ((GAS v2u*)(xbuf + (size_t)row * 2048))[lane + 64 * j] = xo_; \
                        v[j] = (f32x4){bflo(xo_.x), bfhi(xo_.x), bflo(xo_.y), bfhi(xo_.y)}; } \
                } \
                const int nrow = row + NGW; \
                if (nrow < S_) { \
                    _Pragma("unroll") for (int j = 0; j < 8; ++j) { XLOAD(WITH_Y, nv[j], nrow); \
                        if (WITH_Y) { na[j] = NTL((const GAS v2u*)(YB + (size_t)(2 * nrow) * 2048) + (lane + 64 * j)); nb[j] = NTL((const GAS v2u*)(YB + (size_t)(2 * nrow + 1) * 2048) + (lane + 64 * j)); } } \
                } \
                float ss = 0.f; \
                _Pragma("unroll") for (int j = 0; j < 8; ++j) ss += (v[j].x * v[j].x + v[j].y * v[j].y) + (v[j].z * v[j].z + v[j].w * v[j].w); \
                const float rs = 1.f / sqrtf(wave_sum(ss, lane) * (1.f / 2048.f) + RMS_EPS); \
                _Pragma("unroll") for (int j = 0; j < 8; ++j) { const f32x4 o = v[j] * rs * cAl[lane + 64 * j] + cBl[lane + 64 * j]; \
                    if (PROJ_FP8) ((GAS unsigned*)(HB + (size_t)row * 2048))[lane + 64 * j] = pg8::pk4_fp8(o.x, o.y, o.z, o.w); \
                    else { v2u w; w.x = pk2(o.x, o.y); w.y = pk2(o.z, o.w); ((GAS v2u*)((bf16*)HB + (size_t)row * 2048))[lane + 64 * j] = w; } } \
            } } while (0)
            if (l == 0) NORM_LOOP(false); else NORM_LOOP(true);
#undef NORM_LOOP
#undef XLOAD
        }
        SEAM(pb + 0);
        if (INJ(1)) for (int rp = 0; rp < REPS(1); ++rp) {
            PHASE_BEGIN();
            unsigned char* const HB = ws + WS_H; unsigned char* const WIN = ws + WS_WIN; bf16* const PROJ = (bf16*)(ws + WS_PROJ); const float* const COS = (const float*)(ws + WS_COS); const float* const SIN = (const float*)(ws + WS_SIN);
            constexpr int KBP = PROJ_FP8 ? 2048 : 4096;
            pg8::DenseSched Sd; Sd.init(HB, WIN + (size_t)l * 6144 * KBP, S_, INW, KBP, G, bx);
            pg8::EpiProj E{PROJ, COS, SIN, attn_body::C2, PROJ_FP8 ? 1.f / WSC_K2048 : 1.f};
            pg8::gemm_phase<pg8::EpiProj, pg8::DenseSched, true, GEMM_SP2, PROJ_FP8 != 0>(L + RING_OFF, KBP, Sd, E, wave_s);
        }
        SEAM(pb + 1);
        if (INJ(2)) for (int rp = 0; rp < REPS(2); ++rp) {
            PHASE_BEGIN();
            const bf16* const PROJ = (const bf16*)(ws + WS_PROJ); float* const KMEAN = (float*)(ws + WS_KMEAN);
#if ATT_PV8 && ATT_QK8
            for (int t = gw; t < 4096; t += NGW) { const int st = t >> 8, kt = t & 255, hd2 = st >> 1, mp2 = st & 1, c = lane & 3;
                const bf16* const src = PROJ + (size_t)(64 * kt) * 6144 + C_KC + hd2 * 128 + mp2 * 64 + c * 16;
                unsigned char* const dst = ws + WS_K8 + (size_t)t * 4096;
                v4u ka[4], kb[4];
#pragma unroll
                for (int p = 0; p < 4; ++p) { const int key = 16 * p + (lane >> 2); ka[p] = *(const GAS v4u*)(src + (size_t)key * 6144); kb[p] = *(const GAS v4u*)(src + (size_t)key * 6144 + 8); }
#pragma unroll
                for (int p = 0; p < 4; ++p) { const int key = 16 * p + (lane >> 2); const v4u a = ka[p], b = kb[p];
                    v4u o; o.x = pg8::pk4_fp8(bflo(a.x), bfhi(a.x), bflo(a.y), bfhi(a.y)); o.y = pg8::pk4_fp8(bflo(a.z), bfhi(a.z), bflo(a.w), bfhi(a.w));
                    o.z = pg8::pk4_fp8(bflo(b.x), bfhi(b.x), bflo(b.y), bfhi(b.y)); o.w = pg8::pk4_fp8(bflo(b.z), bfhi(b.z), bflo(b.w), bfhi(b.w));
                    *(GAS v4u*)(dst + key * 64 + ((c ^ ((key >> 2) & 3)) * 16)) = o; }
            }
#endif
#if ATT_PV8
            for (int t = gw; t < 2048; t += NGW) { const int h = t >> 8, kt = t & 255;
                const bf16* const src = PROJ + (size_t)(64 * kt) * 6144 + C_VC + h * 128 + 2 * lane;
                unsigned char* const dst = ws + WS_VT8 + (size_t)t * 8192 + (size_t)(2 * lane) * 64; const int sw = (lane >> 1) & 3;
                unsigned oa[16], ob[16];
#pragma unroll
                for (int g = 0; g < 16; ++g) { unsigned w0, w1, w2, w3;
                    w0 = *(const GAS unsigned*)(src + (size_t)(4 * g + 0) * 6144); w1 = *(const GAS unsigned*)(src + (size_t)(4 * g + 1) * 6144);
                    w2 = *(const GAS unsigned*)(src + (size_t)(4 * g + 2) * 6144); w3 = *(const GAS unsigned*)(src + (size_t)(4 * g + 3) * 6144);
                    const int w = (g & 1) * 8 + ((g >> 3) & 1) * 4 + ((g >> 1) & 3);
                    oa[w] = pg8::pk4_fp8(bflo(w0) * VT8_SCALE, bflo(w1) * VT8_SCALE, bflo(w2) * VT8_SCALE, bflo(w3) * VT8_SCALE);
                    ob[w] = pg8::pk4_fp8(bfhi(w0) * VT8_SCALE, bfhi(w1) * VT8_SCALE, bfhi(w2) * VT8_SCALE, bfhi(w3) * VT8_SCALE); }
#pragma unroll
                for (int c = 0; c < 4; ++c) { *(GAS v4u*)(dst + ((c ^ sw) * 16)) = (v4u){oa[4 * c], oa[4 * c + 1], oa[4 * c + 2], oa[4 * c + 3]};
                    *(GAS v4u*)(dst + 64 + ((c ^ sw) * 16)) = (v4u){ob[4 * c], ob[4 * c + 1], ob[4 * c + 2], ob[4 * c + 3]}; }
            }
#endif
            for (int t = gw; t < 512; t += NGW) { const int h = t >> 6, j = t & 63; const int rg = lane >> 3, ch = lane & 7;
                float a[8];
#pragma unroll
                for (int e = 0; e < 8; ++e) a[e] = 0.f;
                for (int hb = 0; hb < 2; ++hb) { v4u kw[16];
#pragma unroll
                    for (int it = 0; it < 16; ++it) kw[it] = *(const GAS v4u*)(PROJ + (size_t)(256 * j + 8 * (16 * hb + it) + rg) * 6144 + C_KB + 64 * h + 8 * ch);
#pragma unroll
                    for (int it = 0; it < 16; ++it) { const v4u w = kw[it];
                        a[0] += bflo(w.x); a[1] += bfhi(w.x); a[2] += bflo(w.y); a[3] += bfhi(w.y); a[4] += bflo(w.z); a[5] += bfhi(w.z); a[6] += bflo(w.w); a[7] += bfhi(w.w); } }
#pragma unroll
                for (int e = 0; e < 8; ++e) { a[e] += shx(a[e], 8, lane); a[e] += shx(a[e], 16, lane); a[e] += shx(a[e], 32, lane); }
                if (lane < 8) {
#pragma unroll
                    for (int e = 0; e < 8; ++e) KMEAN[(size_t)(h * 64 + j) * 64 + 8 * lane + e] = a[e] * (1.f / 256.f); }
            }
        }
        SEAM(pb + 2);
        if (INJ(4)) for (int rp = 0; rp < REPS(4); ++rp) {
            PHASE_BEGIN();
            const bf16* const PROJ = (const bf16*)(ws + WS_PROJ); bf16* const TB = (bf16*)(ws + WS_T);
            char* const shm = (char*)lds + RING_OFF;
            if (rp == 0) {
            const float* const KMEAN = (const float*)(ws + WS_KMEAN); int* const LISTB = (int*)(ws + WS_LIST);
            int* const CNTB = (int*)(ctl + CW_CNTB + l * 512 * CNTB_PITCH);
            for (int it = vcu; it < 512; it += G) { const int hd = it & 7, qq = it >> 3, qb = (qq & 1) ? 63 - (qq >> 1) : (qq >> 1);
                if (qb == 0) continue;
                LAS float* km = (LAS float*)(L + ATT_KM_OFF);
                __syncthreads();
                for (int k4 = tid; k4 < qb * 16; k4 += NWAVES * 64) ((LAS f32x4*)km)[k4] = ((const GAS f32x4*)(KMEAN + (size_t)hd * 64 * 64))[k4];
                const int q = tid >> 1, dh = tid & 1; float qf[32];
                { const bf16* qrow = PROJ + (size_t)(qb * 256 + q) * 6144 + C_QB + hd * 64 + dh * 32;
#pragma unroll
                  for (int c8 = 0; c8 < 4; ++c8) { const v4u w = *(const GAS v4u*)(qrow + 8 * c8); qf[8 * c8 + 0] = bflo(w.x); qf[8 * c8 + 1] = bfhi(w.x); qf[8 * c8 + 2] = bflo(w.y); qf[8 * c8 + 3] = bfhi(w.y);
                      qf[8 * c8 + 4] = bflo(w.z); qf[8 * c8 + 5] = bfhi(w.z); qf[8 * c8 + 6] = bflo(w.w); qf[8 * c8 + 7] = bfhi(w.w); } }
                __syncthreads();
                float b0 = -INFINITY, b1 = -INFINITY, b2 = -INFINITY; int i0 = -1, i1 = -1, i2 = -1;
                for (int j = 0; j < qb; ++j) { const LAS f32x4* kr = (const LAS f32x4*)(km + j * 64 + dh * 32); float g = 0.f;
#pragma unroll
                    for (int c4 = 0; c4 < 8; ++c4) { const f32x4 kv = kr[c4]; g = fmaf(qf[4 * c4 + 0], kv.x, g); g = fmaf(qf[4 * c4 + 1], kv.y, g); g = fmaf(qf[4 * c4 + 2], kv.z, g); g = fmaf(qf[4 * c4 + 3], kv.w, g); }
                    g += shx(g, 1, lane);
                    if (g > b0) { b2 = b1; i2 = i1; b1 = b0; i1 = i0; b0 = g; i0 = j; } else if (g > b1) { b2 = b1; i2 = i1; b1 = g; i1 = j; } else if (g > b2) { b2 = g; i2 = j; } }
                if (dh == 0) { const int row = qb * 256 + q;
                    if (i0 >= 0) { const int p = __hip_atomic_fetch_add(CNTB + (hd * 64 + i0) * CNTB_PITCH, 1, RLX_AGENT); LISTB[(size_t)(hd * 64 + i0) * 16384 + p] = row; }
                    if (i1 >= 0) { const int p = __hip_atomic_fetch_add(CNTB + (hd * 64 + i1) * CNTB_PITCH, 1, RLX_AGENT); LISTB[(size_t)(hd * 64 + i1) * 16384 + p] = row | (1 << 16); }
                    if (i2 >= 0) { const int p = __hip_atomic_fetch_add(CNTB + (hd * 64 + i2) * CNTB_PITCH, 1, RLX_AGENT); LISTB[(size_t)(hd * 64 + i2) * 16384 + p] = row | (2 << 16); } }
            }
            asm volatile("s_waitcnt vmcnt(0)" ::: "memory"); __syncthreads();
            if (tid == 0) { __builtin_amdgcn_fence(__ATOMIC_RELEASE, "agent"); asm volatile("s_waitcnt vmcnt(0)" ::: "memory"); __hip_atomic_fetch_add(ctl + CW_SELDONE + 64 * l, 1u, RLX_AGENT); }
            }
            wconv::Tab wct; wct.w_in = KIN(float, 7); wct.w_out = KIN(float, 8); wct.w_gate = KIN(float, 14); wct.w_up = KIN(float, 15); wct.w_down = KIN(float, 16); wct.ws = ws; wct.l = l;
            wct.n_out = ((OUT_FP8 >> l) & 1) ? 4096 : 0; wct.total = wct.n_out + 65536 + 32768 + ((l == 0 && PROJ_FP8) ? 12288 : 0);
            wconv::State wcs; wcs.idx = gw; wcs.staged = gw; wcs.ctr = 0; wcs.stride = NGW;
            const unsigned wstage = (unsigned)(uintptr_t)(L + RING_OFF) + 98304u + 4096u * (unsigned)wave_s;
            if (rp == 0) { int ln3; asm volatile("v_mbcnt_lo_u32_b32 %0, -1, 0\n\tv_mbcnt_hi_u32_b32 %0, -1, %0" : "=v"(ln3)); wconv::issue(wct, wcs.idx, wstage, ln3); wcs.idx += wcs.stride; }
#if !defined(NO_ATT_C)
#if defined(REPEAT_SKIP_C)
            if (rp == 0)
#endif
            for (int vc = vcu; vc < 256; vc += G) {
                const int st = vc >> 4, hd = st >> 1, mp = st & 1, s = vc & 15;
                const attn_body::bf16* Qp = (const attn_body::bf16*)PROJ + C_QC + hd * 128 + mp * 64; const attn_body::bf16* Kp = (const attn_body::bf16*)PROJ + C_KC + hd * 128 + mp * 64;
                const attn_body::bf16* Vp = (const attn_body::bf16*)PROJ + C_VC + hd * 128; attn_body::bf16* Op = (attn_body::bf16*)TB + (size_t)mp * S_ * 1024 + hd * 128;
                for (int i = 3; i >= 0; --i) { const int qb = 32 * (i >> 1) + ((i & 1) ? 31 - s : s);
#if ATT_PV8 && ATT_QK8 && ATT_R8 && ATT_SUMMFMA
                    const unsigned char* const K8p = ws + WS_K8 + (size_t)st * 256 * 4096; float* const wsfc = (float*)((char*)lds + ATT_WSF_OFF);
                    if (rp == 0) attn_body::attn_unit128r9<8, WC_INLOOP != 0>(qb, Qp, K8p, ws + WS_VT8 + (size_t)hd * 256 * 8192, Op, 1024, shm, wsfc, wave_s, wct, wcs, wstage);
                    else attn_body::attn_unit128r9<8, false>(qb, Qp, K8p, ws + WS_VT8 + (size_t)hd * 256 * 8192, Op, 1024, shm, wsfc, wave_s, wct, wcs, wstage); }
#elif ATT_PV8 && ATT_QK8 && ATT_R8
                    const unsigned char* const K8p = ws + WS_K8 + (size_t)st * 256 * 4096; float* const wsfc = (float*)((char*)lds + ATT_WSF_OFF);
                    if (rp == 0) attn_body::attn_unit128r8<8, WC_INLOOP != 0>(qb, Qp, K8p, ws + WS_VT8 + (size_t)hd * 256 * 8192, Op, 1024, shm, wsfc, wave_s, wct, wcs, wstage);
                    else attn_body::attn_unit128r8<8, false>(qb, Qp, K8p, ws + WS_VT8 + (size_t)hd * 256 * 8192, Op, 1024, shm, wsfc, wave_s, wct, wcs, wstage); }
#elif ATT_PV8 && ATT_QK8
                    const unsigned char* const K8p = ws + WS_K8 + (size_t)st * 256 * 4096;
                    if (rp == 0) attn_body::attn_unit128q8<8, WC_INLOOP != 0>(qb, Qp, K8p, ws + WS_VT8 + (size_t)hd * 256 * 8192, Op, 1024, shm, wave_s, wct, wcs, wstage);
                    else attn_body::attn_unit128q8<8, false>(qb, Qp, K8p, ws + WS_VT8 + (size_t)hd * 256 * 8192, Op, 1024, shm, wave_s, wct, wcs, wstage); }
#elif ATT_PV8
                    if (rp == 0) attn_body::attn_unit128p8<8, WC_INLOOP != 0>(qb, Qp, Kp, ws + WS_VT8 + (size_t)hd * 256 * 8192, Op, 1024, shm, wave_s, wct, wcs, wstage);
                    else attn_body::attn_unit128p8<8, false>(qb, Qp, Kp, ws + WS_VT8 + (size_t)hd * 256 * 8192, Op, 1024, shm, wave_s, wct, wcs, wstage); }
#else
                    attn_body::attn_unit128<8>(qb, Qp, Kp, Vp, Op, 1024, shm, wave_s); }
#endif
            }
#endif
            if (rp == 0) { int ln3; asm volatile("v_mbcnt_lo_u32_b32 %0, -1, 0\n\tv_mbcnt_hi_u32_b32 %0, -1, %0" : "=v"(ln3));
                asm volatile("s_waitcnt vmcnt(0)" ::: "memory"); wconv::finish(wct, wcs.staged, wstage, ln3);
                while (wcs.idx < wct.total) { asm volatile("s_waitcnt lgkmcnt(0)" ::: "memory"); wconv::issue(wct, wcs.idx, wstage, ln3); asm volatile("s_waitcnt vmcnt(0)" ::: "memory"); wconv::finish(wct, wcs.idx, wstage, ln3); wcs.idx += wcs.stride; }
                asm volatile("s_waitcnt vmcnt(0) lgkmcnt(0)" ::: "memory"); }
            { int ln2; asm volatile("v_mbcnt_lo_u32_b32 %0, -1, 0\n\tv_mbcnt_hi_u32_b32 %0, -1, %0" : "=v"(ln2)); const int t2 = wave_s * 64 + ln2;
              LAS int* const ust = (LAS int*)(L + ATT_UST_OFF); LAS int* const wtot = ust + 520; LAS int* const qn = (LAS int*)(L + ATT_QN_OFF);
              const int* const CNTB = (const int*)(ctl + CW_CNTB + l * 512 * CNTB_PITCH);
              if (t2 == 0) { unsigned sp_ = 0; while (__hip_atomic_load(ctl + CW_SELDONE + 64 * l, RLX_AGENT) < (unsigned)G) { __builtin_amdgcn_s_sleep(2); if (++sp_ > (1u << 22)) break; }
                  __builtin_amdgcn_fence(__ATOMIC_ACQUIRE, "agent"); asm volatile("s_waitcnt vmcnt(0)" ::: "memory"); }
              if (t2 < 4) ((LAS unsigned*)(L + ATT_GB_OFF))[t2] = 0u;
              __syncthreads();
              const int nl = __hip_atomic_load(CNTB + t2 * CNTB_PITCH, RLX_AGENT); const int nch = (8 + ((nl + 31) >> 5) + 7) >> 3;
              int inc = nch;
#pragma unroll
              for (int o = 1; o < 64; o <<= 1) { const int v = shup_i(inc, o, t2 & 63); if ((t2 & 63) >= o) inc += v; }
              if ((t2 & 63) == 63) wtot[t2 >> 6] = inc;
              __syncthreads();
              int pre = 0;
              for (int w = 0; w < (t2 >> 6); ++w) pre += wtot[w];
              ust[t2 + 1] = pre + inc; if (t2 == 0) ust[0] = 0;
              LAS int* const nlv = (LAS int*)(L + LDSCTL_OFF + 12288); nlv[t2] = nl;
              __syncthreads();
              const int nB = ust[512], nU = nB + 3072;
              gu32* const qhead = ctl + CW_QUEUE + 64 * (l + 2 * rp);
              const int grp = wave_s >> 2, wg = wave_s & 3;
              char* const gshm = shm + grp * attn_body::BRA_GRP_BYTES; float* const wsf = (float*)((char*)lds + ATT_WSF_OFF) + wave_s * 128;
              LAS unsigned* const gb = (LAS unsigned*)(L + ATT_GB_OFF) + 2 * grp; LAS int* const gq = qn + 16 * grp;
              if (wg == 0 && ln2 == 0) gq[0] = (int)__hip_atomic_fetch_add(qhead, 1u, RLX_AGENT);
              attn_body::grp_bar(gb, ln2);
              for (int kq = 0;; ++kq) {
                  const int u = __builtin_amdgcn_readfirstlane(gq[kq & 1]);
                  if (u >= nU) break;
                  int unext_ = 0; if (wg == 0 && ln2 == 0) unext_ = (int)__hip_atomic_fetch_add(qhead, 1u, RLX_AGENT);
                  attn_body::BraUnit U;
                  if (u < nB) {
                      int lo_ = 0, hi_ = 512;
                      while (hi_ - lo_ > 1) { const int mid = (lo_ + hi_) >> 1; if (ust[mid] <= u) lo_ = mid; else hi_ = mid; }
                      const int hj = lo_, hd = hj >> 6, jb = hj & 63, c = u - ust[hj]; const int nlist = nlv[hj]; const int ntile = 8 + ((nlist + 31) >> 5);
                      U.Q = (const attn_body::bf16*)PROJ + C_QB + hd * 64; U.K = (const attn_body::bf16*)PROJ + C_KB + hd * 64; U.V = (const attn_body::bf16*)PROJ + C_VB + hd * 64;
                      U.PO = (attn_body::bf16*)(ws + WS_POB) + hd * 64; U.PL = (float*)(ws + WS_PLB) + hd;
                      U.kbase = 256 * jb; U.kstride = 1; U.t_first = 0; U.nkt = 4; U.nqt = (ntile - 8 * c) < 8 ? (ntile - 8 * c) : 8;
                      U.qbase = 0; U.qstride = 0; U.slotA = 0; U.list = (const int*)(ws + WS_LIST) + (size_t)hj * 16384; U.nlist = nlist; U.tile0 = 8 * c; U.ownrow0 = 256 * jb;
                      if (rp == 0) attn_body::bra_unit<1, 0>(U, gshm, wsf, (char*)lds + ATT_OST_OFF + wave_s * 2048, gb, wg, gq + ((kq + 1) & 1), unext_); else attn_body::bra_unit<1, ABLV>(U, gshm, wsf, (char*)lds + ATT_OST_OFF + wave_s * 2048, gb, wg, gq + ((kq + 1) & 1), unext_);
                  } else {
                      const int a = u - nB, hd = a / 384, r = a % 384, pt = r >> 7, w7 = r & 127; const int dil = (pt == 0) ? 1 : (pt == 1) ? 4 : 16;
                      const int nblk = 128 / dil, rho = w7 / nblk, ib = w7 % nblk;
                      U.Q = (const attn_body::bf16*)PROJ + C_QA + hd * 64; U.K = (const attn_body::bf16*)PROJ + C_KA + hd * 64; U.V = (const attn_body::bf16*)PROJ + C_VA + hd * 64;
                      U.PO = (attn_body::bf16*)(ws + WS_POA) + hd * 64; U.PL = (float*)(ws + WS_PLA) + hd;
                      U.kbase = rho + dil * (128 * ib - 128); U.kstride = dil; U.t_first = (ib == 0) ? 2 : 0; U.nkt = 4; U.nqt = 4;
                      U.qbase = rho + dil * 128 * ib; U.qstride = dil; U.slotA = pt; U.list = nullptr; U.nlist = 0; U.tile0 = 0; U.ownrow0 = 0;
                      if (rp == 0) attn_body::bra_unit<0, 0>(U, gshm, wsf, (char*)lds + ATT_OST_OFF + wave_s * 2048, gb, wg, gq + ((kq + 1) & 1), unext_); else attn_body::bra_unit<0, ABLV>(U, gshm, wsf, (char*)lds + ATT_OST_OFF + wave_s * 2048, gb, wg, gq + ((kq + 1) & 1), unext_);
                  }
                  attn_body::grp_bar_nv(gb, ln2);
              }
              __syncthreads();
            }
        }
        SEAM(pb + 4);
        if (INJ(5)) for (int rp = 0; rp < REPS(5); ++rp) {
            PHASE_BEGIN();
            const float* const lam_q1 = KIN(float, 9); const float* const lam_k1 = KIN(float, 10); const float* const lam_q2 = KIN(float, 11); const float* const lam_k2 = KIN(float, 12); const float* const g_sub = KIN(float, 13);
            const bf16* const TB = (const bf16*)(ws + WS_T); unsigned char* const MERGED = ws + WS_MERGED;
            const bf16* const POA = (const bf16*)(ws + WS_POA); const bf16* const POB = (const bf16*)(ws + WS_POB); const float* const PLA = (const float*)(ws + WS_PLA); const float* const PLB = (const float*)(ws + WS_PLB);
            const float d1 = wave_sum(lam_q1[l * 64 + lane] * lam_k1[l * 64 + lane], lane), d2 = wave_sum(lam_q2[l * 64 + lane] * lam_k2[l * 64 + lane], lane);
            const float lam = expf(d1) - expf(d2) + lam_init;
            const bool ofp8 = ((OUT_FP8 >> l) & 1) != 0;
            const f32x4 gs = ((const f32x4*)(g_sub + l * 128))[lane & 31]; const float osc = (1.f - lam_init) * (ofp8 ? MSCALE : 1.f);
            for (int row = gw; row < S_; row += NGW) {
                { float ls[3], mx = -INFINITY;
#pragma unroll
                  for (int sl = 0; sl < 3; ++sl) { ls[sl] = PLA[((size_t)sl * S_ + row) * 8 + (lane >> 3)]; mx = fmaxf(mx, ls[sl]); }
                  float acc[8], wsum = 0.f;
#pragma unroll
                  for (int e = 0; e < 8; ++e) acc[e] = 0.f;
#pragma unroll
                  for (int sl = 0; sl < 3; ++sl) { const float wgt = exp2f(ls[sl] - mx); wsum += wgt; const v4u w = ((const GAS v4u*)(POA + ((size_t)sl * S_ + row) * 512))[lane];
                      acc[0] += wgt * bflo(w.x); acc[1] += wgt * bfhi(w.x); acc[2] += wgt * bflo(w.y); acc[3] += wgt * bfhi(w.y); acc[4] += wgt * bflo(w.z); acc[5] += wgt * bfhi(w.z); acc[6] += wgt * bflo(w.w); acc[7] += wgt * bfhi(w.w); }
                  const float iw = (ofp8 ? MSCALE : 1.f) / wsum;
                  if (ofp8) { v2u o; o.x = pg8::pk4_fp8(acc[0] * iw, acc[1] * iw, acc[2] * iw, acc[3] * iw); o.y = pg8::pk4_fp8(acc[4] * iw, acc[5] * iw, acc[6] * iw, acc[7] * iw); ((GAS v2u*)(MERGED + (size_t)row * 2048))[lane] = o; }
                  else { v4u o; o.x = pk2(acc[0] * iw, acc[1] * iw); o.y = pk2(acc[2] * iw, acc[3] * iw); o.z = pk2(acc[4] * iw, acc[5] * iw); o.w = pk2(acc[6] * iw, acc[7] * iw); ((GAS v4u*)((bf16*)MERGED + (size_t)row * 2048))[lane] = o; } }
                { const int own = row >> 8, nsel = own < 3 ? own : 3; float ls[4], mx = -INFINITY;
#pragma unroll
                  for (int sl = 0; sl < 4; ++sl) { const bool on = (sl == 3) || (sl < nsel); ls[sl] = on ? PLB[((size_t)sl * S_ + row) * 8 + (lane >> 3)] : -INFINITY; mx = fmaxf(mx, ls[sl]); }
                  float acc[8], wsum = 0.f;
#pragma unroll
                  for (int e = 0; e < 8; ++e) acc[e] = 0.f;
#pragma unroll
                  for (int sl = 0; sl < 4; ++sl) { const bool on = (sl == 3) || (sl < nsel);
                      if (on) { const float wgt = exp2f(ls[sl] - mx); wsum += wgt; const v4u w = ((const GAS v4u*)(POB + ((size_t)sl * S_ + row) * 512))[lane];
                          acc[0] += wgt * bflo(w.x); acc[1] += wgt * bfhi(w.x); acc[2] += wgt * bflo(w.y); acc[3] += wgt * bfhi(w.y); acc[4] += wgt * bflo(w.z); acc[5] += wgt * bfhi(w.z); acc[6] += wgt * bflo(w.w); acc[7] += wgt * bfhi(w.w); } }
                  const float iw = (ofp8 ? MSCALE : 1.f) / wsum;
                  if (ofp8) { v2u o; o.x = pg8::pk4_fp8(acc[0] * iw, acc[1] * iw, acc[2] * iw, acc[3] * iw); o.y = pg8::pk4_fp8(acc[4] * iw, acc[5] * iw, acc[6] * iw, acc[7] * iw); ((GAS v2u*)(MERGED + (size_t)row * 2048 + 512))[lane] = o; }
                  else { v4u o; o.x = pk2(acc[0] * iw, acc[1] * iw); o.y = pk2(acc[2] * iw, acc[3] * iw); o.z = pk2(acc[4] * iw, acc[5] * iw); o.w = pk2(acc[6] * iw, acc[7] * iw); ((GAS v4u*)((bf16*)MERGED + (size_t)row * 2048 + 512))[lane] = o; } }
#pragma unroll
                for (int j = 0; j < 4; ++j) { const v2u ta = ((const GAS v2u*)(TB + (size_t)row * 1024))[lane + 64 * j], tb = ((const GAS v2u*)(TB + (size_t)(S_ + row) * 1024))[lane + 64 * j];
                    const f32x4 a = (f32x4){bflo(ta.x), bfhi(ta.x), bflo(ta.y), bfhi(ta.y)}, b = (f32x4){bflo(tb.x), bfhi(tb.x), bflo(tb.y), bfhi(tb.y)};
                    const f32x4 v = a - lam * b; float ss = (v.x * v.x + v.y * v.y) + (v.z * v.z + v.w * v.w);
                    ss += shx(ss, 1, lane); ss += shx(ss, 2, lane); ss += shx(ss, 4, lane); ss += shx(ss, 8, lane); ss += shx(ss, 16, lane);
                    const float rs = 1.f / sqrtf(ss * (1.f / 128.f) + RMS_EPS); const f32x4 o = v * rs * gs * osc;
                    if (ofp8) ((GAS unsigned*)(MERGED + (size_t)row * 2048 + 1024))[lane + 64 * j] = pg8::pk4_fp8(o.x, o.y, o.z, o.w);
                    else { v2u w; w.x = pk2(o.x, o.y); w.y = pk2(o.z, o.w); ((GAS v2u*)((bf16*)MERGED + (size_t)row * 2048 + 1024))[lane + 64 * j] = w; } }
            }
        }
        SEAM(pb + 5);
        if (INJ(6)) for (int rp = 0; rp < REPS(6); ++rp) {
            PHASE_BEGIN();
            const float* const x_in = KIN(float, 0); bf16* const xbuf = (bf16*)(ws + WS_XB); const float* const mod = (const float*)(ws + WS_MOD) + l * 12288;
            unsigned char* const MERGED = ws + WS_MERGED; unsigned char* const WOUT = ws + WS_WOUT;
            if (l == 0) { constexpr bool F8 = (OUT_FP8 & 1) != 0; constexpr int KBO = F8 ? 2048 : 4096;
                pg8::DenseSched Sd; Sd.init(MERGED, WOUT, S_, 2048, KBO, G, bx);
                pg8::EpiGateRes<true> E{x_in, xbuf, mod + 4096, F8 ? 1.f / (WSC_K2048 * MSCALE) : 1.f};
                pg8::gemm_phase<pg8::EpiGateRes<true>, pg8::DenseSched, true, GEMM_SP2, F8>(L + RING_OFF, KBO, Sd, E, wave_s); }
            else { constexpr bool F8 = (OUT_FP8 & 2) != 0; constexpr int KBO = F8 ? 2048 : 4096;
                pg8::DenseSched Sd; Sd.init(MERGED, WOUT + (size_t)2048 * 4096, S_, 2048, KBO, G, bx);
                pg8::EpiGateRes<false> E{xbuf, xbuf, mod + 4096, F8 ? 1.f / (WSC_K2048 * MSCALE) : 1.f};
                pg8::gemm_phase<pg8::EpiGateRes<false>, pg8::DenseSched, true, GEMM_SP2, F8>(L + RING_OFF, KBO, Sd, E, wave_s); }
        }
        SEAM(pb + 6);
        if (INJ(7)) for (int rp = 0; rp < REPS(7); ++rp) {
            PHASE_BEGIN();
            const float* const g_mlp = KIN(float, 6); const float* const w_router = KIN(float, 17); const float* const b_router = KIN(float, 18); const bf16* const xbuf = (const bf16*)(ws + WS_XB);
            const float* const mod = (const float*)(ws + WS_MOD) + l * 12288; unsigned char* const HB = ws + WS_H;
            int* const EID = (int*)(ws + WS_EID); float* const WTS = (float*)(ws + WS_WTS); int* const CNT = (int*)(ws + WS_CNT);
            LAS unsigned char* const WF = L; LAS float* const rawp = (LAS float*)(L + LDSCTL_OFF + 4096); LAS float* const bpart = (LAS float*)(L + LDSCTL_OFF + 12288); LAS float* const biasv = (LAS float*)(L + LDSCTL_OFF + 14336); LAS float* const rsv = (LAS float*)(L + LDSCTL_OFF + 14464);
            { const float* const gm = g_mlp + l * 2048; const float* const scv = mod + 8192; const float* const shv = mod + 6144;
              for (int c = tid; c < 4096; c += NWAVES * 64) { const int e = c & 15, g = (c >> 4) & 3, ks = c >> 6, k0 = 32 * ks + 8 * g; unsigned hi4[4], lo4[4];
#pragma unroll
                  for (int i2 = 0; i2 < 4; ++i2) { const int ka = k0 + 2 * i2, kb = ka + 1;
                      const float w0 = w_router[ka * 16 + e] * (gm[ka] * (1.f + scv[ka])), w1 = w_router[kb * 16 + e] * (gm[kb] * (1.f + scv[kb]));
                      const unsigned h0 = f2bf(w0), h1 = f2bf(w1); const float r0 = w0 - __uint_as_float(h0 << 16), r1 = w1 - __uint_as_float(h1 << 16);
                      hi4[i2] = h0 | (h1 << 16); lo4[i2] = f2bf(r0) | (f2bf(r1) << 16); }
                  *(LAS v4u*)(WF + ks * 2048 + (g * 16 + e) * 16) = (v4u){hi4[0], hi4[1], hi4[2], hi4[3]}; *(LAS v4u*)(WF + ks * 2048 + 1024 + (g * 16 + e) * 16) = (v4u){lo4[0], lo4[1], lo4[2], lo4[3]}; }
              { const int e = tid & 15, part = tid >> 4; float s = 0.f;
                for (int k = 64 * part; k < 64 * part + 64; ++k) s += shv[k] * w_router[k * 16 + e];
                bpart[part * 16 + e] = s; }
              __syncthreads();
              if (tid < 16) { float s = 0.f; for (int p = 0; p < 32; ++p) s += bpart[p * 16 + tid]; biasv[tid] = s; }
              __syncthreads(); }
            float bz[16];
#pragma unroll
            for (int e = 0; e < 16; ++e) bz[e] = biasv[e];
            f32x4 cA[8];
#pragma unroll
            for (int j = 0; j < 8; ++j) { const int c4 = lane + 64 * j; const f32x4 g = ((const f32x4*)(g_mlp + l * 2048))[c4]; const f32x4 sc = ((const f32x4*)(mod + 8192))[c4];
                cA[j] = g * (1.f + sc); }
            float br[16];
#pragma unroll
            for (int e = 0; e < 16; ++e) br[e] = b_router[e];
            for (int rb = bx; rb < NROWBLK; rb += G) {
                { const int kh = wave & 1; const bf16* const xr = xbuf + (size_t)(64 * rb + 16 * (wave >> 1) + (lane & 15)) * 2048 + kh * 1024 + (lane >> 4) * 8; const LAS unsigned char* const wf = WF + kh * 32 * 2048 + lane * 16;
                  f32x4 acc = (f32x4){0.f, 0.f, 0.f, 0.f};
#pragma unroll 8
                  for (int ks = 0; ks < 32; ++ks) { const bf16x8 a = *(const GAS bf16x8*)(xr + ks * 32); const bf16x8 bh = *(const LAS bf16x8*)(wf + ks * 2048), bl = *(const LAS bf16x8*)(wf + ks * 2048 + 1024);
                      acc = __builtin_amdgcn_mfma_f32_16x16x32_bf16(a, bh, acc, 0, 0, 0); acc = __builtin_amdgcn_mfma_f32_16x16x32_bf16(a, bl, acc, 0, 0, 0); }
#pragma unroll
                  for (int j = 0; j < 4; ++j) rawp[kh * 1024 + (16 * (wave >> 1) + 4 * (lane >> 4) + j) * 16 + (lane & 15)] = acc[j]; }
                __syncthreads();
                v2u nv[8];
#pragma unroll
                for (int j = 0; j < 8; ++j) nv[j] = NTL((const GAS v2u*)(xbuf + (size_t)(64 * rb + 8 * wave) * 2048) + (lane + 64 * j));
                for (int i = 0; i < 8; ++i) { const int row = 64 * rb + 8 * wave + i;
                    f32x4 v[8]; float ss = 0.f;
#pragma unroll
                    for (int j = 0; j < 8; ++j) { v[j] = (f32x4){bflo(nv[j].x), bfhi(nv[j].x), bflo(nv[j].y), bfhi(nv[j].y)}; ss += (v[j].x * v[j].x + v[j].y * v[j].y) + (v[j].z * v[j].z + v[j].w * v[j].w); }
                    if (i < 7) {
#pragma unroll
                        for (int j = 0; j < 8; ++j) nv[j] = NTL((const GAS v2u*)(xbuf + (size_t)(row + 1) * 2048) + (lane + 64 * j));
                    }
                    const float rs = 1.f / sqrtf(wave_sum(ss, lane) * (1.f / 2048.f) + RMS_EPS);
#pragma unroll
                    for (int j = 0; j < 8; ++j) { const f32x4 o = v[j] * rs * cA[j] + ((const GAS f32x4*)(mod + 6144))[lane + 64 * j]; ((GAS unsigned*)(HB + (size_t)row * 2048))[lane + 64 * j] = pg8::pk4_fp8(o.x, o.y, o.z, o.w); }
                    if (lane == 0) rsv[8 * wave + i] = rs;
                }
                __syncthreads();
                if (wave == 0) { const int row = 64 * rb + lane; const float rs = rsv[lane];
                    float p[16];
                    { const LAS f32x4* const r0 = (const LAS f32x4*)(rawp + lane * 16); const LAS f32x4* const r1 = (const LAS f32x4*)(rawp + 1024 + lane * 16);
#pragma unroll
                      for (int q = 0; q < 4; ++q) { const f32x4 a = r0[q] + r1[q]; p[4 * q] = a.x * rs + bz[4 * q]; p[4 * q + 1] = a.y * rs + bz[4 * q + 1]; p[4 * q + 2] = a.z * rs + bz[4 * q + 2]; p[4 * q + 3] = a.w * rs + bz[4 * q + 3]; } }
                    float sg[16], sv[16];
#pragma unroll
                    for (int e = 0; e < 16; ++e) { sv[e] = 1.f / (1.f + expf(-p[e])); sg[e] = sv[e] + br[e]; }
                    float gsc[4];
#pragma unroll
                    for (int g4 = 0; g4 < 4; ++g4) { const float a = sg[4 * g4], b = sg[4 * g4 + 1], c = sg[4 * g4 + 2], d = sg[4 * g4 + 3];
                        const float h1 = fmaxf(a, b), l1 = fminf(a, b), h2 = fmaxf(c, d), l2 = fminf(c, d); gsc[g4] = fmaxf(h1, h2) + fmaxf(fminf(h1, h2), fmaxf(l1, l2)); }
                    int gi = 0; float gb = gsc[0];
#pragma unroll
                    for (int g4 = 1; g4 < 4; ++g4) if (gsc[g4] > gb) { gb = gsc[g4]; gi = g4; }
                    float cd[4], cs[4];
#pragma unroll
                    for (int k = 0; k < 4; ++k) { cd[k] = (gi == 0) ? sg[k] : (gi == 1) ? sg[4 + k] : (gi == 2) ? sg[8 + k] : sg[12 + k]; cs[k] = (gi == 0) ? sv[k] : (gi == 1) ? sv[4 + k] : (gi == 2) ? sv[8 + k] : sv[12 + k]; }
                    int l0 = 0; float v0 = cd[0], s0 = cs[0];
#pragma unroll
                    for (int k = 1; k < 4; ++k) if (cd[k] > v0) { v0 = cd[k]; l0 = k; s0 = cs[k]; }
                    int l1i = -1; float v1 = -INFINITY, s1 = 0.f;
#pragma unroll
                    for (int k = 0; k < 4; ++k) if (k != l0 && cd[k] > v1) { v1 = cd[k]; l1i = k; s1 = cs[k]; }
                    const int e0 = 4 * gi + l0, e1 = 4 * gi + l1i; const float wsum = s0 + s1;
                    EID[2 * row] = e0; EID[2 * row + 1] = e1; WTS[2 * row] = s0 / wsum; WTS[2 * row + 1] = s1 / wsum;
                    int mine = 0;
#pragma unroll
                    for (int e = 0; e < 16; ++e) { const int c = __popcll(__ballot(e0 == e)) + __popcll(__ballot(e1 == e)); if (lane == e) mine = c; }
                    if (lane < 16) CNT[rb * 16 + lane] = mine; }
                __syncthreads();
            }
        }
        SEAM(pb + 7);
        if (INJ(8)) for (int rp = 0; rp < REPS(8); ++rp) {
            PHASE_BEGIN();
            const unsigned char* const HB = ws + WS_H; unsigned char* const XS = ws + WS_XS;
            const int* const EID = (const int*)(ws + WS_EID); const float* const WTS = (const float*)(ws + WS_WTS); int* const ROWTOK = (int*)(ws + WS_ROWTOK); float* const ROWW = (float*)(ws + WS_ROWW); const int* const CNT = (const int*)(ws + WS_CNT);
            for (int rb = bx; rb < NROWBLK; rb += G) {
                v4u gw[16];
#pragma unroll
                for (int i = 0; i < 8; ++i) { const int row = 64 * rb + 8 * wave + i; gw[2 * i] = ((const GAS v4u*)(HB + (size_t)row * 2048))[lane]; gw[2 * i + 1] = ((const GAS v4u*)(HB + (size_t)row * 2048))[lane + 64]; }
                COMPUTE_SEGMENTS(rb);
                if (wave == 0) { const int row = 64 * rb + lane; const int e0 = EID[2 * row], e1 = EID[2 * row + 1]; int p0 = 0, p1 = 0;
                    const unsigned long long lt = (1ull << lane) - 1ull;
                    for (int e = 0; e < 16; ++e) { const unsigned long long m0 = __ballot(e0 == e), m1 = __ballot(e1 == e); const int r = __popcll(m0 & lt) + __popcll(m1 & lt);
                        if (e0 == e) p0 = basee[e] + r; if (e1 == e) p1 = basee[e] + r; }
                    postab[2 * lane] = p0; postab[2 * lane + 1] = p1;
                    ROWTOK[p0] = 2 * row; ROWTOK[p1] = 2 * row + 1; ROWW[p0] = WTS[2 * row]; ROWW[p1] = WTS[2 * row + 1]; }
                __syncthreads();
                {
#pragma unroll
                  for (int i = 0; i < 8; ++i) { const int r = 8 * wave + i; const int p0 = postab[2 * r], p1 = postab[2 * r + 1];
                      ((GAS v4u*)(XS + (size_t)p0 * 2048))[lane] = gw[2 * i]; ((GAS v4u*)(XS + (size_t)p0 * 2048))[lane + 64] = gw[2 * i + 1];
                      ((GAS v4u*)(XS + (size_t)p1 * 2048))[lane] = gw[2 * i]; ((GAS v4u*)(XS + (size_t)p1 * 2048))[lane + 64] = gw[2 * i + 1]; } }
                if (rb < 16) { const int pbeg = segs[rb] + tot[rb], pend = segs[rb + 1];
                    for (int p = pbeg + tid; p < pend; p += NWAVES * 64) { ROWTOK[p] = -1; ROWW[p] = 0.f; } }
                __syncthreads();
            }
        }
        SEAM(pb + 8);
        if (INJ(9)) for (int rp = 0; rp < REPS(9); ++rp) {
            PHASE_BEGIN();
            const int* const CNT = (const int*)(ws + WS_CNT); unsigned char* const XS = ws + WS_XS; unsigned char* const WGU = ws + WS_WGU; unsigned char* const ACT = ws + WS_ACT;
            COMPUTE_SEGMENTS(0);
            pg8::MoeSched Sm; Sm.init(XS, WGU + (size_t)l * 16 * 2048 * 2048, segs[16], 2048, 2048, (size_t)2048 * 2048, (const PG8_LAS unsigned char*)p2e, G, bx);
            pg8::EpiSwiglu E{ACT, 1.f / WSC_K2048, ASCALE};
            pg8::gemm_phase<pg8::EpiSwiglu, pg8::MoeSched, true, GEMM_SP2, true>(L + RING_OFF, 2048, Sm, E, wave_s);
        }
        SEAM(pb + 9);
        if (INJ(10)) for (int rp = 0; rp < REPS(10); ++rp) {
            PHASE_BEGIN();
            const int* const CNT = (const int*)(ws + WS_CNT); unsigned char* const ACT = ws + WS_ACT; unsigned char* const WDN = ws + WS_WDN; bf16* const YB = (bf16*)(ws + WS_Y);
            const int* const ROWTOK = (const int*)(ws + WS_ROWTOK); const float* const ROWW = (const float*)(ws + WS_ROWW);
            COMPUTE_SEGMENTS(0);
            pg8::MoeSched Sm; Sm.init(ACT, WDN + (size_t)l * 16 * 2048 * 1024, segs[16], 2048, 1024, (size_t)2048 * 1024, (const PG8_LAS unsigned char*)p2e, G, bx);
            pg8::EpiDown E{YB, ROWTOK, ROWW, 1.f / (WSC_K1024 * ASCALE)};
            pg8::gemm_phase<pg8::EpiDown, pg8::MoeSched, true, GEMM_SP2, true>(L + RING_OFF, 1024, Sm, E, wave_s);
        }
        SEAM(pb + 10);
    }
#if defined(STAMP_A)
    float st_delta = 0.f, st_add = 0.f;
    if (hi - lo > 1) {
        if (kbx == 0 && threadIdx.x == 0) { const float ta = (float)(stamps[STAMP_A + 1] - stamps[STAMP_A]) * 0.01f, tb = (float)(stamps[STAMP_B + 1] - stamps[STAMP_B]) * 0.01f;
            __hip_atomic_store(ctl + CW_QUEUE + 512, __float_as_uint(ta * (1.f / 2000.f)), RLX_AGENT); __hip_atomic_store(ctl + CW_QUEUE + 576, __float_as_uint(tb), RLX_AGENT); }
        xcd_barrier(bar);
        st_delta = __uint_as_float(__hip_atomic_load(ctl + CW_QUEUE + 512, RLX_AGENT)); st_add = __uint_as_float(__hip_atomic_load(ctl + CW_QUEUE + 576, RLX_AGENT));
    }
#endif
    if (((PHMASK >> 12) & 1) && IN(23)) {
        PHASE_BEGIN();
        const float* const g_final = KIN(float, 19); float* const outp = ka->out; const bf16* const xbuf = (const bf16*)(ws + WS_XB); const float* const MOD = (const float*)(ws + WS_MOD); const bf16* const YB = (const bf16*)(ws + WS_Y);
        f32x4 cA[8], cG[8];
#pragma unroll
        for (int j = 0; j < 8; ++j) { const int c4 = lane + 64 * j; cA[j] = ((const f32x4*)g_final)[c4]; cG[j] = ((const f32x4*)(MOD + 12288 + 10240))[c4]; }
        v2u nv[8], na[8], nb[8];
#pragma unroll
        for (int j = 0; j < 8; ++j) { nv[j] = NTL((const GAS v2u*)(xbuf + (size_t)gw * 2048) + (lane + 64 * j)); na[j] = NTL((const GAS v2u*)(YB + (size_t)(2 * gw) * 2048) + (lane + 64 * j)); nb[j] = NTL((const GAS v2u*)(YB + (size_t)(2 * gw + 1) * 2048) + (lane + 64 * j)); }
        for (int row = gw; row < S_; row += NGW) {
            f32x4 v[8]; v2u ya[8], yb[8]; float ss = 0.f;
#pragma unroll
            for (int j = 0; j < 8; ++j) { v[j] = (f32x4){bflo(nv[j].x), bfhi(nv[j].x), bflo(nv[j].y), bfhi(nv[j].y)}; ya[j] = na[j]; yb[j] = nb[j]; }
            const int nrow = row + NGW;
            if (nrow < S_) {
#pragma unroll
                for (int j = 0; j < 8; ++j) { nv[j] = NTL((const GAS v2u*)(xbuf + (size_t)nrow * 2048) + (lane + 64 * j)); na[j] = NTL((const GAS v2u*)(YB + (size_t)(2 * nrow) * 2048) + (lane + 64 * j)); nb[j] = NTL((const GAS v2u*)(YB + (size_t)(2 * nrow + 1) * 2048) + (lane + 64 * j)); }
            }
#pragma unroll
            for (int j = 0; j < 8; ++j) { const v2u a = ya[j], b = yb[j];
                const f32x4 ys = (f32x4){bflo(a.x) + bflo(b.x), bfhi(a.x) + bfhi(b.x), bflo(a.y) + bflo(b.y), bfhi(a.y) + bfhi(b.y)};
                v[j] += cG[j] * ys; ss += (v[j].x * v[j].x + v[j].y * v[j].y) + (v[j].z * v[j].z + v[j].w * v[j].w); }
            const float rs = 1.f / sqrtf(wave_sum(ss, lane) * (1.f / 2048.f) + RMS_EPS);
#pragma unroll
            for (int j = 0; j < 8; ++j) { f32x4 o_ = v[j] * rs * cA[j];
#if defined(STAMP_A)
                o_ = o_ * (1.f + st_delta); if (row == 0 && lane == 0 && j == 0) o_.x += st_add;
#endif
                ((GAS f32x4*)(outp + (size_t)row * 2048))[lane + 64 * j] = o_; }
        }
    }
#undef IN
#undef INJ
#undef REPS
#undef PHASE_BEGIN
#undef KIN
#undef SEAM
#undef COMPUTE_SEGMENTS
}

extern "C" void kernel_launch(void* const* d_in, const int* in_sizes, int n_in, void* d_out, int out_size, void* d_ws, size_t ws_size, hipStream_t stream) {
    static int grid = 0;
    if (grid == 0) {
        if (n_in != 20 || in_sizes[0] != S_ * DM_ || out_size != S_ * DM_ || ws_size < WS_END) { fprintf(stderr, "kernel_launch: unexpected shapes or workspace (%d inputs, in0 %d, out %d, ws %zu); nothing launched\n", n_in, n_in > 0 ? in_sizes[0] : -1, out_size, ws_size); grid = -1; return; }
        int dev = 0, cus = 0, per_cu = 0;
        if (hipGetDevice(&dev) != hipSuccess || hipDeviceGetAttribute(&cus, hipDeviceAttributeMultiprocessorCount, dev) != hipSuccess) { grid = -1; return; }
        if (hipFuncSetAttribute((const void*)fwd, hipFuncAttributeMaxDynamicSharedMemorySize, LDS_BYTES) != hipSuccess) { fprintf(stderr, "kernel_launch: hipFuncSetAttribute failed\n"); grid = -1; return; }
        if (hipOccupancyMaxActiveBlocksPerMultiprocessor(&per_cu, (const void*)fwd, NWAVES * 64, LDS_BYTES) != hipSuccess || per_cu < 1) fprintf(stderr, "kernel_launch: occupancy query reports %d blocks per CU\n", per_cu);
        (void)hipGetLastError();
        grid = cus;
    }
    if (grid < 0) return;
    if (hipMemsetAsync((char*)d_ws + WS_CTL, 0, CTL_ZERO_BYTES, stream) != hipSuccess) return;
    Args a{};
    for (int i = 0; i < 20; ++i) a.in[i] = d_in[i];
    a.out = (float*)d_out; a.ws = (unsigned char*)d_ws;
    if (MK_N_LAUNCHES == 1) { a.ph_lo = 0; a.ph_hi = N_PHASES; hipLaunchKernelGGL(fwd, dim3(grid), dim3(NWAVES * 64), LDS_BYTES, stream, a); }
    else for (int p = 0; p < N_PHASES; ++p) { a.ph_lo = p; a.ph_hi = p + 1; hipLaunchKernelGGL(fwd, dim3(grid), dim3(NWAVES * 64), LDS_BYTES, stream, a); }
}
```

```cpp
#include <hip/hip_runtime.h>
#include <hip/hip_bf16.h>
#include <cstdio>
#include <cstdint>
#include <cmath>
namespace pg8 {
#define PG8_LAS __attribute__((address_space(3)))
typedef unsigned short bf16_t;
typedef short bf16x8 __attribute__((ext_vector_type(8)));
typedef float f32x4 __attribute__((ext_vector_type(4)));
typedef unsigned u32x4 __attribute__((ext_vector_type(4)));
constexpr int BM = 256, BK = 64, HALF = 128, HTB = HALF * BK * 2  , STAGE_BYTES = 8 * HTB, NXCD = 8, WGM = 8;

__host__ __device__ __forceinline__ int lds_byte(int r, int c) { const int st = (r >> 4) * 2 + (c >> 5), rr = r & 15, cc = c & 31, ob = rr * 64 + cc * 2; return st * 1024 + (ob ^ (((ob >> 9) & 1) << 5)); }
__host__ __device__ __forceinline__ void stage_rc(int b, int& R, int& C) { const int st = b / 1024, sb = b % 1024, swz = sb ^ (((sb >> 9) & 1) << 5); R = (st >> 1) * 16 + swz / 64; C = (st & 1) * 32 + (swz % 64) / 2; }
__host__ __device__ __forceinline__ int perm32(int rho) { const int n = rho >> 4, i = rho & 15; return 8 * (i >> 2) + 4 * n + (i & 3); }

struct Unit { int pm, pn; };
struct Gemm { const bf16_t* A; const bf16_t* Bt; int M, N, K; };

struct StaticOrder {
    int nM, nN, nwg, G, c;
    __host__ __device__ void init(int M, int N, int G_, int c_) { nM = M / BM; nN = N / BM; nwg = nM * nN; G = G_; c = c_; }
    __host__ __device__ bool next(int i, Unit& u) const {
        const long L = (long)i * G + c; if (L >= nwg) return false;
        int wgid = (int)L; { const int q = nwg / NXCD, r = nwg % NXCD, xcd = wgid % NXCD, off = wgid / NXCD; wgid = (xcd < r ? xcd * (q + 1) : r * (q + 1) + (xcd - r) * q) + off; }
        const int nig = WGM * nN, gid = wgid / nig, fm = gid * WGM, gsz = (nM - fm) < WGM ? (nM - fm) : WGM;
        u.pm = fm + ((wgid % nig) % gsz); u.pn = (wgid % nig) / gsz; return true;
    }
    __device__ __forceinline__ void a_ready(const Unit&) const {}
    __device__ __forceinline__ void done(const Unit&) const {}
};

struct DenseSched {
    const char* A; const char* Bt; size_t tstep; StaticOrder so;
    __device__ __forceinline__ void init(const void* A_, const void* Bt_, int M, int N, int KB, int G, int c) { A = (const char*)A_; Bt = (const char*)Bt_; tstep = (size_t)BM * KB; so.init(M, N, G, c); }
    __device__ __forceinline__ bool next(int i, Unit& u) const { return so.next(i, u); }
    __device__ __forceinline__ const char* a_ptr(const Unit& u) const { return A + (size_t)u.pm * tstep; }
    __device__ __forceinline__ const char* b_ptr(const Unit& u) const { return Bt + (size_t)u.pn * tstep; }
    __device__ __forceinline__ void a_ready(const Unit&) const {}
    __device__ __forceinline__ void done(const Unit&) const {}
};
struct MoeSched {
    const char* A; const char* Bt; size_t tstep, estride; StaticOrder so; const PG8_LAS unsigned char* p2e;
    __device__ __forceinline__ void init(const void* A_, const void* Bt_, int Mpad, int N, int KB, size_t estride_, const PG8_LAS unsigned char* p2e_, int G, int c) {
        A = (const char*)A_; Bt = (const char*)Bt_; tstep = (size_t)BM * KB; estride = estride_; p2e = p2e_; so.init(Mpad, N, G, c); }
    __device__ __forceinline__ bool next(int i, Unit& u) const { return so.next(i, u); }
    __device__ __forceinline__ const char* a_ptr(const Unit& u) const { return A + (size_t)u.pm * tstep; }
    __device__ __forceinline__ const char* b_ptr(const Unit& u) const { const int e = __builtin_amdgcn_readfirstlane((int)p2e[u.pm]); return Bt + (size_t)e * estride + (size_t)u.pn * tstep; }
    __device__ __forceinline__ void a_ready(const Unit&) const {}
    __device__ __forceinline__ void done(const Unit&) const {}
};

__device__ __forceinline__ unsigned pk4_fp8(float a, float b, float c, float d) {
    a = __builtin_fminf(__builtin_fmaxf(a, -448.f), 448.f); b = __builtin_fminf(__builtin_fmaxf(b, -448.f), 448.f); c = __builtin_fminf(__builtin_fmaxf(c, -448.f), 448.f); d = __builtin_fminf(__builtin_fmaxf(d, -448.f), 448.f);
    int w = 0; w = __builtin_amdgcn_cvt_pk_fp8_f32(a, b, w, false); w = __builtin_amdgcn_cvt_pk_fp8_f32(c, d, w, true); return (unsigned)w; }
__device__ __forceinline__ unsigned cvt_pk_bf16(float lo, float hi) { unsigned r; asm volatile("v_cvt_pk_bf16_f32 %0, %1, %2" : "=v"(r) : "v"(lo), "v"(hi)); return r; }

struct EpiProj {
    static constexpr bool PERM = true, AFTER_DRAIN = false;
    bf16_t* O; const float* cosT; const float* sinT; float qscale, oscale;
    __device__ __forceinline__ void operator()(const f32x4 (&acc)[2][2][4][2], const Unit& u, int wr, int wc, int fr, int fq) const {
        const int pn = u.pn;
        const bool isq = (pn < 2) || (pn == 6) || (pn == 7) || (pn >= 12 && pn < 16);
        const bool isk = (pn == 2) || (pn == 3) || (pn == 8) || (pn == 9) || (pn >= 16 && pn < 20);
        const int row0 = u.pm * BM + wr * 64 + fr, col0 = pn * BM + wc * 32 + 8 * fq;
        const int i0 = (wc & 1) * 16 + 4 * fq;
        const float sc = isq ? qscale * oscale : oscale;
#pragma unroll
        for (int ai = 0; ai < 2; ++ai)
#pragma unroll
            for (int m = 0; m < 4; ++m) { const int row = row0 + ai * HALF + m * 16; bf16_t* rowp = O + (size_t)row * 6144 + col0;
                f32x4 cs = (f32x4){1.f, 1.f, 1.f, 1.f}, sn = (f32x4){0.f, 0.f, 0.f, 0.f};
                if (isq || isk) { cs = *(const f32x4*)(cosT + (size_t)row * 32 + i0); sn = *(const f32x4*)(sinT + (size_t)row * 32 + i0); }
#pragma unroll
                for (int bj = 0; bj < 2; ++bj) { const f32x4 v0 = acc[ai][bj][m][0], v1 = acc[ai][bj][m][1];
                    const float a0 = (v0[0] * cs[0] - v0[1] * sn[0]) * sc, b0 = (v0[1] * cs[0] + v0[0] * sn[0]) * sc;
                    const float a1 = (v0[2] * cs[1] - v0[3] * sn[1]) * sc, b1 = (v0[3] * cs[1] + v0[2] * sn[1]) * sc;
                    const float a2 = (v1[0] * cs[2] - v1[1] * sn[2]) * sc, b2 = (v1[1] * cs[2] + v1[0] * sn[2]) * sc;
                    const float a3 = (v1[2] * cs[3] - v1[3] * sn[3]) * sc, b3 = (v1[3] * cs[3] + v1[2] * sn[3]) * sc;
                    u32x4 w; w.x = cvt_pk_bf16(a0, b0); w.y = cvt_pk_bf16(a1, b1); w.z = cvt_pk_bf16(a2, b2); w.w = cvt_pk_bf16(a3, b3);
                    *(u32x4*)(rowp + bj * HALF) = w; } }
    }
};
template <bool BASE_F32> struct EpiGateRes {
    static constexpr bool PERM = true, AFTER_DRAIN = false;
    const void* base; bf16_t* out; const float* gate; float oscale;
    __device__ __forceinline__ void operator()(const f32x4 (&acc)[2][2][4][2], const Unit& u, int wr, int wc, int fr, int fq) const {
        const int col0 = u.pn * BM + wc * 32 + 8 * fq;
        f32x4 gv[2][2];
#pragma unroll
        for (int bj = 0; bj < 2; ++bj)
#pragma unroll
            for (int n = 0; n < 2; ++n) gv[bj][n] = *(const f32x4*)(gate + col0 + bj * HALF + n * 4) * oscale;
#pragma unroll
        for (int ai = 0; ai < 2; ++ai)
#pragma unroll
            for (int m = 0; m < 4; ++m) { const size_t off = (size_t)(u.pm * BM + ai * HALF + wr * 64 + m * 16 + fr) * 2048 + col0;
#pragma unroll
                for (int bj = 0; bj < 2; ++bj) { f32x4 b0, b1;
                    if (BASE_F32) { b0 = *(const f32x4*)((const float*)base + off + bj * HALF); b1 = *(const f32x4*)((const float*)base + off + bj * HALF + 4); }
                    else { const u32x4 w = *(const u32x4*)((const bf16_t*)base + off + bj * HALF);
                        b0 = (f32x4){__builtin_bit_cast(float, w.x << 16), __builtin_bit_cast(float, w.x & 0xffff0000u), __builtin_bit_cast(float, w.y << 16), __builtin_bit_cast(float, w.y & 0xffff0000u)};
                        b1 = (f32x4){__builtin_bit_cast(float, w.z << 16), __builtin_bit_cast(float, w.z & 0xffff0000u), __builtin_bit_cast(float, w.w << 16), __builtin_bit_cast(float, w.w & 0xffff0000u)}; }
                    const f32x4 v0 = b0 + gv[bj][0] * acc[ai][bj][m][0], v1 = b1 + gv[bj][1] * acc[ai][bj][m][1];
                    u32x4 w; w.x = cvt_pk_bf16(v0[0], v0[1]); w.y = cvt_pk_bf16(v0[2], v0[3]); w.z = cvt_pk_bf16(v1[0], v1[1]); w.w = cvt_pk_bf16(v1[2], v1[3]);
                    *(u32x4*)(out + off + bj * HALF) = w; }
                asm volatile("" ::: "memory"); }
    }
};
struct EpiSwiglu {
    static constexpr bool PERM = true, AFTER_DRAIN = false;
    unsigned char* O; float iscale, ascale;
    __device__ __forceinline__ void operator()(const f32x4 (&acc)[2][2][4][2], const Unit& u, int wr, int wc, int fr, int fq) const {
        const int row0 = u.pm * BM + wr * 64 + fr, col0 = u.pn * 128 + wc * 16 + 4 * fq;
#pragma unroll
        for (int ai = 0; ai < 2; ++ai)
#pragma unroll
            for (int m = 0; m < 4; ++m) { unsigned char* rowp = O + (size_t)(row0 + ai * HALF + m * 16) * 1024 + col0;
#pragma unroll
                for (int bj = 0; bj < 2; ++bj) { const f32x4 g = acc[ai][bj][m][0] * iscale, up = acc[ai][bj][m][1] * (iscale * ascale); float r[4];
#pragma unroll
                    for (int j = 0; j < 4; ++j) { const float e = __builtin_amdgcn_exp2f(-1.4426950408889634f * g[j]); r[j] = g[j] * __builtin_amdgcn_rcpf(1.f + e) * up[j]; }
                    *(unsigned*)(rowp + bj * 64) = pk4_fp8(r[0], r[1], r[2], r[3]); } }
    }
};
struct EpiDown {
    static constexpr bool PERM = true, AFTER_DRAIN = false;
    bf16_t* Y; const int* rowtok; const float* roww; float oscale;
    __device__ __forceinline__ void operator()(const f32x4 (&acc)[2][2][4][2], const Unit& u, int wr, int wc, int fr, int fq) const {
        const int row0 = u.pm * BM + wr * 64 + fr, col0 = u.pn * BM + wc * 32 + 8 * fq;
#pragma unroll
        for (int ai = 0; ai < 2; ++ai)
#pragma unroll
            for (int m = 0; m < 4; ++m) { const int pos = row0 + ai * HALF + m * 16; const int tk = rowtok[pos]; const float w8 = roww[pos] * oscale;
                bf16_t* rowp = Y + (size_t)(tk < 0 ? 0 : tk) * 2048 + col0;
#pragma unroll
                for (int bj = 0; bj < 2; ++bj) { const f32x4 v0 = acc[ai][bj][m][0] * w8, v1 = acc[ai][bj][m][1] * w8;
                    u32x4 w; w.x = cvt_pk_bf16(v0[0], v0[1]); w.y = cvt_pk_bf16(v0[2], v0[3]); w.z = cvt_pk_bf16(v1[0], v1[1]); w.w = cvt_pk_bf16(v1[2], v1[3]);
                    if (tk >= 0) *(u32x4*)(rowp + bj * HALF) = w; }
                asm volatile("" ::: "memory"); }
    }
};

template <class Epi, class Sched, bool ALIGN_EPI = false, bool SP2 = false, bool FP8 = false>
__device__ __forceinline__ void gemm_phase(PG8_LAS unsigned char* lds, const int KB  , const Sched& S, const Epi& E, const int wave_s  ) {
    typedef int v4i_t __attribute__((ext_vector_type(4))); typedef int v8i_t __attribute__((ext_vector_type(8)));
    int lane; asm volatile("v_mbcnt_lo_u32_b32 %0, -1, 0\n\tv_mbcnt_hi_u32_b32 %0, -1, %0" : "=v"(lane)); const int wid = wave_s, tid = wid * 64 + lane, wr = wid >> 2, wc = wid & 3, fr = lane & 15, fq = lane >> 4;
    const int nt = KB / (BK * 2);
    unsigned voffA, voffB;
    { int R, C; stage_rc(tid * 16, R, C); const int Rb = Epi::PERM ? ((R & ~31) + perm32(R & 31)) : R; voffA = (unsigned)(R * KB + C * 2); voffB = (unsigned)(Rb * KB + C * 2); }
    const size_t pstep = (size_t)64 * KB;
    const size_t kstep = (size_t)(BK * 2);
    const size_t hstep = (size_t)HALF * KB;
    const unsigned ldsbw = (unsigned)__builtin_amdgcn_readfirstlane((int)((unsigned)(uintptr_t)lds + (unsigned)wid * 1024u));
    const int aoff = lds_byte(wr * 64 + fr, fq * 8), boff = lds_byte(wc * 32 + fr, fq * 8);
#define PG8_SA(b, h) (((b) * 2 + (h)) * HTB)
#define PG8_SB(b, h) ((4 + (b) * 2 + (h)) * HTB)
#define PG8_STAGE1(bufoff, gbase, voff, PI) do { unsigned keep_; \
        asm volatile("s_mov_b32 %0, m0\n\ts_add_i32 m0, %3, %4\n\ts_nop 0\n\tglobal_load_lds_dwordx4 %1, %2\n\ts_mov_b32 m0, %0" : "=&s"(keep_) : "v"(voff), "s"((const char*)(gbase) + (PI) * pstep), "s"(ldsbw), "i"((bufoff) + (PI) * 8192) : "memory", "scc"); } while (0)
#define PG8_STAGE(bufoff, gbase, voff) do { PG8_STAGE1(bufoff, gbase, voff, 0); PG8_STAGE1(bufoff, gbase, voff, 1); } while (0)
#define PG8_LDA(dst, b, h) do { _Pragma("unroll") for (int m = 0; m < 4; ++m) { dst[m].lo = *(const PG8_LAS v4i_t*)(lds + PG8_SA(b, h) + aoff + m * 2048); dst[m].hi = *(const PG8_LAS v4i_t*)(lds + PG8_SA(b, h) + aoff + m * 2048 + 1024); } } while (0)
#define PG8_LDB(dst, b, h) do { _Pragma("unroll") for (int n = 0; n < 2; ++n) { dst[n].lo = *(const PG8_LAS v4i_t*)(lds + PG8_SB(b, h) + boff + n * 2048); dst[n].hi = *(const PG8_LAS v4i_t*)(lds + PG8_SB(b, h) + boff + n * 2048 + 1024); } } while (0)
#define PG8_MMA(ai, bj, At, Bt) do { __builtin_amdgcn_s_setprio(1); _Pragma("unroll") for (int m = 0; m < 4; ++m) _Pragma("unroll") for (int n = 0; n < 2; ++n) { \
        if constexpr (FP8) { acc[ai][bj][m][n] = __builtin_amdgcn_mfma_scale_f32_16x16x128_f8f6f4(Bt[n], At[m], acc[ai][bj][m][n], 0, 0, 0, 0, 0, 0); } \
        else { const v4i_t bl_ = Bt[n].lo, bh_ = Bt[n].hi, al_ = At[m].lo, ah_ = At[m].hi;     \
               acc[ai][bj][m][n] = __builtin_amdgcn_mfma_f32_16x16x32_bf16(__builtin_bit_cast(bf16x8, bl_), __builtin_bit_cast(bf16x8, al_), acc[ai][bj][m][n], 0, 0, 0); \
               acc[ai][bj][m][n] = __builtin_amdgcn_mfma_f32_16x16x32_bf16(__builtin_bit_cast(bf16x8, bh_), __builtin_bit_cast(bf16x8, ah_), acc[ai][bj][m][n], 0, 0, 0); } } \
        __builtin_amdgcn_s_setprio(0); } while (0)
#define PG8_WAIT_V(n) asm volatile("s_waitcnt vmcnt(" #n ")" ::: "memory")
#define PG8_WAIT_L(n) asm volatile("s_waitcnt lgkmcnt(" #n ")" ::: "memory")
#define PG8_BAR __builtin_amdgcn_s_barrier()
#define PG8_SCHED __builtin_amdgcn_sched_barrier(0)
    Unit cur, nxt; int ui = 0;
    if (!S.next(0, cur)) return;
    f32x4 acc[2][2][4][2];
#pragma unroll
    for (int a = 0; a < 2; ++a)
#pragma unroll
        for (int b = 0; b < 2; ++b)
#pragma unroll
            for (int m = 0; m < 4; ++m)
#pragma unroll
                for (int n = 0; n < 2; ++n) acc[a][b][m][n] = (f32x4){0.f, 0.f, 0.f, 0.f};
    v8i_t At[4], B0[2], B1[2];
    const char* cA = S.a_ptr(cur); const char* cB = S.b_ptr(cur);
    S.a_ready(cur);
    if constexpr (SP2) {
        PG8_STAGE(PG8_SB(0, 0), cB, voffB); PG8_STAGE(PG8_SB(0, 1), cB + hstep, voffB); PG8_STAGE(PG8_SA(0, 0), cA, voffA); PG8_STAGE(PG8_SA(0, 1), cA + hstep, voffA);
        if (wr == 1) PG8_BAR;
        PG8_WAIT_V(2); PG8_BAR;
        PG8_STAGE(PG8_SB(1, 0), cB + kstep, voffB); PG8_STAGE(PG8_SA(1, 0), cA + kstep, voffA); PG8_STAGE(PG8_SB(1, 1), cB + hstep + kstep, voffB);
        PG8_WAIT_V(6); PG8_BAR;
    } else {
        PG8_STAGE(PG8_SB(0, 0), cB, voffB); PG8_STAGE(PG8_SA(0, 0), cA, voffA); PG8_STAGE(PG8_SB(0, 1), cB + hstep, voffB); PG8_STAGE(PG8_SA(0, 1), cA + hstep, voffA);
        if (wr == 1) PG8_BAR;
        PG8_WAIT_V(4); PG8_BAR;
        PG8_STAGE(PG8_SB(1, 0), cB + kstep, voffB); PG8_STAGE(PG8_SA(1, 0), cA + kstep, voffA); PG8_STAGE(PG8_SB(1, 1), cB + hstep + kstep, voffB);
        PG8_WAIT_V(6); PG8_BAR;
    }
    for (;;) {
        const bool has_next = S.next(ui + 1, nxt);
        const char* nA = has_next ? S.a_ptr(nxt) : cA; const char* nB = has_next ? S.b_ptr(nxt) : cB;
#pragma unroll 1
        for (int t = 0; t < nt; t += 2) {
            const bool last = (t == nt - 2);
            const char* a1 = cA + (size_t)(t + 1) * kstep;
            const char* a2 = last ? nA : cA + (size_t)(t + 2) * kstep; const char* b2 = last ? nB : cB + (size_t)(t + 2) * kstep;
            const char* a3 = a2 + kstep; const char* b3 = b2 + kstep;
            if (last && has_next) S.a_ready(nxt);
            if constexpr (SP2) {
            PG8_LDB(B0, 0, 0); PG8_LDB(B1, 0, 1); PG8_SCHED; PG8_LDA(At, 0, 0); PG8_STAGE(PG8_SA(1, 1), a1 + hstep, voffA);
            PG8_WAIT_V(8); PG8_WAIT_L(0); PG8_BAR; PG8_MMA(0, 0, At, B0); PG8_MMA(0, 1, At, B1); PG8_BAR; PG8_SCHED;
            PG8_LDA(At, 0, 1); PG8_STAGE(PG8_SB(0, 0), b2, voffB); PG8_STAGE(PG8_SB(0, 1), b2 + hstep, voffB); PG8_STAGE(PG8_SA(0, 0), a2, voffA);
            PG8_WAIT_V(8); PG8_WAIT_L(0); PG8_BAR; PG8_MMA(1, 0, At, B0); PG8_MMA(1, 1, At, B1); PG8_BAR; PG8_SCHED;
            PG8_LDB(B0, 1, 0); PG8_LDB(B1, 1, 1); PG8_SCHED; PG8_LDA(At, 1, 0); PG8_STAGE(PG8_SA(0, 1), a2 + hstep, voffA);
            PG8_WAIT_V(8); PG8_WAIT_L(0); PG8_BAR; PG8_MMA(0, 0, At, B0); PG8_MMA(0, 1, At, B1); PG8_BAR; PG8_SCHED;
            PG8_LDA(At, 1, 1); PG8_STAGE(PG8_SB(1, 0), b3, voffB); PG8_STAGE(PG8_SB(1, 1), b3 + hstep, voffB); PG8_STAGE(PG8_SA(1, 0), a3, voffA);
            PG8_WAIT_V(8); PG8_WAIT_L(0); PG8_BAR; PG8_MMA(1, 0, At, B0); PG8_MMA(1, 1, At, B1); PG8_BAR; PG8_SCHED;
            } else {
            PG8_LDB(B0, 0, 0); PG8_SCHED; PG8_LDA(At, 0, 0); PG8_STAGE(PG8_SA(1, 1), a1 + hstep, voffA);
            PG8_WAIT_L(8); PG8_BAR; PG8_WAIT_L(0); PG8_MMA(0, 0, At, B0); PG8_BAR; PG8_SCHED;
            PG8_LDB(B1, 0, 1); PG8_STAGE(PG8_SB(0, 0), b2, voffB);
            PG8_BAR; PG8_WAIT_L(0); PG8_MMA(0, 1, At, B1); PG8_BAR;
            PG8_LDA(At, 0, 1); PG8_STAGE(PG8_SA(0, 0), a2, voffA);
            PG8_BAR; PG8_WAIT_L(0); PG8_MMA(1, 0, At, B0); PG8_BAR; PG8_SCHED;
            PG8_STAGE(PG8_SB(0, 1), b2 + hstep, voffB);
            PG8_WAIT_V(6); PG8_BAR; PG8_MMA(1, 1, At, B1); PG8_BAR;
            PG8_LDB(B0, 1, 0); PG8_SCHED; PG8_LDA(At, 1, 0); PG8_STAGE(PG8_SA(0, 1), a2 + hstep, voffA);
            PG8_WAIT_L(8); PG8_BAR; PG8_WAIT_L(0); PG8_MMA(0, 0, At, B0); PG8_BAR; PG8_SCHED;
            PG8_LDB(B1, 1, 1); PG8_STAGE(PG8_SB(1, 0), b3, voffB);
            PG8_BAR; PG8_WAIT_L(0); PG8_MMA(0, 1, At, B1); PG8_BAR;
            PG8_LDA(At, 1, 1); PG8_STAGE(PG8_SA(1, 0), a3, voffA);
            PG8_BAR; PG8_WAIT_L(0); PG8_MMA(1, 0, At, B0); PG8_BAR; PG8_SCHED;
            PG8_STAGE(PG8_SB(1, 1), b3 + hstep, voffB);
            PG8_WAIT_V(6); PG8_BAR; PG8_MMA(1, 1, At, B1); PG8_BAR;
            }
        }
        if constexpr (ALIGN_EPI) { if (wr == 0) PG8_BAR; }
        if constexpr (!Epi::AFTER_DRAIN) { int ln_; asm volatile("v_mbcnt_lo_u32_b32 %0, -1, 0\n\tv_mbcnt_hi_u32_b32 %0, -1, %0" : "=v"(ln_));
            E(acc, cur, wr, wc, ln_ & 15, ln_ >> 4); S.done(cur); }
        if (!has_next) break;
#pragma unroll
        for (int a = 0; a < 2; ++a)
#pragma unroll
            for (int b = 0; b < 2; ++b)
#pragma unroll
                for (int m = 0; m < 4; ++m)
#pragma unroll
                    for (int n = 0; n < 2; ++n) acc[a][b][m][n] = (f32x4){0.f, 0.f, 0.f, 0.f};
        cur = nxt; cA = nA; cB = nB; ++ui;
        if constexpr (ALIGN_EPI) { if (wr == 1) PG8_BAR; }
    }
    PG8_WAIT_V(0);
    if constexpr (!ALIGN_EPI) { if (wr == 0) PG8_BAR; }
    PG8_BAR;
    if constexpr (Epi::AFTER_DRAIN) { E.fused(acc, cur, wr, wc, fr, fq, lds, wid, lane); S.done(cur); }
#undef PG8_SA
#undef PG8_SB
#undef PG8_STAGE
#undef PG8_LDA
#undef PG8_LDB
#undef PG8_MMA
#undef PG8_WAIT_V
#undef PG8_WAIT_L
#undef PG8_BAR
#undef PG8_SCHED
}
}

constexpr float WSC_K2048 = 64.f, WSC_K1024 = 32.f, MSCALE = 4.f  , ASCALE = 2.f  ;
__device__ __forceinline__ int dest_row(int map, int n) {
    if (map == 1) { const int seg = n >> 9; const bool qk = (seg == 0) || (seg == 1) || (seg == 3) || (seg == 4) || (seg >= 6 && seg <= 9); if (!qk) return n; const int j = n & 63; return (n & ~63) + ((j < 32) ? 2 * j : 2 * (j - 32) + 1); }
    if (map == 2) return 8 * (n >> 2) + (n & 3);
    if (map == 3) return 8 * (n >> 2) + 4 + (n & 3);
    return n;
}
namespace wconv {
constexpr size_t D_WIN = (size_t)16 << 20, D_WOUT = (size_t)64 << 20, D_WGU = (size_t)80 << 20, D_WDN = (size_t)336 << 20;
struct Tab { const float* w_in; const float* w_out; const float* w_gate; const float* w_up; const float* w_down; unsigned char* ws; int l, n_out, total; };
struct State { int idx, staged, ctr, stride; };
struct Op { const float* src; unsigned char* dst; int N, K, map, n0; float wsc; };
__device__ __forceinline__ void decode(const Tab& T, int idx, Op& o) {
    int r = idx; const int l = T.l;
    if (r < T.n_out) { const int kb = r >> 5, nb = r & 31; o.N = 2048; o.K = 2048; o.map = 0; o.wsc = WSC_K2048; o.n0 = 64 * nb;
        o.src = T.w_out + (size_t)l * 2048 * 2048 + (size_t)(16 * kb) * 2048 + 64 * nb; o.dst = T.ws + D_WOUT + (size_t)l * 2048 * 4096 + 16 * kb; return; }
    r -= T.n_out;
    if (r < 65536) { const int up = r >> 15; r &= 32767; const int mt = l * 16 + (r >> 11), item = r & 2047, kb = item >> 4, nb = item & 15; o.N = 1024; o.K = 2048; o.map = 2 + up; o.wsc = WSC_K2048; o.n0 = 64 * nb;
        o.src = (up ? T.w_up : T.w_gate) + (size_t)mt * 2048 * 1024 + (size_t)(16 * kb) * 1024 + 64 * nb; o.dst = T.ws + D_WGU + (size_t)mt * 2048 * 2048 + 16 * kb; return; }
    r -= 65536;
    if (r < 32768) { const int mt = l * 16 + (r >> 11), item = r & 2047, kb = item >> 5, nb = item & 31; o.N = 2048; o.K = 1024; o.map = 0; o.wsc = WSC_K1024; o.n0 = 64 * nb;
        o.src = T.w_down + (size_t)mt * 1024 * 2048 + (size_t)(16 * kb) * 2048 + 64 * nb; o.dst = T.ws + D_WDN + (size_t)mt * 2048 * 1024 + 16 * kb; return; }
    r -= 32768;
    { const int kb = r / 96, nb = r - 96 * kb; o.N = 6144; o.K = 2048; o.map = 1; o.wsc = WSC_K2048; o.n0 = 64 * nb;
      o.src = T.w_in + (size_t)2048 * 6144 + (size_t)(16 * kb) * 6144 + 64 * nb; o.dst = T.ws + D_WIN + (size_t)6144 * 2048 + 16 * kb; }
}
__device__ __forceinline__ void dma16(const void* sbase, unsigned voff, unsigned lds_dst) { unsigned keep;
    asm volatile("s_mov_b32 %0, m0\n\ts_mov_b32 m0, %3\n\ts_nop 0\n\tglobal_load_lds_dwordx4 %1, %2\n\ts_mov_b32 m0, %0" : "=&s"(keep) : "v"(voff), "s"(sbase), "s"(lds_dst) : "memory"); }
__device__ __forceinline__ void issue(const Tab& T, int idx, unsigned stage, int lane) {
    Op o; decode(T, idx, o);
    const unsigned voff = (unsigned)((lane >> 4) * o.N * 4 + (lane & 15) * 16);
#pragma unroll
    for (int j = 0; j < 4; ++j) dma16(o.src + (size_t)(4 * j) * o.N, voff, (unsigned)__builtin_amdgcn_readfirstlane(stage + 1024u * j));
}
__device__ __forceinline__ void finish(const Tab& T, int idx, unsigned stage, int lane) {
    Op o; decode(T, idx, o);
    typedef __attribute__((address_space(3))) const float* lfp; const lfp sp = (lfp)(uintptr_t)(stage + 4u * lane);
    float f[16];
#pragma unroll
    for (int k = 0; k < 16; ++k) f[k] = sp[64 * k] * o.wsc;
    typedef unsigned u4 __attribute__((ext_vector_type(4)));
    u4 w; w.x = pg8::pk4_fp8(f[0], f[1], f[2], f[3]); w.y = pg8::pk4_fp8(f[4], f[5], f[6], f[7]); w.z = pg8::pk4_fp8(f[8], f[9], f[10], f[11]); w.w = pg8::pk4_fp8(f[12], f[13], f[14], f[15]);
    *(__attribute__((address_space(1))) u4*)(o.dst + (size_t)dest_row(o.map, o.n0 + lane) * o.K) = w;
}
__device__ __forceinline__ void micro(const Tab& T, State& s, unsigned stage, int lane) {
    finish(T, s.staged, stage, lane);
    asm volatile("s_waitcnt lgkmcnt(0)" ::: "memory");
    issue(T, s.idx, stage, lane); s.staged = s.idx; s.idx += s.stride;
}
}

#include <hip/hip_bf16.h>
#include <cmath>
namespace attn_body {
using bf16=__hip_bfloat16;
using bf16x8=__attribute__((ext_vector_type(8)))short;
using s16x4=__attribute__((ext_vector_type(4)))short;
using f32x16=__attribute__((ext_vector_type(16)))float;
using u32x4=__attribute__((ext_vector_type(4)))unsigned;
constexpr int SEQ=16384,D=64,DM=6144;
constexpr int NW=8,QBLK=32,QB=QBLK*NW,KVBLK=64,NQB=SEQ/QB;
constexpr int ATTN_UNIT_ROWS=QB;
__device__ __forceinline__ int crow(int r,int hi){return (r&3)+8*(r>>2)+4*hi;}
#define SBAR() __builtin_amdgcn_sched_barrier(0)
__device__ __forceinline__ void cmask(f32x16&p0,f32x16&p1,int jb,int qrel,int hi){
  const float NEG=-INFINITY; int kb=64*jb+4*hi;
  #pragma unroll
  for(int r=0;r<16;++r){int kv=kb+(r&3)+8*(r>>2); if(kv>qrel)p0[r]=NEG; if(kv+32>qrel)p1[r]=NEG;}
}

constexpr int NSLOT=3, SLOTB=8192;
constexpr int LDS_K=0, LDS_V=NSLOT*SLOTB, LDS_WS=2*NSLOT*SLOTB, LDS_OST=LDS_WS+NW*64*4, LDS_BYTES=LDS_OST+NW*4096;
constexpr float C2=0.125f*1.4426950408889634f;
__device__ __forceinline__ void glds16(const void*gsrc,unsigned lds_dst){unsigned keep;
  asm volatile("s_mov_b32 %0, m0\n\ts_mov_b32 m0, %2\n\ts_nop 0\n\tglobal_load_lds_dwordx4 %1, off\n\ts_mov_b32 m0, %0":"=&s"(keep):"v"(gsrc),"s"(lds_dst):"memory");}
__device__ __forceinline__ void glds16s(const void*sbase,unsigned voff,unsigned lds_dst){unsigned keep;
  asm volatile("s_mov_b32 %0, m0\n\ts_mov_b32 m0, %3\n\ts_nop 0\n\tglobal_load_lds_dwordx4 %1, %2\n\ts_mov_b32 m0, %0":"=&s"(keep):"v"(voff),"s"(sbase),"s"(lds_dst):"memory");}
__device__ __forceinline__ float max3f(float a,float b,float c){float r;asm("v_max3_f32 %0, %1, %2, %3":"=v"(r):"v"(a),"v"(b),"v"(c));return r;}
__device__ __forceinline__ float max2f(float a,float b){float r;asm("v_max_f32_e32 %0, %1, %2":"=v"(r):"v"(a),"v"(b));return r;}
__device__ __forceinline__ float fadd_s(float a,float b){float r;asm("v_add_f32_e32 %0, %1, %2":"=v"(r):"v"(a),"v"(b));return r;}
__device__ __forceinline__ float fsub_s(float a,float b){float r;asm("v_sub_f32_e32 %0, %1, %2":"=v"(r):"v"(a),"v"(b));return r;}
typedef float f32x2_t __attribute__((ext_vector_type(2))); typedef __bf16 bf16x2_t __attribute__((ext_vector_type(2)));
__device__ __forceinline__ unsigned cvtpk_s(float lo,float hi){f32x2_t v={lo,hi};bf16x2_t b=__builtin_convertvector(v,bf16x2_t);return __builtin_bit_cast(unsigned,b);}
#define WAIT_BAR(N) asm volatile("s_waitcnt vmcnt(" #N ") lgkmcnt(0)\n\ts_barrier":::"memory")

__device__ __forceinline__ void qkt(f32x16&p0,f32x16&p1,const char*Kslot,const bf16x8*qr,const f32x16&negm,int r32,int hi){
  const char*kb=Kslot+hi*1024+r32*16;
  #pragma unroll
  for(int d0=0;d0<4;++d0){
    const bf16x8 b0=*reinterpret_cast<const bf16x8*>(kb+d0*2048);
    const bf16x8 b1=*reinterpret_cast<const bf16x8*>(kb+d0*2048+512);
    if(d0==0){p0=__builtin_amdgcn_mfma_f32_32x32x16_bf16(b0,qr[0],negm,0,0,0);p1=__builtin_amdgcn_mfma_f32_32x32x16_bf16(b1,qr[0],negm,0,0,0);}
    else{p0=__builtin_amdgcn_mfma_f32_32x32x16_bf16(b0,qr[d0],p0,0,0,0);p1=__builtin_amdgcn_mfma_f32_32x32x16_bf16(b1,qr[d0],p1,0,0,0);}}
}
__device__ __forceinline__ void qkt_rm(f32x16&p0,f32x16&p1,const char*Kslot,const int ka,const bf16x8*qr,const f32x16&negm){
  #pragma unroll
  for(int d0=0;d0<4;++d0){ const char*kb=Kslot+(ka^(d0<<5));
    const bf16x8 b0=*reinterpret_cast<const bf16x8*>(kb);
    const bf16x8 b1=*reinterpret_cast<const bf16x8*>(kb+4096);
    if(d0==0){p0=__builtin_amdgcn_mfma_f32_32x32x16_bf16(b0,qr[0],negm,0,0,0);p1=__builtin_amdgcn_mfma_f32_32x32x16_bf16(b1,qr[0],negm,0,0,0);}
    else{p0=__builtin_amdgcn_mfma_f32_32x32x16_bf16(b0,qr[d0],p0,0,0,0);p1=__builtin_amdgcn_mfma_f32_32x32x16_bf16(b1,qr[d0],p1,0,0,0);}}
}
typedef __attribute__((address_space(3))) const char* lds_cptr;
typedef short v4i16_t __attribute__((ext_vector_type(4)));
__device__ __forceinline__ void kload8(bf16x8*kf,lds_cptr kp){
  kf[0]=*(const __attribute__((address_space(3))) bf16x8*)(kp);      kf[1]=*(const __attribute__((address_space(3))) bf16x8*)(kp+512);
  kf[2]=*(const __attribute__((address_space(3))) bf16x8*)(kp+2048); kf[3]=*(const __attribute__((address_space(3))) bf16x8*)(kp+2560);
  kf[4]=*(const __attribute__((address_space(3))) bf16x8*)(kp+4096); kf[5]=*(const __attribute__((address_space(3))) bf16x8*)(kp+4608);
  kf[6]=*(const __attribute__((address_space(3))) bf16x8*)(kp+6144); kf[7]=*(const __attribute__((address_space(3))) bf16x8*)(kp+6656);
}
__device__ __forceinline__ void kload2(bf16x8*kf,lds_cptr kp,int j){ kf[2*j]=*(const __attribute__((address_space(3))) bf16x8*)(kp+j*2048); kf[2*j+1]=*(const __attribute__((address_space(3))) bf16x8*)(kp+j*2048+512); }
__device__ __forceinline__ s16x4 vtr(lds_cptr p){ return __builtin_bit_cast(s16x4,__builtin_amdgcn_ds_read_tr16_b64_v4i16((__attribute__((address_space(3))) v4i16_t*)p)); }
__device__ __forceinline__ float rowmax(const f32x16&p0,const f32x16&p1){
  float a=max3f(p0[0],p0[1],p1[0]),b=max3f(p0[2],p0[3],p1[1]);a=max3f(a,p1[2],p1[3]);
  #pragma unroll
  for(int r=4;r<16;r+=4){a=max3f(a,p0[r],p0[r+1]);b=max3f(b,p0[r+2],p0[r+3]);a=max3f(a,p1[r],p1[r+1]);b=max3f(b,p1[r+2],p1[r+3]);}
  const float m=max2f(a,b);
  auto rr=__builtin_amdgcn_permlane32_swap(__float_as_uint(m),__float_as_uint(m),false,false);
  return max2f(__uint_as_float(rr[0]),__uint_as_float(rr[1]));
}
__device__ __forceinline__ void pv(f32x16*o,int vb,bf16x8 pa0,bf16x8 pa1,bf16x8 pa2,bf16x8 pa3){
  #pragma unroll
  for(int d0=0;d0<2;++d0){s16x4 lo[4],hi[4];
    #pragma unroll
    for(int ks=0;ks<4;++ks){
      asm volatile("ds_read_b64_tr_b16 %0,%1 offset:%c2":"=&v"(lo[ks]):"v"(vb),"i"(d0*4096+ks*1024):"memory");
      asm volatile("ds_read_b64_tr_b16 %0,%1 offset:%c2":"=&v"(hi[ks]):"v"(vb),"i"(d0*4096+ks*1024+512):"memory");}
    asm volatile("s_waitcnt lgkmcnt(0)":::"memory");SBAR();
    #define PK(k) (bf16x8){lo[k][0],lo[k][1],lo[k][2],lo[k][3],hi[k][0],hi[k][1],hi[k][2],hi[k][3]}
    o[d0]=__builtin_amdgcn_mfma_f32_32x32x16_bf16(pa0,PK(0),o[d0],0,0,0);
    o[d0]=__builtin_amdgcn_mfma_f32_32x32x16_bf16(pa1,PK(1),o[d0],0,0,0);
    o[d0]=__builtin_amdgcn_mfma_f32_32x32x16_bf16(pa2,PK(2),o[d0],0,0,0);
    o[d0]=__builtin_amdgcn_mfma_f32_32x32x16_bf16(pa3,PK(3),o[d0],0,0,0);
    #undef PK
  }
}

constexpr int ATTN_LDS_BYTES=LDS_BYTES;


#ifndef ATT_STAGGER
#define ATT_STAGGER 0
#endif
constexpr int XSLOTS=4, X_K=0, X_V=XSLOTS*SLOTB, X_WS=X_V+2*XSLOTS*SLOTB, X_LDS_BYTES=X_WS+NW*256;
__device__ __forceinline__ void pv4(f32x16*o,int vb,bf16x8 pa0,bf16x8 pa1,bf16x8 pa2,bf16x8 pa3){
  #pragma unroll
  for(int d0=0;d0<4;++d0){s16x4 lo[4],hi[4];
    #pragma unroll
    for(int ks=0;ks<4;++ks){
      asm volatile("ds_read_b64_tr_b16 %0,%1 offset:%c2":"=&v"(lo[ks]):"v"(vb),"i"(d0*4096+ks*1024):"memory");
      asm volatile("ds_read_b64_tr_b16 %0,%1 offset:%c2":"=&v"(hi[ks]):"v"(vb),"i"(d0*4096+ks*1024+512):"memory");}
    asm volatile("s_waitcnt lgkmcnt(0)":::"memory");SBAR();
    #define PK(k) (bf16x8){lo[k][0],lo[k][1],lo[k][2],lo[k][3],hi[k][0],hi[k][1],hi[k][2],hi[k][3]}
    o[d0]=__builtin_amdgcn_mfma_f32_32x32x16_bf16(pa0,PK(0),o[d0],0,0,0);
    o[d0]=__builtin_amdgcn_mfma_f32_32x32x16_bf16(pa1,PK(1),o[d0],0,0,0);
    o[d0]=__builtin_amdgcn_mfma_f32_32x32x16_bf16(pa2,PK(2),o[d0],0,0,0);
    o[d0]=__builtin_amdgcn_mfma_f32_32x32x16_bf16(pa3,PK(3),o[d0],0,0,0);
    #undef PK
  }
}
template<int THRL> __device__ __forceinline__ void attn_unit128(int qb,const bf16*Q,const bf16*__restrict__ K,const bf16*__restrict__ V,bf16*O,int opitch,char*shm,const int wid){
  int lane; asm volatile("v_mbcnt_lo_u32_b32 %0, -1, 0\n\tv_mbcnt_hi_u32_b32 %0, -1, %0":"=v"(lane)); const int r32=lane&31,hi=lane>>5;
  const int q0=qb*QB;
  const bf16*Qw=Q+(long)(q0+wid*QBLK)*DM;
  const unsigned lds0=(unsigned)(uintptr_t)shm;
  float*wsf=(float*)(shm+X_WS)+wid*64;
  const unsigned koff=(unsigned)(lane*DM+wid*8)*2u;
  const unsigned voff=(unsigned)((16*(wid&3)+(lane>>2))*DM+(wid>>2)*32+(lane&3)*8)*2u;
  const unsigned kdst=lds0+X_K+wid*1024, vdst=lds0+X_V+wid*1024;
  #define DMA_K(t,slot) glds16s(K+(long)(t)*KVBLK*DM,koff,(unsigned)__builtin_amdgcn_readfirstlane(kdst+(slot)))
  #define DMA_V(t,slot) do{ glds16s(V+(long)(t)*KVBLK*DM,voff,(unsigned)__builtin_amdgcn_readfirstlane(vdst+2*(slot))); glds16s(V+(long)(t)*KVBLK*DM+64,voff,(unsigned)__builtin_amdgcn_readfirstlane(vdst+2*(slot)+8192)); }while(0)
  const int vb0=(int)(lds0+X_V)+((lane>>4)&1)*32+(lane&3)*8+(4*hi+((lane&15)>>2))*64;
  const char*Kbase=shm+X_K; bf16x8 kf[8];
  const lds_cptr shm3=(lds_cptr)shm; const lds_cptr kp0=shm3+X_K+hi*1024+r32*16; const lds_cptr vp0=shm3+X_V+((lane>>4)&1)*32+(lane&3)*8+(4*hi+((lane&15)>>2))*64;
  const int NT=(q0+QB)/KVBLK;
  DMA_K(0,0);DMA_V(0,0);DMA_K(1,SLOTB);
  bf16x8 qr[4];
  #pragma unroll
  for(int d0=0;d0<4;++d0)qr[d0]=*reinterpret_cast<const bf16x8*>(&Qw[(long)r32*DM+d0*16+hi*8]);
  float mhat=0.f,l_reg=0.f;f32x16 o[4];o[0]=f32x16{};o[1]=f32x16{};o[2]=f32x16{};o[3]=f32x16{};
  float zz_=0.f; asm volatile("":"+v"(zz_)); f32x16 negm;
  _Pragma("unroll") for(int r=0;r<16;++r)negm[r]=zz_; asm volatile("":"+v"(negm));
  const int qrel=wid*QBLK+r32;
  #define CMASK(P0,P1,t) do{int jb_=(t)-(NT-4); if(jb_>=0)cmask(P0,P1,jb_,qrel,hi);}while(0)
  bool resc=false;
  #define RESC() do{ if(resc){ asm volatile("s_waitcnt lgkmcnt(0)":::"memory"); \
      _Pragma("unroll") for(int d_=0;d_<4;++d_) _Pragma("unroll") for(int r=0;r<16;++r)o[d_][r]*=wsf[crow(r,hi)]; } }while(0)
  f32x16 C0,C1; u32x4 pw0,pw1,pw2,pw3;
  int sl_prev=0,sl_cur=0,sl_next=SLOTB;
  #define ROT() do{sl_prev=sl_cur;sl_cur=sl_next;sl_next=(sl_next==(XSLOTS-1)*SLOTB)?0:sl_next+SLOTB;}while(0)
  #define PKW(P,B) cvtpk_s(P[B],P[B+1])
  DMA_K(2,2*SLOTB);
  WAIT_BAR(4);
  qkt(C0,C1,Kbase,qr,negm,r32,hi);asm volatile("s_nop 15\n\ts_nop 7":"+v"(C0),"+v"(C1));CMASK(C0,C1,0);
  { const float rm=rowmax(C0,C1); const float dl=rm; mhat=fadd_s(mhat,dl);
    _Pragma("unroll") for(int r=0;r<16;++r){C0[r]=fsub_s(C0[r],dl);C1[r]=fsub_s(C1[r],dl);}
    _Pragma("unroll") for(int r=0;r<16;++r)negm[r]=-mhat; asm volatile("":"+v"(negm));
    _Pragma("unroll") for(int r=0;r<16;++r){C0[r]=__builtin_amdgcn_exp2f(C0[r]);C1[r]=__builtin_amdgcn_exp2f(C1[r]);}
    float sacc=C0[0]+C0[1]; _Pragma("unroll") for(int r=2;r<16;++r)sacc+=C0[r]; _Pragma("unroll") for(int r=0;r<16;++r)sacc+=C1[r]; l_reg+=sacc;
    pw0=(u32x4){PKW(C0,0),PKW(C0,2),PKW(C0,4),PKW(C0,6)};pw1=(u32x4){PKW(C0,8),PKW(C0,10),PKW(C0,12),PKW(C0,14)};pw2=(u32x4){PKW(C1,0),PKW(C1,2),PKW(C1,4),PKW(C1,6)};pw3=(u32x4){PKW(C1,8),PKW(C1,10),PKW(C1,12),PKW(C1,14)}; }
  WAIT_BAR(0);
  DMA_K(3,3*SLOTB);DMA_V(1,SLOTB);
  ROT();
  kload8(kf,kp0+sl_cur);
  WAIT_BAR(3);
  s16x4 vlo[8],vhi[8];
  #define PAF(k) __builtin_bit_cast(bf16x8,pw##k)
  #define VFR(i) (bf16x8){vlo[i][0],vlo[i][1],vlo[i][2],vlo[i][3],vhi[i][0],vhi[i][1],vhi[i][2],vhi[i][3]}
  #define PIN(x) asm volatile("":"+v"(x))
  #define MX3(a,b,c) __builtin_fmaxf(__builtin_fmaxf((a),(b)),(c))
  #define EX(v) __builtin_amdgcn_exp2f(v)
  #define VRDF(s,d,ks) do{ vlo[s]=vtr(vp_+((d)*4096+(ks)*1024)); vhi[s]=vtr(vp_+((d)*4096+(ks)*1024+512)); }while(0)
  #define GA(s,MF) do{ VRDF(s,(s)&3,(s)>>2); SBAR(); MF; SBAR(); }while(0)
  #define EX2(X,B) do{ X[B]=EX(X[B]); X[B+1]=EX(X[B+1]); PIN(X); }while(0)
  #define PK1(W,j,X,B) do{ sacc+=X[B]; sacc+=X[B+1]; W[j]=PKW(X,B); PIN(W); PIN(sacc); }while(0)
  #define KRD(G,j) do{ if(G){ kload2(kf,kp0+sl_next,j); } }while(0)
  #define STEP(t,GK,GV,GL) do{ SBAR(); \
    const lds_cptr vp_=vp0+2*sl_prev; \
    GA(0,C0=__builtin_amdgcn_mfma_f32_32x32x16_bf16(kf[0],qr[0],negm,0,0,0)); \
    GA(1,C1=__builtin_amdgcn_mfma_f32_32x32x16_bf16(kf[1],qr[0],negm,0,0,0)); \
    GA(2,C0=__builtin_amdgcn_mfma_f32_32x32x16_bf16(kf[2],qr[1],C0,0,0,0)); \
    GA(3,C1=__builtin_amdgcn_mfma_f32_32x32x16_bf16(kf[3],qr[1],C1,0,0,0)); \
    GA(4,C0=__builtin_amdgcn_mfma_f32_32x32x16_bf16(kf[4],qr[2],C0,0,0,0)); \
    GA(5,C1=__builtin_amdgcn_mfma_f32_32x32x16_bf16(kf[5],qr[2],C1,0,0,0)); \
    GA(6,C0=__builtin_amdgcn_mfma_f32_32x32x16_bf16(kf[6],qr[3],C0,0,0,0)); \
    GA(7,C1=__builtin_amdgcn_mfma_f32_32x32x16_bf16(kf[7],qr[3],C1,0,0,0)); \
    if(GK){DMA_K((t)+3,sl_prev);} if(GV){DMA_V((t)+1,sl_next);} \
    CMASK(C0,C1,t); \
    { float a=MX3(C0[0],C0[1],C1[0]),b=MX3(C0[2],C0[3],C1[1]); a=MX3(a,C1[2],C1[3]); \
      _Pragma("unroll") for(int r=4;r<16;r+=4){a=MX3(a,C0[r],C0[r+1]);b=MX3(b,C0[r+2],C0[r+3]);a=MX3(a,C1[r],C1[r+1]);b=MX3(b,C1[r+2],C1[r+3]);} \
      float rm=__builtin_fmaxf(a,b); { auto rr=__builtin_amdgcn_permlane32_swap(__float_as_uint(rm),__float_as_uint(rm),false,false); rm=__builtin_fmaxf(__uint_as_float(rr[0]),__uint_as_float(rr[1])); } \
      resc=false; \
      if(__builtin_expect(__any(rm>(float)THRL),0)){ const float dl=__builtin_fmaxf(rm,0.f); mhat+=dl; \
        _Pragma("unroll") for(int r=0;r<16;++r){C0[r]-=dl;C1[r]-=dl;} \
        _Pragma("unroll") for(int r=0;r<16;++r)negm[r]=-mhat; asm volatile("":"+v"(negm)); \
        const float f=__builtin_amdgcn_exp2f(-dl); l_reg*=f; if(hi==0)wsf[r32]=f; resc=true; } } \
    SBAR(); MIDBAR(t); \
    float sacc=0.f; u32x4 nw0=(u32x4){0u,0u,0u,0u},nw1=nw0,nw2=nw0,nw3=nw0; \
    o[0]=__builtin_amdgcn_mfma_f32_32x32x16_bf16(PAF(0),VFR(0),o[0],0,0,0); VRDF(0,0,2); EX2(C0,0); SBAR(); \
    o[1]=__builtin_amdgcn_mfma_f32_32x32x16_bf16(PAF(0),VFR(1),o[1],0,0,0); VRDF(1,1,2); EX2(C0,2); SBAR(); \
    o[2]=__builtin_amdgcn_mfma_f32_32x32x16_bf16(PAF(0),VFR(2),o[2],0,0,0); VRDF(2,2,2); EX2(C0,4); SBAR(); \
    o[3]=__builtin_amdgcn_mfma_f32_32x32x16_bf16(PAF(0),VFR(3),o[3],0,0,0); VRDF(3,3,2); EX2(C0,6); SBAR(); \
    o[0]=__builtin_amdgcn_mfma_f32_32x32x16_bf16(PAF(1),VFR(4),o[0],0,0,0); VRDF(4,0,3); EX2(C0,8);  PK1(nw0,0,C0,0); SBAR(); \
    o[1]=__builtin_amdgcn_mfma_f32_32x32x16_bf16(PAF(1),VFR(5),o[1],0,0,0); VRDF(5,1,3); EX2(C0,10); PK1(nw0,1,C0,2); SBAR(); \
    o[2]=__builtin_amdgcn_mfma_f32_32x32x16_bf16(PAF(1),VFR(6),o[2],0,0,0); VRDF(6,2,3); EX2(C0,12); PK1(nw0,2,C0,4); SBAR(); \
    o[3]=__builtin_amdgcn_mfma_f32_32x32x16_bf16(PAF(1),VFR(7),o[3],0,0,0); VRDF(7,3,3); EX2(C0,14); PK1(nw0,3,C0,6); SBAR(); \
    o[0]=__builtin_amdgcn_mfma_f32_32x32x16_bf16(PAF(2),VFR(0),o[0],0,0,0); KRD(GL,0); EX2(C1,0);  PK1(nw1,0,C0,8);  SBAR(); \
    o[1]=__builtin_amdgcn_mfma_f32_32x32x16_bf16(PAF(2),VFR(1),o[1],0,0,0); KRD(GL,1); EX2(C1,2);  PK1(nw1,1,C0,10); SBAR(); \
    o[2]=__builtin_amdgcn_mfma_f32_32x32x16_bf16(PAF(2),VFR(2),o[2],0,0,0); KRD(GL,2); EX2(C1,4);  PK1(nw1,2,C0,12); SBAR(); \
    o[3]=__builtin_amdgcn_mfma_f32_32x32x16_bf16(PAF(2),VFR(3),o[3],0,0,0); KRD(GL,3); EX2(C1,6);  PK1(nw1,3,C0,14); SBAR(); \
    o[0]=__builtin_amdgcn_mfma_f32_32x32x16_bf16(PAF(3),VFR(4),o[0],0,0,0); EX2(C1,8);  PK1(nw2,0,C1,0); SBAR(); \
    o[1]=__builtin_amdgcn_mfma_f32_32x32x16_bf16(PAF(3),VFR(5),o[1],0,0,0); EX2(C1,10); PK1(nw2,1,C1,2); SBAR(); \
    o[2]=__builtin_amdgcn_mfma_f32_32x32x16_bf16(PAF(3),VFR(6),o[2],0,0,0); EX2(C1,12); PK1(nw2,2,C1,4); PK1(nw3,0,C1,8); SBAR(); \
    o[3]=__builtin_amdgcn_mfma_f32_32x32x16_bf16(PAF(3),VFR(7),o[3],0,0,0); EX2(C1,14); PK1(nw2,3,C1,6); PK1(nw3,1,C1,10); SBAR(); \
    PK1(nw3,2,C1,12); PK1(nw3,3,C1,14); l_reg+=sacc; pw0=nw0; pw1=nw1; pw2=nw2; pw3=nw3; \
    }while(0)
  #define ENDW(tt) do{ if((tt)+3<NT){WAIT_BAR(3);} else if((tt)+2<NT){WAIT_BAR(2);} else {WAIT_BAR(0);} }while(0)
  int t=1;
  #undef CMASK
  #define CMASK(P0,P1,t) do{}while(0)
  const bool grpB=ATT_STAGGER&&(wid>=4);
  #define MIDBAR(tt) do{ if(grpB){ WAIT_BAR(3); } }while(0)
  for(;t<NT-4;++t){ STEP(t,true,true,true); if(!grpB){ WAIT_BAR(3); } RESC(); ROT(); }
  #undef MIDBAR
  #undef CMASK
  #define CMASK(P0,P1,t) do{int jb_=(t)-(NT-4); if(jb_>=0)cmask(P0,P1,jb_,qrel,hi);}while(0)
  #define MIDBAR(tt) do{ if(grpB){ ENDW(tt); } }while(0)
  for(;t<NT-1;++t){ STEP(t,(t+3<NT),(t+1<NT),(t+1<NT)); if(!grpB){ ENDW(t); } RESC(); ROT(); }
  #undef MIDBAR
  #define MIDBAR(tt) do{}while(0)
  STEP(NT-1,false,false,false); RESC();
  #undef MIDBAR
  SBAR(); pv4(o,vb0+2*sl_cur,PAF(0),PAF(1),PAF(2),PAF(3));
  #undef PKW
  #undef PAF
  #undef VFR
  #undef PIN
  #undef MX3
  #undef EX
  #undef VRDF
  #undef GA
  #undef EX2
  #undef PK1
  #undef KRD
  #undef STEP
  #undef ENDW
  {auto rr=__builtin_amdgcn_permlane32_swap(__float_as_uint(l_reg),__float_as_uint(l_reg),false,false);l_reg=__uint_as_float(rr[0])+__uint_as_float(rr[1]);}
  if(hi==0)wsf[32+r32]=l_reg;asm volatile("s_waitcnt lgkmcnt(0)":::"memory");
  { bf16*Of=O+(long)(q0+wid*QBLK)*opitch;
    #pragma unroll
    for(int r=0;r<16;++r){const int orow=crow(r,hi); const float rl=__builtin_amdgcn_rcpf(wsf[32+orow]);
      #pragma unroll
      for(int d0=0;d0<4;++d0)Of[(long)orow*opitch+d0*32+r32]=__float2bfloat16(o[d0][r]*rl);} }
  asm volatile("s_waitcnt lgkmcnt(0)\n\ts_barrier":::"memory");
  #undef DMA_K
  #undef DMA_V
  #undef CMASK
  #undef RESC
  #undef ROT
}

typedef int v8i_t __attribute__((ext_vector_type(8))); typedef int v4i_t __attribute__((ext_vector_type(4)));
constexpr float PV8_VSCALE=16.f, PV8_PBIAS=3.f;
constexpr int Y_K=0, Y_V=XSLOTS*SLOTB, Y_WS=Y_V+XSLOTS*SLOTB, Y_LDS_BYTES=Y_WS+NW*256;
template<int THRL,bool HOST> __device__ __forceinline__ void attn_unit128p8(int qb,const bf16*Q,const bf16*__restrict__ K,const unsigned char*__restrict__ VT,bf16*O,int opitch,char*shm,const int wid,const wconv::Tab&wct,wconv::State&wcs,const unsigned wstage){
  int lane; asm volatile("v_mbcnt_lo_u32_b32 %0, -1, 0\n\tv_mbcnt_hi_u32_b32 %0, -1, %0":"=v"(lane)); const int r32=lane&31,hi=lane>>5;
  const int q0=qb*QB;
  const bf16*Qw=Q+(long)(q0+wid*QBLK)*DM;
  const unsigned lds0=(unsigned)(uintptr_t)shm;
  float*wsf=(float*)(shm+Y_WS)+wid*64;
  const unsigned koff=(unsigned)(lane*DM+wid*8)*2u;
  const unsigned voff=(unsigned)(wid*1024+lane*16);
  const unsigned kdst=lds0+Y_K+wid*1024, vdst=lds0+Y_V+wid*1024;
  #define DMA_K(t,slot) glds16s(K+(long)(t)*KVBLK*DM,koff,(unsigned)__builtin_amdgcn_readfirstlane(kdst+(slot)))
  #define DMA_V(t,slot) glds16s(VT+(long)(t)*8192,voff,(unsigned)__builtin_amdgcn_readfirstlane(vdst+(slot)))
  const char*Kbase=shm+Y_K; bf16x8 kf[8];
  const lds_cptr shm3=(lds_cptr)shm; const lds_cptr kp0=shm3+Y_K+hi*1024+r32*16;
  const int sw_=(r32>>2)&3; const lds_cptr vq0=shm3+Y_V+r32*64+((2*hi)^sw_)*16, vq1=shm3+Y_V+r32*64+(((2*hi)^sw_)^1)*16;
  const int NT=(q0+QB)/KVBLK;
  DMA_K(0,0);DMA_V(0,0);DMA_K(1,SLOTB);
  bf16x8 qr[4];
  #pragma unroll
  for(int d0=0;d0<4;++d0)qr[d0]=*reinterpret_cast<const bf16x8*>(&Qw[(long)r32*DM+d0*16+hi*8]);
  float mhat=0.f,l_reg=0.f;f32x16 o[4];o[0]=f32x16{};o[1]=f32x16{};o[2]=f32x16{};o[3]=f32x16{};
  float zz_=0.f; asm volatile("":"+v"(zz_)); f32x16 negm;
  _Pragma("unroll") for(int r=0;r<16;++r)negm[r]=zz_; asm volatile("":"+v"(negm));
  const int qrel=wid*QBLK+r32;
  #define CMASK(P0,P1,t) do{int jb_=(t)-(NT-4); if(jb_>=0)cmask(P0,P1,jb_,qrel,hi);}while(0)
  bool resc=false;
  #define RESC() do{ if(resc){ asm volatile("s_waitcnt lgkmcnt(0)":::"memory"); \
      _Pragma("unroll") for(int d_=0;d_<4;++d_) _Pragma("unroll") for(int r=0;r<16;++r)o[d_][r]*=wsf[crow(r,hi)]; } }while(0)
  f32x16 C0,C1; v8i_t pw;
  int sl_prev=0,sl_cur=0,sl_next=SLOTB;
  #define ROT() do{sl_prev=sl_cur;sl_cur=sl_next;sl_next=(sl_next==(XSLOTS-1)*SLOTB)?0:sl_next+SLOTB;}while(0)
  #define PK8(X,B) ({ int w_; asm volatile("":"=v"(w_)); w_=__builtin_amdgcn_cvt_pk_fp8_f32(X[B],X[(B)+1],w_,false); __builtin_amdgcn_cvt_pk_fp8_f32(X[(B)+2],X[(B)+3],w_,true); })
  #define PKALL() do{ pw=(v8i_t){PK8(C0,0),PK8(C0,4),PK8(C0,8),PK8(C0,12),PK8(C1,0),PK8(C1,4),PK8(C1,8),PK8(C1,12)}; }while(0)
  DMA_K(2,2*SLOTB);
  WAIT_BAR(3);
  qkt(C0,C1,Kbase,qr,negm,r32,hi);asm volatile("s_nop 15\n\ts_nop 7":"+v"(C0),"+v"(C1));CMASK(C0,C1,0);
  { const float rm=rowmax(C0,C1); const float dl=rm-PV8_PBIAS; mhat=fadd_s(mhat,dl);
    _Pragma("unroll") for(int r=0;r<16;++r){C0[r]=fsub_s(C0[r],dl);C1[r]=fsub_s(C1[r],dl);}
    _Pragma("unroll") for(int r=0;r<16;++r)negm[r]=-mhat; asm volatile("":"+v"(negm));
    _Pragma("unroll") for(int r=0;r<16;++r){C0[r]=__builtin_amdgcn_exp2f(C0[r]);C1[r]=__builtin_amdgcn_exp2f(C1[r]);}
    float sacc=C0[0]+C0[1]; _Pragma("unroll") for(int r=2;r<16;++r)sacc+=C0[r]; _Pragma("unroll") for(int r=0;r<16;++r)sacc+=C1[r]; l_reg+=sacc;
    pw=(v8i_t){PK8(C0,0),PK8(C0,4),PK8(C0,8),PK8(C0,12),PK8(C1,0),PK8(C1,4),PK8(C1,8),PK8(C1,12)}; }
  WAIT_BAR(0);
  DMA_K(3,3*SLOTB);DMA_V(1,SLOTB);
  ROT();
  kload8(kf,kp0+sl_cur);
  WAIT_BAR(2);
  v8i_t vf[4];
  #define PIN(x) asm volatile("":"+v"(x))
  #define MX3(a,b,c) __builtin_fmaxf(__builtin_fmaxf((a),(b)),(c))
  #define EX(v) __builtin_amdgcn_exp2f(v)
  #define VRL(d) do{ vf[d].lo=*(const __attribute__((address_space(3))) v4i_t*)(vq0+sl_prev+(d)*2048); }while(0)
  #define VRH(d) do{ vf[d].hi=*(const __attribute__((address_space(3))) v4i_t*)(vq1+sl_prev+(d)*2048); }while(0)
  #define EX8(X,B) do{ _Pragma("unroll") for(int e_=0;e_<8;++e_)X[(B)+e_]=EX(X[(B)+e_]); PIN(X); }while(0)
  #define SM8(X,B) do{ _Pragma("unroll") for(int e_=0;e_<8;++e_)sacc+=X[(B)+e_]; PIN(sacc); }while(0)
  #define KRD(G,j) do{ if(G){ kload2(kf,kp0+sl_next,j); } }while(0)
  #define MF8(d) o[d]=__builtin_amdgcn_mfma_scale_f32_32x32x64_f8f6f4(pw,vf[d],o[d],0,0,0,0,0,0)
  #define STEP(t,GK,GV,GL) do{ SBAR(); \
    VRL(0); SBAR(); C0=__builtin_amdgcn_mfma_f32_32x32x16_bf16(kf[0],qr[0],negm,0,0,0); SBAR(); \
    VRH(0); SBAR(); C1=__builtin_amdgcn_mfma_f32_32x32x16_bf16(kf[1],qr[0],negm,0,0,0); SBAR(); \
    VRL(1); SBAR(); C0=__builtin_amdgcn_mfma_f32_32x32x16_bf16(kf[2],qr[1],C0,0,0,0); SBAR(); \
    VRH(1); SBAR(); C1=__builtin_amdgcn_mfma_f32_32x32x16_bf16(kf[3],qr[1],C1,0,0,0); SBAR(); \
    VRL(2); SBAR(); C0=__builtin_amdgcn_mfma_f32_32x32x16_bf16(kf[4],qr[2],C0,0,0,0); SBAR(); \
    VRH(2); SBAR(); C1=__builtin_amdgcn_mfma_f32_32x32x16_bf16(kf[5],qr[2],C1,0,0,0); SBAR(); \
    VRL(3); SBAR(); C0=__builtin_amdgcn_mfma_f32_32x32x16_bf16(kf[6],qr[3],C0,0,0,0); SBAR(); \
    VRH(3); SBAR(); C1=__builtin_amdgcn_mfma_f32_32x32x16_bf16(kf[7],qr[3],C1,0,0,0); SBAR(); \
    if(GK){DMA_K((t)+3,sl_prev);} if(GV){DMA_V((t)+1,sl_next);} \
    CMASK(C0,C1,t); \
    SBAR(); \
    float sacc=0.f; \
    MF8(0); KRD(GL,0); EX8(C0,0); SM8(C0,0); SBAR(); \
    MF8(1); KRD(GL,1); EX8(C0,8); SM8(C0,8); SBAR(); \
    MF8(2); KRD(GL,2); EX8(C1,0); SM8(C1,0); SBAR(); \
    MF8(3); KRD(GL,3); EX8(C1,8); SM8(C1,8); SBAR(); \
    PKALL(); \
    resc=false; \
    if(__builtin_expect(__any(sacc>256.f),0)){                  \
      float a=MX3(C0[0],C0[1],C1[0]),b=MX3(C0[2],C0[3],C1[1]); a=MX3(a,C1[2],C1[3]); \
      _Pragma("unroll") for(int r=4;r<16;r+=4){a=MX3(a,C0[r],C0[r+1]);b=MX3(b,C0[r+2],C0[r+3]);a=MX3(a,C1[r],C1[r+1]);b=MX3(b,C1[r+2],C1[r+3]);} \
      float rm=__builtin_fmaxf(a,b); { auto rr=__builtin_amdgcn_permlane32_swap(__float_as_uint(rm),__float_as_uint(rm),false,false); rm=__builtin_fmaxf(__uint_as_float(rr[0]),__uint_as_float(rr[1])); } \
      const float dl=__builtin_fmaxf(__builtin_amdgcn_logf(rm)-PV8_PBIAS,0.f); mhat+=dl; \
      _Pragma("unroll") for(int r=0;r<16;++r)negm[r]=-mhat; asm volatile("":"+v"(negm)); \
      const float f=__builtin_amdgcn_exp2f(-dl); l_reg*=f; sacc*=f; if(hi==0)wsf[r32]=f; resc=true; \
      _Pragma("unroll") for(int r=0;r<16;++r){C0[r]*=f;C1[r]*=f;} \
      PKALL(); } \
    l_reg+=sacc; \
    }while(0)
  #define ENDW(tt) do{ if((tt)+3<NT){WAIT_BAR(2);} else if((tt)+2<NT){WAIT_BAR(1);} else {WAIT_BAR(0);} }while(0)
  int t=1;
  #undef CMASK
  #define CMASK(P0,P1,t) do{}while(0)
  for(;t<NT-4;++t){ STEP(t,true,true,true);
    if(HOST&&((wcs.ctr++&7)==0)&&wcs.idx<wct.total){ wconv::micro(wct,wcs,wstage,lane); WAIT_BAR(7); }
    else{ WAIT_BAR(2); }
    RESC(); ROT(); }
  #undef CMASK
  #define CMASK(P0,P1,t) do{int jb_=(t)-(NT-4); if(jb_>=0)cmask(P0,P1,jb_,qrel,hi);}while(0)
  for(;t<NT-1;++t){ STEP(t,(t+3<NT),(t+1<NT),(t+1<NT)); ENDW(t); RESC(); ROT(); }
  STEP(NT-1,false,false,false); RESC();
  { sl_prev=sl_cur; SBAR();
    VRL(0);VRH(0);VRL(1);VRH(1);VRL(2);VRH(2);VRL(3);VRH(3); SBAR(); MF8(0);MF8(1);MF8(2);MF8(3); }
  #undef PK8
  #undef PKALL
  #undef PIN
  #undef MX3
  #undef EX
  #undef VRL
  #undef VRH
  #undef EX8
  #undef SM8
  #undef KRD
  #undef MF8
  #undef STEP
  #undef ENDW
  {auto rr=__builtin_amdgcn_permlane32_swap(__float_as_uint(l_reg),__float_as_uint(l_reg),false,false);l_reg=__uint_as_float(rr[0])+__uint_as_float(rr[1]);}
  if(hi==0)wsf[32+r32]=l_reg;asm volatile("s_waitcnt lgkmcnt(0)":::"memory");
  { bf16*Of=O+(long)(q0+wid*QBLK)*opitch;
    #pragma unroll
    for(int r=0;r<16;++r){const int orow=crow(r,hi); const float rl=__builtin_amdgcn_rcpf(wsf[32+orow])*(1.f/PV8_VSCALE);
      #pragma unroll
      for(int d0=0;d0<4;++d0)Of[(long)orow*opitch+d0*32+r32]=__float2bfloat16(o[d0][r]*rl);} }
  asm volatile("s_waitcnt lgkmcnt(0)\n\ts_barrier":::"memory");
  #undef DMA_K
  #undef DMA_V
  #undef CMASK
  #undef RESC
  #undef ROT
}

template<int THRL,bool HOST> __device__ __forceinline__ void attn_unit128q8(int qb,const bf16*Q,const unsigned char*__restrict__ K8,const unsigned char*__restrict__ VT,bf16*O,int opitch,char*shm,const int wid,const wconv::Tab&wct,wconv::State&wcs,const unsigned wstage){
  int lane; asm volatile("v_mbcnt_lo_u32_b32 %0, -1, 0\n\tv_mbcnt_hi_u32_b32 %0, -1, %0":"=v"(lane)); const int r32=lane&31,hi=lane>>5;
  const int q0=qb*QB;
  const bf16*Qw=Q+(long)(q0+wid*QBLK)*DM;
  const unsigned lds0=(unsigned)(uintptr_t)shm;
  float*wsf=(float*)(shm+Y_WS)+wid*64;
  const unsigned koff=(unsigned)((wid&3)*1024+lane*16);
  const unsigned voff=(unsigned)(wid*1024+lane*16);
  const unsigned kdst=lds0+Y_K+(wid&3)*1024, vdst=lds0+Y_V+wid*1024;
  #define DMA_K(t,slot) glds16s(K8+(long)(t)*4096,koff,(unsigned)__builtin_amdgcn_readfirstlane(kdst+(slot)))
  #define DMA_V(t,slot) glds16s(VT+(long)(t)*8192,voff,(unsigned)__builtin_amdgcn_readfirstlane(vdst+(slot)))
  v8i_t kf8[2];
  const lds_cptr shm3=(lds_cptr)shm;
  const int sw_=(r32>>2)&3; const lds_cptr vq0=shm3+Y_V+r32*64+((2*hi)^sw_)*16, vq1=shm3+Y_V+r32*64+(((2*hi)^sw_)^1)*16; const lds_cptr kq0=vq0+(Y_K-Y_V), kq1=vq1+(Y_K-Y_V);
  const int NT=(q0+QB)/KVBLK;
  DMA_K(0,0);DMA_V(0,0);DMA_K(1,SLOTB);
  v8i_t q8;
  { u32x4 w_[4];
    #pragma unroll
    for(int i=0;i<4;++i)w_[i]=*reinterpret_cast<const u32x4*>(&Qw[(long)r32*DM+hi*32+8*i]);
    #define BL(x) __uint_as_float((x)<<16)
    #define BH(x) __uint_as_float((x)&0xffff0000u)
    #define Q4(a,b) ({ int w2_=0; w2_=__builtin_amdgcn_cvt_pk_fp8_f32(BL(a),BH(a),w2_,false); __builtin_amdgcn_cvt_pk_fp8_f32(BL(b),BH(b),w2_,true); })
    q8=(v8i_t){Q4(w_[0][0],w_[0][1]),Q4(w_[0][2],w_[0][3]),Q4(w_[1][0],w_[1][1]),Q4(w_[1][2],w_[1][3]),Q4(w_[2][0],w_[2][1]),Q4(w_[2][2],w_[2][3]),Q4(w_[3][0],w_[3][1]),Q4(w_[3][2],w_[3][3])};
    #undef BL
    #undef BH
    #undef Q4
  }
  #define KLD(b,sl) do{ kf8[b].lo=*(const __attribute__((address_space(3))) v4i_t*)(kq0+(sl)+(b)*2048); kf8[b].hi=*(const __attribute__((address_space(3))) v4i_t*)(kq1+(sl)+(b)*2048); }while(0)
  #define QK8(b) __builtin_amdgcn_mfma_scale_f32_32x32x64_f8f6f4(kf8[b],q8,negm,0,0,0,0,0,0)
  float mhat=0.f,l_reg=0.f;f32x16 o[4];o[0]=f32x16{};o[1]=f32x16{};o[2]=f32x16{};o[3]=f32x16{};
  float zz_=0.f; asm volatile("":"+v"(zz_)); f32x16 negm;
  _Pragma("unroll") for(int r=0;r<16;++r)negm[r]=zz_; asm volatile("":"+v"(negm));
  const int qrel=wid*QBLK+r32;
  #define CMASK(P0,P1,t) do{int jb_=(t)-(NT-4); if(jb_>=0)cmask(P0,P1,jb_,qrel,hi);}while(0)
  bool resc=false;
  #define RESC() do{ if(resc){ asm volatile("s_waitcnt lgkmcnt(0)":::"memory"); \
      _Pragma("unroll") for(int d_=0;d_<4;++d_) _Pragma("unroll") for(int r=0;r<16;++r)o[d_][r]*=wsf[crow(r,hi)]; } }while(0)
  f32x16 C0,C1; v8i_t pw;
  int sl_prev=0,sl_cur=0,sl_next=SLOTB;
  #define ROT() do{sl_prev=sl_cur;sl_cur=sl_next;sl_next=(sl_next==(XSLOTS-1)*SLOTB)?0:sl_next+SLOTB;}while(0)
  #define PK8(X,B) ({ int w_; asm volatile("":"=v"(w_)); w_=__builtin_amdgcn_cvt_pk_fp8_f32(X[B],X[(B)+1],w_,false); __builtin_amdgcn_cvt_pk_fp8_f32(X[(B)+2],X[(B)+3],w_,true); })
  #define PKALL() do{ pw=(v8i_t){PK8(C0,0),PK8(C0,4),PK8(C0,8),PK8(C0,12),PK8(C1,0),PK8(C1,4),PK8(C1,8),PK8(C1,12)}; }while(0)
  DMA_K(2,2*SLOTB);
  WAIT_BAR(3);
  KLD(0,0);KLD(1,0);asm volatile("s_waitcnt lgkmcnt(0)":::"memory"); C0=QK8(0); C1=QK8(1); asm volatile("s_nop 15\n\ts_nop 7":"+v"(C0),"+v"(C1));CMASK(C0,C1,0);
  { const float rm=rowmax(C0,C1); const float dl=rm-PV8_PBIAS; mhat=fadd_s(mhat,dl);
    _Pragma("unroll") for(int r=0;r<16;++r){C0[r]=fsub_s(C0[r],dl);C1[r]=fsub_s(C1[r],dl);}
    _Pragma("unroll") for(int r=0;r<16;++r)negm[r]=-mhat; asm volatile("":"+v"(negm));
    _Pragma("unroll") for(int r=0;r<16;++r){C0[r]=__builtin_amdgcn_exp2f(C0[r]);C1[r]=__builtin_amdgcn_exp2f(C1[r]);}
    float sacc=C0[0]+C0[1]; _Pragma("unroll") for(int r=2;r<16;++r)sacc+=C0[r]; _Pragma("unroll") for(int r=0;r<16;++r)sacc+=C1[r]; l_reg+=sacc;
    pw=(v8i_t){PK8(C0,0),PK8(C0,4),PK8(C0,8),PK8(C0,12),PK8(C1,0),PK8(C1,4),PK8(C1,8),PK8(C1,12)}; }
  WAIT_BAR(0);
  DMA_K(3,3*SLOTB);DMA_V(1,SLOTB);
  ROT();
  KLD(0,sl_cur);KLD(1,sl_cur);
  WAIT_BAR(2);
  v8i_t vf[4];
  #define PIN(x) asm volatile("":"+v"(x))
  #define MX3(a,b,c) __builtin_fmaxf(__builtin_fmaxf((a),(b)),(c))
  #define EX(v) __builtin_amdgcn_exp2f(v)
  #define VRL(d) do{ vf[d].lo=*(const __attribute__((address_space(3))) v4i_t*)(vq0+sl_prev+(d)*2048); }while(0)
  #define VRH(d) do{ vf[d].hi=*(const __attribute__((address_space(3))) v4i_t*)(vq1+sl_prev+(d)*2048); }while(0)
  #define EX8(X,B) do{ _Pragma("unroll") for(int e_=0;e_<8;++e_)X[(B)+e_]=EX(X[(B)+e_]); PIN(X); }while(0)
  #define SM8(X,B) do{ _Pragma("unroll") for(int e_=0;e_<8;++e_)sacc+=X[(B)+e_]; PIN(sacc); }while(0)
  #define KRD(G,j) do{ if((G)&&(j)<2){ KLD(j,sl_next); } }while(0)
  #define MF8(d) o[d]=__builtin_amdgcn_mfma_scale_f32_32x32x64_f8f6f4(pw,vf[d],o[d],0,0,0,0,0,0)
  #define STEP(t,GK,GV,GL) do{ SBAR(); \
    VRL(0); VRH(0); VRL(1); VRH(1); SBAR(); C0=QK8(0); SBAR(); \
    VRL(2); VRH(2); VRL(3); VRH(3); SBAR(); C1=QK8(1); SBAR(); \
    if(GK){DMA_K((t)+3,sl_prev);} if(GV){DMA_V((t)+1,sl_next);} \
    CMASK(C0,C1,t); \
    SBAR(); \
    float sacc=0.f; \
    MF8(0); KRD(GL,0); EX8(C0,0); SM8(C0,0); SBAR(); \
    MF8(1); KRD(GL,1); EX8(C0,8); SM8(C0,8); SBAR(); \
    MF8(2); KRD(GL,2); EX8(C1,0); SM8(C1,0); SBAR(); \
    MF8(3); KRD(GL,3); EX8(C1,8); SM8(C1,8); SBAR(); \
    PKALL(); \
    resc=false; \
    if(__builtin_expect(__any(sacc>256.f),0)){                  \
      float a=MX3(C0[0],C0[1],C1[0]),b=MX3(C0[2],C0[3],C1[1]); a=MX3(a,C1[2],C1[3]); \
      _Pragma("unroll") for(int r=4;r<16;r+=4){a=MX3(a,C0[r],C0[r+1]);b=MX3(b,C0[r+2],C0[r+3]);a=MX3(a,C1[r],C1[r+1]);b=MX3(b,C1[r+2],C1[r+3]);} \
      float rm=__builtin_fmaxf(a,b); { auto rr=__builtin_amdgcn_permlane32_swap(__float_as_uint(rm),__float_as_uint(rm),false,false); rm=__builtin_fmaxf(__uint_as_float(rr[0]),__uint_as_float(rr[1])); } \
      const float dl=__builtin_fmaxf(__builtin_amdgcn_logf(rm)-PV8_PBIAS,0.f); mhat+=dl; \
      _Pragma("unroll") for(int r=0;r<16;++r)negm[r]=-mhat; asm volatile("":"+v"(negm)); \
      const float f=__builtin_amdgcn_exp2f(-dl); l_reg*=f; sacc*=f; if(hi==0)wsf[r32]=f; resc=true; \
      _Pragma("unroll") for(int r=0;r<16;++r){C0[r]*=f;C1[r]*=f;} \
      PKALL(); } \
    l_reg+=sacc; \
    }while(0)
  #define ENDW(tt) do{ if((tt)+3<NT){WAIT_BAR(2);} else if((tt)+2<NT){WAIT_BAR(1);} else {WAIT_BAR(0);} }while(0)
  int t=1;
  #undef CMASK
  #define CMASK(P0,P1,t) do{}while(0)
  for(;t<NT-4;++t){ STEP(t,true,true,true);
    if(HOST&&((wcs.ctr++&7)==0)&&wcs.idx<wct.total){ wconv::micro(wct,wcs,wstage,lane); WAIT_BAR(7); }
    else{ WAIT_BAR(2); }
    RESC(); ROT(); }
  #undef CMASK
  #define CMASK(P0,P1,t) do{int jb_=(t)-(NT-4); if(jb_>=0)cmask(P0,P1,jb_,qrel,hi);}while(0)
  for(;t<NT-1;++t){ STEP(t,(t+3<NT),(t+1<NT),(t+1<NT)); ENDW(t); RESC(); ROT(); }
  STEP(NT-1,false,false,false); RESC();
  { sl_prev=sl_cur; SBAR();
    VRL(0);VRH(0);VRL(1);VRH(1);VRL(2);VRH(2);VRL(3);VRH(3); SBAR(); MF8(0);MF8(1);MF8(2);MF8(3); }
  #undef PK8
  #undef PKALL
  #undef PIN
  #undef MX3
  #undef EX
  #undef VRL
  #undef VRH
  #undef EX8
  #undef SM8
  #undef KRD
  #undef KLD
  #undef QK8
  #undef MF8
  #undef STEP
  #undef ENDW
  {auto rr=__builtin_amdgcn_permlane32_swap(__float_as_uint(l_reg),__float_as_uint(l_reg),false,false);l_reg=__uint_as_float(rr[0])+__uint_as_float(rr[1]);}
  if(hi==0)wsf[32+r32]=l_reg;asm volatile("s_waitcnt lgkmcnt(0)":::"memory");
  { bf16*Of=O+(long)(q0+wid*QBLK)*opitch;
    #pragma unroll
    for(int r=0;r<16;++r){const int orow=crow(r,hi); const float rl=__builtin_amdgcn_rcpf(wsf[32+orow])*(1.f/PV8_VSCALE);
      #pragma unroll
      for(int d0=0;d0<4;++d0)Of[(long)orow*opitch+d0*32+r32]=__float2bfloat16(o[d0][r]*rl);} }
  asm volatile("s_waitcnt lgkmcnt(0)\n\ts_barrier":::"memory");
  #undef DMA_K
  #undef DMA_V
  #undef CMASK
  #undef RESC
  #undef ROT
}


constexpr int R_K=0, R_V=32768, R_KG=16384, R_VG=32768, R_LDS_BYTES=R_V+2*R_VG;
template<int THRL,bool HOST> __device__ __forceinline__ void attn_unit128r8(int qb,const bf16*Q,const unsigned char*__restrict__ K8,const unsigned char*__restrict__ VT,bf16*O,int opitch,char*shm,float*wsf0,const int wid,const wconv::Tab&wct,wconv::State&wcs,const unsigned wstage){
  int lane; asm volatile("v_mbcnt_lo_u32_b32 %0, -1, 0\n\tv_mbcnt_hi_u32_b32 %0, -1, %0":"=v"(lane)); const int r32=lane&31,hi=lane>>5;
  const int q0=qb*QB;
  const bf16*Qw=Q+(long)(q0+wid*QBLK)*DM;
  const unsigned lds0=(unsigned)(uintptr_t)shm;
  float*wsf=wsf0+wid*64;
  const unsigned poff=(unsigned)(wid*1024+lane*16);
  const unsigned pdst=lds0+wid*1024;
  #define SEND_K(g,np) do{ const unsigned char*s_=K8+(long)(4*(g)+2)*4096; const unsigned d_=pdst+R_K+(((g)+2)&1)*R_KG; \
      glds16s(s_,poff,(unsigned)__builtin_amdgcn_readfirstlane(d_)); if((np)>1){ glds16s(s_+8192,poff,(unsigned)__builtin_amdgcn_readfirstlane(d_+8192)); } }while(0)
  #define SEND_V(g) do{ const unsigned char*s_=VT+(long)(4*(g))*8192; const unsigned d_=pdst+R_V+((g)&1)*R_VG; \
      _Pragma("unroll") for(int j_=0;j_<4;++j_) glds16s(s_+j_*8192,poff,(unsigned)__builtin_amdgcn_readfirstlane(d_+j_*8192)); }while(0)
  v8i_t kf8[2];
  const lds_cptr shm3=(lds_cptr)shm;
  const int sw_=(r32>>2)&3; const lds_cptr vq0=shm3+R_V+r32*64+((2*hi)^sw_)*16, vq1=shm3+R_V+r32*64+(((2*hi)^sw_)^1)*16; const lds_cptr kq0=vq0+(R_K-R_V), kq1=vq1+(R_K-R_V);
  const int NT=(q0+QB)/KVBLK;
  glds16s(K8,poff,(unsigned)__builtin_amdgcn_readfirstlane(pdst+R_K+R_KG));
  v8i_t q8;
  { u32x4 w_[4];
    #pragma unroll
    for(int i=0;i<4;++i)w_[i]=*reinterpret_cast<const u32x4*>(&Qw[(long)r32*DM+hi*32+8*i]);
    SEND_V(0); SEND_K(0,(qb>0)?2:1);
    #define BL(x) __uint_as_float((x)<<16)
    #define BH(x) __uint_as_float((x)&0xffff0000u)
    #define Q4(a,b) ({ int w2_=0; w2_=__builtin_amdgcn_cvt_pk_fp8_f32(BL(a),BH(a),w2_,false); __builtin_amdgcn_cvt_pk_fp8_f32(BL(b),BH(b),w2_,true); })
    q8=(v8i_t){Q4(w_[0][0],w_[0][1]),Q4(w_[0][2],w_[0][3]),Q4(w_[1][0],w_[1][1]),Q4(w_[1][2],w_[1][3]),Q4(w_[2][0],w_[2][1]),Q4(w_[2][2],w_[2][3]),Q4(w_[3][0],w_[3][1]),Q4(w_[3][2],w_[3][3])};
    #undef BL
    #undef BH
    #undef Q4
  }
  #define KLD(b,ko) do{ kf8[b].lo=*(const __attribute__((address_space(3))) v4i_t*)(kq0+(ko)+(b)*2048); kf8[b].hi=*(const __attribute__((address_space(3))) v4i_t*)(kq1+(ko)+(b)*2048); }while(0)
  #define QK8(b) __builtin_amdgcn_mfma_scale_f32_32x32x64_f8f6f4(kf8[b],q8,negm,0,0,0,0,0,0)
  float mhat=0.f,l_reg=0.f;f32x16 o[4];o[0]=f32x16{};o[1]=f32x16{};o[2]=f32x16{};o[3]=f32x16{};
  float zz_=0.f; asm volatile("":"+v"(zz_)); f32x16 negm;
  _Pragma("unroll") for(int r=0;r<16;++r)negm[r]=zz_; asm volatile("":"+v"(negm));
  const int qrel=wid*QBLK+r32;
  #define CMASK(P0,P1,t) do{int jb_=(t)-(NT-4); if(jb_>=0)cmask(P0,P1,jb_,qrel,hi);}while(0)
  bool resc=false;
  #define RESC() do{ if(resc){ asm volatile("s_waitcnt lgkmcnt(0)":::"memory"); \
      _Pragma("unroll") for(int d_=0;d_<4;++d_) _Pragma("unroll") for(int r=0;r<16;++r)o[d_][r]*=wsf[crow(r,hi)]; } }while(0)
  f32x16 C0,C1; v8i_t pw;
  #define PK8(X,B) ({ int w_; asm volatile("":"=v"(w_)); w_=__builtin_amdgcn_cvt_pk_fp8_f32(X[B],X[(B)+1],w_,false); __builtin_amdgcn_cvt_pk_fp8_f32(X[(B)+2],X[(B)+3],w_,true); })
  #define PKALL() do{ pw=(v8i_t){PK8(C0,0),PK8(C0,4),PK8(C0,8),PK8(C0,12),PK8(C1,0),PK8(C1,4),PK8(C1,8),PK8(C1,12)}; }while(0)
  if(qb>0){ WAIT_BAR(6); } else { WAIT_BAR(5); }
  KLD(0,R_KG);KLD(1,R_KG);asm volatile("s_waitcnt lgkmcnt(0)":::"memory"); C0=QK8(0); C1=QK8(1); asm volatile("s_nop 15\n\ts_nop 7":"+v"(C0),"+v"(C1));CMASK(C0,C1,0);
  { const float rm=rowmax(C0,C1); const float dl=rm-PV8_PBIAS; mhat=fadd_s(mhat,dl);
    _Pragma("unroll") for(int r=0;r<16;++r){C0[r]=fsub_s(C0[r],dl);C1[r]=fsub_s(C1[r],dl);}
    _Pragma("unroll") for(int r=0;r<16;++r)negm[r]=-mhat; asm volatile("":"+v"(negm));
    _Pragma("unroll") for(int r=0;r<16;++r){C0[r]=__builtin_amdgcn_exp2f(C0[r]);C1[r]=__builtin_amdgcn_exp2f(C1[r]);}
    float sacc=C0[0]+C0[1]; _Pragma("unroll") for(int r=2;r<16;++r)sacc+=C0[r]; _Pragma("unroll") for(int r=0;r<16;++r)sacc+=C1[r]; l_reg+=sacc;
    pw=(v8i_t){PK8(C0,0),PK8(C0,4),PK8(C0,8),PK8(C0,12),PK8(C1,0),PK8(C1,4),PK8(C1,8),PK8(C1,12)}; }
  KLD(0,R_KG+4096);KLD(1,R_KG+4096);
  WAIT_BAR(0);
  v8i_t vf[4];
  #define PIN(x) asm volatile("":"+v"(x))
  #define MX3(a,b,c) __builtin_fmaxf(__builtin_fmaxf((a),(b)),(c))
  #define EX(v) __builtin_amdgcn_exp2f(v)
  #define VRL(d,vo) do{ vf[d].lo=*(const __attribute__((address_space(3))) v4i_t*)(vq0+(vo)+(d)*2048); }while(0)
  #define VRH(d,vo) do{ vf[d].hi=*(const __attribute__((address_space(3))) v4i_t*)(vq1+(vo)+(d)*2048); }while(0)
  #define EX8(X,B) do{ _Pragma("unroll") for(int e_=0;e_<8;++e_)X[(B)+e_]=EX(X[(B)+e_]); PIN(X); }while(0)
  #define SM8(X,B) do{ _Pragma("unroll") for(int e_=0;e_<8;++e_)sacc+=X[(B)+e_]; PIN(sacc); }while(0)
  #define KRD(G,j,ko) do{ if((G)&&(j)<2){ KLD(j,ko); } }while(0)
  #define MF8(d) o[d]=__builtin_amdgcn_mfma_scale_f32_32x32x64_f8f6f4(pw,vf[d],o[d],0,0,0,0,0,0)
  #define STEP(t,vo,ko,GL) do{ SBAR(); \
    VRL(0,vo); VRH(0,vo); VRL(1,vo); VRH(1,vo); SBAR(); C0=QK8(0); SBAR(); \
    VRL(2,vo); VRH(2,vo); VRL(3,vo); VRH(3,vo); SBAR(); C1=QK8(1); SBAR(); \
    CMASK(C0,C1,t); \
    SBAR(); \
    float sacc=0.f; \
    MF8(0); KRD(GL,0,ko); EX8(C0,0); SM8(C0,0); SBAR(); \
    MF8(1); KRD(GL,1,ko); EX8(C0,8); SM8(C0,8); SBAR(); \
    MF8(2); EX8(C1,0); SM8(C1,0); SBAR(); \
    MF8(3); EX8(C1,8); SM8(C1,8); SBAR(); \
    PKALL(); \
    resc=false; \
    if(__builtin_expect(__any(sacc>128.f),0)){                  \
      float a=MX3(C0[0],C0[1],C1[0]),b=MX3(C0[2],C0[3],C1[1]); a=MX3(a,C1[2],C1[3]); \
      _Pragma("unroll") for(int r=4;r<16;r+=4){a=MX3(a,C0[r],C0[r+1]);b=MX3(b,C0[r+2],C0[r+3]);a=MX3(a,C1[r],C1[r+1]);b=MX3(b,C1[r+2],C1[r+3]);} \
      float rm=__builtin_fmaxf(a,b); { auto rr=__builtin_amdgcn_permlane32_swap(__float_as_uint(rm),__float_as_uint(rm),false,false); rm=__builtin_fmaxf(__uint_as_float(rr[0]),__uint_as_float(rr[1])); } \
      const float dl=__builtin_fmaxf(__builtin_amdgcn_logf(rm)-PV8_PBIAS,0.f); mhat+=dl; \
      _Pragma("unroll") for(int r=0;r<16;++r)negm[r]=-mhat; asm volatile("":"+v"(negm)); \
      const float f=__builtin_amdgcn_exp2f(-dl); l_reg*=f; sacc*=f; if(hi==0)wsf[r32]=f; resc=true; \
      _Pragma("unroll") for(int r=0;r<16;++r){C0[r]*=f;C1[r]*=f;} \
      PKALL(); } \
    l_reg+=sacc; \
    RESC(); \
    }while(0)
  #define QUAD(g) do{ const int vs_=((g)&1)*R_VG, ks_=((g)&1)*R_KG; const int t0_=4*(g)+1; \
      STEP(t0_,vs_,ks_,true); STEP(t0_+1,vs_+8192,ks_+4096,true); STEP(t0_+2,vs_+16384,ks_+8192,true); STEP(t0_+3,vs_+24576,ks_+12288,true); }while(0)
  int g=0;
  #undef CMASK
  #define CMASK(P0,P1,t) do{}while(0)
  for(;g<qb-1;++g){
    SEND_K(g+1,2); SEND_V(g+1);
    QUAD(g);
    if(HOST&&((wcs.ctr++&1)==0)&&wcs.idx<wct.total){ wconv::micro(wct,wcs,wstage,lane); WAIT_BAR(5); }
    else{ WAIT_BAR(0); }
  }
  #undef CMASK
  #define CMASK(P0,P1,t) do{int jb_=(t)-(NT-4); if(jb_>=0)cmask(P0,P1,jb_,qrel,hi);}while(0)
  if(g<qb){
    SEND_K(g+1,1); SEND_V(g+1);
    QUAD(g);
    WAIT_BAR(0); ++g; }
  { const int vs_=(g&1)*R_VG, ks_=(g&1)*R_KG;
    STEP(NT-3,vs_,ks_,true); STEP(NT-2,vs_+8192,ks_+4096,true); STEP(NT-1,vs_+16384,0,false);
    SBAR(); VRL(0,vs_+24576);VRH(0,vs_+24576);VRL(1,vs_+24576);VRH(1,vs_+24576);VRL(2,vs_+24576);VRH(2,vs_+24576);VRL(3,vs_+24576);VRH(3,vs_+24576); SBAR(); MF8(0);MF8(1);MF8(2);MF8(3); }
  #undef QUAD
  #undef PK8
  #undef PKALL
  #undef PIN
  #undef MX3
  #undef EX
  #undef VRL
  #undef VRH
  #undef EX8
  #undef SM8
  #undef KRD
  #undef KLD
  #undef QK8
  #undef MF8
  #undef STEP
  {auto rr=__builtin_amdgcn_permlane32_swap(__float_as_uint(l_reg),__float_as_uint(l_reg),false,false);l_reg=__uint_as_float(rr[0])+__uint_as_float(rr[1]);}
  if(hi==0)wsf[32+r32]=l_reg;asm volatile("s_waitcnt lgkmcnt(0)":::"memory");
  { bf16*Of=O+(long)(q0+wid*QBLK)*opitch;
    #pragma unroll
    for(int r=0;r<16;++r){const int orow=crow(r,hi); const float rl=__builtin_amdgcn_rcpf(wsf[32+orow])*(1.f/PV8_VSCALE);
      #pragma unroll
      for(int d0=0;d0<4;++d0)Of[(long)orow*opitch+d0*32+r32]=__float2bfloat16(o[d0][r]*rl);} }
  asm volatile("s_waitcnt lgkmcnt(0)\n\ts_barrier":::"memory");
  #undef SEND_K
  #undef SEND_V
  #undef CMASK
  #undef RESC
}

template<int THRL,bool HOST> __device__ __forceinline__ void attn_unit128r9(int qb,const bf16*Q,const unsigned char*__restrict__ K8,const unsigned char*__restrict__ VT,bf16*O,int opitch,char*shm,float*wsf0,const int wid,const wconv::Tab&wct,wconv::State&wcs,const unsigned wstage){
  int lane; asm volatile("v_mbcnt_lo_u32_b32 %0, -1, 0\n\tv_mbcnt_hi_u32_b32 %0, -1, %0":"=v"(lane)); const int r32=lane&31,hi=lane>>5;
  const int q0=qb*QB;
  const bf16*Qw=Q+(long)(q0+wid*QBLK)*DM;
  const unsigned lds0=(unsigned)(uintptr_t)shm;
  float*wsf=wsf0+wid*64;
  const unsigned poff=(unsigned)(wid*1024+lane*16);
  const unsigned pdst=lds0+wid*1024;
  #define SEND_K(g,np) do{ const unsigned char*s_=K8+(long)(4*(g)+2)*4096; const unsigned d_=pdst+R_K+(((g)+2)&1)*R_KG; \
      glds16s(s_,poff,(unsigned)__builtin_amdgcn_readfirstlane(d_)); if((np)>1){ glds16s(s_+8192,poff,(unsigned)__builtin_amdgcn_readfirstlane(d_+8192)); } }while(0)
  #define SEND_V(g) do{ const unsigned char*s_=VT+(long)(4*(g))*8192; const unsigned d_=pdst+R_V+((g)&1)*R_VG; \
      _Pragma("unroll") for(int j_=0;j_<4;++j_) glds16s(s_+j_*8192,poff,(unsigned)__builtin_amdgcn_readfirstlane(d_+j_*8192)); }while(0)
  v8i_t kf8[2];
  const lds_cptr shm3=(lds_cptr)shm;
  const int sw_=(r32>>2)&3; const lds_cptr vq0=shm3+R_V+r32*64+((2*hi)^sw_)*16, vq1=shm3+R_V+r32*64+(((2*hi)^sw_)^1)*16; const lds_cptr kq0=vq0+(R_K-R_V), kq1=vq1+(R_K-R_V);
  const int NT=(q0+QB)/KVBLK;
  glds16s(K8,poff,(unsigned)__builtin_amdgcn_readfirstlane(pdst+R_K+R_KG));
  v8i_t q8;
  { u32x4 w_[4];
    #pragma unroll
    for(int i=0;i<4;++i)w_[i]=*reinterpret_cast<const u32x4*>(&Qw[(long)r32*DM+hi*32+8*i]);
    SEND_V(0); SEND_K(0,(qb>0)?2:1);
    #define BL(x) __uint_as_float((x)<<16)
    #define BH(x) __uint_as_float((x)&0xffff0000u)
    #define Q4(a,b) ({ int w2_=0; w2_=__builtin_amdgcn_cvt_pk_fp8_f32(BL(a),BH(a),w2_,false); __builtin_amdgcn_cvt_pk_fp8_f32(BL(b),BH(b),w2_,true); })
    q8=(v8i_t){Q4(w_[0][0],w_[0][1]),Q4(w_[0][2],w_[0][3]),Q4(w_[1][0],w_[1][1]),Q4(w_[1][2],w_[1][3]),Q4(w_[2][0],w_[2][1]),Q4(w_[2][2],w_[2][3]),Q4(w_[3][0],w_[3][1]),Q4(w_[3][2],w_[3][3])};
    #undef BL
    #undef BH
    #undef Q4
  }
  #define KLD(b,ko) do{ kf8[b].lo=*(const __attribute__((address_space(3))) v4i_t*)(kq0+(ko)+(b)*2048); kf8[b].hi=*(const __attribute__((address_space(3))) v4i_t*)(kq1+(ko)+(b)*2048); }while(0)
  #define QK8(b) __builtin_amdgcn_mfma_scale_f32_32x32x64_f8f6f4(kf8[b],q8,negm,0,0,0,0,0,0)
  float mhat=0.f;f32x16 o[4];
  typedef float f32x4s __attribute__((ext_vector_type(4)));
  const int bs_=((lane&15)==((lane>>4)&1))?0x38383838:0; const v8i_t bsel=(v8i_t){bs_,bs_,bs_,bs_,bs_,bs_,bs_,bs_};
  f32x4s lacc=(f32x4s){0.f,0.f,0.f,0.f},dsum=(f32x4s){0.f,0.f,0.f,0.f};
  #define SUMP() dsum=__builtin_amdgcn_mfma_scale_f32_16x16x128_f8f6f4(pw,bsel,(f32x4s){0.f,0.f,0.f,0.f},0,0,0,0,0,0)
o[0]=f32x16{};o[1]=f32x16{};o[2]=f32x16{};o[3]=f32x16{};
  float zz_=0.f; asm volatile("":"+v"(zz_)); f32x16 negm;
  _Pragma("unroll") for(int r=0;r<16;++r)negm[r]=zz_; asm volatile("":"+v"(negm));
  const int qrel=wid*QBLK+r32;
  #define CMASK(P0,P1,t) do{int jb_=(t)-(NT-4); if(jb_>=0)cmask(P0,P1,jb_,qrel,hi);}while(0)
  bool resc=false;
  #define RESC() do{ if(resc){ asm volatile("s_waitcnt lgkmcnt(0)":::"memory"); \
      _Pragma("unroll") for(int d_=0;d_<4;++d_) _Pragma("unroll") for(int r=0;r<16;++r)o[d_][r]*=wsf[crow(r,hi)]; } }while(0)
  f32x16 C0,C1; v8i_t pw;
  #define PK8(X,B) ({ int w_; asm volatile("":"=v"(w_)); w_=__builtin_amdgcn_cvt_pk_fp8_f32(X[B],X[(B)+1],w_,false); __builtin_amdgcn_cvt_pk_fp8_f32(X[(B)+2],X[(B)+3],w_,true); })
  #define PKALL() do{ pw=(v8i_t){PK8(C0,0),PK8(C0,4),PK8(C0,8),PK8(C0,12),PK8(C1,0),PK8(C1,4),PK8(C1,8),PK8(C1,12)}; }while(0)
  if(qb>0){ WAIT_BAR(6); } else { WAIT_BAR(5); }
  KLD(0,R_KG);KLD(1,R_KG);asm volatile("s_waitcnt lgkmcnt(0)":::"memory"); C0=QK8(0); C1=QK8(1); asm volatile("s_nop 15\n\ts_nop 7":"+v"(C0),"+v"(C1));CMASK(C0,C1,0);
  { const float rm=rowmax(C0,C1); const float dl=rm-PV8_PBIAS; mhat=fadd_s(mhat,dl);
    _Pragma("unroll") for(int r=0;r<16;++r){C0[r]=fsub_s(C0[r],dl);C1[r]=fsub_s(C1[r],dl);}
    _Pragma("unroll") for(int r=0;r<16;++r)negm[r]=-mhat; asm volatile("":"+v"(negm));
    _Pragma("unroll") for(int r=0;r<16;++r){C0[r]=__builtin_amdgcn_exp2f(C0[r]);C1[r]=__builtin_amdgcn_exp2f(C1[r]);}
    pw=(v8i_t){PK8(C0,0),PK8(C0,4),PK8(C0,8),PK8(C0,12),PK8(C1,0),PK8(C1,4),PK8(C1,8),PK8(C1,12)}; SUMP(); }
  KLD(0,R_KG+4096);KLD(1,R_KG+4096);
  WAIT_BAR(0);
  v8i_t vf[4];
  #define PIN(x) asm volatile("":"+v"(x))
  #define MX3(a,b,c) __builtin_fmaxf(__builtin_fmaxf((a),(b)),(c))
  #define EX(v) __builtin_amdgcn_exp2f(v)
  #define VRL(d,vo) do{ vf[d].lo=*(const __attribute__((address_space(3))) v4i_t*)(vq0+(vo)+(d)*2048); }while(0)
  #define VRH(d,vo) do{ vf[d].hi=*(const __attribute__((address_space(3))) v4i_t*)(vq1+(vo)+(d)*2048); }while(0)
  #define EX8(X,B) do{ _Pragma("unroll") for(int e_=0;e_<8;++e_)X[(B)+e_]=EX(X[(B)+e_]); PIN(X); }while(0)
  #define SM8(X,B) do{ _Pragma("unroll") for(int e_=0;e_<8;++e_)sacc+=X[(B)+e_]; PIN(sacc); }while(0)
  #define KRD(G,j,ko) do{ if((G)&&(j)<2){ KLD(j,ko); } }while(0)
  #define MF8(d) o[d]=__builtin_amdgcn_mfma_scale_f32_32x32x64_f8f6f4(pw,vf[d],o[d],0,0,0,0,0,0)
  #define CHECKP() do{ resc=false; \
    const float dm_=__builtin_fmaxf(__builtin_fmaxf(dsum[0],dsum[1]),__builtin_fmaxf(dsum[2],dsum[3])); \
    if(__builtin_expect(__any(!(dm_<256.f)),0)){ \
      float a=MX3(C0[0],C0[1],C1[0]),b=MX3(C0[2],C0[3],C1[1]); a=MX3(a,C1[2],C1[3]); \
      _Pragma("unroll") for(int r=4;r<16;r+=4){a=MX3(a,C0[r],C0[r+1]);b=MX3(b,C0[r+2],C0[r+3]);a=MX3(a,C1[r],C1[r+1]);b=MX3(b,C1[r+2],C1[r+3]);} \
      float rm=__builtin_fmaxf(a,b); { auto rr=__builtin_amdgcn_permlane32_swap(__float_as_uint(rm),__float_as_uint(rm),false,false); rm=__builtin_fmaxf(__uint_as_float(rr[0]),__uint_as_float(rr[1])); } \
      const float dl=__builtin_fmaxf(__builtin_amdgcn_logf(rm)-PV8_PBIAS,0.f); mhat+=dl; \
      _Pragma("unroll") for(int r=0;r<16;++r)negm[r]=-mhat; asm volatile("":"+v"(negm)); \
      const float f=__builtin_amdgcn_exp2f(-dl); if(hi==0)wsf[r32]=f; resc=true; \
      _Pragma("unroll") for(int r=0;r<16;++r){C0[r]*=f;C1[r]*=f;} \
      PKALL(); SUMP(); \
      asm volatile("s_waitcnt lgkmcnt(0)":::"memory"); \
      { const int qb_=(lane&15)*16+4*(lane>>4); _Pragma("unroll") for(int j_=0;j_<4;++j_)lacc[j_]*=wsf[(qb_+j_)&31]; } \
      _Pragma("unroll") for(int d_=0;d_<4;++d_) _Pragma("unroll") for(int r=0;r<16;++r)o[d_][r]*=wsf[crow(r,hi)]; } \
    lacc+=dsum; }while(0)
  #define STEP(t,vo,ko,GL) do{ SBAR(); \
    VRL(0,vo); VRH(0,vo); VRL(1,vo); VRH(1,vo); VRL(2,vo); VRH(2,vo); VRL(3,vo); VRH(3,vo); SBAR(); \
    CHECKP(); SBAR(); \
    C0=QK8(0); SBAR(); C1=QK8(1); SBAR(); \
    CMASK(C0,C1,t); \
    SBAR(); \
    MF8(0); KRD(GL,0,ko); EX8(C0,0); SBAR(); \
    MF8(1); KRD(GL,1,ko); EX8(C0,8); SBAR(); \
    MF8(2); EX8(C1,0); SBAR(); \
    MF8(3); EX8(C1,8); SBAR(); \
    PKALL(); SUMP(); \
    }while(0)
  #define QUAD(g) do{ const int vs_=((g)&1)*R_VG, ks_=((g)&1)*R_KG; const int t0_=4*(g)+1; \
      STEP(t0_,vs_,ks_,true); STEP(t0_+1,vs_+8192,ks_+4096,true); STEP(t0_+2,vs_+16384,ks_+8192,true); STEP(t0_+3,vs_+24576,ks_+12288,true); }while(0)
  int g=0;
  #undef CMASK
  #define CMASK(P0,P1,t) do{}while(0)
  for(;g<qb-1;++g){
    SEND_K(g+1,2); SEND_V(g+1);
    QUAD(g);
    if(HOST&&((wcs.ctr++&1)==0)&&wcs.idx<wct.total){ wconv::micro(wct,wcs,wstage,lane); WAIT_BAR(5); }
    else{ WAIT_BAR(0); }
  }
  #undef CMASK
  #define CMASK(P0,P1,t) do{int jb_=(t)-(NT-4); if(jb_>=0)cmask(P0,P1,jb_,qrel,hi);}while(0)
  if(g<qb){
    SEND_K(g+1,1); SEND_V(g+1);
    QUAD(g);
    WAIT_BAR(0); ++g; }
  { const int vs_=(g&1)*R_VG, ks_=(g&1)*R_KG;
    STEP(NT-3,vs_,ks_,true); STEP(NT-2,vs_+8192,ks_+4096,true); STEP(NT-1,vs_+16384,0,false);
    SBAR(); CHECKP(); SBAR(); VRL(0,vs_+24576);VRH(0,vs_+24576);VRL(1,vs_+24576);VRH(1,vs_+24576);VRL(2,vs_+24576);VRH(2,vs_+24576);VRL(3,vs_+24576);VRH(3,vs_+24576); SBAR(); MF8(0);MF8(1);MF8(2);MF8(3); }
  #undef QUAD
  #undef PK8
  #undef PKALL
  #undef PIN
  #undef MX3
  #undef EX
  #undef VRL
  #undef VRH
  #undef EX8
  #undef SM8
  #undef KRD
  #undef KLD
  #undef QK8
  #undef MF8
  #undef STEP
  #undef CHECKP
  #undef SUMP
  if((lane&15)<2){ const int qb_=(lane&15)*16+4*(lane>>4); _Pragma("unroll") for(int j_=0;j_<4;++j_)wsf[32+qb_+j_]=lacc[j_]; }
  asm volatile("s_waitcnt lgkmcnt(0)":::"memory");
  { bf16*Of=O+(long)(q0+wid*QBLK)*opitch;
    #pragma unroll
    for(int r=0;r<16;++r){const int orow=crow(r,hi); const float rl=__builtin_amdgcn_rcpf(wsf[32+orow])*(1.f/PV8_VSCALE);
      #pragma unroll
      for(int d0=0;d0<4;++d0)Of[(long)orow*opitch+d0*32+r32]=__float2bfloat16(o[d0][r]*rl);} }
  asm volatile("s_waitcnt lgkmcnt(0)\n\ts_barrier":::"memory");
  #undef SEND_K
  #undef SEND_V
  #undef CMASK
  #undef RESC
}


constexpr int BRA_NKT=4, BRA_GRP_BYTES=2*BRA_NKT*8192;
__device__ __forceinline__ void grp_bar(__attribute__((address_space(3))) unsigned* gb,int lane){
  asm volatile("s_waitcnt vmcnt(0) lgkmcnt(0)":::"memory");
  if(lane==0){
    const unsigned g0=__hip_atomic_load(gb+1,__ATOMIC_RELAXED,__HIP_MEMORY_SCOPE_WORKGROUP);
    const unsigned old=__hip_atomic_fetch_add(gb,1u,__ATOMIC_ACQ_REL,__HIP_MEMORY_SCOPE_WORKGROUP);
    if(old==3u){ __hip_atomic_store(gb,0u,__ATOMIC_RELAXED,__HIP_MEMORY_SCOPE_WORKGROUP); __hip_atomic_store(gb+1,g0+1u,__ATOMIC_RELEASE,__HIP_MEMORY_SCOPE_WORKGROUP); }
    else { unsigned sp=0; while(__hip_atomic_load(gb+1,__ATOMIC_ACQUIRE,__HIP_MEMORY_SCOPE_WORKGROUP)==g0){ __builtin_amdgcn_s_sleep(1); if(++sp>(1u<<24))break; } } }
  asm volatile("s_waitcnt lgkmcnt(0)":::"memory");
}
__device__ __forceinline__ void grp_bar_nv(__attribute__((address_space(3))) unsigned* gb,int lane){
  asm volatile("s_waitcnt lgkmcnt(0)":::"memory");
  if(lane==0){
    const unsigned g0=__hip_atomic_load(gb+1,__ATOMIC_RELAXED,__HIP_MEMORY_SCOPE_WORKGROUP);
    const unsigned old=__hip_atomic_fetch_add(gb,1u,__ATOMIC_ACQ_REL,__HIP_MEMORY_SCOPE_WORKGROUP);
    if(old==3u){ __hip_atomic_store(gb,0u,__ATOMIC_RELAXED,__HIP_MEMORY_SCOPE_WORKGROUP); __hip_atomic_store(gb+1,g0+1u,__ATOMIC_RELEASE,__HIP_MEMORY_SCOPE_WORKGROUP); }
    else { unsigned sp=0; while(__hip_atomic_load(gb+1,__ATOMIC_ACQUIRE,__HIP_MEMORY_SCOPE_WORKGROUP)==g0){ __builtin_amdgcn_s_sleep(1); if(++sp>(1u<<24))break; } } }
  asm volatile("s_waitcnt lgkmcnt(0)":::"memory");
}
struct BraUnit {
  const bf16* Q; const bf16* K; const bf16* V;
  bf16* PO; float* PL;
  int kbase, kstride, t_first, nkt;
  int nqt;
  int qbase, qstride, slotA;
  const int* list; int nlist, tile0, ownrow0;
};
#define BMX3(a,b,c) __builtin_fmaxf(__builtin_fmaxf((a),(b)),(c))
template<int MODE,int ABL=0> __device__ __forceinline__ void bra_unit(const BraUnit&u,char*shm  ,float*wsf  ,char*ost  ,__attribute__((address_space(3))) unsigned*gb,const int wg  ,__attribute__((address_space(3))) int*gqn  ,const int unext  ){
  int lane; asm volatile("v_mbcnt_lo_u32_b32 %0, -1, 0\n\tv_mbcnt_hi_u32_b32 %0, -1, %0":"=v"(lane)); const int r32=lane&31,hi=lane>>5;
  const unsigned lds0=(unsigned)(uintptr_t)shm;
  constexpr int BRA_K=0, BRA_V=BRA_NKT*8192;
  if(!(ABL&4)) for(int T=u.t_first;T<u.nkt;++T){
    #pragma unroll
    for(int pi=0;pi<2;++pi){ const int p=wg+4*pi;
      const long krow=u.kbase+(long)u.kstride*(64*T+8*p+(lane>>3)), vrow=u.kbase+(long)u.kstride*(64*T+16*(p&3)+(lane>>2));
      glds16(u.K+krow*DM+(((lane&7)^((4*p+(lane>>4))&7))*8),(unsigned)__builtin_amdgcn_readfirstlane(lds0+BRA_K+T*8192+p*1024));
      glds16(u.V+vrow*DM+(p>>2)*32+(lane&3)*8,(unsigned)__builtin_amdgcn_readfirstlane(lds0+BRA_V+T*8192+p*1024)); } }
  int qrow_[2],ql_[2],Tlo_[2],Thi_[2],slot_[2]; bool valid_[2],masked_[2],have_[2]; bf16x8 qr_[2][4];
  #pragma unroll
  for(int i=0;i<2;++i){ const int qt=wg+4*i; have_[i]=qt<u.nqt; valid_[i]=have_[i]; masked_[i]=true; qrow_[i]=0; ql_[i]=0; Tlo_[i]=0; Thi_[i]=-1; slot_[i]=0;
    if(have_[i]){
      if(MODE==0){ ql_[i]=32*qt+r32; qrow_[i]=u.qbase+u.qstride*ql_[i]; Tlo_[i]=(qt>>1)>u.t_first?(qt>>1):u.t_first; Thi_[i]=(qt>>1)+2; slot_[i]=u.slotA; }
      else { const int g=u.tile0+qt;
        if(g<8){ ql_[i]=32*g+r32; qrow_[i]=u.ownrow0+ql_[i]; Tlo_[i]=0; Thi_[i]=g>>1; slot_[i]=3; }
        else { const int e=(g-8)*32+r32; valid_[i]=e<u.nlist; const int ent=valid_[i]?u.list[e]:0; qrow_[i]=ent&0xffff; slot_[i]=ent>>16; Tlo_[i]=0; Thi_[i]=3; masked_[i]=false; } }
      #pragma unroll
      for(int d0=0;d0<4;++d0){ if(!(ABL&8)) qr_[i][d0]=*reinterpret_cast<const bf16x8*>(&u.Q[(long)qrow_[i]*DM+d0*16+hi*8]); else qr_[i][d0]=bf16x8{}; } } }
  grp_bar(gb,lane);
  if(wg==0&&lane==0)*gqn=unext;
  int*wsi=(int*)wsf+64;
  const int kaddr=r32*128+((hi^((r32>>1)&7))<<4);
  const int vbl=(int)(lds0+BRA_V)+((lane>>4)&1)*32+(lane&3)*8+(4*hi+((lane&15)>>2))*64;
  const unsigned dmax=(MODE==0)?128u:0x7fffffffu;
  #pragma unroll
  for(int i=0;i<2;++i){ if(!have_[i])continue;
    const int qrow=qrow_[i],ql=ql_[i],Tlo=Tlo_[i],Thi=Thi_[i],slot=slot_[i]; const bool valid=valid_[i],masked=masked_[i];
    bf16x8 qr[4];
    #pragma unroll
    for(int d0=0;d0<4;++d0)qr[d0]=qr_[i][d0];
    float mhat=0.f,l_reg=0.f; f32x16 o[2]; o[0]=f32x16{}; o[1]=f32x16{}; float zz_=0.f; asm volatile("":"+v"(zz_)); f32x16 negm;
    _Pragma("unroll") for(int r=0;r<16;++r)negm[r]=zz_;
    if(!(ABL&2)) for(int T=Tlo;T<=Thi;++T){
      f32x16 p0,p1; qkt_rm(p0,p1,shm+BRA_K+T*8192,kaddr,qr,negm);
      if(masked){ const int db=ql-64*T-4*hi+((MODE==0)?128:0);
        #pragma unroll
        for(int r=0;r<16;++r){ const int d=db-((r&3)+8*(r>>2)); if((unsigned)d>dmax)p0[r]=-INFINITY; if((unsigned)(d-32)>dmax)p1[r]=-INFINITY; } }
      float a=BMX3(p0[0],p0[1],p1[0]),b=BMX3(p0[2],p0[3],p1[1]); a=BMX3(a,p1[2],p1[3]);
      #pragma unroll
      for(int r=4;r<16;r+=4){a=BMX3(a,p0[r],p0[r+1]);b=BMX3(b,p0[r+2],p0[r+3]);a=BMX3(a,p1[r],p1[r+1]);b=BMX3(b,p1[r+2],p1[r+3]);}
      float rm=__builtin_fmaxf(a,b); { auto rr=__builtin_amdgcn_permlane32_swap(__float_as_uint(rm),__float_as_uint(rm),false,false); rm=__builtin_fmaxf(__uint_as_float(rr[0]),__uint_as_float(rr[1])); }
      if(__any(rm>8.f)){ const float dl=(rm>8.f)?rm:0.f; mhat+=dl;
        #pragma unroll
        for(int r=0;r<16;++r){p0[r]-=dl;p1[r]-=dl;}
        #pragma unroll
        for(int r=0;r<16;++r)negm[r]=-mhat;
        const float f=__builtin_amdgcn_exp2f(-dl); l_reg*=f; if(hi==0)wsf[r32]=f;
        asm volatile("s_waitcnt lgkmcnt(0)":::"memory");
        #pragma unroll
        for(int d_=0;d_<2;++d_)
          #pragma unroll
          for(int r=0;r<16;++r)o[d_][r]*=wsf[crow(r,hi)];
        asm volatile("s_waitcnt lgkmcnt(0)":::"memory"); }
      float sacc=0.f;
      #pragma unroll
      for(int r=0;r<16;++r){p0[r]=__builtin_amdgcn_exp2f(p0[r]);p1[r]=__builtin_amdgcn_exp2f(p1[r]);sacc+=p0[r]+p1[r];}
      l_reg+=sacc;
      u32x4 pw0,pw1,pw2,pw3;
      pw0=(u32x4){cvtpk_s(p0[0],p0[1]),cvtpk_s(p0[2],p0[3]),cvtpk_s(p0[4],p0[5]),cvtpk_s(p0[6],p0[7])}; pw1=(u32x4){cvtpk_s(p0[8],p0[9]),cvtpk_s(p0[10],p0[11]),cvtpk_s(p0[12],p0[13]),cvtpk_s(p0[14],p0[15])};
      pw2=(u32x4){cvtpk_s(p1[0],p1[1]),cvtpk_s(p1[2],p1[3]),cvtpk_s(p1[4],p1[5]),cvtpk_s(p1[6],p1[7])}; pw3=(u32x4){cvtpk_s(p1[8],p1[9]),cvtpk_s(p1[10],p1[11]),cvtpk_s(p1[12],p1[13]),cvtpk_s(p1[14],p1[15])};
      SBAR(); pv(o,vbl+T*8192,__builtin_bit_cast(bf16x8,pw0),__builtin_bit_cast(bf16x8,pw1),__builtin_bit_cast(bf16x8,pw2),__builtin_bit_cast(bf16x8,pw3));
    }
    {auto rr=__builtin_amdgcn_permlane32_swap(__float_as_uint(l_reg),__float_as_uint(l_reg),false,false);l_reg=__uint_as_float(rr[0])+__uint_as_float(rr[1]);}
    if(hi==0){ wsf[r32]=l_reg; wsi[r32]=valid?(slot*SEQ+qrow):-1; }
    asm volatile("s_waitcnt lgkmcnt(0)":::"memory");
    if(!(ABL&1)) if(hi==0&&valid) u.PL[(long)(slot*SEQ+qrow)*8]=mhat+__builtin_amdgcn_logf(l_reg);
    if(!(ABL&1)) { float rl_[16];
      #pragma unroll
      for(int r=0;r<16;++r)rl_[r]=__builtin_amdgcn_rcpf(wsf[crow(r,hi)]);
      typedef __attribute__((address_space(3))) unsigned short* lds_u16p; typedef unsigned u32x4s __attribute__((ext_vector_type(4)));
      const lds_u16p wp=(lds_u16p)(uintptr_t)(unsigned)(uintptr_t)ost + r32; const int rrow=lane>>2, rch=lane&3;
      #pragma unroll
      for(int d_=0;d_<2;++d_){
        #pragma unroll
        for(int r=0;r<16;++r)wp[crow(r,hi)*32]=(unsigned short)(cvtpk_s(o[d_][r]*rl_[r],0.f)&0xffffu);
        asm volatile("s_waitcnt lgkmcnt(0)":::"memory");
        #pragma unroll
        for(int p=0;p<2;++p){ const int row=16*p+rrow; const u32x4s w=*(const __attribute__((address_space(3))) u32x4s*)((lds_cptr)ost+row*64+rch*16); const int dst=wsi[row];
          if(dst>=0) *(__attribute__((address_space(1))) u32x4s*)(u.PO+(long)dst*512+d_*32+rch*8)=w; }
        asm volatile("s_waitcnt lgkmcnt(0)":::"memory"); } }
  }
}
#undef BMX3
#undef SBAR
#undef WAIT_BAR
}


constexpr int NWAVES = 8;
#ifndef MK_N_LAUNCHES
#define MK_N_LAUNCHES 1
#endif
constexpr int N_PHASES = 24;
static_assert(MK_N_LAUNCHES == 1 || MK_N_LAUNCHES == N_PHASES, "MK_N_LAUNCHES is 1 or 24");

constexpr int S_ = 16384, DM_ = 2048, INW = 6144, NEXP = 16, DEXP = 1024, DEPTH = 2, NROWBLK = 256  ;
constexpr int C_QA = 0, C_KA = 512, C_VA = 1024, C_QB = 1536, C_KB = 2048, C_VB = 2560, C_QC = 3072, C_KC = 4096, C_VC = 5120;
constexpr int MAXPOS = 2 * S_ + NEXP * 256;
constexpr float RMS_EPS = 1e-6f;
#ifndef ATT_PV8
#define ATT_PV8 1
#endif
constexpr float VT8_SCALE = 16.f;
#ifndef ATT_QK8
#define ATT_QK8 1
#endif
#ifndef ATT_R8
#define ATT_R8 1
#endif
#ifndef ABLV
#define ABLV 0
#endif
#ifndef ATT_SUMMFMA
#define ATT_SUMMFMA 0
#endif
#ifndef SEL_PASSES
#define SEL_PASSES 1
#endif
#ifndef WC_INLOOP
#define WC_INLOOP 1
#endif
#ifndef GEMM_SP2
#define GEMM_SP2 true
#endif
#ifndef PROJ_FP8
#define PROJ_FP8 1
#endif
#ifndef OUT_FP8
#define OUT_FP8 3
#endif

constexpr size_t MiB = 1u << 20;
constexpr size_t WS_CTL = 0, CTL_ZERO_BYTES = 1 * MiB;
constexpr size_t WS_MOD = 1 * MiB;
constexpr size_t WS_COS = 2 * MiB, WS_SIN = 4 * MiB;
constexpr size_t WS_EID = 6 * MiB;
constexpr size_t WS_WTS = WS_EID + 131072;
constexpr size_t WS_ROWTOK = WS_WTS + 131072;
constexpr size_t WS_ROWW = WS_ROWTOK + 163840;
constexpr size_t WS_CNT = WS_ROWW + 163840;
constexpr size_t WS_KMEAN = 8 * MiB;
constexpr size_t WS_WIN = 16 * MiB;
constexpr size_t WS_WOUT = 64 * MiB;
constexpr size_t WS_WGU = 80 * MiB;
constexpr size_t WS_WDN = 336 * MiB;
constexpr size_t WS_H = 464 * MiB;
constexpr size_t WS_PROJ = 528 * MiB;
constexpr size_t WS_MERGED = 720 * MiB;
constexpr size_t WS_T = 784 * MiB;
constexpr size_t WS_VT8 = 848 * MiB;
constexpr size_t WS_K8 = 864 * MiB;
constexpr size_t WS_ACT = 912 * MiB;
constexpr size_t WS_XS = 984 * MiB;
constexpr size_t WS_POA = WS_ACT;
constexpr size_t WS_POB = WS_POA + 48 * MiB;
constexpr size_t WS_PLA = WS_POB + 64 * MiB;
constexpr size_t WS_PLB = WS_PLA + 2 * MiB;
constexpr size_t WS_LIST = WS_PLB + 2 * MiB;
static_assert(WS_LIST + 32 * MiB <= 1128 * MiB, "partials and lists inside the MoE-only regions");
constexpr size_t WS_Y = WS_PROJ;
constexpr size_t WS_XB = 1128 * MiB;
constexpr size_t WS_END = 1192 * MiB;
static_assert(WS_WIN == wconv::D_WIN && WS_WOUT == wconv::D_WOUT && WS_WGU == wconv::D_WGU && WS_WDN == wconv::D_WDN, "wconv destinations");
static_assert(WS_XS + (size_t)MAXPOS * 2048 * 2 <= WS_END && WS_ACT + (size_t)MAXPOS * 1024 * 2 <= WS_XS && WS_CNT + 16384 <= WS_KMEAN, "d_ws map");
constexpr int CW_TMO = 0, CW_CODE = 1, CW_BAR = 4096;
constexpr int CW_CNTB = 65536, CNTB_PITCH = 32;
constexpr int CW_SELDONE = 8192 + 2048;
constexpr int CW_QUEUE = 8192 + 1024;

constexpr int RING_OFF = 0, RING_BYTES = 131072;
constexpr int LDSCTL_OFF = RING_BYTES, MISC_OFF = LDSCTL_OFF + 320;
constexpr int LT_SEGS = LDSCTL_OFF + 1024;
constexpr int LT_TOT = LT_SEGS + 128;
constexpr int LT_BASE = LT_TOT + 64;
constexpr int LT_CNT = LT_BASE + 64;
constexpr int LT_P2E = LT_CNT + 64;
constexpr int LT_POS = LT_P2E + 160;
constexpr int LDS_BYTES = 163840;
constexpr int ATT_OST_OFF = 147456;
constexpr int ATT_KM_OFF = 0;
constexpr int ATT_WSF_OFF = LDSCTL_OFF + 4096;
constexpr int ATT_UST_OFF = LDSCTL_OFF + 8192, ATT_QN_OFF = ATT_UST_OFF + 2304, ATT_GB_OFF = ATT_QN_OFF + 128;
static_assert(attn_body::R_LDS_BYTES + 32768 <= RING_BYTES, "attention unit key-tile groups + weight-copy stage");
static_assert(LT_POS + 512 <= LDSCTL_OFF + 4096 && attn_body::ATTN_LDS_BYTES <= RING_BYTES && attn_body::X_LDS_BYTES <= RING_BYTES && 2 * attn_body::BRA_GRP_BYTES <= RING_BYTES && ATT_GB_OFF + 64 <= LDS_BYTES, "LDS map");

#define GAS __attribute__((address_space(1)))
#define LAS __attribute__((address_space(3)))
typedef unsigned short bf16;
typedef unsigned v4u __attribute__((ext_vector_type(4)));
typedef unsigned v2u __attribute__((ext_vector_type(2)));
typedef float f32x4 __attribute__((ext_vector_type(4)));
typedef short bf16x8 __attribute__((ext_vector_type(8)));
typedef GAS unsigned gu32;
#define RLX_AGENT __ATOMIC_RELAXED, __HIP_MEMORY_SCOPE_AGENT
#define LDS_WAIT() asm volatile("s_waitcnt lgkmcnt(0)" ::: "memory")
__device__ __forceinline__ unsigned f2bf(float f) { unsigned u = __builtin_bit_cast(unsigned, f); return (u + 0x7fffu + ((u >> 16) & 1u)) >> 16; }
__device__ __forceinline__ unsigned pk2(float lo, float hi) { return f2bf(lo) | (f2bf(hi) << 16); }
__device__ __forceinline__ float bflo(unsigned w) { return __builtin_bit_cast(float, w << 16); }
__device__ __forceinline__ float bfhi(unsigned w) { return __builtin_bit_cast(float, w & 0xffff0000u); }
#ifndef USE_NT
#define USE_NT 1
#endif
#if USE_NT
#define NTL(p) __builtin_nontemporal_load(p)
#define NTS(v, p) __builtin_nontemporal_store((v), (p))
#else
#define NTL(p) (*(p))
#define NTS(v, p) (*(p) = (v))
#endif
__device__ __forceinline__ float shx(float v, int o, int lane) { return __builtin_bit_cast(float, __builtin_amdgcn_ds_bpermute((lane ^ o) << 2, __builtin_bit_cast(int, v))); }
__device__ __forceinline__ int shup_i(int v, int o, int lane) { return __builtin_amdgcn_ds_bpermute(((lane - o) & 63) << 2, v); }
__device__ __forceinline__ float wave_sum(float v, int lane) {
#pragma unroll
    for (int o = 1; o < 64; o <<= 1) v += shx(v, o, lane);
    return v;
}

#define XB_TMO      128
#define XB_XCNT(j)  (256  + 64 * (j))
#define XB_XSUB(j)  (1280 + 64 * (j))
#define XB_XGEN(j)  (2304 + 64 * (j))
#define XB_TOP      3328
#define XB_TOPGEN   3392
#define XCD_BAR_WORDS 3456
#define XB_SPIN_CAP (1u << 18)

__device__ __forceinline__ unsigned xb_ld(unsigned* p)              { return __hip_atomic_load(p, __ATOMIC_RELAXED, __HIP_MEMORY_SCOPE_AGENT); }
__device__ __forceinline__ unsigned xb_add(unsigned* p, unsigned v) { return __hip_atomic_fetch_add(p, v, __ATOMIC_RELAXED, __HIP_MEMORY_SCOPE_AGENT); }
__device__ __forceinline__ unsigned xb_xcc_id() { return (unsigned)__builtin_amdgcn_s_getreg((3 << 11) | 20) & 0xFu; }
#define XB_SPIN(cond, bar) do { unsigned _sp = 0; while (cond) { __builtin_amdgcn_s_sleep(1); \
    if ((++_sp & 255u) == 0u) { if (xb_ld(&(bar)[XB_TMO])) break; if (_sp > XB_SPIN_CAP) { atomicAdd(&(bar)[XB_TMO], 1u); break; } } } } while (0)

struct XcdBarrier {
    unsigned* bar; unsigned x;
    volatile LAS unsigned* st;
};

__device__ __forceinline__ XcdBarrier xcd_barrier_post(unsigned* bar, volatile LAS unsigned* st) {
    XcdBarrier b; b.bar = bar; b.x = xb_xcc_id(); b.st = st;
    if (threadIdx.x == 0) (void)xb_add(&bar[XB_XCNT(b.x)], 1u);
    return b;
}
__device__ __forceinline__ void xcd_barrier_complete(unsigned* bar, unsigned x, unsigned& nloc, unsigned& nx) {
    const unsigned G = gridDim.x * gridDim.y * gridDim.z;
    unsigned sum, cnt, mine, sp = 0u;
    for (;;) {
        sum = 0u; cnt = 0u; mine = 0u;
#pragma unroll
        for (unsigned j = 0; j < 16; ++j) { const unsigned c = xb_ld(&bar[XB_XCNT(j)]); sum += c; cnt += (c > 0u) ? 1u : 0u; mine = (j == x) ? c : mine; }
        if (sum == G) break;
        __builtin_amdgcn_s_sleep(1);
        if ((++sp & 255u) == 0u) { if (xb_ld(&bar[XB_TMO])) break; if (sp > XB_SPIN_CAP) { atomicAdd(&bar[XB_TMO], 1u); break; } }
    }
    nloc = mine > 0u ? mine : 1u; nx = cnt > 0u ? cnt : 1u;
}

__device__ __forceinline__ void xcd_barrier(const XcdBarrier& b) {
    asm volatile("s_waitcnt vmcnt(0)" ::: "memory");
    __syncthreads();
    if (threadIdx.x == 0) {
        unsigned* bar = b.bar; asm volatile("" : "+s"(bar)); unsigned bx_ = b.x; asm volatile("" : "+s"(bx_));
        __builtin_amdgcn_s_waitcnt(0);
        unsigned nloc = b.st[0], nx = b.st[1];
        if (nloc == 0u) { xcd_barrier_complete(bar, bx_, nloc, nx); b.st[0] = nloc; b.st[1] = nx; }
        const unsigned old = xb_add(&bar[XB_XSUB(bx_)], 1u);
        const unsigned gen = old / nloc;
        if (old + 1u == (gen + 1u) * nloc) {
            __builtin_amdgcn_fence(__ATOMIC_RELEASE, "agent");
            asm volatile("s_waitcnt vmcnt(0)" ::: "memory");
            const unsigned og = xb_add(&bar[XB_TOP], 1u);
            const unsigned tg = og / nx;
            if (og + 1u == (tg + 1u) * nx) xb_add(&bar[XB_TOPGEN], 1u);
            else XB_SPIN(xb_ld(&bar[XB_TOPGEN]) == tg, bar);
            __builtin_amdgcn_fence(__ATOMIC_ACQUIRE, "agent");
            xb_add(&bar[XB_XGEN(bx_)], 1u);
            asm volatile("s_waitcnt vmcnt(0)" ::: "memory");
        } else {
            XB_SPIN(xb_ld(&bar[XB_XGEN(bx_)]) == gen, bar);
            __builtin_amdgcn_fence(__ATOMIC_ACQUIRE, "agent");
            asm volatile("s_waitcnt vmcnt(0)" ::: "memory");
        }
    }
    __syncthreads();
}


struct TItem { const float* W; unsigned char* WT; int K, N, map, item, b16; float wsc; };
__device__ __forceinline__ void titem_load(const TItem& t, float (&tv)[32], int lane) {
    const int nblk = t.N / 32, kb = t.item / nblk, nb = t.item % nblk, k0 = 64 * kb, n0 = 32 * nb;
#pragma unroll
    for (int i = 0; i < 32; ++i) tv[i] = t.W[(size_t)(k0 + 2 * i + (lane >> 5)) * t.N + n0 + (lane & 31)];
}
__device__ __forceinline__ void titem_finish(const TItem& t, const float (&tv)[32], LAS float* scr, int lane) {
    const int nblk = t.N / 32, kb = t.item / nblk, nb = t.item % nblk, k0 = 64 * kb, n0 = 32 * nb;
#pragma unroll
    for (int i = 0; i < 32; ++i) scr[(2 * i + (lane >> 5)) * 33 + (lane & 31)] = tv[i] * t.wsc;
    LDS_WAIT(); asm volatile("" ::: "memory");
    if (t.b16) { const int c = lane & 7;
#pragma unroll
        for (int j = 0; j < 4; ++j) { const int n = (lane >> 3) + 8 * j; const LAS float* sp = scr + (8 * c) * 33 + n;
            v4u o; o.x = pk2(sp[0 * 33], sp[1 * 33]); o.y = pk2(sp[2 * 33], sp[3 * 33]); o.z = pk2(sp[4 * 33], sp[5 * 33]); o.w = pk2(sp[6 * 33], sp[7 * 33]);
            *(GAS v4u*)((bf16*)t.WT + (size_t)dest_row(t.map, n0 + n) * t.K + k0 + 8 * c) = o; }
    } else { const int c = lane & 3;
#pragma unroll
        for (int j = 0; j < 2; ++j) { const int n = (lane >> 2) + 16 * j; const LAS float* sp = scr + (16 * c) * 33 + n;
            v4u o; o.x = pg8::pk4_fp8(sp[0 * 33], sp[1 * 33], sp[2 * 33], sp[3 * 33]); o.y = pg8::pk4_fp8(sp[4 * 33], sp[5 * 33], sp[6 * 33], sp[7 * 33]);
            o.z = pg8::pk4_fp8(sp[8 * 33], sp[9 * 33], sp[10 * 33], sp[11 * 33]); o.w = pg8::pk4_fp8(sp[12 * 33], sp[13 * 33], sp[14 * 33], sp[15 * 33]);
            *(GAS v4u*)(t.WT + (size_t)dest_row(t.map, n0 + n) * t.K + k0 + 16 * c) = o; } }
    LDS_WAIT(); asm volatile("" ::: "memory");
}

struct Args { const void* in[20]; float* out; unsigned char* ws; int ph_lo, ph_hi; };

__global__ void __launch_bounds__(NWAVES * 64, 2) fwd(Args args) {
    extern __shared__ __attribute__((aligned(16))) unsigned char lds[];
    LAS unsigned char* const L = (LAS unsigned char*)lds;
    const int kG = gridDim.x, kbx = blockIdx.x;
    const int kwave = __builtin_amdgcn_readfirstlane((int)threadIdx.x >> 6);
    typedef __attribute__((address_space(4))) const Args* kargp_t;
#define PHASE_BEGIN() \
    kargp_t ka = (kargp_t)__builtin_amdgcn_kernarg_segment_ptr(); asm volatile("" : "+s"(ka)); \
    unsigned char* const ws = ka->ws; \
    int lane; asm volatile("v_mbcnt_lo_u32_b32 %0, -1, 0\n\tv_mbcnt_hi_u32_b32 %0, -1, %0" : "=v"(lane)); \
    int G = kG, bx = kbx, wave_s = kwave; asm volatile("" : "+s"(G), "+s"(bx), "+s"(wave_s));     \
    const int vcu = (G % 8 == 0) ? (bx % 8) * (G / 8) + bx / 8 : bx; const int NGW = G * NWAVES; \
    const int wave = wave_s; const int tid = wave * 64 + lane; const int gw = vcu * NWAVES + wave; (void)gw; (void)lane; (void)ws; (void)tid; (void)NGW
#define KIN(T, k) ((const T*)ka->in[k])
    LAS int* const segs = (LAS int*)(L + LT_SEGS); LAS int* const tot = (LAS int*)(L + LT_TOT); LAS int* const basee = (LAS int*)(L + LT_BASE); LAS int* const cnt16 = (LAS int*)(L + LT_CNT);
    LAS unsigned char* const p2e = L + LT_P2E; LAS int* const postab = (LAS int*)(L + LT_POS);
    gu32* const ctl = (gu32*)(args.ws + WS_CTL);

    for (int u = threadIdx.x; u < (LDS_BYTES - LDSCTL_OFF) / 4; u += NWAVES * 64) ((LAS unsigned*)(L + LDSCTL_OFF))[u] = 0u;
    __syncthreads();
    const int lo = args.ph_lo, hi = args.ph_hi;
    XcdBarrier bar; bar.bar = (unsigned*)(ctl + CW_BAR); bar.x = 0; bar.st = nullptr;
    if (hi - lo > 1) bar = xcd_barrier_post((unsigned*)(ctl + CW_BAR), (volatile LAS unsigned*)(L + MISC_OFF) + 8);
#ifndef PHMASK
#define PHMASK 0x1fff
#endif
#define IN(k) (lo <= (k) && (k) < hi)
#define INJ(j) ((((PHMASK) >> (j)) & 1) && IN(pb + (j)))
#ifndef REPEAT_J
#define REPEAT_J (-1)
#endif
#ifndef REPEAT_L
#define REPEAT_L 0
#endif
#ifndef REPEAT_N
#define REPEAT_N 2
#endif
#define REPS(j) ((REPEAT_J == (j) && l == REPEAT_L) ? REPEAT_N : 1)
#if defined(STAMP_A)
    LAS unsigned long long* const stamps = (LAS unsigned long long*)(L + LDSCTL_OFF + 2048); int n_stamp = 0;
#define STAMP() do { if (kbx == 0 && threadIdx.x == 0) stamps[n_stamp] = __builtin_amdgcn_s_memrealtime(); ++n_stamp; } while (0)
    STAMP();
#else
#define STAMP() do { } while (0)
#endif
#define SEAM(k) do { if (IN(k) && IN((k) + 1)) { xcd_barrier(bar); STAMP(); } } while (0)

#define COMPUTE_SEGMENTS(myrb) do { \
        _Pragma("unroll") for (int q_ = 0; q_ < 2; ++q_) { const int e_ = 2 * wave + q_; int t_ = 0, p_ = 0; \
            _Pragma("unroll") for (int j_ = 0; j_ < 4; ++j_) { const int rb_ = lane + 64 * j_; const int c_ = CNT[rb_ * 16 + e_]; t_ += c_; p_ += (rb_ < (myrb)) ? c_ : 0; } \
            t_ = (int)wave_sum((float)t_, lane); p_ = (int)wave_sum((float)p_, lane); if (lane == 0) { tot[e_] = t_; basee[e_] = p_; } } \
        __syncthreads(); \
        if (tid == 0) { int s_ = 0; for (int e_ = 0; e_ < 16; ++e_) { segs[e_] = s_; s_ += (tot[e_] + 255) & ~255; } segs[16] = s_; } \
        __syncthreads(); \
        if (tid < 160) { const int r_ = tid * 256; int e_ = 0; for (int k_ = 1; k_ < 16; ++k_) if (r_ >= segs[k_]) e_ = k_; p2e[tid] = (unsigned char)e_; } \
        if (tid < 16) basee[tid] += segs[tid]; \
        __syncthreads(); } while (0)

    if (((PHMASK >> 11) & 1) && IN(0)) for (int rp = 0; rp < ((REPEAT_J == 11) ? REPEAT_N : 1); ++rp) {
        PHASE_BEGIN();
        const float* const c_in = KIN(float, 1); const int* const positions = KIN(int, 2); const float* const w_ada = KIN(float, 3); const float* const b_ada = KIN(float, 4);
        const float* const w_in = KIN(float, 7); const float* const w_out = KIN(float, 8); const float* const w_gate = KIN(float, 14); const float* const w_up = KIN(float, 15); const float* const w_down = KIN(float, 16);
        float* const MOD = (float*)(ws + WS_MOD); float* const COS = (float*)(ws + WS_COS); float* const SIN = (float*)(ws + WS_SIN);
        unsigned char* const WIN = ws + WS_WIN; unsigned char* const WOUT = ws + WS_WOUT; unsigned char* const WGU = ws + WS_WGU; unsigned char* const WDN = ws + WS_WDN;
        for (int it = bx; it < 192; it += G) {
            const int l = it / 96, cg = it % 96, col = cg * 128 + lane * 2;
            const float* W = w_ada + ((size_t)l * 2048 + wave * 256) * 12288 + col; const float* cc = c_in + wave * 256;
            typedef float f32x2 __attribute__((ext_vector_type(2)));
            f32x2 a = (f32x2){0.f, 0.f};
#pragma unroll 32
            for (int k = 0; k < 256; ++k) { const float cv = cc[k]; const float sv = cv / (1.f + expf(-cv)); a += sv * *(const GAS f32x2*)(W + (size_t)k * 12288); }
            LAS f32x2* red = (LAS f32x2*)L; red[wave * 64 + lane] = a;
            __syncthreads();
            if (tid < 128) { float s = 0.f; const LAS float* rf = (const LAS float*)L;
#pragma unroll
                for (int w = 0; w < 8; ++w) s += rf[(w * 64 + (tid >> 1)) * 2 + (tid & 1)];
                MOD[l * 12288 + cg * 128 + tid] = s + b_ada[l * 12288 + cg * 128 + tid]; }
            __syncthreads();
        }
        { LAS float* scr = (LAS float*)(L + RING_OFF + wave * 16384);
          constexpr int I_IN = (PROJ_FP8 ? 1 : 2) * 32 * 192, N_OUT16 = 2 - ((OUT_FP8 & 1) + ((OUT_FP8 >> 1) & 1)), I_OUT = N_OUT16 * 32 * 64, NITEMS = I_IN + I_OUT;
#define TDECODE(T, it_) do { int r = (it_); \
              if (r < I_IN) { const int l_ = r / 6144; T.W = w_in + (size_t)l_ * 2048 * 6144; T.K = 2048; T.N = 6144; T.map = 1; T.item = r % 6144; T.b16 = PROJ_FP8 ? 0 : 1; T.wsc = PROJ_FP8 ? WSC_K2048 : 1.f; T.WT = WIN + (size_t)l_ * 6144 * (PROJ_FP8 ? 2048 : 4096); break; } r -= I_IN; \
              { const int l_ = (r / 2048 == 0) ? ((OUT_FP8 & 1) ? 1 : 0) : 1; T.W = w_out + (size_t)l_ * 2048 * 2048; T.K = 2048; T.N = 2048; T.map = 0; T.item = r % 2048; T.b16 = 1; T.wsc = 1.f; T.WT = WOUT + (size_t)l_ * 2048 * 4096; } } while (0)
          gu32* const tq = ctl + CW_QUEUE + 256;
          for (;;) {
              int c0 = 0; if (lane == 0) c0 = (int)__hip_atomic_fetch_add(tq, 1u, RLX_AGENT);
              c0 = __builtin_amdgcn_readfirstlane(c0) * 16; if (c0 >= NITEMS) break;
              const int c1 = (c0 + 16 < NITEMS) ? c0 + 16 : NITEMS;
              TItem cur; TDECODE(cur, c0); float tv[32]; titem_load(cur, tv, lane);
              for (int it = c0; it < c1; ++it) {
                  TItem nxt = cur; float tn[32]; const bool hn = it + 1 < c1;
                  if (hn) { TDECODE(nxt, it + 1); titem_load(nxt, tn, lane); }
                  titem_finish(cur, tv, scr, lane);
                  if (hn) { cur = nxt;
#pragma unroll
                      for (int i = 0; i < 32; ++i) tv[i] = tn[i]; }
              }
          }
#undef TDECODE
        }
        for (int idx = (vcu * NWAVES * 64 + tid); idx < S_ * 32; idx += G * NWAVES * 64) {
            const int pi = idx >> 5, i = idx & 31; const float inv = (float)exp2(-(double)i * (13.287712379549449 / 32.0)); const float ang = (float)positions[pi] * inv;
            COS[idx] = cosf(ang); SIN[idx] = sinf(ang); }
    }
    SEAM(0);

#if defined(EXTRA_BARRIERS)
    if (lo == 0 && hi - lo > 1) for (int xb = 0; xb < EXTRA_BARRIERS; ++xb) xcd_barrier(bar);
#endif
    for (int l = 0; l < DEPTH; ++l) {
        const int pb = 1 + 11 * l;
        const float lam_init = (l == 0) ? 0.2f : 0.35550906759f;
        if (INJ(0)) for (int rp = 0; rp < REPS(0); ++rp) {
            PHASE_BEGIN();
            const float* const x_in = KIN(float, 0); const float* const g_attn = KIN(float, 5); bf16* const xbuf = (bf16*)(ws + WS_XB);
            const float* const MOD = (const float*)(ws + WS_MOD); const float* const mod = MOD + l * 12288; unsigned char* const HB = ws + WS_H; const bf16* const YB = (const bf16*)(ws + WS_Y);
            LAS f32x4* const cAl = (LAS f32x4*)L; LAS f32x4* const cBl = cAl + 512; LAS f32x4* const cGl = cAl + 1024;
            { const int c4 = tid; const f32x4 g = ((const f32x4*)(g_attn + l * 2048))[c4]; const f32x4 sc = ((const f32x4*)(mod + 2048))[c4];
              cAl[c4] = g * (1.f + sc); cBl[c4] = ((const f32x4*)(mod + 0))[c4]; cGl[c4] = (l > 0) ? ((const f32x4*)(MOD + (l - 1) * 12288 + 10240))[c4] : (f32x4){0.f, 0.f, 0.f, 0.f}; }
            __syncthreads();
#define XLOAD(WY_, dst, r_) do { if (WY_) { const v2u xw_ = NTL((const GAS v2u*)(xbuf + (size_t)(r_) * 2048) + (lane + 64 * j)); dst = (f32x4){bflo(xw_.x), bfhi(xw_.x), bflo(xw_.y), bfhi(xw_.y)}; } \
                              else dst = NTL((const GAS f32x4*)(x_in + (size_t)(r_) * 2048) + (lane + 64 * j)); } while (0)
#define NORM_LOOP(WITH_Y) do { \
            f32x4 nv[8]; v2u na[8], nb[8]; \
            _Pragma("unroll") for (int j = 0; j < 8; ++j) { XLOAD(WITH_Y, nv[j], gw); \
                if (WITH_Y) { na[j] = NTL((const GAS v2u*)(YB + (size_t)(2 * gw) * 2048) + (lane + 64 * j)); nb[j] = NTL((const GAS v2u*)(YB + (size_t)(2 * gw + 1) * 2048) + (lane + 64 * j)); } } \
            for (int row = gw; row < S_; row += NGW) { \
                f32x4 v[8]; \
                _Pragma("unroll") for (int j = 0; j < 8; ++j) v[j] = nv[j]; \
                if (WITH_Y) { \
                    _Pragma("unroll") for (int j = 0; j < 8; ++j) { const v2u a = na[j], b = nb[j]; \
                        const f32x4 ys = (f32x4){bflo(a.x) + bflo(b.x), bfhi(a.x) + bfhi(b.x), bflo(a.y) + bflo(b.y), bfhi(a.y) + bfhi(b.y)}; \
                        v[j] += cGl[lane + 64 * j] * ys; v2u xo_; xo_.x = pk2(v[j].x, v[j].y); xo_.y = pk2(v[j].z, v[j].w); ((GAS v2u*)(xbuf + (size_t)row * 2048))[lane + 64 * j] = xo_; \
                        v[j] = (f32x4){bflo(xo_.x), bfhi(xo_.x), bflo(xo_.y), bfhi(xo_.y)}; } \
                } \
                const int nrow = row + NGW; \
                if (nrow < S_) { \
                    _Pragma("unroll") for (int j = 0; j < 8; ++j) { XLOAD(WITH_Y, nv[j], nrow); \
                        if (WITH_Y) { na[j] = NTL((const GAS v2u*)(YB + (size_t)(2 * nrow) * 2048) + (lane + 64 * j)); nb[j] = NTL((const GAS v2u*)(YB + (size_t)(2 * nrow + 1) * 2048) + (lane + 64 * j)); } } \
                } \
                float ss = 0.f; \
                _Pragma("unroll") for (int j = 0; j < 8; ++j) ss += (v[j].x * v[j].x + v[j].y * v[j].y) + (v[j].z * v[j].z + v[j].w * v[j].w); \
                const float rs = 1.f / sqrtf(wave_sum(ss, lane) * (1.f / 2048.f) + RMS_EPS); \
                _Pragma("unroll") for (int j = 0; j < 8; ++j) { const f32x4 o = v[j] * rs * cAl[lane + 64 * j] + cBl[lane + 64 * j]; \
                    if (PROJ_FP8) ((GAS unsigned*)(HB + (size_t)row * 2048))[lane + 64 * j] = pg8::pk4_fp8(o.x, o.y, o.z, o.w); \
                    else { v2u w; w.x = pk2(o.x, o.y); w.y = pk2(o.z, o.w); ((GAS v2u*)((bf16*)HB + (size_t)row * 2048))[lane + 64 * j] = w; } } \
            } } while (0)
            if (l == 0) NORM_LOOP(false); else NORM_LOOP(true);
#undef NORM_LOOP
#undef XLOAD
        }
        SEAM(pb + 0);
        if (INJ(1)) for (int rp = 0; rp < REPS(1); ++rp) {
            PHASE_BEGIN();
            unsigned char* const HB = ws + WS_H; unsigned char* const WIN = ws + WS_WIN; bf16* const PROJ = (bf16*)(ws + WS_PROJ); const float* const COS = (const float*)(ws + WS_COS); const float* const SIN = (const float*)(ws + WS_SIN);
            constexpr int KBP = PROJ_FP8 ? 2048 : 4096;
            pg8::DenseSched Sd; Sd.init(HB, WIN + (size_t)l * 6144 * KBP, S_, INW, KBP, G, bx);
            pg8::EpiProj E{PROJ, COS, SIN, attn_body::C2, PROJ_FP8 ? 1.f / WSC_K2048 : 1.f};
            pg8::gemm_phase<pg8::EpiProj, pg8::DenseSched, true, GEMM_SP2, PROJ_FP8 != 0>(L + RING_OFF, KBP, Sd, E, wave_s);
        }
        SEAM(pb + 1);
        if (INJ(2)) for (int rp = 0; rp < REPS(2); ++rp) {
            PHASE_BEGIN();
            const bf16* const PROJ = (const bf16*)(ws + WS_PROJ); float* const KMEAN = (float*)(ws + WS_KMEAN);
#if ATT_PV8 && ATT_QK8
            for (int t = gw; t < 4096; t += NGW) { const int st = t >> 8, kt = t & 255, hd2 = st >> 1, mp2 = st & 1, c = lane & 3;
                const bf16* const src = PROJ + (size_t)(64 * kt) * 6144 + C_KC + hd2 * 128 + mp2 * 64 + c * 16;
                unsigned char* const dst = ws + WS_K8 + (size_t)t * 4096;
                v4u ka[4], kb[4];
#pragma unroll
                for (int p = 0; p < 4; ++p) { const int key = 16 * p + (lane >> 2); ka[p] = *(const GAS v4u*)(src + (size_t)key * 6144); kb[p] = *(const GAS v4u*)(src + (size_t)key * 6144 + 8); }
#pragma unroll
                for (int p = 0; p < 4; ++p) { const int key = 16 * p + (lane >> 2); const v4u a = ka[p], b = kb[p];
                    v4u o; o.x = pg8::pk4_fp8(bflo(a.x), bfhi(a.x), bflo(a.y), bfhi(a.y)); o.y = pg8::pk4_fp8(bflo(a.z), bfhi(a.z), bflo(a.w), bfhi(a.w));
                    o.z = pg8::pk4_fp8(bflo(b.x), bfhi(b.x), bflo(b.y), bfhi(b.y)); o.w = pg8::pk4_fp8(bflo(b.z), bfhi(b.z), bflo(b.w), bfhi(b.w));
                    *(GAS v4u*)(dst + key * 64 + ((c ^ ((key >> 2) & 3)) * 16)) = o; }
            }
#endif
#if ATT_PV8
            for (int t = gw; t < 2048; t += NGW) { const int h = t >> 8, kt = t & 255;
                const bf16* const src = PROJ + (size_t)(64 * kt) * 6144 + C_VC + h * 128 + 2 * lane;
                unsigned char* const dst = ws + WS_VT8 + (size_t)t * 8192 + (size_t)(2 * lane) * 64; const int sw = (lane >> 1) & 3;
                unsigned oa[16], ob[16];
#pragma unroll
                for (int g = 0; g < 16; ++g) { unsigned w0, w1, w2, w3;
                    w0 = *(const GAS unsigned*)(src + (size_t)(4 * g + 0) * 6144); w1 = *(const GAS unsigned*)(src + (size_t)(4 * g + 1) * 6144);
                    w2 = *(const GAS unsigned*)(src + (size_t)(4 * g + 2) * 6144); w3 = *(const GAS unsigned*)(src + (size_t)(4 * g + 3) * 6144);
                    const int w = (g & 1) * 8 + ((g >> 3) & 1) * 4 + ((g >> 1) & 3);
                    oa[w] = pg8::pk4_fp8(bflo(w0) * VT8_SCALE, bflo(w1) * VT8_SCALE, bflo(w2) * VT8_SCALE, bflo(w3) * VT8_SCALE);
                    ob[w] = pg8::pk4_fp8(bfhi(w0) * VT8_SCALE, bfhi(w1) * VT8_SCALE, bfhi(w2) * VT8_SCALE, bfhi(w3) * VT8_SCALE); }
#pragma unroll
                for (int c = 0; c < 4; ++c) { *(GAS v4u*)(dst + ((c ^ sw) * 16)) = (v4u){oa[4 * c], oa[4 * c + 1], oa[4 * c + 2], oa[4 * c + 3]};
                    *(GAS v4u*)(dst + 64 + ((c ^ sw) * 16)) = (v4u){ob[4 * c], ob[4 * c + 1], ob[4 * c + 2], ob[4 * c + 3]}; }
            }
#endif
            for (int t = gw; t < 512; t += NGW) { const int h = t >> 6, j = t & 63; const int rg = lane >> 3, ch = lane & 7;
                float a[8];
#pragma unroll
                for (int e = 0; e < 8; ++e) a[e] = 0.f;
                for (int hb = 0; hb < 2; ++hb) { v4u kw[16];
#pragma unroll
                    for (int it = 0; it < 16; ++it) kw[it] = *(const GAS v4u*)(PROJ + (size_t)(256 * j + 8 * (16 * hb + it) + rg) * 6144 + C_KB + 64 * h + 8 * ch);
#pragma unroll
                    for (int it = 0; it < 16; ++it) { const v4u w = kw[it];
                        a[0] += bflo(w.x); a[1] += bfhi(w.x); a[2] += bflo(w.y); a[3] += bfhi(w.y); a[4] += bflo(w.z); a[5] += bfhi(w.z); a[6] += bflo(w.w); a[7] += bfhi(w.w); } }
#pragma unroll
                for (int e = 0; e < 8; ++e) { a[e] += shx(a[e], 8, lane); a[e] += shx(a[e], 16, lane); a[e] += shx(a[e], 32, lane); }
                if (lane < 8) {
#pragma unroll
                    for (int e = 0; e < 8; ++e) KMEAN[(size_t)(h * 64 + j) * 64 + 8 * lane + e] = a[e] * (1.f / 256.f); }
            }
        }
        SEAM(pb + 2);
        if (INJ(4)) for (int rp = 0; rp < REPS(4); ++rp) {
            PHASE_BEGIN();
            const bf16* const PROJ = (const bf16*)(ws + WS_PROJ); bf16* const TB = (bf16*)(ws + WS_T);
            char* const shm = (char*)lds + RING_OFF;
            if (rp == 0) for (int selp = 0; selp < SEL_PASSES; ++selp) {
            const float* const KMEAN = (const float*)(ws + WS_KMEAN); int* const LISTB = (selp == 0) ? (int*)(ws + WS_LIST) : (int*)(ws + (size_t)496 * MiB);
            int* const CNTB = (int*)(ctl + ((selp == 0) ? CW_CNTB : 131072 + 32768 * (selp - 1)) + l * 512 * CNTB_PITCH);
            for (int it = vcu; it < 512; it += G) { const int hd = it & 7, qq = it >> 3, qb = (qq & 1) ? 63 - (qq >> 1) : (qq >> 1);
                if (qb == 0) continue;
                LAS float* km = (LAS float*)(L + ATT_KM_OFF);
                __syncthreads();
                for (int k4 = tid; k4 < qb * 16; k4 += NWAVES * 64) ((LAS f32x4*)km)[k4] = ((const GAS f32x4*)(KMEAN + (size_t)hd * 64 * 64))[k4];
                const int q = tid >> 1, dh = tid & 1; float qf[32];
                { const bf16* qrow = PROJ + (size_t)(qb * 256 + q) * 6144 + C_QB + hd * 64 + dh * 32;
#pragma unroll
                  for (int c8 = 0; c8 < 4; ++c8) { const v4u w = *(const GAS v4u*)(qrow + 8 * c8); qf[8 * c8 + 0] = bflo(w.x); qf[8 * c8 + 1] = bfhi(w.x); qf[8 * c8 + 2] = bflo(w.y); qf[8 * c8 + 3] = bfhi(w.y);
                      qf[8 * c8 + 4] = bflo(w.z); qf[8 * c8 + 5] = bfhi(w.z); qf[8 * c8 + 6] = bflo(w.w); qf[8 * c8 + 7] = bfhi(w.w); } }
                __syncthreads();
                float b0 = -INFINITY, b1 = -INFINITY, b2 = -INFINITY; int i0 = -1, i1 = -1, i2 = -1;
                for (int j = 0; j < qb; ++j) { const LAS f32x4* kr = (const LAS f32x4*)(km + j * 64 + dh * 32); float g = 0.f;
#pragma unroll
                    for (int c4 = 0; c4 < 8; ++c4) { const f32x4 kv = kr[c4]; g = fmaf(qf[4 * c4 + 0], kv.x, g); g = fmaf(qf[4 * c4 + 1], kv.y, g); g = fmaf(qf[4 * c4 + 2], kv.z, g); g = fmaf(qf[4 * c4 + 3], kv.w, g); }
                    g += shx(g, 1, lane);
                    if (g > b0) { b2 = b1; i2 = i1; b1 = b0; i1 = i0; b0 = g; i0 = j; } else if (g > b1) { b2 = b1; i2 = i1; b1 = g; i1 = j; } else if (g > b2) { b2 = g; i2 = j; } }
                { LAS int* const lc = (LAS int*)(L + 16384); LAS int* const lb = lc + 64;
                  if (tid < 64) lc[tid] = 0;
                  __syncthreads();
                  int r0 = 0, r1 = 0, r2 = 0;
                  if (dh == 0) { if (i0 >= 0) r0 = __hip_atomic_fetch_add((int*)(lc + i0), 1, __ATOMIC_RELAXED, __HIP_MEMORY_SCOPE_WORKGROUP);
                                 if (i1 >= 0) r1 = __hip_atomic_fetch_add((int*)(lc + i1), 1, __ATOMIC_RELAXED, __HIP_MEMORY_SCOPE_WORKGROUP);
                                 if (i2 >= 0) r2 = __hip_atomic_fetch_add((int*)(lc + i2), 1, __ATOMIC_RELAXED, __HIP_MEMORY_SCOPE_WORKGROUP); }
                  __syncthreads();
                  if (tid < qb) { const int n = lc[tid]; lb[tid] = (n > 0) ? __hip_atomic_fetch_add(CNTB + (hd * 64 + tid) * CNTB_PITCH, n, RLX_AGENT) : 0; }
                  __syncthreads();
                  if (dh == 0) { const int row = qb * 256 + q;
                      if (i0 >= 0) LISTB[(size_t)(hd * 64 + i0) * 16384 + lb[i0] + r0] = row;
                      if (i1 >= 0) LISTB[(size_t)(hd * 64 + i1) * 16384 + lb[i1] + r1] = row | (1 << 16);
                      if (i2 >= 0) LISTB[(size_t)(hd * 64 + i2) * 16384 + lb[i2] + r2] = row | (2 << 16); } }
            }
            asm volatile("s_waitcnt vmcnt(0)" ::: "memory"); __syncthreads();
            if (selp == 0 && tid == 0) { __builtin_amdgcn_fence(__ATOMIC_RELEASE, "agent"); asm volatile("s_waitcnt vmcnt(0)" ::: "memory"); __hip_atomic_fetch_add(ctl + CW_SELDONE + 64 * l, 1u, RLX_AGENT); }
            }
            wconv::Tab wct; wct.w_in = KIN(float, 7); wct.w_out = KIN(float, 8); wct.w_gate = KIN(float, 14); wct.w_up = KIN(float, 15); wct.w_down = KIN(float, 16); wct.ws = ws; wct.l = l;
            wct.n_out = ((OUT_FP8 >> l) & 1) ? 4096 : 0; wct.total = wct.n_out + 65536 + 32768 + ((l == 0 && PROJ_FP8) ? 12288 : 0);
            wconv::State wcs; wcs.idx = gw; wcs.staged = gw; wcs.ctr = 0; wcs.stride = NGW;
            const unsigned wstage = (unsigned)(uintptr_t)(L + RING_OFF) + 98304u + 4096u * (unsigned)wave_s;
            if (rp == 0) { int ln3; asm volatile("v_mbcnt_lo_u32_b32 %0, -1, 0\n\tv_mbcnt_hi_u32_b32 %0, -1, %0" : "=v"(ln3)); wconv::issue(wct, wcs.idx, wstage, ln3); wcs.idx += wcs.stride; }
#if !defined(NO_ATT_C)
#if defined(REPEAT_SKIP_C)
            if (rp == 0)
#endif
            for (int vc = vcu; vc < 256; vc += G) {
                const int st = vc >> 4, hd = st >> 1, mp = st & 1, s = vc & 15;
                const attn_body::bf16* Qp = (const attn_body::bf16*)PROJ + C_QC + hd * 128 + mp * 64; const attn_body::bf16* Kp = (const attn_body::bf16*)PROJ + C_KC + hd * 128 + mp * 64;
                const attn_body::bf16* Vp = (const attn_body::bf16*)PROJ + C_VC + hd * 128; attn_body::bf16* Op = (attn_body::bf16*)TB + (size_t)mp * S_ * 1024 + hd * 128;
                for (int i = 3; i >= 0; --i) { const int qb = 32 * (i >> 1) + ((i & 1) ? 31 - s : s);
#if ATT_PV8 && ATT_QK8 && ATT_R8 && ATT_SUMMFMA
                    const unsigned char* const K8p = ws + WS_K8 + (size_t)st * 256 * 4096; float* const wsfc = (float*)((char*)lds + ATT_WSF_OFF);
                    if (rp == 0) attn_body::attn_unit128r9<8, WC_INLOOP != 0>(qb, Qp, K8p, ws + WS_VT8 + (size_t)hd * 256 * 8192, Op, 1024, shm, wsfc, wave_s, wct, wcs, wstage);
                    else attn_body::attn_unit128r9<8, false>(qb, Qp, K8p, ws + WS_VT8 + (size_t)hd * 256 * 8192, Op, 1024, shm, wsfc, wave_s, wct, wcs, wstage); }
#elif ATT_PV8 && ATT_QK8 && ATT_R8
                    const unsigned char* const K8p = ws + WS_K8 + (size_t)st * 256 * 4096; float* const wsfc = (float*)((char*)lds + ATT_WSF_OFF);
                    if (rp == 0) attn_body::attn_unit128r8<8, WC_INLOOP != 0>(qb, Qp, K8p, ws + WS_VT8 + (size_t)hd * 256 * 8192, Op, 1024, shm, wsfc, wave_s, wct, wcs, wstage);
                    else attn_body::attn_unit128r8<8, false>(qb, Qp, K8p, ws + WS_VT8 + (size_t)hd * 256 * 8192, Op, 1024, shm, wsfc, wave_s, wct, wcs, wstage); }
#elif ATT_PV8 && ATT_QK8
                    const unsigned char* const K8p = ws + WS_K8 + (size_t)st * 256 * 4096;
                    if (rp == 0) attn_body::attn_unit128q8<8, WC_INLOOP != 0>(qb, Qp, K8p, ws + WS_VT8 + (size_t)hd * 256 * 8192, Op, 1024, shm, wave_s, wct, wcs, wstage);
                    else attn_body::attn_unit128q8<8, false>(qb, Qp, K8p, ws + WS_VT8 + (size_t)hd * 256 * 8192, Op, 1024, shm, wave_s, wct, wcs, wstage); }
#elif ATT_PV8
                    if (rp == 0) attn_body::attn_unit128p8<8, WC_INLOOP != 0>(qb, Qp, Kp, ws + WS_VT8 + (size_t)hd * 256 * 8192, Op, 1024, shm, wave_s, wct, wcs, wstage);
                    else attn_body::attn_unit128p8<8, false>(qb, Qp, Kp, ws + WS_VT8 + (size_t)hd * 256 * 8192, Op, 1024, shm, wave_s, wct, wcs, wstage); }
#else
                    attn_body::attn_unit128<8>(qb, Qp, Kp, Vp, Op, 1024, shm, wave_s); }
#endif
            }
#endif
            if (rp == 0) { int ln3; asm volatile("v_mbcnt_lo_u32_b32 %0, -1, 0\n\tv_mbcnt_hi_u32_b32 %0, -1, %0" : "=v"(ln3));
                asm volatile("s_waitcnt vmcnt(0)" ::: "memory"); wconv::finish(wct, wcs.staged, wstage, ln3);
                while (wcs.idx < wct.total) { asm volatile("s_waitcnt lgkmcnt(0)" ::: "memory"); wconv::issue(wct, wcs.idx, wstage, ln3); asm volatile("s_waitcnt vmcnt(0)" ::: "memory"); wconv::finish(wct, wcs.idx, wstage, ln3); wcs.idx += wcs.stride; }
                asm volatile("s_waitcnt vmcnt(0) lgkmcnt(0)" ::: "memory"); }
            { int ln2; asm volatile("v_mbcnt_lo_u32_b32 %0, -1, 0\n\tv_mbcnt_hi_u32_b32 %0, -1, %0" : "=v"(ln2)); const int t2 = wave_s * 64 + ln2;
              LAS int* const ust = (LAS int*)(L + ATT_UST_OFF); LAS int* const wtot = ust + 520; LAS int* const qn = (LAS int*)(L + ATT_QN_OFF);
              const int* const CNTB = (const int*)(ctl + CW_CNTB + l * 512 * CNTB_PITCH);
              if (t2 == 0) { unsigned sp_ = 0; while (__hip_atomic_load(ctl + CW_SELDONE + 64 * l, RLX_AGENT) < (unsigned)G) { __builtin_amdgcn_s_sleep(2); if (++sp_ > (1u << 22)) break; }
                  __builtin_amdgcn_fence(__ATOMIC_ACQUIRE, "agent"); asm volatile("s_waitcnt vmcnt(0)" ::: "memory"); }
              if (t2 < 4) ((LAS unsigned*)(L + ATT_GB_OFF))[t2] = 0u;
              __syncthreads();
              const int nl = __hip_atomic_load(CNTB + t2 * CNTB_PITCH, RLX_AGENT); const int nch = (8 + ((nl + 31) >> 5) + 7) >> 3;
              int inc = nch;
#pragma unroll
              for (int o = 1; o < 64; o <<= 1) { const int v = shup_i(inc, o, t2 & 63); if ((t2 & 63) >= o) inc += v; }
              if ((t2 & 63) == 63) wtot[t2 >> 6] = inc;
              __syncthreads();
              int pre = 0;
              for (int w = 0; w < (t2 >> 6); ++w) pre += wtot[w];
              ust[t2 + 1] = pre + inc; if (t2 == 0) ust[0] = 0;
              LAS int* const nlv = (LAS int*)(L + LDSCTL_OFF + 12288); nlv[t2] = nl;
              __syncthreads();
              const int nB = ust[512], nU = nB + 3072;
              gu32* const qhead = ctl + CW_QUEUE + 64 * (l + 2 * rp);
              const int grp = wave_s >> 2, wg = wave_s & 3;
              char* const gshm = shm + grp * attn_body::BRA_GRP_BYTES; float* const wsf = (float*)((char*)lds + ATT_WSF_OFF) + wave_s * 128;
              LAS unsigned* const gb = (LAS unsigned*)(L + ATT_GB_OFF) + 2 * grp; LAS int* const gq = qn + 16 * grp;
              if (wg == 0 && ln2 == 0) gq[0] = (int)__hip_atomic_fetch_add(qhead, 1u, RLX_AGENT);
              attn_body::grp_bar(gb, ln2);
              for (int kq = 0;; ++kq) {
                  const int u = __builtin_amdgcn_readfirstlane(gq[kq & 1]);
                  if (u >= nU) break;
                  int unext_ = 0; if (wg == 0 && ln2 == 0) unext_ = (int)__hip_atomic_fetch_add(qhead, 1u, RLX_AGENT);
                  attn_body::BraUnit U;
                  if (u < nB) {
                      int lo_ = 0, hi_ = 512;
                      while (hi_ - lo_ > 1) { const int mid = (lo_ + hi_) >> 1; if (ust[mid] <= u) lo_ = mid; else hi_ = mid; }
                      const int hj = lo_, hd = hj >> 6, jb = hj & 63, c = u - ust[hj]; const int nlist = nlv[hj]; const int ntile = 8 + ((nlist + 31) >> 5);
                      U.Q = (const attn_body::bf16*)PROJ + C_QB + hd * 64; U.K = (const attn_body::bf16*)PROJ + C_KB + hd * 64; U.V = (const attn_body::bf16*)PROJ + C_VB + hd * 64;
                      U.PO = (attn_body::bf16*)(ws + WS_POB) + hd * 64; U.PL = (float*)(ws + WS_PLB) + hd;
                      U.kbase = 256 * jb; U.kstride = 1; U.t_first = 0; U.nkt = 4; U.nqt = (ntile - 8 * c) < 8 ? (ntile - 8 * c) : 8;
                      U.qbase = 0; U.qstride = 0; U.slotA = 0; U.list = (const int*)(ws + WS_LIST) + (size_t)hj * 16384; U.nlist = nlist; U.tile0 = 8 * c; U.ownrow0 = 256 * jb;
                      if (rp == 0) attn_body::bra_unit<1, 0>(U, gshm, wsf, (char*)lds + ATT_OST_OFF + wave_s * 2048, gb, wg, gq + ((kq + 1) & 1), unext_); else attn_body::bra_unit<1, ABLV>(U, gshm, wsf, (char*)lds + ATT_OST_OFF + wave_s * 2048, gb, wg, gq + ((kq + 1) & 1), unext_);
                  } else {
                      const int a = u - nB, hd = a / 384, r = a % 384, pt = r >> 7, w7 = r & 127; const int dil = (pt == 0) ? 1 : (pt == 1) ? 4 : 16;
                      const int nblk = 128 / dil, rho = w7 / nblk, ib = w7 % nblk;
                      U.Q = (const attn_body::bf16*)PROJ + C_QA + hd * 64; U.K = (const attn_body::bf16*)PROJ + C_KA + hd * 64; U.V = (const attn_body::bf16*)PROJ + C_VA + hd * 64;
                      U.PO = (attn_body::bf16*)(ws + WS_POA) + hd * 64; U.PL = (float*)(ws + WS_PLA) + hd;
                      U.kbase = rho + dil * (128 * ib - 128); U.kstride = dil; U.t_first = (ib == 0) ? 2 : 0; U.nkt = 4; U.nqt = 4;
                      U.qbase = rho + dil * 128 * ib; U.qstride = dil; U.slotA = pt; U.list = nullptr; U.nlist = 0; U.tile0 = 0; U.ownrow0 = 0;
                      if (rp == 0) attn_body::bra_unit<0, 0>(U, gshm, wsf, (char*)lds + ATT_OST_OFF + wave_s * 2048, gb, wg, gq + ((kq + 1) & 1), unext_); else attn_body::bra_unit<0, ABLV>(U, gshm, wsf, (char*)lds + ATT_OST_OFF + wave_s * 2048, gb, wg, gq + ((kq + 1) & 1), unext_);
                  }
                  attn_body::grp_bar_nv(gb, ln2);
              }
              __syncthreads();
            }
        }
        SEAM(pb + 4);
        if (INJ(5)) for (int rp = 0; rp < REPS(5); ++rp) {
            PHASE_BEGIN();
            const float* const lam_q1 = KIN(float, 9); const float* const lam_k1 = KIN(float, 10); const float* const lam_q2 = KIN(float, 11); const float* const lam_k2 = KIN(float, 12); const float* const g_sub = KIN(float, 13);
            const bf16* const TB = (const bf16*)(ws + WS_T); unsigned char* const MERGED = ws + WS_MERGED;
            const bf16* const POA = (const bf16*)(ws + WS_POA); const bf16* const POB = (const bf16*)(ws + WS_POB); const float* const PLA = (const float*)(ws + WS_PLA); const float* const PLB = (const float*)(ws + WS_PLB);
            const float d1 = wave_sum(lam_q1[l * 64 + lane] * lam_k1[l * 64 + lane], lane), d2 = wave_sum(lam_q2[l * 64 + lane] * lam_k2[l * 64 + lane], lane);
            const float lam = expf(d1) - expf(d2) + lam_init;
            const bool ofp8 = ((OUT_FP8 >> l) & 1) != 0;
            const f32x4 gs = ((const f32x4*)(g_sub + l * 128))[lane & 31]; const float osc = (1.f - lam_init) * (ofp8 ? MSCALE : 1.f);
            for (int row = gw; row < S_; row += NGW) {
                { float ls[3], mx = -INFINITY;
#pragma unroll
                  for (int sl = 0; sl < 3; ++sl) { ls[sl] = PLA[((size_t)sl * S_ + row) * 8 + (lane >> 3)]; mx = fmaxf(mx, ls[sl]); }
                  float acc[8], wsum = 0.f;
#pragma unroll
                  for (int e = 0; e < 8; ++e) acc[e] = 0.f;
#pragma unroll
                  for (int sl = 0; sl < 3; ++sl) { const float wgt = exp2f(ls[sl] - mx); wsum += wgt; const v4u w = ((const GAS v4u*)(POA + ((size_t)sl * S_ + row) * 512))[lane];
                      acc[0] += wgt * bflo(w.x); acc[1] += wgt * bfhi(w.x); acc[2] += wgt * bflo(w.y); acc[3] += wgt * bfhi(w.y); acc[4] += wgt * bflo(w.z); acc[5] += wgt * bfhi(w.z); acc[6] += wgt * bflo(w.w); acc[7] += wgt * bfhi(w.w); }
                  const float iw = (ofp8 ? MSCALE : 1.f) / wsum;
                  if (ofp8) { v2u o; o.x = pg8::pk4_fp8(acc[0] * iw, acc[1] * iw, acc[2] * iw, acc[3] * iw); o.y = pg8::pk4_fp8(acc[4] * iw, acc[5] * iw, acc[6] * iw, acc[7] * iw); ((GAS v2u*)(MERGED + (size_t)row * 2048))[lane] = o; }
                  else { v4u o; o.x = pk2(acc[0] * iw, acc[1] * iw); o.y = pk2(acc[2] * iw, acc[3] * iw); o.z = pk2(acc[4] * iw, acc[5] * iw); o.w = pk2(acc[6] * iw, acc[7] * iw); ((GAS v4u*)((bf16*)MERGED + (size_t)row * 2048))[lane] = o; } }
                { const int own = row >> 8, nsel = own < 3 ? own : 3; float ls[4], mx = -INFINITY;
#pragma unroll
                  for (int sl = 0; sl < 4; ++sl) { const bool on = (sl == 3) || (sl < nsel); ls[sl] = on ? PLB[((size_t)sl * S_ + row) * 8 + (lane >> 3)] : -INFINITY; mx = fmaxf(mx, ls[sl]); }
                  float acc[8], wsum = 0.f;
#pragma unroll
                  for (int e = 0; e < 8; ++e) acc[e] = 0.f;
#pragma unroll
                  for (int sl = 0; sl < 4; ++sl) { const bool on = (sl == 3) || (sl < nsel);
                      if (on) { const float wgt = exp2f(ls[sl] - mx); wsum += wgt; const v4u w = ((const GAS v4u*)(POB + ((size_t)sl * S_ + row) * 512))[lane];
                          acc[0] += wgt * bflo(w.x); acc[1] += wgt * bfhi(w.x); acc[2] += wgt * bflo(w.y); acc[3] += wgt * bfhi(w.y); acc[4] += wgt * bflo(w.z); acc[5] += wgt * bfhi(w.z); acc[6] += wgt * bflo(w.w); acc[7] += wgt * bfhi(w.w); } }
                  const float iw = (ofp8 ? MSCALE : 1.f) / wsum;
                  if (ofp8) { v2u o; o.x = pg8::pk4_fp8(acc[0] * iw, acc[1] * iw, acc[2] * iw, acc[3] * iw); o.y = pg8::pk4_fp8(acc[4] * iw, acc[5] * iw, acc[6] * iw, acc[7] * iw); ((GAS v2u*)(MERGED + (size_t)row * 2048 + 512))[lane] = o; }
                  else { v4u o; o.x = pk2(acc[0] * iw, acc[1] * iw); o.y = pk2(acc[2] * iw, acc[3] * iw); o.z = pk2(acc[4] * iw, acc[5] * iw); o.w = pk2(acc[6] * iw, acc[7] * iw); ((GAS v4u*)((bf16*)MERGED + (size_t)row * 2048 + 512))[lane] = o; } }
#pragma unroll
                for (int j = 0; j < 4; ++j) { const v2u ta = ((const GAS v2u*)(TB + (size_t)row * 1024))[lane + 64 * j], tb = ((const GAS v2u*)(TB + (size_t)(S_ + row) * 1024))[lane + 64 * j];
                    const f32x4 a = (f32x4){bflo(ta.x), bfhi(ta.x), bflo(ta.y), bfhi(ta.y)}, b = (f32x4){bflo(tb.x), bfhi(tb.x), bflo(tb.y), bfhi(tb.y)};
                    const f32x4 v = a - lam * b; float ss = (v.x * v.x + v.y * v.y) + (v.z * v.z + v.w * v.w);
                    ss += shx(ss, 1, lane); ss += shx(ss, 2, lane); ss += shx(ss, 4, lane); ss += shx(ss, 8, lane); ss += shx(ss, 16, lane);
                    const float rs = 1.f / sqrtf(ss * (1.f / 128.f) + RMS_EPS); const f32x4 o = v * rs * gs * osc;
                    if (ofp8) ((GAS unsigned*)(MERGED + (size_t)row * 2048 + 1024))[lane + 64 * j] = pg8::pk4_fp8(o.x, o.y, o.z, o.w);
                    else { v2u w; w.x = pk2(o.x, o.y); w.y = pk2(o.z, o.w); ((GAS v2u*)((bf16*)MERGED + (size_t)row * 2048 + 1024))[lane + 64 * j] = w; } }
            }
        }
        SEAM(pb + 5);
        if (INJ(6)) for (int rp = 0; rp < REPS(6); ++rp) {
            PHASE_BEGIN();
            const float* const x_in = KIN(float, 0); bf16* const xbuf = (bf16*)(ws + WS_XB); const float* const mod = (const float*)(ws + WS_MOD) + l * 12288;
            unsigned char* const MERGED = ws + WS_MERGED; unsigned char* const WOUT = ws + WS_WOUT;
            if (l == 0) { constexpr bool F8 = (OUT_FP8 & 1) != 0; constexpr int KBO = F8 ? 2048 : 4096;
                pg8::DenseSched Sd; Sd.init(MERGED, WOUT, S_, 2048, KBO, G, bx);
                pg8::EpiGateRes<true> E{x_in, xbuf, mod + 4096, F8 ? 1.f / (WSC_K2048 * MSCALE) : 1.f};
                pg8::gemm_phase<pg8::EpiGateRes<true>, pg8::DenseSched, true, GEMM_SP2, F8>(L + RING_OFF, KBO, Sd, E, wave_s); }
            else { constexpr bool F8 = (OUT_FP8 & 2) != 0; constexpr int KBO = F8 ? 2048 : 4096;
                pg8::DenseSched Sd; Sd.init(MERGED, WOUT + (size_t)2048 * 4096, S_, 2048, KBO, G, bx);
                pg8::EpiGateRes<false> E{xbuf, xbuf, mod + 4096, F8 ? 1.f / (WSC_K2048 * MSCALE) : 1.f};
                pg8::gemm_phase<pg8::EpiGateRes<false>, pg8::DenseSched, true, GEMM_SP2, F8>(L + RING_OFF, KBO, Sd, E, wave_s); }
        }
        SEAM(pb + 6);
        if (INJ(7)) for (int rp = 0; rp < REPS(7); ++rp) {
            PHASE_BEGIN();
            const float* const g_mlp = KIN(float, 6); const float* const w_router = KIN(float, 17); const float* const b_router = KIN(float, 18); const bf16* const xbuf = (const bf16*)(ws + WS_XB);
            const float* const mod = (const float*)(ws + WS_MOD) + l * 12288; unsigned char* const HB = ws + WS_H;
            int* const EID = (int*)(ws + WS_EID); float* const WTS = (float*)(ws + WS_WTS); int* const CNT = (int*)(ws + WS_CNT);
            LAS unsigned char* const WF = L; LAS float* const rawp = (LAS float*)(L + LDSCTL_OFF + 4096); LAS float* const bpart = (LAS float*)(L + LDSCTL_OFF + 12288); LAS float* const biasv = (LAS float*)(L + LDSCTL_OFF + 14336); LAS float* const rsv = (LAS float*)(L + LDSCTL_OFF + 14464);
            { const float* const gm = g_mlp + l * 2048; const float* const scv = mod + 8192; const float* const shv = mod + 6144;
              for (int c = tid; c < 4096; c += NWAVES * 64) { const int e = c & 15, g = (c >> 4) & 3, ks = c >> 6, k0 = 32 * ks + 8 * g; unsigned hi4[4], lo4[4];
#pragma unroll
                  for (int i2 = 0; i2 < 4; ++i2) { const int ka = k0 + 2 * i2, kb = ka + 1;
                      const float w0 = w_router[ka * 16 + e] * (gm[ka] * (1.f + scv[ka])), w1 = w_router[kb * 16 + e] * (gm[kb] * (1.f + scv[kb]));
                      const unsigned h0 = f2bf(w0), h1 = f2bf(w1); const float r0 = w0 - __uint_as_float(h0 << 16), r1 = w1 - __uint_as_float(h1 << 16);
                      hi4[i2] = h0 | (h1 << 16); lo4[i2] = f2bf(r0) | (f2bf(r1) << 16); }
                  *(LAS v4u*)(WF + ks * 2048 + (g * 16 + e) * 16) = (v4u){hi4[0], hi4[1], hi4[2], hi4[3]}; *(LAS v4u*)(WF + ks * 2048 + 1024 + (g * 16 + e) * 16) = (v4u){lo4[0], lo4[1], lo4[2], lo4[3]}; }
              { const int e = tid & 15, part = tid >> 4; float s = 0.f;
                for (int k = 64 * part; k < 64 * part + 64; ++k) s += shv[k] * w_router[k * 16 + e];
                bpart[part * 16 + e] = s; }
              __syncthreads();
              if (tid < 16) { float s = 0.f; for (int p = 0; p < 32; ++p) s += bpart[p * 16 + tid]; biasv[tid] = s; }
              __syncthreads(); }
            float bz[16];
#pragma unroll
            for (int e = 0; e < 16; ++e) bz[e] = biasv[e];
            f32x4 cA[8];
#pragma unroll
            for (int j = 0; j < 8; ++j) { const int c4 = lane + 64 * j; const f32x4 g = ((const f32x4*)(g_mlp + l * 2048))[c4]; const f32x4 sc = ((const f32x4*)(mod + 8192))[c4];
                cA[j] = g * (1.f + sc); }
            float br[16];
#pragma unroll
            for (int e = 0; e < 16; ++e) br[e] = b_router[e];
            for (int rb = bx; rb < NROWBLK; rb += G) {
                { const int kh = wave & 1; const bf16* const xr = xbuf + (size_t)(64 * rb + 16 * (wave >> 1) + (lane & 15)) * 2048 + kh * 1024 + (lane >> 4) * 8; const LAS unsigned char* const wf = WF + kh * 32 * 2048 + lane * 16;
                  f32x4 acc = (f32x4){0.f, 0.f, 0.f, 0.f};
#pragma unroll 8
                  for (int ks = 0; ks < 32; ++ks) { const bf16x8 a = *(const GAS bf16x8*)(xr + ks * 32); const bf16x8 bh = *(const LAS bf16x8*)(wf + ks * 2048), bl = *(const LAS bf16x8*)(wf + ks * 2048 + 1024);
                      acc = __builtin_amdgcn_mfma_f32_16x16x32_bf16(a, bh, acc, 0, 0, 0); acc = __builtin_amdgcn_mfma_f32_16x16x32_bf16(a, bl, acc, 0, 0, 0); }
#pragma unroll
                  for (int j = 0; j < 4; ++j) rawp[kh * 1024 + (16 * (wave >> 1) + 4 * (lane >> 4) + j) * 16 + (lane & 15)] = acc[j]; }
                __syncthreads();
                v2u nv[8];
#pragma unroll
                for (int j = 0; j < 8; ++j) nv[j] = NTL((const GAS v2u*)(xbuf + (size_t)(64 * rb + 8 * wave) * 2048) + (lane + 64 * j));
                for (int i = 0; i < 8; ++i) { const int row = 64 * rb + 8 * wave + i;
                    f32x4 v[8]; float ss = 0.f;
#pragma unroll
                    for (int j = 0; j < 8; ++j) { v[j] = (f32x4){bflo(nv[j].x), bfhi(nv[j].x), bflo(nv[j].y), bfhi(nv[j].y)}; ss += (v[j].x * v[j].x + v[j].y * v[j].y) + (v[j].z * v[j].z + v[j].w * v[j].w); }
                    if (i < 7) {
#pragma unroll
                        for (int j = 0; j < 8; ++j) nv[j] = NTL((const GAS v2u*)(xbuf + (size_t)(row + 1) * 2048) + (lane + 64 * j));
                    }
                    const float rs = 1.f / sqrtf(wave_sum(ss, lane) * (1.f / 2048.f) + RMS_EPS);
#pragma unroll
                    for (int j = 0; j < 8; ++j) { const f32x4 o = v[j] * rs * cA[j] + ((const GAS f32x4*)(mod + 6144))[lane + 64 * j]; ((GAS unsigned*)(HB + (size_t)row * 2048))[lane + 64 * j] = pg8::pk4_fp8(o.x, o.y, o.z, o.w); }
                    if (lane == 0) rsv[8 * wave + i] = rs;
                }
                __syncthreads();
                if (wave == 0) { const int row = 64 * rb + lane; const float rs = rsv[lane];
                    float p[16];
                    { const LAS f32x4* const r0 = (const LAS f32x4*)(rawp + lane * 16); const LAS f32x4* const r1 = (const LAS f32x4*)(rawp + 1024 + lane * 16);
#pragma unroll
                      for (int q = 0; q < 4; ++q) { const f32x4 a = r0[q] + r1[q]; p[4 * q] = a.x * rs + bz[4 * q]; p[4 * q + 1] = a.y * rs + bz[4 * q + 1]; p[4 * q + 2] = a.z * rs + bz[4 * q + 2]; p[4 * q + 3] = a.w * rs + bz[4 * q + 3]; } }
                    float sg[16], sv[16];
#pragma unroll
                    for (int e = 0; e < 16; ++e) { sv[e] = 1.f / (1.f + expf(-p[e])); sg[e] = sv[e] + br[e]; }
                    float gsc[4];
#pragma unroll
                    for (int g4 = 0; g4 < 4; ++g4) { const float a = sg[4 * g4], b = sg[4 * g4 + 1], c = sg[4 * g4 + 2], d = sg[4 * g4 + 3];
                        const float h1 = fmaxf(a, b), l1 = fminf(a, b), h2 = fmaxf(c, d), l2 = fminf(c, d); gsc[g4] = fmaxf(h1, h2) + fmaxf(fminf(h1, h2), fmaxf(l1, l2)); }
                    int gi = 0; float gb = gsc[0];
#pragma unroll
                    for (int g4 = 1; g4 < 4; ++g4) if (gsc[g4] > gb) { gb = gsc[g4]; gi = g4; }
                    float cd[4], cs[4];
#pragma unroll
                    for (int k = 0; k < 4; ++k) { cd[k] = (gi == 0) ? sg[k] : (gi == 1) ? sg[4 + k] : (gi == 2) ? sg[8 + k] : sg[12 + k]; cs[k] = (gi == 0) ? sv[k] : (gi == 1) ? sv[4 + k] : (gi == 2) ? sv[8 + k] : sv[12 + k]; }
                    int l0 = 0; float v0 = cd[0], s0 = cs[0];
#pragma unroll
                    for (int k = 1; k < 4; ++k) if (cd[k] > v0) { v0 = cd[k]; l0 = k; s0 = cs[k]; }
                    int l1i = -1; float v1 = -INFINITY, s1 = 0.f;
#pragma unroll
                    for (int k = 0; k < 4; ++k) if (k != l0 && cd[k] > v1) { v1 = cd[k]; l1i = k; s1 = cs[k]; }
                    const int e0 = 4 * gi + l0, e1 = 4 * gi + l1i; const float wsum = s0 + s1;
                    EID[2 * row] = e0; EID[2 * row + 1] = e1; WTS[2 * row] = s0 / wsum; WTS[2 * row + 1] = s1 / wsum;
                    int mine = 0;
#pragma unroll
                    for (int e = 0; e < 16; ++e) { const int c = __popcll(__ballot(e0 == e)) + __popcll(__ballot(e1 == e)); if (lane == e) mine = c; }
                    if (lane < 16) CNT[rb * 16 + lane] = mine; }
                __syncthreads();
            }
        }
        SEAM(pb + 7);
        if (INJ(8)) for (int rp = 0; rp < REPS(8); ++rp) {
            PHASE_BEGIN();
            const unsigned char* const HB = ws + WS_H; unsigned char* const XS = ws + WS_XS;
            const int* const EID = (const int*)(ws + WS_EID); const float* const WTS = (const float*)(ws + WS_WTS); int* const ROWTOK = (int*)(ws + WS_ROWTOK); float* const ROWW = (float*)(ws + WS_ROWW); const int* const CNT = (const int*)(ws + WS_CNT);
            for (int rb = bx; rb < NROWBLK; rb += G) {
                v4u gw[16];
#pragma unroll
                for (int i = 0; i < 8; ++i) { const int row = 64 * rb + 8 * wave + i; gw[2 * i] = ((const GAS v4u*)(HB + (size_t)row * 2048))[lane]; gw[2 * i + 1] = ((const GAS v4u*)(HB + (size_t)row * 2048))[lane + 64]; }
                COMPUTE_SEGMENTS(rb);
                if (wave == 0) { const int row = 64 * rb + lane; const int e0 = EID[2 * row], e1 = EID[2 * row + 1]; int p0 = 0, p1 = 0;
                    const unsigned long long lt = (1ull << lane) - 1ull;
                    for (int e = 0; e < 16; ++e) { const unsigned long long m0 = __ballot(e0 == e), m1 = __ballot(e1 == e); const int r = __popcll(m0 & lt) + __popcll(m1 & lt);
                        if (e0 == e) p0 = basee[e] + r; if (e1 == e) p1 = basee[e] + r; }
                    postab[2 * lane] = p0; postab[2 * lane + 1] = p1;
                    ROWTOK[p0] = 2 * row; ROWTOK[p1] = 2 * row + 1; ROWW[p0] = WTS[2 * row]; ROWW[p1] = WTS[2 * row + 1]; }
                __syncthreads();
                {
#pragma unroll
                  for (int i = 0; i < 8; ++i) { const int r = 8 * wave + i; const int p0 = postab[2 * r], p1 = postab[2 * r + 1];
                      ((GAS v4u*)(XS + (size_t)p0 * 2048))[lane] = gw[2 * i]; ((GAS v4u*)(XS + (size_t)p0 * 2048))[lane + 64] = gw[2 * i + 1];
                      ((GAS v4u*)(XS + (size_t)p1 * 2048))[lane] = gw[2 * i]; ((GAS v4u*)(XS + (size_t)p1 * 2048))[lane + 64] = gw[2 * i + 1]; } }
                if (rb < 16) { const int pbeg = segs[rb] + tot[rb], pend = segs[rb + 1];
                    for (int p = pbeg + tid; p < pend; p += NWAVES * 64) { ROWTOK[p] = -1; ROWW[p] = 0.f; } }
                __syncthreads();
            }
        }
        SEAM(pb + 8);
        if (INJ(9)) for (int rp = 0; rp < REPS(9); ++rp) {
            PHASE_BEGIN();
            const int* const CNT = (const int*)(ws + WS_CNT); unsigned char* const XS = ws + WS_XS; unsigned char* const WGU = ws + WS_WGU; unsigned char* const ACT = ws + WS_ACT;
            COMPUTE_SEGMENTS(0);
            pg8::MoeSched Sm; Sm.init(XS, WGU + (size_t)l * 16 * 2048 * 2048, segs[16], 2048, 2048, (size_t)2048 * 2048, (const PG8_LAS unsigned char*)p2e, G, bx);
            pg8::EpiSwiglu E{ACT, 1.f / WSC_K2048, ASCALE};
            pg8::gemm_phase<pg8::EpiSwiglu, pg8::MoeSched, true, GEMM_SP2, true>(L + RING_OFF, 2048, Sm, E, wave_s);
        }
        SEAM(pb + 9);
        if (INJ(10)) for (int rp = 0; rp < REPS(10); ++rp) {
            PHASE_BEGIN();
            const int* const CNT = (const int*)(ws + WS_CNT); unsigned char* const ACT = ws + WS_ACT; unsigned char* const WDN = ws + WS_WDN; bf16* const YB = (bf16*)(ws + WS_Y);
            const int* const ROWTOK = (const int*)(ws + WS_ROWTOK); const float* const ROWW = (const float*)(ws + WS_ROWW);
            COMPUTE_SEGMENTS(0);
            pg8::MoeSched Sm; Sm.init(ACT, WDN + (size_t)l * 16 * 2048 * 1024, segs[16], 2048, 1024, (size_t)2048 * 1024, (const PG8_LAS unsigned char*)p2e, G, bx);
            pg8::EpiDown E{YB, ROWTOK, ROWW, 1.f / (WSC_K1024 * ASCALE)};
            pg8::gemm_phase<pg8::EpiDown, pg8::MoeSched, true, GEMM_SP2, true>(L + RING_OFF, 1024, Sm, E, wave_s);
        }
        SEAM(pb + 10);
    }
#if defined(STAMP_A)
    float st_delta = 0.f, st_add = 0.f;
    if (hi - lo > 1) {
        if (kbx == 0 && threadIdx.x == 0) { const float ta = (float)(stamps[STAMP_A + 1] - stamps[STAMP_A]) * 0.01f, tb = (float)(stamps[STAMP_B + 1] - stamps[STAMP_B]) * 0.01f;
            __hip_atomic_store(ctl + CW_QUEUE + 512, __float_as_uint(ta * (1.f / 2000.f)), RLX_AGENT); __hip_atomic_store(ctl + CW_QUEUE + 576, __float_as_uint(tb), RLX_AGENT); }
        xcd_barrier(bar);
        st_delta = __uint_as_float(__hip_atomic_load(ctl + CW_QUEUE + 512, RLX_AGENT)); st_add = __uint_as_float(__hip_atomic_load(ctl + CW_QUEUE + 576, RLX_AGENT));
    }
#endif
    if (((PHMASK >> 12) & 1) && IN(23)) {
        PHASE_BEGIN();
        const float* const g_final = KIN(float, 19); float* const outp = ka->out; const bf16* const xbuf = (const bf16*)(ws + WS_XB); const float* const MOD = (const float*)(ws + WS_MOD); const bf16* const YB = (const bf16*)(ws + WS_Y);
        f32x4 cA[8], cG[8];
#pragma unroll
        for (int j = 0; j < 8; ++j) { const int c4 = lane + 64 * j; cA[j] = ((const f32x4*)g_final)[c4]; cG[j] = ((const f32x4*)(MOD + 12288 + 10240))[c4]; }
        v2u nv[8], na[8], nb[8];
#pragma unroll
        for (int j = 0; j < 8; ++j) { nv[j] = NTL((const GAS v2u*)(xbuf + (size_t)gw * 2048) + (lane + 64 * j)); na[j] = NTL((const GAS v2u*)(YB + (size_t)(2 * gw) * 2048) + (lane + 64 * j)); nb[j] = NTL((const GAS v2u*)(YB + (size_t)(2 * gw + 1) * 2048) + (lane + 64 * j)); }
        for (int row = gw; row < S_; row += NGW) {
            f32x4 v[8]; v2u ya[8], yb[8]; float ss = 0.f;
#pragma unroll
            for (int j = 0; j < 8; ++j) { v[j] = (f32x4){bflo(nv[j].x), bfhi(nv[j].x), bflo(nv[j].y), bfhi(nv[j].y)}; ya[j] = na[j]; yb[j] = nb[j]; }
            const int nrow = row + NGW;
            if (nrow < S_) {
#pragma unroll
                for (int j = 0; j < 8; ++j) { nv[j] = NTL((const GAS v2u*)(xbuf + (size_t)nrow * 2048) + (lane + 64 * j)); na[j] = NTL((const GAS v2u*)(YB + (size_t)(2 * nrow) * 2048) + (lane + 64 * j)); nb[j] = NTL((const GAS v2u*)(YB + (size_t)(2 * nrow + 1) * 2048) + (lane + 64 * j)); }
            }
#pragma unroll
            for (int j = 0; j < 8; ++j) { const v2u a = ya[j], b = yb[j];
                const f32x4 ys = (f32x4){bflo(a.x) + bflo(b.x), bfhi(a.x) + bfhi(b.x), bflo(a.y) + bflo(b.y), bfhi(a.y) + bfhi(b.y)};
                v[j] += cG[j] * ys; ss += (v[j].x * v[j].x + v[j].y * v[j].y) + (v[j].z * v[j].z + v[j].w * v[j].w); }
            const float rs = 1.f / sqrtf(wave_sum(ss, lane) * (1.f / 2048.f) + RMS_EPS);
#pragma unroll
            for (int j = 0; j < 8; ++j) { f32x4 o_ = v[j] * rs * cA[j];
#if defined(STAMP_A)
                o_ = o_ * (1.f + st_delta); if (row == 0 && lane == 0 && j == 0) o_.x += st_add;
#endif
                ((GAS f32x4*)(outp + (size_t)row * 2048))[lane + 64 * j] = o_; }
        }
    }
#undef IN
#undef INJ
#undef REPS
#undef PHASE_BEGIN
#undef KIN
#undef SEAM
#undef COMPUTE_SEGMENTS
}

extern "C" void kernel_launch(void* const* d_in, const int* in_sizes, int n_in, void* d_out, int out_size, void* d_ws, size_t ws_size, hipStream_t stream) {
    static int grid = 0;
    if (grid == 0) {
        if (n_in != 20 || in_sizes[0] != S_ * DM_ || out_size != S_ * DM_ || ws_size < WS_END) { fprintf(stderr, "kernel_launch: unexpected shapes or workspace (%d inputs, in0 %d, out %d, ws %zu); nothing launched\n", n_in, n_in > 0 ? in_sizes[0] : -1, out_size, ws_size); grid = -1; return; }
        int dev = 0, cus = 0, per_cu = 0;
        if (hipGetDevice(&dev) != hipSuccess || hipDeviceGetAttribute(&cus, hipDeviceAttributeMultiprocessorCount, dev) != hipSuccess) { grid = -1; return; }
        if (hipFuncSetAttribute((const void*)fwd, hipFuncAttributeMaxDynamicSharedMemorySize, LDS_BYTES) != hipSuccess) { fprintf(stderr, "kernel_launch: hipFuncSetAttribute failed\n"); grid = -1; return; }
        if (hipOccupancyMaxActiveBlocksPerMultiprocessor(&per_cu, (const void*)fwd, NWAVES * 64, LDS_BYTES) != hipSuccess || per_cu < 1) fprintf(stderr, "kernel_launch: occupancy query reports %d blocks per CU\n", per_cu);
        (void)hipGetLastError();
        grid = cus;
    }
    if (grid < 0) return;
    if (hipMemsetAsync((char*)d_ws + WS_CTL, 0, CTL_ZERO_BYTES, stream) != hipSuccess) return;
    Args a{};
    for (int i = 0; i < 20; ++i) a.in[i] = d_in[i];
    a.out = (float*)d_out; a.ws = (unsigned char*)d_ws;
    if (MK_N_LAUNCHES == 1) { a.ph_lo = 0; a.ph_hi = N_PHASES; hipLaunchKernelGGL(fwd, dim3(grid), dim3(NWAVES * 64), LDS_BYTES, stream, a); }
    else for (int p = 0; p < N_PHASES; ++p) { a.ph_lo = p; a.ph_hi = p + 1; hipLaunchKernelGGL(fwd, dim3(grid), dim3(NWAVES * 64), LDS_BYTES, stream, a); }
}
```

```cpp
#include <hip/hip_runtime.h>
#include <hip/hip_bf16.h>
#include <cstdio>
#include <cstdint>
#include <cmath>
namespace pg8 {
#define PG8_LAS __attribute__((address_space(3)))
typedef unsigned short bf16_t;
typedef short bf16x8 __attribute__((ext_vector_type(8)));
typedef float f32x4 __attribute__((ext_vector_type(4)));
typedef unsigned u32x4 __attribute__((ext_vector_type(4)));
constexpr int BM = 256, BK = 64, HALF = 128, HTB = HALF * BK * 2  , STAGE_BYTES = 8 * HTB, NXCD = 8, WGM = 8;

__host__ __device__ __forceinline__ int lds_byte(int r, int c) { const int st = (r >> 4) * 2 + (c >> 5), rr = r & 15, cc = c & 31, ob = rr * 64 + cc * 2; return st * 1024 + (ob ^ (((ob >> 9) & 1) << 5)); }
__host__ __device__ __forceinline__ void stage_rc(int b, int& R, int& C) { const int st = b / 1024, sb = b % 1024, swz = sb ^ (((sb >> 9) & 1) << 5); R = (st >> 1) * 16 + swz / 64; C = (st & 1) * 32 + (swz % 64) / 2; }
__host__ __device__ __forceinline__ int perm32(int rho) { const int n = rho >> 4, i = rho & 15; return 8 * (i >> 2) + 4 * n + (i & 3); }

struct Unit { int pm, pn; };
struct Gemm { const bf16_t* A; const bf16_t* Bt; int M, N, K; };

struct StaticOrder {
    int nM, nN, nwg, G, c;
    __host__ __device__ void init(int M, int N, int G_, int c_) { nM = M / BM; nN = N / BM; nwg = nM * nN; G = G_; c = c_; }
    __host__ __device__ bool next(int i, Unit& u) const {
        const long L = (long)i * G + c; if (L >= nwg) return false;
        int wgid = (int)L; { const int q = nwg / NXCD, r = nwg % NXCD, xcd = wgid % NXCD, off = wgid / NXCD; wgid = (xcd < r ? xcd * (q + 1) : r * (q + 1) + (xcd - r) * q) + off; }
        const int nig = WGM * nN, gid = wgid / nig, fm = gid * WGM, gsz = (nM - fm) < WGM ? (nM - fm) : WGM;
        u.pm = fm + ((wgid % nig) % gsz); u.pn = (wgid % nig) / gsz; return true;
    }
    __device__ __forceinline__ void a_ready(const Unit&) const {}
    __device__ __forceinline__ void done(const Unit&) const {}
};

struct DenseSched {
    const char* A; const char* Bt; size_t tstep; StaticOrder so;
    __device__ __forceinline__ void init(const void* A_, const void* Bt_, int M, int N, int KB, int G, int c) { A = (const char*)A_; Bt = (const char*)Bt_; tstep = (size_t)BM * KB; so.init(M, N, G, c); }
    __device__ __forceinline__ bool next(int i, Unit& u) const { return so.next(i, u); }
    __device__ __forceinline__ const char* a_ptr(const Unit& u) const { return A + (size_t)u.pm * tstep; }
    __device__ __forceinline__ const char* b_ptr(const Unit& u) const { return Bt + (size_t)u.pn * tstep; }
    __device__ __forceinline__ void a_ready(const Unit&) const {}
    __device__ __forceinline__ void done(const Unit&) const {}
};
struct MoeSched {
    const char* A; const char* Bt; size_t tstep, estride; StaticOrder so; const PG8_LAS unsigned char* p2e;
    __device__ __forceinline__ void init(const void* A_, const void* Bt_, int Mpad, int N, int KB, size_t estride_, const PG8_LAS unsigned char* p2e_, int G, int c) {
        A = (const char*)A_; Bt = (const char*)Bt_; tstep = (size_t)BM * KB; estride = estride_; p2e = p2e_; so.init(Mpad, N, G, c); }
    __device__ __forceinline__ bool next(int i, Unit& u) const { return so.next(i, u); }
    __device__ __forceinline__ const char* a_ptr(const Unit& u) const { return A + (size_t)u.pm * tstep; }
    __device__ __forceinline__ const char* b_ptr(const Unit& u) const { const int e = __builtin_amdgcn_readfirstlane((int)p2e[u.pm]); return Bt + (size_t)e * estride + (size_t)u.pn * tstep; }
    __device__ __forceinline__ void a_ready(const Unit&) const {}
    __device__ __forceinline__ void done(const Unit&) const {}
};

__device__ __forceinline__ unsigned pk4_fp8(float a, float b, float c, float d) {
    a = __builtin_fminf(__builtin_fmaxf(a, -448.f), 448.f); b = __builtin_fminf(__builtin_fmaxf(b, -448.f), 448.f); c = __builtin_fminf(__builtin_fmaxf(c, -448.f), 448.f); d = __builtin_fminf(__builtin_fmaxf(d, -448.f), 448.f);
    int w = 0; w = __builtin_amdgcn_cvt_pk_fp8_f32(a, b, w, false); w = __builtin_amdgcn_cvt_pk_fp8_f32(c, d, w, true); return (unsigned)w; }
__device__ __forceinline__ unsigned cvt_pk_bf16(float lo, float hi) { unsigned r; asm volatile("v_cvt_pk_bf16_f32 %0, %1, %2" : "=v"(r) : "v"(lo), "v"(hi)); return r; }

struct EpiProj {
    static constexpr bool PERM = true, AFTER_DRAIN = false;
    bf16_t* O; const float* cosT; const float* sinT; float qscale, oscale;
    __device__ __forceinline__ void operator()(const f32x4 (&acc)[2][2][4][2], const Unit& u, int wr, int wc, int fr, int fq) const {
        const int pn = u.pn;
        const bool isq = (pn < 2) || (pn == 6) || (pn == 7) || (pn >= 12 && pn < 16);
        const bool isk = (pn == 2) || (pn == 3) || (pn == 8) || (pn == 9) || (pn >= 16 && pn < 20);
        const int row0 = u.pm * BM + wr * 64 + fr, col0 = pn * BM + wc * 32 + 8 * fq;
        const int i0 = (wc & 1) * 16 + 4 * fq;
        const float sc = isq ? qscale * oscale : oscale;
#pragma unroll
        for (int ai = 0; ai < 2; ++ai)
#pragma unroll
            for (int m = 0; m < 4; ++m) { const int row = row0 + ai * HALF + m * 16; bf16_t* rowp = O + (size_t)row * 6144 + col0;
                f32x4 cs = (f32x4){1.f, 1.f, 1.f, 1.f}, sn = (f32x4){0.f, 0.f, 0.f, 0.f};
                if (isq || isk) { cs = *(const f32x4*)(cosT + (size_t)row * 32 + i0); sn = *(const f32x4*)(sinT + (size_t)row * 32 + i0); }
#pragma unroll
                for (int bj = 0; bj < 2; ++bj) { const f32x4 v0 = acc[ai][bj][m][0], v1 = acc[ai][bj][m][1];
                    const float a0 = (v0[0] * cs[0] - v0[1] * sn[0]) * sc, b0 = (v0[1] * cs[0] + v0[0] * sn[0]) * sc;
                    const float a1 = (v0[2] * cs[1] - v0[3] * sn[1]) * sc, b1 = (v0[3] * cs[1] + v0[2] * sn[1]) * sc;
                    const float a2 = (v1[0] * cs[2] - v1[1] * sn[2]) * sc, b2 = (v1[1] * cs[2] + v1[0] * sn[2]) * sc;
                    const float a3 = (v1[2] * cs[3] - v1[3] * sn[3]) * sc, b3 = (v1[3] * cs[3] + v1[2] * sn[3]) * sc;
                    u32x4 w; w.x = cvt_pk_bf16(a0, b0); w.y = cvt_pk_bf16(a1, b1); w.z = cvt_pk_bf16(a2, b2); w.w = cvt_pk_bf16(a3, b3);
                    *(u32x4*)(rowp + bj * HALF) = w; } }
    }
};
template <bool BASE_F32> struct EpiGateRes {
    static constexpr bool PERM = true, AFTER_DRAIN = false;
    const void* base; bf16_t* out; const float* gate; float oscale;
    __device__ __forceinline__ void operator()(const f32x4 (&acc)[2][2][4][2], const Unit& u, int wr, int wc, int fr, int fq) const {
        const int col0 = u.pn * BM + wc * 32 + 8 * fq;
        f32x4 gv[2][2];
#pragma unroll
        for (int bj = 0; bj < 2; ++bj)
#pragma unroll
            for (int n = 0; n < 2; ++n) gv[bj][n] = *(const f32x4*)(gate + col0 + bj * HALF + n * 4) * oscale;
#pragma unroll
        for (int ai = 0; ai < 2; ++ai)
#pragma unroll
            for (int m = 0; m < 4; ++m) { const size_t off = (size_t)(u.pm * BM + ai * HALF + wr * 64 + m * 16 + fr) * 2048 + col0;
#pragma unroll
                for (int bj = 0; bj < 2; ++bj) { f32x4 b0, b1;
                    if (BASE_F32) { b0 = *(const f32x4*)((const float*)base + off + bj * HALF); b1 = *(const f32x4*)((const float*)base + off + bj * HALF + 4); }
                    else { const u32x4 w = *(const u32x4*)((const bf16_t*)base + off + bj * HALF);
                        b0 = (f32x4){__builtin_bit_cast(float, w.x << 16), __builtin_bit_cast(float, w.x & 0xffff0000u), __builtin_bit_cast(float, w.y << 16), __builtin_bit_cast(float, w.y & 0xffff0000u)};
                        b1 = (f32x4){__builtin_bit_cast(float, w.z << 16), __builtin_bit_cast(float, w.z & 0xffff0000u), __builtin_bit_cast(float, w.w << 16), __builtin_bit_cast(float, w.w & 0xffff0000u)}; }
                    const f32x4 v0 = b0 + gv[bj][0] * acc[ai][bj][m][0], v1 = b1 + gv[bj][1] * acc[ai][bj][m][1];
                    u32x4 w; w.x = cvt_pk_bf16(v0[0], v0[1]); w.y = cvt_pk_bf16(v0[2], v0[3]); w.z = cvt_pk_bf16(v1[0], v1[1]); w.w = cvt_pk_bf16(v1[2], v1[3]);
                    *(u32x4*)(out + off + bj * HALF) = w; }
                asm volatile("" ::: "memory"); }
    }
};
struct EpiSwiglu {
    static constexpr bool PERM = true, AFTER_DRAIN = false;
    unsigned char* O; float iscale, ascale;
    __device__ __forceinline__ void operator()(const f32x4 (&acc)[2][2][4][2], const Unit& u, int wr, int wc, int fr, int fq) const {
        const int row0 = u.pm * BM + wr * 64 + fr, col0 = u.pn * 128 + wc * 16 + 4 * fq;
#pragma unroll
        for (int ai = 0; ai < 2; ++ai)
#pragma unroll
            for (int m = 0; m < 4; ++m) { unsigned char* rowp = O + (size_t)(row0 + ai * HALF + m * 16) * 1024 + col0;
#pragma unroll
                for (int bj = 0; bj < 2; ++bj) { const f32x4 g = acc[ai][bj][m][0] * iscale, up = acc[ai][bj][m][1] * (iscale * ascale); float r[4];
#pragma unroll
                    for (int j = 0; j < 4; ++j) { const float e = __builtin_amdgcn_exp2f(-1.4426950408889634f * g[j]); r[j] = g[j] * __builtin_amdgcn_rcpf(1.f + e) * up[j]; }
                    *(unsigned*)(rowp + bj * 64) = pk4_fp8(r[0], r[1], r[2], r[3]); } }
    }
};
struct EpiDown {
    static constexpr bool PERM = true, AFTER_DRAIN = false;
    bf16_t* Y; const int* rowtok; const float* roww; float oscale;
    __device__ __forceinline__ void operator()(const f32x4 (&acc)[2][2][4][2], const Unit& u, int wr, int wc, int fr, int fq) const {
        const int row0 = u.pm * BM + wr * 64 + fr, col0 = u.pn * BM + wc * 32 + 8 * fq;
#pragma unroll
        for (int ai = 0; ai < 2; ++ai)
#pragma unroll
            for (int m = 0; m < 4; ++m) { const int pos = row0 + ai * HALF + m * 16; const int tk = rowtok[pos]; const float w8 = roww[pos] * oscale;
                bf16_t* rowp = Y + (size_t)(tk < 0 ? 0 : tk) * 2048 + col0;
#pragma unroll
                for (int bj = 0; bj < 2; ++bj) { const f32x4 v0 = acc[ai][bj][m][0] * w8, v1 = acc[ai][bj][m][1] * w8;
                    u32x4 w; w.x = cvt_pk_bf16(v0[0], v0[1]); w.y = cvt_pk_bf16(v0[2], v0[3]); w.z = cvt_pk_bf16(v1[0], v1[1]); w.w = cvt_pk_bf16(v1[2], v1[3]);
                    if (tk >= 0) *(u32x4*)(rowp + bj * HALF) = w; }
                asm volatile("" ::: "memory"); }
    }
};

template <class Epi, class Sched, bool ALIGN_EPI = false, bool SP2 = false, bool FP8 = false>
__device__ __forceinline__ void gemm_phase(PG8_LAS unsigned char* lds, const int KB  , const Sched& S, const Epi& E, const int wave_s  ) {
    typedef int v4i_t __attribute__((ext_vector_type(4))); typedef int v8i_t __attribute__((ext_vector_type(8)));
    int lane; asm volatile("v_mbcnt_lo_u32_b32 %0, -1, 0\n\tv_mbcnt_hi_u32_b32 %0, -1, %0" : "=v"(lane)); const int wid = wave_s, tid = wid * 64 + lane, wr = wid >> 2, wc = wid & 3, fr = lane & 15, fq = lane >> 4;
    const int nt = KB / (BK * 2);
    unsigned voffA, voffB;
    { int R, C; stage_rc(tid * 16, R, C); const int Rb = Epi::PERM ? ((R & ~31) + perm32(R & 31)) : R; voffA = (unsigned)(R * KB + C * 2); voffB = (unsigned)(Rb * KB + C * 2); }
    const size_t pstep = (size_t)64 * KB;
    const size_t kstep = (size_t)(BK * 2);
    const size_t hstep = (size_t)HALF * KB;
    const unsigned ldsbw = (unsigned)__builtin_amdgcn_readfirstlane((int)((unsigned)(uintptr_t)lds + (unsigned)wid * 1024u));
    const int aoff = lds_byte(wr * 64 + fr, fq * 8), boff = lds_byte(wc * 32 + fr, fq * 8);
#define PG8_SA(b, h) (((b) * 2 + (h)) * HTB)
#define PG8_SB(b, h) ((4 + (b) * 2 + (h)) * HTB)
#define PG8_STAGE1(bufoff, gbase, voff, PI) do { unsigned keep_; \
        asm volatile("s_mov_b32 %0, m0\n\ts_add_i32 m0, %3, %4\n\ts_nop 0\n\tglobal_load_lds_dwordx4 %1, %2\n\ts_mov_b32 m0, %0" : "=&s"(keep_) : "v"(voff), "s"((const char*)(gbase) + (PI) * pstep), "s"(ldsbw), "i"((bufoff) + (PI) * 8192) : "memory", "scc"); } while (0)
#define PG8_STAGE(bufoff, gbase, voff) do { PG8_STAGE1(bufoff, gbase, voff, 0); PG8_STAGE1(bufoff, gbase, voff, 1); } while (0)
#define PG8_LDA(dst, b, h) do { _Pragma("unroll") for (int m = 0; m < 4; ++m) { dst[m].lo = *(const PG8_LAS v4i_t*)(lds + PG8_SA(b, h) + aoff + m * 2048); dst[m].hi = *(const PG8_LAS v4i_t*)(lds + PG8_SA(b, h) + aoff + m * 2048 + 1024); } } while (0)
#define PG8_LDB(dst, b, h) do { _Pragma("unroll") for (int n = 0; n < 2; ++n) { dst[n].lo = *(const PG8_LAS v4i_t*)(lds + PG8_SB(b, h) + boff + n * 2048); dst[n].hi = *(const PG8_LAS v4i_t*)(lds + PG8_SB(b, h) + boff + n * 2048 + 1024); } } while (0)
#define PG8_MMA(ai, bj, At, Bt) do { __builtin_amdgcn_s_setprio(1); _Pragma("unroll") for (int m = 0; m < 4; ++m) _Pragma("unroll") for (int n = 0; n < 2; ++n) { \
        if constexpr (FP8) { acc[ai][bj][m][n] = __builtin_amdgcn_mfma_scale_f32_16x16x128_f8f6f4(Bt[n], At[m], acc[ai][bj][m][n], 0, 0, 0, 0, 0, 0); } \
        else { const v4i_t bl_ = Bt[n].lo, bh_ = Bt[n].hi, al_ = At[m].lo, ah_ = At[m].hi;     \
               acc[ai][bj][m][n] = __builtin_amdgcn_mfma_f32_16x16x32_bf16(__builtin_bit_cast(bf16x8, bl_), __builtin_bit_cast(bf16x8, al_), acc[ai][bj][m][n], 0, 0, 0); \
               acc[ai][bj][m][n] = __builtin_amdgcn_mfma_f32_16x16x32_bf16(__builtin_bit_cast(bf16x8, bh_), __builtin_bit_cast(bf16x8, ah_), acc[ai][bj][m][n], 0, 0, 0); } } \
        __builtin_amdgcn_s_setprio(0); } while (0)
#define PG8_WAIT_V(n) asm volatile("s_waitcnt vmcnt(" #n ")" ::: "memory")
#define PG8_WAIT_L(n) asm volatile("s_waitcnt lgkmcnt(" #n ")" ::: "memory")
#define PG8_BAR __builtin_amdgcn_s_barrier()
#define PG8_SCHED __builtin_amdgcn_sched_barrier(0)
    Unit cur, nxt; int ui = 0;
    if (!S.next(0, cur)) return;
    f32x4 acc[2][2][4][2];
#pragma unroll
    for (int a = 0; a < 2; ++a)
#pragma unroll
        for (int b = 0; b < 2; ++b)
#pragma unroll
            for (int m = 0; m < 4; ++m)
#pragma unroll
                for (int n = 0; n < 2; ++n) acc[a][b][m][n] = (f32x4){0.f, 0.f, 0.f, 0.f};
    v8i_t At[4], B0[2], B1[2];
    const char* cA = S.a_ptr(cur); const char* cB = S.b_ptr(cur);
    S.a_ready(cur);
    if constexpr (SP2) {
        PG8_STAGE(PG8_SB(0, 0), cB, voffB); PG8_STAGE(PG8_SB(0, 1), cB + hstep, voffB); PG8_STAGE(PG8_SA(0, 0), cA, voffA); PG8_STAGE(PG8_SA(0, 1), cA + hstep, voffA);
        if (wr == 1) PG8_BAR;
        PG8_WAIT_V(2); PG8_BAR;
        PG8_STAGE(PG8_SB(1, 0), cB + kstep, voffB); PG8_STAGE(PG8_SA(1, 0), cA + kstep, voffA); PG8_STAGE(PG8_SB(1, 1), cB + hstep + kstep, voffB);
        PG8_WAIT_V(6); PG8_BAR;
    } else {
        PG8_STAGE(PG8_SB(0, 0), cB, voffB); PG8_STAGE(PG8_SA(0, 0), cA, voffA); PG8_STAGE(PG8_SB(0, 1), cB + hstep, voffB); PG8_STAGE(PG8_SA(0, 1), cA + hstep, voffA);
        if (wr == 1) PG8_BAR;
        PG8_WAIT_V(4); PG8_BAR;
        PG8_STAGE(PG8_SB(1, 0), cB + kstep, voffB); PG8_STAGE(PG8_SA(1, 0), cA + kstep, voffA); PG8_STAGE(PG8_SB(1, 1), cB + hstep + kstep, voffB);
        PG8_WAIT_V(6); PG8_BAR;
    }
    for (;;) {
        const bool has_next = S.next(ui + 1, nxt);
        const char* nA = has_next ? S.a_ptr(nxt) : cA; const char* nB = has_next ? S.b_ptr(nxt) : cB;
#pragma unroll 1
        for (int t = 0; t < nt; t += 2) {
            const bool last = (t == nt - 2);
            const char* a1 = cA + (size_t)(t + 1) * kstep;
            const char* a2 = last ? nA : cA + (size_t)(t + 2) * kstep; const char* b2 = last ? nB : cB + (size_t)(t + 2) * kstep;
            const char* a3 = a2 + kstep; const char* b3 = b2 + kstep;
            if (last && has_next) S.a_ready(nxt);
            if constexpr (SP2) {
            PG8_LDB(B0, 0, 0); PG8_LDB(B1, 0, 1); PG8_SCHED; PG8_LDA(At, 0, 0); PG8_STAGE(PG8_SA(1, 1), a1 + hstep, voffA);
            PG8_WAIT_V(8); PG8_WAIT_L(0); PG8_BAR; PG8_MMA(0, 0, At, B0); PG8_MMA(0, 1, At, B1); PG8_BAR; PG8_SCHED;
            PG8_LDA(At, 0, 1); PG8_STAGE(PG8_SB(0, 0), b2, voffB); PG8_STAGE(PG8_SB(0, 1), b2 + hstep, voffB); PG8_STAGE(PG8_SA(0, 0), a2, voffA);
            PG8_WAIT_V(8); PG8_WAIT_L(0); PG8_BAR; PG8_MMA(1, 0, At, B0); PG8_MMA(1, 1, At, B1); PG8_BAR; PG8_SCHED;
            PG8_LDB(B0, 1, 0); PG8_LDB(B1, 1, 1); PG8_SCHED; PG8_LDA(At, 1, 0); PG8_STAGE(PG8_SA(0, 1), a2 + hstep, voffA);
            PG8_WAIT_V(8); PG8_WAIT_L(0); PG8_BAR; PG8_MMA(0, 0, At, B0); PG8_MMA(0, 1, At, B1); PG8_BAR; PG8_SCHED;
            PG8_LDA(At, 1, 1); PG8_STAGE(PG8_SB(1, 0), b3, voffB); PG8_STAGE(PG8_SB(1, 1), b3 + hstep, voffB); PG8_STAGE(PG8_SA(1, 0), a3, voffA);
            PG8_WAIT_V(8); PG8_WAIT_L(0); PG8_BAR; PG8_MMA(1, 0, At, B0); PG8_MMA(1, 1, At, B1); PG8_BAR; PG8_SCHED;
            } else {
            PG8_LDB(B0, 0, 0); PG8_SCHED; PG8_LDA(At, 0, 0); PG8_STAGE(PG8_SA(1, 1), a1 + hstep, voffA);
            PG8_WAIT_L(8); PG8_BAR; PG8_WAIT_L(0); PG8_MMA(0, 0, At, B0); PG8_BAR; PG8_SCHED;
            PG8_LDB(B1, 0, 1); PG8_STAGE(PG8_SB(0, 0), b2, voffB);
            PG8_BAR; PG8_WAIT_L(0); PG8_MMA(0, 1, At, B1); PG8_BAR;
            PG8_LDA(At, 0, 1); PG8_STAGE(PG8_SA(0, 0), a2, voffA);
            PG8_BAR; PG8_WAIT_L(0); PG8_MMA(1, 0, At, B0); PG8_BAR; PG8_SCHED;
            PG8_STAGE(PG8_SB(0, 1), b2 + hstep, voffB);
            PG8_WAIT_V(6); PG8_BAR; PG8_MMA(1, 1, At, B1); PG8_BAR;
            PG8_LDB(B0, 1, 0); PG8_SCHED; PG8_LDA(At, 1, 0); PG8_STAGE(PG8_SA(0, 1), a2 + hstep, voffA);
            PG8_WAIT_L(8); PG8_BAR; PG8_WAIT_L(0); PG8_MMA(0, 0, At, B0); PG8_BAR; PG8_SCHED;
            PG8_LDB(B1, 1, 1); PG8_STAGE(PG8_SB(1, 0), b3, voffB);
            PG8_BAR; PG8_WAIT_L(0); PG8_MMA(0, 1, At, B1); PG8_BAR;
            PG8_LDA(At, 1, 1); PG8_STAGE(PG8_SA(1, 0), a3, voffA);
            PG8_BAR; PG8_WAIT_L(0); PG8_MMA(1, 0, At, B0); PG8_BAR; PG8_SCHED;
            PG8_STAGE(PG8_SB(1, 1), b3 + hstep, voffB);
            PG8_WAIT_V(6); PG8_BAR; PG8_MMA(1, 1, At, B1); PG8_BAR;
            }
        }
        if constexpr (ALIGN_EPI) { if (wr == 0) PG8_BAR; }
        if constexpr (!Epi::AFTER_DRAIN) { int ln_; asm volatile("v_mbcnt_lo_u32_b32 %0, -1, 0\n\tv_mbcnt_hi_u32_b32 %0, -1, %0" : "=v"(ln_));
            E(acc, cur, wr, wc, ln_ & 15, ln_ >> 4); S.done(cur); }
        if (!has_next) break;
#pragma unroll
        for (int a = 0; a < 2; ++a)
#pragma unroll
            for (int b = 0; b < 2; ++b)
#pragma unroll
                for (int m = 0; m < 4; ++m)
#pragma unroll
                    for (int n = 0; n < 2; ++n) acc[a][b][m][n] = (f32x4){0.f, 0.f, 0.f, 0.f};
        cur = nxt; cA = nA; cB = nB; ++ui;
        if constexpr (ALIGN_EPI) { if (wr == 1) PG8_BAR; }
    }
    PG8_WAIT_V(0);
    if constexpr (!ALIGN_EPI) { if (wr == 0) PG8_BAR; }
    PG8_BAR;
    if constexpr (Epi::AFTER_DRAIN) { E.fused(acc, cur, wr, wc, fr, fq, lds, wid, lane); S.done(cur); }
#undef PG8_SA
#undef PG8_SB
#undef PG8_STAGE
#undef PG8_LDA
#undef PG8_LDB
#undef PG8_MMA
#undef PG8_WAIT_V
#undef PG8_WAIT_L
#undef PG8_BAR
#undef PG8_SCHED
}
}

constexpr float WSC_K2048 = 64.f, WSC_K1024 = 32.f, MSCALE = 4.f  , ASCALE = 2.f  ;
__device__ __forceinline__ int dest_row(int map, int n) {
    if (map == 1) { const int seg = n >> 9; const bool qk = (seg == 0) || (seg == 1) || (seg == 3) || (seg == 4) || (seg >= 6 && seg <= 9); if (!qk) return n; const int j = n & 63; return (n & ~63) + ((j < 32) ? 2 * j : 2 * (j - 32) + 1); }
    if (map == 2) return 8 * (n >> 2) + (n & 3);
    if (map == 3) return 8 * (n >> 2) + 4 + (n & 3);
    return n;
}
namespace wconv {
constexpr size_t D_WIN = (size_t)16 << 20, D_WOUT = (size_t)64 << 20, D_WGU = (size_t)80 << 20, D_WDN = (size_t)336 << 20;
struct Tab { const float* w_in; const float* w_out; const float* w_gate; const float* w_up; const float* w_down; unsigned char* ws; int l, n_out, total; };
struct State { int idx, staged, ctr, stride; };
struct Op { const float* src; unsigned char* dst; int N, K, map, n0; float wsc; };
__device__ __forceinline__ void decode(const Tab& T, int idx, Op& o) {
    int r = idx; const int l = T.l;
    if (r < T.n_out) { const int kb = r >> 5, nb = r & 31; o.N = 2048; o.K = 2048; o.map = 0; o.wsc = WSC_K2048; o.n0 = 64 * nb;
        o.src = T.w_out + (size_t)l * 2048 * 2048 + (size_t)(16 * kb) * 2048 + 64 * nb; o.dst = T.ws + D_WOUT + (size_t)l * 2048 * 4096 + 16 * kb; return; }
    r -= T.n_out;
    if (r < 65536) { const int up = r >> 15; r &= 32767; const int mt = l * 16 + (r >> 11), item = r & 2047, kb = item >> 4, nb = item & 15; o.N = 1024; o.K = 2048; o.map = 2 + up; o.wsc = WSC_K2048; o.n0 = 64 * nb;
        o.src = (up ? T.w_up : T.w_gate) + (size_t)mt * 2048 * 1024 + (size_t)(16 * kb) * 1024 + 64 * nb; o.dst = T.ws + D_WGU + (size_t)mt * 2048 * 2048 + 16 * kb; return; }
    r -= 65536;
    if (r < 32768) { const int mt = l * 16 + (r >> 11), item = r & 2047, kb = item >> 5, nb = item & 31; o.N = 2048; o.K = 1024; o.map = 0; o.wsc = WSC_K1024; o.n0 = 64 * nb;
        o.src = T.w_down + (size_t)mt * 1024 * 2048 + (size_t)(16 * kb) * 2048 + 64 * nb; o.dst = T.ws + D_WDN + (size_t)mt * 2048 * 1024 + 16 * kb; return; }
    r -= 32768;
    { const int kb = r / 96, nb = r - 96 * kb; o.N = 6144; o.K = 2048; o.map = 1; o.wsc = WSC_K2048; o.n0 = 64 * nb;
      o.src = T.w_in + (size_t)2048 * 6144 + (size_t)(16 * kb) * 6144 + 64 * nb; o.dst = T.ws + D_WIN + (size_t)6144 * 2048 + 16 * kb; }
}
__device__ __forceinline__ void dma16(const void* sbase, unsigned voff, unsigned lds_dst) { unsigned keep;
    asm volatile("s_mov_b32 %0, m0\n\ts_mov_b32 m0, %3\n\ts_nop 0\n\tglobal_load_lds_dwordx4 %1, %2\n\ts_mov_b32 m0, %0" : "=&s"(keep) : "v"(voff), "s"(sbase), "s"(lds_dst) : "memory"); }
__device__ __forceinline__ void issue(const Tab& T, int idx, unsigned stage, int lane) {
    Op o; decode(T, idx, o);
    const unsigned voff = (unsigned)((lane >> 4) * o.N * 4 + (lane & 15) * 16);
#pragma unroll
    for (int j = 0; j < 4; ++j) dma16(o.src + (size_t)(4 * j) * o.N, voff, (unsigned)__builtin_amdgcn_readfirstlane(stage + 1024u * j));
}
__device__ __forceinline__ void finish(const Tab& T, int idx, unsigned stage, int lane) {
    Op o; decode(T, idx, o);
    typedef __attribute__((address_space(3))) const float* lfp; const lfp sp = (lfp)(uintptr_t)(stage + 4u * lane);
    float f[16];
#pragma unroll
    for (int k = 0; k < 16; ++k) f[k] = sp[64 * k] * o.wsc;
    typedef unsigned u4 __attribute__((ext_vector_type(4)));
    u4 w; w.x = pg8::pk4_fp8(f[0], f[1], f[2], f[3]); w.y = pg8::pk4_fp8(f[4], f[5], f[6], f[7]); w.z = pg8::pk4_fp8(f[8], f[9], f[10], f[11]); w.w = pg8::pk4_fp8(f[12], f[13], f[14], f[15]);
    *(__attribute__((address_space(1))) u4*)(o.dst + (size_t)dest_row(o.map, o.n0 + lane) * o.K) = w;
}
__device__ __forceinline__ void micro(const Tab& T, State& s, unsigned stage, int lane) {
    finish(T, s.staged, stage, lane);
    asm volatile("s_waitcnt lgkmcnt(0)" ::: "memory");
    issue(T, s.idx, stage, lane); s.staged = s.idx; s.idx += s.stride;
}
}

#include <hip/hip_bf16.h>
#include <cmath>
namespace attn_body {
using bf16=__hip_bfloat16;
using bf16x8=__attribute__((ext_vector_type(8)))short;
using s16x4=__attribute__((ext_vector_type(4)))short;
using f32x16=__attribute__((ext_vector_type(16)))float;
using u32x4=__attribute__((ext_vector_type(4)))unsigned;
constexpr int SEQ=16384,D=64,DM=6144;
constexpr int NW=8,QBLK=32,QB=QBLK*NW,KVBLK=64,NQB=SEQ/QB;
constexpr int ATTN_UNIT_ROWS=QB;
__device__ __forceinline__ int crow(int r,int hi){return (r&3)+8*(r>>2)+4*hi;}
#define SBAR() __builtin_amdgcn_sched_barrier(0)
__device__ __forceinline__ void cmask(f32x16&p0,f32x16&p1,int jb,int qrel,int hi){
  const float NEG=-INFINITY; int kb=64*jb+4*hi;
  #pragma unroll
  for(int r=0;r<16;++r){int kv=kb+(r&3)+8*(r>>2); if(kv>qrel)p0[r]=NEG; if(kv+32>qrel)p1[r]=NEG;}
}

constexpr int NSLOT=3, SLOTB=8192;
constexpr int LDS_K=0, LDS_V=NSLOT*SLOTB, LDS_WS=2*NSLOT*SLOTB, LDS_OST=LDS_WS+NW*64*4, LDS_BYTES=LDS_OST+NW*4096;
constexpr float C2=0.125f*1.4426950408889634f;
__device__ __forceinline__ void glds16(const void*gsrc,unsigned lds_dst){unsigned keep;
  asm volatile("s_mov_b32 %0, m0\n\ts_mov_b32 m0, %2\n\ts_nop 0\n\tglobal_load_lds_dwordx4 %1, off\n\ts_mov_b32 m0, %0":"=&s"(keep):"v"(gsrc),"s"(lds_dst):"memory");}
__device__ __forceinline__ void glds16s(const void*sbase,unsigned voff,unsigned lds_dst){unsigned keep;
  asm volatile("s_mov_b32 %0, m0\n\ts_mov_b32 m0, %3\n\ts_nop 0\n\tglobal_load_lds_dwordx4 %1, %2\n\ts_mov_b32 m0, %0":"=&s"(keep):"v"(voff),"s"(sbase),"s"(lds_dst):"memory");}
__device__ __forceinline__ float max3f(float a,float b,float c){float r;asm("v_max3_f32 %0, %1, %2, %3":"=v"(r):"v"(a),"v"(b),"v"(c));return r;}
__device__ __forceinline__ float max2f(float a,float b){float r;asm("v_max_f32_e32 %0, %1, %2":"=v"(r):"v"(a),"v"(b));return r;}
__device__ __forceinline__ float fadd_s(float a,float b){float r;asm("v_add_f32_e32 %0, %1, %2":"=v"(r):"v"(a),"v"(b));return r;}
__device__ __forceinline__ float fsub_s(float a,float b){float r;asm("v_sub_f32_e32 %0, %1, %2":"=v"(r):"v"(a),"v"(b));return r;}
typedef float f32x2_t __attribute__((ext_vector_type(2))); typedef __bf16 bf16x2_t __attribute__((ext_vector_type(2)));
__device__ __forceinline__ unsigned cvtpk_s(float lo,float hi){f32x2_t v={lo,hi};bf16x2_t b=__builtin_convertvector(v,bf16x2_t);return __builtin_bit_cast(unsigned,b);}
#define WAIT_BAR(N) asm volatile("s_waitcnt vmcnt(" #N ") lgkmcnt(0)\n\ts_barrier":::"memory")

__device__ __forceinline__ void qkt(f32x16&p0,f32x16&p1,const char*Kslot,const bf16x8*qr,const f32x16&negm,int r32,int hi){
  const char*kb=Kslot+hi*1024+r32*16;
  #pragma unroll
  for(int d0=0;d0<4;++d0){
    const bf16x8 b0=*reinterpret_cast<const bf16x8*>(kb+d0*2048);
    const bf16x8 b1=*reinterpret_cast<const bf16x8*>(kb+d0*2048+512);
    if(d0==0){p0=__builtin_amdgcn_mfma_f32_32x32x16_bf16(b0,qr[0],negm,0,0,0);p1=__builtin_amdgcn_mfma_f32_32x32x16_bf16(b1,qr[0],negm,0,0,0);}
    else{p0=__builtin_amdgcn_mfma_f32_32x32x16_bf16(b0,qr[d0],p0,0,0,0);p1=__builtin_amdgcn_mfma_f32_32x32x16_bf16(b1,qr[d0],p1,0,0,0);}}
}
__device__ __forceinline__ void qkt_rm(f32x16&p0,f32x16&p1,const char*Kslot,const int ka,const bf16x8*qr,const f32x16&negm){
  #pragma unroll
  for(int d0=0;d0<4;++d0){ const char*kb=Kslot+(ka^(d0<<5));
    const bf16x8 b0=*reinterpret_cast<const bf16x8*>(kb);
    const bf16x8 b1=*reinterpret_cast<const bf16x8*>(kb+4096);
    if(d0==0){p0=__builtin_amdgcn_mfma_f32_32x32x16_bf16(b0,qr[0],negm,0,0,0);p1=__builtin_amdgcn_mfma_f32_32x32x16_bf16(b1,qr[0],negm,0,0,0);}
    else{p0=__builtin_amdgcn_mfma_f32_32x32x16_bf16(b0,qr[d0],p0,0,0,0);p1=__builtin_amdgcn_mfma_f32_32x32x16_bf16(b1,qr[d0],p1,0,0,0);}}
}
typedef __attribute__((address_space(3))) const char* lds_cptr;
typedef short v4i16_t __attribute__((ext_vector_type(4)));
__device__ __forceinline__ void kload8(bf16x8*kf,lds_cptr kp){
  kf[0]=*(const __attribute__((address_space(3))) bf16x8*)(kp);      kf[1]=*(const __attribute__((address_space(3))) bf16x8*)(kp+512);
  kf[2]=*(const __attribute__((address_space(3))) bf16x8*)(kp+2048); kf[3]=*(const __attribute__((address_space(3))) bf16x8*)(kp+2560);
  kf[4]=*(const __attribute__((address_space(3))) bf16x8*)(kp+4096); kf[5]=*(const __attribute__((address_space(3))) bf16x8*)(kp+4608);
  kf[6]=*(const __attribute__((address_space(3))) bf16x8*)(kp+6144); kf[7]=*(const __attribute__((address_space(3))) bf16x8*)(kp+6656);
}
__device__ __forceinline__ void kload2(bf16x8*kf,lds_cptr kp,int j){ kf[2*j]=*(const __attribute__((address_space(3))) bf16x8*)(kp+j*2048); kf[2*j+1]=*(const __attribute__((address_space(3))) bf16x8*)(kp+j*2048+512); }
__device__ __forceinline__ s16x4 vtr(lds_cptr p){ return __builtin_bit_cast(s16x4,__builtin_amdgcn_ds_read_tr16_b64_v4i16((__attribute__((address_space(3))) v4i16_t*)p)); }
__device__ __forceinline__ float rowmax(const f32x16&p0,const f32x16&p1){
  float a=max3f(p0[0],p0[1],p1[0]),b=max3f(p0[2],p0[3],p1[1]);a=max3f(a,p1[2],p1[3]);
  #pragma unroll
  for(int r=4;r<16;r+=4){a=max3f(a,p0[r],p0[r+1]);b=max3f(b,p0[r+2],p0[r+3]);a=max3f(a,p1[r],p1[r+1]);b=max3f(b,p1[r+2],p1[r+3]);}
  const float m=max2f(a,b);
  auto rr=__builtin_amdgcn_permlane32_swap(__float_as_uint(m),__float_as_uint(m),false,false);
  return max2f(__uint_as_float(rr[0]),__uint_as_float(rr[1]));
}
__device__ __forceinline__ void pv(f32x16*o,int vb,bf16x8 pa0,bf16x8 pa1,bf16x8 pa2,bf16x8 pa3){
  #pragma unroll
  for(int d0=0;d0<2;++d0){s16x4 lo[4],hi[4];
    #pragma unroll
    for(int ks=0;ks<4;++ks){
      asm volatile("ds_read_b64_tr_b16 %0,%1 offset:%c2":"=&v"(lo[ks]):"v"(vb),"i"(d0*4096+ks*1024):"memory");
      asm volatile("ds_read_b64_tr_b16 %0,%1 offset:%c2":"=&v"(hi[ks]):"v"(vb),"i"(d0*4096+ks*1024+512):"memory");}
    asm volatile("s_waitcnt lgkmcnt(0)":::"memory");SBAR();
    #define PK(k) (bf16x8){lo[k][0],lo[k][1],lo[k][2],lo[k][3],hi[k][0],hi[k][1],hi[k][2],hi[k][3]}
    o[d0]=__builtin_amdgcn_mfma_f32_32x32x16_bf16(pa0,PK(0),o[d0],0,0,0);
    o[d0]=__builtin_amdgcn_mfma_f32_32x32x16_bf16(pa1,PK(1),o[d0],0,0,0);
    o[d0]=__builtin_amdgcn_mfma_f32_32x32x16_bf16(pa2,PK(2),o[d0],0,0,0);
    o[d0]=__builtin_amdgcn_mfma_f32_32x32x16_bf16(pa3,PK(3),o[d0],0,0,0);
    #undef PK
  }
}

constexpr int ATTN_LDS_BYTES=LDS_BYTES;


#ifndef ATT_STAGGER
#define ATT_STAGGER 0
#endif
constexpr int XSLOTS=4, X_K=0, X_V=XSLOTS*SLOTB, X_WS=X_V+2*XSLOTS*SLOTB, X_LDS_BYTES=X_WS+NW*256;
__device__ __forceinline__ void pv4(f32x16*o,int vb,bf16x8 pa0,bf16x8 pa1,bf16x8 pa2,bf16x8 pa3){
  #pragma unroll
  for(int d0=0;d0<4;++d0){s16x4 lo[4],hi[4];
    #pragma unroll
    for(int ks=0;ks<4;++ks){
      asm volatile("ds_read_b64_tr_b16 %0,%1 offset:%c2":"=&v"(lo[ks]):"v"(vb),"i"(d0*4096+ks*1024):"memory");
      asm volatile("ds_read_b64_tr_b16 %0,%1 offset:%c2":"=&v"(hi[ks]):"v"(vb),"i"(d0*4096+ks*1024+512):"memory");}
    asm volatile("s_waitcnt lgkmcnt(0)":::"memory");SBAR();
    #define PK(k) (bf16x8){lo[k][0],lo[k][1],lo[k][2],lo[k][3],hi[k][0],hi[k][1],hi[k][2],hi[k][3]}
    o[d0]=__builtin_amdgcn_mfma_f32_32x32x16_bf16(pa0,PK(0),o[d0],0,0,0);
    o[d0]=__builtin_amdgcn_mfma_f32_32x32x16_bf16(pa1,PK(1),o[d0],0,0,0);
    o[d0]=__builtin_amdgcn_mfma_f32_32x32x16_bf16(pa2,PK(2),o[d0],0,0,0);
    o[d0]=__builtin_amdgcn_mfma_f32_32x32x16_bf16(pa3,PK(3),o[d0],0,0,0);
    #undef PK
  }
}
template<int THRL> __device__ __forceinline__ void attn_unit128(int qb,const bf16*Q,const bf16*__restrict__ K,const bf16*__restrict__ V,bf16*O,int opitch,char*shm,const int wid){
  int lane; asm volatile("v_mbcnt_lo_u32_b32 %0, -1, 0\n\tv_mbcnt_hi_u32_b32 %0, -1, %0":"=v"(lane)); const int r32=lane&31,hi=lane>>5;
  const int q0=qb*QB;
  const bf16*Qw=Q+(long)(q0+wid*QBLK)*DM;
  const unsigned lds0=(unsigned)(uintptr_t)shm;
  float*wsf=(float*)(shm+X_WS)+wid*64;
  const unsigned koff=(unsigned)(lane*DM+wid*8)*2u;
  const unsigned voff=(unsigned)((16*(wid&3)+(lane>>2))*DM+(wid>>2)*32+(lane&3)*8)*2u;
  const unsigned kdst=lds0+X_K+wid*1024, vdst=lds0+X_V+wid*1024;
  #define DMA_K(t,slot) glds16s(K+(long)(t)*KVBLK*DM,koff,(unsigned)__builtin_amdgcn_readfirstlane(kdst+(slot)))
  #define DMA_V(t,slot) do{ glds16s(V+(long)(t)*KVBLK*DM,voff,(unsigned)__builtin_amdgcn_readfirstlane(vdst+2*(slot))); glds16s(V+(long)(t)*KVBLK*DM+64,voff,(unsigned)__builtin_amdgcn_readfirstlane(vdst+2*(slot)+8192)); }while(0)
  const int vb0=(int)(lds0+X_V)+((lane>>4)&1)*32+(lane&3)*8+(4*hi+((lane&15)>>2))*64;
  const char*Kbase=shm+X_K; bf16x8 kf[8];
  const lds_cptr shm3=(lds_cptr)shm; const lds_cptr kp0=shm3+X_K+hi*1024+r32*16; const lds_cptr vp0=shm3+X_V+((lane>>4)&1)*32+(lane&3)*8+(4*hi+((lane&15)>>2))*64;
  const int NT=(q0+QB)/KVBLK;
  DMA_K(0,0);DMA_V(0,0);DMA_K(1,SLOTB);
  bf16x8 qr[4];
  #pragma unroll
  for(int d0=0;d0<4;++d0)qr[d0]=*reinterpret_cast<const bf16x8*>(&Qw[(long)r32*DM+d0*16+hi*8]);
  float mhat=0.f,l_reg=0.f;f32x16 o[4];o[0]=f32x16{};o[1]=f32x16{};o[2]=f32x16{};o[3]=f32x16{};
  float zz_=0.f; asm volatile("":"+v"(zz_)); f32x16 negm;
  _Pragma("unroll") for(int r=0;r<16;++r)negm[r]=zz_; asm volatile("":"+v"(negm));
  const int qrel=wid*QBLK+r32;
  #define CMASK(P0,P1,t) do{int jb_=(t)-(NT-4); if(jb_>=0)cmask(P0,P1,jb_,qrel,hi);}while(0)
  bool resc=false;
  #define RESC() do{ if(resc){ asm volatile("s_waitcnt lgkmcnt(0)":::"memory"); \
      _Pragma("unroll") for(int d_=0;d_<4;++d_) _Pragma("unroll") for(int r=0;r<16;++r)o[d_][r]*=wsf[crow(r,hi)]; } }while(0)
  f32x16 C0,C1; u32x4 pw0,pw1,pw2,pw3;
  int sl_prev=0,sl_cur=0,sl_next=SLOTB;
  #define ROT() do{sl_prev=sl_cur;sl_cur=sl_next;sl_next=(sl_next==(XSLOTS-1)*SLOTB)?0:sl_next+SLOTB;}while(0)
  #define PKW(P,B) cvtpk_s(P[B],P[B+1])
  DMA_K(2,2*SLOTB);
  WAIT_BAR(4);
  qkt(C0,C1,Kbase,qr,negm,r32,hi);asm volatile("s_nop 15\n\ts_nop 7":"+v"(C0),"+v"(C1));CMASK(C0,C1,0);
  { const float rm=rowmax(C0,C1); const float dl=rm; mhat=fadd_s(mhat,dl);
    _Pragma("unroll") for(int r=0;r<16;++r){C0[r]=fsub_s(C0[r],dl);C1[r]=fsub_s(C1[r],dl);}
    _Pragma("unroll") for(int r=0;r<16;++r)negm[r]=-mhat; asm volatile("":"+v"(negm));
    _Pragma("unroll") for(int r=0;r<16;++r){C0[r]=__builtin_amdgcn_exp2f(C0[r]);C1[r]=__builtin_amdgcn_exp2f(C1[r]);}
    float sacc=C0[0]+C0[1]; _Pragma("unroll") for(int r=2;r<16;++r)sacc+=C0[r]; _Pragma("unroll") for(int r=0;r<16;++r)sacc+=C1[r]; l_reg+=sacc;
    pw0=(u32x4){PKW(C0,0),PKW(C0,2),PKW(C0,4),PKW(C0,6)};pw1=(u32x4){PKW(C0,8),PKW(C0,10),PKW(C0,12),PKW(C0,14)};pw2=(u32x4){PKW(C1,0),PKW(C1,2),PKW(C1,4),PKW(C1,6)};pw3=(u32x4){PKW(C1,8),PKW(C1,10),PKW(C1,12),PKW(C1,14)}; }
  WAIT_BAR(0);
  DMA_K(3,3*SLOTB);DMA_V(1,SLOTB);
  ROT();
  kload8(kf,kp0+sl_cur);
  WAIT_BAR(3);
  s16x4 vlo[8],vhi[8];
  #define PAF(k) __builtin_bit_cast(bf16x8,pw##k)
  #define VFR(i) (bf16x8){vlo[i][0],vlo[i][1],vlo[i][2],vlo[i][3],vhi[i][0],vhi[i][1],vhi[i][2],vhi[i][3]}
  #define PIN(x) asm volatile("":"+v"(x))
  #define MX3(a,b,c) __builtin_fmaxf(__builtin_fmaxf((a),(b)),(c))
  #define EX(v) __builtin_amdgcn_exp2f(v)
  #define VRDF(s,d,ks) do{ vlo[s]=vtr(vp_+((d)*4096+(ks)*1024)); vhi[s]=vtr(vp_+((d)*4096+(ks)*1024+512)); }while(0)
  #define GA(s,MF) do{ VRDF(s,(s)&3,(s)>>2); SBAR(); MF; SBAR(); }while(0)
  #define EX2(X,B) do{ X[B]=EX(X[B]); X[B+1]=EX(X[B+1]); PIN(X); }while(0)
  #define PK1(W,j,X,B) do{ sacc+=X[B]; sacc+=X[B+1]; W[j]=PKW(X,B); PIN(W); PIN(sacc); }while(0)
  #define KRD(G,j) do{ if(G){ kload2(kf,kp0+sl_next,j); } }while(0)
  #define STEP(t,GK,GV,GL) do{ SBAR(); \
    const lds_cptr vp_=vp0+2*sl_prev; \
    GA(0,C0=__builtin_amdgcn_mfma_f32_32x32x16_bf16(kf[0],qr[0],negm,0,0,0)); \
    GA(1,C1=__builtin_amdgcn_mfma_f32_32x32x16_bf16(kf[1],qr[0],negm,0,0,0)); \
    GA(2,C0=__builtin_amdgcn_mfma_f32_32x32x16_bf16(kf[2],qr[1],C0,0,0,0)); \
    GA(3,C1=__builtin_amdgcn_mfma_f32_32x32x16_bf16(kf[3],qr[1],C1,0,0,0)); \
    GA(4,C0=__builtin_amdgcn_mfma_f32_32x32x16_bf16(kf[4],qr[2],C0,0,0,0)); \
    GA(5,C1=__builtin_amdgcn_mfma_f32_32x32x16_bf16(kf[5],qr[2],C1,0,0,0)); \
    GA(6,C0=__builtin_amdgcn_mfma_f32_32x32x16_bf16(kf[6],qr[3],C0,0,0,0)); \
    GA(7,C1=__builtin_amdgcn_mfma_f32_32x32x16_bf16(kf[7],qr[3],C1,0,0,0)); \
    if(GK){DMA_K((t)+3,sl_prev);} if(GV){DMA_V((t)+1,sl_next);} \
    CMASK(C0,C1,t); \
    { float a=MX3(C0[0],C0[1],C1[0]),b=MX3(C0[2],C0[3],C1[1]); a=MX3(a,C1[2],C1[3]); \
      _Pragma("unroll") for(int r=4;r<16;r+=4){a=MX3(a,C0[r],C0[r+1]);b=MX3(b,C0[r+2],C0[r+3]);a=MX3(a,C1[r],C1[r+1]);b=MX3(b,C1[r+2],C1[r+3]);} \
      float rm=__builtin_fmaxf(a,b); { auto rr=__builtin_amdgcn_permlane32_swap(__float_as_uint(rm),__float_as_uint(rm),false,false); rm=__builtin_fmaxf(__uint_as_float(rr[0]),__uint_as_float(rr[1])); } \
      resc=false; \
      if(__builtin_expect(__any(rm>(float)THRL),0)){ const float dl=__builtin_fmaxf(rm,0.f); mhat+=dl; \
        _Pragma("unroll") for(int r=0;r<16;++r){C0[r]-=dl;C1[r]-=dl;} \
        _Pragma("unroll") for(int r=0;r<16;++r)negm[r]=-mhat; asm volatile("":"+v"(negm)); \
        const float f=__builtin_amdgcn_exp2f(-dl); l_reg*=f; if(hi==0)wsf[r32]=f; resc=true; } } \
    SBAR(); MIDBAR(t); \
    float sacc=0.f; u32x4 nw0=(u32x4){0u,0u,0u,0u},nw1=nw0,nw2=nw0,nw3=nw0; \
    o[0]=__builtin_amdgcn_mfma_f32_32x32x16_bf16(PAF(0),VFR(0),o[0],0,0,0); VRDF(0,0,2); EX2(C0,0); SBAR(); \
    o[1]=__builtin_amdgcn_mfma_f32_32x32x16_bf16(PAF(0),VFR(1),o[1],0,0,0); VRDF(1,1,2); EX2(C0,2); SBAR(); \
    o[2]=__builtin_amdgcn_mfma_f32_32x32x16_bf16(PAF(0),VFR(2),o[2],0,0,0); VRDF(2,2,2); EX2(C0,4); SBAR(); \
    o[3]=__builtin_amdgcn_mfma_f32_32x32x16_bf16(PAF(0),VFR(3),o[3],0,0,0); VRDF(3,3,2); EX2(C0,6); SBAR(); \
    o[0]=__builtin_amdgcn_mfma_f32_32x32x16_bf16(PAF(1),VFR(4),o[0],0,0,0); VRDF(4,0,3); EX2(C0,8);  PK1(nw0,0,C0,0); SBAR(); \
    o[1]=__builtin_amdgcn_mfma_f32_32x32x16_bf16(PAF(1),VFR(5),o[1],0,0,0); VRDF(5,1,3); EX2(C0,10); PK1(nw0,1,C0,2); SBAR(); \
    o[2]=__builtin_amdgcn_mfma_f32_32x32x16_bf16(PAF(1),VFR(6),o[2],0,0,0); VRDF(6,2,3); EX2(C0,12); PK1(nw0,2,C0,4); SBAR(); \
    o[3]=__builtin_amdgcn_mfma_f32_32x32x16_bf16(PAF(1),VFR(7),o[3],0,0,0); VRDF(7,3,3); EX2(C0,14); PK1(nw0,3,C0,6); SBAR(); \
    o[0]=__builtin_amdgcn_mfma_f32_32x32x16_bf16(PAF(2),VFR(0),o[0],0,0,0); KRD(GL,0); EX2(C1,0);  PK1(nw1,0,C0,8);  SBAR(); \
    o[1]=__builtin_amdgcn_mfma_f32_32x32x16_bf16(PAF(2),VFR(1),o[1],0,0,0); KRD(GL,1); EX2(C1,2);  PK1(nw1,1,C0,10); SBAR(); \
    o[2]=__builtin_amdgcn_mfma_f32_32x32x16_bf16(PAF(2),VFR(2),o[2],0,0,0); KRD(GL,2); EX2(C1,4);  PK1(nw1,2,C0,12); SBAR(); \
    o[3]=__builtin_amdgcn_mfma_f32_32x32x16_bf16(PAF(2),VFR(3),o[3],0,0,0); KRD(GL,3); EX2(C1,6);  PK1(nw1,3,C0,14); SBAR(); \
    o[0]=__builtin_amdgcn_mfma_f32_32x32x16_bf16(PAF(3),VFR(4),o[0],0,0,0); EX2(C1,8);  PK1(nw2,0,C1,0); SBAR(); \
    o[1]=__builtin_amdgcn_mfma_f32_32x32x16_bf16(PAF(3),VFR(5),o[1],0,0,0); EX2(C1,10); PK1(nw2,1,C1,2); SBAR(); \
    o[2]=__builtin_amdgcn_mfma_f32_32x32x16_bf16(PAF(3),VFR(6),o[2],0,0,0); EX2(C1,12); PK1(nw2,2,C1,4); PK1(nw3,0,C1,8); SBAR(); \
    o[3]=__builtin_amdgcn_mfma_f32_32x32x16_bf16(PAF(3),VFR(7),o[3],0,0,0); EX2(C1,14); PK1(nw2,3,C1,6); PK1(nw3,1,C1,10); SBAR(); \
    PK1(nw3,2,C1,12); PK1(nw3,3,C1,14); l_reg+=sacc; pw0=nw0; pw1=nw1; pw2=nw2; pw3=nw3; \
    }while(0)
  #define ENDW(tt) do{ if((tt)+3<NT){WAIT_BAR(3);} else if((tt)+2<NT){WAIT_BAR(2);} else {WAIT_BAR(0);} }while(0)
  int t=1;
  #undef CMASK
  #define CMASK(P0,P1,t) do{}while(0)
  const bool grpB=ATT_STAGGER&&(wid>=4);
  #define MIDBAR(tt) do{ if(grpB){ WAIT_BAR(3); } }while(0)
  for(;t<NT-4;++t){ STEP(t,true,true,true); if(!grpB){ WAIT_BAR(3); } RESC(); ROT(); }
  #undef MIDBAR
  #undef CMASK
  #define CMASK(P0,P1,t) do{int jb_=(t)-(NT-4); if(jb_>=0)cmask(P0,P1,jb_,qrel,hi);}while(0)
  #define MIDBAR(tt) do{ if(grpB){ ENDW(tt); } }while(0)
  for(;t<NT-1;++t){ STEP(t,(t+3<NT),(t+1<NT),(t+1<NT)); if(!grpB){ ENDW(t); } RESC(); ROT(); }
  #undef MIDBAR
  #define MIDBAR(tt) do{}while(0)
  STEP(NT-1,false,false,false); RESC();
  #undef MIDBAR
  SBAR(); pv4(o,vb0+2*sl_cur,PAF(0),PAF(1),PAF(2),PAF(3));
  #undef PKW
  #undef PAF
  #undef VFR
  #undef PIN
  #undef MX3
  #undef EX
  #undef VRDF
  #undef GA
  #undef EX2
  #undef PK1
  #undef KRD
  #undef STEP
  #undef ENDW
  {auto rr=__builtin_amdgcn_permlane32_swap(__float_as_uint(l_reg),__float_as_uint(l_reg),false,false);l_reg=__uint_as_float(rr[0])+__uint_as_float(rr[1]);}
  if(hi==0)wsf[32+r32]=l_reg;asm volatile("s_waitcnt lgkmcnt(0)":::"memory");
  { bf16*Of=O+(long)(q0+wid*QBLK)*opitch;
    #pragma unroll
    for(int r=0;r<16;++r){const int orow=crow(r,hi); const float rl=__builtin_amdgcn_rcpf(wsf[32+orow]);
      #pragma unroll
      for(int d0=0;d0<4;++d0)Of[(long)orow*opitch+d0*32+r32]=__float2bfloat16(o[d0][r]*rl);} }
  asm volatile("s_waitcnt lgkmcnt(0)\n\ts_barrier":::"memory");
  #undef DMA_K
  #undef DMA_V
  #undef CMASK
  #undef RESC
  #undef ROT
}

typedef int v8i_t __attribute__((ext_vector_type(8))); typedef int v4i_t __attribute__((ext_vector_type(4)));
constexpr float PV8_VSCALE=16.f, PV8_PBIAS=3.f;
constexpr int Y_K=0, Y_V=XSLOTS*SLOTB, Y_WS=Y_V+XSLOTS*SLOTB, Y_LDS_BYTES=Y_WS+NW*256;
template<int THRL,bool HOST> __device__ __forceinline__ void attn_unit128p8(int qb,const bf16*Q,const bf16*__restrict__ K,const unsigned char*__restrict__ VT,bf16*O,int opitch,char*shm,const int wid,const wconv::Tab&wct,wconv::State&wcs,const unsigned wstage){
  int lane; asm volatile("v_mbcnt_lo_u32_b32 %0, -1, 0\n\tv_mbcnt_hi_u32_b32 %0, -1, %0":"=v"(lane)); const int r32=lane&31,hi=lane>>5;
  const int q0=qb*QB;
  const bf16*Qw=Q+(long)(q0+wid*QBLK)*DM;
  const unsigned lds0=(unsigned)(uintptr_t)shm;
  float*wsf=(float*)(shm+Y_WS)+wid*64;
  const unsigned koff=(unsigned)(lane*DM+wid*8)*2u;
  const unsigned voff=(unsigned)(wid*1024+lane*16);
  const unsigned kdst=lds0+Y_K+wid*1024, vdst=lds0+Y_V+wid*1024;
  #define DMA_K(t,slot) glds16s(K+(long)(t)*KVBLK*DM,koff,(unsigned)__builtin_amdgcn_readfirstlane(kdst+(slot)))
  #define DMA_V(t,slot) glds16s(VT+(long)(t)*8192,voff,(unsigned)__builtin_amdgcn_readfirstlane(vdst+(slot)))
  const char*Kbase=shm+Y_K; bf16x8 kf[8];
  const lds_cptr shm3=(lds_cptr)shm; const lds_cptr kp0=shm3+Y_K+hi*1024+r32*16;
  const int sw_=(r32>>2)&3; const lds_cptr vq0=shm3+Y_V+r32*64+((2*hi)^sw_)*16, vq1=shm3+Y_V+r32*64+(((2*hi)^sw_)^1)*16;
  const int NT=(q0+QB)/KVBLK;
  DMA_K(0,0);DMA_V(0,0);DMA_K(1,SLOTB);
  bf16x8 qr[4];
  #pragma unroll
  for(int d0=0;d0<4;++d0)qr[d0]=*reinterpret_cast<const bf16x8*>(&Qw[(long)r32*DM+d0*16+hi*8]);
  float mhat=0.f,l_reg=0.f;f32x16 o[4];o[0]=f32x16{};o[1]=f32x16{};o[2]=f32x16{};o[3]=f32x16{};
  float zz_=0.f; asm volatile("":"+v"(zz_)); f32x16 negm;
  _Pragma("unroll") for(int r=0;r<16;++r)negm[r]=zz_; asm volatile("":"+v"(negm));
  const int qrel=wid*QBLK+r32;
  #define CMASK(P0,P1,t) do{int jb_=(t)-(NT-4); if(jb_>=0)cmask(P0,P1,jb_,qrel,hi);}while(0)
  bool resc=false;
  #define RESC() do{ if(resc){ asm volatile("s_waitcnt lgkmcnt(0)":::"memory"); \
      _Pragma("unroll") for(int d_=0;d_<4;++d_) _Pragma("unroll") for(int r=0;r<16;++r)o[d_][r]*=wsf[crow(r,hi)]; } }while(0)
  f32x16 C0,C1; v8i_t pw;
  int sl_prev=0,sl_cur=0,sl_next=SLOTB;
  #define ROT() do{sl_prev=sl_cur;sl_cur=sl_next;sl_next=(sl_next==(XSLOTS-1)*SLOTB)?0:sl_next+SLOTB;}while(0)
  #define PK8(X,B) ({ int w_; asm volatile("":"=v"(w_)); w_=__builtin_amdgcn_cvt_pk_fp8_f32(X[B],X[(B)+1],w_,false); __builtin_amdgcn_cvt_pk_fp8_f32(X[(B)+2],X[(B)+3],w_,true); })
  #define PKALL() do{ pw=(v8i_t){PK8(C0,0),PK8(C0,4),PK8(C0,8),PK8(C0,12),PK8(C1,0),PK8(C1,4),PK8(C1,8),PK8(C1,12)}; }while(0)
  DMA_K(2,2*SLOTB);
  WAIT_BAR(3);
  qkt(C0,C1,Kbase,qr,negm,r32,hi);asm volatile("s_nop 15\n\ts_nop 7":"+v"(C0),"+v"(C1));CMASK(C0,C1,0);
  { const float rm=rowmax(C0,C1); const float dl=rm-PV8_PBIAS; mhat=fadd_s(mhat,dl);
    _Pragma("unroll") for(int r=0;r<16;++r){C0[r]=fsub_s(C0[r],dl);C1[r]=fsub_s(C1[r],dl);}
    _Pragma("unroll") for(int r=0;r<16;++r)negm[r]=-mhat; asm volatile("":"+v"(negm));
    _Pragma("unroll") for(int r=0;r<16;++r){C0[r]=__builtin_amdgcn_exp2f(C0[r]);C1[r]=__builtin_amdgcn_exp2f(C1[r]);}
    float sacc=C0[0]+C0[1]; _Pragma("unroll") for(int r=2;r<16;++r)sacc+=C0[r]; _Pragma("unroll") for(int r=0;r<16;++r)sacc+=C1[r]; l_reg+=sacc;
    pw=(v8i_t){PK8(C0,0),PK8(C0,4),PK8(C0,8),PK8(C0,12),PK8(C1,0),PK8(C1,4),PK8(C1,8),PK8(C1,12)}; }
  WAIT_BAR(0);
  DMA_K(3,3*SLOTB);DMA_V(1,SLOTB);
  ROT();
  kload8(kf,kp0+sl_cur);
  WAIT_BAR(2);
  v8i_t vf[4];
  #define PIN(x) asm volatile("":"+v"(x))
  #define MX3(a,b,c) __builtin_fmaxf(__builtin_fmaxf((a),(b)),(c))
  #define EX(v) __builtin_amdgcn_exp2f(v)
  #define VRL(d) do{ vf[d].lo=*(const __attribute__((address_space(3))) v4i_t*)(vq0+sl_prev+(d)*2048); }while(0)
  #define VRH(d) do{ vf[d].hi=*(const __attribute__((address_space(3))) v4i_t*)(vq1+sl_prev+(d)*2048); }while(0)
  #define EX8(X,B) do{ _Pragma("unroll") for(int e_=0;e_<8;++e_)X[(B)+e_]=EX(X[(B)+e_]); PIN(X); }while(0)
  #define SM8(X,B) do{ _Pragma("unroll") for(int e_=0;e_<8;++e_)sacc+=X[(B)+e_]; PIN(sacc); }while(0)
  #define KRD(G,j) do{ if(G){ kload2(kf,kp0+sl_next,j); } }while(0)
  #define MF8(d) o[d]=__builtin_amdgcn_mfma_scale_f32_32x32x64_f8f6f4(pw,vf[d],o[d],0,0,0,0,0,0)
  #define STEP(t,GK,GV,GL) do{ SBAR(); \
    VRL(0); SBAR(); C0=__builtin_amdgcn_mfma_f32_32x32x16_bf16(kf[0],qr[0],negm,0,0,0); SBAR(); \
    VRH(0); SBAR(); C1=__builtin_amdgcn_mfma_f32_32x32x16_bf16(kf[1],qr[0],negm,0,0,0); SBAR(); \
    VRL(1); SBAR(); C0=__builtin_amdgcn_mfma_f32_32x32x16_bf16(kf[2],qr[1],C0,0,0,0); SBAR(); \
    VRH(1); SBAR(); C1=__builtin_amdgcn_mfma_f32_32x32x16_bf16(kf[3],qr[1],C1,0,0,0); SBAR(); \
    VRL(2); SBAR(); C0=__builtin_amdgcn_mfma_f32_32x32x16_bf16(kf[4],qr[2],C0,0,0,0); SBAR(); \
    VRH(2); SBAR(); C1=__builtin_amdgcn_mfma_f32_32x32x16_bf16(kf[5],qr[2],C1,0,0,0); SBAR(); \
    VRL(3); SBAR(); C0=__builtin_amdgcn_mfma_f32_32x32x16_bf16(kf[6],qr[3],C0,0,0,0); SBAR(); \
    VRH(3); SBAR(); C1=__builtin_amdgcn_mfma_f32_32x32x16_bf16(kf[7],qr[3],C1,0,0,0); SBAR(); \
    if(GK){DMA_K((t)+3,sl_prev);} if(GV){DMA_V((t)+1,sl_next);} \
    CMASK(C0,C1,t); \
    SBAR(); \
    float sacc=0.f; \
    MF8(0); KRD(GL,0); EX8(C0,0); SM8(C0,0); SBAR(); \
    MF8(1); KRD(GL,1); EX8(C0,8); SM8(C0,8); SBAR(); \
    MF8(2); KRD(GL,2); EX8(C1,0); SM8(C1,0); SBAR(); \
    MF8(3); KRD(GL,3); EX8(C1,8); SM8(C1,8); SBAR(); \
    PKALL(); \
    resc=false; \
    if(__builtin_expect(__any(sacc>256.f),0)){                  \
      float a=MX3(C0[0],C0[1],C1[0]),b=MX3(C0[2],C0[3],C1[1]); a=MX3(a,C1[2],C1[3]); \
      _Pragma("unroll") for(int r=4;r<16;r+=4){a=MX3(a,C0[r],C0[r+1]);b=MX3(b,C0[r+2],C0[r+3]);a=MX3(a,C1[r],C1[r+1]);b=MX3(b,C1[r+2],C1[r+3]);} \
      float rm=__builtin_fmaxf(a,b); { auto rr=__builtin_amdgcn_permlane32_swap(__float_as_uint(rm),__float_as_uint(rm),false,false); rm=__builtin_fmaxf(__uint_as_float(rr[0]),__uint_as_float(rr[1])); } \
      const float dl=__builtin_fmaxf(__builtin_amdgcn_logf(rm)-PV8_PBIAS,0.f); mhat+=dl; \
      _Pragma("unroll") for(int r=0;r<16;++r)negm[r]=-mhat; asm volatile("":"+v"(negm)); \
      const float f=__builtin_amdgcn_exp2f(-dl); l_reg*=f; sacc*=f; if(hi==0)wsf[r32]=f; resc=true; \
      _Pragma("unroll") for(int r=0;r<16;++r){C0[r]*=f;C1[r]*=f;} \
      PKALL(); } \
    l_reg+=sacc; \
    }while(0)
  #define ENDW(tt) do{ if((tt)+3<NT){WAIT_BAR(2);} else if((tt)+2<NT){WAIT_BAR(1);} else {WAIT_BAR(0);} }while(0)
  int t=1;
  #undef CMASK
  #define CMASK(P0,P1,t) do{}while(0)
  for(;t<NT-4;++t){ STEP(t,true,true,true);
    if(HOST&&((wcs.ctr++&7)==0)&&wcs.idx<wct.total){ wconv::micro(wct,wcs,wstage,lane); WAIT_BAR(7); }
    else{ WAIT_BAR(2); }
    RESC(); ROT(); }
  #undef CMASK
  #define CMASK(P0,P1,t) do{int jb_=(t)-(NT-4); if(jb_>=0)cmask(P0,P1,jb_,qrel,hi);}while(0)
  for(;t<NT-1;++t){ STEP(t,(t+3<NT),(t+1<NT),(t+1<NT)); ENDW(t); RESC(); ROT(); }
  STEP(NT-1,false,false,false); RESC();
  { sl_prev=sl_cur; SBAR();
    VRL(0);VRH(0);VRL(1);VRH(1);VRL(2);VRH(2);VRL(3);VRH(3); SBAR(); MF8(0);MF8(1);MF8(2);MF8(3); }
  #undef PK8
  #undef PKALL
  #undef PIN
  #undef MX3
  #undef EX
  #undef VRL
  #undef VRH
  #undef EX8
  #undef SM8
  #undef KRD
  #undef MF8
  #undef STEP
  #undef ENDW
  {auto rr=__builtin_amdgcn_permlane32_swap(__float_as_uint(l_reg),__float_as_uint(l_reg),false,false);l_reg=__uint_as_float(rr[0])+__uint_as_float(rr[1]);}
  if(hi==0)wsf[32+r32]=l_reg;asm volatile("s_waitcnt lgkmcnt(0)":::"memory");
  { bf16*Of=O+(long)(q0+wid*QBLK)*opitch;
    #pragma unroll
    for(int r=0;r<16;++r){const int orow=crow(r,hi); const float rl=__builtin_amdgcn_rcpf(wsf[32+orow])*(1.f/PV8_VSCALE);
      #pragma unroll
      for(int d0=0;d0<4;++d0)Of[(long)orow*opitch+d0*32+r32]=__float2bfloat16(o[d0][r]*rl);} }
  asm volatile("s_waitcnt lgkmcnt(0)\n\ts_barrier":::"memory");
  #undef DMA_K
  #undef DMA_V
  #undef CMASK
  #undef RESC
  #undef ROT
}

template<int THRL,bool HOST> __device__ __forceinline__ void attn_unit128q8(int qb,const bf16*Q,const unsigned char*__restrict__ K8,const unsigned char*__restrict__ VT,bf16*O,int opitch,char*shm,const int wid,const wconv::Tab&wct,wconv::State&wcs,const unsigned wstage){
  int lane; asm volatile("v_mbcnt_lo_u32_b32 %0, -1, 0\n\tv_mbcnt_hi_u32_b32 %0, -1, %0":"=v"(lane)); const int r32=lane&31,hi=lane>>5;
  const int q0=qb*QB;
  const bf16*Qw=Q+(long)(q0+wid*QBLK)*DM;
  const unsigned lds0=(unsigned)(uintptr_t)shm;
  float*wsf=(float*)(shm+Y_WS)+wid*64;
  const unsigned koff=(unsigned)((wid&3)*1024+lane*16);
  const unsigned voff=(unsigned)(wid*1024+lane*16);
  const unsigned kdst=lds0+Y_K+(wid&3)*1024, vdst=lds0+Y_V+wid*1024;
  #define DMA_K(t,slot) glds16s(K8+(long)(t)*4096,koff,(unsigned)__builtin_amdgcn_readfirstlane(kdst+(slot)))
  #define DMA_V(t,slot) glds16s(VT+(long)(t)*8192,voff,(unsigned)__builtin_amdgcn_readfirstlane(vdst+(slot)))
  v8i_t kf8[2];
  const lds_cptr shm3=(lds_cptr)shm;
  const int sw_=(r32>>2)&3; const lds_cptr vq0=shm3+Y_V+r32*64+((2*hi)^sw_)*16, vq1=shm3+Y_V+r32*64+(((2*hi)^sw_)^1)*16; const lds_cptr kq0=vq0+(Y_K-Y_V), kq1=vq1+(Y_K-Y_V);
  const int NT=(q0+QB)/KVBLK;
  DMA_K(0,0);DMA_V(0,0);DMA_K(1,SLOTB);
  v8i_t q8;
  { u32x4 w_[4];
    #pragma unroll
    for(int i=0;i<4;++i)w_[i]=*reinterpret_cast<const u32x4*>(&Qw[(long)r32*DM+hi*32+8*i]);
    #define BL(x) __uint_as_float((x)<<16)
    #define BH(x) __uint_as_float((x)&0xffff0000u)
    #define Q4(a,b) ({ int w2_=0; w2_=__builtin_amdgcn_cvt_pk_fp8_f32(BL(a),BH(a),w2_,false); __builtin_amdgcn_cvt_pk_fp8_f32(BL(b),BH(b),w2_,true); })
    q8=(v8i_t){Q4(w_[0][0],w_[0][1]),Q4(w_[0][2],w_[0][3]),Q4(w_[1][0],w_[1][1]),Q4(w_[1][2],w_[1][3]),Q4(w_[2][0],w_[2][1]),Q4(w_[2][2],w_[2][3]),Q4(w_[3][0],w_[3][1]),Q4(w_[3][2],w_[3][3])};
    #undef BL
    #undef BH
    #undef Q4
  }
  #define KLD(b,sl) do{ kf8[b].lo=*(const __attribute__((address_space(3))) v4i_t*)(kq0+(sl)+(b)*2048); kf8[b].hi=*(const __attribute__((address_space(3))) v4i_t*)(kq1+(sl)+(b)*2048); }while(0)
  #define QK8(b) __builtin_amdgcn_mfma_scale_f32_32x32x64_f8f6f4(kf8[b],q8,negm,0,0,0,0,0,0)
  float mhat=0.f,l_reg=0.f;f32x16 o[4];o[0]=f32x16{};o[1]=f32x16{};o[2]=f32x16{};o[3]=f32x16{};
  float zz_=0.f; asm volatile("":"+v"(zz_)); f32x16 negm;
  _Pragma("unroll") for(int r=0;r<16;++r)negm[r]=zz_; asm volatile("":"+v"(negm));
  const int qrel=wid*QBLK+r32;
  #define CMASK(P0,P1,t) do{int jb_=(t)-(NT-4); if(jb_>=0)cmask(P0,P1,jb_,qrel,hi);}while(0)
  bool resc=false;
  #define RESC() do{ if(resc){ asm volatile("s_waitcnt lgkmcnt(0)":::"memory"); \
      _Pragma("unroll") for(int d_=0;d_<4;++d_) _Pragma("unroll") for(int r=0;r<16;++r)o[d_][r]*=wsf[crow(r,hi)]; } }while(0)
  f32x16 C0,C1; v8i_t pw;
  int sl_prev=0,sl_cur=0,sl_next=SLOTB;
  #define ROT() do{sl_prev=sl_cur;sl_cur=sl_next;sl_next=(sl_next==(XSLOTS-1)*SLOTB)?0:sl_next+SLOTB;}while(0)
  #define PK8(X,B) ({ int w_; asm volatile("":"=v"(w_)); w_=__builtin_amdgcn_cvt_pk_fp8_f32(X[B],X[(B)+1],w_,false); __builtin_amdgcn_cvt_pk_fp8_f32(X[(B)+2],X[(B)+3],w_,true); })
  #define PKALL() do{ pw=(v8i_t){PK8(C0,0),PK8(C0,4),PK8(C0,8),PK8(C0,12),PK8(C1,0),PK8(C1,4),PK8(C1,8),PK8(C1,12)}; }while(0)
  DMA_K(2,2*SLOTB);
  WAIT_BAR(3);
  KLD(0,0);KLD(1,0);asm volatile("s_waitcnt lgkmcnt(0)":::"memory"); C0=QK8(0); C1=QK8(1); asm volatile("s_nop 15\n\ts_nop 7":"+v"(C0),"+v"(C1));CMASK(C0,C1,0);
  { const float rm=rowmax(C0,C1); const float dl=rm-PV8_PBIAS; mhat=fadd_s(mhat,dl);
    _Pragma("unroll") for(int r=0;r<16;++r){C0[r]=fsub_s(C0[r],dl);C1[r]=fsub_s(C1[r],dl);}
    _Pragma("unroll") for(int r=0;r<16;++r)negm[r]=-mhat; asm volatile("":"+v"(negm));
    _Pragma("unroll") for(int r=0;r<16;++r){C0[r]=__builtin_amdgcn_exp2f(C0[r]);C1[r]=__builtin_amdgcn_exp2f(C1[r]);}
    float sacc=C0[0]+C0[1]; _Pragma("unroll") for(int r=2;r<16;++r)sacc+=C0[r]; _Pragma("unroll") for(int r=0;r<16;++r)sacc+=C1[r]; l_reg+=sacc;
    pw=(v8i_t){PK8(C0,0),PK8(C0,4),PK8(C0,8),PK8(C0,12),PK8(C1,0),PK8(C1,4),PK8(C1,8),PK8(C1,12)}; }
  WAIT_BAR(0);
  DMA_K(3,3*SLOTB);DMA_V(1,SLOTB);
  ROT();
  KLD(0,sl_cur);KLD(1,sl_cur);
  WAIT_BAR(2);
  v8i_t vf[4];
  #define PIN(x) asm volatile("":"+v"(x))
  #define MX3(a,b,c) __builtin_fmaxf(__builtin_fmaxf((a),(b)),(c))
  #define EX(v) __builtin_amdgcn_exp2f(v)
  #define VRL(d) do{ vf[d].lo=*(const __attribute__((address_space(3))) v4i_t*)(vq0+sl_prev+(d)*2048); }while(0)
  #define VRH(d) do{ vf[d].hi=*(const __attribute__((address_space(3))) v4i_t*)(vq1+sl_prev+(d)*2048); }while(0)
  #define EX8(X,B) do{ _Pragma("unroll") for(int e_=0;e_<8;++e_)X[(B)+e_]=EX(X[(B)+e_]); PIN(X); }while(0)
  #define SM8(X,B) do{ _Pragma("unroll") for(int e_=0;e_<8;++e_)sacc+=X[(B)+e_]; PIN(sacc); }while(0)
  #define KRD(G,j) do{ if((G)&&(j)<2){ KLD(j,sl_next); } }while(0)
  #define MF8(d) o[d]=__builtin_amdgcn_mfma_scale_f32_32x32x64_f8f6f4(pw,vf[d],o[d],0,0,0,0,0,0)
  #define STEP(t,GK,GV,GL) do{ SBAR(); \
    VRL(0); VRH(0); VRL(1); VRH(1); SBAR(); C0=QK8(0); SBAR(); \
    VRL(2); VRH(2); VRL(3); VRH(3); SBAR(); C1=QK8(1); SBAR(); \
    if(GK){DMA_K((t)+3,sl_prev);} if(GV){DMA_V((t)+1,sl_next);} \
    CMASK(C0,C1,t); \
    SBAR(); \
    float sacc=0.f; \
    MF8(0); KRD(GL,0); EX8(C0,0); SM8(C0,0); SBAR(); \
    MF8(1); KRD(GL,1); EX8(C0,8); SM8(C0,8); SBAR(); \
    MF8(2); KRD(GL,2); EX8(C1,0); SM8(C1,0); SBAR(); \
    MF8(3); KRD(GL,3); EX8(C1,8); SM8(C1,8); SBAR(); \
    PKALL(); \
    resc=false; \
    if(__builtin_expect(__any(sacc>256.f),0)){                  \
      float a=MX3(C0[0],C0[1],C1[0]),b=MX3(C0[2],C0[3],C1[1]); a=MX3(a,C1[2],C1[3]); \
      _Pragma("unroll") for(int r=4;r<16;r+=4){a=MX3(a,C0[r],C0[r+1]);b=MX3(b,C0[r+2],C0[r+3]);a=MX3(a,C1[r],C1[r+1]);b=MX3(b,C1[r+2],C1[r+3]);} \
      float rm=__builtin_fmaxf(a,b); { auto rr=__builtin_amdgcn_permlane32_swap(__float_as_uint(rm),__float_as_uint(rm),false,false); rm=__builtin_fmaxf(__uint_as_float(rr[0]),__uint_as_float(rr[1])); } \
      const float dl=__builtin_fmaxf(__builtin_amdgcn_logf(rm)-PV8_PBIAS,0.f); mhat+=dl; \
      _Pragma("unroll") for(int r=0;r<16;++r)negm[r]=-mhat; asm volatile("":"+v"(negm)); \
      const float f=__builtin_amdgcn_exp2f(-dl); l_reg*=f; sacc*=f; if(hi==0)wsf[r32]=f; resc=true; \
      _Pragma("unroll") for(int r=0;r<16;++r){C0[r]*=f;C1[r]*=f;} \
      PKALL(); } \
    l_reg+=sacc; \
    }while(0)
  #define ENDW(tt) do{ if((tt)+3<NT){WAIT_BAR(2);} else if((tt)+2<NT){WAIT_BAR(1);} else {WAIT_BAR(0);} }while(0)
  int t=1;
  #undef CMASK
  #define CMASK(P0,P1,t) do{}while(0)
  for(;t<NT-4;++t){ STEP(t,true,true,true);
    if(HOST&&((wcs.ctr++&7)==0)&&wcs.idx<wct.total){ wconv::micro(wct,wcs,wstage,lane); WAIT_BAR(7); }
    else{ WAIT_BAR(2); }
    RESC(); ROT(); }
  #undef CMASK
  #define CMASK(P0,P1,t) do{int jb_=(t)-(NT-4); if(jb_>=0)cmask(P0,P1,jb_,qrel,hi);}while(0)
  for(;t<NT-1;++t){ STEP(t,(t+3<NT),(t+1<NT),(t+1<NT)); ENDW(t); RESC(); ROT(); }
  STEP(NT-1,false,false,false); RESC();
  { sl_prev=sl_cur; SBAR();
    VRL(0);VRH(0);VRL(1);VRH(1);VRL(2);VRH(2);VRL(3);VRH(3); SBAR(); MF8(0);MF8(1);MF8(2);MF8(3); }
  #undef PK8
  #undef PKALL
  #undef PIN
  #undef MX3
  #undef EX
  #undef VRL
  #undef VRH
  #undef EX8
  #undef SM8
  #undef KRD
  #undef KLD
  #undef QK8
  #undef MF8
  #undef STEP
  #undef ENDW
  {auto rr=__builtin_amdgcn_permlane32_swap(__float_as_uint(l_reg),__float_as_uint(l_reg),false,false);l_reg=__uint_as_float(rr[0])+__uint_as_float(rr[1]);}
  if(hi==0)wsf[32+r32]=l_reg;asm volatile("s_waitcnt lgkmcnt(0)":::"memory");
  { bf16*Of=O+(long)(q0+wid*QBLK)*opitch;
    #pragma unroll
    for(int r=0;r<16;++r){const int orow=crow(r,hi); const float rl=__builtin_amdgcn_rcpf(wsf[32+orow])*(1.f/PV8_VSCALE);
      #pragma unroll
      for(int d0=0;d0<4;++d0)Of[(long)orow*opitch+d0*32+r32]=__float2bfloat16(o[d0][r]*rl);} }
  asm volatile("s_waitcnt lgkmcnt(0)\n\ts_barrier":::"memory");
  #undef DMA_K
  #undef DMA_V
  #undef CMASK
  #undef RESC
  #undef ROT
}


constexpr int R_K=0, R_V=32768, R_KG=16384, R_VG=32768, R_LDS_BYTES=R_V+2*R_VG;
template<int THRL,bool HOST> __device__ __forceinline__ void attn_unit128r8(int qb,const bf16*Q,const unsigned char*__restrict__ K8,const unsigned char*__restrict__ VT,bf16*O,int opitch,char*shm,float*wsf0,const int wid,const wconv::Tab&wct,wconv::State&wcs,const unsigned wstage){
  int lane; asm volatile("v_mbcnt_lo_u32_b32 %0, -1, 0\n\tv_mbcnt_hi_u32_b32 %0, -1, %0":"=v"(lane)); const int r32=lane&31,hi=lane>>5;
  const int q0=qb*QB;
  const bf16*Qw=Q+(long)(q0+wid*QBLK)*DM;
  const unsigned lds0=(unsigned)(uintptr_t)shm;
  float*wsf=wsf0+wid*64;
  const unsigned poff=(unsigned)(wid*1024+lane*16);
  const unsigned pdst=lds0+wid*1024;
  #define SEND_K(g,np) do{ const unsigned char*s_=K8+(long)(4*(g)+2)*4096; const unsigned d_=pdst+R_K+(((g)+2)&1)*R_KG; \
      glds16s(s_,poff,(unsigned)__builtin_amdgcn_readfirstlane(d_)); if((np)>1){ glds16s(s_+8192,poff,(unsigned)__builtin_amdgcn_readfirstlane(d_+8192)); } }while(0)
  #define SEND_V(g) do{ const unsigned char*s_=VT+(long)(4*(g))*8192; const unsigned d_=pdst+R_V+((g)&1)*R_VG; \
      _Pragma("unroll") for(int j_=0;j_<4;++j_) glds16s(s_+j_*8192,poff,(unsigned)__builtin_amdgcn_readfirstlane(d_+j_*8192)); }while(0)
  v8i_t kf8[2];
  const lds_cptr shm3=(lds_cptr)shm;
  const int sw_=(r32>>2)&3; const lds_cptr vq0=shm3+R_V+r32*64+((2*hi)^sw_)*16, vq1=shm3+R_V+r32*64+(((2*hi)^sw_)^1)*16; const lds_cptr kq0=vq0+(R_K-R_V), kq1=vq1+(R_K-R_V);
  const int NT=(q0+QB)/KVBLK;
  glds16s(K8,poff,(unsigned)__builtin_amdgcn_readfirstlane(pdst+R_K+R_KG));
  v8i_t q8;
  { u32x4 w_[4];
    #pragma unroll
    for(int i=0;i<4;++i)w_[i]=*reinterpret_cast<const u32x4*>(&Qw[(long)r32*DM+hi*32+8*i]);
    SEND_V(0); SEND_K(0,(qb>0)?2:1);
    #define BL(x) __uint_as_float((x)<<16)
    #define BH(x) __uint_as_float((x)&0xffff0000u)
    #define Q4(a,b) ({ int w2_=0; w2_=__builtin_amdgcn_cvt_pk_fp8_f32(BL(a),BH(a),w2_,false); __builtin_amdgcn_cvt_pk_fp8_f32(BL(b),BH(b),w2_,true); })
    q8=(v8i_t){Q4(w_[0][0],w_[0][1]),Q4(w_[0][2],w_[0][3]),Q4(w_[1][0],w_[1][1]),Q4(w_[1][2],w_[1][3]),Q4(w_[2][0],w_[2][1]),Q4(w_[2][2],w_[2][3]),Q4(w_[3][0],w_[3][1]),Q4(w_[3][2],w_[3][3])};
    #undef BL
    #undef BH
    #undef Q4
  }
  #define KLD(b,ko) do{ kf8[b].lo=*(const __attribute__((address_space(3))) v4i_t*)(kq0+(ko)+(b)*2048); kf8[b].hi=*(const __attribute__((address_space(3))) v4i_t*)(kq1+(ko)+(b)*2048); }while(0)
  #define QK8(b) __builtin_amdgcn_mfma_scale_f32_32x32x64_f8f6f4(kf8[b],q8,negm,0,0,0,0,0,0)
  float mhat=0.f,l_reg=0.f;f32x16 o[4];o[0]=f32x16{};o[1]=f32x16{};o[2]=f32x16{};o[3]=f32x16{};
  float zz_=0.f; asm volatile("":"+v"(zz_)); f32x16 negm;
  _Pragma("unroll") for(int r=0;r<16;++r)negm[r]=zz_; asm volatile("":"+v"(negm));
  const int qrel=wid*QBLK+r32;
  #define CMASK(P0,P1,t) do{int jb_=(t)-(NT-4); if(jb_>=0)cmask(P0,P1,jb_,qrel,hi);}while(0)
  bool resc=false;
  #define RESC() do{ if(resc){ asm volatile("s_waitcnt lgkmcnt(0)":::"memory"); \
      _Pragma("unroll") for(int d_=0;d_<4;++d_) _Pragma("unroll") for(int r=0;r<16;++r)o[d_][r]*=wsf[crow(r,hi)]; } }while(0)
  f32x16 C0,C1; v8i_t pw;
  #define PK8(X,B) ({ int w_; asm volatile("":"=v"(w_)); w_=__builtin_amdgcn_cvt_pk_fp8_f32(X[B],X[(B)+1],w_,false); __builtin_amdgcn_cvt_pk_fp8_f32(X[(B)+2],X[(B)+3],w_,true); })
  #define PKALL() do{ pw=(v8i_t){PK8(C0,0),PK8(C0,4),PK8(C0,8),PK8(C0,12),PK8(C1,0),PK8(C1,4),PK8(C1,8),PK8(C1,12)}; }while(0)
  if(qb>0){ WAIT_BAR(6); } else { WAIT_BAR(5); }
  KLD(0,R_KG);KLD(1,R_KG);asm volatile("s_waitcnt lgkmcnt(0)":::"memory"); C0=QK8(0); C1=QK8(1); asm volatile("s_nop 15\n\ts_nop 7":"+v"(C0),"+v"(C1));CMASK(C0,C1,0);
  { const float rm=rowmax(C0,C1); const float dl=rm-PV8_PBIAS; mhat=fadd_s(mhat,dl);
    _Pragma("unroll") for(int r=0;r<16;++r){C0[r]=fsub_s(C0[r],dl);C1[r]=fsub_s(C1[r],dl);}
    _Pragma("unroll") for(int r=0;r<16;++r)negm[r]=-mhat; asm volatile("":"+v"(negm));
    _Pragma("unroll") for(int r=0;r<16;++r){C0[r]=__builtin_amdgcn_exp2f(C0[r]);C1[r]=__builtin_amdgcn_exp2f(C1[r]);}
    float sacc=C0[0]+C0[1]; _Pragma("unroll") for(int r=2;r<16;++r)sacc+=C0[r]; _Pragma("unroll") for(int r=0;r<16;++r)sacc+=C1[r]; l_reg+=sacc;
    pw=(v8i_t){PK8(C0,0),PK8(C0,4),PK8(C0,8),PK8(C0,12),PK8(C1,0),PK8(C1,4),PK8(C1,8),PK8(C1,12)}; }
  KLD(0,R_KG+4096);KLD(1,R_KG+4096);
  WAIT_BAR(0);
  v8i_t vf[4];
  #define PIN(x) asm volatile("":"+v"(x))
  #define MX3(a,b,c) __builtin_fmaxf(__builtin_fmaxf((a),(b)),(c))
  #define EX(v) __builtin_amdgcn_exp2f(v)
  #define VRL(d,vo) do{ vf[d].lo=*(const __attribute__((address_space(3))) v4i_t*)(vq0+(vo)+(d)*2048); }while(0)
  #define VRH(d,vo) do{ vf[d].hi=*(const __attribute__((address_space(3))) v4i_t*)(vq1+(vo)+(d)*2048); }while(0)
  #define EX8(X,B) do{ _Pragma("unroll") for(int e_=0;e_<8;++e_)X[(B)+e_]=EX(X[(B)+e_]); PIN(X); }while(0)
  #define SM8(X,B) do{ _Pragma("unroll") for(int e_=0;e_<8;++e_)sacc+=X[(B)+e_]; PIN(sacc); }while(0)
  #define KRD(G,j,ko) do{ if((G)&&(j)<2){ KLD(j,ko); } }while(0)
  #define MF8(d) o[d]=__builtin_amdgcn_mfma_scale_f32_32x32x64_f8f6f4(pw,vf[d],o[d],0,0,0,0,0,0)
  #define STEP(t,vo,ko,GL) do{ SBAR(); \
    VRL(0,vo); VRH(0,vo); VRL(1,vo); VRH(1,vo); SBAR(); C0=QK8(0); SBAR(); \
    VRL(2,vo); VRH(2,vo); VRL(3,vo); VRH(3,vo); SBAR(); C1=QK8(1); SBAR(); \
    CMASK(C0,C1,t); \
    SBAR(); \
    float sacc=0.f; \
    MF8(0); KRD(GL,0,ko); EX8(C0,0); SM8(C0,0); SBAR(); \
    MF8(1); KRD(GL,1,ko); EX8(C0,8); SM8(C0,8); SBAR(); \
    MF8(2); EX8(C1,0); SM8(C1,0); SBAR(); \
    MF8(3); EX8(C1,8); SM8(C1,8); SBAR(); \
    PKALL(); \
    resc=false; \
    if(__builtin_expect(__any(sacc>128.f),0)){                  \
      float a=MX3(C0[0],C0[1],C1[0]),b=MX3(C0[2],C0[3],C1[1]); a=MX3(a,C1[2],C1[3]); \
      _Pragma("unroll") for(int r=4;r<16;r+=4){a=MX3(a,C0[r],C0[r+1]);b=MX3(b,C0[r+2],C0[r+3]);a=MX3(a,C1[r],C1[r+1]);b=MX3(b,C1[r+2],C1[r+3]);} \
      float rm=__builtin_fmaxf(a,b); { auto rr=__builtin_amdgcn_permlane32_swap(__float_as_uint(rm),__float_as_uint(rm),false,false); rm=__builtin_fmaxf(__uint_as_float(rr[0]),__uint_as_float(rr[1])); } \
      const float dl=__builtin_fmaxf(__builtin_amdgcn_logf(rm)-PV8_PBIAS,0.f); mhat+=dl; \
      _Pragma("unroll") for(int r=0;r<16;++r)negm[r]=-mhat; asm volatile("":"+v"(negm)); \
      const float f=__builtin_amdgcn_exp2f(-dl); l_reg*=f; sacc*=f; if(hi==0)wsf[r32]=f; resc=true; \
      _Pragma("unroll") for(int r=0;r<16;++r){C0[r]*=f;C1[r]*=f;} \
      PKALL(); } \
    l_reg+=sacc; \
    RESC(); \
    }while(0)
  #define QUAD(g) do{ const int vs_=((g)&1)*R_VG, ks_=((g)&1)*R_KG; const int t0_=4*(g)+1; \
      STEP(t0_,vs_,ks_,true); STEP(t0_+1,vs_+8192,ks_+4096,true); STEP(t0_+2,vs_+16384,ks_+8192,true); STEP(t0_+3,vs_+24576,ks_+12288,true); }while(0)
  int g=0;
  #undef CMASK
  #define CMASK(P0,P1,t) do{}while(0)
  for(;g<qb-1;++g){
    SEND_K(g+1,2); SEND_V(g+1);
    QUAD(g);
    if(HOST&&((wcs.ctr++&1)==0)&&wcs.idx<wct.total){ wconv::micro(wct,wcs,wstage,lane); WAIT_BAR(5); }
    else{ WAIT_BAR(0); }
  }
  #undef CMASK
  #define CMASK(P0,P1,t) do{int jb_=(t)-(NT-4); if(jb_>=0)cmask(P0,P1,jb_,qrel,hi);}while(0)
  if(g<qb){
    SEND_K(g+1,1); SEND_V(g+1);
    QUAD(g);
    WAIT_BAR(0); ++g; }
  { const int vs_=(g&1)*R_VG, ks_=(g&1)*R_KG;
    STEP(NT-3,vs_,ks_,true); STEP(NT-2,vs_+8192,ks_+4096,true); STEP(NT-1,vs_+16384,0,false);
    SBAR(); VRL(0,vs_+24576);VRH(0,vs_+24576);VRL(1,vs_+24576);VRH(1,vs_+24576);VRL(2,vs_+24576);VRH(2,vs_+24576);VRL(3,vs_+24576);VRH(3,vs_+24576); SBAR(); MF8(0);MF8(1);MF8(2);MF8(3); }
  #undef QUAD
  #undef PK8
  #undef PKALL
  #undef PIN
  #undef MX3
  #undef EX
  #undef VRL
  #undef VRH
  #undef EX8
  #undef SM8
  #undef KRD
  #undef KLD
  #undef QK8
  #undef MF8
  #undef STEP
  {auto rr=__builtin_amdgcn_permlane32_swap(__float_as_uint(l_reg),__float_as_uint(l_reg),false,false);l_reg=__uint_as_float(rr[0])+__uint_as_float(rr[1]);}
  if(hi==0)wsf[32+r32]=l_reg;asm volatile("s_waitcnt lgkmcnt(0)":::"memory");
  { bf16*Of=O+(long)(q0+wid*QBLK)*opitch;
    #pragma unroll
    for(int r=0;r<16;++r){const int orow=crow(r,hi); const float rl=__builtin_amdgcn_rcpf(wsf[32+orow])*(1.f/PV8_VSCALE);
      #pragma unroll
      for(int d0=0;d0<4;++d0)Of[(long)orow*opitch+d0*32+r32]=__float2bfloat16(o[d0][r]*rl);} }
  asm volatile("s_waitcnt lgkmcnt(0)\n\ts_barrier":::"memory");
  #undef SEND_K
  #undef SEND_V
  #undef CMASK
  #undef RESC
}

template<int THRL,bool HOST> __device__ __forceinline__ void attn_unit128r9(int qb,const bf16*Q,const unsigned char*__restrict__ K8,const unsigned char*__restrict__ VT,bf16*O,int opitch,char*shm,float*wsf0,const int wid,const wconv::Tab&wct,wconv::State&wcs,const unsigned wstage){
  int lane; asm volatile("v_mbcnt_lo_u32_b32 %0, -1, 0\n\tv_mbcnt_hi_u32_b32 %0, -1, %0":"=v"(lane)); const int r32=lane&31,hi=lane>>5;
  const int q0=qb*QB;
  const bf16*Qw=Q+(long)(q0+wid*QBLK)*DM;
  const unsigned lds0=(unsigned)(uintptr_t)shm;
  float*wsf=wsf0+wid*64;
  const unsigned poff=(unsigned)(wid*1024+lane*16);
  const unsigned pdst=lds0+wid*1024;
  #define SEND_K(g,np) do{ const unsigned char*s_=K8+(long)(4*(g)+2)*4096; const unsigned d_=pdst+R_K+(((g)+2)&1)*R_KG; \
      glds16s(s_,poff,(unsigned)__builtin_amdgcn_readfirstlane(d_)); if((np)>1){ glds16s(s_+8192,poff,(unsigned)__builtin_amdgcn_readfirstlane(d_+8192)); } }while(0)
  #define SEND_V(g) do{ const unsigned char*s_=VT+(long)(4*(g))*8192; const unsigned d_=pdst+R_V+((g)&1)*R_VG; \
      _Pragma("unroll") for(int j_=0;j_<4;++j_) glds16s(s_+j_*8192,poff,(unsigned)__builtin_amdgcn_readfirstlane(d_+j_*8192)); }while(0)
  v8i_t kf8[2];
  const lds_cptr shm3=(lds_cptr)shm;
  const int sw_=(r32>>2)&3; const lds_cptr vq0=shm3+R_V+r32*64+((2*hi)^sw_)*16, vq1=shm3+R_V+r32*64+(((2*hi)^sw_)^1)*16; const lds_cptr kq0=vq0+(R_K-R_V), kq1=vq1+(R_K-R_V);
  const int NT=(q0+QB)/KVBLK;
  glds16s(K8,poff,(unsigned)__builtin_amdgcn_readfirstlane(pdst+R_K+R_KG));
  v8i_t q8;
  { u32x4 w_[4];
    #pragma unroll
    for(int i=0;i<4;++i)w_[i]=*reinterpret_cast<const u32x4*>(&Qw[(long)r32*DM+hi*32+8*i]);
    SEND_V(0); SEND_K(0,(qb>0)?2:1);
    #define BL(x) __uint_as_float((x)<<16)
    #define BH(x) __uint_as_float((x)&0xffff0000u)
    #define Q4(a,b) ({ int w2_=0; w2_=__builtin_amdgcn_cvt_pk_fp8_f32(BL(a),BH(a),w2_,false); __builtin_amdgcn_cvt_pk_fp8_f32(BL(b),BH(b),w2_,true); })
    q8=(v8i_t){Q4(w_[0][0],w_[0][1]),Q4(w_[0][2],w_[0][3]),Q4(w_[1][0],w_[1][1]),Q4(w_[1][2],w_[1][3]),Q4(w_[2][0],w_[2][1]),Q4(w_[2][2],w_[2][3]),Q4(w_[3][0],w_[3][1]),Q4(w_[3][2],w_[3][3])};
    #undef BL
    #undef BH
    #undef Q4
  }
  #define KLD(b,ko) do{ kf8[b].lo=*(const __attribute__((address_space(3))) v4i_t*)(kq0+(ko)+(b)*2048); kf8[b].hi=*(const __attribute__((address_space(3))) v4i_t*)(kq1+(ko)+(b)*2048); }while(0)
  #define QK8(b) __builtin_amdgcn_mfma_scale_f32_32x32x64_f8f6f4(kf8[b],q8,negm,0,0,0,0,0,0)
  float mhat=0.f;f32x16 o[4];
  typedef float f32x4s __attribute__((ext_vector_type(4)));
  const int bs_=((lane&15)==((lane>>4)&1))?0x38383838:0; const v8i_t bsel=(v8i_t){bs_,bs_,bs_,bs_,bs_,bs_,bs_,bs_};
  f32x4s lacc=(f32x4s){0.f,0.f,0.f,0.f},dsum=(f32x4s){0.f,0.f,0.f,0.f};
  #define SUMP() dsum=__builtin_amdgcn_mfma_scale_f32_16x16x128_f8f6f4(pw,bsel,(f32x4s){0.f,0.f,0.f,0.f},0,0,0,0,0,0)
o[0]=f32x16{};o[1]=f32x16{};o[2]=f32x16{};o[3]=f32x16{};
  float zz_=0.f; asm volatile("":"+v"(zz_)); f32x16 negm;
  _Pragma("unroll") for(int r=0;r<16;++r)negm[r]=zz_; asm volatile("":"+v"(negm));
  const int qrel=wid*QBLK+r32;
  #define CMASK(P0,P1,t) do{int jb_=(t)-(NT-4); if(jb_>=0)cmask(P0,P1,jb_,qrel,hi);}while(0)
  bool resc=false;
  #define RESC() do{ if(resc){ asm volatile("s_waitcnt lgkmcnt(0)":::"memory"); \
      _Pragma("unroll") for(int d_=0;d_<4;++d_) _Pragma("unroll") for(int r=0;r<16;++r)o[d_][r]*=wsf[crow(r,hi)]; } }while(0)
  f32x16 C0,C1; v8i_t pw;
  #define PK8(X,B) ({ int w_; asm volatile("":"=v"(w_)); w_=__builtin_amdgcn_cvt_pk_fp8_f32(X[B],X[(B)+1],w_,false); __builtin_amdgcn_cvt_pk_fp8_f32(X[(B)+2],X[(B)+3],w_,true); })
  #define PKALL() do{ pw=(v8i_t){PK8(C0,0),PK8(C0,4),PK8(C0,8),PK8(C0,12),PK8(C1,0),PK8(C1,4),PK8(C1,8),PK8(C1,12)}; }while(0)
  if(qb>0){ WAIT_BAR(6); } else { WAIT_BAR(5); }
  KLD(0,R_KG);KLD(1,R_KG);asm volatile("s_waitcnt lgkmcnt(0)":::"memory"); C0=QK8(0); C1=QK8(1); asm volatile("s_nop 15\n\ts_nop 7":"+v"(C0),"+v"(C1));CMASK(C0,C1,0);
  { const float rm=rowmax(C0,C1); const float dl=rm-PV8_PBIAS; mhat=fadd_s(mhat,dl);
    _Pragma("unroll") for(int r=0;r<16;++r){C0[r]=fsub_s(C0[r],dl);C1[r]=fsub_s(C1[r],dl);}
    _Pragma("unroll") for(int r=0;r<16;++r)negm[r]=-mhat; asm volatile("":"+v"(negm));
    _Pragma("unroll") for(int r=0;r<16;++r){C0[r]=__builtin_amdgcn_exp2f(C0[r]);C1[r]=__builtin_amdgcn_exp2f(C1[r]);}
    pw=(v8i_t){PK8(C0,0),PK8(C0,4),PK8(C0,8),PK8(C0,12),PK8(C1,0),PK8(C1,4),PK8(C1,8),PK8(C1,12)}; SUMP(); }
  KLD(0,R_KG+4096);KLD(1,R_KG+4096);
  WAIT_BAR(0);
  v8i_t vf[4];
  #define PIN(x) asm volatile("":"+v"(x))
  #define MX3(a,b,c) __builtin_fmaxf(__builtin_fmaxf((a),(b)),(c))
  #define EX(v) __builtin_amdgcn_exp2f(v)
  #define VRL(d,vo) do{ vf[d].lo=*(const __attribute__((address_space(3))) v4i_t*)(vq0+(vo)+(d)*2048); }while(0)
  #define VRH(d,vo) do{ vf[d].hi=*(const __attribute__((address_space(3))) v4i_t*)(vq1+(vo)+(d)*2048); }while(0)
  #define EX8(X,B) do{ _Pragma("unroll") for(int e_=0;e_<8;++e_)X[(B)+e_]=EX(X[(B)+e_]); PIN(X); }while(0)
  #define SM8(X,B) do{ _Pragma("unroll") for(int e_=0;e_<8;++e_)sacc+=X[(B)+e_]; PIN(sacc); }while(0)
  #define KRD(G,j,ko) do{ if((G)&&(j)<2){ KLD(j,ko); } }while(0)
  #define MF8(d) o[d]=__builtin_amdgcn_mfma_scale_f32_32x32x64_f8f6f4(pw,vf[d],o[d],0,0,0,0,0,0)
  #define CHECKP() do{ resc=false; \
    const float dm_=__builtin_fmaxf(__builtin_fmaxf(dsum[0],dsum[1]),__builtin_fmaxf(dsum[2],dsum[3])); \
    if(__builtin_expect(__any(!(dm_<256.f)),0)){ \
      float a=MX3(C0[0],C0[1],C1[0]),b=MX3(C0[2],C0[3],C1[1]); a=MX3(a,C1[2],C1[3]); \
      _Pragma("unroll") for(int r=4;r<16;r+=4){a=MX3(a,C0[r],C0[r+1]);b=MX3(b,C0[r+2],C0[r+3]);a=MX3(a,C1[r],C1[r+1]);b=MX3(b,C1[r+2],C1[r+3]);} \
      float rm=__builtin_fmaxf(a,b); { auto rr=__builtin_amdgcn_permlane32_swap(__float_as_uint(rm),__float_as_uint(rm),false,false); rm=__builtin_fmaxf(__uint_as_float(rr[0]),__uint_as_float(rr[1])); } \
      const float dl=__builtin_fmaxf(__builtin_amdgcn_logf(rm)-PV8_PBIAS,0.f); mhat+=dl; \
      _Pragma("unroll") for(int r=0;r<16;++r)negm[r]=-mhat; asm volatile("":"+v"(negm)); \
      const float f=__builtin_amdgcn_exp2f(-dl); if(hi==0)wsf[r32]=f; resc=true; \
      _Pragma("unroll") for(int r=0;r<16;++r){C0[r]*=f;C1[r]*=f;} \
      PKALL(); SUMP(); \
      asm volatile("s_waitcnt lgkmcnt(0)":::"memory"); \
      { const int qb_=(lane&15)*16+4*(lane>>4); _Pragma("unroll") for(int j_=0;j_<4;++j_)lacc[j_]*=wsf[(qb_+j_)&31]; } \
      _Pragma("unroll") for(int d_=0;d_<4;++d_) _Pragma("unroll") for(int r=0;r<16;++r)o[d_][r]*=wsf[crow(r,hi)]; } \
    lacc+=dsum; }while(0)
  #define STEP(t,vo,ko,GL) do{ SBAR(); \
    VRL(0,vo); VRH(0,vo); VRL(1,vo); VRH(1,vo); VRL(2,vo); VRH(2,vo); VRL(3,vo); VRH(3,vo); SBAR(); \
    CHECKP(); SBAR(); \
    C0=QK8(0); SBAR(); C1=QK8(1); SBAR(); \
    CMASK(C0,C1,t); \
    SBAR(); \
    MF8(0); KRD(GL,0,ko); EX8(C0,0); SBAR(); \
    MF8(1); KRD(GL,1,ko); EX8(C0,8); SBAR(); \
    MF8(2); EX8(C1,0); SBAR(); \
    MF8(3); EX8(C1,8); SBAR(); \
    PKALL(); SUMP(); \
    }while(0)
  #define QUAD(g) do{ const int vs_=((g)&1)*R_VG, ks_=((g)&1)*R_KG; const int t0_=4*(g)+1; \
      STEP(t0_,vs_,ks_,true); STEP(t0_+1,vs_+8192,ks_+4096,true); STEP(t0_+2,vs_+16384,ks_+8192,true); STEP(t0_+3,vs_+24576,ks_+12288,true); }while(0)
  int g=0;
  #undef CMASK
  #define CMASK(P0,P1,t) do{}while(0)
  for(;g<qb-1;++g){
    SEND_K(g+1,2); SEND_V(g+1);
    QUAD(g);
    if(HOST&&((wcs.ctr++&1)==0)&&wcs.idx<wct.total){ wconv::micro(wct,wcs,wstage,lane); WAIT_BAR(5); }
    else{ WAIT_BAR(0); }
  }
  #undef CMASK
  #define CMASK(P0,P1,t) do{int jb_=(t)-(NT-4); if(jb_>=0)cmask(P0,P1,jb_,qrel,hi);}while(0)
  if(g<qb){
    SEND_K(g+1,1); SEND_V(g+1);
    QUAD(g);
    WAIT_BAR(0); ++g; }
  { const int vs_=(g&1)*R_VG, ks_=(g&1)*R_KG;
    STEP(NT-3,vs_,ks_,true); STEP(NT-2,vs_+8192,ks_+4096,true); STEP(NT-1,vs_+16384,0,false);
    SBAR(); CHECKP(); SBAR(); VRL(0,vs_+24576);VRH(0,vs_+24576);VRL(1,vs_+24576);VRH(1,vs_+24576);VRL(2,vs_+24576);VRH(2,vs_+24576);VRL(3,vs_+24576);VRH(3,vs_+24576); SBAR(); MF8(0);MF8(1);MF8(2);MF8(3); }
  #undef QUAD
  #undef PK8
  #undef PKALL
  #undef PIN
  #undef MX3
  #undef EX
  #undef VRL
  #undef VRH
  #undef EX8
  #undef SM8
  #undef KRD
  #undef KLD
  #undef QK8
  #undef MF8
  #undef STEP
  #undef CHECKP
  #undef SUMP
  if((lane&15)<2){ const int qb_=(lane&15)*16+4*(lane>>4); _Pragma("unroll") for(int j_=0;j_<4;++j_)wsf[32+qb_+j_]=lacc[j_]; }
  asm volatile("s_waitcnt lgkmcnt(0)":::"memory");
  { bf16*Of=O+(long)(q0+wid*QBLK)*opitch;
    #pragma unroll
    for(int r=0;r<16;++r){const int orow=crow(r,hi); const float rl=__builtin_amdgcn_rcpf(wsf[32+orow])*(1.f/PV8_VSCALE);
      #pragma unroll
      for(int d0=0;d0<4;++d0)Of[(long)orow*opitch+d0*32+r32]=__float2bfloat16(o[d0][r]*rl);} }
  asm volatile("s_waitcnt lgkmcnt(0)\n\ts_barrier":::"memory");
  #undef SEND_K
  #undef SEND_V
  #undef CMASK
  #undef RESC
}


constexpr int BRA_NKT=4, BRA_GRP_BYTES=2*BRA_NKT*8192;
__device__ __forceinline__ void grp_bar(__attribute__((address_space(3))) unsigned* gb,int lane){
  asm volatile("s_waitcnt vmcnt(0) lgkmcnt(0)":::"memory");
  if(lane==0){
    const unsigned g0=__hip_atomic_load(gb+1,__ATOMIC_RELAXED,__HIP_MEMORY_SCOPE_WORKGROUP);
    const unsigned old=__hip_atomic_fetch_add(gb,1u,__ATOMIC_ACQ_REL,__HIP_MEMORY_SCOPE_WORKGROUP);
    if(old==3u){ __hip_atomic_store(gb,0u,__ATOMIC_RELAXED,__HIP_MEMORY_SCOPE_WORKGROUP); __hip_atomic_store(gb+1,g0+1u,__ATOMIC_RELEASE,__HIP_MEMORY_SCOPE_WORKGROUP); }
    else { unsigned sp=0; while(__hip_atomic_load(gb+1,__ATOMIC_ACQUIRE,__HIP_MEMORY_SCOPE_WORKGROUP)==g0){ __builtin_amdgcn_s_sleep(1); if(++sp>(1u<<24))break; } } }
  asm volatile("s_waitcnt lgkmcnt(0)":::"memory");
}
__device__ __forceinline__ void grp_bar_nv(__attribute__((address_space(3))) unsigned* gb,int lane){
  asm volatile("s_waitcnt lgkmcnt(0)":::"memory");
  if(lane==0){
    const unsigned g0=__hip_atomic_load(gb+1,__ATOMIC_RELAXED,__HIP_MEMORY_SCOPE_WORKGROUP);
    const unsigned old=__hip_atomic_fetch_add(gb,1u,__ATOMIC_ACQ_REL,__HIP_MEMORY_SCOPE_WORKGROUP);
    if(old==3u){ __hip_atomic_store(gb,0u,__ATOMIC_RELAXED,__HIP_MEMORY_SCOPE_WORKGROUP); __hip_atomic_store(gb+1,g0+1u,__ATOMIC_RELEASE,__HIP_MEMORY_SCOPE_WORKGROUP); }
    else { unsigned sp=0; while(__hip_atomic_load(gb+1,__ATOMIC_ACQUIRE,__HIP_MEMORY_SCOPE_WORKGROUP)==g0){ __builtin_amdgcn_s_sleep(1); if(++sp>(1u<<24))break; } } }
  asm volatile("s_waitcnt lgkmcnt(0)":::"memory");
}
struct BraUnit {
  const bf16* Q; const bf16* K; const bf16* V;
  bf16* PO; float* PL;
  int kbase, kstride, t_first, nkt;
  int nqt;
  int qbase, qstride, slotA;
  const int* list; int nlist, tile0, ownrow0;
};
#define BMX3(a,b,c) __builtin_fmaxf(__builtin_fmaxf((a),(b)),(c))
template<int MODE,int ABL=0> __device__ __forceinline__ void bra_unit(const BraUnit&u,char*shm  ,float*wsf  ,char*ost  ,__attribute__((address_space(3))) unsigned*gb,const int wg  ,__attribute__((address_space(3))) int*gqn  ,const int unext  ){
  int lane; asm volatile("v_mbcnt_lo_u32_b32 %0, -1, 0\n\tv_mbcnt_hi_u32_b32 %0, -1, %0":"=v"(lane)); const int r32=lane&31,hi=lane>>5;
  const unsigned lds0=(unsigned)(uintptr_t)shm;
  constexpr int BRA_K=0, BRA_V=BRA_NKT*8192;
  if(!(ABL&4)) for(int T=u.t_first;T<u.nkt;++T){
    #pragma unroll
    for(int pi=0;pi<2;++pi){ const int p=wg+4*pi;
      const long krow=u.kbase+(long)u.kstride*(64*T+8*p+(lane>>3)), vrow=u.kbase+(long)u.kstride*(64*T+16*(p&3)+(lane>>2));
      glds16(u.K+krow*DM+(((lane&7)^((4*p+(lane>>4))&7))*8),(unsigned)__builtin_amdgcn_readfirstlane(lds0+BRA_K+T*8192+p*1024));
      glds16(u.V+vrow*DM+(p>>2)*32+(lane&3)*8,(unsigned)__builtin_amdgcn_readfirstlane(lds0+BRA_V+T*8192+p*1024)); } }
  int qrow_[2],ql_[2],Tlo_[2],Thi_[2],slot_[2]; bool valid_[2],masked_[2],have_[2]; bf16x8 qr_[2][4];
  #pragma unroll
  for(int i=0;i<2;++i){ const int qt=wg+4*i; have_[i]=qt<u.nqt; valid_[i]=have_[i]; masked_[i]=true; qrow_[i]=0; ql_[i]=0; Tlo_[i]=0; Thi_[i]=-1; slot_[i]=0;
    if(have_[i]){
      if(MODE==0){ ql_[i]=32*qt+r32; qrow_[i]=u.qbase+u.qstride*ql_[i]; Tlo_[i]=(qt>>1)>u.t_first?(qt>>1):u.t_first; Thi_[i]=(qt>>1)+2; slot_[i]=u.slotA; }
      else { const int g=u.tile0+qt;
        if(g<8){ ql_[i]=32*g+r32; qrow_[i]=u.ownrow0+ql_[i]; Tlo_[i]=0; Thi_[i]=g>>1; slot_[i]=3; }
        else { const int e=(g-8)*32+r32; valid_[i]=e<u.nlist; const int ent=valid_[i]?u.list[e]:0; qrow_[i]=ent&0xffff; slot_[i]=ent>>16; Tlo_[i]=0; Thi_[i]=3; masked_[i]=false; } }
      #pragma unroll
      for(int d0=0;d0<4;++d0){ if(!(ABL&8)) qr_[i][d0]=*reinterpret_cast<const bf16x8*>(&u.Q[(long)qrow_[i]*DM+d0*16+hi*8]); else qr_[i][d0]=bf16x8{}; } } }
  grp_bar(gb,lane);
  if(wg==0&&lane==0)*gqn=unext;
  int*wsi=(int*)wsf+64;
  const int kaddr=r32*128+((hi^((r32>>1)&7))<<4);
  const int vbl=(int)(lds0+BRA_V)+((lane>>4)&1)*32+(lane&3)*8+(4*hi+((lane&15)>>2))*64;
  const unsigned dmax=(MODE==0)?128u:0x7fffffffu;
  #pragma unroll
  for(int i=0;i<2;++i){ if(!have_[i])continue;
    const int qrow=qrow_[i],ql=ql_[i],Tlo=Tlo_[i],Thi=Thi_[i],slot=slot_[i]; const bool valid=valid_[i],masked=masked_[i];
    bf16x8 qr[4];
    #pragma unroll
    for(int d0=0;d0<4;++d0)qr[d0]=qr_[i][d0];
    float mhat=0.f,l_reg=0.f; f32x16 o[2]; o[0]=f32x16{}; o[1]=f32x16{}; float zz_=0.f; asm volatile("":"+v"(zz_)); f32x16 negm;
    _Pragma("unroll") for(int r=0;r<16;++r)negm[r]=zz_;
    if(!(ABL&2)) for(int T=Tlo;T<=Thi;++T){
      f32x16 p0,p1; qkt_rm(p0,p1,shm+BRA_K+T*8192,kaddr,qr,negm);
      if(masked){ const int db=ql-64*T-4*hi+((MODE==0)?128:0);
        #pragma unroll
        for(int r=0;r<16;++r){ const int d=db-((r&3)+8*(r>>2)); if((unsigned)d>dmax)p0[r]=-INFINITY; if((unsigned)(d-32)>dmax)p1[r]=-INFINITY; } }
      float a=BMX3(p0[0],p0[1],p1[0]),b=BMX3(p0[2],p0[3],p1[1]); a=BMX3(a,p1[2],p1[3]);
      #pragma unroll
      for(int r=4;r<16;r+=4){a=BMX3(a,p0[r],p0[r+1]);b=BMX3(b,p0[r+2],p0[r+3]);a=BMX3(a,p1[r],p1[r+1]);b=BMX3(b,p1[r+2],p1[r+3]);}
      float rm=__builtin_fmaxf(a,b); { auto rr=__builtin_amdgcn_permlane32_swap(__float_as_uint(rm),__float_as_uint(rm),false,false); rm=__builtin_fmaxf(__uint_as_float(rr[0]),__uint_as_float(rr[1])); }
      if(__any(rm>8.f)){ const float dl=(rm>8.f)?rm:0.f; mhat+=dl;
        #pragma unroll
        for(int r=0;r<16;++r){p0[r]-=dl;p1[r]-=dl;}
        #pragma unroll
        for(int r=0;r<16;++r)negm[r]=-mhat;
        const float f=__builtin_amdgcn_exp2f(-dl); l_reg*=f; if(hi==0)wsf[r32]=f;
        asm volatile("s_waitcnt lgkmcnt(0)":::"memory");
        #pragma unroll
        for(int d_=0;d_<2;++d_)
          #pragma unroll
          for(int r=0;r<16;++r)o[d_][r]*=wsf[crow(r,hi)];
        asm volatile("s_waitcnt lgkmcnt(0)":::"memory"); }
      float sacc=0.f;
      #pragma unroll
      for(int r=0;r<16;++r){p0[r]=__builtin_amdgcn_exp2f(p0[r]);p1[r]=__builtin_amdgcn_exp2f(p1[r]);sacc+=p0[r]+p1[r];}
      l_reg+=sacc;
      u32x4 pw0,pw1,pw2,pw3;
      pw0=(u32x4){cvtpk_s(p0[0],p0[1]),cvtpk_s(p0[2],p0[3]),cvtpk_s(p0[4],p0[5]),cvtpk_s(p0[6],p0[7])}; pw1=(u32x4){cvtpk_s(p0[8],p0[9]),cvtpk_s(p0[10],p0[11]),cvtpk_s(p0[12],p0[13]),cvtpk_s(p0[14],p0[15])};
      pw2=(u32x4){cvtpk_s(p1[0],p1[1]),cvtpk_s(p1[2],p1[3]),cvtpk_s(p1[4],p1[5]),cvtpk_s(p1[6],p1[7])}; pw3=(u32x4){cvtpk_s(p1[8],p1[9]),cvtpk_s(p1[10],p1[11]),cvtpk_s(p1[12],p1[13]),cvtpk_s(p1[14],p1[15])};
      SBAR(); pv(o,vbl+T*8192,__builtin_bit_cast(bf16x8,pw0),__builtin_bit_cast(bf16x8,pw1),__builtin_bit_cast(bf16x8,pw2),__builtin_bit_cast(bf16x8,pw3));
    }
    {auto rr=__builtin_amdgcn_permlane32_swap(__float_as_uint(l_reg),__float_as_uint(l_reg),false,false);l_reg=__uint_as_float(rr[0])+__uint_as_float(rr[1]);}
    if(hi==0){ wsf[r32]=l_reg; wsi[r32]=valid?(slot*SEQ+qrow):-1; }
    asm volatile("s_waitcnt lgkmcnt(0)":::"memory");
    if(!(ABL&1)) if(hi==0&&valid) u.PL[(long)(slot*SEQ+qrow)*8]=mhat+__builtin_amdgcn_logf(l_reg);
    if(!(ABL&1)) { float rl_[16];
      #pragma unroll
      for(int r=0;r<16;++r)rl_[r]=__builtin_amdgcn_rcpf(wsf[crow(r,hi)]);
      typedef __attribute__((address_space(3))) unsigned short* lds_u16p; typedef unsigned u32x4s __attribute__((ext_vector_type(4)));
      const lds_u16p wp=(lds_u16p)(uintptr_t)(unsigned)(uintptr_t)ost + r32; const int rrow=lane>>2, rch=lane&3;
      #pragma unroll
      for(int d_=0;d_<2;++d_){
        #pragma unroll
        for(int r=0;r<16;++r)wp[crow(r,hi)*32]=(unsigned short)(cvtpk_s(o[d_][r]*rl_[r],0.f)&0xffffu);
        asm volatile("s_waitcnt lgkmcnt(0)":::"memory");
        #pragma unroll
        for(int p=0;p<2;++p){ const int row=16*p+rrow; const u32x4s w=*(const __attribute__((address_space(3))) u32x4s*)((lds_cptr)ost+row*64+rch*16); const int dst=wsi[row];
          if(dst>=0) *(__attribute__((address_space(1))) u32x4s*)(u.PO+(long)dst*512+d_*32+rch*8)=w; }
        asm volatile("s_waitcnt lgkmcnt(0)":::"memory"); } }
  }
}
#undef BMX3
#undef SBAR
#undef WAIT_BAR
}


constexpr int NWAVES = 8;
#ifndef MK_N_LAUNCHES
#define MK_N_LAUNCHES 1
#endif
constexpr int N_PHASES = 24;
static_assert(MK_N_LAUNCHES == 1 || MK_N_LAUNCHES == N_PHASES, "MK_N_LAUNCHES is 1 or 24");

constexpr int S_ = 16384, DM_ = 2048, INW = 6144, NEXP = 16, DEXP = 1024, DEPTH = 2, NROWBLK = 256  ;
constexpr int C_QA = 0, C_KA = 512, C_VA = 1024, C_QB = 1536, C_KB = 2048, C_VB = 2560, C_QC = 3072, C_KC = 4096, C_VC = 5120;
constexpr int MAXPOS = 2 * S_ + NEXP * 256;
constexpr float RMS_EPS = 1e-6f;
#ifndef ATT_PV8
#define ATT_PV8 1
#endif
constexpr float VT8_SCALE = 16.f;
#ifndef ATT_QK8
#define ATT_QK8 1
#endif
#ifndef ATT_R8
#define ATT_R8 1
#endif
#ifndef ABLV
#define ABLV 0
#endif
#ifndef ATT_SUMMFMA
#define ATT_SUMMFMA 0
#endif
#ifndef SEL_PASSES
#define SEL_PASSES 1
#endif
#ifndef SEL_MFMA
#define SEL_MFMA 1
#endif
#ifndef WC_INLOOP
#define WC_INLOOP 1
#endif
#ifndef GEMM_SP2
#define GEMM_SP2 true
#endif
#ifndef PROJ_FP8
#define PROJ_FP8 1
#endif
#ifndef OUT_FP8
#define OUT_FP8 3
#endif

constexpr size_t MiB = 1u << 20;
constexpr size_t WS_CTL = 0, CTL_ZERO_BYTES = 1 * MiB;
constexpr size_t WS_MOD = 1 * MiB;
constexpr size_t WS_COS = 2 * MiB, WS_SIN = 4 * MiB;
constexpr size_t WS_EID = 6 * MiB;
constexpr size_t WS_WTS = WS_EID + 131072;
constexpr size_t WS_ROWTOK = WS_WTS + 131072;
constexpr size_t WS_ROWW = WS_ROWTOK + 163840;
constexpr size_t WS_CNT = WS_ROWW + 163840;
constexpr size_t WS_KMEAN = 8 * MiB;
constexpr size_t WS_WIN = 16 * MiB;
constexpr size_t WS_WOUT = 64 * MiB;
constexpr size_t WS_WGU = 80 * MiB;
constexpr size_t WS_WDN = 336 * MiB;
constexpr size_t WS_H = 464 * MiB;
constexpr size_t WS_PROJ = 528 * MiB;
constexpr size_t WS_MERGED = 720 * MiB;
constexpr size_t WS_T = 784 * MiB;
constexpr size_t WS_VT8 = 848 * MiB;
constexpr size_t WS_K8 = 864 * MiB;
constexpr size_t WS_ACT = 912 * MiB;
constexpr size_t WS_XS = 984 * MiB;
constexpr size_t WS_POA = WS_ACT;
constexpr size_t WS_POB = WS_POA + 48 * MiB;
constexpr size_t WS_PLA = WS_POB + 64 * MiB;
constexpr size_t WS_PLB = WS_PLA + 2 * MiB;
constexpr size_t WS_LIST = WS_PLB + 2 * MiB;
static_assert(WS_LIST + 32 * MiB <= 1128 * MiB, "partials and lists inside the MoE-only regions");
constexpr size_t WS_Y = WS_PROJ;
constexpr size_t WS_XB = 1128 * MiB;
constexpr size_t WS_END = 1192 * MiB;
static_assert(WS_WIN == wconv::D_WIN && WS_WOUT == wconv::D_WOUT && WS_WGU == wconv::D_WGU && WS_WDN == wconv::D_WDN, "wconv destinations");
static_assert(WS_XS + (size_t)MAXPOS * 2048 * 2 <= WS_END && WS_ACT + (size_t)MAXPOS * 1024 * 2 <= WS_XS && WS_CNT + 16384 <= WS_KMEAN, "d_ws map");
constexpr int CW_TMO = 0, CW_CODE = 1, CW_BAR = 4096;
constexpr int CW_CNTB = 65536, CNTB_PITCH = 32;
constexpr int CW_SELDONE = 8192 + 2048;
constexpr int CW_QUEUE = 8192 + 1024;

constexpr int RING_OFF = 0, RING_BYTES = 131072;
constexpr int LDSCTL_OFF = RING_BYTES, MISC_OFF = LDSCTL_OFF + 320;
constexpr int LT_SEGS = LDSCTL_OFF + 1024;
constexpr int LT_TOT = LT_SEGS + 128;
constexpr int LT_BASE = LT_TOT + 64;
constexpr int LT_CNT = LT_BASE + 64;
constexpr int LT_P2E = LT_CNT + 64;
constexpr int LT_POS = LT_P2E + 160;
constexpr int LDS_BYTES = 163840;
constexpr int ATT_OST_OFF = 147456;
constexpr int ATT_KM_OFF = 0;
constexpr int ATT_WSF_OFF = LDSCTL_OFF + 4096;
constexpr int ATT_UST_OFF = LDSCTL_OFF + 8192, ATT_QN_OFF = ATT_UST_OFF + 2304, ATT_GB_OFF = ATT_QN_OFF + 128;
static_assert(attn_body::R_LDS_BYTES + 32768 <= RING_BYTES, "attention unit key-tile groups + weight-copy stage");
static_assert(LT_POS + 512 <= LDSCTL_OFF + 4096 && attn_body::ATTN_LDS_BYTES <= RING_BYTES && attn_body::X_LDS_BYTES <= RING_BYTES && 2 * attn_body::BRA_GRP_BYTES <= RING_BYTES && ATT_GB_OFF + 64 <= LDS_BYTES, "LDS map");

#define GAS __attribute__((address_space(1)))
#define LAS __attribute__((address_space(3)))
typedef unsigned short bf16;
typedef unsigned v4u __attribute__((ext_vector_type(4)));
typedef unsigned v2u __attribute__((ext_vector_type(2)));
typedef float f32x4 __attribute__((ext_vector_type(4)));
typedef short bf16x8 __attribute__((ext_vector_type(8)));
typedef GAS unsigned gu32;
#define RLX_AGENT __ATOMIC_RELAXED, __HIP_MEMORY_SCOPE_AGENT
#define LDS_WAIT() asm volatile("s_waitcnt lgkmcnt(0)" ::: "memory")
__device__ __forceinline__ unsigned f2bf(float f) { unsigned u = __builtin_bit_cast(unsigned, f); return (u + 0x7fffu + ((u >> 16) & 1u)) >> 16; }
__device__ __forceinline__ unsigned pk2(float lo, float hi) { return f2bf(lo) | (f2bf(hi) << 16); }
__device__ __forceinline__ float bflo(unsigned w) { return __builtin_bit_cast(float, w << 16); }
__device__ __forceinline__ float bfhi(unsigned w) { return __builtin_bit_cast(float, w & 0xffff0000u); }
#ifndef USE_NT
#define USE_NT 1
#endif
#if USE_NT
#define NTL(p) __builtin_nontemporal_load(p)
#define NTS(v, p) __builtin_nontemporal_store((v), (p))
#else
#define NTL(p) (*(p))
#define NTS(v, p) (*(p) = (v))
#endif
__device__ __forceinline__ float shx(float v, int o, int lane) { return __builtin_bit_cast(float, __builtin_amdgcn_ds_bpermute((lane ^ o) << 2, __builtin_bit_cast(int, v))); }
__device__ __forceinline__ int shup_i(int v, int o, int lane) { return __builtin_amdgcn_ds_bpermute(((lane - o) & 63) << 2, v); }
__device__ __forceinline__ float wave_sum(float v, int lane) {
#pragma unroll
    for (int o = 1; o < 64; o <<= 1) v += shx(v, o, lane);
    return v;
}

#define XB_TMO      128
#define XB_XCNT(j)  (256  + 64 * (j))
#define XB_XSUB(j)  (1280 + 64 * (j))
#define XB_XGEN(j)  (2304 + 64 * (j))
#define XB_TOP      3328
#define XB_TOPGEN   3392
#define XCD_BAR_WORDS 3456
#define XB_SPIN_CAP (1u << 18)

__device__ __forceinline__ unsigned xb_ld(unsigned* p)              { return __hip_atomic_load(p, __ATOMIC_RELAXED, __HIP_MEMORY_SCOPE_AGENT); }
__device__ __forceinline__ unsigned xb_add(unsigned* p, unsigned v) { return __hip_atomic_fetch_add(p, v, __ATOMIC_RELAXED, __HIP_MEMORY_SCOPE_AGENT); }
__device__ __forceinline__ unsigned xb_xcc_id() { return (unsigned)__builtin_amdgcn_s_getreg((3 << 11) | 20) & 0xFu; }
#define XB_SPIN(cond, bar) do { unsigned _sp = 0; while (cond) { __builtin_amdgcn_s_sleep(1); \
    if ((++_sp & 255u) == 0u) { if (xb_ld(&(bar)[XB_TMO])) break; if (_sp > XB_SPIN_CAP) { atomicAdd(&(bar)[XB_TMO], 1u); break; } } } } while (0)

struct XcdBarrier {
    unsigned* bar; unsigned x;
    volatile LAS unsigned* st;
};

__device__ __forceinline__ XcdBarrier xcd_barrier_post(unsigned* bar, volatile LAS unsigned* st) {
    XcdBarrier b; b.bar = bar; b.x = xb_xcc_id(); b.st = st;
    if (threadIdx.x == 0) (void)xb_add(&bar[XB_XCNT(b.x)], 1u);
    return b;
}
__device__ __forceinline__ void xcd_barrier_complete(unsigned* bar, unsigned x, unsigned& nloc, unsigned& nx) {
    const unsigned G = gridDim.x * gridDim.y * gridDim.z;
    unsigned sum, cnt, mine, sp = 0u;
    for (;;) {
        sum = 0u; cnt = 0u; mine = 0u;
#pragma unroll
        for (unsigned j = 0; j < 16; ++j) { const unsigned c = xb_ld(&bar[XB_XCNT(j)]); sum += c; cnt += (c > 0u) ? 1u : 0u; mine = (j == x) ? c : mine; }
        if (sum == G) break;
        __builtin_amdgcn_s_sleep(1);
        if ((++sp & 255u) == 0u) { if (xb_ld(&bar[XB_TMO])) break; if (sp > XB_SPIN_CAP) { atomicAdd(&bar[XB_TMO], 1u); break; } }
    }
    nloc = mine > 0u ? mine : 1u; nx = cnt > 0u ? cnt : 1u;
}

__device__ __forceinline__ void xcd_barrier(const XcdBarrier& b) {
    asm volatile("s_waitcnt vmcnt(0)" ::: "memory");
    __syncthreads();
    if (threadIdx.x == 0) {
        unsigned* bar = b.bar; asm volatile("" : "+s"(bar)); unsigned bx_ = b.x; asm volatile("" : "+s"(bx_));
        __builtin_amdgcn_s_waitcnt(0);
        unsigned nloc = b.st[0], nx = b.st[1];
        if (nloc == 0u) { xcd_barrier_complete(bar, bx_, nloc, nx); b.st[0] = nloc; b.st[1] = nx; }
        const unsigned old = xb_add(&bar[XB_XSUB(bx_)], 1u);
        const unsigned gen = old / nloc;
        if (old + 1u == (gen + 1u) * nloc) {
            __builtin_amdgcn_fence(__ATOMIC_RELEASE, "agent");
            asm volatile("s_waitcnt vmcnt(0)" ::: "memory");
            const unsigned og = xb_add(&bar[XB_TOP], 1u);
            const unsigned tg = og / nx;
            if (og + 1u == (tg + 1u) * nx) xb_add(&bar[XB_TOPGEN], 1u);
            else XB_SPIN(xb_ld(&bar[XB_TOPGEN]) == tg, bar);
            __builtin_amdgcn_fence(__ATOMIC_ACQUIRE, "agent");
            xb_add(&bar[XB_XGEN(bx_)], 1u);
            asm volatile("s_waitcnt vmcnt(0)" ::: "memory");
        } else {
            XB_SPIN(xb_ld(&bar[XB_XGEN(bx_)]) == gen, bar);
            __builtin_amdgcn_fence(__ATOMIC_ACQUIRE, "agent");
            asm volatile("s_waitcnt vmcnt(0)" ::: "memory");
        }
    }
    __syncthreads();
}


struct TItem { const float* W; unsigned char* WT; int K, N, map, item, b16; float wsc; };
__device__ __forceinline__ void titem_load(const TItem& t, float (&tv)[32], int lane) {
    const int nblk = t.N / 32, kb = t.item / nblk, nb = t.item % nblk, k0 = 64 * kb, n0 = 32 * nb;
#pragma unroll
    for (int i = 0; i < 32; ++i) tv[i] = t.W[(size_t)(k0 + 2 * i + (lane >> 5)) * t.N + n0 + (lane & 31)];
}
__device__ __forceinline__ void titem_finish(const TItem& t, const float (&tv)[32], LAS float* scr, int lane) {
    const int nblk = t.N / 32, kb = t.item / nblk, nb = t.item % nblk, k0 = 64 * kb, n0 = 32 * nb;
#pragma unroll
    for (int i = 0; i < 32; ++i) scr[(2 * i + (lane >> 5)) * 33 + (lane & 31)] = tv[i] * t.wsc;
    LDS_WAIT(); asm volatile("" ::: "memory");
    if (t.b16) { const int c = lane & 7;
#pragma unroll
        for (int j = 0; j < 4; ++j) { const int n = (lane >> 3) + 8 * j; const LAS float* sp = scr + (8 * c) * 33 + n;
            v4u o; o.x = pk2(sp[0 * 33], sp[1 * 33]); o.y = pk2(sp[2 * 33], sp[3 * 33]); o.z = pk2(sp[4 * 33], sp[5 * 33]); o.w = pk2(sp[6 * 33], sp[7 * 33]);
            *(GAS v4u*)((bf16*)t.WT + (size_t)dest_row(t.map, n0 + n) * t.K + k0 + 8 * c) = o; }
    } else { const int c = lane & 3;
#pragma unroll
        for (int j = 0; j < 2; ++j) { const int n = (lane >> 2) + 16 * j; const LAS float* sp = scr + (16 * c) * 33 + n;
            v4u o; o.x = pg8::pk4_fp8(sp[0 * 33], sp[1 * 33], sp[2 * 33], sp[3 * 33]); o.y = pg8::pk4_fp8(sp[4 * 33], sp[5 * 33], sp[6 * 33], sp[7 * 33]);
            o.z = pg8::pk4_fp8(sp[8 * 33], sp[9 * 33], sp[10 * 33], sp[11 * 33]); o.w = pg8::pk4_fp8(sp[12 * 33], sp[13 * 33], sp[14 * 33], sp[15 * 33]);
            *(GAS v4u*)(t.WT + (size_t)dest_row(t.map, n0 + n) * t.K + k0 + 16 * c) = o; } }
    LDS_WAIT(); asm volatile("" ::: "memory");
}

struct Args { const void* in[20]; float* out; unsigned char* ws; int ph_lo, ph_hi; };

__global__ void __launch_bounds__(NWAVES * 64, 2) fwd(Args args) {
    extern __shared__ __attribute__((aligned(16))) unsigned char lds[];
    LAS unsigned char* const L = (LAS unsigned char*)lds;
    const int kG = gridDim.x, kbx = blockIdx.x;
    const int kwave = __builtin_amdgcn_readfirstlane((int)threadIdx.x >> 6);
    typedef __attribute__((address_space(4))) const Args* kargp_t;
#define PHASE_BEGIN() \
    kargp_t ka = (kargp_t)__builtin_amdgcn_kernarg_segment_ptr(); asm volatile("" : "+s"(ka)); \
    unsigned char* const ws = ka->ws; \
    int lane; asm volatile("v_mbcnt_lo_u32_b32 %0, -1, 0\n\tv_mbcnt_hi_u32_b32 %0, -1, %0" : "=v"(lane)); \
    int G = kG, bx = kbx, wave_s = kwave; asm volatile("" : "+s"(G), "+s"(bx), "+s"(wave_s));     \
    const int vcu = (G % 8 == 0) ? (bx % 8) * (G / 8) + bx / 8 : bx; const int NGW = G * NWAVES; \
    const int wave = wave_s; const int tid = wave * 64 + lane; const int gw = vcu * NWAVES + wave; (void)gw; (void)lane; (void)ws; (void)tid; (void)NGW
#define KIN(T, k) ((const T*)ka->in[k])
    LAS int* const segs = (LAS int*)(L + LT_SEGS); LAS int* const tot = (LAS int*)(L + LT_TOT); LAS int* const basee = (LAS int*)(L + LT_BASE); LAS int* const cnt16 = (LAS int*)(L + LT_CNT);
    LAS unsigned char* const p2e = L + LT_P2E; LAS int* const postab = (LAS int*)(L + LT_POS);
    gu32* const ctl = (gu32*)(args.ws + WS_CTL);

    for (int u = threadIdx.x; u < (LDS_BYTES - LDSCTL_OFF) / 4; u += NWAVES * 64) ((LAS unsigned*)(L + LDSCTL_OFF))[u] = 0u;
    __syncthreads();
    const int lo = args.ph_lo, hi = args.ph_hi;
    XcdBarrier bar; bar.bar = (unsigned*)(ctl + CW_BAR); bar.x = 0; bar.st = nullptr;
    if (hi - lo > 1) bar = xcd_barrier_post((unsigned*)(ctl + CW_BAR), (volatile LAS unsigned*)(L + MISC_OFF) + 8);
#ifndef PHMASK
#define PHMASK 0x1fff
#endif
#define IN(k) (lo <= (k) && (k) < hi)
#define INJ(j) ((((PHMASK) >> (j)) & 1) && IN(pb + (j)))
#ifndef REPEAT_J
#define REPEAT_J (-1)
#endif
#ifndef REPEAT_L
#define REPEAT_L 0
#endif
#ifndef REPEAT_N
#define REPEAT_N 2
#endif
#define REPS(j) ((REPEAT_J == (j) && l == REPEAT_L) ? REPEAT_N : 1)
#if defined(STAMP_A)
    LAS unsigned long long* const stamps = (LAS unsigned long long*)(L + LDSCTL_OFF + 2048); int n_stamp = 0;
#define STAMP() do { if (kbx == 0 && threadIdx.x == 0) stamps[n_stamp] = __builtin_amdgcn_s_memrealtime(); ++n_stamp; } while (0)
    STAMP();
#else
#define STAMP() do { } while (0)
#endif
#define SEAM(k) do { if (IN(k) && IN((k) + 1)) { xcd_barrier(bar); STAMP(); } } while (0)

#define COMPUTE_SEGMENTS(myrb) do { \
        _Pragma("unroll") for (int q_ = 0; q_ < 2; ++q_) { const int e_ = 2 * wave + q_; int t_ = 0, p_ = 0; \
            _Pragma("unroll") for (int j_ = 0; j_ < 4; ++j_) { const int rb_ = lane + 64 * j_; const int c_ = CNT[rb_ * 16 + e_]; t_ += c_; p_ += (rb_ < (myrb)) ? c_ : 0; } \
            t_ = (int)wave_sum((float)t_, lane); p_ = (int)wave_sum((float)p_, lane); if (lane == 0) { tot[e_] = t_; basee[e_] = p_; } } \
        __syncthreads(); \
        if (tid == 0) { int s_ = 0; for (int e_ = 0; e_ < 16; ++e_) { segs[e_] = s_; s_ += (tot[e_] + 255) & ~255; } segs[16] = s_; } \
        __syncthreads(); \
        if (tid < 160) { const int r_ = tid * 256; int e_ = 0; for (int k_ = 1; k_ < 16; ++k_) if (r_ >= segs[k_]) e_ = k_; p2e[tid] = (unsigned char)e_; } \
        if (tid < 16) basee[tid] += segs[tid]; \
        __syncthreads(); } while (0)

    if (((PHMASK >> 11) & 1) && IN(0)) for (int rp = 0; rp < ((REPEAT_J == 11) ? REPEAT_N : 1); ++rp) {
        PHASE_BEGIN();
        const float* const c_in = KIN(float, 1); const int* const positions = KIN(int, 2); const float* const w_ada = KIN(float, 3); const float* const b_ada = KIN(float, 4);
        const float* const w_in = KIN(float, 7); const float* const w_out = KIN(float, 8); const float* const w_gate = KIN(float, 14); const float* const w_up = KIN(float, 15); const float* const w_down = KIN(float, 16);
        float* const MOD = (float*)(ws + WS_MOD); float* const COS = (float*)(ws + WS_COS); float* const SIN = (float*)(ws + WS_SIN);
        unsigned char* const WIN = ws + WS_WIN; unsigned char* const WOUT = ws + WS_WOUT; unsigned char* const WGU = ws + WS_WGU; unsigned char* const WDN = ws + WS_WDN;
        for (int it = bx; it < 192; it += G) {
            const int l = it / 96, cg = it % 96, col = cg * 128 + lane * 2;
            const float* W = w_ada + ((size_t)l * 2048 + wave * 256) * 12288 + col; const float* cc = c_in + wave * 256;
            typedef float f32x2 __attribute__((ext_vector_type(2)));
            f32x2 a = (f32x2){0.f, 0.f};
#pragma unroll 32
            for (int k = 0; k < 256; ++k) { const float cv = cc[k]; const float sv = cv / (1.f + expf(-cv)); a += sv * *(const GAS f32x2*)(W + (size_t)k * 12288); }
            LAS f32x2* red = (LAS f32x2*)L; red[wave * 64 + lane] = a;
            __syncthreads();
            if (tid < 128) { float s = 0.f; const LAS float* rf = (const LAS float*)L;
#pragma unroll
                for (int w = 0; w < 8; ++w) s += rf[(w * 64 + (tid >> 1)) * 2 + (tid & 1)];
                MOD[l * 12288 + cg * 128 + tid] = s + b_ada[l * 12288 + cg * 128 + tid]; }
            __syncthreads();
        }
        { LAS float* scr = (LAS float*)(L + RING_OFF + wave * 16384);
          constexpr int I_IN = (PROJ_FP8 ? 1 : 2) * 32 * 192, N_OUT16 = 2 - ((OUT_FP8 & 1) + ((OUT_FP8 >> 1) & 1)), I_OUT = N_OUT16 * 32 * 64, NITEMS = I_IN + I_OUT;
#define TDECODE(T, it_) do { int r = (it_); \
              if (r < I_IN) { const int l_ = r / 6144; T.W = w_in + (size_t)l_ * 2048 * 6144; T.K = 2048; T.N = 6144; T.map = 1; T.item = r % 6144; T.b16 = PROJ_FP8 ? 0 : 1; T.wsc = PROJ_FP8 ? WSC_K2048 : 1.f; T.WT = WIN + (size_t)l_ * 6144 * (PROJ_FP8 ? 2048 : 4096); break; } r -= I_IN; \
              { const int l_ = (r / 2048 == 0) ? ((OUT_FP8 & 1) ? 1 : 0) : 1; T.W = w_out + (size_t)l_ * 2048 * 2048; T.K = 2048; T.N = 2048; T.map = 0; T.item = r % 2048; T.b16 = 1; T.wsc = 1.f; T.WT = WOUT + (size_t)l_ * 2048 * 4096; } } while (0)
          gu32* const tq = ctl + CW_QUEUE + 256;
          for (;;) {
              int c0 = 0; if (lane == 0) c0 = (int)__hip_atomic_fetch_add(tq, 1u, RLX_AGENT);
              c0 = __builtin_amdgcn_readfirstlane(c0) * 16; if (c0 >= NITEMS) break;
              const int c1 = (c0 + 16 < NITEMS) ? c0 + 16 : NITEMS;
              TItem cur; TDECODE(cur, c0); float tv[32]; titem_load(cur, tv, lane);
              for (int it = c0; it < c1; ++it) {
                  TItem nxt = cur; float tn[32]; const bool hn = it + 1 < c1;
                  if (hn) { TDECODE(nxt, it + 1); titem_load(nxt, tn, lane); }
                  titem_finish(cur, tv, scr, lane);
                  if (hn) { cur = nxt;
#pragma unroll
                      for (int i = 0; i < 32; ++i) tv[i] = tn[i]; }
              }
          }
#undef TDECODE
        }
        for (int idx = (vcu * NWAVES * 64 + tid); idx < S_ * 32; idx += G * NWAVES * 64) {
            const int pi = idx >> 5, i = idx & 31; const float inv = (float)exp2(-(double)i * (13.287712379549449 / 32.0)); const float ang = (float)positions[pi] * inv;
            COS[idx] = cosf(ang); SIN[idx] = sinf(ang); }
    }
    SEAM(0);

#if defined(EXTRA_BARRIERS)
    if (lo == 0 && hi - lo > 1) for (int xb = 0; xb < EXTRA_BARRIERS; ++xb) xcd_barrier(bar);
#endif
    for (int l = 0; l < DEPTH; ++l) {
        const int pb = 1 + 11 * l;
        const float lam_init = (l == 0) ? 0.2f : 0.35550906759f;
        if (INJ(0)) for (int rp = 0; rp < REPS(0); ++rp) {
            PHASE_BEGIN();
            const float* const x_in = KIN(float, 0); const float* const g_attn = KIN(float, 5); bf16* const xbuf = (bf16*)(ws + WS_XB);
            const float* const MOD = (const float*)(ws + WS_MOD); const float* const mod = MOD + l * 12288; unsigned char* const HB = ws + WS_H; const bf16* const YB = (const bf16*)(ws + WS_Y);
            LAS f32x4* const cAl = (LAS f32x4*)L; LAS f32x4* const cBl = cAl + 512; LAS f32x4* const cGl = cAl + 1024;
            { const int c4 = tid; const f32x4 g = ((const f32x4*)(g_attn + l * 2048))[c4]; const f32x4 sc = ((const f32x4*)(mod + 2048))[c4];
              cAl[c4] = g * (1.f + sc); cBl[c4] = ((const f32x4*)(mod + 0))[c4]; cGl[c4] = (l > 0) ? ((const f32x4*)(MOD + (l - 1) * 12288 + 10240))[c4] : (f32x4){0.f, 0.f, 0.f, 0.f}; }
            __syncthreads();
#define XLOAD(WY_, dst, r_) do { if (WY_) { const v2u xw_ = NTL((const GAS v2u*)(xbuf + (size_t)(r_) * 2048) + (lane + 64 * j)); dst = (f32x4){bflo(xw_.x), bfhi(xw_.x), bflo(xw_.y), bfhi(xw_.y)}; } \
                              else dst = NTL((const GAS f32x4*)(x_in + (size_t)(r_) * 2048) + (lane + 64 * j)); } while (0)
#define NORM_LOOP(WITH_Y) do { \
            f32x4 nv[8]; v2u na[8], nb[8]; \
            _Pragma("unroll") for (int j = 0; j < 8; ++j) { XLOAD(WITH_Y, nv[j], gw); \
                if (WITH_Y) { na[j] = NTL((const GAS v2u*)(YB + (size_t)(2 * gw) * 2048) + (lane + 64 * j)); nb[j] = NTL((const GAS v2u*)(YB + (size_t)(2 * gw + 1) * 2048) + (lane + 64 * j)); } } \
            for (int row = gw; row < S_; row += NGW) { \
                f32x4 v[8]; \
                _Pragma("unroll") for (int j = 0; j < 8; ++j) v[j] = nv[j]; \
                if (WITH_Y) { \
                    _Pragma("unroll") for (int j = 0; j < 8; ++j) { const v2u a = na[j], b = nb[j]; \
                        const f32x4 ys = (f32x4){bflo(a.x) + bflo(b.x), bfhi(a.x) + bfhi(b.x), bflo(a.y) + bflo(b.y), bfhi(a.y) + bfhi(b.y)}; \
                        v[j] += cGl[lane + 64 * j] * ys; v2u xo_; xo_.x = pk2(v[j].x, v[j].y); xo_.y = pk2(v[j].z, v[j].w); ((GAS v2u*)(xbuf + (size_t)row * 2048))[lane + 64 * j] = xo_; \
                        v[j] = (f32x4){bflo(xo_.x), bfhi(xo_.x), bflo(xo_.y), bfhi(xo_.y)}; } \
                } \
                const int nrow = row + NGW; \
                if (nrow < S_) { \
                    _Pragma("unroll") for (int j = 0; j < 8; ++j) { XLOAD(WITH_Y, nv[j], nrow); \
                        if (WITH_Y) { na[j] = NTL((const GAS v2u*)(YB + (size_t)(2 * nrow) * 2048) + (lane + 64 * j)); nb[j] = NTL((const GAS v2u*)(YB + (size_t)(2 * nrow + 1) * 2048) + (lane + 64 * j)); } } \
                } \
                float ss = 0.f; \
                _Pragma("unroll") for (int j = 0; j < 8; ++j) ss += (v[j].x * v[j].x + v[j].y * v[j].y) + (v[j].z * v[j].z + v[j].w * v[j].w); \
                const float rs = 1.f / sqrtf(wave_sum(ss, lane) * (1.f / 2048.f) + RMS_EPS); \
                _Pragma("unroll") for (int j = 0; j < 8; ++j) { const f32x4 o = v[j] * rs * cAl[lane + 64 * j] + cBl[lane + 64 * j]; \
                    if (PROJ_FP8) ((GAS unsigned*)(HB + (size_t)row * 2048))[lane + 64 * j] = pg8::pk4_fp8(o.x, o.y, o.z, o.w); \
                    else { v2u w; w.x = pk2(o.x, o.y); w.y = pk2(o.z, o.w); ((GAS v2u*)((bf16*)HB + (size_t)row * 2048))[lane + 64 * j] = w; } } \
            } } while (0)
            if (l == 0) NORM_LOOP(false); else NORM_LOOP(true);
#undef NORM_LOOP
#undef XLOAD
        }
        SEAM(pb + 0);
        if (INJ(1)) for (int rp = 0; rp < REPS(1); ++rp) {
            PHASE_BEGIN();
            unsigned char* const HB = ws + WS_H; unsigned char* const WIN = ws + WS_WIN; bf16* const PROJ = (bf16*)(ws + WS_PROJ); const float* const COS = (const float*)(ws + WS_COS); const float* const SIN = (const float*)(ws + WS_SIN);
            constexpr int KBP = PROJ_FP8 ? 2048 : 4096;
            pg8::DenseSched Sd; Sd.init(HB, WIN + (size_t)l * 6144 * KBP, S_, INW, KBP, G, bx);
            pg8::EpiProj E{PROJ, COS, SIN, attn_body::C2, PROJ_FP8 ? 1.f / WSC_K2048 : 1.f};
            pg8::gemm_phase<pg8::EpiProj, pg8::DenseSched, true, GEMM_SP2, PROJ_FP8 != 0>(L + RING_OFF, KBP, Sd, E, wave_s);
        }
        SEAM(pb + 1);
        if (INJ(2)) for (int rp = 0; rp < REPS(2); ++rp) {
            PHASE_BEGIN();
            const bf16* const PROJ = (const bf16*)(ws + WS_PROJ); float* const KMEAN = (float*)(ws + WS_KMEAN);
#if ATT_PV8 && ATT_QK8
            for (int t = gw; t < 4096; t += NGW) { const int st = t >> 8, kt = t & 255, hd2 = st >> 1, mp2 = st & 1, c = lane & 3;
                const bf16* const src = PROJ + (size_t)(64 * kt) * 6144 + C_KC + hd2 * 128 + mp2 * 64 + c * 16;
                unsigned char* const dst = ws + WS_K8 + (size_t)t * 4096;
                v4u ka[4], kb[4];
#pragma unroll
                for (int p = 0; p < 4; ++p) { const int key = 16 * p + (lane >> 2); ka[p] = *(const GAS v4u*)(src + (size_t)key * 6144); kb[p] = *(const GAS v4u*)(src + (size_t)key * 6144 + 8); }
#pragma unroll
                for (int p = 0; p < 4; ++p) { const int key = 16 * p + (lane >> 2); const v4u a = ka[p], b = kb[p];
                    v4u o; o.x = pg8::pk4_fp8(bflo(a.x), bfhi(a.x), bflo(a.y), bfhi(a.y)); o.y = pg8::pk4_fp8(bflo(a.z), bfhi(a.z), bflo(a.w), bfhi(a.w));
                    o.z = pg8::pk4_fp8(bflo(b.x), bfhi(b.x), bflo(b.y), bfhi(b.y)); o.w = pg8::pk4_fp8(bflo(b.z), bfhi(b.z), bflo(b.w), bfhi(b.w));
                    *(GAS v4u*)(dst + key * 64 + ((c ^ ((key >> 2) & 3)) * 16)) = o; }
            }
#endif
#if ATT_PV8
            for (int t = gw; t < 2048; t += NGW) { const int h = t >> 8, kt = t & 255;
                const bf16* const src = PROJ + (size_t)(64 * kt) * 6144 + C_VC + h * 128 + 2 * lane;
                unsigned char* const dst = ws + WS_VT8 + (size_t)t * 8192 + (size_t)(2 * lane) * 64; const int sw = (lane >> 1) & 3;
                unsigned oa[16], ob[16];
#pragma unroll
                for (int g = 0; g < 16; ++g) { unsigned w0, w1, w2, w3;
                    w0 = *(const GAS unsigned*)(src + (size_t)(4 * g + 0) * 6144); w1 = *(const GAS unsigned*)(src + (size_t)(4 * g + 1) * 6144);
                    w2 = *(const GAS unsigned*)(src + (size_t)(4 * g + 2) * 6144); w3 = *(const GAS unsigned*)(src + (size_t)(4 * g + 3) * 6144);
                    const int w = (g & 1) * 8 + ((g >> 3) & 1) * 4 + ((g >> 1) & 3);
                    oa[w] = pg8::pk4_fp8(bflo(w0) * VT8_SCALE, bflo(w1) * VT8_SCALE, bflo(w2) * VT8_SCALE, bflo(w3) * VT8_SCALE);
                    ob[w] = pg8::pk4_fp8(bfhi(w0) * VT8_SCALE, bfhi(w1) * VT8_SCALE, bfhi(w2) * VT8_SCALE, bfhi(w3) * VT8_SCALE); }
#pragma unroll
                for (int c = 0; c < 4; ++c) { *(GAS v4u*)(dst + ((c ^ sw) * 16)) = (v4u){oa[4 * c], oa[4 * c + 1], oa[4 * c + 2], oa[4 * c + 3]};
                    *(GAS v4u*)(dst + 64 + ((c ^ sw) * 16)) = (v4u){ob[4 * c], ob[4 * c + 1], ob[4 * c + 2], ob[4 * c + 3]}; }
            }
#endif
            for (int t = gw; t < 512; t += NGW) { const int h = t >> 6, j = t & 63; const int rg = lane >> 3, ch = lane & 7;
                float a[8];
#pragma unroll
                for (int e = 0; e < 8; ++e) a[e] = 0.f;
                for (int hb = 0; hb < 2; ++hb) { v4u kw[16];
#pragma unroll
                    for (int it = 0; it < 16; ++it) kw[it] = *(const GAS v4u*)(PROJ + (size_t)(256 * j + 8 * (16 * hb + it) + rg) * 6144 + C_KB + 64 * h + 8 * ch);
#pragma unroll
                    for (int it = 0; it < 16; ++it) { const v4u w = kw[it];
                        a[0] += bflo(w.x); a[1] += bfhi(w.x); a[2] += bflo(w.y); a[3] += bfhi(w.y); a[4] += bflo(w.z); a[5] += bfhi(w.z); a[6] += bflo(w.w); a[7] += bfhi(w.w); } }
#pragma unroll
                for (int e = 0; e < 8; ++e) { a[e] += shx(a[e], 8, lane); a[e] += shx(a[e], 16, lane); a[e] += shx(a[e], 32, lane); }
                if (lane < 8) {
#pragma unroll
                    for (int e = 0; e < 8; ++e) KMEAN[(size_t)(h * 64 + j) * 64 + 8 * lane + e] = a[e] * (1.f / 256.f); }
            }
        }
        SEAM(pb + 2);
        if (INJ(4)) for (int rp = 0; rp < REPS(4); ++rp) {
            PHASE_BEGIN();
            const bf16* const PROJ = (const bf16*)(ws + WS_PROJ); bf16* const TB = (bf16*)(ws + WS_T);
            char* const shm = (char*)lds + RING_OFF;
            if (rp == 0) for (int selp = 0; selp < SEL_PASSES; ++selp) {
            const float* const KMEAN = (const float*)(ws + WS_KMEAN); int* const LISTB = (selp == 0) ? (int*)(ws + WS_LIST) : (int*)(ws + (size_t)496 * MiB);
            int* const CNTB = (int*)(ctl + ((selp == 0) ? CW_CNTB : 131072 + 32768 * (selp - 1)) + l * 512 * CNTB_PITCH);
            for (int it = vcu; it < 512; it += G) { const int hd = it & 7, qq = it >> 3, qb = (qq & 1) ? 63 - (qq >> 1) : (qq >> 1);
                if (qb == 0) continue;
#if SEL_MFMA
                LAS unsigned char* const Bf = L; LAS float* const SC = (LAS float*)(L + 17408);
                __syncthreads();
                { const int ct = tid >> 7, ks = (tid >> 6) & 1, j = 16 * ct + (lane & 15), k0 = 32 * ks + 8 * (lane >> 4); float kv[8];
                  if (j < qb) { const f32x4 a = *(const GAS f32x4*)(KMEAN + (size_t)(hd * 64 + j) * 64 + k0), b = *(const GAS f32x4*)(KMEAN + (size_t)(hd * 64 + j) * 64 + k0 + 4);
                      kv[0] = a.x; kv[1] = a.y; kv[2] = a.z; kv[3] = a.w; kv[4] = b.x; kv[5] = b.y; kv[6] = b.z; kv[7] = b.w; }
                  else {
#pragma unroll
                      for (int i2 = 0; i2 < 8; ++i2) kv[i2] = 0.f; }
                  unsigned hi4[4], lo4[4];
#pragma unroll
                  for (int i2 = 0; i2 < 4; ++i2) { const float w0 = kv[2 * i2], w1 = kv[2 * i2 + 1]; const unsigned h0 = f2bf(w0), h1 = f2bf(w1);
                      const float r0 = w0 - __uint_as_float(h0 << 16), r1 = w1 - __uint_as_float(h1 << 16); hi4[i2] = h0 | (h1 << 16); lo4[i2] = f2bf(r0) | (f2bf(r1) << 16); }
                  *(LAS v4u*)(Bf + ((ct * 2 + ks) * 2 + 0) * 1024 + lane * 16) = (v4u){hi4[0], hi4[1], hi4[2], hi4[3]};
                  *(LAS v4u*)(Bf + ((ct * 2 + ks) * 2 + 1) * 1024 + lane * 16) = (v4u){lo4[0], lo4[1], lo4[2], lo4[3]}; }
                bf16x8 qa[2][2];
#pragma unroll
                for (int i = 0; i < 2; ++i)
#pragma unroll
                    for (int ks = 0; ks < 2; ++ks) qa[i][ks] = *(const GAS bf16x8*)(PROJ + (size_t)(qb * 256 + 32 * wave + 16 * i + (lane & 15)) * 6144 + C_QB + hd * 64 + 32 * ks + 8 * (lane >> 4));
                __syncthreads();
#pragma unroll
                for (int i = 0; i < 2; ++i)
#pragma unroll
                    for (int ct = 0; ct < 4; ++ct) { f32x4 acc = (f32x4){0.f, 0.f, 0.f, 0.f};
#pragma unroll
                        for (int ks = 0; ks < 2; ++ks) { const bf16x8 bh = *(const LAS bf16x8*)(Bf + ((ct * 2 + ks) * 2 + 0) * 1024 + lane * 16), bl = *(const LAS bf16x8*)(Bf + ((ct * 2 + ks) * 2 + 1) * 1024 + lane * 16);
                            acc = __builtin_amdgcn_mfma_f32_16x16x32_bf16(qa[i][ks], bh, acc, 0, 0, 0); acc = __builtin_amdgcn_mfma_f32_16x16x32_bf16(qa[i][ks], bl, acc, 0, 0, 0); }
#pragma unroll
                        for (int r = 0; r < 4; ++r) SC[(32 * wave + 16 * i + 4 * (lane >> 4) + r) * 65 + 16 * ct + (lane & 15)] = acc[r]; }
                __syncthreads();
                const int q = tid >> 1, dh = tid & 1;
                float b0 = -INFINITY, b1 = -INFINITY, b2 = -INFINITY; int i0 = -1, i1 = -1, i2 = -1;
                { const int jlo = 32 * dh, jhi = (qb < jlo + 32) ? qb : jlo + 32; const LAS float* const sr = SC + q * 65;
                  for (int j = jlo; j < jhi; ++j) { const float g = sr[j];
                      if (g > b0) { b2 = b1; i2 = i1; b1 = b0; i1 = i0; b0 = g; i0 = j; } else if (g > b1) { b2 = b1; i2 = i1; b1 = g; i1 = j; } else if (g > b2) { b2 = g; i2 = j; } } }
                { const float c0 = shx(b0, 1, lane), c1 = shx(b1, 1, lane), c2 = shx(b2, 1, lane);
                  const int d0 = __builtin_amdgcn_ds_bpermute((lane ^ 1) << 2, i0), d1 = __builtin_amdgcn_ds_bpermute((lane ^ 1) << 2, i1), d2 = __builtin_amdgcn_ds_bpermute((lane ^ 1) << 2, i2);
#define SEL_INS(g_, j_) do { const float g = (g_); const int j = (j_); if (g > b0) { b2 = b1; i2 = i1; b1 = b0; i1 = i0; b0 = g; i0 = j; } else if (g > b1) { b2 = b1; i2 = i1; b1 = g; i1 = j; } else if (g > b2) { b2 = g; i2 = j; } } while (0)
                  if (dh == 0) { SEL_INS(c0, d0); SEL_INS(c1, d1); SEL_INS(c2, d2); }
#undef SEL_INS
                }
#else
                LAS float* km = (LAS float*)(L + ATT_KM_OFF);
                __syncthreads();
                for (int k4 = tid; k4 < qb * 16; k4 += NWAVES * 64) ((LAS f32x4*)km)[k4] = ((const GAS f32x4*)(KMEAN + (size_t)hd * 64 * 64))[k4];
                const int q = tid >> 1, dh = tid & 1; float qf[32];
                { const bf16* qrow = PROJ + (size_t)(qb * 256 + q) * 6144 + C_QB + hd * 64 + dh * 32;
#pragma unroll
                  for (int c8 = 0; c8 < 4; ++c8) { const v4u w = *(const GAS v4u*)(qrow + 8 * c8); qf[8 * c8 + 0] = bflo(w.x); qf[8 * c8 + 1] = bfhi(w.x); qf[8 * c8 + 2] = bflo(w.y); qf[8 * c8 + 3] = bfhi(w.y);
                      qf[8 * c8 + 4] = bflo(w.z); qf[8 * c8 + 5] = bfhi(w.z); qf[8 * c8 + 6] = bflo(w.w); qf[8 * c8 + 7] = bfhi(w.w); } }
                __syncthreads();
                float b0 = -INFINITY, b1 = -INFINITY, b2 = -INFINITY; int i0 = -1, i1 = -1, i2 = -1;
                for (int j = 0; j < qb; ++j) { const LAS f32x4* kr = (const LAS f32x4*)(km + j * 64 + dh * 32); float g = 0.f;
#pragma unroll
                    for (int c4 = 0; c4 < 8; ++c4) { const f32x4 kv = kr[c4]; g = fmaf(qf[4 * c4 + 0], kv.x, g); g = fmaf(qf[4 * c4 + 1], kv.y, g); g = fmaf(qf[4 * c4 + 2], kv.z, g); g = fmaf(qf[4 * c4 + 3], kv.w, g); }
                    g += shx(g, 1, lane);
                    if (g > b0) { b2 = b1; i2 = i1; b1 = b0; i1 = i0; b0 = g; i0 = j; } else if (g > b1) { b2 = b1; i2 = i1; b1 = g; i1 = j; } else if (g > b2) { b2 = g; i2 = j; } }
#endif
                { LAS int* const lc = (LAS int*)(L + 16384); LAS int* const lb = lc + 64;
                  if (tid < 64) lc[tid] = 0;
                  __syncthreads();
                  int r0 = 0, r1 = 0, r2 = 0;
                  if (dh == 0) { if (i0 >= 0) r0 = __hip_atomic_fetch_add((int*)(lc + i0), 1, __ATOMIC_RELAXED, __HIP_MEMORY_SCOPE_WORKGROUP);
                                 if (i1 >= 0) r1 = __hip_atomic_fetch_add((int*)(lc + i1), 1, __ATOMIC_RELAXED, __HIP_MEMORY_SCOPE_WORKGROUP);
                                 if (i2 >= 0) r2 = __hip_atomic_fetch_add((int*)(lc + i2), 1, __ATOMIC_RELAXED, __HIP_MEMORY_SCOPE_WORKGROUP); }
                  __syncthreads();
                  if (tid < qb) { const int n = lc[tid]; lb[tid] = (n > 0) ? __hip_atomic_fetch_add(CNTB + (hd * 64 + tid) * CNTB_PITCH, n, RLX_AGENT) : 0; }
                  __syncthreads();
                  if (dh == 0) { const int row = qb * 256 + q;
                      if (i0 >= 0) LISTB[(size_t)(hd * 64 + i0) * 16384 + lb[i0] + r0] = row;
                      if (i1 >= 0) LISTB[(size_t)(hd * 64 + i1) * 16384 + lb[i1] + r1] = row | (1 << 16);
                      if (i2 >= 0) LISTB[(size_t)(hd * 64 + i2) * 16384 + lb[i2] + r2] = row | (2 << 16); } }
            }
            asm volatile("s_waitcnt vmcnt(0)" ::: "memory"); __syncthreads();
            if (selp == 0 && tid == 0) { __builtin_amdgcn_fence(__ATOMIC_RELEASE, "agent"); asm volatile("s_waitcnt vmcnt(0)" ::: "memory"); __hip_atomic_fetch_add(ctl + CW_SELDONE + 64 * l, 1u, RLX_AGENT); }
            }
            wconv::Tab wct; wct.w_in = KIN(float, 7); wct.w_out = KIN(float, 8); wct.w_gate = KIN(float, 14); wct.w_up = KIN(float, 15); wct.w_down = KIN(float, 16); wct.ws = ws; wct.l = l;
            wct.n_out = ((OUT_FP8 >> l) & 1) ? 4096 : 0; wct.total = wct.n_out + 65536 + 32768 + ((l == 0 && PROJ_FP8) ? 12288 : 0);
            wconv::State wcs; wcs.idx = gw; wcs.staged = gw; wcs.ctr = 0; wcs.stride = NGW;
            const unsigned wstage = (unsigned)(uintptr_t)(L + RING_OFF) + 98304u + 4096u * (unsigned)wave_s;
            if (rp == 0) { int ln3; asm volatile("v_mbcnt_lo_u32_b32 %0, -1, 0\n\tv_mbcnt_hi_u32_b32 %0, -1, %0" : "=v"(ln3)); wconv::issue(wct, wcs.idx, wstage, ln3); wcs.idx += wcs.stride; }
#if !defined(NO_ATT_C)
#if defined(REPEAT_SKIP_C)
            if (rp == 0)
#endif
            for (int vc = vcu; vc < 256; vc += G) {
                const int st = vc >> 4, hd = st >> 1, mp = st & 1, s = vc & 15;
                const attn_body::bf16* Qp = (const attn_body::bf16*)PROJ + C_QC + hd * 128 + mp * 64; const attn_body::bf16* Kp = (const attn_body::bf16*)PROJ + C_KC + hd * 128 + mp * 64;
                const attn_body::bf16* Vp = (const attn_body::bf16*)PROJ + C_VC + hd * 128; attn_body::bf16* Op = (attn_body::bf16*)TB + (size_t)mp * S_ * 1024 + hd * 128;
                for (int i = 3; i >= 0; --i) { const int qb = 32 * (i >> 1) + ((i & 1) ? 31 - s : s);
#if ATT_PV8 && ATT_QK8 && ATT_R8 && ATT_SUMMFMA
                    const unsigned char* const K8p = ws + WS_K8 + (size_t)st * 256 * 4096; float* const wsfc = (float*)((char*)lds + ATT_WSF_OFF);
                    if (rp == 0) attn_body::attn_unit128r9<8, WC_INLOOP != 0>(qb, Qp, K8p, ws + WS_VT8 + (size_t)hd * 256 * 8192, Op, 1024, shm, wsfc, wave_s, wct, wcs, wstage);
                    else attn_body::attn_unit128r9<8, false>(qb, Qp, K8p, ws + WS_VT8 + (size_t)hd * 256 * 8192, Op, 1024, shm, wsfc, wave_s, wct, wcs, wstage); }
#elif ATT_PV8 && ATT_QK8 && ATT_R8
                    const unsigned char* const K8p = ws + WS_K8 + (size_t)st * 256 * 4096; float* const wsfc = (float*)((char*)lds + ATT_WSF_OFF);
                    if (rp == 0) attn_body::attn_unit128r8<8, WC_INLOOP != 0>(qb, Qp, K8p, ws + WS_VT8 + (size_t)hd * 256 * 8192, Op, 1024, shm, wsfc, wave_s, wct, wcs, wstage);
                    else attn_body::attn_unit128r8<8, false>(qb, Qp, K8p, ws + WS_VT8 + (size_t)hd * 256 * 8192, Op, 1024, shm, wsfc, wave_s, wct, wcs, wstage); }
#elif ATT_PV8 && ATT_QK8
                    const unsigned char* const K8p = ws + WS_K8 + (size_t)st * 256 * 4096;
                    if (rp == 0) attn_body::attn_unit128q8<8, WC_INLOOP != 0>(qb, Qp, K8p, ws + WS_VT8 + (size_t)hd * 256 * 8192, Op, 1024, shm, wave_s, wct, wcs, wstage);
                    else attn_body::attn_unit128q8<8, false>(qb, Qp, K8p, ws + WS_VT8 + (size_t)hd * 256 * 8192, Op, 1024, shm, wave_s, wct, wcs, wstage); }
#elif ATT_PV8
                    if (rp == 0) attn_body::attn_unit128p8<8, WC_INLOOP != 0>(qb, Qp, Kp, ws + WS_VT8 + (size_t)hd * 256 * 8192, Op, 1024, shm, wave_s, wct, wcs, wstage);
                    else attn_body::attn_unit128p8<8, false>(qb, Qp, Kp, ws + WS_VT8 + (size_t)hd * 256 * 8192, Op, 1024, shm, wave_s, wct, wcs, wstage); }
#else
                    attn_body::attn_unit128<8>(qb, Qp, Kp, Vp, Op, 1024, shm, wave_s); }
#endif
            }
#endif
            if (rp == 0) { int ln3; asm volatile("v_mbcnt_lo_u32_b32 %0, -1, 0\n\tv_mbcnt_hi_u32_b32 %0, -1, %0" : "=v"(ln3));
                asm volatile("s_waitcnt vmcnt(0)" ::: "memory"); wconv::finish(wct, wcs.staged, wstage, ln3);
                while (wcs.idx < wct.total) { asm volatile("s_waitcnt lgkmcnt(0)" ::: "memory"); wconv::issue(wct, wcs.idx, wstage, ln3); asm volatile("s_waitcnt vmcnt(0)" ::: "memory"); wconv::finish(wct, wcs.idx, wstage, ln3); wcs.idx += wcs.stride; }
                asm volatile("s_waitcnt vmcnt(0) lgkmcnt(0)" ::: "memory"); }
            { int ln2; asm volatile("v_mbcnt_lo_u32_b32 %0, -1, 0\n\tv_mbcnt_hi_u32_b32 %0, -1, %0" : "=v"(ln2)); const int t2 = wave_s * 64 + ln2;
              LAS int* const ust = (LAS int*)(L + ATT_UST_OFF); LAS int* const wtot = ust + 520; LAS int* const qn = (LAS int*)(L + ATT_QN_OFF);
              const int* const CNTB = (const int*)(ctl + CW_CNTB + l * 512 * CNTB_PITCH);
              if (t2 == 0) { unsigned sp_ = 0; while (__hip_atomic_load(ctl + CW_SELDONE + 64 * l, RLX_AGENT) < (unsigned)G) { __builtin_amdgcn_s_sleep(2); if (++sp_ > (1u << 22)) break; }
                  __builtin_amdgcn_fence(__ATOMIC_ACQUIRE, "agent"); asm volatile("s_waitcnt vmcnt(0)" ::: "memory"); }
              if (t2 < 4) ((LAS unsigned*)(L + ATT_GB_OFF))[t2] = 0u;
              __syncthreads();
              const int nl = __hip_atomic_load(CNTB + t2 * CNTB_PITCH, RLX_AGENT); const int nch = (8 + ((nl + 31) >> 5) + 7) >> 3;
              int inc = nch;
#pragma unroll
              for (int o = 1; o < 64; o <<= 1) { const int v = shup_i(inc, o, t2 & 63); if ((t2 & 63) >= o) inc += v; }
              if ((t2 & 63) == 63) wtot[t2 >> 6] = inc;
              __syncthreads();
              int pre = 0;
              for (int w = 0; w < (t2 >> 6); ++w) pre += wtot[w];
              ust[t2 + 1] = pre + inc; if (t2 == 0) ust[0] = 0;
              LAS int* const nlv = (LAS int*)(L + LDSCTL_OFF + 12288); nlv[t2] = nl;
              __syncthreads();
              const int nB = ust[512], nU = nB + 3072;
              gu32* const qhead = ctl + CW_QUEUE + 64 * (l + 2 * rp);
              const int grp = wave_s >> 2, wg = wave_s & 3;
              char* const gshm = shm + grp * attn_body::BRA_GRP_BYTES; float* const wsf = (float*)((char*)lds + ATT_WSF_OFF) + wave_s * 128;
              LAS unsigned* const gb = (LAS unsigned*)(L + ATT_GB_OFF) + 2 * grp; LAS int* const gq = qn + 16 * grp;
              if (wg == 0 && ln2 == 0) gq[0] = (int)__hip_atomic_fetch_add(qhead, 1u, RLX_AGENT);
              attn_body::grp_bar(gb, ln2);
              for (int kq = 0;; ++kq) {
                  const int u = __builtin_amdgcn_readfirstlane(gq[kq & 1]);
                  if (u >= nU) break;
                  int unext_ = 0; if (wg == 0 && ln2 == 0) unext_ = (int)__hip_atomic_fetch_add(qhead, 1u, RLX_AGENT);
                  attn_body::BraUnit U;
                  if (u < nB) {
                      int lo_ = 0, hi_ = 512;
                      while (hi_ - lo_ > 1) { const int mid = (lo_ + hi_) >> 1; if (ust[mid] <= u) lo_ = mid; else hi_ = mid; }
                      const int hj = lo_, hd = hj >> 6, jb = hj & 63, c = u - ust[hj]; const int nlist = nlv[hj]; const int ntile = 8 + ((nlist + 31) >> 5);
                      U.Q = (const attn_body::bf16*)PROJ + C_QB + hd * 64; U.K = (const attn_body::bf16*)PROJ + C_KB + hd * 64; U.V = (const attn_body::bf16*)PROJ + C_VB + hd * 64;
                      U.PO = (attn_body::bf16*)(ws + WS_POB) + hd * 64; U.PL = (float*)(ws + WS_PLB) + hd;
                      U.kbase = 256 * jb; U.kstride = 1; U.t_first = 0; U.nkt = 4; U.nqt = (ntile - 8 * c) < 8 ? (ntile - 8 * c) : 8;
                      U.qbase = 0; U.qstride = 0; U.slotA = 0; U.list = (const int*)(ws + WS_LIST) + (size_t)hj * 16384; U.nlist = nlist; U.tile0 = 8 * c; U.ownrow0 = 256 * jb;
                      if (rp == 0) attn_body::bra_unit<1, 0>(U, gshm, wsf, (char*)lds + ATT_OST_OFF + wave_s * 2048, gb, wg, gq + ((kq + 1) & 1), unext_); else attn_body::bra_unit<1, ABLV>(U, gshm, wsf, (char*)lds + ATT_OST_OFF + wave_s * 2048, gb, wg, gq + ((kq + 1) & 1), unext_);
                  } else {
                      const int a = u - nB, hd = a / 384, r = a % 384, pt = r >> 7, w7 = r & 127; const int dil = (pt == 0) ? 1 : (pt == 1) ? 4 : 16;
                      const int nblk = 128 / dil, rho = w7 / nblk, ib = w7 % nblk;
                      U.Q = (const attn_body::bf16*)PROJ + C_QA + hd * 64; U.K = (const attn_body::bf16*)PROJ + C_KA + hd * 64; U.V = (const attn_body::bf16*)PROJ + C_VA + hd * 64;
                      U.PO = (attn_body::bf16*)(ws + WS_POA) + hd * 64; U.PL = (float*)(ws + WS_PLA) + hd;
                      U.kbase = rho + dil * (128 * ib - 128); U.kstride = dil; U.t_first = (ib == 0) ? 2 : 0; U.nkt = 4; U.nqt = 4;
                      U.qbase = rho + dil * 128 * ib; U.qstride = dil; U.slotA = pt; U.list = nullptr; U.nlist = 0; U.tile0 = 0; U.ownrow0 = 0;
                      if (rp == 0) attn_body::bra_unit<0, 0>(U, gshm, wsf, (char*)lds + ATT_OST_OFF + wave_s * 2048, gb, wg, gq + ((kq + 1) & 1), unext_); else attn_body::bra_unit<0, ABLV>(U, gshm, wsf, (char*)lds + ATT_OST_OFF + wave_s * 2048, gb, wg, gq + ((kq + 1) & 1), unext_);
                  }
                  attn_body::grp_bar_nv(gb, ln2);
              }
              __syncthreads();
            }
        }
        SEAM(pb + 4);
        if (INJ(5)) for (int rp = 0; rp < REPS(5); ++rp) {
            PHASE_BEGIN();
            const float* const lam_q1 = KIN(float, 9); const float* const lam_k1 = KIN(float, 10); const float* const lam_q2 = KIN(float, 11); const float* const lam_k2 = KIN(float, 12); const float* const g_sub = KIN(float, 13);
            const bf16* const TB = (const bf16*)(ws + WS_T); unsigned char* const MERGED = ws + WS_MERGED;
            const bf16* const POA = (const bf16*)(ws + WS_POA); const bf16* const POB = (const bf16*)(ws + WS_POB); const float* const PLA = (const float*)(ws + WS_PLA); const float* const PLB = (const float*)(ws + WS_PLB);
            const float d1 = wave_sum(lam_q1[l * 64 + lane] * lam_k1[l * 64 + lane], lane), d2 = wave_sum(lam_q2[l * 64 + lane] * lam_k2[l * 64 + lane], lane);
            const float lam = expf(d1) - expf(d2) + lam_init;
            const bool ofp8 = ((OUT_FP8 >> l) & 1) != 0;
            const f32x4 gs = ((const f32x4*)(g_sub + l * 128))[lane & 31]; const float osc = (1.f - lam_init) * (ofp8 ? MSCALE : 1.f);
            for (int row = gw; row < S_; row += NGW) {
                { float ls[3], mx = -INFINITY;
#pragma unroll
                  for (int sl = 0; sl < 3; ++sl) { ls[sl] = PLA[((size_t)sl * S_ + row) * 8 + (lane >> 3)]; mx = fmaxf(mx, ls[sl]); }
                  float acc[8], wsum = 0.f;
#pragma unroll
                  for (int e = 0; e < 8; ++e) acc[e] = 0.f;
#pragma unroll
                  for (int sl = 0; sl < 3; ++sl) { const float wgt = exp2f(ls[sl] - mx); wsum += wgt; const v4u w = ((const GAS v4u*)(POA + ((size_t)sl * S_ + row) * 512))[lane];
                      acc[0] += wgt * bflo(w.x); acc[1] += wgt * bfhi(w.x); acc[2] += wgt * bflo(w.y); acc[3] += wgt * bfhi(w.y); acc[4] += wgt * bflo(w.z); acc[5] += wgt * bfhi(w.z); acc[6] += wgt * bflo(w.w); acc[7] += wgt * bfhi(w.w); }
                  const float iw = (ofp8 ? MSCALE : 1.f) / wsum;
                  if (ofp8) { v2u o; o.x = pg8::pk4_fp8(acc[0] * iw, acc[1] * iw, acc[2] * iw, acc[3] * iw); o.y = pg8::pk4_fp8(acc[4] * iw, acc[5] * iw, acc[6] * iw, acc[7] * iw); ((GAS v2u*)(MERGED + (size_t)row * 2048))[lane] = o; }
                  else { v4u o; o.x = pk2(acc[0] * iw, acc[1] * iw); o.y = pk2(acc[2] * iw, acc[3] * iw); o.z = pk2(acc[4] * iw, acc[5] * iw); o.w = pk2(acc[6] * iw, acc[7] * iw); ((GAS v4u*)((bf16*)MERGED + (size_t)row * 2048))[lane] = o; } }
                { const int own = row >> 8, nsel = own < 3 ? own : 3; float ls[4], mx = -INFINITY;
#pragma unroll
                  for (int sl = 0; sl < 4; ++sl) { const bool on = (sl == 3) || (sl < nsel); ls[sl] = on ? PLB[((size_t)sl * S_ + row) * 8 + (lane >> 3)] : -INFINITY; mx = fmaxf(mx, ls[sl]); }
                  float acc[8], wsum = 0.f;
#pragma unroll
                  for (int e = 0; e < 8; ++e) acc[e] = 0.f;
#pragma unroll
                  for (int sl = 0; sl < 4; ++sl) { const bool on = (sl == 3) || (sl < nsel);
                      if (on) { const float wgt = exp2f(ls[sl] - mx); wsum += wgt; const v4u w = ((const GAS v4u*)(POB + ((size_t)sl * S_ + row) * 512))[lane];
                          acc[0] += wgt * bflo(w.x); acc[1] += wgt * bfhi(w.x); acc[2] += wgt * bflo(w.y); acc[3] += wgt * bfhi(w.y); acc[4] += wgt * bflo(w.z); acc[5] += wgt * bfhi(w.z); acc[6] += wgt * bflo(w.w); acc[7] += wgt * bfhi(w.w); } }
                  const float iw = (ofp8 ? MSCALE : 1.f) / wsum;
                  if (ofp8) { v2u o; o.x = pg8::pk4_fp8(acc[0] * iw, acc[1] * iw, acc[2] * iw, acc[3] * iw); o.y = pg8::pk4_fp8(acc[4] * iw, acc[5] * iw, acc[6] * iw, acc[7] * iw); ((GAS v2u*)(MERGED + (size_t)row * 2048 + 512))[lane] = o; }
                  else { v4u o; o.x = pk2(acc[0] * iw, acc[1] * iw); o.y = pk2(acc[2] * iw, acc[3] * iw); o.z = pk2(acc[4] * iw, acc[5] * iw); o.w = pk2(acc[6] * iw, acc[7] * iw); ((GAS v4u*)((bf16*)MERGED + (size_t)row * 2048 + 512))[lane] = o; } }
#pragma unroll
                for (int j = 0; j < 4; ++j) { const v2u ta = ((const GAS v2u*)(TB + (size_t)row * 1024))[lane + 64 * j], tb = ((const GAS v2u*)(TB + (size_t)(S_ + row) * 1024))[lane + 64 * j];
                    const f32x4 a = (f32x4){bflo(ta.x), bfhi(ta.x), bflo(ta.y), bfhi(ta.y)}, b = (f32x4){bflo(tb.x), bfhi(tb.x), bflo(tb.y), bfhi(tb.y)};
                    const f32x4 v = a - lam * b; float ss = (v.x * v.x + v.y * v.y) + (v.z * v.z + v.w * v.w);
                    ss += shx(ss, 1, lane); ss += shx(ss, 2, lane); ss += shx(ss, 4, lane); ss += shx(ss, 8, lane); ss += shx(ss, 16, lane);
                    const float rs = 1.f / sqrtf(ss * (1.f / 128.f) + RMS_EPS); const f32x4 o = v * rs * gs * osc;
                    if (ofp8) ((GAS unsigned*)(MERGED + (size_t)row * 2048 + 1024))[lane + 64 * j] = pg8::pk4_fp8(o.x, o.y, o.z, o.w);
                    else { v2u w; w.x = pk2(o.x, o.y); w.y = pk2(o.z, o.w); ((GAS v2u*)((bf16*)MERGED + (size_t)row * 2048 + 1024))[lane + 64 * j] = w; } }
            }
        }
        SEAM(pb + 5);
        if (INJ(6)) for (int rp = 0; rp < REPS(6); ++rp) {
            PHASE_BEGIN();
            const float* const x_in = KIN(float, 0); bf16* const xbuf = (bf16*)(ws + WS_XB); const float* const mod = (const float*)(ws + WS_MOD) + l * 12288;
            unsigned char* const MERGED = ws + WS_MERGED; unsigned char* const WOUT = ws + WS_WOUT;
            if (l == 0) { constexpr bool F8 = (OUT_FP8 & 1) != 0; constexpr int KBO = F8 ? 2048 : 4096;
                pg8::DenseSched Sd; Sd.init(MERGED, WOUT, S_, 2048, KBO, G, bx);
                pg8::EpiGateRes<true> E{x_in, xbuf, mod + 4096, F8 ? 1.f / (WSC_K2048 * MSCALE) : 1.f};
                pg8::gemm_phase<pg8::EpiGateRes<true>, pg8::DenseSched, true, GEMM_SP2, F8>(L + RING_OFF, KBO, Sd, E, wave_s); }
            else { constexpr bool F8 = (OUT_FP8 & 2) != 0; constexpr int KBO = F8 ? 2048 : 4096;
                pg8::DenseSched Sd; Sd.init(MERGED, WOUT + (size_t)2048 * 4096, S_, 2048, KBO, G, bx);
                pg8::EpiGateRes<false> E{xbuf, xbuf, mod + 4096, F8 ? 1.f / (WSC_K2048 * MSCALE) : 1.f};
                pg8::gemm_phase<pg8::EpiGateRes<false>, pg8::DenseSched, true, GEMM_SP2, F8>(L + RING_OFF, KBO, Sd, E, wave_s); }
        }
        SEAM(pb + 6);
        if (INJ(7)) for (int rp = 0; rp < REPS(7); ++rp) {
            PHASE_BEGIN();
            const float* const g_mlp = KIN(float, 6); const float* const w_router = KIN(float, 17); const float* const b_router = KIN(float, 18); const bf16* const xbuf = (const bf16*)(ws + WS_XB);
            const float* const mod = (const float*)(ws + WS_MOD) + l * 12288; unsigned char* const HB = ws + WS_H;
            int* const EID = (int*)(ws + WS_EID); float* const WTS = (float*)(ws + WS_WTS); int* const CNT = (int*)(ws + WS_CNT);
            LAS unsigned char* const WF = L; LAS float* const rawp = (LAS float*)(L + LDSCTL_OFF + 4096); LAS float* const bpart = (LAS float*)(L + LDSCTL_OFF + 12288); LAS float* const biasv = (LAS float*)(L + LDSCTL_OFF + 14336); LAS float* const rsv = (LAS float*)(L + LDSCTL_OFF + 14464);
            { const float* const gm = g_mlp + l * 2048; const float* const scv = mod + 8192; const float* const shv = mod + 6144;
              for (int c = tid; c < 4096; c += NWAVES * 64) { const int e = c & 15, g = (c >> 4) & 3, ks = c >> 6, k0 = 32 * ks + 8 * g; unsigned hi4[4], lo4[4];
#pragma unroll
                  for (int i2 = 0; i2 < 4; ++i2) { const int ka = k0 + 2 * i2, kb = ka + 1;
                      const float w0 = w_router[ka * 16 + e] * (gm[ka] * (1.f + scv[ka])), w1 = w_router[kb * 16 + e] * (gm[kb] * (1.f + scv[kb]));
                      const unsigned h0 = f2bf(w0), h1 = f2bf(w1); const float r0 = w0 - __uint_as_float(h0 << 16), r1 = w1 - __uint_as_float(h1 << 16);
                      hi4[i2] = h0 | (h1 << 16); lo4[i2] = f2bf(r0) | (f2bf(r1) << 16); }
                  *(LAS v4u*)(WF + ks * 2048 + (g * 16 + e) * 16) = (v4u){hi4[0], hi4[1], hi4[2], hi4[3]}; *(LAS v4u*)(WF + ks * 2048 + 1024 + (g * 16 + e) * 16) = (v4u){lo4[0], lo4[1], lo4[2], lo4[3]}; }
              { const int e = tid & 15, part = tid >> 4; float s = 0.f;
                for (int k = 64 * part; k < 64 * part + 64; ++k) s += shv[k] * w_router[k * 16 + e];
                bpart[part * 16 + e] = s; }
              __syncthreads();
              if (tid < 16) { float s = 0.f; for (int p = 0; p < 32; ++p) s += bpart[p * 16 + tid]; biasv[tid] = s; }
              __syncthreads(); }
            float bz[16];
#pragma unroll
            for (int e = 0; e < 16; ++e) bz[e] = biasv[e];
            f32x4 cA[8];
#pragma unroll
            for (int j = 0; j < 8; ++j) { const int c4 = lane + 64 * j; const f32x4 g = ((const f32x4*)(g_mlp + l * 2048))[c4]; const f32x4 sc = ((const f32x4*)(mod + 8192))[c4];
                cA[j] = g * (1.f + sc); }
            float br[16];
#pragma unroll
            for (int e = 0; e < 16; ++e) br[e] = b_router[e];
            for (int rb = bx; rb < NROWBLK; rb += G) {
                { const int kh = wave & 1; const bf16* const xr = xbuf + (size_t)(64 * rb + 16 * (wave >> 1) + (lane & 15)) * 2048 + kh * 1024 + (lane >> 4) * 8; const LAS unsigned char* const wf = WF + kh * 32 * 2048 + lane * 16;
                  f32x4 acc = (f32x4){0.f, 0.f, 0.f, 0.f};
#pragma unroll 8
                  for (int ks = 0; ks < 32; ++ks) { const bf16x8 a = *(const GAS bf16x8*)(xr + ks * 32); const bf16x8 bh = *(const LAS bf16x8*)(wf + ks * 2048), bl = *(const LAS bf16x8*)(wf + ks * 2048 + 1024);
                      acc = __builtin_amdgcn_mfma_f32_16x16x32_bf16(a, bh, acc, 0, 0, 0); acc = __builtin_amdgcn_mfma_f32_16x16x32_bf16(a, bl, acc, 0, 0, 0); }
#pragma unroll
                  for (int j = 0; j < 4; ++j) rawp[kh * 1024 + (16 * (wave >> 1) + 4 * (lane >> 4) + j) * 16 + (lane & 15)] = acc[j]; }
                __syncthreads();
                v2u nv[8];
#pragma unroll
                for (int j = 0; j < 8; ++j) nv[j] = NTL((const GAS v2u*)(xbuf + (size_t)(64 * rb + 8 * wave) * 2048) + (lane + 64 * j));
                for (int i = 0; i < 8; ++i) { const int row = 64 * rb + 8 * wave + i;
                    f32x4 v[8]; float ss = 0.f;
#pragma unroll
                    for (int j = 0; j < 8; ++j) { v[j] = (f32x4){bflo(nv[j].x), bfhi(nv[j].x), bflo(nv[j].y), bfhi(nv[j].y)}; ss += (v[j].x * v[j].x + v[j].y * v[j].y) + (v[j].z * v[j].z + v[j].w * v[j].w); }
                    if (i < 7) {
#pragma unroll
                        for (int j = 0; j < 8; ++j) nv[j] = NTL((const GAS v2u*)(xbuf + (size_t)(row + 1) * 2048) + (lane + 64 * j));
                    }
                    const float rs = 1.f / sqrtf(wave_sum(ss, lane) * (1.f / 2048.f) + RMS_EPS);
#pragma unroll
                    for (int j = 0; j < 8; ++j) { const f32x4 o = v[j] * rs * cA[j] + ((const GAS f32x4*)(mod + 6144))[lane + 64 * j]; ((GAS unsigned*)(HB + (size_t)row * 2048))[lane + 64 * j] = pg8::pk4_fp8(o.x, o.y, o.z, o.w); }
                    if (lane == 0) rsv[8 * wave + i] = rs;
                }
                __syncthreads();
                if (wave == 0) { const int row = 64 * rb + lane; const float rs = rsv[lane];
                    float p[16];
                    { const LAS f32x4* const r0 = (const LAS f32x4*)(rawp + lane * 16); const LAS f32x4* const r1 = (const LAS f32x4*)(rawp + 1024 + lane * 16);
#pragma unroll
                      for (int q = 0; q < 4; ++q) { const f32x4 a = r0[q] + r1[q]; p[4 * q] = a.x * rs + bz[4 * q]; p[4 * q + 1] = a.y * rs + bz[4 * q + 1]; p[4 * q + 2] = a.z * rs + bz[4 * q + 2]; p[4 * q + 3] = a.w * rs + bz[4 * q + 3]; } }
                    float sg[16], sv[16];
#pragma unroll
                    for (int e = 0; e < 16; ++e) { sv[e] = 1.f / (1.f + expf(-p[e])); sg[e] = sv[e] + br[e]; }
                    float gsc[4];
#pragma unroll
                    for (int g4 = 0; g4 < 4; ++g4) { const float a = sg[4 * g4], b = sg[4 * g4 + 1], c = sg[4 * g4 + 2], d = sg[4 * g4 + 3];
                        const float h1 = fmaxf(a, b), l1 = fminf(a, b), h2 = fmaxf(c, d), l2 = fminf(c, d); gsc[g4] = fmaxf(h1, h2) + fmaxf(fminf(h1, h2), fmaxf(l1, l2)); }
                    int gi = 0; float gb = gsc[0];
#pragma unroll
                    for (int g4 = 1; g4 < 4; ++g4) if (gsc[g4] > gb) { gb = gsc[g4]; gi = g4; }
                    float cd[4], cs[4];
#pragma unroll
                    for (int k = 0; k < 4; ++k) { cd[k] = (gi == 0) ? sg[k] : (gi == 1) ? sg[4 + k] : (gi == 2) ? sg[8 + k] : sg[12 + k]; cs[k] = (gi == 0) ? sv[k] : (gi == 1) ? sv[4 + k] : (gi == 2) ? sv[8 + k] : sv[12 + k]; }
                    int l0 = 0; float v0 = cd[0], s0 = cs[0];
#pragma unroll
                    for (int k = 1; k < 4; ++k) if (cd[k] > v0) { v0 = cd[k]; l0 = k; s0 = cs[k]; }
                    int l1i = -1; float v1 = -INFINITY, s1 = 0.f;
#pragma unroll
                    for (int k = 0; k < 4; ++k) if (k != l0 && cd[k] > v1) { v1 = cd[k]; l1i = k; s1 = cs[k]; }
                    const int e0 = 4 * gi + l0, e1 = 4 * gi + l1i; const float wsum = s0 + s1;
                    EID[2 * row] = e0; EID[2 * row + 1] = e1; WTS[2 * row] = s0 / wsum; WTS[2 * row + 1] = s1 / wsum;
                    int mine = 0;
#pragma unroll
                    for (int e = 0; e < 16; ++e) { const int c = __popcll(__ballot(e0 == e)) + __popcll(__ballot(e1 == e)); if (lane == e) mine = c; }
                    if (lane < 16) CNT[rb * 16 + lane] = mine; }
                __syncthreads();
            }
        }
        SEAM(pb + 7);
        if (INJ(8)) for (int rp = 0; rp < REPS(8); ++rp) {
            PHASE_BEGIN();
            const unsigned char* const HB = ws + WS_H; unsigned char* const XS = ws + WS_XS;
            const int* const EID = (const int*)(ws + WS_EID); const float* const WTS = (const float*)(ws + WS_WTS); int* const ROWTOK = (int*)(ws + WS_ROWTOK); float* const ROWW = (float*)(ws + WS_ROWW); const int* const CNT = (const int*)(ws + WS_CNT);
            for (int rb = bx; rb < NROWBLK; rb += G) {
                v4u gw[16];
#pragma unroll
                for (int i = 0; i < 8; ++i) { const int row = 64 * rb + 8 * wave + i; gw[2 * i] = ((const GAS v4u*)(HB + (size_t)row * 2048))[lane]; gw[2 * i + 1] = ((const GAS v4u*)(HB + (size_t)row * 2048))[lane + 64]; }
                COMPUTE_SEGMENTS(rb);
                if (wave == 0) { const int row = 64 * rb + lane; const int e0 = EID[2 * row], e1 = EID[2 * row + 1]; int p0 = 0, p1 = 0;
                    const unsigned long long lt = (1ull << lane) - 1ull;
                    for (int e = 0; e < 16; ++e) { const unsigned long long m0 = __ballot(e0 == e), m1 = __ballot(e1 == e); const int r = __popcll(m0 & lt) + __popcll(m1 & lt);
                        if (e0 == e) p0 = basee[e] + r; if (e1 == e) p1 = basee[e] + r; }
                    postab[2 * lane] = p0; postab[2 * lane + 1] = p1;
                    ROWTOK[p0] = 2 * row; ROWTOK[p1] = 2 * row + 1; ROWW[p0] = WTS[2 * row]; ROWW[p1] = WTS[2 * row + 1]; }
                __syncthreads();
                {
#pragma unroll
                  for (int i = 0; i < 8; ++i) { const int r = 8 * wave + i; const int p0 = postab[2 * r], p1 = postab[2 * r + 1];
                      ((GAS v4u*)(XS + (size_t)p0 * 2048))[lane] = gw[2 * i]; ((GAS v4u*)(XS + (size_t)p0 * 2048))[lane + 64] = gw[2 * i + 1];
                      ((GAS v4u*)(XS + (size_t)p1 * 2048))[lane] = gw[2 * i]; ((GAS v4u*)(XS + (size_t)p1 * 2048))[lane + 64] = gw[2 * i + 1]; } }
                if (rb < 16) { const int pbeg = segs[rb] + tot[rb], pend = segs[rb + 1];
                    for (int p = pbeg + tid; p < pend; p += NWAVES * 64) { ROWTOK[p] = -1; ROWW[p] = 0.f; } }
                __syncthreads();
            }
        }
        SEAM(pb + 8);
        if (INJ(9)) for (int rp = 0; rp < REPS(9); ++rp) {
            PHASE_BEGIN();
            const int* const CNT = (const int*)(ws + WS_CNT); unsigned char* const XS = ws + WS_XS; unsigned char* const WGU = ws + WS_WGU; unsigned char* const ACT = ws + WS_ACT;
            COMPUTE_SEGMENTS(0);
            pg8::MoeSched Sm; Sm.init(XS, WGU + (size_t)l * 16 * 2048 * 2048, segs[16], 2048, 2048, (size_t)2048 * 2048, (const PG8_LAS unsigned char*)p2e, G, bx);
            pg8::EpiSwiglu E{ACT, 1.f / WSC_K2048, ASCALE};
            pg8::gemm_phase<pg8::EpiSwiglu, pg8::MoeSched, true, GEMM_SP2, true>(L + RING_OFF, 2048, Sm, E, wave_s);
        }
        SEAM(pb + 9);
        if (INJ(10)) for (int rp = 0; rp < REPS(10); ++rp) {
            PHASE_BEGIN();
            const int* const CNT = (const int*)(ws + WS_CNT); unsigned char* const ACT = ws + WS_ACT; unsigned char* const WDN = ws + WS_WDN; bf16* const YB = (bf16*)(ws + WS_Y);
            const int* const ROWTOK = (const int*)(ws + WS_ROWTOK); const float* const ROWW = (const float*)(ws + WS_ROWW);
            COMPUTE_SEGMENTS(0);
            pg8::MoeSched Sm; Sm.init(ACT, WDN + (size_t)l * 16 * 2048 * 1024, segs[16], 2048, 1024, (size_t)2048 * 1024, (const PG8_LAS unsigned char*)p2e, G, bx);
            pg8::EpiDown E{YB, ROWTOK, ROWW, 1.f / (WSC_K1024 * ASCALE)};
            pg8::gemm_phase<pg8::EpiDown, pg8::MoeSched, true, GEMM_SP2, true>(L + RING_OFF, 1024, Sm, E, wave_s);
        }
        SEAM(pb + 10);
    }
#if defined(STAMP_A)
    float st_delta = 0.f, st_add = 0.f;
    if (hi - lo > 1) {
        if (kbx == 0 && threadIdx.x == 0) { const float ta = (float)(stamps[STAMP_A + 1] - stamps[STAMP_A]) * 0.01f, tb = (float)(stamps[STAMP_B + 1] - stamps[STAMP_B]) * 0.01f;
            __hip_atomic_store(ctl + CW_QUEUE + 512, __float_as_uint(ta * (1.f / 2000.f)), RLX_AGENT); __hip_atomic_store(ctl + CW_QUEUE + 576, __float_as_uint(tb), RLX_AGENT); }
        xcd_barrier(bar);
        st_delta = __uint_as_float(__hip_atomic_load(ctl + CW_QUEUE + 512, RLX_AGENT)); st_add = __uint_as_float(__hip_atomic_load(ctl + CW_QUEUE + 576, RLX_AGENT));
    }
#endif
    if (((PHMASK >> 12) & 1) && IN(23)) {
        PHASE_BEGIN();
        const float* const g_final = KIN(float, 19); float* const outp = ka->out; const bf16* const xbuf = (const bf16*)(ws + WS_XB); const float* const MOD = (const float*)(ws + WS_MOD); const bf16* const YB = (const bf16*)(ws + WS_Y);
        f32x4 cA[8], cG[8];
#pragma unroll
        for (int j = 0; j < 8; ++j) { const int c4 = lane + 64 * j; cA[j] = ((const f32x4*)g_final)[c4]; cG[j] = ((const f32x4*)(MOD + 12288 + 10240))[c4]; }
        v2u nv[8], na[8], nb[8];
#pragma unroll
        for (int j = 0; j < 8; ++j) { nv[j] = NTL((const GAS v2u*)(xbuf + (size_t)gw * 2048) + (lane + 64 * j)); na[j] = NTL((const GAS v2u*)(YB + (size_t)(2 * gw) * 2048) + (lane + 64 * j)); nb[j] = NTL((const GAS v2u*)(YB + (size_t)(2 * gw + 1) * 2048) + (lane + 64 * j)); }
        for (int row = gw; row < S_; row += NGW) {
            f32x4 v[8]; v2u ya[8], yb[8]; float ss = 0.f;
#pragma unroll
            for (int j = 0; j < 8; ++j) { v[j] = (f32x4){bflo(nv[j].x), bfhi(nv[j].x), bflo(nv[j].y), bfhi(nv[j].y)}; ya[j] = na[j]; yb[j] = nb[j]; }
            const int nrow = row + NGW;
            if (nrow < S_) {
#pragma unroll
                for (int j = 0; j < 8; ++j) { nv[j] = NTL((const GAS v2u*)(xbuf + (size_t)nrow * 2048) + (lane + 64 * j)); na[j] = NTL((const GAS v2u*)(YB + (size_t)(2 * nrow) * 2048) + (lane + 64 * j)); nb[j] = NTL((const GAS v2u*)(YB + (size_t)(2 * nrow + 1) * 2048) + (lane + 64 * j)); }
            }
#pragma unroll
            for (int j = 0; j < 8; ++j) { const v2u a = ya[j], b = yb[j];
                const f32x4 ys = (f32x4){bflo(a.x) + bflo(b.x), bfhi(a.x) + bfhi(b.x), bflo(a.y) + bflo(b.y), bfhi(a.y) + bfhi(b.y)};
                v[j] += cG[j] * ys; ss += (v[j].x * v[j].x + v[j].y * v[j].y) + (v[j].z * v[j].z + v[j].w * v[j].w); }
            const float rs = 1.f / sqrtf(wave_sum(ss, lane) * (1.f / 2048.f) + RMS_EPS);
#pragma unroll
            for (int j = 0; j < 8; ++j) { f32x4 o_ = v[j] * rs * cA[j];
#if defined(STAMP_A)
                o_ = o_ * (1.f + st_delta); if (row == 0 && lane == 0 && j == 0) o_.x += st_add;
#endif
                ((GAS f32x4*)(outp + (size_t)row * 2048))[lane + 64 * j] = o_; }
        }
    }
#undef IN
#undef INJ
#undef REPS
#undef PHASE_BEGIN
#undef KIN
#undef SEAM
#undef COMPUTE_SEGMENTS
}

extern "C" void kernel_launch(void* const* d_in, const int* in_sizes, int n_in, void* d_out, int out_size, void* d_ws, size_t ws_size, hipStream_t stream) {
    static int grid = 0;
    if (grid == 0) {
        if (n_in != 20 || in_sizes[0] != S_ * DM_ || out_size != S_ * DM_ || ws_size < WS_END) { fprintf(stderr, "kernel_launch: unexpected shapes or workspace (%d inputs, in0 %d, out %d, ws %zu); nothing launched\n", n_in, n_in > 0 ? in_sizes[0] : -1, out_size, ws_size); grid = -1; return; }
        int dev = 0, cus = 0, per_cu = 0;
        if (hipGetDevice(&dev) != hipSuccess || hipDeviceGetAttribute(&cus, hipDeviceAttributeMultiprocessorCount, dev) != hipSuccess) { grid = -1; return; }
        if (hipFuncSetAttribute((const void*)fwd, hipFuncAttributeMaxDynamicSharedMemorySize, LDS_BYTES) != hipSuccess) { fprintf(stderr, "kernel_launch: hipFuncSetAttribute failed\n"); grid = -1; return; }
        if (hipOccupancyMaxActiveBlocksPerMultiprocessor(&per_cu, (const void*)fwd, NWAVES * 64, LDS_BYTES) != hipSuccess || per_cu < 1) fprintf(stderr, "kernel_launch: occupancy query reports %d blocks per CU\n", per_cu);
        (void)hipGetLastError();
        grid = cus;
    }
    if (grid < 0) return;
    if (hipMemsetAsync((char*)d_ws + WS_CTL, 0, CTL_ZERO_BYTES, stream) != hipSuccess) return;
    Args a{};
    for (int i = 0; i < 20; ++i) a.in[i] = d_in[i];
    a.out = (float*)d_out; a.ws = (unsigned char*)d_ws;
    if (MK_N_LAUNCHES == 1) { a.ph_lo = 0; a.ph_hi = N_PHASES; hipLaunchKernelGGL(fwd, dim3(grid), dim3(NWAVES * 64), LDS_BYTES, stream, a); }
    else for (int p = 0; p < N_PHASES; ++p) { a.ph_lo = p; a.ph_hi = p + 1; hipLaunchKernelGGL(fwd, dim3(grid), dim3(NWAVES * 64), LDS_BYTES, stream, a); }
}
```

```cpp
#include <hip/hip_runtime.h>
#include <hip/hip_bf16.h>
#include <cstdio>
#include <cstdint>
#include <cmath>
namespace pg8 {
#define PG8_LAS __attribute__((address_space(3)))
typedef unsigned short bf16_t;
typedef short bf16x8 __attribute__((ext_vector_type(8)));
typedef float f32x4 __attribute__((ext_vector_type(4)));
typedef unsigned u32x4 __attribute__((ext_vector_type(4)));
constexpr int BM = 256, BK = 64, HALF = 128, HTB = HALF * BK * 2  , STAGE_BYTES = 8 * HTB, NXCD = 8, WGM = 8;

__host__ __device__ __forceinline__ int lds_byte(int r, int c) { const int st = (r >> 4) * 2 + (c >> 5), rr = r & 15, cc = c & 31, ob = rr * 64 + cc * 2; return st * 1024 + (ob ^ (((ob >> 9) & 1) << 5)); }
__host__ __device__ __forceinline__ void stage_rc(int b, int& R, int& C) { const int st = b / 1024, sb = b % 1024, swz = sb ^ (((sb >> 9) & 1) << 5); R = (st >> 1) * 16 + swz / 64; C = (st & 1) * 32 + (swz % 64) / 2; }
__host__ __device__ __forceinline__ int perm32(int rho) { const int n = rho >> 4, i = rho & 15; return 8 * (i >> 2) + 4 * n + (i & 3); }

struct Unit { int pm, pn; };
struct Gemm { const bf16_t* A; const bf16_t* Bt; int M, N, K; };

struct StaticOrder {
    int nM, nN, nwg, G, c;
    __host__ __device__ void init(int M, int N, int G_, int c_) { nM = M / BM; nN = N / BM; nwg = nM * nN; G = G_; c = c_; }
    __host__ __device__ bool next(int i, Unit& u) const {
        const long L = (long)i * G + c; if (L >= nwg) return false;
        int wgid = (int)L; { const int q = nwg / NXCD, r = nwg % NXCD, xcd = wgid % NXCD, off = wgid / NXCD; wgid = (xcd < r ? xcd * (q + 1) : r * (q + 1) + (xcd - r) * q) + off; }
        const int nig = WGM * nN, gid = wgid / nig, fm = gid * WGM, gsz = (nM - fm) < WGM ? (nM - fm) : WGM;
        u.pm = fm + ((wgid % nig) % gsz); u.pn = (wgid % nig) / gsz; return true;
    }
    __device__ __forceinline__ void a_ready(const Unit&) const {}
    __device__ __forceinline__ void done(const Unit&) const {}
};

struct DenseSched {
    const char* A; const char* Bt; size_t tstep; StaticOrder so;
    __device__ __forceinline__ void init(const void* A_, const void* Bt_, int M, int N, int KB, int G, int c) { A = (const char*)A_; Bt = (const char*)Bt_; tstep = (size_t)BM * KB; so.init(M, N, G, c); }
    __device__ __forceinline__ bool next(int i, Unit& u) const { return so.next(i, u); }
    __device__ __forceinline__ const char* a_ptr(const Unit& u) const { return A + (size_t)u.pm * tstep; }
    __device__ __forceinline__ const char* b_ptr(const Unit& u) const { return Bt + (size_t)u.pn * tstep; }
    __device__ __forceinline__ void a_ready(const Unit&) const {}
    __device__ __forceinline__ void done(const Unit&) const {}
};
struct MoeSched {
    const char* A; const char* Bt; size_t tstep, estride; StaticOrder so; const PG8_LAS unsigned char* p2e;
    __device__ __forceinline__ void init(const void* A_, const void* Bt_, int Mpad, int N, int KB, size_t estride_, const PG8_LAS unsigned char* p2e_, int G, int c) {
        A = (const char*)A_; Bt = (const char*)Bt_; tstep = (size_t)BM * KB; estride = estride_; p2e = p2e_; so.init(Mpad, N, G, c); }
    __device__ __forceinline__ bool next(int i, Unit& u) const { return so.next(i, u); }
    __device__ __forceinline__ const char* a_ptr(const Unit& u) const { return A + (size_t)u.pm * tstep; }
    __device__ __forceinline__ const char* b_ptr(const Unit& u) const { const int e = __builtin_amdgcn_readfirstlane((int)p2e[u.pm]); return Bt + (size_t)e * estride + (size_t)u.pn * tstep; }
    __device__ __forceinline__ void a_ready(const Unit&) const {}
    __device__ __forceinline__ void done(const Unit&) const {}
};

__device__ __forceinline__ unsigned pk4_fp8(float a, float b, float c, float d) {
    a = __builtin_fminf(__builtin_fmaxf(a, -448.f), 448.f); b = __builtin_fminf(__builtin_fmaxf(b, -448.f), 448.f); c = __builtin_fminf(__builtin_fmaxf(c, -448.f), 448.f); d = __builtin_fminf(__builtin_fmaxf(d, -448.f), 448.f);
    int w = 0; w = __builtin_amdgcn_cvt_pk_fp8_f32(a, b, w, false); w = __builtin_amdgcn_cvt_pk_fp8_f32(c, d, w, true); return (unsigned)w; }
__device__ __forceinline__ unsigned cvt_pk_bf16(float lo, float hi) { unsigned r; asm volatile("v_cvt_pk_bf16_f32 %0, %1, %2" : "=v"(r) : "v"(lo), "v"(hi)); return r; }

struct EpiProj {
    static constexpr bool PERM = true, AFTER_DRAIN = false;
    bf16_t* O; const float* cosT; const float* sinT; float qscale, oscale;
    __device__ __forceinline__ void operator()(const f32x4 (&acc)[2][2][4][2], const Unit& u, int wr, int wc, int fr, int fq) const {
        const int pn = u.pn;
        const bool isq = (pn < 2) || (pn == 6) || (pn == 7) || (pn >= 12 && pn < 16);
        const bool isk = (pn == 2) || (pn == 3) || (pn == 8) || (pn == 9) || (pn >= 16 && pn < 20);
        const int row0 = u.pm * BM + wr * 64 + fr, col0 = pn * BM + wc * 32 + 8 * fq;
        const int i0 = (wc & 1) * 16 + 4 * fq;
        const float sc = isq ? qscale * oscale : oscale;
#pragma unroll
        for (int ai = 0; ai < 2; ++ai)
#pragma unroll
            for (int m = 0; m < 4; ++m) { const int row = row0 + ai * HALF + m * 16; bf16_t* rowp = O + (size_t)row * 6144 + col0;
                f32x4 cs = (f32x4){1.f, 1.f, 1.f, 1.f}, sn = (f32x4){0.f, 0.f, 0.f, 0.f};
                if (isq || isk) { cs = *(const f32x4*)(cosT + (size_t)row * 32 + i0); sn = *(const f32x4*)(sinT + (size_t)row * 32 + i0); }
#pragma unroll
                for (int bj = 0; bj < 2; ++bj) { const f32x4 v0 = acc[ai][bj][m][0], v1 = acc[ai][bj][m][1];
                    const float a0 = (v0[0] * cs[0] - v0[1] * sn[0]) * sc, b0 = (v0[1] * cs[0] + v0[0] * sn[0]) * sc;
                    const float a1 = (v0[2] * cs[1] - v0[3] * sn[1]) * sc, b1 = (v0[3] * cs[1] + v0[2] * sn[1]) * sc;
                    const float a2 = (v1[0] * cs[2] - v1[1] * sn[2]) * sc, b2 = (v1[1] * cs[2] + v1[0] * sn[2]) * sc;
                    const float a3 = (v1[2] * cs[3] - v1[3] * sn[3]) * sc, b3 = (v1[3] * cs[3] + v1[2] * sn[3]) * sc;
                    u32x4 w; w.x = cvt_pk_bf16(a0, b0); w.y = cvt_pk_bf16(a1, b1); w.z = cvt_pk_bf16(a2, b2); w.w = cvt_pk_bf16(a3, b3);
                    *(u32x4*)(rowp + bj * HALF) = w; } }
    }
};
template <bool BASE_F32> struct EpiGateRes {
    static constexpr bool PERM = true, AFTER_DRAIN = false;
    const void* base; bf16_t* out; const float* gate; float oscale;
    __device__ __forceinline__ void operator()(const f32x4 (&acc)[2][2][4][2], const Unit& u, int wr, int wc, int fr, int fq) const {
        const int col0 = u.pn * BM + wc * 32 + 8 * fq;
        f32x4 gv[2][2];
#pragma unroll
        for (int bj = 0; bj < 2; ++bj)
#pragma unroll
            for (int n = 0; n < 2; ++n) gv[bj][n] = *(const f32x4*)(gate + col0 + bj * HALF + n * 4) * oscale;
#pragma unroll
        for (int ai = 0; ai < 2; ++ai)
#pragma unroll
            for (int m = 0; m < 4; ++m) { const size_t off = (size_t)(u.pm * BM + ai * HALF + wr * 64 + m * 16 + fr) * 2048 + col0;
#pragma unroll
                for (int bj = 0; bj < 2; ++bj) { f32x4 b0, b1;
                    if (BASE_F32) { b0 = *(const f32x4*)((const float*)base + off + bj * HALF); b1 = *(const f32x4*)((const float*)base + off + bj * HALF + 4); }
                    else { const u32x4 w = *(const u32x4*)((const bf16_t*)base + off + bj * HALF);
                        b0 = (f32x4){__builtin_bit_cast(float, w.x << 16), __builtin_bit_cast(float, w.x & 0xffff0000u), __builtin_bit_cast(float, w.y << 16), __builtin_bit_cast(float, w.y & 0xffff0000u)};
                        b1 = (f32x4){__builtin_bit_cast(float, w.z << 16), __builtin_bit_cast(float, w.z & 0xffff0000u), __builtin_bit_cast(float, w.w << 16), __builtin_bit_cast(float, w.w & 0xffff0000u)}; }
                    const f32x4 v0 = b0 + gv[bj][0] * acc[ai][bj][m][0], v1 = b1 + gv[bj][1] * acc[ai][bj][m][1];
                    u32x4 w; w.x = cvt_pk_bf16(v0[0], v0[1]); w.y = cvt_pk_bf16(v0[2], v0[3]); w.z = cvt_pk_bf16(v1[0], v1[1]); w.w = cvt_pk_bf16(v1[2], v1[3]);
                    *(u32x4*)(out + off + bj * HALF) = w; }
                asm volatile("" ::: "memory"); }
    }
};
struct EpiSwiglu {
    static constexpr bool PERM = true, AFTER_DRAIN = false;
    unsigned char* O; float iscale, ascale;
    __device__ __forceinline__ void operator()(const f32x4 (&acc)[2][2][4][2], const Unit& u, int wr, int wc, int fr, int fq) const {
        const int row0 = u.pm * BM + wr * 64 + fr, col0 = u.pn * 128 + wc * 16 + 4 * fq;
#pragma unroll
        for (int ai = 0; ai < 2; ++ai)
#pragma unroll
            for (int m = 0; m < 4; ++m) { unsigned char* rowp = O + (size_t)(row0 + ai * HALF + m * 16) * 1024 + col0;
#pragma unroll
                for (int bj = 0; bj < 2; ++bj) { const f32x4 g = acc[ai][bj][m][0] * iscale, up = acc[ai][bj][m][1] * (iscale * ascale); float r[4];
#pragma unroll
                    for (int j = 0; j < 4; ++j) { const float e = __builtin_amdgcn_exp2f(-1.4426950408889634f * g[j]); r[j] = g[j] * __builtin_amdgcn_rcpf(1.f + e) * up[j]; }
                    *(unsigned*)(rowp + bj * 64) = pk4_fp8(r[0], r[1], r[2], r[3]); } }
    }
};
struct EpiDown {
    static constexpr bool PERM = true, AFTER_DRAIN = false;
    bf16_t* Y; const int* rowtok; const float* roww; float oscale;
    __device__ __forceinline__ void operator()(const f32x4 (&acc)[2][2][4][2], const Unit& u, int wr, int wc, int fr, int fq) const {
        const int row0 = u.pm * BM + wr * 64 + fr, col0 = u.pn * BM + wc * 32 + 8 * fq;
#pragma unroll
        for (int ai = 0; ai < 2; ++ai)
#pragma unroll
            for (int m = 0; m < 4; ++m) { const int pos = row0 + ai * HALF + m * 16; const int tk = rowtok[pos]; const float w8 = roww[pos] * oscale;
                bf16_t* rowp = Y + (size_t)(tk < 0 ? 0 : tk) * 2048 + col0;
#pragma unroll
                for (int bj = 0; bj < 2; ++bj) { const f32x4 v0 = acc[ai][bj][m][0] * w8, v1 = acc[ai][bj][m][1] * w8;
                    u32x4 w; w.x = cvt_pk_bf16(v0[0], v0[1]); w.y = cvt_pk_bf16(v0[2], v0[3]); w.z = cvt_pk_bf16(v1[0], v1[1]); w.w = cvt_pk_bf16(v1[2], v1[3]);
                    if (tk >= 0) *(u32x4*)(rowp + bj * HALF) = w; }
                asm volatile("" ::: "memory"); }
    }
};

template <class Epi, class Sched, bool ALIGN_EPI = false, bool SP2 = false, bool FP8 = false>
__device__ __forceinline__ void gemm_phase(PG8_LAS unsigned char* lds, const int KB  , const Sched& S, const Epi& E, const int wave_s  ) {
    typedef int v4i_t __attribute__((ext_vector_type(4))); typedef int v8i_t __attribute__((ext_vector_type(8)));
    int lane; asm volatile("v_mbcnt_lo_u32_b32 %0, -1, 0\n\tv_mbcnt_hi_u32_b32 %0, -1, %0" : "=v"(lane)); const int wid = wave_s, tid = wid * 64 + lane, wr = wid >> 2, wc = wid & 3, fr = lane & 15, fq = lane >> 4;
    const int nt = KB / (BK * 2);
    unsigned voffA, voffB;
    { int R, C; stage_rc(tid * 16, R, C); const int Rb = Epi::PERM ? ((R & ~31) + perm32(R & 31)) : R; voffA = (unsigned)(R * KB + C * 2); voffB = (unsigned)(Rb * KB + C * 2); }
    const size_t pstep = (size_t)64 * KB;
    const size_t kstep = (size_t)(BK * 2);
    const size_t hstep = (size_t)HALF * KB;
    const unsigned ldsbw = (unsigned)__builtin_amdgcn_readfirstlane((int)((unsigned)(uintptr_t)lds + (unsigned)wid * 1024u));
    const int aoff = lds_byte(wr * 64 + fr, fq * 8), boff = lds_byte(wc * 32 + fr, fq * 8);
#define PG8_SA(b, h) (((b) * 2 + (h)) * HTB)
#define PG8_SB(b, h) ((4 + (b) * 2 + (h)) * HTB)
#define PG8_STAGE1(bufoff, gbase, voff, PI) do { unsigned keep_; \
        asm volatile("s_mov_b32 %0, m0\n\ts_add_i32 m0, %3, %4\n\ts_nop 0\n\tglobal_load_lds_dwordx4 %1, %2\n\ts_mov_b32 m0, %0" : "=&s"(keep_) : "v"(voff), "s"((const char*)(gbase) + (PI) * pstep), "s"(ldsbw), "i"((bufoff) + (PI) * 8192) : "memory", "scc"); } while (0)
#define PG8_STAGE(bufoff, gbase, voff) do { PG8_STAGE1(bufoff, gbase, voff, 0); PG8_STAGE1(bufoff, gbase, voff, 1); } while (0)
#define PG8_LDA(dst, b, h) do { _Pragma("unroll") for (int m = 0; m < 4; ++m) { dst[m].lo = *(const PG8_LAS v4i_t*)(lds + PG8_SA(b, h) + aoff + m * 2048); dst[m].hi = *(const PG8_LAS v4i_t*)(lds + PG8_SA(b, h) + aoff + m * 2048 + 1024); } } while (0)
#define PG8_LDB(dst, b, h) do { _Pragma("unroll") for (int n = 0; n < 2; ++n) { dst[n].lo = *(const PG8_LAS v4i_t*)(lds + PG8_SB(b, h) + boff + n * 2048); dst[n].hi = *(const PG8_LAS v4i_t*)(lds + PG8_SB(b, h) + boff + n * 2048 + 1024); } } while (0)
#define PG8_MMA(ai, bj, At, Bt) do { __builtin_amdgcn_s_setprio(1); _Pragma("unroll") for (int m = 0; m < 4; ++m) _Pragma("unroll") for (int n = 0; n < 2; ++n) { \
        if constexpr (FP8) { acc[ai][bj][m][n] = __builtin_amdgcn_mfma_scale_f32_16x16x128_f8f6f4(Bt[n], At[m], acc[ai][bj][m][n], 0, 0, 0, 0, 0, 0); } \
        else { const v4i_t bl_ = Bt[n].lo, bh_ = Bt[n].hi, al_ = At[m].lo, ah_ = At[m].hi;     \
               acc[ai][bj][m][n] = __builtin_amdgcn_mfma_f32_16x16x32_bf16(__builtin_bit_cast(bf16x8, bl_), __builtin_bit_cast(bf16x8, al_), acc[ai][bj][m][n], 0, 0, 0); \
               acc[ai][bj][m][n] = __builtin_amdgcn_mfma_f32_16x16x32_bf16(__builtin_bit_cast(bf16x8, bh_), __builtin_bit_cast(bf16x8, ah_), acc[ai][bj][m][n], 0, 0, 0); } } \
        __builtin_amdgcn_s_setprio(0); } while (0)
#define PG8_WAIT_V(n) asm volatile("s_waitcnt vmcnt(" #n ")" ::: "memory")
#define PG8_WAIT_L(n) asm volatile("s_waitcnt lgkmcnt(" #n ")" ::: "memory")
#define PG8_BAR __builtin_amdgcn_s_barrier()
#define PG8_SCHED __builtin_amdgcn_sched_barrier(0)
    Unit cur, nxt; int ui = 0;
    if (!S.next(0, cur)) return;
    f32x4 acc[2][2][4][2];
#pragma unroll
    for (int a = 0; a < 2; ++a)
#pragma unroll
        for (int b = 0; b < 2; ++b)
#pragma unroll
            for (int m = 0; m < 4; ++m)
#pragma unroll
                for (int n = 0; n < 2; ++n) acc[a][b][m][n] = (f32x4){0.f, 0.f, 0.f, 0.f};
    v8i_t At[4], B0[2], B1[2];
    const char* cA = S.a_ptr(cur); const char* cB = S.b_ptr(cur);
    S.a_ready(cur);
    if constexpr (SP2) {
        PG8_STAGE(PG8_SB(0, 0), cB, voffB); PG8_STAGE(PG8_SB(0, 1), cB + hstep, voffB); PG8_STAGE(PG8_SA(0, 0), cA, voffA); PG8_STAGE(PG8_SA(0, 1), cA + hstep, voffA);
        if (wr == 1) PG8_BAR;
        PG8_WAIT_V(2); PG8_BAR;
        PG8_STAGE(PG8_SB(1, 0), cB + kstep, voffB); PG8_STAGE(PG8_SA(1, 0), cA + kstep, voffA); PG8_STAGE(PG8_SB(1, 1), cB + hstep + kstep, voffB);
        PG8_WAIT_V(6); PG8_BAR;
    } else {
        PG8_STAGE(PG8_SB(0, 0), cB, voffB); PG8_STAGE(PG8_SA(0, 0), cA, voffA); PG8_STAGE(PG8_SB(0, 1), cB + hstep, voffB); PG8_STAGE(PG8_SA(0, 1), cA + hstep, voffA);
        if (wr == 1) PG8_BAR;
        PG8_WAIT_V(4); PG8_BAR;
        PG8_STAGE(PG8_SB(1, 0), cB + kstep, voffB); PG8_STAGE(PG8_SA(1, 0), cA + kstep, voffA); PG8_STAGE(PG8_SB(1, 1), cB + hstep + kstep, voffB);
        PG8_WAIT_V(6); PG8_BAR;
    }
    for (;;) {
        const bool has_next = S.next(ui + 1, nxt);
        const char* nA = has_next ? S.a_ptr(nxt) : cA; const char* nB = has_next ? S.b_ptr(nxt) : cB;
#pragma unroll 1
        for (int t = 0; t < nt; t += 2) {
            const bool last = (t == nt - 2);
            const char* a1 = cA + (size_t)(t + 1) * kstep;
            const char* a2 = last ? nA : cA + (size_t)(t + 2) * kstep; const char* b2 = last ? nB : cB + (size_t)(t + 2) * kstep;
            const char* a3 = a2 + kstep; const char* b3 = b2 + kstep;
            if (last && has_next) S.a_ready(nxt);
            if constexpr (SP2) {
            PG8_LDB(B0, 0, 0); PG8_LDB(B1, 0, 1); PG8_SCHED; PG8_LDA(At, 0, 0); PG8_STAGE(PG8_SA(1, 1), a1 + hstep, voffA);
            PG8_WAIT_V(8); PG8_WAIT_L(0); PG8_BAR; PG8_MMA(0, 0, At, B0); PG8_MMA(0, 1, At, B1); PG8_BAR; PG8_SCHED;
            PG8_LDA(At, 0, 1); PG8_STAGE(PG8_SB(0, 0), b2, voffB); PG8_STAGE(PG8_SB(0, 1), b2 + hstep, voffB); PG8_STAGE(PG8_SA(0, 0), a2, voffA);
            PG8_WAIT_V(8); PG8_WAIT_L(0); PG8_BAR; PG8_MMA(1, 0, At, B0); PG8_MMA(1, 1, At, B1); PG8_BAR; PG8_SCHED;
            PG8_LDB(B0, 1, 0); PG8_LDB(B1, 1, 1); PG8_SCHED; PG8_LDA(At, 1, 0); PG8_STAGE(PG8_SA(0, 1), a2 + hstep, voffA);
            PG8_WAIT_V(8); PG8_WAIT_L(0); PG8_BAR; PG8_MMA(0, 0, At, B0); PG8_MMA(0, 1, At, B1); PG8_BAR; PG8_SCHED;
            PG8_LDA(At, 1, 1); PG8_STAGE(PG8_SB(1, 0), b3, voffB); PG8_STAGE(PG8_SB(1, 1), b3 + hstep, voffB); PG8_STAGE(PG8_SA(1, 0), a3, voffA);
            PG8_WAIT_V(8); PG8_WAIT_L(0); PG8_BAR; PG8_MMA(1, 0, At, B0); PG8_MMA(1, 1, At, B1); PG8_BAR; PG8_SCHED;
            } else {
            PG8_LDB(B0, 0, 0); PG8_SCHED; PG8_LDA(At, 0, 0); PG8_STAGE(PG8_SA(1, 1), a1 + hstep, voffA);
            PG8_WAIT_L(8); PG8_BAR; PG8_WAIT_L(0); PG8_MMA(0, 0, At, B0); PG8_BAR; PG8_SCHED;
            PG8_LDB(B1, 0, 1); PG8_STAGE(PG8_SB(0, 0), b2, voffB);
            PG8_BAR; PG8_WAIT_L(0); PG8_MMA(0, 1, At, B1); PG8_BAR;
            PG8_LDA(At, 0, 1); PG8_STAGE(PG8_SA(0, 0), a2, voffA);
            PG8_BAR; PG8_WAIT_L(0); PG8_MMA(1, 0, At, B0); PG8_BAR; PG8_SCHED;
            PG8_STAGE(PG8_SB(0, 1), b2 + hstep, voffB);
            PG8_WAIT_V(6); PG8_BAR; PG8_MMA(1, 1, At, B1); PG8_BAR;
            PG8_LDB(B0, 1, 0); PG8_SCHED; PG8_LDA(At, 1, 0); PG8_STAGE(PG8_SA(0, 1), a2 + hstep, voffA);
            PG8_WAIT_L(8); PG8_BAR; PG8_WAIT_L(0); PG8_MMA(0, 0, At, B0); PG8_BAR; PG8_SCHED;
            PG8_LDB(B1, 1, 1); PG8_STAGE(PG8_SB(1, 0), b3, voffB);
            PG8_BAR; PG8_WAIT_L(0); PG8_MMA(0, 1, At, B1); PG8_BAR;
            PG8_LDA(At, 1, 1); PG8_STAGE(PG8_SA(1, 0), a3, voffA);
            PG8_BAR; PG8_WAIT_L(0); PG8_MMA(1, 0, At, B0); PG8_BAR; PG8_SCHED;
            PG8_STAGE(PG8_SB(1, 1), b3 + hstep, voffB);
            PG8_WAIT_V(6); PG8_BAR; PG8_MMA(1, 1, At, B1); PG8_BAR;
            }
        }
        if constexpr (ALIGN_EPI) { if (wr == 0) PG8_BAR; }
        if constexpr (!Epi::AFTER_DRAIN) { int ln_; asm volatile("v_mbcnt_lo_u32_b32 %0, -1, 0\n\tv_mbcnt_hi_u32_b32 %0, -1, %0" : "=v"(ln_));
            E(acc, cur, wr, wc, ln_ & 15, ln_ >> 4); S.done(cur); }
        if (!has_next) break;
#pragma unroll
        for (int a = 0; a < 2; ++a)
#pragma unroll
            for (int b = 0; b < 2; ++b)
#pragma unroll
                for (int m = 0; m < 4; ++m)
#pragma unroll
                    for (int n = 0; n < 2; ++n) acc[a][b][m][n] = (f32x4){0.f, 0.f, 0.f, 0.f};
        cur = nxt; cA = nA; cB = nB; ++ui;
        if constexpr (ALIGN_EPI) { if (wr == 1) PG8_BAR; }
    }
    PG8_WAIT_V(0);
    if constexpr (!ALIGN_EPI) { if (wr == 0) PG8_BAR; }
    PG8_BAR;
    if constexpr (Epi::AFTER_DRAIN) { E.fused(acc, cur, wr, wc, fr, fq, lds, wid, lane); S.done(cur); }
#undef PG8_SA
#undef PG8_SB
#undef PG8_STAGE
#undef PG8_LDA
#undef PG8_LDB
#undef PG8_MMA
#undef PG8_WAIT_V
#undef PG8_WAIT_L
#undef PG8_BAR
#undef PG8_SCHED
}
}

constexpr float WSC_K2048 = 64.f, WSC_K1024 = 32.f, MSCALE = 4.f  , ASCALE = 2.f  ;
__device__ __forceinline__ int dest_row(int map, int n) {
    if (map == 1) { const int seg = n >> 9; const bool qk = (seg == 0) || (seg == 1) || (seg == 3) || (seg == 4) || (seg >= 6 && seg <= 9); if (!qk) return n; const int j = n & 63; return (n & ~63) + ((j < 32) ? 2 * j : 2 * (j - 32) + 1); }
    if (map == 2) return 8 * (n >> 2) + (n & 3);
    if (map == 3) return 8 * (n >> 2) + 4 + (n & 3);
    return n;
}
namespace wconv {
constexpr size_t D_WIN = (size_t)16 << 20, D_WOUT = (size_t)64 << 20, D_WGU = (size_t)80 << 20, D_WDN = (size_t)336 << 20;
struct Tab { const float* w_in; const float* w_out; const float* w_gate; const float* w_up; const float* w_down; unsigned char* ws; int l, n_out, total; };
struct State { int idx, staged, ctr, stride; };
struct Op { const float* src; unsigned char* dst; int N, K, map, n0; float wsc; };
__device__ __forceinline__ void decode(const Tab& T, int idx, Op& o) {
    int r = idx; const int l = T.l;
    if (r < T.n_out) { const int kb = r >> 5, nb = r & 31; o.N = 2048; o.K = 2048; o.map = 0; o.wsc = WSC_K2048; o.n0 = 64 * nb;
        o.src = T.w_out + (size_t)l * 2048 * 2048 + (size_t)(16 * kb) * 2048 + 64 * nb; o.dst = T.ws + D_WOUT + (size_t)l * 2048 * 4096 + 16 * kb; return; }
    r -= T.n_out;
    if (r < 65536) { const int up = r >> 15; r &= 32767; const int mt = l * 16 + (r >> 11), item = r & 2047, kb = item >> 4, nb = item & 15; o.N = 1024; o.K = 2048; o.map = 2 + up; o.wsc = WSC_K2048; o.n0 = 64 * nb;
        o.src = (up ? T.w_up : T.w_gate) + (size_t)mt * 2048 * 1024 + (size_t)(16 * kb) * 1024 + 64 * nb; o.dst = T.ws + D_WGU + (size_t)mt * 2048 * 2048 + 16 * kb; return; }
    r -= 65536;
    if (r < 32768) { const int mt = l * 16 + (r >> 11), item = r & 2047, kb = item >> 5, nb = item & 31; o.N = 2048; o.K = 1024; o.map = 0; o.wsc = WSC_K1024; o.n0 = 64 * nb;
        o.src = T.w_down + (size_t)mt * 1024 * 2048 + (size_t)(16 * kb) * 2048 + 64 * nb; o.dst = T.ws + D_WDN + (size_t)mt * 2048 * 1024 + 16 * kb; return; }
    r -= 32768;
    { const int kb = r / 96, nb = r - 96 * kb; o.N = 6144; o.K = 2048; o.map = 1; o.wsc = WSC_K2048; o.n0 = 64 * nb;
      o.src = T.w_in + (size_t)2048 * 6144 + (size_t)(16 * kb) * 6144 + 64 * nb; o.dst = T.ws + D_WIN + (size_t)6144 * 2048 + 16 * kb; }
}
__device__ __forceinline__ void dma16(const void* sbase, unsigned voff, unsigned lds_dst) { unsigned keep;
    asm volatile("s_mov_b32 %0, m0\n\ts_mov_b32 m0, %3\n\ts_nop 0\n\tglobal_load_lds_dwordx4 %1, %2\n\ts_mov_b32 m0, %0" : "=&s"(keep) : "v"(voff), "s"(sbase), "s"(lds_dst) : "memory"); }
__device__ __forceinline__ void issue(const Tab& T, int idx, unsigned stage, int lane) {
    Op o; decode(T, idx, o);
    const unsigned voff = (unsigned)((lane >> 4) * o.N * 4 + (lane & 15) * 16);
#pragma unroll
    for (int j = 0; j < 4; ++j) dma16(o.src + (size_t)(4 * j) * o.N, voff, (unsigned)__builtin_amdgcn_readfirstlane(stage + 1024u * j));
}
__device__ __forceinline__ void finish(const Tab& T, int idx, unsigned stage, int lane) {
    Op o; decode(T, idx, o);
    typedef __attribute__((address_space(3))) const float* lfp; const lfp sp = (lfp)(uintptr_t)(stage + 4u * lane);
    float f[16];
#pragma unroll
    for (int k = 0; k < 16; ++k) f[k] = sp[64 * k] * o.wsc;
    typedef unsigned u4 __attribute__((ext_vector_type(4)));
    u4 w; w.x = pg8::pk4_fp8(f[0], f[1], f[2], f[3]); w.y = pg8::pk4_fp8(f[4], f[5], f[6], f[7]); w.z = pg8::pk4_fp8(f[8], f[9], f[10], f[11]); w.w = pg8::pk4_fp8(f[12], f[13], f[14], f[15]);
    *(__attribute__((address_space(1))) u4*)(o.dst + (size_t)dest_row(o.map, o.n0 + lane) * o.K) = w;
}
__device__ __forceinline__ void micro(const Tab& T, State& s, unsigned stage, int lane) {
    finish(T, s.staged, stage, lane);
    asm volatile("s_waitcnt lgkmcnt(0)" ::: "memory");
    issue(T, s.idx, stage, lane); s.staged = s.idx; s.idx += s.stride;
}
}

#include <hip/hip_bf16.h>
#include <cmath>
namespace attn_body {
using bf16=__hip_bfloat16;
using bf16x8=__attribute__((ext_vector_type(8)))short;
using s16x4=__attribute__((ext_vector_type(4)))short;
using f32x16=__attribute__((ext_vector_type(16)))float;
using u32x4=__attribute__((ext_vector_type(4)))unsigned;
constexpr int SEQ=16384,D=64,DM=6144;
constexpr int NW=8,QBLK=32,QB=QBLK*NW,KVBLK=64,NQB=SEQ/QB;
constexpr int ATTN_UNIT_ROWS=QB;
__device__ __forceinline__ int crow(int r,int hi){return (r&3)+8*(r>>2)+4*hi;}
#define SBAR() __builtin_amdgcn_sched_barrier(0)
__device__ __forceinline__ void cmask(f32x16&p0,f32x16&p1,int jb,int qrel,int hi){
  const float NEG=-INFINITY; int kb=64*jb+4*hi;
  #pragma unroll
  for(int r=0;r<16;++r){int kv=kb+(r&3)+8*(r>>2); if(kv>qrel)p0[r]=NEG; if(kv+32>qrel)p1[r]=NEG;}
}

constexpr int NSLOT=3, SLOTB=8192;
constexpr int LDS_K=0, LDS_V=NSLOT*SLOTB, LDS_WS=2*NSLOT*SLOTB, LDS_OST=LDS_WS+NW*64*4, LDS_BYTES=LDS_OST+NW*4096;
constexpr float C2=0.125f*1.4426950408889634f;
__device__ __forceinline__ void glds16(const void*gsrc,unsigned lds_dst){unsigned keep;
  asm volatile("s_mov_b32 %0, m0\n\ts_mov_b32 m0, %2\n\ts_nop 0\n\tglobal_load_lds_dwordx4 %1, off\n\ts_mov_b32 m0, %0":"=&s"(keep):"v"(gsrc),"s"(lds_dst):"memory");}
__device__ __forceinline__ void glds16s(const void*sbase,unsigned voff,unsigned lds_dst){unsigned keep;
  asm volatile("s_mov_b32 %0, m0\n\ts_mov_b32 m0, %3\n\ts_nop 0\n\tglobal_load_lds_dwordx4 %1, %2\n\ts_mov_b32 m0, %0":"=&s"(keep):"v"(voff),"s"(sbase),"s"(lds_dst):"memory");}
__device__ __forceinline__ float max3f(float a,float b,float c){float r;asm("v_max3_f32 %0, %1, %2, %3":"=v"(r):"v"(a),"v"(b),"v"(c));return r;}
__device__ __forceinline__ float max2f(float a,float b){float r;asm("v_max_f32_e32 %0, %1, %2":"=v"(r):"v"(a),"v"(b));return r;}
__device__ __forceinline__ float fadd_s(float a,float b){float r;asm("v_add_f32_e32 %0, %1, %2":"=v"(r):"v"(a),"v"(b));return r;}
__device__ __forceinline__ float fsub_s(float a,float b){float r;asm("v_sub_f32_e32 %0, %1, %2":"=v"(r):"v"(a),"v"(b));return r;}
typedef float f32x2_t __attribute__((ext_vector_type(2))); typedef __bf16 bf16x2_t __attribute__((ext_vector_type(2)));
__device__ __forceinline__ unsigned cvtpk_s(float lo,float hi){f32x2_t v={lo,hi};bf16x2_t b=__builtin_convertvector(v,bf16x2_t);return __builtin_bit_cast(unsigned,b);}
#define WAIT_BAR(N) asm volatile("s_waitcnt vmcnt(" #N ") lgkmcnt(0)\n\ts_barrier":::"memory")

__device__ __forceinline__ void qkt(f32x16&p0,f32x16&p1,const char*Kslot,const bf16x8*qr,const f32x16&negm,int r32,int hi){
  const char*kb=Kslot+hi*1024+r32*16;
  #pragma unroll
  for(int d0=0;d0<4;++d0){
    const bf16x8 b0=*reinterpret_cast<const bf16x8*>(kb+d0*2048);
    const bf16x8 b1=*reinterpret_cast<const bf16x8*>(kb+d0*2048+512);
    if(d0==0){p0=__builtin_amdgcn_mfma_f32_32x32x16_bf16(b0,qr[0],negm,0,0,0);p1=__builtin_amdgcn_mfma_f32_32x32x16_bf16(b1,qr[0],negm,0,0,0);}
    else{p0=__builtin_amdgcn_mfma_f32_32x32x16_bf16(b0,qr[d0],p0,0,0,0);p1=__builtin_amdgcn_mfma_f32_32x32x16_bf16(b1,qr[d0],p1,0,0,0);}}
}
__device__ __forceinline__ void qkt_rm(f32x16&p0,f32x16&p1,const char*Kslot,const int ka,const bf16x8*qr,const f32x16&negm){
  #pragma unroll
  for(int d0=0;d0<4;++d0){ const char*kb=Kslot+(ka^(d0<<5));
    const bf16x8 b0=*reinterpret_cast<const bf16x8*>(kb);
    const bf16x8 b1=*reinterpret_cast<const bf16x8*>(kb+4096);
    if(d0==0){p0=__builtin_amdgcn_mfma_f32_32x32x16_bf16(b0,qr[0],negm,0,0,0);p1=__builtin_amdgcn_mfma_f32_32x32x16_bf16(b1,qr[0],negm,0,0,0);}
    else{p0=__builtin_amdgcn_mfma_f32_32x32x16_bf16(b0,qr[d0],p0,0,0,0);p1=__builtin_amdgcn_mfma_f32_32x32x16_bf16(b1,qr[d0],p1,0,0,0);}}
}
typedef __attribute__((address_space(3))) const char* lds_cptr;
typedef short v4i16_t __attribute__((ext_vector_type(4)));
__device__ __forceinline__ void kload8(bf16x8*kf,lds_cptr kp){
  kf[0]=*(const __attribute__((address_space(3))) bf16x8*)(kp);      kf[1]=*(const __attribute__((address_space(3))) bf16x8*)(kp+512);
  kf[2]=*(const __attribute__((address_space(3))) bf16x8*)(kp+2048); kf[3]=*(const __attribute__((address_space(3))) bf16x8*)(kp+2560);
  kf[4]=*(const __attribute__((address_space(3))) bf16x8*)(kp+4096); kf[5]=*(const __attribute__((address_space(3))) bf16x8*)(kp+4608);
  kf[6]=*(const __attribute__((address_space(3))) bf16x8*)(kp+6144); kf[7]=*(const __attribute__((address_space(3))) bf16x8*)(kp+6656);
}
__device__ __forceinline__ void kload2(bf16x8*kf,lds_cptr kp,int j){ kf[2*j]=*(const __attribute__((address_space(3))) bf16x8*)(kp+j*2048); kf[2*j+1]=*(const __attribute__((address_space(3))) bf16x8*)(kp+j*2048+512); }
__device__ __forceinline__ s16x4 vtr(lds_cptr p){ return __builtin_bit_cast(s16x4,__builtin_amdgcn_ds_read_tr16_b64_v4i16((__attribute__((address_space(3))) v4i16_t*)p)); }
__device__ __forceinline__ float rowmax(const f32x16&p0,const f32x16&p1){
  float a=max3f(p0[0],p0[1],p1[0]),b=max3f(p0[2],p0[3],p1[1]);a=max3f(a,p1[2],p1[3]);
  #pragma unroll
  for(int r=4;r<16;r+=4){a=max3f(a,p0[r],p0[r+1]);b=max3f(b,p0[r+2],p0[r+3]);a=max3f(a,p1[r],p1[r+1]);b=max3f(b,p1[r+2],p1[r+3]);}
  const float m=max2f(a,b);
  auto rr=__builtin_amdgcn_permlane32_swap(__float_as_uint(m),__float_as_uint(m),false,false);
  return max2f(__uint_as_float(rr[0]),__uint_as_float(rr[1]));
}
__device__ __forceinline__ void pv(f32x16*o,int vb,bf16x8 pa0,bf16x8 pa1,bf16x8 pa2,bf16x8 pa3){
  #pragma unroll
  for(int d0=0;d0<2;++d0){s16x4 lo[4],hi[4];
    #pragma unroll
    for(int ks=0;ks<4;++ks){
      asm volatile("ds_read_b64_tr_b16 %0,%1 offset:%c2":"=&v"(lo[ks]):"v"(vb),"i"(d0*4096+ks*1024):"memory");
      asm volatile("ds_read_b64_tr_b16 %0,%1 offset:%c2":"=&v"(hi[ks]):"v"(vb),"i"(d0*4096+ks*1024+512):"memory");}
    asm volatile("s_waitcnt lgkmcnt(0)":::"memory");SBAR();
    #define PK(k) (bf16x8){lo[k][0],lo[k][1],lo[k][2],lo[k][3],hi[k][0],hi[k][1],hi[k][2],hi[k][3]}
    o[d0]=__builtin_amdgcn_mfma_f32_32x32x16_bf16(pa0,PK(0),o[d0],0,0,0);
    o[d0]=__builtin_amdgcn_mfma_f32_32x32x16_bf16(pa1,PK(1),o[d0],0,0,0);
    o[d0]=__builtin_amdgcn_mfma_f32_32x32x16_bf16(pa2,PK(2),o[d0],0,0,0);
    o[d0]=__builtin_amdgcn_mfma_f32_32x32x16_bf16(pa3,PK(3),o[d0],0,0,0);
    #undef PK
  }
}

constexpr int ATTN_LDS_BYTES=LDS_BYTES;


#ifndef ATT_STAGGER
#define ATT_STAGGER 0
#endif
constexpr int XSLOTS=4, X_K=0, X_V=XSLOTS*SLOTB, X_WS=X_V+2*XSLOTS*SLOTB, X_LDS_BYTES=X_WS+NW*256;
__device__ __forceinline__ void pv4(f32x16*o,int vb,bf16x8 pa0,bf16x8 pa1,bf16x8 pa2,bf16x8 pa3){
  #pragma unroll
  for(int d0=0;d0<4;++d0){s16x4 lo[4],hi[4];
    #pragma unroll
    for(int ks=0;ks<4;++ks){
      asm volatile("ds_read_b64_tr_b16 %0,%1 offset:%c2":"=&v"(lo[ks]):"v"(vb),"i"(d0*4096+ks*1024):"memory");
      asm volatile("ds_read_b64_tr_b16 %0,%1 offset:%c2":"=&v"(hi[ks]):"v"(vb),"i"(d0*4096+ks*1024+512):"memory");}
    asm volatile("s_waitcnt lgkmcnt(0)":::"memory");SBAR();
    #define PK(k) (bf16x8){lo[k][0],lo[k][1],lo[k][2],lo[k][3],hi[k][0],hi[k][1],hi[k][2],hi[k][3]}
    o[d0]=__builtin_amdgcn_mfma_f32_32x32x16_bf16(pa0,PK(0),o[d0],0,0,0);
    o[d0]=__builtin_amdgcn_mfma_f32_32x32x16_bf16(pa1,PK(1),o[d0],0,0,0);
    o[d0]=__builtin_amdgcn_mfma_f32_32x32x16_bf16(pa2,PK(2),o[d0],0,0,0);
    o[d0]=__builtin_amdgcn_mfma_f32_32x32x16_bf16(pa3,PK(3),o[d0],0,0,0);
    #undef PK
  }
}
template<int THRL> __device__ __forceinline__ void attn_unit128(int qb,const bf16*Q,const bf16*__restrict__ K,const bf16*__restrict__ V,bf16*O,int opitch,char*shm,const int wid){
  int lane; asm volatile("v_mbcnt_lo_u32_b32 %0, -1, 0\n\tv_mbcnt_hi_u32_b32 %0, -1, %0":"=v"(lane)); const int r32=lane&31,hi=lane>>5;
  const int q0=qb*QB;
  const bf16*Qw=Q+(long)(q0+wid*QBLK)*DM;
  const unsigned lds0=(unsigned)(uintptr_t)shm;
  float*wsf=(float*)(shm+X_WS)+wid*64;
  const unsigned koff=(unsigned)(lane*DM+wid*8)*2u;
  const unsigned voff=(unsigned)((16*(wid&3)+(lane>>2))*DM+(wid>>2)*32+(lane&3)*8)*2u;
  const unsigned kdst=lds0+X_K+wid*1024, vdst=lds0+X_V+wid*1024;
  #define DMA_K(t,slot) glds16s(K+(long)(t)*KVBLK*DM,koff,(unsigned)__builtin_amdgcn_readfirstlane(kdst+(slot)))
  #define DMA_V(t,slot) do{ glds16s(V+(long)(t)*KVBLK*DM,voff,(unsigned)__builtin_amdgcn_readfirstlane(vdst+2*(slot))); glds16s(V+(long)(t)*KVBLK*DM+64,voff,(unsigned)__builtin_amdgcn_readfirstlane(vdst+2*(slot)+8192)); }while(0)
  const int vb0=(int)(lds0+X_V)+((lane>>4)&1)*32+(lane&3)*8+(4*hi+((lane&15)>>2))*64;
  const char*Kbase=shm+X_K; bf16x8 kf[8];
  const lds_cptr shm3=(lds_cptr)shm; const lds_cptr kp0=shm3+X_K+hi*1024+r32*16; const lds_cptr vp0=shm3+X_V+((lane>>4)&1)*32+(lane&3)*8+(4*hi+((lane&15)>>2))*64;
  const int NT=(q0+QB)/KVBLK;
  DMA_K(0,0);DMA_V(0,0);DMA_K(1,SLOTB);
  bf16x8 qr[4];
  #pragma unroll
  for(int d0=0;d0<4;++d0)qr[d0]=*reinterpret_cast<const bf16x8*>(&Qw[(long)r32*DM+d0*16+hi*8]);
  float mhat=0.f,l_reg=0.f;f32x16 o[4];o[0]=f32x16{};o[1]=f32x16{};o[2]=f32x16{};o[3]=f32x16{};
  float zz_=0.f; asm volatile("":"+v"(zz_)); f32x16 negm;
  _Pragma("unroll") for(int r=0;r<16;++r)negm[r]=zz_; asm volatile("":"+v"(negm));
  const int qrel=wid*QBLK+r32;
  #define CMASK(P0,P1,t) do{int jb_=(t)-(NT-4); if(jb_>=0)cmask(P0,P1,jb_,qrel,hi);}while(0)
  bool resc=false;
  #define RESC() do{ if(resc){ asm volatile("s_waitcnt lgkmcnt(0)":::"memory"); \
      _Pragma("unroll") for(int d_=0;d_<4;++d_) _Pragma("unroll") for(int r=0;r<16;++r)o[d_][r]*=wsf[crow(r,hi)]; } }while(0)
  f32x16 C0,C1; u32x4 pw0,pw1,pw2,pw3;
  int sl_prev=0,sl_cur=0,sl_next=SLOTB;
  #define ROT() do{sl_prev=sl_cur;sl_cur=sl_next;sl_next=(sl_next==(XSLOTS-1)*SLOTB)?0:sl_next+SLOTB;}while(0)
  #define PKW(P,B) cvtpk_s(P[B],P[B+1])
  DMA_K(2,2*SLOTB);
  WAIT_BAR(4);
  qkt(C0,C1,Kbase,qr,negm,r32,hi);asm volatile("s_nop 15\n\ts_nop 7":"+v"(C0),"+v"(C1));CMASK(C0,C1,0);
  { const float rm=rowmax(C0,C1); const float dl=rm; mhat=fadd_s(mhat,dl);
    _Pragma("unroll") for(int r=0;r<16;++r){C0[r]=fsub_s(C0[r],dl);C1[r]=fsub_s(C1[r],dl);}
    _Pragma("unroll") for(int r=0;r<16;++r)negm[r]=-mhat; asm volatile("":"+v"(negm));
    _Pragma("unroll") for(int r=0;r<16;++r){C0[r]=__builtin_amdgcn_exp2f(C0[r]);C1[r]=__builtin_amdgcn_exp2f(C1[r]);}
    float sacc=C0[0]+C0[1]; _Pragma("unroll") for(int r=2;r<16;++r)sacc+=C0[r]; _Pragma("unroll") for(int r=0;r<16;++r)sacc+=C1[r]; l_reg+=sacc;
    pw0=(u32x4){PKW(C0,0),PKW(C0,2),PKW(C0,4),PKW(C0,6)};pw1=(u32x4){PKW(C0,8),PKW(C0,10),PKW(C0,12),PKW(C0,14)};pw2=(u32x4){PKW(C1,0),PKW(C1,2),PKW(C1,4),PKW(C1,6)};pw3=(u32x4){PKW(C1,8),PKW(C1,10),PKW(C1,12),PKW(C1,14)}; }
  WAIT_BAR(0);
  DMA_K(3,3*SLOTB);DMA_V(1,SLOTB);
  ROT();
  kload8(kf,kp0+sl_cur);
  WAIT_BAR(3);
  s16x4 vlo[8],vhi[8];
  #define PAF(k) __builtin_bit_cast(bf16x8,pw##k)
  #define VFR(i) (bf16x8){vlo[i][0],vlo[i][1],vlo[i][2],vlo[i][3],vhi[i][0],vhi[i][1],vhi[i][2],vhi[i][3]}
  #define PIN(x) asm volatile("":"+v"(x))
  #define MX3(a,b,c) __builtin_fmaxf(__builtin_fmaxf((a),(b)),(c))
  #define EX(v) __builtin_amdgcn_exp2f(v)
  #define VRDF(s,d,ks) do{ vlo[s]=vtr(vp_+((d)*4096+(ks)*1024)); vhi[s]=vtr(vp_+((d)*4096+(ks)*1024+512)); }while(0)
  #define GA(s,MF) do{ VRDF(s,(s)&3,(s)>>2); SBAR(); MF; SBAR(); }while(0)
  #define EX2(X,B) do{ X[B]=EX(X[B]); X[B+1]=EX(X[B+1]); PIN(X); }while(0)
  #define PK1(W,j,X,B) do{ sacc+=X[B]; sacc+=X[B+1]; W[j]=PKW(X,B); PIN(W); PIN(sacc); }while(0)
  #define KRD(G,j) do{ if(G){ kload2(kf,kp0+sl_next,j); } }while(0)
  #define STEP(t,GK,GV,GL) do{ SBAR(); \
    const lds_cptr vp_=vp0+2*sl_prev; \
    GA(0,C0=__builtin_amdgcn_mfma_f32_32x32x16_bf16(kf[0],qr[0],negm,0,0,0)); \
    GA(1,C1=__builtin_amdgcn_mfma_f32_32x32x16_bf16(kf[1],qr[0],negm,0,0,0)); \
    GA(2,C0=__builtin_amdgcn_mfma_f32_32x32x16_bf16(kf[2],qr[1],C0,0,0,0)); \
    GA(3,C1=__builtin_amdgcn_mfma_f32_32x32x16_bf16(kf[3],qr[1],C1,0,0,0)); \
    GA(4,C0=__builtin_amdgcn_mfma_f32_32x32x16_bf16(kf[4],qr[2],C0,0,0,0)); \
    GA(5,C1=__builtin_amdgcn_mfma_f32_32x32x16_bf16(kf[5],qr[2],C1,0,0,0)); \
    GA(6,C0=__builtin_amdgcn_mfma_f32_32x32x16_bf16(kf[6],qr[3],C0,0,0,0)); \
    GA(7,C1=__builtin_amdgcn_mfma_f32_32x32x16_bf16(kf[7],qr[3],C1,0,0,0)); \
    if(GK){DMA_K((t)+3,sl_prev);} if(GV){DMA_V((t)+1,sl_next);} \
    CMASK(C0,C1,t); \
    { float a=MX3(C0[0],C0[1],C1[0]),b=MX3(C0[2],C0[3],C1[1]); a=MX3(a,C1[2],C1[3]); \
      _Pragma("unroll") for(int r=4;r<16;r+=4){a=MX3(a,C0[r],C0[r+1]);b=MX3(b,C0[r+2],C0[r+3]);a=MX3(a,C1[r],C1[r+1]);b=MX3(b,C1[r+2],C1[r+3]);} \
      float rm=__builtin_fmaxf(a,b); { auto rr=__builtin_amdgcn_permlane32_swap(__float_as_uint(rm),__float_as_uint(rm),false,false); rm=__builtin_fmaxf(__uint_as_float(rr[0]),__uint_as_float(rr[1])); } \
      resc=false; \
      if(__builtin_expect(__any(rm>(float)THRL),0)){ const float dl=__builtin_fmaxf(rm,0.f); mhat+=dl; \
        _Pragma("unroll") for(int r=0;r<16;++r){C0[r]-=dl;C1[r]-=dl;} \
        _Pragma("unroll") for(int r=0;r<16;++r)negm[r]=-mhat; asm volatile("":"+v"(negm)); \
        const float f=__builtin_amdgcn_exp2f(-dl); l_reg*=f; if(hi==0)wsf[r32]=f; resc=true; } } \
    SBAR(); MIDBAR(t); \
    float sacc=0.f; u32x4 nw0=(u32x4){0u,0u,0u,0u},nw1=nw0,nw2=nw0,nw3=nw0; \
    o[0]=__builtin_amdgcn_mfma_f32_32x32x16_bf16(PAF(0),VFR(0),o[0],0,0,0); VRDF(0,0,2); EX2(C0,0); SBAR(); \
    o[1]=__builtin_amdgcn_mfma_f32_32x32x16_bf16(PAF(0),VFR(1),o[1],0,0,0); VRDF(1,1,2); EX2(C0,2); SBAR(); \
    o[2]=__builtin_amdgcn_mfma_f32_32x32x16_bf16(PAF(0),VFR(2),o[2],0,0,0); VRDF(2,2,2); EX2(C0,4); SBAR(); \
    o[3]=__builtin_amdgcn_mfma_f32_32x32x16_bf16(PAF(0),VFR(3),o[3],0,0,0); VRDF(3,3,2); EX2(C0,6); SBAR(); \
    o[0]=__builtin_amdgcn_mfma_f32_32x32x16_bf16(PAF(1),VFR(4),o[0],0,0,0); VRDF(4,0,3); EX2(C0,8);  PK1(nw0,0,C0,0); SBAR(); \
    o[1]=__builtin_amdgcn_mfma_f32_32x32x16_bf16(PAF(1),VFR(5),o[1],0,0,0); VRDF(5,1,3); EX2(C0,10); PK1(nw0,1,C0,2); SBAR(); \
    o[2]=__builtin_amdgcn_mfma_f32_32x32x16_bf16(PAF(1),VFR(6),o[2],0,0,0); VRDF(6,2,3); EX2(C0,12); PK1(nw0,2,C0,4); SBAR(); \
    o[3]=__builtin_amdgcn_mfma_f32_32x32x16_bf16(PAF(1),VFR(7),o[3],0,0,0); VRDF(7,3,3); EX2(C0,14); PK1(nw0,3,C0,6); SBAR(); \
    o[0]=__builtin_amdgcn_mfma_f32_32x32x16_bf16(PAF(2),VFR(0),o[0],0,0,0); KRD(GL,0); EX2(C1,0);  PK1(nw1,0,C0,8);  SBAR(); \
    o[1]=__builtin_amdgcn_mfma_f32_32x32x16_bf16(PAF(2),VFR(1),o[1],0,0,0); KRD(GL,1); EX2(C1,2);  PK1(nw1,1,C0,10); SBAR(); \
    o[2]=__builtin_amdgcn_mfma_f32_32x32x16_bf16(PAF(2),VFR(2),o[2],0,0,0); KRD(GL,2); EX2(C1,4);  PK1(nw1,2,C0,12); SBAR(); \
    o[3]=__builtin_amdgcn_mfma_f32_32x32x16_bf16(PAF(2),VFR(3),o[3],0,0,0); KRD(GL,3); EX2(C1,6);  PK1(nw1,3,C0,14); SBAR(); \
    o[0]=__builtin_amdgcn_mfma_f32_32x32x16_bf16(PAF(3),VFR(4),o[0],0,0,0); EX2(C1,8);  PK1(nw2,0,C1,0); SBAR(); \
    o[1]=__builtin_amdgcn_mfma_f32_32x32x16_bf16(PAF(3),VFR(5),o[1],0,0,0); EX2(C1,10); PK1(nw2,1,C1,2); SBAR(); \
    o[2]=__builtin_amdgcn_mfma_f32_32x32x16_bf16(PAF(3),VFR(6),o[2],0,0,0); EX2(C1,12); PK1(nw2,2,C1,4); PK1(nw3,0,C1,8); SBAR(); \
    o[3]=__builtin_amdgcn_mfma_f32_32x32x16_bf16(PAF(3),VFR(7),o[3],0,0,0); EX2(C1,14); PK1(nw2,3,C1,6); PK1(nw3,1,C1,10); SBAR(); \
    PK1(nw3,2,C1,12); PK1(nw3,3,C1,14); l_reg+=sacc; pw0=nw0; pw1=nw1; pw2=nw2; pw3=nw3; \
    }while(0)
  #define ENDW(tt) do{ if((tt)+3<NT){WAIT_BAR(3);} else if((tt)+2<NT){WAIT_BAR(2);} else {WAIT_BAR(0);} }while(0)
  int t=1;
  #undef CMASK
  #define CMASK(P0,P1,t) do{}while(0)
  const bool grpB=ATT_STAGGER&&(wid>=4);
  #define MIDBAR(tt) do{ if(grpB){ WAIT_BAR(3); } }while(0)
  for(;t<NT-4;++t){ STEP(t,true,true,true); if(!grpB){ WAIT_BAR(3); } RESC(); ROT(); }
  #undef MIDBAR
  #undef CMASK
  #define CMASK(P0,P1,t) do{int jb_=(t)-(NT-4); if(jb_>=0)cmask(P0,P1,jb_,qrel,hi);}while(0)
  #define MIDBAR(tt) do{ if(grpB){ ENDW(tt); } }while(0)
  for(;t<NT-1;++t){ STEP(t,(t+3<NT),(t+1<NT),(t+1<NT)); if(!grpB){ ENDW(t); } RESC(); ROT(); }
  #undef MIDBAR
  #define MIDBAR(tt) do{}while(0)
  STEP(NT-1,false,false,false); RESC();
  #undef MIDBAR
  SBAR(); pv4(o,vb0+2*sl_cur,PAF(0),PAF(1),PAF(2),PAF(3));
  #undef PKW
  #undef PAF
  #undef VFR
  #undef PIN
  #undef MX3
  #undef EX
  #undef VRDF
  #undef GA
  #undef EX2
  #undef PK1
  #undef KRD
  #undef STEP
  #undef ENDW
  {auto rr=__builtin_amdgcn_permlane32_swap(__float_as_uint(l_reg),__float_as_uint(l_reg),false,false);l_reg=__uint_as_float(rr[0])+__uint_as_float(rr[1]);}
  if(hi==0)wsf[32+r32]=l_reg;asm volatile("s_waitcnt lgkmcnt(0)":::"memory");
  { bf16*Of=O+(long)(q0+wid*QBLK)*opitch;
    #pragma unroll
    for(int r=0;r<16;++r){const int orow=crow(r,hi); const float rl=__builtin_amdgcn_rcpf(wsf[32+orow]);
      #pragma unroll
      for(int d0=0;d0<4;++d0)Of[(long)orow*opitch+d0*32+r32]=__float2bfloat16(o[d0][r]*rl);} }
  asm volatile("s_waitcnt lgkmcnt(0)\n\ts_barrier":::"memory");
  #undef DMA_K
  #undef DMA_V
  #undef CMASK
  #undef RESC
  #undef ROT
}

typedef int v8i_t __attribute__((ext_vector_type(8))); typedef int v4i_t __attribute__((ext_vector_type(4)));
constexpr float PV8_VSCALE=16.f, PV8_PBIAS=3.f;
constexpr int Y_K=0, Y_V=XSLOTS*SLOTB, Y_WS=Y_V+XSLOTS*SLOTB, Y_LDS_BYTES=Y_WS+NW*256;
template<int THRL,bool HOST> __device__ __forceinline__ void attn_unit128p8(int qb,const bf16*Q,const bf16*__restrict__ K,const unsigned char*__restrict__ VT,bf16*O,int opitch,char*shm,const int wid,const wconv::Tab&wct,wconv::State&wcs,const unsigned wstage){
  int lane; asm volatile("v_mbcnt_lo_u32_b32 %0, -1, 0\n\tv_mbcnt_hi_u32_b32 %0, -1, %0":"=v"(lane)); const int r32=lane&31,hi=lane>>5;
  const int q0=qb*QB;
  const bf16*Qw=Q+(long)(q0+wid*QBLK)*DM;
  const unsigned lds0=(unsigned)(uintptr_t)shm;
  float*wsf=(float*)(shm+Y_WS)+wid*64;
  const unsigned koff=(unsigned)(lane*DM+wid*8)*2u;
  const unsigned voff=(unsigned)(wid*1024+lane*16);
  const unsigned kdst=lds0+Y_K+wid*1024, vdst=lds0+Y_V+wid*1024;
  #define DMA_K(t,slot) glds16s(K+(long)(t)*KVBLK*DM,koff,(unsigned)__builtin_amdgcn_readfirstlane(kdst+(slot)))
  #define DMA_V(t,slot) glds16s(VT+(long)(t)*8192,voff,(unsigned)__builtin_amdgcn_readfirstlane(vdst+(slot)))
  const char*Kbase=shm+Y_K; bf16x8 kf[8];
  const lds_cptr shm3=(lds_cptr)shm; const lds_cptr kp0=shm3+Y_K+hi*1024+r32*16;
  const int sw_=(r32>>2)&3; const lds_cptr vq0=shm3+Y_V+r32*64+((2*hi)^sw_)*16, vq1=shm3+Y_V+r32*64+(((2*hi)^sw_)^1)*16;
  const int NT=(q0+QB)/KVBLK;
  DMA_K(0,0);DMA_V(0,0);DMA_K(1,SLOTB);
  bf16x8 qr[4];
  #pragma unroll
  for(int d0=0;d0<4;++d0)qr[d0]=*reinterpret_cast<const bf16x8*>(&Qw[(long)r32*DM+d0*16+hi*8]);
  float mhat=0.f,l_reg=0.f;f32x16 o[4];o[0]=f32x16{};o[1]=f32x16{};o[2]=f32x16{};o[3]=f32x16{};
  float zz_=0.f; asm volatile("":"+v"(zz_)); f32x16 negm;
  _Pragma("unroll") for(int r=0;r<16;++r)negm[r]=zz_; asm volatile("":"+v"(negm));
  const int qrel=wid*QBLK+r32;
  #define CMASK(P0,P1,t) do{int jb_=(t)-(NT-4); if(jb_>=0)cmask(P0,P1,jb_,qrel,hi);}while(0)
  bool resc=false;
  #define RESC() do{ if(resc){ asm volatile("s_waitcnt lgkmcnt(0)":::"memory"); \
      _Pragma("unroll") for(int d_=0;d_<4;++d_) _Pragma("unroll") for(int r=0;r<16;++r)o[d_][r]*=wsf[crow(r,hi)]; } }while(0)
  f32x16 C0,C1; v8i_t pw;
  int sl_prev=0,sl_cur=0,sl_next=SLOTB;
  #define ROT() do{sl_prev=sl_cur;sl_cur=sl_next;sl_next=(sl_next==(XSLOTS-1)*SLOTB)?0:sl_next+SLOTB;}while(0)
  #define PK8(X,B) ({ int w_; asm volatile("":"=v"(w_)); w_=__builtin_amdgcn_cvt_pk_fp8_f32(X[B],X[(B)+1],w_,false); __builtin_amdgcn_cvt_pk_fp8_f32(X[(B)+2],X[(B)+3],w_,true); })
  #define PKALL() do{ pw=(v8i_t){PK8(C0,0),PK8(C0,4),PK8(C0,8),PK8(C0,12),PK8(C1,0),PK8(C1,4),PK8(C1,8),PK8(C1,12)}; }while(0)
  DMA_K(2,2*SLOTB);
  WAIT_BAR(3);
  qkt(C0,C1,Kbase,qr,negm,r32,hi);asm volatile("s_nop 15\n\ts_nop 7":"+v"(C0),"+v"(C1));CMASK(C0,C1,0);
  { const float rm=rowmax(C0,C1); const float dl=rm-PV8_PBIAS; mhat=fadd_s(mhat,dl);
    _Pragma("unroll") for(int r=0;r<16;++r){C0[r]=fsub_s(C0[r],dl);C1[r]=fsub_s(C1[r],dl);}
    _Pragma("unroll") for(int r=0;r<16;++r)negm[r]=-mhat; asm volatile("":"+v"(negm));
    _Pragma("unroll") for(int r=0;r<16;++r){C0[r]=__builtin_amdgcn_exp2f(C0[r]);C1[r]=__builtin_amdgcn_exp2f(C1[r]);}
    float sacc=C0[0]+C0[1]; _Pragma("unroll") for(int r=2;r<16;++r)sacc+=C0[r]; _Pragma("unroll") for(int r=0;r<16;++r)sacc+=C1[r]; l_reg+=sacc;
    pw=(v8i_t){PK8(C0,0),PK8(C0,4),PK8(C0,8),PK8(C0,12),PK8(C1,0),PK8(C1,4),PK8(C1,8),PK8(C1,12)}; }
  WAIT_BAR(0);
  DMA_K(3,3*SLOTB);DMA_V(1,SLOTB);
  ROT();
  kload8(kf,kp0+sl_cur);
  WAIT_BAR(2);
  v8i_t vf[4];
  #define PIN(x) asm volatile("":"+v"(x))
  #define MX3(a,b,c) __builtin_fmaxf(__builtin_fmaxf((a),(b)),(c))
  #define EX(v) __builtin_amdgcn_exp2f(v)
  #define VRL(d) do{ vf[d].lo=*(const __attribute__((address_space(3))) v4i_t*)(vq0+sl_prev+(d)*2048); }while(0)
  #define VRH(d) do{ vf[d].hi=*(const __attribute__((address_space(3))) v4i_t*)(vq1+sl_prev+(d)*2048); }while(0)
  #define EX8(X,B) do{ _Pragma("unroll") for(int e_=0;e_<8;++e_)X[(B)+e_]=EX(X[(B)+e_]); PIN(X); }while(0)
  #define SM8(X,B) do{ _Pragma("unroll") for(int e_=0;e_<8;++e_)sacc+=X[(B)+e_]; PIN(sacc); }while(0)
  #define KRD(G,j) do{ if(G){ kload2(kf,kp0+sl_next,j); } }while(0)
  #define MF8(d) o[d]=__builtin_amdgcn_mfma_scale_f32_32x32x64_f8f6f4(pw,vf[d],o[d],0,0,0,0,0,0)
  #define STEP(t,GK,GV,GL) do{ SBAR(); \
    VRL(0); SBAR(); C0=__builtin_amdgcn_mfma_f32_32x32x16_bf16(kf[0],qr[0],negm,0,0,0); SBAR(); \
    VRH(0); SBAR(); C1=__builtin_amdgcn_mfma_f32_32x32x16_bf16(kf[1],qr[0],negm,0,0,0); SBAR(); \
    VRL(1); SBAR(); C0=__builtin_amdgcn_mfma_f32_32x32x16_bf16(kf[2],qr[1],C0,0,0,0); SBAR(); \
    VRH(1); SBAR(); C1=__builtin_amdgcn_mfma_f32_32x32x16_bf16(kf[3],qr[1],C1,0,0,0); SBAR(); \
    VRL(2); SBAR(); C0=__builtin_amdgcn_mfma_f32_32x32x16_bf16(kf[4],qr[2],C0,0,0,0); SBAR(); \
    VRH(2); SBAR(); C1=__builtin_amdgcn_mfma_f32_32x32x16_bf16(kf[5],qr[2],C1,0,0,0); SBAR(); \
    VRL(3); SBAR(); C0=__builtin_amdgcn_mfma_f32_32x32x16_bf16(kf[6],qr[3],C0,0,0,0); SBAR(); \
    VRH(3); SBAR(); C1=__builtin_amdgcn_mfma_f32_32x32x16_bf16(kf[7],qr[3],C1,0,0,0); SBAR(); \
    if(GK){DMA_K((t)+3,sl_prev);} if(GV){DMA_V((t)+1,sl_next);} \
    CMASK(C0,C1,t); \
    SBAR(); \
    float sacc=0.f; \
    MF8(0); KRD(GL,0); EX8(C0,0); SM8(C0,0); SBAR(); \
    MF8(1); KRD(GL,1); EX8(C0,8); SM8(C0,8); SBAR(); \
    MF8(2); KRD(GL,2); EX8(C1,0); SM8(C1,0); SBAR(); \
    MF8(3); KRD(GL,3); EX8(C1,8); SM8(C1,8); SBAR(); \
    PKALL(); \
    resc=false; \
    if(__builtin_expect(__any(sacc>256.f),0)){                  \
      float a=MX3(C0[0],C0[1],C1[0]),b=MX3(C0[2],C0[3],C1[1]); a=MX3(a,C1[2],C1[3]); \
      _Pragma("unroll") for(int r=4;r<16;r+=4){a=MX3(a,C0[r],C0[r+1]);b=MX3(b,C0[r+2],C0[r+3]);a=MX3(a,C1[r],C1[r+1]);b=MX3(b,C1[r+2],C1[r+3]);} \
      float rm=__builtin_fmaxf(a,b); { auto rr=__builtin_amdgcn_permlane32_swap(__float_as_uint(rm),__float_as_uint(rm),false,false); rm=__builtin_fmaxf(__uint_as_float(rr[0]),__uint_as_float(rr[1])); } \
      const float dl=__builtin_fmaxf(__builtin_amdgcn_logf(rm)-PV8_PBIAS,0.f); mhat+=dl; \
      _Pragma("unroll") for(int r=0;r<16;++r)negm[r]=-mhat; asm volatile("":"+v"(negm)); \
      const float f=__builtin_amdgcn_exp2f(-dl); l_reg*=f; sacc*=f; if(hi==0)wsf[r32]=f; resc=true; \
      _Pragma("unroll") for(int r=0;r<16;++r){C0[r]*=f;C1[r]*=f;} \
      PKALL(); } \
    l_reg+=sacc; \
    }while(0)
  #define ENDW(tt) do{ if((tt)+3<NT){WAIT_BAR(2);} else if((tt)+2<NT){WAIT_BAR(1);} else {WAIT_BAR(0);} }while(0)
  int t=1;
  #undef CMASK
  #define CMASK(P0,P1,t) do{}while(0)
  for(;t<NT-4;++t){ STEP(t,true,true,true);
    if(HOST&&((wcs.ctr++&7)==0)&&wcs.idx<wct.total){ wconv::micro(wct,wcs,wstage,lane); WAIT_BAR(7); }
    else{ WAIT_BAR(2); }
    RESC(); ROT(); }
  #undef CMASK
  #define CMASK(P0,P1,t) do{int jb_=(t)-(NT-4); if(jb_>=0)cmask(P0,P1,jb_,qrel,hi);}while(0)
  for(;t<NT-1;++t){ STEP(t,(t+3<NT),(t+1<NT),(t+1<NT)); ENDW(t); RESC(); ROT(); }
  STEP(NT-1,false,false,false); RESC();
  { sl_prev=sl_cur; SBAR();
    VRL(0);VRH(0);VRL(1);VRH(1);VRL(2);VRH(2);VRL(3);VRH(3); SBAR(); MF8(0);MF8(1);MF8(2);MF8(3); }
  #undef PK8
  #undef PKALL
  #undef PIN
  #undef MX3
  #undef EX
  #undef VRL
  #undef VRH
  #undef EX8
  #undef SM8
  #undef KRD
  #undef MF8
  #undef STEP
  #undef ENDW
  {auto rr=__builtin_amdgcn_permlane32_swap(__float_as_uint(l_reg),__float_as_uint(l_reg),false,false);l_reg=__uint_as_float(rr[0])+__uint_as_float(rr[1]);}
  if(hi==0)wsf[32+r32]=l_reg;asm volatile("s_waitcnt lgkmcnt(0)":::"memory");
  { bf16*Of=O+(long)(q0+wid*QBLK)*opitch;
    #pragma unroll
    for(int r=0;r<16;++r){const int orow=crow(r,hi); const float rl=__builtin_amdgcn_rcpf(wsf[32+orow])*(1.f/PV8_VSCALE);
      #pragma unroll
      for(int d0=0;d0<4;++d0)Of[(long)orow*opitch+d0*32+r32]=__float2bfloat16(o[d0][r]*rl);} }
  asm volatile("s_waitcnt lgkmcnt(0)\n\ts_barrier":::"memory");
  #undef DMA_K
  #undef DMA_V
  #undef CMASK
  #undef RESC
  #undef ROT
}

template<int THRL,bool HOST> __device__ __forceinline__ void attn_unit128q8(int qb,const bf16*Q,const unsigned char*__restrict__ K8,const unsigned char*__restrict__ VT,bf16*O,int opitch,char*shm,const int wid,const wconv::Tab&wct,wconv::State&wcs,const unsigned wstage){
  int lane; asm volatile("v_mbcnt_lo_u32_b32 %0, -1, 0\n\tv_mbcnt_hi_u32_b32 %0, -1, %0":"=v"(lane)); const int r32=lane&31,hi=lane>>5;
  const int q0=qb*QB;
  const bf16*Qw=Q+(long)(q0+wid*QBLK)*DM;
  const unsigned lds0=(unsigned)(uintptr_t)shm;
  float*wsf=(float*)(shm+Y_WS)+wid*64;
  const unsigned koff=(unsigned)((wid&3)*1024+lane*16);
  const unsigned voff=(unsigned)(wid*1024+lane*16);
  const unsigned kdst=lds0+Y_K+(wid&3)*1024, vdst=lds0+Y_V+wid*1024;
  #define DMA_K(t,slot) glds16s(K8+(long)(t)*4096,koff,(unsigned)__builtin_amdgcn_readfirstlane(kdst+(slot)))
  #define DMA_V(t,slot) glds16s(VT+(long)(t)*8192,voff,(unsigned)__builtin_amdgcn_readfirstlane(vdst+(slot)))
  v8i_t kf8[2];
  const lds_cptr shm3=(lds_cptr)shm;
  const int sw_=(r32>>2)&3; const lds_cptr vq0=shm3+Y_V+r32*64+((2*hi)^sw_)*16, vq1=shm3+Y_V+r32*64+(((2*hi)^sw_)^1)*16; const lds_cptr kq0=vq0+(Y_K-Y_V), kq1=vq1+(Y_K-Y_V);
  const int NT=(q0+QB)/KVBLK;
  DMA_K(0,0);DMA_V(0,0);DMA_K(1,SLOTB);
  v8i_t q8;
  { u32x4 w_[4];
    #pragma unroll
    for(int i=0;i<4;++i)w_[i]=*reinterpret_cast<const u32x4*>(&Qw[(long)r32*DM+hi*32+8*i]);
    #define BL(x) __uint_as_float((x)<<16)
    #define BH(x) __uint_as_float((x)&0xffff0000u)
    #define Q4(a,b) ({ int w2_=0; w2_=__builtin_amdgcn_cvt_pk_fp8_f32(BL(a),BH(a),w2_,false); __builtin_amdgcn_cvt_pk_fp8_f32(BL(b),BH(b),w2_,true); })
    q8=(v8i_t){Q4(w_[0][0],w_[0][1]),Q4(w_[0][2],w_[0][3]),Q4(w_[1][0],w_[1][1]),Q4(w_[1][2],w_[1][3]),Q4(w_[2][0],w_[2][1]),Q4(w_[2][2],w_[2][3]),Q4(w_[3][0],w_[3][1]),Q4(w_[3][2],w_[3][3])};
    #undef BL
    #undef BH
    #undef Q4
  }
  #define KLD(b,sl) do{ kf8[b].lo=*(const __attribute__((address_space(3))) v4i_t*)(kq0+(sl)+(b)*2048); kf8[b].hi=*(const __attribute__((address_space(3))) v4i_t*)(kq1+(sl)+(b)*2048); }while(0)
  #define QK8(b) __builtin_amdgcn_mfma_scale_f32_32x32x64_f8f6f4(kf8[b],q8,negm,0,0,0,0,0,0)
  float mhat=0.f,l_reg=0.f;f32x16 o[4];o[0]=f32x16{};o[1]=f32x16{};o[2]=f32x16{};o[3]=f32x16{};
  float zz_=0.f; asm volatile("":"+v"(zz_)); f32x16 negm;
  _Pragma("unroll") for(int r=0;r<16;++r)negm[r]=zz_; asm volatile("":"+v"(negm));
  const int qrel=wid*QBLK+r32;
  #define CMASK(P0,P1,t) do{int jb_=(t)-(NT-4); if(jb_>=0)cmask(P0,P1,jb_,qrel,hi);}while(0)
  bool resc=false;
  #define RESC() do{ if(resc){ asm volatile("s_waitcnt lgkmcnt(0)":::"memory"); \
      _Pragma("unroll") for(int d_=0;d_<4;++d_) _Pragma("unroll") for(int r=0;r<16;++r)o[d_][r]*=wsf[crow(r,hi)]; } }while(0)
  f32x16 C0,C1; v8i_t pw;
  int sl_prev=0,sl_cur=0,sl_next=SLOTB;
  #define ROT() do{sl_prev=sl_cur;sl_cur=sl_next;sl_next=(sl_next==(XSLOTS-1)*SLOTB)?0:sl_next+SLOTB;}while(0)
  #define PK8(X,B) ({ int w_; asm volatile("":"=v"(w_)); w_=__builtin_amdgcn_cvt_pk_fp8_f32(X[B],X[(B)+1],w_,false); __builtin_amdgcn_cvt_pk_fp8_f32(X[(B)+2],X[(B)+3],w_,true); })
  #define PKALL() do{ pw=(v8i_t){PK8(C0,0),PK8(C0,4),PK8(C0,8),PK8(C0,12),PK8(C1,0),PK8(C1,4),PK8(C1,8),PK8(C1,12)}; }while(0)
  DMA_K(2,2*SLOTB);
  WAIT_BAR(3);
  KLD(0,0);KLD(1,0);asm volatile("s_waitcnt lgkmcnt(0)":::"memory"); C0=QK8(0); C1=QK8(1); asm volatile("s_nop 15\n\ts_nop 7":"+v"(C0),"+v"(C1));CMASK(C0,C1,0);
  { const float rm=rowmax(C0,C1); const float dl=rm-PV8_PBIAS; mhat=fadd_s(mhat,dl);
    _Pragma("unroll") for(int r=0;r<16;++r){C0[r]=fsub_s(C0[r],dl);C1[r]=fsub_s(C1[r],dl);}
    _Pragma("unroll") for(int r=0;r<16;++r)negm[r]=-mhat; asm volatile("":"+v"(negm));
    _Pragma("unroll") for(int r=0;r<16;++r){C0[r]=__builtin_amdgcn_exp2f(C0[r]);C1[r]=__builtin_amdgcn_exp2f(C1[r]);}
    float sacc=C0[0]+C0[1]; _Pragma("unroll") for(int r=2;r<16;++r)sacc+=C0[r]; _Pragma("unroll") for(int r=0;r<16;++r)sacc+=C1[r]; l_reg+=sacc;
    pw=(v8i_t){PK8(C0,0),PK8(C0,4),PK8(C0,8),PK8(C0,12),PK8(C1,0),PK8(C1,4),PK8(C1,8),PK8(C1,12)}; }
  WAIT_BAR(0);
  DMA_K(3,3*SLOTB);DMA_V(1,SLOTB);
  ROT();
  KLD(0,sl_cur);KLD(1,sl_cur);
  WAIT_BAR(2);
  v8i_t vf[4];
  #define PIN(x) asm volatile("":"+v"(x))
  #define MX3(a,b,c) __builtin_fmaxf(__builtin_fmaxf((a),(b)),(c))
  #define EX(v) __builtin_amdgcn_exp2f(v)
  #define VRL(d) do{ vf[d].lo=*(const __attribute__((address_space(3))) v4i_t*)(vq0+sl_prev+(d)*2048); }while(0)
  #define VRH(d) do{ vf[d].hi=*(const __attribute__((address_space(3))) v4i_t*)(vq1+sl_prev+(d)*2048); }while(0)
  #define EX8(X,B) do{ _Pragma("unroll") for(int e_=0;e_<8;++e_)X[(B)+e_]=EX(X[(B)+e_]); PIN(X); }while(0)
  #define SM8(X,B) do{ _Pragma("unroll") for(int e_=0;e_<8;++e_)sacc+=X[(B)+e_]; PIN(sacc); }while(0)
  #define KRD(G,j) do{ if((G)&&(j)<2){ KLD(j,sl_next); } }while(0)
  #define MF8(d) o[d]=__builtin_amdgcn_mfma_scale_f32_32x32x64_f8f6f4(pw,vf[d],o[d],0,0,0,0,0,0)
  #define STEP(t,GK,GV,GL) do{ SBAR(); \
    VRL(0); VRH(0); VRL(1); VRH(1); SBAR(); C0=QK8(0); SBAR(); \
    VRL(2); VRH(2); VRL(3); VRH(3); SBAR(); C1=QK8(1); SBAR(); \
    if(GK){DMA_K((t)+3,sl_prev);} if(GV){DMA_V((t)+1,sl_next);} \
    CMASK(C0,C1,t); \
    SBAR(); \
    float sacc=0.f; \
    MF8(0); KRD(GL,0); EX8(C0,0); SM8(C0,0); SBAR(); \
    MF8(1); KRD(GL,1); EX8(C0,8); SM8(C0,8); SBAR(); \
    MF8(2); KRD(GL,2); EX8(C1,0); SM8(C1,0); SBAR(); \
    MF8(3); KRD(GL,3); EX8(C1,8); SM8(C1,8); SBAR(); \
    PKALL(); \
    resc=false; \
    if(__builtin_expect(__any(sacc>256.f),0)){                  \
      float a=MX3(C0[0],C0[1],C1[0]),b=MX3(C0[2],C0[3],C1[1]); a=MX3(a,C1[2],C1[3]); \
      _Pragma("unroll") for(int r=4;r<16;r+=4){a=MX3(a,C0[r],C0[r+1]);b=MX3(b,C0[r+2],C0[r+3]);a=MX3(a,C1[r],C1[r+1]);b=MX3(b,C1[r+2],C1[r+3]);} \
      float rm=__builtin_fmaxf(a,b); { auto rr=__builtin_amdgcn_permlane32_swap(__float_as_uint(rm),__float_as_uint(rm),false,false); rm=__builtin_fmaxf(__uint_as_float(rr[0]),__uint_as_float(rr[1])); } \
      const float dl=__builtin_fmaxf(__builtin_amdgcn_logf(rm)-PV8_PBIAS,0.f); mhat+=dl; \
      _Pragma("unroll") for(int r=0;r<16;++r)negm[r]=-mhat; asm volatile("":"+v"(negm)); \
      const float f=__builtin_amdgcn_exp2f(-dl); l_reg*=f; sacc*=f; if(hi==0)wsf[r32]=f; resc=true; \
      _Pragma("unroll") for(int r=0;r<16;++r){C0[r]*=f;C1[r]*=f;} \
      PKALL(); } \
    l_reg+=sacc; \
    }while(0)
  #define ENDW(tt) do{ if((tt)+3<NT){WAIT_BAR(2);} else if((tt)+2<NT){WAIT_BAR(1);} else {WAIT_BAR(0);} }while(0)
  int t=1;
  #undef CMASK
  #define CMASK(P0,P1,t) do{}while(0)
  for(;t<NT-4;++t){ STEP(t,true,true,true);
    if(HOST&&((wcs.ctr++&7)==0)&&wcs.idx<wct.total){ wconv::micro(wct,wcs,wstage,lane); WAIT_BAR(7); }
    else{ WAIT_BAR(2); }
    RESC(); ROT(); }
  #undef CMASK
  #define CMASK(P0,P1,t) do{int jb_=(t)-(NT-4); if(jb_>=0)cmask(P0,P1,jb_,qrel,hi);}while(0)
  for(;t<NT-1;++t){ STEP(t,(t+3<NT),(t+1<NT),(t+1<NT)); ENDW(t); RESC(); ROT(); }
  STEP(NT-1,false,false,false); RESC();
  { sl_prev=sl_cur; SBAR();
    VRL(0);VRH(0);VRL(1);VRH(1);VRL(2);VRH(2);VRL(3);VRH(3); SBAR(); MF8(0);MF8(1);MF8(2);MF8(3); }
  #undef PK8
  #undef PKALL
  #undef PIN
  #undef MX3
  #undef EX
  #undef VRL
  #undef VRH
  #undef EX8
  #undef SM8
  #undef KRD
  #undef KLD
  #undef QK8
  #undef MF8
  #undef STEP
  #undef ENDW
  {auto rr=__builtin_amdgcn_permlane32_swap(__float_as_uint(l_reg),__float_as_uint(l_reg),false,false);l_reg=__uint_as_float(rr[0])+__uint_as_float(rr[1]);}
  if(hi==0)wsf[32+r32]=l_reg;asm volatile("s_waitcnt lgkmcnt(0)":::"memory");
  { bf16*Of=O+(long)(q0+wid*QBLK)*opitch;
    #pragma unroll
    for(int r=0;r<16;++r){const int orow=crow(r,hi); const float rl=__builtin_amdgcn_rcpf(wsf[32+orow])*(1.f/PV8_VSCALE);
      #pragma unroll
      for(int d0=0;d0<4;++d0)Of[(long)orow*opitch+d0*32+r32]=__float2bfloat16(o[d0][r]*rl);} }
  asm volatile("s_waitcnt lgkmcnt(0)\n\ts_barrier":::"memory");
  #undef DMA_K
  #undef DMA_V
  #undef CMASK
  #undef RESC
  #undef ROT
}


constexpr int R_K=0, R_V=32768, R_KG=16384, R_VG=32768, R_LDS_BYTES=R_V+2*R_VG;
template<int THRL,bool HOST> __device__ __forceinline__ void attn_unit128r8(int qb,const bf16*Q,const unsigned char*__restrict__ K8,const unsigned char*__restrict__ VT,bf16*O,int opitch,char*shm,float*wsf0,const int wid,const wconv::Tab&wct,wconv::State&wcs,const unsigned wstage){
  int lane; asm volatile("v_mbcnt_lo_u32_b32 %0, -1, 0\n\tv_mbcnt_hi_u32_b32 %0, -1, %0":"=v"(lane)); const int r32=lane&31,hi=lane>>5;
  const int q0=qb*QB;
  const bf16*Qw=Q+(long)(q0+wid*QBLK)*DM;
  const unsigned lds0=(unsigned)(uintptr_t)shm;
  float*wsf=wsf0+wid*64;
  const unsigned poff=(unsigned)(wid*1024+lane*16);
  const unsigned pdst=lds0+wid*1024;
  #define SEND_K(g,np) do{ const unsigned char*s_=K8+(long)(4*(g)+2)*4096; const unsigned d_=pdst+R_K+(((g)+2)&1)*R_KG; \
      glds16s(s_,poff,(unsigned)__builtin_amdgcn_readfirstlane(d_)); if((np)>1){ glds16s(s_+8192,poff,(unsigned)__builtin_amdgcn_readfirstlane(d_+8192)); } }while(0)
  #define SEND_V(g) do{ const unsigned char*s_=VT+(long)(4*(g))*8192; const unsigned d_=pdst+R_V+((g)&1)*R_VG; \
      _Pragma("unroll") for(int j_=0;j_<4;++j_) glds16s(s_+j_*8192,poff,(unsigned)__builtin_amdgcn_readfirstlane(d_+j_*8192)); }while(0)
  v8i_t kf8[2];
  const lds_cptr shm3=(lds_cptr)shm;
  const int sw_=(r32>>2)&3; const lds_cptr vq0=shm3+R_V+r32*64+((2*hi)^sw_)*16, vq1=shm3+R_V+r32*64+(((2*hi)^sw_)^1)*16; const lds_cptr kq0=vq0+(R_K-R_V), kq1=vq1+(R_K-R_V);
  const int NT=(q0+QB)/KVBLK;
  glds16s(K8,poff,(unsigned)__builtin_amdgcn_readfirstlane(pdst+R_K+R_KG));
  v8i_t q8;
  { u32x4 w_[4];
    #pragma unroll
    for(int i=0;i<4;++i)w_[i]=*reinterpret_cast<const u32x4*>(&Qw[(long)r32*DM+hi*32+8*i]);
    SEND_V(0); SEND_K(0,(qb>0)?2:1);
    #define BL(x) __uint_as_float((x)<<16)
    #define BH(x) __uint_as_float((x)&0xffff0000u)
    #define Q4(a,b) ({ int w2_=0; w2_=__builtin_amdgcn_cvt_pk_fp8_f32(BL(a),BH(a),w2_,false); __builtin_amdgcn_cvt_pk_fp8_f32(BL(b),BH(b),w2_,true); })
    q8=(v8i_t){Q4(w_[0][0],w_[0][1]),Q4(w_[0][2],w_[0][3]),Q4(w_[1][0],w_[1][1]),Q4(w_[1][2],w_[1][3]),Q4(w_[2][0],w_[2][1]),Q4(w_[2][2],w_[2][3]),Q4(w_[3][0],w_[3][1]),Q4(w_[3][2],w_[3][3])};
    #undef BL
    #undef BH
    #undef Q4
  }
  #define KLD(b,ko) do{ kf8[b].lo=*(const __attribute__((address_space(3))) v4i_t*)(kq0+(ko)+(b)*2048); kf8[b].hi=*(const __attribute__((address_space(3))) v4i_t*)(kq1+(ko)+(b)*2048); }while(0)
  #define QK8(b) __builtin_amdgcn_mfma_scale_f32_32x32x64_f8f6f4(kf8[b],q8,negm,0,0,0,0,0,0)
  float mhat=0.f,l_reg=0.f;f32x16 o[4];o[0]=f32x16{};o[1]=f32x16{};o[2]=f32x16{};o[3]=f32x16{};
  float zz_=0.f; asm volatile("":"+v"(zz_)); f32x16 negm;
  _Pragma("unroll") for(int r=0;r<16;++r)negm[r]=zz_; asm volatile("":"+v"(negm));
  const int qrel=wid*QBLK+r32;
  #define CMASK(P0,P1,t) do{int jb_=(t)-(NT-4); if(jb_>=0)cmask(P0,P1,jb_,qrel,hi);}while(0)
  bool resc=false;
  #define RESC() do{ if(resc){ asm volatile("s_waitcnt lgkmcnt(0)":::"memory"); \
      _Pragma("unroll") for(int d_=0;d_<4;++d_) _Pragma("unroll") for(int r=0;r<16;++r)o[d_][r]*=wsf[crow(r,hi)]; } }while(0)
  f32x16 C0,C1; v8i_t pw;
  #define PK8(X,B) ({ int w_; asm volatile("":"=v"(w_)); w_=__builtin_amdgcn_cvt_pk_fp8_f32(X[B],X[(B)+1],w_,false); __builtin_amdgcn_cvt_pk_fp8_f32(X[(B)+2],X[(B)+3],w_,true); })
  #define PKALL() do{ pw=(v8i_t){PK8(C0,0),PK8(C0,4),PK8(C0,8),PK8(C0,12),PK8(C1,0),PK8(C1,4),PK8(C1,8),PK8(C1,12)}; }while(0)
  if(qb>0){ WAIT_BAR(6); } else { WAIT_BAR(5); }
  KLD(0,R_KG);KLD(1,R_KG);asm volatile("s_waitcnt lgkmcnt(0)":::"memory"); C0=QK8(0); C1=QK8(1); asm volatile("s_nop 15\n\ts_nop 7":"+v"(C0),"+v"(C1));CMASK(C0,C1,0);
  { const float rm=rowmax(C0,C1); const float dl=rm-PV8_PBIAS; mhat=fadd_s(mhat,dl);
    _Pragma("unroll") for(int r=0;r<16;++r){C0[r]=fsub_s(C0[r],dl);C1[r]=fsub_s(C1[r],dl);}
    _Pragma("unroll") for(int r=0;r<16;++r)negm[r]=-mhat; asm volatile("":"+v"(negm));
    _Pragma("unroll") for(int r=0;r<16;++r){C0[r]=__builtin_amdgcn_exp2f(C0[r]);C1[r]=__builtin_amdgcn_exp2f(C1[r]);}
    float sacc=C0[0]+C0[1]; _Pragma("unroll") for(int r=2;r<16;++r)sacc+=C0[r]; _Pragma("unroll") for(int r=0;r<16;++r)sacc+=C1[r]; l_reg+=sacc;
    pw=(v8i_t){PK8(C0,0),PK8(C0,4),PK8(C0,8),PK8(C0,12),PK8(C1,0),PK8(C1,4),PK8(C1,8),PK8(C1,12)}; }
  KLD(0,R_KG+4096);KLD(1,R_KG+4096);
  WAIT_BAR(0);
  v8i_t vf[4];
  #define PIN(x) asm volatile("":"+v"(x))
  #define MX3(a,b,c) __builtin_fmaxf(__builtin_fmaxf((a),(b)),(c))
  #define EX(v) __builtin_amdgcn_exp2f(v)
  #define VRL(d,vo) do{ vf[d].lo=*(const __attribute__((address_space(3))) v4i_t*)(vq0+(vo)+(d)*2048); }while(0)
  #define VRH(d,vo) do{ vf[d].hi=*(const __attribute__((address_space(3))) v4i_t*)(vq1+(vo)+(d)*2048); }while(0)
  #define EX8(X,B) do{ _Pragma("unroll") for(int e_=0;e_<8;++e_)X[(B)+e_]=EX(X[(B)+e_]); PIN(X); }while(0)
  #define SM8(X,B) do{ _Pragma("unroll") for(int e_=0;e_<8;++e_)sacc+=X[(B)+e_]; PIN(sacc); }while(0)
  #define KRD(G,j,ko) do{ if((G)&&(j)<2){ KLD(j,ko); } }while(0)
  #define MF8(d) o[d]=__builtin_amdgcn_mfma_scale_f32_32x32x64_f8f6f4(pw,vf[d],o[d],0,0,0,0,0,0)
  #define STEP(t,vo,ko,GL) do{ SBAR(); \
    VRL(0,vo); VRH(0,vo); VRL(1,vo); VRH(1,vo); SBAR(); C0=QK8(0); SBAR(); \
    VRL(2,vo); VRH(2,vo); VRL(3,vo); VRH(3,vo); SBAR(); C1=QK8(1); SBAR(); \
    CMASK(C0,C1,t); \
    SBAR(); \
    float sacc=0.f; \
    MF8(0); KRD(GL,0,ko); EX8(C0,0); SM8(C0,0); SBAR(); \
    MF8(1); KRD(GL,1,ko); EX8(C0,8); SM8(C0,8); SBAR(); \
    MF8(2); EX8(C1,0); SM8(C1,0); SBAR(); \
    MF8(3); EX8(C1,8); SM8(C1,8); SBAR(); \
    PKALL(); \
    resc=false; \
    if(__builtin_expect(__any(sacc>128.f),0)){                  \
      float a=MX3(C0[0],C0[1],C1[0]),b=MX3(C0[2],C0[3],C1[1]); a=MX3(a,C1[2],C1[3]); \
      _Pragma("unroll") for(int r=4;r<16;r+=4){a=MX3(a,C0[r],C0[r+1]);b=MX3(b,C0[r+2],C0[r+3]);a=MX3(a,C1[r],C1[r+1]);b=MX3(b,C1[r+2],C1[r+3]);} \
      float rm=__builtin_fmaxf(a,b); { auto rr=__builtin_amdgcn_permlane32_swap(__float_as_uint(rm),__float_as_uint(rm),false,false); rm=__builtin_fmaxf(__uint_as_float(rr[0]),__uint_as_float(rr[1])); } \
      const float dl=__builtin_fmaxf(__builtin_amdgcn_logf(rm)-PV8_PBIAS,0.f); mhat+=dl; \
      _Pragma("unroll") for(int r=0;r<16;++r)negm[r]=-mhat; asm volatile("":"+v"(negm)); \
      const float f=__builtin_amdgcn_exp2f(-dl); l_reg*=f; sacc*=f; if(hi==0)wsf[r32]=f; resc=true; \
      _Pragma("unroll") for(int r=0;r<16;++r){C0[r]*=f;C1[r]*=f;} \
      PKALL(); } \
    l_reg+=sacc; \
    RESC(); \
    }while(0)
  #define QUAD(g) do{ const int vs_=((g)&1)*R_VG, ks_=((g)&1)*R_KG; const int t0_=4*(g)+1; \
      STEP(t0_,vs_,ks_,true); STEP(t0_+1,vs_+8192,ks_+4096,true); STEP(t0_+2,vs_+16384,ks_+8192,true); STEP(t0_+3,vs_+24576,ks_+12288,true); }while(0)
  int g=0;
  #undef CMASK
  #define CMASK(P0,P1,t) do{}while(0)
  for(;g<qb-1;++g){
    SEND_K(g+1,2); SEND_V(g+1);
    QUAD(g);
    if(HOST&&((wcs.ctr++&1)==0)&&wcs.idx<wct.total){ wconv::micro(wct,wcs,wstage,lane); WAIT_BAR(5); }
    else{ WAIT_BAR(0); }
  }
  #undef CMASK
  #define CMASK(P0,P1,t) do{int jb_=(t)-(NT-4); if(jb_>=0)cmask(P0,P1,jb_,qrel,hi);}while(0)
  if(g<qb){
    SEND_K(g+1,1); SEND_V(g+1);
    QUAD(g);
    WAIT_BAR(0); ++g; }
  { const int vs_=(g&1)*R_VG, ks_=(g&1)*R_KG;
    STEP(NT-3,vs_,ks_,true); STEP(NT-2,vs_+8192,ks_+4096,true); STEP(NT-1,vs_+16384,0,false);
    SBAR(); VRL(0,vs_+24576);VRH(0,vs_+24576);VRL(1,vs_+24576);VRH(1,vs_+24576);VRL(2,vs_+24576);VRH(2,vs_+24576);VRL(3,vs_+24576);VRH(3,vs_+24576); SBAR(); MF8(0);MF8(1);MF8(2);MF8(3); }
  #undef QUAD
  #undef PK8
  #undef PKALL
  #undef PIN
  #undef MX3
  #undef EX
  #undef VRL
  #undef VRH
  #undef EX8
  #undef SM8
  #undef KRD
  #undef KLD
  #undef QK8
  #undef MF8
  #undef STEP
  {auto rr=__builtin_amdgcn_permlane32_swap(__float_as_uint(l_reg),__float_as_uint(l_reg),false,false);l_reg=__uint_as_float(rr[0])+__uint_as_float(rr[1]);}
  if(hi==0)wsf[32+r32]=l_reg;asm volatile("s_waitcnt lgkmcnt(0)":::"memory");
  { bf16*Of=O+(long)(q0+wid*QBLK)*opitch;
    #pragma unroll
    for(int r=0;r<16;++r){const int orow=crow(r,hi); const float rl=__builtin_amdgcn_rcpf(wsf[32+orow])*(1.f/PV8_VSCALE);
      #pragma unroll
      for(int d0=0;d0<4;++d0)Of[(long)orow*opitch+d0*32+r32]=__float2bfloat16(o[d0][r]*rl);} }
  asm volatile("s_waitcnt lgkmcnt(0)\n\ts_barrier":::"memory");
  #undef SEND_K
  #undef SEND_V
  #undef CMASK
  #undef RESC
}

template<int THRL,bool HOST> __device__ __forceinline__ void attn_unit128r9(int qb,const bf16*Q,const unsigned char*__restrict__ K8,const unsigned char*__restrict__ VT,bf16*O,int opitch,char*shm,float*wsf0,const int wid,const wconv::Tab&wct,wconv::State&wcs,const unsigned wstage){
  int lane; asm volatile("v_mbcnt_lo_u32_b32 %0, -1, 0\n\tv_mbcnt_hi_u32_b32 %0, -1, %0":"=v"(lane)); const int r32=lane&31,hi=lane>>5;
  const int q0=qb*QB;
  const bf16*Qw=Q+(long)(q0+wid*QBLK)*DM;
  const unsigned lds0=(unsigned)(uintptr_t)shm;
  float*wsf=wsf0+wid*64;
  const unsigned poff=(unsigned)(wid*1024+lane*16);
  const unsigned pdst=lds0+wid*1024;
  #define SEND_K(g,np) do{ const unsigned char*s_=K8+(long)(4*(g)+2)*4096; const unsigned d_=pdst+R_K+(((g)+2)&1)*R_KG; \
      glds16s(s_,poff,(unsigned)__builtin_amdgcn_readfirstlane(d_)); if((np)>1){ glds16s(s_+8192,poff,(unsigned)__builtin_amdgcn_readfirstlane(d_+8192)); } }while(0)
  #define SEND_V(g) do{ const unsigned char*s_=VT+(long)(4*(g))*8192; const unsigned d_=pdst+R_V+((g)&1)*R_VG; \
      _Pragma("unroll") for(int j_=0;j_<4;++j_) glds16s(s_+j_*8192,poff,(unsigned)__builtin_amdgcn_readfirstlane(d_+j_*8192)); }while(0)
  v8i_t kf8[2];
  const lds_cptr shm3=(lds_cptr)shm;
  const int sw_=(r32>>2)&3; const lds_cptr vq0=shm3+R_V+r32*64+((2*hi)^sw_)*16, vq1=shm3+R_V+r32*64+(((2*hi)^sw_)^1)*16; const lds_cptr kq0=vq0+(R_K-R_V), kq1=vq1+(R_K-R_V);
  const int NT=(q0+QB)/KVBLK;
  glds16s(K8,poff,(unsigned)__builtin_amdgcn_readfirstlane(pdst+R_K+R_KG));
  v8i_t q8;
  { u32x4 w_[4];
    #pragma unroll
    for(int i=0;i<4;++i)w_[i]=*reinterpret_cast<const u32x4*>(&Qw[(long)r32*DM+hi*32+8*i]);
    SEND_V(0); SEND_K(0,(qb>0)?2:1);
    #define BL(x) __uint_as_float((x)<<16)
    #define BH(x) __uint_as_float((x)&0xffff0000u)
    #define Q4(a,b) ({ int w2_=0; w2_=__builtin_amdgcn_cvt_pk_fp8_f32(BL(a),BH(a),w2_,false); __builtin_amdgcn_cvt_pk_fp8_f32(BL(b),BH(b),w2_,true); })
    q8=(v8i_t){Q4(w_[0][0],w_[0][1]),Q4(w_[0][2],w_[0][3]),Q4(w_[1][0],w_[1][1]),Q4(w_[1][2],w_[1][3]),Q4(w_[2][0],w_[2][1]),Q4(w_[2][2],w_[2][3]),Q4(w_[3][0],w_[3][1]),Q4(w_[3][2],w_[3][3])};
    #undef BL
    #undef BH
    #undef Q4
  }
  #define KLD(b,ko) do{ kf8[b].lo=*(const __attribute__((address_space(3))) v4i_t*)(kq0+(ko)+(b)*2048); kf8[b].hi=*(const __attribute__((address_space(3))) v4i_t*)(kq1+(ko)+(b)*2048); }while(0)
  #define QK8(b) __builtin_amdgcn_mfma_scale_f32_32x32x64_f8f6f4(kf8[b],q8,negm,0,0,0,0,0,0)
  float mhat=0.f;f32x16 o[4];
  typedef float f32x4s __attribute__((ext_vector_type(4)));
  const int bs_=((lane&15)==((lane>>4)&1))?0x38383838:0; const v8i_t bsel=(v8i_t){bs_,bs_,bs_,bs_,bs_,bs_,bs_,bs_};
  f32x4s lacc=(f32x4s){0.f,0.f,0.f,0.f},dsum=(f32x4s){0.f,0.f,0.f,0.f};
  #define SUMP() dsum=__builtin_amdgcn_mfma_scale_f32_16x16x128_f8f6f4(pw,bsel,(f32x4s){0.f,0.f,0.f,0.f},0,0,0,0,0,0)
o[0]=f32x16{};o[1]=f32x16{};o[2]=f32x16{};o[3]=f32x16{};
  float zz_=0.f; asm volatile("":"+v"(zz_)); f32x16 negm;
  _Pragma("unroll") for(int r=0;r<16;++r)negm[r]=zz_; asm volatile("":"+v"(negm));
  const int qrel=wid*QBLK+r32;
  #define CMASK(P0,P1,t) do{int jb_=(t)-(NT-4); if(jb_>=0)cmask(P0,P1,jb_,qrel,hi);}while(0)
  bool resc=false;
  #define RESC() do{ if(resc){ asm volatile("s_waitcnt lgkmcnt(0)":::"memory"); \
      _Pragma("unroll") for(int d_=0;d_<4;++d_) _Pragma("unroll") for(int r=0;r<16;++r)o[d_][r]*=wsf[crow(r,hi)]; } }while(0)
  f32x16 C0,C1; v8i_t pw;
  #define PK8(X,B) ({ int w_; asm volatile("":"=v"(w_)); w_=__builtin_amdgcn_cvt_pk_fp8_f32(X[B],X[(B)+1],w_,false); __builtin_amdgcn_cvt_pk_fp8_f32(X[(B)+2],X[(B)+3],w_,true); })
  #define PKALL() do{ pw=(v8i_t){PK8(C0,0),PK8(C0,4),PK8(C0,8),PK8(C0,12),PK8(C1,0),PK8(C1,4),PK8(C1,8),PK8(C1,12)}; }while(0)
  if(qb>0){ WAIT_BAR(6); } else { WAIT_BAR(5); }
  KLD(0,R_KG);KLD(1,R_KG);asm volatile("s_waitcnt lgkmcnt(0)":::"memory"); C0=QK8(0); C1=QK8(1); asm volatile("s_nop 15\n\ts_nop 7":"+v"(C0),"+v"(C1));CMASK(C0,C1,0);
  { const float rm=rowmax(C0,C1); const float dl=rm-PV8_PBIAS; mhat=fadd_s(mhat,dl);
    _Pragma("unroll") for(int r=0;r<16;++r){C0[r]=fsub_s(C0[r],dl);C1[r]=fsub_s(C1[r],dl);}
    _Pragma("unroll") for(int r=0;r<16;++r)negm[r]=-mhat; asm volatile("":"+v"(negm));
    _Pragma("unroll") for(int r=0;r<16;++r){C0[r]=__builtin_amdgcn_exp2f(C0[r]);C1[r]=__builtin_amdgcn_exp2f(C1[r]);}
    pw=(v8i_t){PK8(C0,0),PK8(C0,4),PK8(C0,8),PK8(C0,12),PK8(C1,0),PK8(C1,4),PK8(C1,8),PK8(C1,12)}; SUMP(); }
  KLD(0,R_KG+4096);KLD(1,R_KG+4096);
  WAIT_BAR(0);
  v8i_t vf[4];
  #define PIN(x) asm volatile("":"+v"(x))
  #define MX3(a,b,c) __builtin_fmaxf(__builtin_fmaxf((a),(b)),(c))
  #define EX(v) __builtin_amdgcn_exp2f(v)
  #define VRL(d,vo) do{ vf[d].lo=*(const __attribute__((address_space(3))) v4i_t*)(vq0+(vo)+(d)*2048); }while(0)
  #define VRH(d,vo) do{ vf[d].hi=*(const __attribute__((address_space(3))) v4i_t*)(vq1+(vo)+(d)*2048); }while(0)
  #define EX8(X,B) do{ _Pragma("unroll") for(int e_=0;e_<8;++e_)X[(B)+e_]=EX(X[(B)+e_]); PIN(X); }while(0)
  #define SM8(X,B) do{ _Pragma("unroll") for(int e_=0;e_<8;++e_)sacc+=X[(B)+e_]; PIN(sacc); }while(0)
  #define KRD(G,j,ko) do{ if((G)&&(j)<2){ KLD(j,ko); } }while(0)
  #define MF8(d) o[d]=__builtin_amdgcn_mfma_scale_f32_32x32x64_f8f6f4(pw,vf[d],o[d],0,0,0,0,0,0)
  #define CHECKP() do{ resc=false; \
    const float dm_=__builtin_fmaxf(__builtin_fmaxf(dsum[0],dsum[1]),__builtin_fmaxf(dsum[2],dsum[3])); \
    if(__builtin_expect(__any(!(dm_<256.f)),0)){ \
      float a=MX3(C0[0],C0[1],C1[0]),b=MX3(C0[2],C0[3],C1[1]); a=MX3(a,C1[2],C1[3]); \
      _Pragma("unroll") for(int r=4;r<16;r+=4){a=MX3(a,C0[r],C0[r+1]);b=MX3(b,C0[r+2],C0[r+3]);a=MX3(a,C1[r],C1[r+1]);b=MX3(b,C1[r+2],C1[r+3]);} \
      float rm=__builtin_fmaxf(a,b); { auto rr=__builtin_amdgcn_permlane32_swap(__float_as_uint(rm),__float_as_uint(rm),false,false); rm=__builtin_fmaxf(__uint_as_float(rr[0]),__uint_as_float(rr[1])); } \
      const float dl=__builtin_fmaxf(__builtin_amdgcn_logf(rm)-PV8_PBIAS,0.f); mhat+=dl; \
      _Pragma("unroll") for(int r=0;r<16;++r)negm[r]=-mhat; asm volatile("":"+v"(negm)); \
      const float f=__builtin_amdgcn_exp2f(-dl); if(hi==0)wsf[r32]=f; resc=true; \
      _Pragma("unroll") for(int r=0;r<16;++r){C0[r]*=f;C1[r]*=f;} \
      PKALL(); SUMP(); \
      asm volatile("s_waitcnt lgkmcnt(0)":::"memory"); \
      { const int qb_=(lane&15)*16+4*(lane>>4); _Pragma("unroll") for(int j_=0;j_<4;++j_)lacc[j_]*=wsf[(qb_+j_)&31]; } \
      _Pragma("unroll") for(int d_=0;d_<4;++d_) _Pragma("unroll") for(int r=0;r<16;++r)o[d_][r]*=wsf[crow(r,hi)]; } \
    lacc+=dsum; }while(0)
  #define STEP(t,vo,ko,GL) do{ SBAR(); \
    VRL(0,vo); VRH(0,vo); VRL(1,vo); VRH(1,vo); VRL(2,vo); VRH(2,vo); VRL(3,vo); VRH(3,vo); SBAR(); \
    CHECKP(); SBAR(); \
    C0=QK8(0); SBAR(); C1=QK8(1); SBAR(); \
    CMASK(C0,C1,t); \
    SBAR(); \
    MF8(0); KRD(GL,0,ko); EX8(C0,0); SBAR(); \
    MF8(1); KRD(GL,1,ko); EX8(C0,8); SBAR(); \
    MF8(2); EX8(C1,0); SBAR(); \
    MF8(3); EX8(C1,8); SBAR(); \
    PKALL(); SUMP(); \
    }while(0)
  #define QUAD(g) do{ const int vs_=((g)&1)*R_VG, ks_=((g)&1)*R_KG; const int t0_=4*(g)+1; \
      STEP(t0_,vs_,ks_,true); STEP(t0_+1,vs_+8192,ks_+4096,true); STEP(t0_+2,vs_+16384,ks_+8192,true); STEP(t0_+3,vs_+24576,ks_+12288,true); }while(0)
  int g=0;
  #undef CMASK
  #define CMASK(P0,P1,t) do{}while(0)
  for(;g<qb-1;++g){
    SEND_K(g+1,2); SEND_V(g+1);
    QUAD(g);
    if(HOST&&((wcs.ctr++&1)==0)&&wcs.idx<wct.total){ wconv::micro(wct,wcs,wstage,lane); WAIT_BAR(5); }
    else{ WAIT_BAR(0); }
  }
  #undef CMASK
  #define CMASK(P0,P1,t) do{int jb_=(t)-(NT-4); if(jb_>=0)cmask(P0,P1,jb_,qrel,hi);}while(0)
  if(g<qb){
    SEND_K(g+1,1); SEND_V(g+1);
    QUAD(g);
    WAIT_BAR(0); ++g; }
  { const int vs_=(g&1)*R_VG, ks_=(g&1)*R_KG;
    STEP(NT-3,vs_,ks_,true); STEP(NT-2,vs_+8192,ks_+4096,true); STEP(NT-1,vs_+16384,0,false);
    SBAR(); CHECKP(); SBAR(); VRL(0,vs_+24576);VRH(0,vs_+24576);VRL(1,vs_+24576);VRH(1,vs_+24576);VRL(2,vs_+24576);VRH(2,vs_+24576);VRL(3,vs_+24576);VRH(3,vs_+24576); SBAR(); MF8(0);MF8(1);MF8(2);MF8(3); }
  #undef QUAD
  #undef PK8
  #undef PKALL
  #undef PIN
  #undef MX3
  #undef EX
  #undef VRL
  #undef VRH
  #undef EX8
  #undef SM8
  #undef KRD
  #undef KLD
  #undef QK8
  #undef MF8
  #undef STEP
  #undef CHECKP
  #undef SUMP
  if((lane&15)<2){ const int qb_=(lane&15)*16+4*(lane>>4); _Pragma("unroll") for(int j_=0;j_<4;++j_)wsf[32+qb_+j_]=lacc[j_]; }
  asm volatile("s_waitcnt lgkmcnt(0)":::"memory");
  { bf16*Of=O+(long)(q0+wid*QBLK)*opitch;
    #pragma unroll
    for(int r=0;r<16;++r){const int orow=crow(r,hi); const float rl=__builtin_amdgcn_rcpf(wsf[32+orow])*(1.f/PV8_VSCALE);
      #pragma unroll
      for(int d0=0;d0<4;++d0)Of[(long)orow*opitch+d0*32+r32]=__float2bfloat16(o[d0][r]*rl);} }
  asm volatile("s_waitcnt lgkmcnt(0)\n\ts_barrier":::"memory");
  #undef SEND_K
  #undef SEND_V
  #undef CMASK
  #undef RESC
}


constexpr int BRA_NKT=4, BRA_GRP_BYTES=2*BRA_NKT*8192;
__device__ __forceinline__ void grp_bar(__attribute__((address_space(3))) unsigned* gb,int lane){
  asm volatile("s_waitcnt vmcnt(0) lgkmcnt(0)":::"memory");
  if(lane==0){
    const unsigned g0=__hip_atomic_load(gb+1,__ATOMIC_RELAXED,__HIP_MEMORY_SCOPE_WORKGROUP);
    const unsigned old=__hip_atomic_fetch_add(gb,1u,__ATOMIC_ACQ_REL,__HIP_MEMORY_SCOPE_WORKGROUP);
    if(old==3u){ __hip_atomic_store(gb,0u,__ATOMIC_RELAXED,__HIP_MEMORY_SCOPE_WORKGROUP); __hip_atomic_store(gb+1,g0+1u,__ATOMIC_RELEASE,__HIP_MEMORY_SCOPE_WORKGROUP); }
    else { unsigned sp=0; while(__hip_atomic_load(gb+1,__ATOMIC_ACQUIRE,__HIP_MEMORY_SCOPE_WORKGROUP)==g0){ __builtin_amdgcn_s_sleep(1); if(++sp>(1u<<24))break; } } }
  asm volatile("s_waitcnt lgkmcnt(0)":::"memory");
}
__device__ __forceinline__ void grp_bar_nv(__attribute__((address_space(3))) unsigned* gb,int lane){
  asm volatile("s_waitcnt lgkmcnt(0)":::"memory");
  if(lane==0){
    const unsigned g0=__hip_atomic_load(gb+1,__ATOMIC_RELAXED,__HIP_MEMORY_SCOPE_WORKGROUP);
    const unsigned old=__hip_atomic_fetch_add(gb,1u,__ATOMIC_ACQ_REL,__HIP_MEMORY_SCOPE_WORKGROUP);
    if(old==3u){ __hip_atomic_store(gb,0u,__ATOMIC_RELAXED,__HIP_MEMORY_SCOPE_WORKGROUP); __hip_atomic_store(gb+1,g0+1u,__ATOMIC_RELEASE,__HIP_MEMORY_SCOPE_WORKGROUP); }
    else { unsigned sp=0; while(__hip_atomic_load(gb+1,__ATOMIC_ACQUIRE,__HIP_MEMORY_SCOPE_WORKGROUP)==g0){ __builtin_amdgcn_s_sleep(1); if(++sp>(1u<<24))break; } } }
  asm volatile("s_waitcnt lgkmcnt(0)":::"memory");
}
struct BraUnit {
  const bf16* Q; const bf16* K; const bf16* V;
  bf16* PO; float* PL;
  int kbase, kstride, t_first, nkt;
  int nqt;
  int qbase, qstride, slotA;
  const int* list; int nlist, tile0, ownrow0;
};
#define BMX3(a,b,c) __builtin_fmaxf(__builtin_fmaxf((a),(b)),(c))
template<int MODE,int ABL=0> __device__ __forceinline__ void bra_unit(const BraUnit&u,char*shm  ,float*wsf  ,char*ost  ,__attribute__((address_space(3))) unsigned*gb,const int wg  ,__attribute__((address_space(3))) int*gqn  ,const int unext  ){
  int lane; asm volatile("v_mbcnt_lo_u32_b32 %0, -1, 0\n\tv_mbcnt_hi_u32_b32 %0, -1, %0":"=v"(lane)); const int r32=lane&31,hi=lane>>5;
  const unsigned lds0=(unsigned)(uintptr_t)shm;
  constexpr int BRA_K=0, BRA_V=BRA_NKT*8192;
  if(!(ABL&4)) for(int T=u.t_first;T<u.nkt;++T){
    #pragma unroll
    for(int pi=0;pi<2;++pi){ const int p=wg+4*pi;
      const long krow=u.kbase+(long)u.kstride*(64*T+8*p+(lane>>3)), vrow=u.kbase+(long)u.kstride*(64*T+16*(p&3)+(lane>>2));
      glds16(u.K+krow*DM+(((lane&7)^((4*p+(lane>>4))&7))*8),(unsigned)__builtin_amdgcn_readfirstlane(lds0+BRA_K+T*8192+p*1024));
      glds16(u.V+vrow*DM+(p>>2)*32+(lane&3)*8,(unsigned)__builtin_amdgcn_readfirstlane(lds0+BRA_V+T*8192+p*1024)); } }
  int qrow_[2],ql_[2],Tlo_[2],Thi_[2],slot_[2]; bool valid_[2],masked_[2],have_[2]; bf16x8 qr_[2][4];
  #pragma unroll
  for(int i=0;i<2;++i){ const int qt=wg+4*i; have_[i]=qt<u.nqt; valid_[i]=have_[i]; masked_[i]=true; qrow_[i]=0; ql_[i]=0; Tlo_[i]=0; Thi_[i]=-1; slot_[i]=0;
    if(have_[i]){
      if(MODE==0){ ql_[i]=32*qt+r32; qrow_[i]=u.qbase+u.qstride*ql_[i]; Tlo_[i]=(qt>>1)>u.t_first?(qt>>1):u.t_first; Thi_[i]=(qt>>1)+2; slot_[i]=u.slotA; }
      else { const int g=u.tile0+qt;
        if(g<8){ ql_[i]=32*g+r32; qrow_[i]=u.ownrow0+ql_[i]; Tlo_[i]=0; Thi_[i]=g>>1; slot_[i]=3; }
        else { const int e=(g-8)*32+r32; valid_[i]=e<u.nlist; const int ent=valid_[i]?u.list[e]:0; qrow_[i]=ent&0xffff; slot_[i]=ent>>16; Tlo_[i]=0; Thi_[i]=3; masked_[i]=false; } }
      #pragma unroll
      for(int d0=0;d0<4;++d0){ if(!(ABL&8)) qr_[i][d0]=*reinterpret_cast<const bf16x8*>(&u.Q[(long)qrow_[i]*DM+d0*16+hi*8]); else qr_[i][d0]=bf16x8{}; } } }
  grp_bar(gb,lane);
  if(wg==0&&lane==0)*gqn=unext;
  int*wsi=(int*)wsf+64;
  const int kaddr=r32*128+((hi^((r32>>1)&7))<<4);
  const int vbl=(int)(lds0+BRA_V)+((lane>>4)&1)*32+(lane&3)*8+(4*hi+((lane&15)>>2))*64;
  const unsigned dmax=(MODE==0)?128u:0x7fffffffu;
  #pragma unroll
  for(int i=0;i<2;++i){ if(!have_[i])continue;
    const int qrow=qrow_[i],ql=ql_[i],Tlo=Tlo_[i],Thi=Thi_[i],slot=slot_[i]; const bool valid=valid_[i],masked=masked_[i];
    bf16x8 qr[4];
    #pragma unroll
    for(int d0=0;d0<4;++d0)qr[d0]=qr_[i][d0];
    float mhat=0.f,l_reg=0.f; f32x16 o[2]; o[0]=f32x16{}; o[1]=f32x16{}; float zz_=0.f; asm volatile("":"+v"(zz_)); f32x16 negm;
    _Pragma("unroll") for(int r=0;r<16;++r)negm[r]=zz_;
    if(!(ABL&2)) for(int T=Tlo;T<=Thi;++T){
      f32x16 p0,p1; qkt_rm(p0,p1,shm+BRA_K+T*8192,kaddr,qr,negm);
      if(masked){ const int db=ql-64*T-4*hi+((MODE==0)?128:0);
        #pragma unroll
        for(int r=0;r<16;++r){ const int d=db-((r&3)+8*(r>>2)); if((unsigned)d>dmax)p0[r]=-INFINITY; if((unsigned)(d-32)>dmax)p1[r]=-INFINITY; } }
      float a=BMX3(p0[0],p0[1],p1[0]),b=BMX3(p0[2],p0[3],p1[1]); a=BMX3(a,p1[2],p1[3]);
      #pragma unroll
      for(int r=4;r<16;r+=4){a=BMX3(a,p0[r],p0[r+1]);b=BMX3(b,p0[r+2],p0[r+3]);a=BMX3(a,p1[r],p1[r+1]);b=BMX3(b,p1[r+2],p1[r+3]);}
      float rm=__builtin_fmaxf(a,b); { auto rr=__builtin_amdgcn_permlane32_swap(__float_as_uint(rm),__float_as_uint(rm),false,false); rm=__builtin_fmaxf(__uint_as_float(rr[0]),__uint_as_float(rr[1])); }
      if(__any(rm>8.f)){ const float dl=(rm>8.f)?rm:0.f; mhat+=dl;
        #pragma unroll
        for(int r=0;r<16;++r){p0[r]-=dl;p1[r]-=dl;}
        #pragma unroll
        for(int r=0;r<16;++r)negm[r]=-mhat;
        const float f=__builtin_amdgcn_exp2f(-dl); l_reg*=f; if(hi==0)wsf[r32]=f;
        asm volatile("s_waitcnt lgkmcnt(0)":::"memory");
        #pragma unroll
        for(int d_=0;d_<2;++d_)
          #pragma unroll
          for(int r=0;r<16;++r)o[d_][r]*=wsf[crow(r,hi)];
        asm volatile("s_waitcnt lgkmcnt(0)":::"memory"); }
      float sacc=0.f;
      #pragma unroll
      for(int r=0;r<16;++r){p0[r]=__builtin_amdgcn_exp2f(p0[r]);p1[r]=__builtin_amdgcn_exp2f(p1[r]);sacc+=p0[r]+p1[r];}
      l_reg+=sacc;
      u32x4 pw0,pw1,pw2,pw3;
      pw0=(u32x4){cvtpk_s(p0[0],p0[1]),cvtpk_s(p0[2],p0[3]),cvtpk_s(p0[4],p0[5]),cvtpk_s(p0[6],p0[7])}; pw1=(u32x4){cvtpk_s(p0[8],p0[9]),cvtpk_s(p0[10],p0[11]),cvtpk_s(p0[12],p0[13]),cvtpk_s(p0[14],p0[15])};
      pw2=(u32x4){cvtpk_s(p1[0],p1[1]),cvtpk_s(p1[2],p1[3]),cvtpk_s(p1[4],p1[5]),cvtpk_s(p1[6],p1[7])}; pw3=(u32x4){cvtpk_s(p1[8],p1[9]),cvtpk_s(p1[10],p1[11]),cvtpk_s(p1[12],p1[13]),cvtpk_s(p1[14],p1[15])};
      SBAR(); pv(o,vbl+T*8192,__builtin_bit_cast(bf16x8,pw0),__builtin_bit_cast(bf16x8,pw1),__builtin_bit_cast(bf16x8,pw2),__builtin_bit_cast(bf16x8,pw3));
    }
    {auto rr=__builtin_amdgcn_permlane32_swap(__float_as_uint(l_reg),__float_as_uint(l_reg),false,false);l_reg=__uint_as_float(rr[0])+__uint_as_float(rr[1]);}
    if(hi==0){ wsf[r32]=l_reg; wsi[r32]=valid?(slot*SEQ+qrow):-1; }
    asm volatile("s_waitcnt lgkmcnt(0)":::"memory");
    if(!(ABL&1)) if(hi==0&&valid) u.PL[(long)(slot*SEQ+qrow)*8]=mhat+__builtin_amdgcn_logf(l_reg);
    if(!(ABL&1)) { float rl_[16];
      #pragma unroll
      for(int r=0;r<16;++r)rl_[r]=__builtin_amdgcn_rcpf(wsf[crow(r,hi)]);
      typedef __attribute__((address_space(3))) unsigned short* lds_u16p; typedef unsigned u32x4s __attribute__((ext_vector_type(4)));
      const lds_u16p wp=(lds_u16p)(uintptr_t)(unsigned)(uintptr_t)ost + r32; const int rrow=lane>>2, rch=lane&3;
      #pragma unroll
      for(int d_=0;d_<2;++d_){
        #pragma unroll
        for(int r=0;r<16;++r)wp[crow(r,hi)*32]=(unsigned short)(cvtpk_s(o[d_][r]*rl_[r],0.f)&0xffffu);
        asm volatile("s_waitcnt lgkmcnt(0)":::"memory");
        #pragma unroll
        for(int p=0;p<2;++p){ const int row=16*p+rrow; const u32x4s w=*(const __attribute__((address_space(3))) u32x4s*)((lds_cptr)ost+row*64+rch*16); const int dst=wsi[row];
          if(dst>=0) *(__attribute__((address_space(1))) u32x4s*)(u.PO+(long)dst*512+d_*32+rch*8)=w; }
        asm volatile("s_waitcnt lgkmcnt(0)":::"memory"); } }
  }
}
#undef BMX3
#undef SBAR
#undef WAIT_BAR
}


constexpr int NWAVES = 8;
#ifndef MK_N_LAUNCHES
#define MK_N_LAUNCHES 1
#endif
constexpr int N_PHASES = 24;
static_assert(MK_N_LAUNCHES == 1 || MK_N_LAUNCHES == N_PHASES, "MK_N_LAUNCHES is 1 or 24");

constexpr int S_ = 16384, DM_ = 2048, INW = 6144, NEXP = 16, DEXP = 1024, DEPTH = 2, NROWBLK = 256  ;
constexpr int C_QA = 0, C_KA = 512, C_VA = 1024, C_QB = 1536, C_KB = 2048, C_VB = 2560, C_QC = 3072, C_KC = 4096, C_VC = 5120;
constexpr int MAXPOS = 2 * S_ + NEXP * 256;
constexpr float RMS_EPS = 1e-6f;
#ifndef ATT_PV8
#define ATT_PV8 1
#endif
constexpr float VT8_SCALE = 16.f;
#ifndef ATT_QK8
#define ATT_QK8 1
#endif
#ifndef ATT_R8
#define ATT_R8 1
#endif
#ifndef ABLV
#define ABLV 0
#endif
#ifndef ATT_SUMMFMA
#define ATT_SUMMFMA 0
#endif
#ifndef SEL_PASSES
#define SEL_PASSES 1
#endif
#ifndef SEL_MFMA
#define SEL_MFMA 1
#endif
#ifndef WC_INLOOP
#define WC_INLOOP 1
#endif
#ifndef GEMM_SP2
#define GEMM_SP2 true
#endif
#ifndef PROJ_FP8
#define PROJ_FP8 1
#endif
#ifndef OUT_FP8
#define OUT_FP8 3
#endif

constexpr size_t MiB = 1u << 20;
constexpr size_t WS_CTL = 0, CTL_ZERO_BYTES = 1 * MiB;
constexpr size_t WS_MOD = 1 * MiB;
constexpr size_t WS_COS = 2 * MiB, WS_SIN = 4 * MiB;
constexpr size_t WS_EID = 6 * MiB;
constexpr size_t WS_WTS = WS_EID + 131072;
constexpr size_t WS_ROWTOK = WS_WTS + 131072;
constexpr size_t WS_ROWW = WS_ROWTOK + 163840;
constexpr size_t WS_CNT = WS_ROWW + 163840;
constexpr size_t WS_KMEAN = 8 * MiB;
constexpr size_t WS_WIN = 16 * MiB;
constexpr size_t WS_WOUT = 64 * MiB;
constexpr size_t WS_WGU = 80 * MiB;
constexpr size_t WS_WDN = 336 * MiB;
constexpr size_t WS_H = 464 * MiB;
constexpr size_t WS_PROJ = 528 * MiB;
constexpr size_t WS_MERGED = 720 * MiB;
constexpr size_t WS_T = 784 * MiB;
constexpr size_t WS_VT8 = 848 * MiB;
constexpr size_t WS_K8 = 864 * MiB;
constexpr size_t WS_ACT = 912 * MiB;
constexpr size_t WS_XS = 984 * MiB;
constexpr size_t WS_POA = WS_ACT;
constexpr size_t WS_POB = WS_POA + 48 * MiB;
constexpr size_t WS_PLA = WS_POB + 64 * MiB;
constexpr size_t WS_PLB = WS_PLA + 2 * MiB;
constexpr size_t WS_LIST = WS_PLB + 2 * MiB;
static_assert(WS_LIST + 32 * MiB <= 1128 * MiB, "partials and lists inside the MoE-only regions");
constexpr size_t WS_Y = WS_PROJ;
constexpr size_t WS_XB = 1128 * MiB;
constexpr size_t WS_END = 1192 * MiB;
static_assert(WS_WIN == wconv::D_WIN && WS_WOUT == wconv::D_WOUT && WS_WGU == wconv::D_WGU && WS_WDN == wconv::D_WDN, "wconv destinations");
static_assert(WS_XS + (size_t)MAXPOS * 2048 * 2 <= WS_END && WS_ACT + (size_t)MAXPOS * 1024 * 2 <= WS_XS && WS_CNT + 16384 <= WS_KMEAN, "d_ws map");
constexpr int CW_TMO = 0, CW_CODE = 1, CW_BAR = 4096;
constexpr int CW_CNTB = 65536, CNTB_PITCH = 32;
constexpr int CW_SELDONE = 8192 + 2048;
constexpr int CW_QUEUE = 8192 + 1024;

constexpr int RING_OFF = 0, RING_BYTES = 131072;
constexpr int LDSCTL_OFF = RING_BYTES, MISC_OFF = LDSCTL_OFF + 320;
constexpr int LT_SEGS = LDSCTL_OFF + 1024;
constexpr int LT_TOT = LT_SEGS + 128;
constexpr int LT_BASE = LT_TOT + 64;
constexpr int LT_CNT = LT_BASE + 64;
constexpr int LT_P2E = LT_CNT + 64;
constexpr int LT_POS = LT_P2E + 160;
constexpr int LDS_BYTES = 163840;
constexpr int ATT_OST_OFF = 147456;
constexpr int ATT_KM_OFF = 0;
constexpr int ATT_WSF_OFF = LDSCTL_OFF + 4096;
constexpr int ATT_UST_OFF = LDSCTL_OFF + 8192, ATT_QN_OFF = ATT_UST_OFF + 2304, ATT_GB_OFF = ATT_QN_OFF + 128;
static_assert(attn_body::R_LDS_BYTES + 32768 <= RING_BYTES, "attention unit key-tile groups + weight-copy stage");
static_assert(LT_POS + 512 <= LDSCTL_OFF + 4096 && attn_body::ATTN_LDS_BYTES <= RING_BYTES && attn_body::X_LDS_BYTES <= RING_BYTES && 2 * attn_body::BRA_GRP_BYTES <= RING_BYTES && ATT_GB_OFF + 64 <= LDS_BYTES, "LDS map");

#define GAS __attribute__((address_space(1)))
#define LAS __attribute__((address_space(3)))
typedef unsigned short bf16;
typedef unsigned v4u __attribute__((ext_vector_type(4)));
typedef unsigned v2u __attribute__((ext_vector_type(2)));
typedef float f32x4 __attribute__((ext_vector_type(4)));
typedef short bf16x8 __attribute__((ext_vector_type(8)));
typedef GAS unsigned gu32;
#define RLX_AGENT __ATOMIC_RELAXED, __HIP_MEMORY_SCOPE_AGENT
#define LDS_WAIT() asm volatile("s_waitcnt lgkmcnt(0)" ::: "memory")
__device__ __forceinline__ unsigned f2bf(float f) { unsigned u = __builtin_bit_cast(unsigned, f); return (u + 0x7fffu + ((u >> 16) & 1u)) >> 16; }
__device__ __forceinline__ unsigned pk2(float lo, float hi) { return f2bf(lo) | (f2bf(hi) << 16); }
__device__ __forceinline__ float bflo(unsigned w) { return __builtin_bit_cast(float, w << 16); }
__device__ __forceinline__ float bfhi(unsigned w) { return __builtin_bit_cast(float, w & 0xffff0000u); }
#ifndef USE_NT
#define USE_NT 1
#endif
#if USE_NT
#define NTL(p) __builtin_nontemporal_load(p)
#define NTS(v, p) __builtin_nontemporal_store((v), (p))
#else
#define NTL(p) (*(p))
#define NTS(v, p) (*(p) = (v))
#endif
__device__ __forceinline__ float shx(float v, int o, int lane) { return __builtin_bit_cast(float, __builtin_amdgcn_ds_bpermute((lane ^ o) << 2, __builtin_bit_cast(int, v))); }
__device__ __forceinline__ int shup_i(int v, int o, int lane) { return __builtin_amdgcn_ds_bpermute(((lane - o) & 63) << 2, v); }
__device__ __forceinline__ float wave_sum(float v, int lane) {
#pragma unroll
    for (int o = 1; o < 64; o <<= 1) v += shx(v, o, lane);
    return v;
}

#define XB_TMO      128
#define XB_XCNT(j)  (256  + 64 * (j))
#define XB_XSUB(j)  (1280 + 64 * (j))
#define XB_XGEN(j)  (2304 + 64 * (j))
#define XB_TOP      3328
#define XB_TOPGEN   3392
#define XCD_BAR_WORDS 3456
#define XB_SPIN_CAP (1u << 18)

__device__ __forceinline__ unsigned xb_ld(unsigned* p)              { return __hip_atomic_load(p, __ATOMIC_RELAXED, __HIP_MEMORY_SCOPE_AGENT); }
__device__ __forceinline__ unsigned xb_add(unsigned* p, unsigned v) { return __hip_atomic_fetch_add(p, v, __ATOMIC_RELAXED, __HIP_MEMORY_SCOPE_AGENT); }
__device__ __forceinline__ unsigned xb_xcc_id() { return (unsigned)__builtin_amdgcn_s_getreg((3 << 11) | 20) & 0xFu; }
#define XB_SPIN(cond, bar) do { unsigned _sp = 0; while (cond) { __builtin_amdgcn_s_sleep(1); \
    if ((++_sp & 255u) == 0u) { if (xb_ld(&(bar)[XB_TMO])) break; if (_sp > XB_SPIN_CAP) { atomicAdd(&(bar)[XB_TMO], 1u); break; } } } } while (0)

struct XcdBarrier {
    unsigned* bar; unsigned x;
    volatile LAS unsigned* st;
};

__device__ __forceinline__ XcdBarrier xcd_barrier_post(unsigned* bar, volatile LAS unsigned* st) {
    XcdBarrier b; b.bar = bar; b.x = xb_xcc_id(); b.st = st;
    if (threadIdx.x == 0) (void)xb_add(&bar[XB_XCNT(b.x)], 1u);
    return b;
}
__device__ __forceinline__ void xcd_barrier_complete(unsigned* bar, unsigned x, unsigned& nloc, unsigned& nx) {
    const unsigned G = gridDim.x * gridDim.y * gridDim.z;
    unsigned sum, cnt, mine, sp = 0u;
    for (;;) {
        sum = 0u; cnt = 0u; mine = 0u;
#pragma unroll
        for (unsigned j = 0; j < 16; ++j) { const unsigned c = xb_ld(&bar[XB_XCNT(j)]); sum += c; cnt += (c > 0u) ? 1u : 0u; mine = (j == x) ? c : mine; }
        if (sum == G) break;
        __builtin_amdgcn_s_sleep(1);
        if ((++sp & 255u) == 0u) { if (xb_ld(&bar[XB_TMO])) break; if (sp > XB_SPIN_CAP) { atomicAdd(&bar[XB_TMO], 1u); break; } }
    }
    nloc = mine > 0u ? mine : 1u; nx = cnt > 0u ? cnt : 1u;
}

__device__ __forceinline__ void xcd_barrier(const XcdBarrier& b) {
    asm volatile("s_waitcnt vmcnt(0)" ::: "memory");
    __syncthreads();
    if (threadIdx.x == 0) {
        unsigned* bar = b.bar; asm volatile("" : "+s"(bar)); unsigned bx_ = b.x; asm volatile("" : "+s"(bx_));
        __builtin_amdgcn_s_waitcnt(0);
        unsigned nloc = b.st[0], nx = b.st[1];
        if (nloc == 0u) { xcd_barrier_complete(bar, bx_, nloc, nx); b.st[0] = nloc; b.st[1] = nx; }
        const unsigned old = xb_add(&bar[XB_XSUB(bx_)], 1u);
        const unsigned gen = old / nloc;
        if (old + 1u == (gen + 1u) * nloc) {
            __builtin_amdgcn_fence(__ATOMIC_RELEASE, "agent");
            asm volatile("s_waitcnt vmcnt(0)" ::: "memory");
            const unsigned og = xb_add(&bar[XB_TOP], 1u);
            const unsigned tg = og / nx;
            if (og + 1u == (tg + 1u) * nx) xb_add(&bar[XB_TOPGEN], 1u);
            else XB_SPIN(xb_ld(&bar[XB_TOPGEN]) == tg, bar);
            __builtin_amdgcn_fence(__ATOMIC_ACQUIRE, "agent");
            xb_add(&bar[XB_XGEN(bx_)], 1u);
            asm volatile("s_waitcnt vmcnt(0)" ::: "memory");
        } else {
            XB_SPIN(xb_ld(&bar[XB_XGEN(bx_)]) == gen, bar);
            __builtin_amdgcn_fence(__ATOMIC_ACQUIRE, "agent");
            asm volatile("s_waitcnt vmcnt(0)" ::: "memory");
        }
    }
    __syncthreads();
}


struct TItem { const float* W; unsigned char* WT; int K, N, map, item, b16; float wsc; };
__device__ __forceinline__ void titem_load(const TItem& t, float (&tv)[32], int lane) {
    const int nblk = t.N / 32, kb = t.item / nblk, nb = t.item % nblk, k0 = 64 * kb, n0 = 32 * nb;
#pragma unroll
    for (int i = 0; i < 32; ++i) tv[i] = t.W[(size_t)(k0 + 2 * i + (lane >> 5)) * t.N + n0 + (lane & 31)];
}
__device__ __forceinline__ void titem_finish(const TItem& t, const float (&tv)[32], LAS float* scr, int lane) {
    const int nblk = t.N / 32, kb = t.item / nblk, nb = t.item % nblk, k0 = 64 * kb, n0 = 32 * nb;
#pragma unroll
    for (int i = 0; i < 32; ++i) scr[(2 * i + (lane >> 5)) * 33 + (lane & 31)] = tv[i] * t.wsc;
    LDS_WAIT(); asm volatile("" ::: "memory");
    if (t.b16) { const int c = lane & 7;
#pragma unroll
        for (int j = 0; j < 4; ++j) { const int n = (lane >> 3) + 8 * j; const LAS float* sp = scr + (8 * c) * 33 + n;
            v4u o; o.x = pk2(sp[0 * 33], sp[1 * 33]); o.y = pk2(sp[2 * 33], sp[3 * 33]); o.z = pk2(sp[4 * 33], sp[5 * 33]); o.w = pk2(sp[6 * 33], sp[7 * 33]);
            *(GAS v4u*)((bf16*)t.WT + (size_t)dest_row(t.map, n0 + n) * t.K + k0 + 8 * c) = o; }
    } else { const int c = lane & 3;
#pragma unroll
        for (int j = 0; j < 2; ++j) { const int n = (lane >> 2) + 16 * j; const LAS float* sp = scr + (16 * c) * 33 + n;
            v4u o; o.x = pg8::pk4_fp8(sp[0 * 33], sp[1 * 33], sp[2 * 33], sp[3 * 33]); o.y = pg8::pk4_fp8(sp[4 * 33], sp[5 * 33], sp[6 * 33], sp[7 * 33]);
            o.z = pg8::pk4_fp8(sp[8 * 33], sp[9 * 33], sp[10 * 33], sp[11 * 33]); o.w = pg8::pk4_fp8(sp[12 * 33], sp[13 * 33], sp[14 * 33], sp[15 * 33]);
            *(GAS v4u*)(t.WT + (size_t)dest_row(t.map, n0 + n) * t.K + k0 + 16 * c) = o; } }
    LDS_WAIT(); asm volatile("" ::: "memory");
}

struct Args { const void* in[20]; float* out; unsigned char* ws; int ph_lo, ph_hi; };

__global__ void __launch_bounds__(NWAVES * 64, 2) fwd(Args args) {
    extern __shared__ __attribute__((aligned(16))) unsigned char lds[];
    LAS unsigned char* const L = (LAS unsigned char*)lds;
    const int kG = gridDim.x, kbx = blockIdx.x;
    const int kwave = __builtin_amdgcn_readfirstlane((int)threadIdx.x >> 6);
    typedef __attribute__((address_space(4))) const Args* kargp_t;
#define PHASE_BEGIN() \
    kargp_t ka = (kargp_t)__builtin_amdgcn_kernarg_segment_ptr(); asm volatile("" : "+s"(ka)); \
    unsigned char* const ws = ka->ws; \
    int lane; asm volatile("v_mbcnt_lo_u32_b32 %0, -1, 0\n\tv_mbcnt_hi_u32_b32 %0, -1, %0" : "=v"(lane)); \
    int G = kG, bx = kbx, wave_s = kwave; asm volatile("" : "+s"(G), "+s"(bx), "+s"(wave_s));     \
    const int vcu = (G % 8 == 0) ? (bx % 8) * (G / 8) + bx / 8 : bx; const int NGW = G * NWAVES; \
    const int wave = wave_s; const int tid = wave * 64 + lane; const int gw = vcu * NWAVES + wave; (void)gw; (void)lane; (void)ws; (void)tid; (void)NGW
#define KIN(T, k) ((const T*)ka->in[k])
    LAS int* const segs = (LAS int*)(L + LT_SEGS); LAS int* const tot = (LAS int*)(L + LT_TOT); LAS int* const basee = (LAS int*)(L + LT_BASE); LAS int* const cnt16 = (LAS int*)(L + LT_CNT);
    LAS unsigned char* const p2e = L + LT_P2E; LAS int* const postab = (LAS int*)(L + LT_POS);
    gu32* const ctl = (gu32*)(args.ws + WS_CTL);

    for (int u = threadIdx.x; u < (LDS_BYTES - LDSCTL_OFF) / 4; u += NWAVES * 64) ((LAS unsigned*)(L + LDSCTL_OFF))[u] = 0u;
    __syncthreads();
    const int lo = args.ph_lo, hi = args.ph_hi;
    XcdBarrier bar; bar.bar = (unsigned*)(ctl + CW_BAR); bar.x = 0; bar.st = nullptr;
    if (hi - lo > 1) bar = xcd_barrier_post((unsigned*)(ctl + CW_BAR), (volatile LAS unsigned*)(L + MISC_OFF) + 8);
#ifndef PHMASK
#define PHMASK 0x1fff
#endif
#define IN(k) (lo <= (k) && (k) < hi)
#define INJ(j) ((((PHMASK) >> (j)) & 1) && IN(pb + (j)))
#ifndef REPEAT_J
#define REPEAT_J (-1)
#endif
#ifndef REPEAT_L
#define REPEAT_L 0
#endif
#ifndef REPEAT_N
#define REPEAT_N 2
#endif
#define REPS(j) ((REPEAT_J == (j) && l == REPEAT_L) ? REPEAT_N : 1)
#if defined(STAMP_A)
    LAS unsigned long long* const stamps = (LAS unsigned long long*)(L + LDSCTL_OFF + 2048); int n_stamp = 0;
#define STAMP() do { if (kbx == 0 && threadIdx.x == 0) stamps[n_stamp] = __builtin_amdgcn_s_memrealtime(); ++n_stamp; } while (0)
    STAMP();
#else
#define STAMP() do { } while (0)
#endif
#define SEAM(k) do { if (IN(k) && IN((k) + 1)) { xcd_barrier(bar); STAMP(); } } while (0)

#define COMPUTE_SEGMENTS(myrb) do { \
        _Pragma("unroll") for (int q_ = 0; q_ < 2; ++q_) { const int e_ = 2 * wave + q_; int t_ = 0, p_ = 0; \
            _Pragma("unroll") for (int j_ = 0; j_ < 4; ++j_) { const int rb_ = lane + 64 * j_; const int c_ = CNT[rb_ * 16 + e_]; t_ += c_; p_ += (rb_ < (myrb)) ? c_ : 0; } \
            t_ = (int)wave_sum((float)t_, lane); p_ = (int)wave_sum((float)p_, lane); if (lane == 0) { tot[e_] = t_; basee[e_] = p_; } } \
        __syncthreads(); \
        if (tid == 0) { int s_ = 0; for (int e_ = 0; e_ < 16; ++e_) { segs[e_] = s_; s_ += (tot[e_] + 255) & ~255; } segs[16] = s_; } \
        __syncthreads(); \
        if (tid < 160) { const int r_ = tid * 256; int e_ = 0; for (int k_ = 1; k_ < 16; ++k_) if (r_ >= segs[k_]) e_ = k_; p2e[tid] = (unsigned char)e_; } \
        if (tid < 16) basee[tid] += segs[tid]; \
        __syncthreads(); } while (0)

    if (((PHMASK >> 11) & 1) && IN(0)) for (int rp = 0; rp < ((REPEAT_J == 11) ? REPEAT_N : 1); ++rp) {
        PHASE_BEGIN();
        const float* const c_in = KIN(float, 1); const int* const positions = KIN(int, 2); const float* const w_ada = KIN(float, 3); const float* const b_ada = KIN(float, 4);
        const float* const w_in = KIN(float, 7); const float* const w_out = KIN(float, 8); const float* const w_gate = KIN(float, 14); const float* const w_up = KIN(float, 15); const float* const w_down = KIN(float, 16);
        float* const MOD = (float*)(ws + WS_MOD); float* const COS = (float*)(ws + WS_COS); float* const SIN = (float*)(ws + WS_SIN);
        unsigned char* const WIN = ws + WS_WIN; unsigned char* const WOUT = ws + WS_WOUT; unsigned char* const WGU = ws + WS_WGU; unsigned char* const WDN = ws + WS_WDN;
        LAS float* const svt = (LAS float*)(L + 8192);
        if (bx < 192) {
#pragma unroll
            for (int i = 0; i < 4; ++i) { const float cv = c_in[tid + 512 * i]; svt[tid + 512 * i] = cv / (1.f + expf(-cv)); }
            __syncthreads(); }
        for (int it = bx; it < 192; it += G) {
            const int l = it / 96, cg = it % 96, col = cg * 128 + lane * 2;
            const float* W = w_ada + ((size_t)l * 2048 + wave * 256) * 12288 + col; const LAS f32x4* const sv4 = (const LAS f32x4*)(svt + wave * 256);
            typedef float f32x2 __attribute__((ext_vector_type(2)));
            f32x2 a = (f32x2){0.f, 0.f};
#pragma unroll 8
            for (int k4 = 0; k4 < 64; ++k4) { const f32x4 s4 = sv4[k4]; const float* Wk = W + (size_t)(4 * k4) * 12288;
                const f32x2 w0 = *(const GAS f32x2*)(Wk), w1 = *(const GAS f32x2*)(Wk + 12288), w2 = *(const GAS f32x2*)(Wk + 2 * 12288), w3 = *(const GAS f32x2*)(Wk + 3 * 12288);
                a += s4.x * w0; a += s4.y * w1; a += s4.z * w2; a += s4.w * w3; }
            LAS f32x2* red = (LAS f32x2*)L; red[wave * 64 + lane] = a;
            __syncthreads();
            if (tid < 128) { float s = 0.f; const LAS float* rf = (const LAS float*)L;
#pragma unroll
                for (int w = 0; w < 8; ++w) s += rf[(w * 64 + (tid >> 1)) * 2 + (tid & 1)];
                MOD[l * 12288 + cg * 128 + tid] = s + b_ada[l * 12288 + cg * 128 + tid]; }
            __syncthreads();
        }
        { LAS float* scr = (LAS float*)(L + RING_OFF + wave * 16384);
          constexpr int I_IN = (PROJ_FP8 ? 1 : 2) * 32 * 192, N_OUT16 = 2 - ((OUT_FP8 & 1) + ((OUT_FP8 >> 1) & 1)), I_OUT = N_OUT16 * 32 * 64, NITEMS = I_IN + I_OUT;
#define TDECODE(T, it_) do { int r = (it_); \
              if (r < I_IN) { const int l_ = r / 6144; T.W = w_in + (size_t)l_ * 2048 * 6144; T.K = 2048; T.N = 6144; T.map = 1; T.item = r % 6144; T.b16 = PROJ_FP8 ? 0 : 1; T.wsc = PROJ_FP8 ? WSC_K2048 : 1.f; T.WT = WIN + (size_t)l_ * 6144 * (PROJ_FP8 ? 2048 : 4096); break; } r -= I_IN; \
              { const int l_ = (r / 2048 == 0) ? ((OUT_FP8 & 1) ? 1 : 0) : 1; T.W = w_out + (size_t)l_ * 2048 * 2048; T.K = 2048; T.N = 2048; T.map = 0; T.item = r % 2048; T.b16 = 1; T.wsc = 1.f; T.WT = WOUT + (size_t)l_ * 2048 * 4096; } } while (0)
          const bool spare = (G > 192); const int ncw = spare ? (G - 192) * NWAVES : G * NWAVES, cw = spare ? (bx - 192) * NWAVES + wave : bx * NWAVES + wave;
          for (int ch = cw; ch >= 0; ch += ncw) {
              const int c0 = ch * 16; if (c0 >= NITEMS) break;
              const int c1 = (c0 + 16 < NITEMS) ? c0 + 16 : NITEMS;
              TItem cur; TDECODE(cur, c0); float tv[32]; titem_load(cur, tv, lane);
              for (int it = c0; it < c1; ++it) {
                  TItem nxt = cur; float tn[32]; const bool hn = it + 1 < c1;
                  if (hn) { TDECODE(nxt, it + 1); titem_load(nxt, tn, lane); }
                  titem_finish(cur, tv, scr, lane);
                  if (hn) { cur = nxt;
#pragma unroll
                      for (int i = 0; i < 32; ++i) tv[i] = tn[i]; }
              }
          }
#undef TDECODE
        }
        for (int idx = (vcu * NWAVES * 64 + tid); idx < S_ * 32; idx += G * NWAVES * 64) {
            const int pi = idx >> 5, i = idx & 31; const float inv = (float)exp2(-(double)i * (13.287712379549449 / 32.0)); const float ang = (float)positions[pi] * inv;
            COS[idx] = cosf(ang); SIN[idx] = sinf(ang); }
    }
    SEAM(0);

#if defined(EXTRA_BARRIERS)
    if (lo == 0 && hi - lo > 1) for (int xb = 0; xb < EXTRA_BARRIERS; ++xb) xcd_barrier(bar);
#endif
    for (int l = 0; l < DEPTH; ++l) {
        const int pb = 1 + 11 * l;
        const float lam_init = (l == 0) ? 0.2f : 0.35550906759f;
        if (INJ(0)) for (int rp = 0; rp < REPS(0); ++rp) {
            PHASE_BEGIN();
            const float* const x_in = KIN(float, 0); const float* const g_attn = KIN(float, 5); bf16* const xbuf = (bf16*)(ws + WS_XB);
            const float* const MOD = (const float*)(ws + WS_MOD); const float* const mod = MOD + l * 12288; unsigned char* const HB = ws + WS_H; const bf16* const YB = (const bf16*)(ws + WS_Y);
            LAS f32x4* const cAl = (LAS f32x4*)L; LAS f32x4* const cBl = cAl + 512; LAS f32x4* const cGl = cAl + 1024;
            { const int c4 = tid; const f32x4 g = ((const f32x4*)(g_attn + l * 2048))[c4]; const f32x4 sc = ((const f32x4*)(mod + 2048))[c4];
              cAl[c4] = g * (1.f + sc); cBl[c4] = ((const f32x4*)(mod + 0))[c4]; cGl[c4] = (l > 0) ? ((const f32x4*)(MOD + (l - 1) * 12288 + 10240))[c4] : (f32x4){0.f, 0.f, 0.f, 0.f}; }
            __syncthreads();
#define XLOAD(WY_, dst, r_) do { if (WY_) { const v2u xw_ = NTL((const GAS v2u*)(xbuf + (size_t)(r_) * 2048) + (lane + 64 * j)); dst = (f32x4){bflo(xw_.x), bfhi(xw_.x), bflo(xw_.y), bfhi(xw_.y)}; } \
                              else dst = NTL((const GAS f32x4*)(x_in + (size_t)(r_) * 2048) + (lane + 64 * j)); } while (0)
#define NORM_LOOP(WITH_Y) do { \
            f32x4 nv[8]; v2u na[8], nb[8]; \
            _Pragma("unroll") for (int j = 0; j < 8; ++j) { XLOAD(WITH_Y, nv[j], gw); \
                if (WITH_Y) { na[j] = NTL((const GAS v2u*)(YB + (size_t)(2 * gw) * 2048) + (lane + 64 * j)); nb[j] = NTL((const GAS v2u*)(YB + (size_t)(2 * gw + 1) * 2048) + (lane + 64 * j)); } } \
            for (int row = gw; row < S_; row += NGW) { \
                f32x4 v[8]; \
                _Pragma("unroll") for (int j = 0; j < 8; ++j) v[j] = nv[j]; \
                if (WITH_Y) { \
                    _Pragma("unroll") for (int j = 0; j < 8; ++j) { const v2u a = na[j], b = nb[j]; \
                        const f32x4 ys = (f32x4){bflo(a.x) + bflo(b.x), bfhi(a.x) + bfhi(b.x), bflo(a.y) + bflo(b.y), bfhi(a.y) + bfhi(b.y)}; \
                        v[j] += cGl[lane + 64 * j] * ys; v2u xo_; xo_.x = pk2(v[j].x, v[j].y); xo_.y = pk2(v[j].z, v[j].w); ((GAS v2u*)(xbuf + (size_t)row * 2048))[lane + 64 * j] = xo_; \
                        v[j] = (f32x4){bflo(xo_.x), bfhi(xo_.x), bflo(xo_.y), bfhi(xo_.y)}; } \
                } \
                const int nrow = row + NGW; \
                if (nrow < S_) { \
                    _Pragma("unroll") for (int j = 0; j < 8; ++j) { XLOAD(WITH_Y, nv[j], nrow); \
                        if (WITH_Y) { na[j] = NTL((const GAS v2u*)(YB + (size_t)(2 * nrow) * 2048) + (lane + 64 * j)); nb[j] = NTL((const GAS v2u*)(YB + (size_t)(2 * nrow + 1) * 2048) + (lane + 64 * j)); } } \
                } \
                float ss = 0.f; \
                _Pragma("unroll") for (int j = 0; j < 8; ++j) ss += (v[j].x * v[j].x + v[j].y * v[j].y) + (v[j].z * v[j].z + v[j].w * v[j].w); \
                const float rs = 1.f / sqrtf(wave_sum(ss, lane) * (1.f / 2048.f) + RMS_EPS); \
                _Pragma("unroll") for (int j = 0; j < 8; ++j) { const f32x4 o = v[j] * rs * cAl[lane + 64 * j] + cBl[lane + 64 * j]; \
                    if (PROJ_FP8) ((GAS unsigned*)(HB + (size_t)row * 2048))[lane + 64 * j] = pg8::pk4_fp8(o.x, o.y, o.z, o.w); \
                    else { v2u w; w.x = pk2(o.x, o.y); w.y = pk2(o.z, o.w); ((GAS v2u*)((bf16*)HB + (size_t)row * 2048))[lane + 64 * j] = w; } } \
            } } while (0)
            if (l == 0) NORM_LOOP(false); else NORM_LOOP(true);
#undef NORM_LOOP
#undef XLOAD
        }
        SEAM(pb + 0);
        if (INJ(1)) for (int rp = 0; rp < REPS(1); ++rp) {
            PHASE_BEGIN();
            unsigned char* const HB = ws + WS_H; unsigned char* const WIN = ws + WS_WIN; bf16* const PROJ = (bf16*)(ws + WS_PROJ); const float* const COS = (const float*)(ws + WS_COS); const float* const SIN = (const float*)(ws + WS_SIN);
            constexpr int KBP = PROJ_FP8 ? 2048 : 4096;
            pg8::DenseSched Sd; Sd.init(HB, WIN + (size_t)l * 6144 * KBP, S_, INW, KBP, G, bx);
            pg8::EpiProj E{PROJ, COS, SIN, attn_body::C2, PROJ_FP8 ? 1.f / WSC_K2048 : 1.f};
            pg8::gemm_phase<pg8::EpiProj, pg8::DenseSched, true, GEMM_SP2, PROJ_FP8 != 0>(L + RING_OFF, KBP, Sd, E, wave_s);
        }
        SEAM(pb + 1);
        if (INJ(2)) for (int rp = 0; rp < REPS(2); ++rp) {
            PHASE_BEGIN();
            const bf16* const PROJ = (const bf16*)(ws + WS_PROJ); float* const KMEAN = (float*)(ws + WS_KMEAN);
#if ATT_PV8 && ATT_QK8
            for (int t = gw; t < 4096; t += NGW) { const int st = t >> 8, kt = t & 255, hd2 = st >> 1, mp2 = st & 1, c = lane & 3;
                const bf16* const src = PROJ + (size_t)(64 * kt) * 6144 + C_KC + hd2 * 128 + mp2 * 64 + c * 16;
                unsigned char* const dst = ws + WS_K8 + (size_t)t * 4096;
                v4u ka[4], kb[4];
#pragma unroll
                for (int p = 0; p < 4; ++p) { const int key = 16 * p + (lane >> 2); ka[p] = *(const GAS v4u*)(src + (size_t)key * 6144); kb[p] = *(const GAS v4u*)(src + (size_t)key * 6144 + 8); }
#pragma unroll
                for (int p = 0; p < 4; ++p) { const int key = 16 * p + (lane >> 2); const v4u a = ka[p], b = kb[p];
                    v4u o; o.x = pg8::pk4_fp8(bflo(a.x), bfhi(a.x), bflo(a.y), bfhi(a.y)); o.y = pg8::pk4_fp8(bflo(a.z), bfhi(a.z), bflo(a.w), bfhi(a.w));
                    o.z = pg8::pk4_fp8(bflo(b.x), bfhi(b.x), bflo(b.y), bfhi(b.y)); o.w = pg8::pk4_fp8(bflo(b.z), bfhi(b.z), bflo(b.w), bfhi(b.w));
                    *(GAS v4u*)(dst + key * 64 + ((c ^ ((key >> 2) & 3)) * 16)) = o; }
            }
#endif
#if ATT_PV8
            for (int t = gw; t < 2048; t += NGW) { const int h = t >> 8, kt = t & 255;
                const bf16* const src = PROJ + (size_t)(64 * kt) * 6144 + C_VC + h * 128 + 2 * lane;
                unsigned char* const dst = ws + WS_VT8 + (size_t)t * 8192 + (size_t)(2 * lane) * 64; const int sw = (lane >> 1) & 3;
                unsigned oa[16], ob[16];
#pragma unroll
                for (int g = 0; g < 16; ++g) { unsigned w0, w1, w2, w3;
                    w0 = *(const GAS unsigned*)(src + (size_t)(4 * g + 0) * 6144); w1 = *(const GAS unsigned*)(src + (size_t)(4 * g + 1) * 6144);
                    w2 = *(const GAS unsigned*)(src + (size_t)(4 * g + 2) * 6144); w3 = *(const GAS unsigned*)(src + (size_t)(4 * g + 3) * 6144);
                    const int w = (g & 1) * 8 + ((g >> 3) & 1) * 4 + ((g >> 1) & 3);
                    oa[w] = pg8::pk4_fp8(bflo(w0) * VT8_SCALE, bflo(w1) * VT8_SCALE, bflo(w2) * VT8_SCALE, bflo(w3) * VT8_SCALE);
                    ob[w] = pg8::pk4_fp8(bfhi(w0) * VT8_SCALE, bfhi(w1) * VT8_SCALE, bfhi(w2) * VT8_SCALE, bfhi(w3) * VT8_SCALE); }
#pragma unroll
                for (int c = 0; c < 4; ++c) { *(GAS v4u*)(dst + ((c ^ sw) * 16)) = (v4u){oa[4 * c], oa[4 * c + 1], oa[4 * c + 2], oa[4 * c + 3]};
                    *(GAS v4u*)(dst + 64 + ((c ^ sw) * 16)) = (v4u){ob[4 * c], ob[4 * c + 1], ob[4 * c + 2], ob[4 * c + 3]}; }
            }
#endif
            for (int t = gw; t < 512; t += NGW) { const int h = t >> 6, j = t & 63; const int rg = lane >> 3, ch = lane & 7;
                float a[8];
#pragma unroll
                for (int e = 0; e < 8; ++e) a[e] = 0.f;
                for (int hb = 0; hb < 2; ++hb) { v4u kw[16];
#pragma unroll
                    for (int it = 0; it < 16; ++it) kw[it] = *(const GAS v4u*)(PROJ + (size_t)(256 * j + 8 * (16 * hb + it) + rg) * 6144 + C_KB + 64 * h + 8 * ch);
#pragma unroll
                    for (int it = 0; it < 16; ++it) { const v4u w = kw[it];
                        a[0] += bflo(w.x); a[1] += bfhi(w.x); a[2] += bflo(w.y); a[3] += bfhi(w.y); a[4] += bflo(w.z); a[5] += bfhi(w.z); a[6] += bflo(w.w); a[7] += bfhi(w.w); } }
#pragma unroll
                for (int e = 0; e < 8; ++e) { a[e] += shx(a[e], 8, lane); a[e] += shx(a[e], 16, lane); a[e] += shx(a[e], 32, lane); }
                if (lane < 8) {
#pragma unroll
                    for (int e = 0; e < 8; ++e) KMEAN[(size_t)(h * 64 + j) * 64 + 8 * lane + e] = a[e] * (1.f / 256.f); }
            }
        }
        SEAM(pb + 2);
        if (INJ(4)) for (int rp = 0; rp < REPS(4); ++rp) {
            PHASE_BEGIN();
            const bf16* const PROJ = (const bf16*)(ws + WS_PROJ); bf16* const TB = (bf16*)(ws + WS_T);
            char* const shm = (char*)lds + RING_OFF;
            if (rp == 0) for (int selp = 0; selp < SEL_PASSES; ++selp) {
            const float* const KMEAN = (const float*)(ws + WS_KMEAN); int* const LISTB = (selp == 0) ? (int*)(ws + WS_LIST) : (int*)(ws + (size_t)496 * MiB);
            int* const CNTB = (int*)(ctl + ((selp == 0) ? CW_CNTB : 131072 + 32768 * (selp - 1)) + l * 512 * CNTB_PITCH);
            for (int it = vcu; it < 512; it += G) { const int hd = it & 7, qq = it >> 3, qb = (qq & 1) ? 63 - (qq >> 1) : (qq >> 1);
                if (qb == 0) continue;
#if SEL_MFMA
                LAS unsigned char* const Bf = L; LAS float* const SC = (LAS float*)(L + 17408);
                __syncthreads();
                { const int ct = tid >> 7, ks = (tid >> 6) & 1, j = 16 * ct + (lane & 15), k0 = 32 * ks + 8 * (lane >> 4); float kv[8];
                  if (j < qb) { const f32x4 a = *(const GAS f32x4*)(KMEAN + (size_t)(hd * 64 + j) * 64 + k0), b = *(const GAS f32x4*)(KMEAN + (size_t)(hd * 64 + j) * 64 + k0 + 4);
                      kv[0] = a.x; kv[1] = a.y; kv[2] = a.z; kv[3] = a.w; kv[4] = b.x; kv[5] = b.y; kv[6] = b.z; kv[7] = b.w; }
                  else {
#pragma unroll
                      for (int i2 = 0; i2 < 8; ++i2) kv[i2] = 0.f; }
                  unsigned hi4[4], lo4[4];
#pragma unroll
                  for (int i2 = 0; i2 < 4; ++i2) { const float w0 = kv[2 * i2], w1 = kv[2 * i2 + 1]; const unsigned h0 = f2bf(w0), h1 = f2bf(w1);
                      const float r0 = w0 - __uint_as_float(h0 << 16), r1 = w1 - __uint_as_float(h1 << 16); hi4[i2] = h0 | (h1 << 16); lo4[i2] = f2bf(r0) | (f2bf(r1) << 16); }
                  *(LAS v4u*)(Bf + ((ct * 2 + ks) * 2 + 0) * 1024 + lane * 16) = (v4u){hi4[0], hi4[1], hi4[2], hi4[3]};
                  *(LAS v4u*)(Bf + ((ct * 2 + ks) * 2 + 1) * 1024 + lane * 16) = (v4u){lo4[0], lo4[1], lo4[2], lo4[3]}; }
                bf16x8 qa[2][2];
#pragma unroll
                for (int i = 0; i < 2; ++i)
#pragma unroll
                    for (int ks = 0; ks < 2; ++ks) qa[i][ks] = *(const GAS bf16x8*)(PROJ + (size_t)(qb * 256 + 32 * wave + 16 * i + (lane & 15)) * 6144 + C_QB + hd * 64 + 32 * ks + 8 * (lane >> 4));
                __syncthreads();
#pragma unroll
                for (int i = 0; i < 2; ++i)
#pragma unroll
                    for (int ct = 0; ct < 4; ++ct) { f32x4 acc = (f32x4){0.f, 0.f, 0.f, 0.f};
#pragma unroll
                        for (int ks = 0; ks < 2; ++ks) { const bf16x8 bh = *(const LAS bf16x8*)(Bf + ((ct * 2 + ks) * 2 + 0) * 1024 + lane * 16), bl = *(const LAS bf16x8*)(Bf + ((ct * 2 + ks) * 2 + 1) * 1024 + lane * 16);
                            acc = __builtin_amdgcn_mfma_f32_16x16x32_bf16(qa[i][ks], bh, acc, 0, 0, 0); acc = __builtin_amdgcn_mfma_f32_16x16x32_bf16(qa[i][ks], bl, acc, 0, 0, 0); }
#pragma unroll
                        for (int r = 0; r < 4; ++r) SC[(32 * wave + 16 * i + 4 * (lane >> 4) + r) * 65 + 16 * ct + (lane & 15)] = acc[r]; }
                __syncthreads();
                const int q = tid >> 1, dh = tid & 1;
                float b0 = -INFINITY, b1 = -INFINITY, b2 = -INFINITY; int i0 = -1, i1 = -1, i2 = -1;
                { const int jlo = 32 * dh, jhi = (qb < jlo + 32) ? qb : jlo + 32; const LAS float* const sr = SC + q * 65;
                  for (int j = jlo; j < jhi; ++j) { const float g = sr[j];
                      if (g > b0) { b2 = b1; i2 = i1; b1 = b0; i1 = i0; b0 = g; i0 = j; } else if (g > b1) { b2 = b1; i2 = i1; b1 = g; i1 = j; } else if (g > b2) { b2 = g; i2 = j; } } }
                { const float c0 = shx(b0, 1, lane), c1 = shx(b1, 1, lane), c2 = shx(b2, 1, lane);
                  const int d0 = __builtin_amdgcn_ds_bpermute((lane ^ 1) << 2, i0), d1 = __builtin_amdgcn_ds_bpermute((lane ^ 1) << 2, i1), d2 = __builtin_amdgcn_ds_bpermute((lane ^ 1) << 2, i2);
#define SEL_INS(g_, j_) do { const float g = (g_); const int j = (j_); if (g > b0) { b2 = b1; i2 = i1; b1 = b0; i1 = i0; b0 = g; i0 = j; } else if (g > b1) { b2 = b1; i2 = i1; b1 = g; i1 = j; } else if (g > b2) { b2 = g; i2 = j; } } while (0)
                  if (dh == 0) { SEL_INS(c0, d0); SEL_INS(c1, d1); SEL_INS(c2, d2); }
#undef SEL_INS
                }
#else
                LAS float* km = (LAS float*)(L + ATT_KM_OFF);
                __syncthreads();
                for (int k4 = tid; k4 < qb * 16; k4 += NWAVES * 64) ((LAS f32x4*)km)[k4] = ((const GAS f32x4*)(KMEAN + (size_t)hd * 64 * 64))[k4];
                const int q = tid >> 1, dh = tid & 1; float qf[32];
                { const bf16* qrow = PROJ + (size_t)(qb * 256 + q) * 6144 + C_QB + hd * 64 + dh * 32;
#pragma unroll
                  for (int c8 = 0; c8 < 4; ++c8) { const v4u w = *(const GAS v4u*)(qrow + 8 * c8); qf[8 * c8 + 0] = bflo(w.x); qf[8 * c8 + 1] = bfhi(w.x); qf[8 * c8 + 2] = bflo(w.y); qf[8 * c8 + 3] = bfhi(w.y);
                      qf[8 * c8 + 4] = bflo(w.z); qf[8 * c8 + 5] = bfhi(w.z); qf[8 * c8 + 6] = bflo(w.w); qf[8 * c8 + 7] = bfhi(w.w); } }
                __syncthreads();
                float b0 = -INFINITY, b1 = -INFINITY, b2 = -INFINITY; int i0 = -1, i1 = -1, i2 = -1;
                for (int j = 0; j < qb; ++j) { const LAS f32x4* kr = (const LAS f32x4*)(km + j * 64 + dh * 32); float g = 0.f;
#pragma unroll
                    for (int c4 = 0; c4 < 8; ++c4) { const f32x4 kv = kr[c4]; g = fmaf(qf[4 * c4 + 0], kv.x, g); g = fmaf(qf[4 * c4 + 1], kv.y, g); g = fmaf(qf[4 * c4 + 2], kv.z, g); g = fmaf(qf[4 * c4 + 3], kv.w, g); }
                    g += shx(g, 1, lane);
                    if (g > b0) { b2 = b1; i2 = i1; b1 = b0; i1 = i0; b0 = g; i0 = j; } else if (g > b1) { b2 = b1; i2 = i1; b1 = g; i1 = j; } else if (g > b2) { b2 = g; i2 = j; } }
#endif
                { LAS int* const lc = (LAS int*)(L + 16384); LAS int* const lb = lc + 64;
                  if (tid < 64) lc[tid] = 0;
                  __syncthreads();
                  int r0 = 0, r1 = 0, r2 = 0;
                  if (dh == 0) { if (i0 >= 0) r0 = __hip_atomic_fetch_add((int*)(lc + i0), 1, __ATOMIC_RELAXED, __HIP_MEMORY_SCOPE_WORKGROUP);
                                 if (i1 >= 0) r1 = __hip_atomic_fetch_add((int*)(lc + i1), 1, __ATOMIC_RELAXED, __HIP_MEMORY_SCOPE_WORKGROUP);
                                 if (i2 >= 0) r2 = __hip_atomic_fetch_add((int*)(lc + i2), 1, __ATOMIC_RELAXED, __HIP_MEMORY_SCOPE_WORKGROUP); }
                  __syncthreads();
                  if (tid < qb) { const int n = lc[tid]; lb[tid] = (n > 0) ? __hip_atomic_fetch_add(CNTB + (hd * 64 + tid) * CNTB_PITCH, n, RLX_AGENT) : 0; }
                  __syncthreads();
                  if (dh == 0) { const int row = qb * 256 + q;
                      if (i0 >= 0) LISTB[(size_t)(hd * 64 + i0) * 16384 + lb[i0] + r0] = row;
                      if (i1 >= 0) LISTB[(size_t)(hd * 64 + i1) * 16384 + lb[i1] + r1] = row | (1 << 16);
                      if (i2 >= 0) LISTB[(size_t)(hd * 64 + i2) * 16384 + lb[i2] + r2] = row | (2 << 16); } }
            }
            asm volatile("s_waitcnt vmcnt(0)" ::: "memory"); __syncthreads();
            if (selp == 0 && tid == 0) { __builtin_amdgcn_fence(__ATOMIC_RELEASE, "agent"); asm volatile("s_waitcnt vmcnt(0)" ::: "memory"); __hip_atomic_fetch_add(ctl + CW_SELDONE + 64 * l, 1u, RLX_AGENT); }
            }
            wconv::Tab wct; wct.w_in = KIN(float, 7); wct.w_out = KIN(float, 8); wct.w_gate = KIN(float, 14); wct.w_up = KIN(float, 15); wct.w_down = KIN(float, 16); wct.ws = ws; wct.l = l;
            wct.n_out = ((OUT_FP8 >> l) & 1) ? 4096 : 0; wct.total = wct.n_out + 65536 + 32768 + ((l == 0 && PROJ_FP8) ? 12288 : 0);
            wconv::State wcs; wcs.idx = gw; wcs.staged = gw; wcs.ctr = 0; wcs.stride = NGW;
            const unsigned wstage = (unsigned)(uintptr_t)(L + RING_OFF) + 98304u + 4096u * (unsigned)wave_s;
            if (rp == 0) { int ln3; asm volatile("v_mbcnt_lo_u32_b32 %0, -1, 0\n\tv_mbcnt_hi_u32_b32 %0, -1, %0" : "=v"(ln3)); wconv::issue(wct, wcs.idx, wstage, ln3); wcs.idx += wcs.stride; }
#if !defined(NO_ATT_C)
#if defined(REPEAT_SKIP_C)
            if (rp == 0)
#endif
            for (int vc = vcu; vc < 256; vc += G) {
                const int st = vc >> 4, hd = st >> 1, mp = st & 1, s = vc & 15;
                const attn_body::bf16* Qp = (const attn_body::bf16*)PROJ + C_QC + hd * 128 + mp * 64; const attn_body::bf16* Kp = (const attn_body::bf16*)PROJ + C_KC + hd * 128 + mp * 64;
                const attn_body::bf16* Vp = (const attn_body::bf16*)PROJ + C_VC + hd * 128; attn_body::bf16* Op = (attn_body::bf16*)TB + (size_t)mp * S_ * 1024 + hd * 128;
                for (int i = 3; i >= 0; --i) { const int qb = 32 * (i >> 1) + ((i & 1) ? 31 - s : s);
#if ATT_PV8 && ATT_QK8 && ATT_R8 && ATT_SUMMFMA
                    const unsigned char* const K8p = ws + WS_K8 + (size_t)st * 256 * 4096; float* const wsfc = (float*)((char*)lds + ATT_WSF_OFF);
                    if (rp == 0) attn_body::attn_unit128r9<8, WC_INLOOP != 0>(qb, Qp, K8p, ws + WS_VT8 + (size_t)hd * 256 * 8192, Op, 1024, shm, wsfc, wave_s, wct, wcs, wstage);
                    else attn_body::attn_unit128r9<8, false>(qb, Qp, K8p, ws + WS_VT8 + (size_t)hd * 256 * 8192, Op, 1024, shm, wsfc, wave_s, wct, wcs, wstage); }
#elif ATT_PV8 && ATT_QK8 && ATT_R8
                    const unsigned char* const K8p = ws + WS_K8 + (size_t)st * 256 * 4096; float* const wsfc = (float*)((char*)lds + ATT_WSF_OFF);
                    if (rp == 0) attn_body::attn_unit128r8<8, WC_INLOOP != 0>(qb, Qp, K8p, ws + WS_VT8 + (size_t)hd * 256 * 8192, Op, 1024, shm, wsfc, wave_s, wct, wcs, wstage);
                    else attn_body::attn_unit128r8<8, false>(qb, Qp, K8p, ws + WS_VT8 + (size_t)hd * 256 * 8192, Op, 1024, shm, wsfc, wave_s, wct, wcs, wstage); }
#elif ATT_PV8 && ATT_QK8
                    const unsigned char* const K8p = ws + WS_K8 + (size_t)st * 256 * 4096;
                    if (rp == 0) attn_body::attn_unit128q8<8, WC_INLOOP != 0>(qb, Qp, K8p, ws + WS_VT8 + (size_t)hd * 256 * 8192, Op, 1024, shm, wave_s, wct, wcs, wstage);
                    else attn_body::attn_unit128q8<8, false>(qb, Qp, K8p, ws + WS_VT8 + (size_t)hd * 256 * 8192, Op, 1024, shm, wave_s, wct, wcs, wstage); }
#elif ATT_PV8
                    if (rp == 0) attn_body::attn_unit128p8<8, WC_INLOOP != 0>(qb, Qp, Kp, ws + WS_VT8 + (size_t)hd * 256 * 8192, Op, 1024, shm, wave_s, wct, wcs, wstage);
                    else attn_body::attn_unit128p8<8, false>(qb, Qp, Kp, ws + WS_VT8 + (size_t)hd * 256 * 8192, Op, 1024, shm, wave_s, wct, wcs, wstage); }
#else
                    attn_body::attn_unit128<8>(qb, Qp, Kp, Vp, Op, 1024, shm, wave_s); }
#endif
            }
#endif
            if (rp == 0) { int ln3; asm volatile("v_mbcnt_lo_u32_b32 %0, -1, 0\n\tv_mbcnt_hi_u32_b32 %0, -1, %0" : "=v"(ln3));
                asm volatile("s_waitcnt vmcnt(0)" ::: "memory"); wconv::finish(wct, wcs.staged, wstage, ln3);
                while (wcs.idx < wct.total) { asm volatile("s_waitcnt lgkmcnt(0)" ::: "memory"); wconv::issue(wct, wcs.idx, wstage, ln3); asm volatile("s_waitcnt vmcnt(0)" ::: "memory"); wconv::finish(wct, wcs.idx, wstage, ln3); wcs.idx += wcs.stride; }
                asm volatile("s_waitcnt vmcnt(0) lgkmcnt(0)" ::: "memory"); }
            { int ln2; asm volatile("v_mbcnt_lo_u32_b32 %0, -1, 0\n\tv_mbcnt_hi_u32_b32 %0, -1, %0" : "=v"(ln2)); const int t2 = wave_s * 64 + ln2;
              LAS int* const ust = (LAS int*)(L + ATT_UST_OFF); LAS int* const wtot = ust + 520; LAS int* const qn = (LAS int*)(L + ATT_QN_OFF);
              const int* const CNTB = (const int*)(ctl + CW_CNTB + l * 512 * CNTB_PITCH);
              if (t2 == 0) { unsigned sp_ = 0; while (__hip_atomic_load(ctl + CW_SELDONE + 64 * l, RLX_AGENT) < (unsigned)G) { __builtin_amdgcn_s_sleep(2); if (++sp_ > (1u << 22)) break; }
                  __builtin_amdgcn_fence(__ATOMIC_ACQUIRE, "agent"); asm volatile("s_waitcnt vmcnt(0)" ::: "memory"); }
              if (t2 < 4) ((LAS unsigned*)(L + ATT_GB_OFF))[t2] = 0u;
              __syncthreads();
              const int nl = __hip_atomic_load(CNTB + t2 * CNTB_PITCH, RLX_AGENT); const int nch = (8 + ((nl + 31) >> 5) + 7) >> 3;
              int inc = nch;
#pragma unroll
              for (int o = 1; o < 64; o <<= 1) { const int v = shup_i(inc, o, t2 & 63); if ((t2 & 63) >= o) inc += v; }
              if ((t2 & 63) == 63) wtot[t2 >> 6] = inc;
              __syncthreads();
              int pre = 0;
              for (int w = 0; w < (t2 >> 6); ++w) pre += wtot[w];
              ust[t2 + 1] = pre + inc; if (t2 == 0) ust[0] = 0;
              LAS int* const nlv = (LAS int*)(L + LDSCTL_OFF + 12288); nlv[t2] = nl;
              __syncthreads();
              const int nB = ust[512], nU = nB + 3072;
              gu32* const qhead = ctl + CW_QUEUE + 64 * (l + 2 * rp);
              const int grp = wave_s >> 2, wg = wave_s & 3;
              char* const gshm = shm + grp * attn_body::BRA_GRP_BYTES; float* const wsf = (float*)((char*)lds + ATT_WSF_OFF) + wave_s * 128;
              LAS unsigned* const gb = (LAS unsigned*)(L + ATT_GB_OFF) + 2 * grp; LAS int* const gq = qn + 16 * grp;
              if (wg == 0 && ln2 == 0) gq[0] = (int)__hip_atomic_fetch_add(qhead, 1u, RLX_AGENT);
              attn_body::grp_bar(gb, ln2);
              for (int kq = 0;; ++kq) {
                  const int u = __builtin_amdgcn_readfirstlane(gq[kq & 1]);
                  if (u >= nU) break;
                  int unext_ = 0; if (wg == 0 && ln2 == 0) unext_ = (int)__hip_atomic_fetch_add(qhead, 1u, RLX_AGENT);
                  attn_body::BraUnit U;
                  if (u < nB) {
                      int lo_ = 0, hi_ = 512;
                      while (hi_ - lo_ > 1) { const int mid = (lo_ + hi_) >> 1; if (ust[mid] <= u) lo_ = mid; else hi_ = mid; }
                      const int hj = lo_, hd = hj >> 6, jb = hj & 63, c = u - ust[hj]; const int nlist = nlv[hj]; const int ntile = 8 + ((nlist + 31) >> 5);
                      U.Q = (const attn_body::bf16*)PROJ + C_QB + hd * 64; U.K = (const attn_body::bf16*)PROJ + C_KB + hd * 64; U.V = (const attn_body::bf16*)PROJ + C_VB + hd * 64;
                      U.PO = (attn_body::bf16*)(ws + WS_POB) + hd * 64; U.PL = (float*)(ws + WS_PLB) + hd;
                      U.kbase = 256 * jb; U.kstride = 1; U.t_first = 0; U.nkt = 4; U.nqt = (ntile - 8 * c) < 8 ? (ntile - 8 * c) : 8;
                      U.qbase = 0; U.qstride = 0; U.slotA = 0; U.list = (const int*)(ws + WS_LIST) + (size_t)hj * 16384; U.nlist = nlist; U.tile0 = 8 * c; U.ownrow0 = 256 * jb;
                      if (rp == 0) attn_body::bra_unit<1, 0>(U, gshm, wsf, (char*)lds + ATT_OST_OFF + wave_s * 2048, gb, wg, gq + ((kq + 1) & 1), unext_); else attn_body::bra_unit<1, ABLV>(U, gshm, wsf, (char*)lds + ATT_OST_OFF + wave_s * 2048, gb, wg, gq + ((kq + 1) & 1), unext_);
                  } else {
                      const int a = u - nB, hd = a / 384, r = a % 384, pt = r >> 7, w7 = r & 127; const int dil = (pt == 0) ? 1 : (pt == 1) ? 4 : 16;
                      const int nblk = 128 / dil, rho = w7 / nblk, ib = w7 % nblk;
                      U.Q = (const attn_body::bf16*)PROJ + C_QA + hd * 64; U.K = (const attn_body::bf16*)PROJ + C_KA + hd * 64; U.V = (const attn_body::bf16*)PROJ + C_VA + hd * 64;
                      U.PO = (attn_body::bf16*)(ws + WS_POA) + hd * 64; U.PL = (float*)(ws + WS_PLA) + hd;
                      U.kbase = rho + dil * (128 * ib - 128); U.kstride = dil; U.t_first = (ib == 0) ? 2 : 0; U.nkt = 4; U.nqt = 4;
                      U.qbase = rho + dil * 128 * ib; U.qstride = dil; U.slotA = pt; U.list = nullptr; U.nlist = 0; U.tile0 = 0; U.ownrow0 = 0;
                      if (rp == 0) attn_body::bra_unit<0, 0>(U, gshm, wsf, (char*)lds + ATT_OST_OFF + wave_s * 2048, gb, wg, gq + ((kq + 1) & 1), unext_); else attn_body::bra_unit<0, ABLV>(U, gshm, wsf, (char*)lds + ATT_OST_OFF + wave_s * 2048, gb, wg, gq + ((kq + 1) & 1), unext_);
                  }
                  attn_body::grp_bar_nv(gb, ln2);
              }
              __syncthreads();
            }
        }
        SEAM(pb + 4);
        if (INJ(5)) for (int rp = 0; rp < REPS(5); ++rp) {
            PHASE_BEGIN();
            const float* const lam_q1 = KIN(float, 9); const float* const lam_k1 = KIN(float, 10); const float* const lam_q2 = KIN(float, 11); const float* const lam_k2 = KIN(float, 12); const float* const g_sub = KIN(float, 13);
            const bf16* const TB = (const bf16*)(ws + WS_T); unsigned char* const MERGED = ws + WS_MERGED;
            const bf16* const POA = (const bf16*)(ws + WS_POA); const bf16* const POB = (const bf16*)(ws + WS_POB); const float* const PLA = (const float*)(ws + WS_PLA); const float* const PLB = (const float*)(ws + WS_PLB);
            const float d1 = wave_sum(lam_q1[l * 64 + lane] * lam_k1[l * 64 + lane], lane), d2 = wave_sum(lam_q2[l * 64 + lane] * lam_k2[l * 64 + lane], lane);
            const float lam = expf(d1) - expf(d2) + lam_init;
            const bool ofp8 = ((OUT_FP8 >> l) & 1) != 0;
            const f32x4 gs = ((const f32x4*)(g_sub + l * 128))[lane & 31]; const float osc = (1.f - lam_init) * (ofp8 ? MSCALE : 1.f);
            for (int row = gw; row < S_; row += NGW) {
                { float ls[3], mx = -INFINITY;
#pragma unroll
                  for (int sl = 0; sl < 3; ++sl) { ls[sl] = PLA[((size_t)sl * S_ + row) * 8 + (lane >> 3)]; mx = fmaxf(mx, ls[sl]); }
                  float acc[8], wsum = 0.f;
#pragma unroll
                  for (int e = 0; e < 8; ++e) acc[e] = 0.f;
#pragma unroll
                  for (int sl = 0; sl < 3; ++sl) { const float wgt = exp2f(ls[sl] - mx); wsum += wgt; const v4u w = ((const GAS v4u*)(POA + ((size_t)sl * S_ + row) * 512))[lane];
                      acc[0] += wgt * bflo(w.x); acc[1] += wgt * bfhi(w.x); acc[2] += wgt * bflo(w.y); acc[3] += wgt * bfhi(w.y); acc[4] += wgt * bflo(w.z); acc[5] += wgt * bfhi(w.z); acc[6] += wgt * bflo(w.w); acc[7] += wgt * bfhi(w.w); }
                  const float iw = (ofp8 ? MSCALE : 1.f) / wsum;
                  if (ofp8) { v2u o; o.x = pg8::pk4_fp8(acc[0] * iw, acc[1] * iw, acc[2] * iw, acc[3] * iw); o.y = pg8::pk4_fp8(acc[4] * iw, acc[5] * iw, acc[6] * iw, acc[7] * iw); ((GAS v2u*)(MERGED + (size_t)row * 2048))[lane] = o; }
                  else { v4u o; o.x = pk2(acc[0] * iw, acc[1] * iw); o.y = pk2(acc[2] * iw, acc[3] * iw); o.z = pk2(acc[4] * iw, acc[5] * iw); o.w = pk2(acc[6] * iw, acc[7] * iw); ((GAS v4u*)((bf16*)MERGED + (size_t)row * 2048))[lane] = o; } }
                { const int own = row >> 8, nsel = own < 3 ? own : 3; float ls[4], mx = -INFINITY;
#pragma unroll
                  for (int sl = 0; sl < 4; ++sl) { const bool on = (sl == 3) || (sl < nsel); ls[sl] = on ? PLB[((size_t)sl * S_ + row) * 8 + (lane >> 3)] : -INFINITY; mx = fmaxf(mx, ls[sl]); }
                  float acc[8], wsum = 0.f;
#pragma unroll
                  for (int e = 0; e < 8; ++e) acc[e] = 0.f;
#pragma unroll
                  for (int sl = 0; sl < 4; ++sl) { const bool on = (sl == 3) || (sl < nsel);
                      if (on) { const float wgt = exp2f(ls[sl] - mx); wsum += wgt; const v4u w = ((const GAS v4u*)(POB + ((size_t)sl * S_ + row) * 512))[lane];
                          acc[0] += wgt * bflo(w.x); acc[1] += wgt * bfhi(w.x); acc[2] += wgt * bflo(w.y); acc[3] += wgt * bfhi(w.y); acc[4] += wgt * bflo(w.z); acc[5] += wgt * bfhi(w.z); acc[6] += wgt * bflo(w.w); acc[7] += wgt * bfhi(w.w); } }
                  const float iw = (ofp8 ? MSCALE : 1.f) / wsum;
                  if (ofp8) { v2u o; o.x = pg8::pk4_fp8(acc[0] * iw, acc[1] * iw, acc[2] * iw, acc[3] * iw); o.y = pg8::pk4_fp8(acc[4] * iw, acc[5] * iw, acc[6] * iw, acc[7] * iw); ((GAS v2u*)(MERGED + (size_t)row * 2048 + 512))[lane] = o; }
                  else { v4u o; o.x = pk2(acc[0] * iw, acc[1] * iw); o.y = pk2(acc[2] * iw, acc[3] * iw); o.z = pk2(acc[4] * iw, acc[5] * iw); o.w = pk2(acc[6] * iw, acc[7] * iw); ((GAS v4u*)((bf16*)MERGED + (size_t)row * 2048 + 512))[lane] = o; } }
#pragma unroll
                for (int j = 0; j < 4; ++j) { const v2u ta = ((const GAS v2u*)(TB + (size_t)row * 1024))[lane + 64 * j], tb = ((const GAS v2u*)(TB + (size_t)(S_ + row) * 1024))[lane + 64 * j];
                    const f32x4 a = (f32x4){bflo(ta.x), bfhi(ta.x), bflo(ta.y), bfhi(ta.y)}, b = (f32x4){bflo(tb.x), bfhi(tb.x), bflo(tb.y), bfhi(tb.y)};
                    const f32x4 v = a - lam * b; float ss = (v.x * v.x + v.y * v.y) + (v.z * v.z + v.w * v.w);
                    ss += shx(ss, 1, lane); ss += shx(ss, 2, lane); ss += shx(ss, 4, lane); ss += shx(ss, 8, lane); ss += shx(ss, 16, lane);
                    const float rs = 1.f / sqrtf(ss * (1.f / 128.f) + RMS_EPS); const f32x4 o = v * rs * gs * osc;
                    if (ofp8) ((GAS unsigned*)(MERGED + (size_t)row * 2048 + 1024))[lane + 64 * j] = pg8::pk4_fp8(o.x, o.y, o.z, o.w);
                    else { v2u w; w.x = pk2(o.x, o.y); w.y = pk2(o.z, o.w); ((GAS v2u*)((bf16*)MERGED + (size_t)row * 2048 + 1024))[lane + 64 * j] = w; } }
            }
        }
        SEAM(pb + 5);
        if (INJ(6)) for (int rp = 0; rp < REPS(6); ++rp) {
            PHASE_BEGIN();
            const float* const x_in = KIN(float, 0); bf16* const xbuf = (bf16*)(ws + WS_XB); const float* const mod = (const float*)(ws + WS_MOD) + l * 12288;
            unsigned char* const MERGED = ws + WS_MERGED; unsigned char* const WOUT = ws + WS_WOUT;
            if (l == 0) { constexpr bool F8 = (OUT_FP8 & 1) != 0; constexpr int KBO = F8 ? 2048 : 4096;
                pg8::DenseSched Sd; Sd.init(MERGED, WOUT, S_, 2048, KBO, G, bx);
                pg8::EpiGateRes<true> E{x_in, xbuf, mod + 4096, F8 ? 1.f / (WSC_K2048 * MSCALE) : 1.f};
                pg8::gemm_phase<pg8::EpiGateRes<true>, pg8::DenseSched, true, GEMM_SP2, F8>(L + RING_OFF, KBO, Sd, E, wave_s); }
            else { constexpr bool F8 = (OUT_FP8 & 2) != 0; constexpr int KBO = F8 ? 2048 : 4096;
                pg8::DenseSched Sd; Sd.init(MERGED, WOUT + (size_t)2048 * 4096, S_, 2048, KBO, G, bx);
                pg8::EpiGateRes<false> E{xbuf, xbuf, mod + 4096, F8 ? 1.f / (WSC_K2048 * MSCALE) : 1.f};
                pg8::gemm_phase<pg8::EpiGateRes<false>, pg8::DenseSched, true, GEMM_SP2, F8>(L + RING_OFF, KBO, Sd, E, wave_s); }
        }
        SEAM(pb + 6);
        if (INJ(7)) for (int rp = 0; rp < REPS(7); ++rp) {
            PHASE_BEGIN();
            const float* const g_mlp = KIN(float, 6); const float* const w_router = KIN(float, 17); const float* const b_router = KIN(float, 18); const bf16* const xbuf = (const bf16*)(ws + WS_XB);
            const float* const mod = (const float*)(ws + WS_MOD) + l * 12288; unsigned char* const HB = ws + WS_H;
            int* const EID = (int*)(ws + WS_EID); float* const WTS = (float*)(ws + WS_WTS); int* const CNT = (int*)(ws + WS_CNT);
            LAS unsigned char* const WF = L; LAS float* const rawp = (LAS float*)(L + LDSCTL_OFF + 4096); LAS float* const bpart = (LAS float*)(L + LDSCTL_OFF + 12288); LAS float* const biasv = (LAS float*)(L + LDSCTL_OFF + 14336); LAS float* const rsv = (LAS float*)(L + LDSCTL_OFF + 14464);
            { const float* const gm = g_mlp + l * 2048; const float* const scv = mod + 8192; const float* const shv = mod + 6144;
              for (int c = tid; c < 4096; c += NWAVES * 64) { const int e = c & 15, g = (c >> 4) & 3, ks = c >> 6, k0 = 32 * ks + 8 * g; unsigned hi4[4], lo4[4];
#pragma unroll
                  for (int i2 = 0; i2 < 4; ++i2) { const int ka = k0 + 2 * i2, kb = ka + 1;
                      const float w0 = w_router[ka * 16 + e] * (gm[ka] * (1.f + scv[ka])), w1 = w_router[kb * 16 + e] * (gm[kb] * (1.f + scv[kb]));
                      const unsigned h0 = f2bf(w0), h1 = f2bf(w1); const float r0 = w0 - __uint_as_float(h0 << 16), r1 = w1 - __uint_as_float(h1 << 16);
                      hi4[i2] = h0 | (h1 << 16); lo4[i2] = f2bf(r0) | (f2bf(r1) << 16); }
                  *(LAS v4u*)(WF + ks * 2048 + (g * 16 + e) * 16) = (v4u){hi4[0], hi4[1], hi4[2], hi4[3]}; *(LAS v4u*)(WF + ks * 2048 + 1024 + (g * 16 + e) * 16) = (v4u){lo4[0], lo4[1], lo4[2], lo4[3]}; }
              { const int e = tid & 15, part = tid >> 4; float s = 0.f;
                for (int k = 64 * part; k < 64 * part + 64; ++k) s += shv[k] * w_router[k * 16 + e];
                bpart[part * 16 + e] = s; }
              __syncthreads();
              if (tid < 16) { float s = 0.f; for (int p = 0; p < 32; ++p) s += bpart[p * 16 + tid]; biasv[tid] = s; }
              __syncthreads(); }
            float bz[16];
#pragma unroll
            for (int e = 0; e < 16; ++e) bz[e] = biasv[e];
            f32x4 cA[8];
#pragma unroll
            for (int j = 0; j < 8; ++j) { const int c4 = lane + 64 * j; const f32x4 g = ((const f32x4*)(g_mlp + l * 2048))[c4]; const f32x4 sc = ((const f32x4*)(mod + 8192))[c4];
                cA[j] = g * (1.f + sc); }
            float br[16];
#pragma unroll
            for (int e = 0; e < 16; ++e) br[e] = b_router[e];
            for (int rb = bx; rb < NROWBLK; rb += G) {
                { const int kh = wave & 1; const bf16* const xr = xbuf + (size_t)(64 * rb + 16 * (wave >> 1) + (lane & 15)) * 2048 + kh * 1024 + (lane >> 4) * 8; const LAS unsigned char* const wf = WF + kh * 32 * 2048 + lane * 16;
                  f32x4 acc = (f32x4){0.f, 0.f, 0.f, 0.f};
#pragma unroll 8
                  for (int ks = 0; ks < 32; ++ks) { const bf16x8 a = *(const GAS bf16x8*)(xr + ks * 32); const bf16x8 bh = *(const LAS bf16x8*)(wf + ks * 2048), bl = *(const LAS bf16x8*)(wf + ks * 2048 + 1024);
                      acc = __builtin_amdgcn_mfma_f32_16x16x32_bf16(a, bh, acc, 0, 0, 0); acc = __builtin_amdgcn_mfma_f32_16x16x32_bf16(a, bl, acc, 0, 0, 0); }
#pragma unroll
                  for (int j = 0; j < 4; ++j) rawp[kh * 1024 + (16 * (wave >> 1) + 4 * (lane >> 4) + j) * 16 + (lane & 15)] = acc[j]; }
                __syncthreads();
                v2u nv[8];
#pragma unroll
                for (int j = 0; j < 8; ++j) nv[j] = NTL((const GAS v2u*)(xbuf + (size_t)(64 * rb + 8 * wave) * 2048) + (lane + 64 * j));
                for (int i = 0; i < 8; ++i) { const int row = 64 * rb + 8 * wave + i;
                    f32x4 v[8]; float ss = 0.f;
#pragma unroll
                    for (int j = 0; j < 8; ++j) { v[j] = (f32x4){bflo(nv[j].x), bfhi(nv[j].x), bflo(nv[j].y), bfhi(nv[j].y)}; ss += (v[j].x * v[j].x + v[j].y * v[j].y) + (v[j].z * v[j].z + v[j].w * v[j].w); }
                    if (i < 7) {
#pragma unroll
                        for (int j = 0; j < 8; ++j) nv[j] = NTL((const GAS v2u*)(xbuf + (size_t)(row + 1) * 2048) + (lane + 64 * j));
                    }
                    const float rs = 1.f / sqrtf(wave_sum(ss, lane) * (1.f / 2048.f) + RMS_EPS);
#pragma unroll
                    for (int j = 0; j < 8; ++j) { const f32x4 o = v[j] * rs * cA[j] + ((const GAS f32x4*)(mod + 6144))[lane + 64 * j]; ((GAS unsigned*)(HB + (size_t)row * 2048))[lane + 64 * j] = pg8::pk4_fp8(o.x, o.y, o.z, o.w); }
                    if (lane == 0) rsv[8 * wave + i] = rs;
                }
                __syncthreads();
                if (wave == 0) { const int row = 64 * rb + lane; const float rs = rsv[lane];
                    float p[16];
                    { const LAS f32x4* const r0 = (const LAS f32x4*)(rawp + lane * 16); const LAS f32x4* const r1 = (const LAS f32x4*)(rawp + 1024 + lane * 16);
#pragma unroll
                      for (int q = 0; q < 4; ++q) { const f32x4 a = r0[q] + r1[q]; p[4 * q] = a.x * rs + bz[4 * q]; p[4 * q + 1] = a.y * rs + bz[4 * q + 1]; p[4 * q + 2] = a.z * rs + bz[4 * q + 2]; p[4 * q + 3] = a.w * rs + bz[4 * q + 3]; } }
                    float sg[16], sv[16];
#pragma unroll
                    for (int e = 0; e < 16; ++e) { sv[e] = 1.f / (1.f + expf(-p[e])); sg[e] = sv[e] + br[e]; }
                    float gsc[4];
#pragma unroll
                    for (int g4 = 0; g4 < 4; ++g4) { const float a = sg[4 * g4], b = sg[4 * g4 + 1], c = sg[4 * g4 + 2], d = sg[4 * g4 + 3];
                        const float h1 = fmaxf(a, b), l1 = fminf(a, b), h2 = fmaxf(c, d), l2 = fminf(c, d); gsc[g4] = fmaxf(h1, h2) + fmaxf(fminf(h1, h2), fmaxf(l1, l2)); }
                    int gi = 0; float gb = gsc[0];
#pragma unroll
                    for (int g4 = 1; g4 < 4; ++g4) if (gsc[g4] > gb) { gb = gsc[g4]; gi = g4; }
                    float cd[4], cs[4];
#pragma unroll
                    for (int k = 0; k < 4; ++k) { cd[k] = (gi == 0) ? sg[k] : (gi == 1) ? sg[4 + k] : (gi == 2) ? sg[8 + k] : sg[12 + k]; cs[k] = (gi == 0) ? sv[k] : (gi == 1) ? sv[4 + k] : (gi == 2) ? sv[8 + k] : sv[12 + k]; }
                    int l0 = 0; float v0 = cd[0], s0 = cs[0];
#pragma unroll
                    for (int k = 1; k < 4; ++k) if (cd[k] > v0) { v0 = cd[k]; l0 = k; s0 = cs[k]; }
                    int l1i = -1; float v1 = -INFINITY, s1 = 0.f;
#pragma unroll
                    for (int k = 0; k < 4; ++k) if (k != l0 && cd[k] > v1) { v1 = cd[k]; l1i = k; s1 = cs[k]; }
                    const int e0 = 4 * gi + l0, e1 = 4 * gi + l1i; const float wsum = s0 + s1;
                    EID[2 * row] = e0; EID[2 * row + 1] = e1; WTS[2 * row] = s0 / wsum; WTS[2 * row + 1] = s1 / wsum;
                    int mine = 0;
#pragma unroll
                    for (int e = 0; e < 16; ++e) { const int c = __popcll(__ballot(e0 == e)) + __popcll(__ballot(e1 == e)); if (lane == e) mine = c; }
                    if (lane < 16) CNT[rb * 16 + lane] = mine; }
                __syncthreads();
            }
        }
        SEAM(pb + 7);
        if (INJ(8)) for (int rp = 0; rp < REPS(8); ++rp) {
            PHASE_BEGIN();
            const unsigned char* const HB = ws + WS_H; unsigned char* const XS = ws + WS_XS;
            const int* const EID = (const int*)(ws + WS_EID); const float* const WTS = (const float*)(ws + WS_WTS); int* const ROWTOK = (int*)(ws + WS_ROWTOK); float* const ROWW = (float*)(ws + WS_ROWW); const int* const CNT = (const int*)(ws + WS_CNT);
            for (int rb = bx; rb < NROWBLK; rb += G) {
                v4u gw[16];
#pragma unroll
                for (int i = 0; i < 8; ++i) { const int row = 64 * rb + 8 * wave + i; gw[2 * i] = ((const GAS v4u*)(HB + (size_t)row * 2048))[lane]; gw[2 * i + 1] = ((const GAS v4u*)(HB + (size_t)row * 2048))[lane + 64]; }
                COMPUTE_SEGMENTS(rb);
                if (wave == 0) { const int row = 64 * rb + lane; const int e0 = EID[2 * row], e1 = EID[2 * row + 1]; int p0 = 0, p1 = 0;
                    const unsigned long long lt = (1ull << lane) - 1ull;
                    for (int e = 0; e < 16; ++e) { const unsigned long long m0 = __ballot(e0 == e), m1 = __ballot(e1 == e); const int r = __popcll(m0 & lt) + __popcll(m1 & lt);
                        if (e0 == e) p0 = basee[e] + r; if (e1 == e) p1 = basee[e] + r; }
                    postab[2 * lane] = p0; postab[2 * lane + 1] = p1;
                    ROWTOK[p0] = 2 * row; ROWTOK[p1] = 2 * row + 1; ROWW[p0] = WTS[2 * row]; ROWW[p1] = WTS[2 * row + 1]; }
                __syncthreads();
                {
#pragma unroll
                  for (int i = 0; i < 8; ++i) { const int r = 8 * wave + i; const int p0 = postab[2 * r], p1 = postab[2 * r + 1];
                      ((GAS v4u*)(XS + (size_t)p0 * 2048))[lane] = gw[2 * i]; ((GAS v4u*)(XS + (size_t)p0 * 2048))[lane + 64] = gw[2 * i + 1];
                      ((GAS v4u*)(XS + (size_t)p1 * 2048))[lane] = gw[2 * i]; ((GAS v4u*)(XS + (size_t)p1 * 2048))[lane + 64] = gw[2 * i + 1]; } }
                if (rb < 16) { const int pbeg = segs[rb] + tot[rb], pend = segs[rb + 1];
                    for (int p = pbeg + tid; p < pend; p += NWAVES * 64) { ROWTOK[p] = -1; ROWW[p] = 0.f; } }
                __syncthreads();
            }
        }
        SEAM(pb + 8);
        if (INJ(9)) for (int rp = 0; rp < REPS(9); ++rp) {
            PHASE_BEGIN();
            const int* const CNT = (const int*)(ws + WS_CNT); unsigned char* const XS = ws + WS_XS; unsigned char* const WGU = ws + WS_WGU; unsigned char* const ACT = ws + WS_ACT;
            COMPUTE_SEGMENTS(0);
            pg8::MoeSched Sm; Sm.init(XS, WGU + (size_t)l * 16 * 2048 * 2048, segs[16], 2048, 2048, (size_t)2048 * 2048, (const PG8_LAS unsigned char*)p2e, G, bx);
            pg8::EpiSwiglu E{ACT, 1.f / WSC_K2048, ASCALE};
            pg8::gemm_phase<pg8::EpiSwiglu, pg8::MoeSched, true, GEMM_SP2, true>(L + RING_OFF, 2048, Sm, E, wave_s);
        }
        SEAM(pb + 9);
        if (INJ(10)) for (int rp = 0; rp < REPS(10); ++rp) {
            PHASE_BEGIN();
            const int* const CNT = (const int*)(ws + WS_CNT); unsigned char* const ACT = ws + WS_ACT; unsigned char* const WDN = ws + WS_WDN; bf16* const YB = (bf16*)(ws + WS_Y);
            const int* const ROWTOK = (const int*)(ws + WS_ROWTOK); const float* const ROWW = (const float*)(ws + WS_ROWW);
            COMPUTE_SEGMENTS(0);
            pg8::MoeSched Sm; Sm.init(ACT, WDN + (size_t)l * 16 * 2048 * 1024, segs[16], 2048, 1024, (size_t)2048 * 1024, (const PG8_LAS unsigned char*)p2e, G, bx);
            pg8::EpiDown E{YB, ROWTOK, ROWW, 1.f / (WSC_K1024 * ASCALE)};
            pg8::gemm_phase<pg8::EpiDown, pg8::MoeSched, true, GEMM_SP2, true>(L + RING_OFF, 1024, Sm, E, wave_s);
        }
        SEAM(pb + 10);
    }
#if defined(STAMP_A)
    float st_delta = 0.f, st_add = 0.f;
    if (hi - lo > 1) {
        if (kbx == 0 && threadIdx.x == 0) { const float ta = (float)(stamps[STAMP_A + 1] - stamps[STAMP_A]) * 0.01f, tb = (float)(stamps[STAMP_B + 1] - stamps[STAMP_B]) * 0.01f;
            __hip_atomic_store(ctl + CW_QUEUE + 512, __float_as_uint(ta * (1.f / 2000.f)), RLX_AGENT); __hip_atomic_store(ctl + CW_QUEUE + 576, __float_as_uint(tb), RLX_AGENT); }
        xcd_barrier(bar);
        st_delta = __uint_as_float(__hip_atomic_load(ctl + CW_QUEUE + 512, RLX_AGENT)); st_add = __uint_as_float(__hip_atomic_load(ctl + CW_QUEUE + 576, RLX_AGENT));
    }
#endif
    if (((PHMASK >> 12) & 1) && IN(23)) {
        PHASE_BEGIN();
        const float* const g_final = KIN(float, 19); float* const outp = ka->out; const bf16* const xbuf = (const bf16*)(ws + WS_XB); const float* const MOD = (const float*)(ws + WS_MOD); const bf16* const YB = (const bf16*)(ws + WS_Y);
        f32x4 cA[8], cG[8];
#pragma unroll
        for (int j = 0; j < 8; ++j) { const int c4 = lane + 64 * j; cA[j] = ((const f32x4*)g_final)[c4]; cG[j] = ((const f32x4*)(MOD + 12288 + 10240))[c4]; }
        v2u nv[8], na[8], nb[8];
#pragma unroll
        for (int j = 0; j < 8; ++j) { nv[j] = NTL((const GAS v2u*)(xbuf + (size_t)gw * 2048) + (lane + 64 * j)); na[j] = NTL((const GAS v2u*)(YB + (size_t)(2 * gw) * 2048) + (lane + 64 * j)); nb[j] = NTL((const GAS v2u*)(YB + (size_t)(2 * gw + 1) * 2048) + (lane + 64 * j)); }
        for (int row = gw; row < S_; row += NGW) {
            f32x4 v[8]; v2u ya[8], yb[8]; float ss = 0.f;
#pragma unroll
            for (int j = 0; j < 8; ++j) { v[j] = (f32x4){bflo(nv[j].x), bfhi(nv[j].x), bflo(nv[j].y), bfhi(nv[j].y)}; ya[j] = na[j]; yb[j] = nb[j]; }
            const int nrow = row + NGW;
            if (nrow < S_) {
#pragma unroll
                for (int j = 0; j < 8; ++j) { nv[j] = NTL((const GAS v2u*)(xbuf + (size_t)nrow * 2048) + (lane + 64 * j)); na[j] = NTL((const GAS v2u*)(YB + (size_t)(2 * nrow) * 2048) + (lane + 64 * j)); nb[j] = NTL((const GAS v2u*)(YB + (size_t)(2 * nrow + 1) * 2048) + (lane + 64 * j)); }
            }
#pragma unroll
            for (int j = 0; j < 8; ++j) { const v2u a = ya[j], b = yb[j];
                const f32x4 ys = (f32x4){bflo(a.x) + bflo(b.x), bfhi(a.x) + bfhi(b.x), bflo(a.y) + bflo(b.y), bfhi(a.y) + bfhi(b.y)};
                v[j] += cG[j] * ys; ss += (v[j].x * v[j].x + v[j].y * v[j].y) + (v[j].z * v[j].z + v[j].w * v[j].w); }
            const float rs = 1.f / sqrtf(wave_sum(ss, lane) * (1.f / 2048.f) + RMS_EPS);
#pragma unroll
            for (int j = 0; j < 8; ++j) { f32x4 o_ = v[j] * rs * cA[j];
#if defined(STAMP_A)
                o_ = o_ * (1.f + st_delta); if (row == 0 && lane == 0 && j == 0) o_.x += st_add;
#endif
                ((GAS f32x4*)(outp + (size_t)row * 2048))[lane + 64 * j] = o_; }
        }
    }
#undef IN
#undef INJ
#undef REPS
#undef PHASE_BEGIN
#undef KIN
#undef SEAM
#undef COMPUTE_SEGMENTS
}

extern "C" void kernel_launch(void* const* d_in, const int* in_sizes, int n_in, void* d_out, int out_size, void* d_ws, size_t ws_size, hipStream_t stream) {
    static int grid = 0;
    if (grid == 0) {
        if (n_in != 20 || in_sizes[0] != S_ * DM_ || out_size != S_ * DM_ || ws_size < WS_END) { fprintf(stderr, "kernel_launch: unexpected shapes or workspace (%d inputs, in0 %d, out %d, ws %zu); nothing launched\n", n_in, n_in > 0 ? in_sizes[0] : -1, out_size, ws_size); grid = -1; return; }
        int dev = 0, cus = 0, per_cu = 0;
        if (hipGetDevice(&dev) != hipSuccess || hipDeviceGetAttribute(&cus, hipDeviceAttributeMultiprocessorCount, dev) != hipSuccess) { grid = -1; return; }
        if (hipFuncSetAttribute((const void*)fwd, hipFuncAttributeMaxDynamicSharedMemorySize, LDS_BYTES) != hipSuccess) { fprintf(stderr, "kernel_launch: hipFuncSetAttribute failed\n"); grid = -1; return; }
        if (hipOccupancyMaxActiveBlocksPerMultiprocessor(&per_cu, (const void*)fwd, NWAVES * 64, LDS_BYTES) != hipSuccess || per_cu < 1) fprintf(stderr, "kernel_launch: occupancy query reports %d blocks per CU\n", per_cu);
        (void)hipGetLastError();
        grid = cus;
    }
    if (grid < 0) return;
    if (hipMemsetAsync((char*)d_ws + WS_CTL, 0, CTL_ZERO_BYTES, stream) != hipSuccess) return;
    Args a{};
    for (int i = 0; i < 20; ++i) a.in[i] = d_in[i];
    a.out = (float*)d_out; a.ws = (unsigned char*)d_ws;
    if (MK_N_LAUNCHES == 1) { a.ph_lo = 0; a.ph_hi = N_PHASES; hipLaunchKernelGGL(fwd, dim3(grid), dim3(NWAVES * 64), LDS_BYTES, stream, a); }
    else for (int p = 0; p < N_PHASES; ++p) { a.ph_lo = p; a.ph_hi = p + 1; hipLaunchKernelGGL(fwd, dim3(grid), dim3(NWAVES * 64), LDS_BYTES, stream, a); }
}
```
